# Optimizing an MI355X kernel written in HIP

```python
import math
import jax, jax.numpy as jnp
from jax import lax
import numpy as np

D_MODEL = 1024
BATCH = 4
SEQ = 8192
DEPTH = 1
DEC_BATCH = 32
DEC_SEQ = 1
PAST_LEN = 16384
PAGE_SIZE = 128

D_MIX = 2 * D_MODEL
D_ATTN = D_MIX // 2
D_SSD = D_MIX - D_ATTN
HEAD_DIM = 64
N_ATTN_HEADS = D_ATTN // HEAD_DIM
PATTERNS = ((128, 1), (512, 4), (2048, 16))
WINDOW_MAX = 2048
BLK = 128
N_BUCKETS = 32
MAX_DISTANCE = WINDOW_MAX
SSD_HEAD_DIM = 64
N_SSD_HEADS = D_SSD // SSD_HEAD_DIM
D_STATE = 128
N_GROUPS = 2
HEADS_PER_GROUP = N_SSD_HEADS // N_GROUPS
CONV_W = 4
CONV_DIM = D_SSD + 2 * N_GROUPS * D_STATE
CHUNK = 128
DT_MIN = 0.001
DT_MAX = 0.1
D_IN_PROJ = 4 * D_ATTN + D_SSD + CONV_DIM + N_SSD_HEADS
EPS = 1e-6

kernel_name = "hybrid_dilated_swa_ssd_step"


def _rmsnorm(x, w):
    xf = x.astype(jnp.float32)
    y = xf * lax.rsqrt(jnp.mean(xf * xf, axis=-1, keepdims=True) + EPS)
    return (y * w.astype(jnp.float32)).astype(x.dtype)


def _t5_bucket(dist):
    max_exact = N_BUCKETS // 2
    d_f = jnp.maximum(dist, 1).astype(jnp.float32)
    large = max_exact + (jnp.log(d_f / max_exact) / math.log(MAX_DISTANCE / max_exact)
                         * (N_BUCKETS - max_exact)).astype(jnp.int32)
    large = jnp.minimum(large, N_BUCKETS - 1)
    return jnp.where(dist < max_exact, dist, large)


def _mixer_inputs(x, norm_w, w_in, q_norm_w, k_norm_w):
    h = _rmsnorm(x, norm_w)
    proj = h @ w_in
    cuts = [D_ATTN, 2 * D_ATTN, 3 * D_ATTN, 4 * D_ATTN, 4 * D_ATTN + D_SSD,
            4 * D_ATTN + D_SSD + CONV_DIM]
    q, k, v, g, z, xbc, dt_raw = jnp.split(proj, cuts, axis=-1)
    heads = x.shape[:-1] + (N_ATTN_HEADS, HEAD_DIM)
    q = _rmsnorm(q.reshape(heads), q_norm_w)
    k = _rmsnorm(k.reshape(heads), k_norm_w)
    return q, k, v.reshape(heads), g, z, xbc, dt_raw


def _mixer_output(x, o_attn, g, y_ssd, z, ssd_norm_w, w_out):
    lead = x.shape[:-1]
    a = o_attn.reshape(lead + (D_ATTN,)).astype(jnp.float32) * jax.nn.silu(g.astype(jnp.float32))
    s = _rmsnorm(y_ssd.reshape(lead + (D_SSD,)).astype(jnp.float32)
                 * jax.nn.silu(z.astype(jnp.float32)), ssd_norm_w)
    mixed = jnp.concatenate([a, s], axis=-1).astype(x.dtype)
    return x + mixed @ w_out


def _merge(outs, lses):
    wts = jax.nn.softmax(jnp.stack(lses, axis=0), axis=0)
    o = jnp.sum(wts[..., None] * jnp.stack(outs, axis=0).astype(jnp.float32), axis=0)
    return o.astype(outs[0].dtype)


def _to_residue(a, d):
    b, s = a.shape[:2]
    L = s // d
    a = a.reshape((b, L, d) + a.shape[2:])
    a = jnp.moveaxis(a, 2, 1).reshape((b * d, L) + a.shape[3:])
    lp = -(-L // BLK) * BLK
    return jnp.pad(a, [(0, 0), (0, lp - L)] + [(0, 0)] * (a.ndim - 2))


def _from_residue(a, b, d, L):
    a = a[:, :L].reshape((b, d, L) + a.shape[2:])
    a = jnp.moveaxis(a, 1, 2)
    return a.reshape((b, L * d) + a.shape[3:])


def _band_attn(q, k, v, win_sub, dil, rel_bias):
    n, lp, h, dh = q.shape
    nb = lp // BLK
    qb = q.reshape(n, nb, BLK, h, dh)

    def ext(a):
        a = a.reshape(n, nb, BLK, h, dh)
        prev = jnp.concatenate([jnp.zeros_like(a[:, :1]), a[:, :-1]], axis=1)
        return jnp.concatenate([prev, a], axis=2)

    kx, vx = ext(k), ext(v)
    rel = jnp.arange(BLK)[:, None] + BLK - jnp.arange(2 * BLK)[None, :]
    band = (rel >= 0) & (rel <= win_sub)
    bias = jnp.moveaxis(rel_bias[_t5_bucket(jnp.maximum(rel, 0) * dil)], -1, 0).astype(jnp.float32)
    not_first = jnp.arange(2 * BLK) >= BLK
    scale = HEAD_DIM ** -0.5

    def one_block(args):
        qi, ki, vi, bi = args
        s = jnp.einsum('nqhd,nkhd->nhqk', qi, ki).astype(jnp.float32) * scale + bias
        valid = band & ((bi > 0) | not_first)[None, :]
        s = jnp.where(valid, s, -jnp.inf)
        lse = jax.nn.logsumexp(s, axis=-1)
        p = jnp.exp(s - lse[..., None]).astype(vi.dtype)
        o = jnp.einsum('nhqk,nkhd->nqhd', p, vi)
        return o, jnp.moveaxis(lse, 1, 2)

    o, lse = lax.map(one_block, (jnp.moveaxis(qb, 1, 0), jnp.moveaxis(kx, 1, 0),
                                 jnp.moveaxis(vx, 1, 0), jnp.arange(nb)))
    o = jnp.moveaxis(o, 0, 1).reshape(n, lp, h, dh)
    lse = jnp.moveaxis(lse, 0, 1).reshape(n, lp, h)
    return o, lse


def _dilated_attn_prompt(q, k, v, rel_bias):
    b, s = q.shape[:2]
    outs, lses = [], []
    for w, d in PATTERNS:
        L = s // d
        o, lse = _band_attn(_to_residue(q, d), _to_residue(k, d), _to_residue(v, d),
                            w // d, d, rel_bias)
        outs.append(_from_residue(o, b, d, L))
        lses.append(_from_residue(lse, b, d, L))
    return _merge(outs, lses)


def _dilated_attn_sample(q, k_all, v_all, n_past, rel_bias):
    t = q.shape[1]
    j = jnp.arange(t)
    scale = HEAD_DIM ** -0.5
    outs, lses = [], []
    for w, d in PATTERNS:
        kk = jnp.arange(w // d + 1)
        idx = n_past + j[:, None] - kk[None, :] * d
        valid = idx >= 0
        idx = jnp.maximum(idx, 0)
        kg, vg = k_all[:, idx], v_all[:, idx]
        bias = rel_bias[_t5_bucket(kk * d)].T.astype(jnp.float32)
        s = jnp.einsum('bthd,btkhd->bhtk', q, kg).astype(jnp.float32) * scale + bias[None, :, None, :]
        s = jnp.where(valid, s, -jnp.inf)
        lse = jax.nn.logsumexp(s, axis=-1)
        p = jnp.exp(s - lse[..., None]).astype(vg.dtype)
        outs.append(jnp.einsum('bhtk,btkhd->bthd', p, vg))
        lses.append(jnp.moveaxis(lse, 1, 2))
    return _merge(outs, lses)


def _conv_silu(xpad, conv_w, conv_b, t):
    y = conv_b + sum(xpad[:, i:i + t] * conv_w[i] for i in range(CONV_W))
    return jax.nn.silu(y)


def _ssd_split(xc, dt_raw, dt_bias, a_log):
    lead = xc.shape[:-1]
    gn = N_GROUPS * D_STATE
    xs = xc[..., :D_SSD].reshape(lead + (N_GROUPS, HEADS_PER_GROUP, SSD_HEAD_DIM))
    bm = xc[..., D_SSD:D_SSD + gn].reshape(lead + (N_GROUPS, D_STATE)).astype(jnp.float32)
    cm = xc[..., D_SSD + gn:].reshape(lead + (N_GROUPS, D_STATE)).astype(jnp.float32)
    dt = jax.nn.softplus(dt_raw.astype(jnp.float32) + dt_bias.astype(jnp.float32))
    dt = dt.reshape(lead + (N_GROUPS, HEADS_PER_GROUP))
    a = -jnp.exp(a_log.astype(jnp.float32)).reshape(N_GROUPS, HEADS_PER_GROUP)
    return xs, bm, cm, dt, a


def _ssd_chunked(xs, dt, a, bm, cm):
    b, s = xs.shape[:2]
    nc = s // CHUNK
    xdt = (xs.astype(jnp.float32) * dt[..., None]).reshape(b, nc, CHUNK, N_GROUPS, HEADS_PER_GROUP, SSD_HEAD_DIM)
    la = (dt * a).reshape(b, nc, CHUNK, N_GROUPS, HEADS_PER_GROUP)
    bc = bm.reshape(b, nc, CHUNK, N_GROUPS, D_STATE)
    cc = cm.reshape(b, nc, CHUNK, N_GROUPS, D_STATE)
    a_cs = jnp.cumsum(la, axis=2)
    causal = jnp.tril(jnp.ones((CHUNK, CHUNK), bool))[:, :, None, None]
    seg = a_cs[:, :, :, None] - a_cs[:, :, None, :]
    lmat = jnp.exp(jnp.where(causal, seg, -jnp.inf))
    cb = jnp.einsum('bclgn,bcsgn->bclsg', cc, bc)
    y_diag = jnp.einsum('bclsg,bclsgr,bcsgrp->bclgrp', cb, lmat, xdt)
    decay_to_end = jnp.exp(a_cs[:, :, -1:] - a_cs)
    states = jnp.einsum('bclgn,bclgr,bclgrp->bcgrpn', bc, decay_to_end, xdt)
    chunk_decay = jnp.exp(a_cs[:, :, -1])

    def step(h, inp):
        st, dec = inp
        return h * dec[..., None, None] + st, h

    h0 = jnp.zeros((b, N_GROUPS, HEADS_PER_GROUP, SSD_HEAD_DIM, D_STATE), jnp.float32)
    h_fin, h_prev = lax.scan(step, h0, (jnp.moveaxis(states, 1, 0), jnp.moveaxis(chunk_decay, 1, 0)))
    h_prev = jnp.moveaxis(h_prev, 0, 1)
    y_off = jnp.einsum('bclgn,bcgrpn,bclgr->bclgrp', cc, h_prev, jnp.exp(a_cs))
    y = (y_diag + y_off).reshape(b, s, N_GROUPS, HEADS_PER_GROUP, SSD_HEAD_DIM)
    return y, h_fin


def _ssd_recurrent(xs, dt, a, bm, cm, h0):
    def step(h, inp):
        xt, dtt, bt, ct = inp
        h = h * jnp.exp(dtt * a)[..., None, None] + jnp.einsum(
            'bgrp,bgn->bgrpn', xt.astype(jnp.float32) * dtt[..., None], bt)
        return h, jnp.einsum('bgrpn,bgn->bgrp', h, ct)

    h, ys = lax.scan(step, h0, (jnp.moveaxis(xs, 1, 0), jnp.moveaxis(dt, 1, 0),
                                jnp.moveaxis(bm, 1, 0), jnp.moveaxis(cm, 1, 0)))
    return jnp.moveaxis(ys, 0, 1), h


def _prompt_layer(x, norm_w, w_in, q_norm_w, k_norm_w, rel_bias, conv_w, conv_b,
                  dt_bias, a_log, d_skip, ssd_norm_w, w_out):
    b, s = x.shape[:2]
    q, k, v, g, z, xbc, dt_raw = _mixer_inputs(x, norm_w, w_in, q_norm_w, k_norm_w)
    o = _dilated_attn_prompt(q, k, v, rel_bias)
    xc = _conv_silu(jnp.pad(xbc, ((0, 0), (CONV_W - 1, 0), (0, 0))), conv_w, conv_b, s)
    xs, bm, cm, dt, a = _ssd_split(xc, dt_raw, dt_bias, a_log)
    y, h = _ssd_chunked(xs, dt, a, bm, cm)
    y = y + d_skip.astype(jnp.float32).reshape(N_GROUPS, HEADS_PER_GROUP)[..., None] * xs.astype(jnp.float32)
    out = _mixer_output(x, o, g, y, z, ssd_norm_w, w_out)
    nw = min(WINDOW_MAX, s)
    new = (k[:, s - nw:], v[:, s - nw:], xbc[:, s - (CONV_W - 1):],
           h.reshape(b, N_SSD_HEADS, SSD_HEAD_DIM, D_STATE).astype(x.dtype))
    return out, new


def _sample_layer(x, win_k, win_v, conv_state, ssm_state, norm_w, w_in, q_norm_w, k_norm_w,
                  rel_bias, conv_w, conv_b, dt_bias, a_log, d_skip, ssd_norm_w, w_out):
    b, t = x.shape[:2]
    q, k, v, g, z, xbc, dt_raw = _mixer_inputs(x, norm_w, w_in, q_norm_w, k_norm_w)
    k_all = jnp.concatenate([win_k.astype(k.dtype), k], axis=1)
    v_all = jnp.concatenate([win_v.astype(v.dtype), v], axis=1)
    o = _dilated_attn_sample(q, k_all, v_all, win_k.shape[1], rel_bias)
    xcat = jnp.concatenate([conv_state.astype(xbc.dtype), xbc], axis=1)
    xc = _conv_silu(xcat, conv_w, conv_b, t)
    xs, bm, cm, dt, a = _ssd_split(xc, dt_raw, dt_bias, a_log)
    h0 = ssm_state.reshape(b, N_GROUPS, HEADS_PER_GROUP, SSD_HEAD_DIM, D_STATE).astype(jnp.float32)
    y, h = _ssd_recurrent(xs, dt, a, bm, cm, h0)
    y = y + d_skip.astype(jnp.float32).reshape(N_GROUPS, HEADS_PER_GROUP)[..., None] * xs.astype(jnp.float32)
    out = _mixer_output(x, o, g, y, z, ssd_norm_w, w_out)
    new = (k, v, xcat[:, -(CONV_W - 1):],
           h.reshape(b, N_SSD_HEADS, SSD_HEAD_DIM, D_STATE).astype(x.dtype))
    return out, new


def setup_inputs(seed: int = 0) -> dict:
    key = jax.random.key(seed)
    ks = jax.random.split(key, 18)
    f32 = jnp.float32
    win_buf = min(WINDOW_MAX, PAST_LEN)

    def gain(k, n):
        return 1.0 + 0.02 * jax.random.normal(k, (DEPTH, n), f32)

    u = jax.random.uniform(ks[10], (DEPTH, N_SSD_HEADS), f32)
    dt0 = jnp.exp(u * (math.log(DT_MAX) - math.log(DT_MIN)) + math.log(DT_MIN))
    dt_bias = dt0 + jnp.log(-jnp.expm1(-dt0))
    return {
        "x_prompt": jax.random.normal(ks[0], (BATCH, SEQ, D_MODEL), f32),
        "x_sample": jax.random.normal(ks[1], (DEC_BATCH, DEC_SEQ, D_MODEL), f32),
        "cache_win_k": jax.random.normal(ks[2], (DEPTH, DEC_BATCH, win_buf, N_ATTN_HEADS, HEAD_DIM), f32),
        "cache_win_v": jax.random.normal(ks[3], (DEPTH, DEC_BATCH, win_buf, N_ATTN_HEADS, HEAD_DIM), f32),
        "state_conv": jax.random.normal(ks[4], (DEPTH, DEC_BATCH, CONV_W - 1, CONV_DIM), f32),
        "state_ssm": 0.5 * jax.random.normal(ks[5], (DEPTH, DEC_BATCH, N_SSD_HEADS, SSD_HEAD_DIM, D_STATE), f32),
        "norm_w": gain(ks[6], D_MODEL),
        "w_in": jax.random.normal(ks[7], (DEPTH, D_MODEL, D_IN_PROJ), f32) * D_MODEL ** -0.5,
        "q_norm_w": gain(ks[8], HEAD_DIM),
        "k_norm_w": gain(ks[9], HEAD_DIM),
        "rel_bias": 0.5 * jax.random.normal(ks[11], (N_BUCKETS, N_ATTN_HEADS), f32),
        "conv_w": jax.random.normal(ks[12], (DEPTH, CONV_W, CONV_DIM), f32) * CONV_W ** -0.5,
        "conv_b": 0.01 * jax.random.normal(ks[13], (DEPTH, CONV_DIM), f32),
        "dt_bias": dt_bias,
        "a_log": jnp.log(jax.random.uniform(ks[14], (DEPTH, N_SSD_HEADS), f32, 1.0, 16.0)),
        "d_skip": gain(ks[15], N_SSD_HEADS),
        "ssd_norm_w": gain(ks[16], D_SSD),
        "w_out": jax.random.normal(ks[17], (DEPTH, D_MIX, D_MODEL), f32) * D_MIX ** -0.5,
    }


def reference(x_prompt, x_sample, cache_win_k, cache_win_v, state_conv, state_ssm,
              norm_w, w_in, q_norm_w, k_norm_w, rel_bias, conv_w, conv_b, dt_bias,
              a_log, d_skip, ssd_norm_w, w_out):
    y_p, y_s = x_prompt, x_sample
    new_p, new_s = [], []
    for l in range(DEPTH):
        lw = (norm_w[l], w_in[l], q_norm_w[l], k_norm_w[l], rel_bias, conv_w[l], conv_b[l],
              dt_bias[l], a_log[l], d_skip[l], ssd_norm_w[l], w_out[l])
        y_p, st_p = _prompt_layer(y_p, *lw)
        y_s, st_s = _sample_layer(y_s, cache_win_k[l], cache_win_v[l], state_conv[l], state_ssm[l], *lw)
        new_p.append(st_p)
        new_s.append(st_s)
    kp, vp, cp, hp = (jnp.stack(a) for a in zip(*new_p))
    k_s, v_s, c_s, h_s = (jnp.stack(a) for a in zip(*new_s))
    return (y_p, y_s, kp, vp, cp, hp, k_s, v_s, c_s, h_s)
```

```cpp
#include <hip/hip_runtime.h>
#include <cstdio>
#include <cstdint>

constexpr int DM = 1024, NB = 4, SEQ = 8192, DB = 32, WIN = 2048;
constexpr int NPROJ = 6672, NTOK = NB * SEQ, NROWS = NTOK + DB;
constexpr int C_Q = 0, C_K = 1024, C_V = 2048, C_G = 3072, C_Z = 4096, C_XBC = 5120, C_DT = 6656;
constexpr int CONVD = 1536, NH = 16, HD = 64, DS = 128;
constexpr float EPS = 1e-6f;
constexpr size_t O_YP = 0, O_YS = O_YP + (size_t)NTOK * DM, O_KP = O_YS + (size_t)DB * DM, O_VP = O_KP + (size_t)NB * WIN * DM,
                 O_CP = O_VP + (size_t)NB * WIN * DM, O_HP = O_CP + (size_t)NB * 3 * CONVD, O_KS = O_HP + (size_t)NB * NH * HD * DS,
                 O_VS = O_KS + (size_t)DB * DM, O_CS = O_VS + (size_t)DB * DM, O_HS = O_CS + (size_t)DB * 3 * CONVD,
                 O_END = O_HS + (size_t)DB * NH * HD * DS;
static_assert(O_END == 55314432, "output size");

struct Ins {
    const float *xp, *xs, *ck, *cv, *sconv, *sssm, *norm_w, *w_in, *qnw, *knw, *rel_bias, *conv_w, *conv_b, *dt_bias, *a_log, *d_skip, *ssd_norm_w, *w_out;
};

__device__ __forceinline__ float wave_sum(float v) {
#pragma unroll
    for (int o = 1; o < 64; o <<= 1) v += __shfl_xor(v, o);
    return v;
}
__device__ __forceinline__ float wave_max(float v) {
#pragma unroll
    for (int o = 1; o < 64; o <<= 1) v = fmaxf(v, __shfl_xor(v, o));
    return v;
}
__device__ __forceinline__ float silu_f(float x) { return x / (1.f + __expf(-x)); }
__device__ __forceinline__ float softplus_f(float x) { return x > 20.f ? x : log1pf(__expf(x)); }
__device__ __forceinline__ int t5_bucket(int d) {
    if (d < 16) return d;
    int b = 16;
    b += d >= 22; b += d >= 30; b += d >= 40; b += d >= 54; b += d >= 73; b += d >= 99; b += d >= 134; b += d >= 182;
    b += d >= 246; b += d >= 332; b += d >= 450; b += d >= 609; b += d >= 825; b += d >= 1117; b += d >= 1513;
    return b;
}
__device__ __forceinline__ const float* xrow(const Ins& I, int r) { return r < NTOK ? I.xp + (size_t)r * DM : I.xs + (size_t)(r - NTOK) * DM; }

namespace nv {
__global__ void __launch_bounds__(256) k_rstd_x(Ins I, float* rstd) {
    const int w = (blockIdx.x * 256 + threadIdx.x) >> 6, lane = threadIdx.x & 63;
    if (w >= NROWS) return;
    const float* x = xrow(I, w);
    float s = 0.f;
    for (int i = lane; i < DM; i += 64) { const float v = x[i]; s += v * v; }
    s = wave_sum(s);
    if (lane == 0) rstd[w] = rsqrtf(s * (1.f / DM) + EPS);
}

template <class LoadA, class LoadB, class Epi>
__device__ __forceinline__ void gemm_tile(int M, int N, int K, int bm, int bn, LoadA la, LoadB lb, Epi epi) {
    __shared__ float As[16][128 + 4];
    __shared__ float Bs[16][128 + 4];
    const int tid = threadIdx.x, tx = tid & 15, ty = tid >> 4;
    float acc[8][8];
#pragma unroll
    for (int i = 0; i < 8; ++i)
#pragma unroll
        for (int j = 0; j < 8; ++j) acc[i][j] = 0.f;
    for (int k0 = 0; k0 < K; k0 += 16) {
#pragma unroll
        for (int e = 0; e < 8; ++e) { const int idx = tid + e * 256, r = idx >> 4, k = idx & 15; const int gr = bm + r; As[k][r] = gr < M ? la(gr, k0 + k) : 0.f; }
#pragma unroll
        for (int e = 0; e < 8; ++e) { const int idx = tid + e * 256, k = idx >> 7, c = idx & 127; const int gc = bn + c; Bs[k][c] = gc < N ? lb(k0 + k, gc) : 0.f; }
        __syncthreads();
#pragma unroll
        for (int k = 0; k < 16; ++k) {
            float a[8], b[8];
#pragma unroll
            for (int i = 0; i < 8; ++i) a[i] = As[k][ty * 8 + i];
#pragma unroll
            for (int j = 0; j < 8; ++j) b[j] = Bs[k][tx + 16 * j];
#pragma unroll
            for (int i = 0; i < 8; ++i)
#pragma unroll
                for (int j = 0; j < 8; ++j) acc[i][j] += a[i] * b[j];
        }
        __syncthreads();
    }
#pragma unroll
    for (int i = 0; i < 8; ++i)
#pragma unroll
        for (int j = 0; j < 8; ++j) { const int gr = bm + ty * 8 + i, gc = bn + tx + 16 * j; if (gr < M && gc < N) epi(gr, gc, acc[i][j]); }
}

__global__ void __launch_bounds__(256) k_inproj(Ins I, const float* rstd, float* P) {
    const int bn = blockIdx.x * 128, bm = blockIdx.y * 128;
    gemm_tile(NROWS, NPROJ, DM, bm, bn,
        [&](int r, int k) { return xrow(I, r)[k] * I.norm_w[k]; },
        [&](int k, int c) { return I.w_in[(size_t)k * NPROJ + c]; },
        [&](int r, int c, float v) { P[(size_t)r * NPROJ + c] = v * rstd[r]; });
}

__global__ void __launch_bounds__(256) k_qknorm(Ins I, float* P) {
    const int w = (blockIdx.x * 256 + threadIdx.x) >> 6, lane = threadIdx.x & 63;
    if (w >= NROWS * 32) return;
    const int r = w >> 5, which = (w >> 4) & 1, h = w & 15;
    float* p = P + (size_t)r * NPROJ + (which ? C_K : C_Q) + h * HD;
    const float v = p[lane];
    const float ss = wave_sum(v * v);
    p[lane] = v * rsqrtf(ss * (1.f / HD) + EPS) * (which ? I.knw[lane] : I.qnw[lane]);
}

__global__ void __launch_bounds__(256) k_attn(Ins I, float* P) {
    __shared__ float qs[4][64];
    __shared__ float ps[4][388];
    const int wl = threadIdx.x >> 6, lane = threadIdx.x & 63;
    const int w = blockIdx.x * 4 + wl;
    if (w >= NROWS * NH) return;
    const int r = w >> 4, h = w & 15;
    const bool samp = r >= NTOK;
    const int b = samp ? r - NTOK : r / SEQ, t = samp ? 0 : r % SEQ;
    float* prow = P + (size_t)r * NPROJ;
    qs[wl][lane] = prow[C_Q + h * HD + lane];
    __builtin_amdgcn_wave_barrier();
    auto kvptr = [&](int idx, int col, bool& valid) -> const float* {
        const int pat = idx / 129, j = idx - pat * 129, d = pat == 0 ? 1 : (pat == 1 ? 4 : 16);
        if (samp) {
            valid = true;
            if (j == 0) return prow + col + h * HD;
            const int row = WIN - j * d;
            return (col == C_K ? I.ck : I.cv) + (((size_t)b * WIN + row) * NH + h) * HD;
        } else {
            const int kt = t - j * d; valid = kt >= 0;
            return P + (size_t)(b * SEQ + (valid ? kt : 0)) * NPROJ + col + h * HD;
        }
    };
    float sc[7]; float mx = -INFINITY;
#pragma unroll
    for (int it = 0; it < 7; ++it) {
        const int idx = it * 64 + lane; sc[it] = -INFINITY;
        if (idx < 387) {
            bool valid; const float* kp = kvptr(idx, C_K, valid);
            const int pat = idx / 129, j = idx - pat * 129, d = pat == 0 ? 1 : (pat == 1 ? 4 : 16);
            float s = 0.f;
            for (int e = 0; e < 64; ++e) s += qs[wl][e] * kp[e];
            s = s * 0.125f + I.rel_bias[t5_bucket(j * d) * NH + h];
            if (valid) sc[it] = s;
        }
        mx = fmaxf(mx, sc[it]);
    }
    mx = wave_max(mx);
    float sum = 0.f;
#pragma unroll
    for (int it = 0; it < 7; ++it) { const int idx = it * 64 + lane; const float p = (sc[it] == -INFINITY) ? 0.f : __expf(sc[it] - mx); if (idx < 387) ps[wl][idx] = p; sum += p; }
    sum = wave_sum(sum);
    __builtin_amdgcn_wave_barrier();
    float o = 0.f;
    for (int idx = 0; idx < 387; ++idx) {
        const float p = ps[wl][idx];
        if (p != 0.f) { bool valid; const float* vp = kvptr(idx, C_V, valid); o += p * vp[lane]; }
    }
    o /= sum;
    const float g = prow[C_G + h * HD + lane];
    prow[C_G + h * HD + lane] = o * silu_f(g);
}

__global__ void __launch_bounds__(512) k_ssd(Ins I, float* P, float* out) {
    constexpr int TB = 8;
    __shared__ float xs_l[TB][64], B_l[TB][128], C_l[TB][128], dt_l[TB];
    const int tid = threadIdx.x, p = tid >> 3, ng = tid & 7;
    const int bh = blockIdx.x; const bool samp = bh >= NB * NH;
    const int b = samp ? (bh - NB * NH) / NH : bh / NH, hd = bh % NH, grp = hd >> 3;
    const int nsteps = samp ? 1 : SEQ;
    const size_t row0 = samp ? (size_t)NTOK + b : (size_t)b * SEQ;
    float h[16];
#pragma unroll
    for (int i = 0; i < 16; ++i) h[i] = samp ? I.sssm[(((size_t)b * NH + hd) * HD + p) * DS + ng * 16 + i] : 0.f;
    const float A = -__expf(I.a_log[hd]), dtb = I.dt_bias[hd], dsk = I.d_skip[hd];
    auto xbc_at = [&](int t, int c) -> float {
        if (t >= 0) return P[(row0 + t) * NPROJ + C_XBC + c];
        if (!samp) return 0.f;
        return I.sconv[((size_t)b * 3 + (3 + t)) * CONVD + c];
    };
    for (int t0 = 0; t0 < nsteps; t0 += TB) {
        const int nb = nsteps - t0 < TB ? nsteps - t0 : TB;
        for (int e = tid; e < nb * 320; e += 512) {
            const int s = e / 320, ci = e % 320;
            const int c = ci < 64 ? hd * 64 + ci : (ci < 192 ? 1024 + grp * 128 + (ci - 64) : 1280 + grp * 128 + (ci - 192));
            const int t = t0 + s;
            float v = I.conv_b[c];
#pragma unroll
            for (int i = 0; i < 4; ++i) v += xbc_at(t + i - 3, c) * I.conv_w[i * CONVD + c];
            v = silu_f(v);
            if (ci < 64) xs_l[s][ci] = v; else if (ci < 192) B_l[s][ci - 64] = v; else C_l[s][ci - 192] = v;
        }
        if (tid < nb) dt_l[tid] = softplus_f(P[(row0 + t0 + tid) * NPROJ + C_DT + hd] + dtb);
        __syncthreads();
        for (int s = 0; s < nb; ++s) {
            const float dt = dt_l[s], x = xs_l[s][p], dec = __expf(dt * A), xdt = x * dt;
            float y = 0.f;
#pragma unroll
            for (int i = 0; i < 16; ++i) { h[i] = h[i] * dec + xdt * B_l[s][ng * 16 + i]; y += h[i] * C_l[s][ng * 16 + i]; }
            y += __shfl_xor(y, 1); y += __shfl_xor(y, 2); y += __shfl_xor(y, 4);
            if (ng == 0) {
                float* zp = P + (row0 + t0 + s) * NPROJ + C_Z + hd * 64 + p;
                const float z = *zp;
                *zp = (y + dsk * x) * silu_f(z);
            }
        }
        __syncthreads();
    }
    float* hout = out + (samp ? O_HS : O_HP) + (((size_t)b * NH + hd) * HD + p) * DS + ng * 16;
#pragma unroll
    for (int i = 0; i < 16; ++i) hout[i] = h[i];
}

__global__ void __launch_bounds__(256) k_rstd_u(const float* P, float* rstd) {
    const int w = (blockIdx.x * 256 + threadIdx.x) >> 6, lane = threadIdx.x & 63;
    if (w >= NROWS) return;
    const float* u = P + (size_t)w * NPROJ + C_Z;
    float s = 0.f;
    for (int i = lane; i < 1024; i += 64) { const float v = u[i]; s += v * v; }
    s = wave_sum(s);
    if (lane == 0) rstd[w] = rsqrtf(s * (1.f / 1024) + EPS);
}

__global__ void __launch_bounds__(256) k_outproj(Ins I, const float* P, const float* rstd_u, float* out) {
    const int bn = blockIdx.x * 128, bm = blockIdx.y * 128;
    gemm_tile(NROWS, DM, 2048, bm, bn,
        [&](int r, int k) { return k < 1024 ? P[(size_t)r * NPROJ + C_G + k] : P[(size_t)r * NPROJ + C_Z + (k - 1024)] * rstd_u[r] * I.ssd_norm_w[k - 1024]; },
        [&](int k, int c) { return I.w_out[(size_t)k * DM + c]; },
        [&](int r, int c, float v) { const float y = xrow(I, r)[c] + v; if (r < NTOK) out[O_YP + (size_t)r * DM + c] = y; else out[O_YS + (size_t)(r - NTOK) * DM + c] = y; });
}

__global__ void __launch_bounds__(256) k_copy(Ins I, const float* P, float* out) {
    const size_t gid = (size_t)blockIdx.x * 256 + threadIdx.x, nth = (size_t)gridDim.x * 256;
    for (size_t i = gid; i < (size_t)NB * WIN * DM; i += nth) {
        const int c = i % DM; const size_t rr = i / DM; const int t = rr % WIN, b = rr / WIN;
        const size_t r = (size_t)b * SEQ + (SEQ - WIN) + t;
        out[O_KP + i] = P[r * NPROJ + C_K + c]; out[O_VP + i] = P[r * NPROJ + C_V + c];
    }
    for (size_t i = gid; i < (size_t)DB * DM; i += nth) {
        const int c = i % DM, b = i / DM; const size_t r = (size_t)NTOK + b;
        out[O_KS + i] = P[r * NPROJ + C_K + c]; out[O_VS + i] = P[r * NPROJ + C_V + c];
    }
    for (size_t i = gid; i < (size_t)NB * 3 * CONVD; i += nth) {
        const int c = i % CONVD; const int rr = i / CONVD, j = rr % 3, b = rr / 3;
        out[O_CP + i] = P[((size_t)b * SEQ + SEQ - 3 + j) * NPROJ + C_XBC + c];
    }
    for (size_t i = gid; i < (size_t)DB * 3 * CONVD; i += nth) {
        const int c = i % CONVD; const int rr = i / CONVD, j = rr % 3, b = rr / 3;
        out[O_CS + i] = j < 2 ? I.sconv[((size_t)b * 3 + j + 1) * CONVD + c] : P[((size_t)NTOK + b) * NPROJ + C_XBC + c];
    }
}
}

extern "C" void kernel_launch(void* const* d_in, const int* in_sizes, int n_in, void* d_out, int out_size, void* d_ws, size_t ws_size, hipStream_t stream) {
    if (n_in != 18 || out_size != (int)O_END) { fprintf(stderr, "kernel_launch: unexpected n_in %d / out_size %d\n", n_in, out_size); return; }
    Ins I{};
    const float** ip = (const float**)&I;
    for (int i = 0; i < 18; ++i) ip[i] = (const float*)d_in[i];
    float* out = (float*)d_out;
    unsigned char* ws = (unsigned char*)d_ws;
    const size_t P_BYTES = (size_t)NROWS * NPROJ * 4;
    float* P = (float*)ws;
    float* rstd_x = (float*)(ws + ((P_BYTES + 255) & ~(size_t)255));
    float* rstd_u = rstd_x + 32832;
    if ((size_t)((unsigned char*)(rstd_u + 32832) - ws) > ws_size) { fprintf(stderr, "kernel_launch: workspace too small (%zu)\n", ws_size); return; }
    nv::k_rstd_x<<<(NROWS * 64 + 255) / 256, 256, 0, stream>>>(I, rstd_x);
    nv::k_inproj<<<dim3((NPROJ + 127) / 128, (NROWS + 127) / 128), 256, 0, stream>>>(I, rstd_x, P);
    nv::k_qknorm<<<(NROWS * 32 * 64 + 255) / 256, 256, 0, stream>>>(I, P);
    nv::k_copy<<<2048, 256, 0, stream>>>(I, P, out);
    nv::k_attn<<<(NROWS * NH + 3) / 4, 256, 0, stream>>>(I, P);
    nv::k_ssd<<<NB * NH + DB * NH, 512, 0, stream>>>(I, P, out);
    nv::k_rstd_u<<<(NROWS * 64 + 255) / 256, 256, 0, stream>>>(P, rstd_u);
    nv::k_outproj<<<dim3(DM / 128, (NROWS + 127) / 128), 256, 0, stream>>>(I, P, rstd_u, out);
}
```

```cpp
#include <hip/hip_runtime.h>
#include <cstdio>
#include <cstdint>

constexpr int DM = 1024, NB = 4, SEQ = 8192, DB = 32, WIN = 2048;
constexpr int NPROJ = 6672, NMAIN = 6656, NTOK = NB * SEQ, NROWS = NTOK + DB;
constexpr int MROWS = 33024;
constexpr int C_Q = 0, C_K = 1024, C_V = 2048, C_G = 3072, C_Z = 4096, C_XBC = 5120, C_DT = 6656;
constexpr int CONVD = 1536, NH = 16, HD = 64, DS = 128;
constexpr float EPS = 1e-6f;
constexpr float QSCALE = 0.125f * 1.4426950408889634f;
constexpr float LOG2E = 1.4426950408889634f;
constexpr size_t O_YP = 0, O_YS = O_YP + (size_t)NTOK * DM, O_KP = O_YS + (size_t)DB * DM, O_VP = O_KP + (size_t)NB * WIN * DM,
                 O_CP = O_VP + (size_t)NB * WIN * DM, O_HP = O_CP + (size_t)NB * 3 * CONVD, O_KS = O_HP + (size_t)NB * NH * HD * DS,
                 O_VS = O_KS + (size_t)DB * DM, O_CS = O_VS + (size_t)DB * DM, O_HS = O_CS + (size_t)DB * 3 * CONVD,
                 O_END = O_HS + (size_t)DB * NH * HD * DS;
static_assert(O_END == 55314432, "output size");

constexpr size_t MiB = 1u << 20;
constexpr size_t WS_CTL = 0, CTL_ZERO_BYTES = 1 * MiB;
constexpr size_t WS_WIN = 2 * MiB;
constexpr size_t WS_WOUT = 16 * MiB;
constexpr size_t WS_DT = 20 * MiB;
constexpr size_t WS_SSQ = 24 * MiB;
constexpr size_t WS_XN = 32 * MiB;
constexpr size_t WS_Q = 100 * MiB;
constexpr size_t WS_K = 168 * MiB;
constexpr size_t WS_V = 236 * MiB;
constexpr size_t WS_AU = 304 * MiB;
constexpr size_t WS_XBC = 436 * MiB;
constexpr size_t WS_END = 536 * MiB;
static_assert(WS_XN + (size_t)MROWS * DM * 2 <= WS_Q && WS_Q + (size_t)MROWS * DM * 2 <= WS_K && WS_K + (size_t)MROWS * DM * 2 <= WS_V && WS_V + (size_t)MROWS * DM * 2 <= WS_AU &&
              WS_AU + (size_t)MROWS * 2048 * 2 <= WS_XBC && WS_XBC + (size_t)MROWS * CONVD * 2 <= WS_END && WS_WIN + (size_t)NMAIN * DM * 2 <= WS_WOUT && WS_WOUT + (size_t)DM * 2048 * 2 <= WS_DT &&
              WS_DT + (size_t)MROWS * 16 * 4 <= WS_SSQ && WS_SSQ + (size_t)MROWS * 16 * 4 <= WS_XN, "d_ws map");

struct Ins {
    const float *xp, *xs, *ck, *cv, *sconv, *sssm, *norm_w, *w_in, *qnw, *knw, *rel_bias, *conv_w, *conv_b, *dt_bias, *a_log, *d_skip, *ssd_norm_w, *w_out;
};

typedef unsigned short bf16;
__device__ __forceinline__ float wave_sum(float v) {
#pragma unroll
    for (int o = 1; o < 64; o <<= 1) v += __shfl_xor(v, o);
    return v;
}
__device__ __forceinline__ float wave_max(float v) {
#pragma unroll
    for (int o = 1; o < 64; o <<= 1) v = fmaxf(v, __shfl_xor(v, o));
    return v;
}
__device__ __forceinline__ float silu_f(float x) { return x / (1.f + __expf(-x)); }
__device__ __forceinline__ float silu_fast(float x) { return x * __builtin_amdgcn_rcpf(1.f + __builtin_amdgcn_exp2f(-LOG2E * x)); }
__device__ __forceinline__ float softplus_f(float x) { return x > 20.f ? x : log1pf(__expf(x)); }
__device__ __forceinline__ int t5_bucket(int d) {
    if (d < 16) return d;
    int b = 16;
    b += d >= 22; b += d >= 30; b += d >= 40; b += d >= 54; b += d >= 73; b += d >= 99; b += d >= 134; b += d >= 182;
    b += d >= 246; b += d >= 332; b += d >= 450; b += d >= 609; b += d >= 825; b += d >= 1117; b += d >= 1513;
    return b;
}
__device__ __forceinline__ const float* xrow(const Ins& I, int r) { return r < NTOK ? I.xp + (size_t)r * DM : I.xs + (size_t)(r - NTOK) * DM; }
__device__ __forceinline__ float bf2f(bf16 v) { return __uint_as_float((unsigned)v << 16); }
__device__ __forceinline__ unsigned f2bf(float f) { unsigned u = __float_as_uint(f); return (u + 0x7fffu + ((u >> 16) & 1u)) >> 16; }
__device__ __forceinline__ unsigned pk2(float lo, float hi) { return f2bf(lo) | (f2bf(hi) << 16); }
__host__ __device__ __forceinline__ int vrow_of_col(int a) { return 128 * ((a >> 5) & 1) + 32 * ((a >> 6) & 3) + (a & 31); }

namespace pg8 {
#define PG8_LAS __attribute__((address_space(3)))
typedef unsigned short bf16_t;
typedef short bf16x8 __attribute__((ext_vector_type(8)));
typedef float f32x4 __attribute__((ext_vector_type(4)));
typedef unsigned u32x4 __attribute__((ext_vector_type(4)));
constexpr int BM = 256, BK = 64, HALF = 128, HTB = HALF * BK * 2  , STAGE_BYTES = 8 * HTB, NXCD = 8, WGM = 8;

__host__ __device__ __forceinline__ int lds_byte(int r, int c) { const int st = (r >> 4) * 2 + (c >> 5), rr = r & 15, cc = c & 31, ob = rr * 64 + cc * 2; return st * 1024 + (ob ^ (((ob >> 9) & 1) << 5)); }
__host__ __device__ __forceinline__ void stage_rc(int b, int& R, int& C) { const int st = b / 1024, sb = b % 1024, swz = sb ^ (((sb >> 9) & 1) << 5); R = (st >> 1) * 16 + swz / 64; C = (st & 1) * 32 + (swz % 64) / 2; }
__host__ __device__ __forceinline__ int perm32(int rho) { const int n = rho >> 4, i = rho & 15; return 8 * (i >> 2) + 4 * n + (i & 3); }

struct Unit { int pm, pn; };
struct Gemm { const bf16_t* A; const bf16_t* Bt; int M, N, K; };

struct StaticOrder {
    int nM, nN, nwg, G, c;
    __host__ __device__ void init(int M, int N, int G_, int c_) { nM = M / BM; nN = N / BM; nwg = nM * nN; G = G_; c = c_; }
    __host__ __device__ bool next(int i, Unit& u) const {
        const long L = (long)i * G + c; if (L >= nwg) return false;
        int wgid = (int)L; { const int q = nwg / NXCD, r = nwg % NXCD, xcd = wgid % NXCD, off = wgid / NXCD; wgid = (xcd < r ? xcd * (q + 1) : r * (q + 1) + (xcd - r) * q) + off; }
        const int nig = WGM * nN, gid = wgid / nig, fm = gid * WGM, gsz = (nM - fm) < WGM ? (nM - fm) : WGM;
        u.pm = fm + ((wgid % nig) % gsz); u.pn = (wgid % nig) / gsz; return true;
    }
    __device__ __forceinline__ void a_ready(const Unit&) const {}
    __device__ __forceinline__ void done(const Unit&) const {}
};

__device__ __forceinline__ unsigned cvt_pk_bf16(float lo, float hi) { unsigned r; asm volatile("v_cvt_pk_bf16_f32 %0, %1, %2" : "=v"(r) : "v"(lo), "v"(hi)); return r; }

struct EpiIn {
    static constexpr bool PERM = true, AFTER_DRAIN = false, MIDK = false;
    bf16_t *Q, *K, *V, *AU, *XBC; float* out; const float *qnw, *knw;
    __device__ __forceinline__ void mid(f32x4 (&)[2][2][4][2], const Unit&, int, int, int, int) const {}
    __device__ __forceinline__ void operator()(const f32x4 (&acc)[2][2][4][2], const Unit& u, int wr, int wc, int fr, int fq) const {
        const int pn = u.pn;
        const int rowb = u.pm * BM + wr * 64 + fr;
        const int cl = wc * 64 + 8 * fq;
        if (pn < 8) {
            const bool isq = pn < 4; const float* nw = isq ? qnw : knw;
            f32x4 w[2][2];
#pragma unroll
            for (int bj = 0; bj < 2; ++bj)
#pragma unroll
                for (int n = 0; n < 2; ++n) w[bj][n] = *(const f32x4*)(nw + 8 * fq + 32 * bj + 4 * n);
            bf16_t* dstb = (isq ? Q : K) + (pn & 3) * 256 + cl;
#pragma unroll
            for (int ai = 0; ai < 2; ++ai)
#pragma unroll
                for (int m = 0; m < 4; ++m) {
                    const int r = rowb + ai * HALF + m * 16;
                    float ss = 0.f;
#pragma unroll
                    for (int bj = 0; bj < 2; ++bj)
#pragma unroll
                        for (int n = 0; n < 2; ++n) { const f32x4 v = acc[ai][bj][m][n]; ss += (v[0] * v[0] + v[1] * v[1]) + (v[2] * v[2] + v[3] * v[3]); }
                    ss += __shfl_xor(ss, 16); ss += __shfl_xor(ss, 32);
                    const float sc = rsqrtf(ss * (1.f / 64.f) + EPS), scs = isq ? sc * QSCALE : sc;
                    float* f32dst = nullptr;
                    if (!isq) { if (r < NTOK) { const int t = r & (SEQ - 1); if (t >= SEQ - WIN) f32dst = out + O_KP + ((size_t)((r >> 13) * WIN + t - (SEQ - WIN))) * DM + (pn & 3) * 256 + cl; }
                                else if (r < NROWS) f32dst = out + O_KS + (size_t)(r - NTOK) * DM + (pn & 3) * 256 + cl; }
#pragma unroll
                    for (int bj = 0; bj < 2; ++bj) {
                        const f32x4 a0 = acc[ai][bj][m][0] * w[bj][0], a1 = acc[ai][bj][m][1] * w[bj][1];
                        u32x4 o; o.x = cvt_pk_bf16(a0[0] * scs, a0[1] * scs); o.y = cvt_pk_bf16(a0[2] * scs, a0[3] * scs); o.z = cvt_pk_bf16(a1[0] * scs, a1[1] * scs); o.w = cvt_pk_bf16(a1[2] * scs, a1[3] * scs);
                        *(u32x4*)(dstb + (size_t)r * DM + 32 * bj) = o;
                        if (f32dst) { *(f32x4*)(f32dst + 32 * bj) = a0 * sc; *(f32x4*)(f32dst + 32 * bj + 4) = a1 * sc; }
                    }
                }
        } else if (pn < 12) {
            bf16_t* dstb = V + (pn & 3) * 256 + cl;
#pragma unroll
            for (int ai = 0; ai < 2; ++ai)
#pragma unroll
                for (int m = 0; m < 4; ++m) {
                    const int r = rowb + ai * HALF + m * 16;
                    float* f32dst = nullptr;
                    if (r < NTOK) { const int t = r & (SEQ - 1); if (t >= SEQ - WIN) f32dst = out + O_VP + ((size_t)((r >> 13) * WIN + t - (SEQ - WIN))) * DM + (pn & 3) * 256 + cl; }
                    else if (r < NROWS) f32dst = out + O_VS + (size_t)(r - NTOK) * DM + (pn & 3) * 256 + cl;
#pragma unroll
                    for (int bj = 0; bj < 2; ++bj) {
                        const f32x4 a0 = acc[ai][bj][m][0], a1 = acc[ai][bj][m][1];
                        u32x4 o; o.x = cvt_pk_bf16(a0[0], a0[1]); o.y = cvt_pk_bf16(a0[2], a0[3]); o.z = cvt_pk_bf16(a1[0], a1[1]); o.w = cvt_pk_bf16(a1[2], a1[3]);
                        *(u32x4*)(dstb + (size_t)r * DM + 32 * bj) = o;
                        if (f32dst) { *(f32x4*)(f32dst + 32 * bj) = a0; *(f32x4*)(f32dst + 32 * bj + 4) = a1; }
                    }
                }
        } else if (pn < 20) {
            bf16_t* dstb = AU + (pn < 16 ? 1024 : 0) + (pn & 3) * 256 + cl;
#pragma unroll
            for (int ai = 0; ai < 2; ++ai)
#pragma unroll
                for (int m = 0; m < 4; ++m) {
                    const int r = rowb + ai * HALF + m * 16;
#pragma unroll
                    for (int bj = 0; bj < 2; ++bj) {
                        f32x4 a0 = acc[ai][bj][m][0], a1 = acc[ai][bj][m][1];
#pragma unroll
                        for (int i = 0; i < 4; ++i) { a0[i] = silu_fast(a0[i]); a1[i] = silu_fast(a1[i]); }
                        u32x4 o; o.x = cvt_pk_bf16(a0[0], a0[1]); o.y = cvt_pk_bf16(a0[2], a0[3]); o.z = cvt_pk_bf16(a1[0], a1[1]); o.w = cvt_pk_bf16(a1[2], a1[3]);
                        *(u32x4*)(dstb + (size_t)r * 2048 + 32 * bj) = o;
                    }
                }
        } else {
            const int cb = (pn - 20) * 256 + cl;
            bf16_t* dstb = XBC + cb;
#pragma unroll
            for (int ai = 0; ai < 2; ++ai)
#pragma unroll
                for (int m = 0; m < 4; ++m) {
                    const int r = rowb + ai * HALF + m * 16;
                    float* f32dst = nullptr;
                    if (r < NTOK) { const int t = r & (SEQ - 1); if (t >= SEQ - 3) f32dst = out + O_CP + ((size_t)((r >> 13) * 3 + t - (SEQ - 3))) * CONVD + cb; }
                    else if (r < NROWS) f32dst = out + O_CS + ((size_t)(r - NTOK) * 3 + 2) * CONVD + cb;
#pragma unroll
                    for (int bj = 0; bj < 2; ++bj) {
                        const f32x4 a0 = acc[ai][bj][m][0], a1 = acc[ai][bj][m][1];
                        u32x4 o; o.x = cvt_pk_bf16(a0[0], a0[1]); o.y = cvt_pk_bf16(a0[2], a0[3]); o.z = cvt_pk_bf16(a1[0], a1[1]); o.w = cvt_pk_bf16(a1[2], a1[3]);
                        *(u32x4*)(dstb + (size_t)r * CONVD + 32 * bj) = o;
                        if (f32dst) { *(f32x4*)(f32dst + 32 * bj) = a0; *(f32x4*)(f32dst + 32 * bj + 4) = a1; }
                    }
                }
        }
    }
};

struct EpiOut {
    static constexpr bool PERM = true, AFTER_DRAIN = false, MIDK = true;
    const float* xp; const float* xs; const float* ssq; float* out;
    __device__ __forceinline__ void mid(f32x4 (&acc)[2][2][4][2], const Unit& u, int wr, int wc, int fr, int fq) const {
        const int rowb = u.pm * BM + wr * 64 + fr;
#pragma unroll
        for (int ai = 0; ai < 2; ++ai)
#pragma unroll
            for (int m = 0; m < 4; ++m) {
                const f32x4* sp = (const f32x4*)(ssq + (size_t)(rowb + ai * HALF + m * 16) * 16);
                const f32x4 s0 = sp[0], s1 = sp[1], s2 = sp[2], s3 = sp[3];
                const float s = ((s0[0] + s0[1]) + (s0[2] + s0[3])) + ((s1[0] + s1[1]) + (s1[2] + s1[3])) + ((s2[0] + s2[1]) + (s2[2] + s2[3])) + ((s3[0] + s3[1]) + (s3[2] + s3[3]));
                const float rs = rsqrtf(s * (1.f / 1024.f) + EPS);
#pragma unroll
                for (int bj = 0; bj < 2; ++bj)
#pragma unroll
                    for (int n = 0; n < 2; ++n) acc[ai][bj][m][n] *= rs;
            }
    }
    __device__ __forceinline__ void operator()(const f32x4 (&acc)[2][2][4][2], const Unit& u, int wr, int wc, int fr, int fq) const {
        const int rowb = u.pm * BM + wr * 64 + fr, col = u.pn * BM + wc * 64 + 8 * fq;
#pragma unroll
        for (int ai = 0; ai < 2; ++ai)
#pragma unroll
            for (int m = 0; m < 4; ++m) {
                const int r = rowb + ai * HALF + m * 16;
                if (r >= NROWS) continue;
                const float* xr = (r < NTOK ? xp + (size_t)r * DM : xs + (size_t)(r - NTOK) * DM) + col;
                float* yr = out + (r < NTOK ? O_YP + (size_t)r * DM : O_YS + (size_t)(r - NTOK) * DM) + col;
#pragma unroll
                for (int bj = 0; bj < 2; ++bj) {
                    *(f32x4*)(yr + 32 * bj) = *(const f32x4*)(xr + 32 * bj) + acc[ai][bj][m][0];
                    *(f32x4*)(yr + 32 * bj + 4) = *(const f32x4*)(xr + 32 * bj + 4) + acc[ai][bj][m][1];
                }
            }
    }
};

template <class Epi, class Sched, bool ALIGN_EPI = false, bool SP2 = false>
__device__ __forceinline__ void gemm_phase(PG8_LAS unsigned char* lds, const Gemm g, const Sched& S, const Epi& E) {
    const int tid = threadIdx.x, wid = __builtin_amdgcn_readfirstlane(tid >> 6), lane = tid & 63, wr = wid >> 2, wc = wid & 3, fr = lane & 15, fq = lane >> 4;
    const int K = g.K, nt = K / BK;
    unsigned voffA[2], voffB[2];
#pragma unroll
    for (int i = 0; i < 2; ++i) { int R, C; stage_rc(tid * 16 + i * 8192, R, C); const int Rb = Epi::PERM ? ((R & ~31) + perm32(R & 31)) : R;
        voffA[i] = (unsigned)(R * K + C) * 2u; voffB[i] = (unsigned)(Rb * K + C) * 2u; }
    const size_t kstep = (size_t)(BK * 2);
    const size_t hstep = (size_t)HALF * K * 2;
    const size_t tstep = 2 * hstep;
    const unsigned ldsw = (unsigned)wid * 1024u;
    const int aoff = lds_byte(wr * 64 + fr, fq * 8), boff = lds_byte(wc * 32 + fr, fq * 8);
#define PG8_SA(b, h) (((b) * 2 + (h)) * HTB)
#define PG8_SB(b, h) ((4 + (b) * 2 + (h)) * HTB)
#define PG8_STAGE(bufoff, gbase, voff) do { _Pragma("unroll") for (int _i = 0; _i < 2; ++_i) \
        __builtin_amdgcn_global_load_lds((const unsigned*)((const char*)(gbase) + (voff)[_i]), (PG8_LAS unsigned*)(lds + (bufoff) + ldsw + _i * 8192), 16, 0, 0); } while (0)
#define PG8_LDA(dst, b, h) do { _Pragma("unroll") for (int m = 0; m < 4; ++m) _Pragma("unroll") for (int k = 0; k < 2; ++k) dst[m][k] = *(const PG8_LAS bf16x8*)(lds + PG8_SA(b, h) + aoff + m * 2048 + k * 1024); } while (0)
#define PG8_LDB(dst, b, h) do { _Pragma("unroll") for (int n = 0; n < 2; ++n) _Pragma("unroll") for (int k = 0; k < 2; ++k) dst[n][k] = *(const PG8_LAS bf16x8*)(lds + PG8_SB(b, h) + boff + n * 2048 + k * 1024); } while (0)
#define PG8_MMA(ai, bj, At, Bt) do { __builtin_amdgcn_s_setprio(1); _Pragma("unroll") for (int m = 0; m < 4; ++m) _Pragma("unroll") for (int n = 0; n < 2; ++n) _Pragma("unroll") for (int k = 0; k < 2; ++k) \
        acc[ai][bj][m][n] = __builtin_amdgcn_mfma_f32_16x16x32_bf16(Bt[n][k], At[m][k], acc[ai][bj][m][n], 0, 0, 0); __builtin_amdgcn_s_setprio(0); } while (0)
#define PG8_WAIT_V(n) asm volatile("s_waitcnt vmcnt(" #n ")" ::: "memory")
#define PG8_WAIT_L(n) asm volatile("s_waitcnt lgkmcnt(" #n ")" ::: "memory")
#define PG8_BAR __builtin_amdgcn_s_barrier()
#define PG8_SCHED __builtin_amdgcn_sched_barrier(0)
    Unit cur, nxt; int ui = 0;
    if (!S.next(0, cur)) return;
    f32x4 acc[2][2][4][2];
#pragma unroll
    for (int a = 0; a < 2; ++a)
#pragma unroll
        for (int b = 0; b < 2; ++b)
#pragma unroll
            for (int m = 0; m < 4; ++m)
#pragma unroll
                for (int n = 0; n < 2; ++n) acc[a][b][m][n] = (f32x4){0.f, 0.f, 0.f, 0.f};
    bf16x8 At[4][2], B0[2][2], B1[2][2];
    const char* cA = (const char*)g.A + (size_t)cur.pm * tstep; const char* cB = (const char*)g.Bt + (size_t)cur.pn * tstep;
    S.a_ready(cur);
    if constexpr (SP2) {
        PG8_STAGE(PG8_SB(0, 0), cB, voffB); PG8_STAGE(PG8_SB(0, 1), cB + hstep, voffB); PG8_STAGE(PG8_SA(0, 0), cA, voffA); PG8_STAGE(PG8_SA(0, 1), cA + hstep, voffA);
        if (wr == 1) PG8_BAR;
        PG8_WAIT_V(2); PG8_BAR;
        PG8_STAGE(PG8_SB(1, 0), cB + kstep, voffB); PG8_STAGE(PG8_SA(1, 0), cA + kstep, voffA); PG8_STAGE(PG8_SB(1, 1), cB + hstep + kstep, voffB);
        PG8_WAIT_V(6); PG8_BAR;
    } else {
        PG8_STAGE(PG8_SB(0, 0), cB, voffB); PG8_STAGE(PG8_SA(0, 0), cA, voffA); PG8_STAGE(PG8_SB(0, 1), cB + hstep, voffB); PG8_STAGE(PG8_SA(0, 1), cA + hstep, voffA);
        if (wr == 1) PG8_BAR;
        PG8_WAIT_V(4); PG8_BAR;
        PG8_STAGE(PG8_SB(1, 0), cB + kstep, voffB); PG8_STAGE(PG8_SA(1, 0), cA + kstep, voffA); PG8_STAGE(PG8_SB(1, 1), cB + hstep + kstep, voffB);
        PG8_WAIT_V(6); PG8_BAR;
    }
    for (;;) {
        const bool has_next = S.next(ui + 1, nxt);
        const char* nA = has_next ? (const char*)g.A + (size_t)nxt.pm * tstep : cA; const char* nB = has_next ? (const char*)g.Bt + (size_t)nxt.pn * tstep : cB;
        for (int t = 0; t < nt; t += 2) {
            const bool last = (t == nt - 2);
            if constexpr (Epi::MIDK) { if (t == (nt >> 1)) E.mid(acc, cur, wr, wc, fr, fq); }
            const char* a1 = cA + (size_t)(t + 1) * kstep;
            const char* a2 = last ? nA : cA + (size_t)(t + 2) * kstep; const char* b2 = last ? nB : cB + (size_t)(t + 2) * kstep;
            const char* a3 = a2 + kstep; const char* b3 = b2 + kstep;
            if (last && has_next) S.a_ready(nxt);
            if constexpr (SP2) {
            PG8_LDB(B0, 0, 0); PG8_LDB(B1, 0, 1); PG8_SCHED; PG8_LDA(At, 0, 0); PG8_STAGE(PG8_SA(1, 1), a1 + hstep, voffA);
            PG8_WAIT_V(8); PG8_WAIT_L(0); PG8_BAR; PG8_MMA(0, 0, At, B0); PG8_MMA(0, 1, At, B1); PG8_BAR; PG8_SCHED;
            PG8_LDA(At, 0, 1); PG8_STAGE(PG8_SB(0, 0), b2, voffB); PG8_STAGE(PG8_SB(0, 1), b2 + hstep, voffB); PG8_STAGE(PG8_SA(0, 0), a2, voffA);
            PG8_WAIT_V(8); PG8_WAIT_L(0); PG8_BAR; PG8_MMA(1, 0, At, B0); PG8_MMA(1, 1, At, B1); PG8_BAR; PG8_SCHED;
            PG8_LDB(B0, 1, 0); PG8_LDB(B1, 1, 1); PG8_SCHED; PG8_LDA(At, 1, 0); PG8_STAGE(PG8_SA(0, 1), a2 + hstep, voffA);
            PG8_WAIT_V(8); PG8_WAIT_L(0); PG8_BAR; PG8_MMA(0, 0, At, B0); PG8_MMA(0, 1, At, B1); PG8_BAR; PG8_SCHED;
            PG8_LDA(At, 1, 1); PG8_STAGE(PG8_SB(1, 0), b3, voffB); PG8_STAGE(PG8_SB(1, 1), b3 + hstep, voffB); PG8_STAGE(PG8_SA(1, 0), a3, voffA);
            PG8_WAIT_V(8); PG8_WAIT_L(0); PG8_BAR; PG8_MMA(1, 0, At, B0); PG8_MMA(1, 1, At, B1); PG8_BAR; PG8_SCHED;
            } else {
            PG8_LDB(B0, 0, 0); PG8_SCHED; PG8_LDA(At, 0, 0); PG8_STAGE(PG8_SA(1, 1), a1 + hstep, voffA);
            PG8_WAIT_L(8); PG8_BAR; PG8_WAIT_L(0); PG8_MMA(0, 0, At, B0); PG8_BAR; PG8_SCHED;
            PG8_LDB(B1, 0, 1); PG8_STAGE(PG8_SB(0, 0), b2, voffB);
            PG8_BAR; PG8_WAIT_L(0); PG8_MMA(0, 1, At, B1); PG8_BAR;
            PG8_LDA(At, 0, 1); PG8_STAGE(PG8_SA(0, 0), a2, voffA);
            PG8_BAR; PG8_WAIT_L(0); PG8_MMA(1, 0, At, B0); PG8_BAR; PG8_SCHED;
            PG8_STAGE(PG8_SB(0, 1), b2 + hstep, voffB);
            PG8_WAIT_V(6); PG8_BAR; PG8_MMA(1, 1, At, B1); PG8_BAR;
            PG8_LDB(B0, 1, 0); PG8_SCHED; PG8_LDA(At, 1, 0); PG8_STAGE(PG8_SA(0, 1), a2 + hstep, voffA);
            PG8_WAIT_L(8); PG8_BAR; PG8_WAIT_L(0); PG8_MMA(0, 0, At, B0); PG8_BAR; PG8_SCHED;
            PG8_LDB(B1, 1, 1); PG8_STAGE(PG8_SB(1, 0), b3, voffB);
            PG8_BAR; PG8_WAIT_L(0); PG8_MMA(0, 1, At, B1); PG8_BAR;
            PG8_LDA(At, 1, 1); PG8_STAGE(PG8_SA(1, 0), a3, voffA);
            PG8_BAR; PG8_WAIT_L(0); PG8_MMA(1, 0, At, B0); PG8_BAR; PG8_SCHED;
            PG8_STAGE(PG8_SB(1, 1), b3 + hstep, voffB);
            PG8_WAIT_V(6); PG8_BAR; PG8_MMA(1, 1, At, B1); PG8_BAR;
            }
        }
        if constexpr (ALIGN_EPI) { if (wr == 0) PG8_BAR; }
        if constexpr (!Epi::AFTER_DRAIN) { E(acc, cur, wr, wc, fr, fq); S.done(cur); }
        if (!has_next) break;
#pragma unroll
        for (int a = 0; a < 2; ++a)
#pragma unroll
            for (int b = 0; b < 2; ++b)
#pragma unroll
                for (int m = 0; m < 4; ++m)
#pragma unroll
                    for (int n = 0; n < 2; ++n) acc[a][b][m][n] = (f32x4){0.f, 0.f, 0.f, 0.f};
        cur = nxt; cA = nA; cB = nB; ++ui;
        if constexpr (ALIGN_EPI) { if (wr == 1) PG8_BAR; }
    }
    PG8_WAIT_V(0);
    if constexpr (!ALIGN_EPI) { if (wr == 0) PG8_BAR; }
    PG8_BAR;
    if constexpr (Epi::AFTER_DRAIN) { E.fused(acc, cur, wr, wc, fr, fq, lds, wid, lane); S.done(cur); }
#undef PG8_SA
#undef PG8_SB
#undef PG8_STAGE
#undef PG8_LDA
#undef PG8_LDB
#undef PG8_MMA
#undef PG8_WAIT_V
#undef PG8_WAIT_L
#undef PG8_BAR
#undef PG8_SCHED
}
}
#define GAS __attribute__((address_space(1)))
#define LAS __attribute__((address_space(3)))
typedef unsigned v4u __attribute__((ext_vector_type(4)));
typedef float f32x4 __attribute__((ext_vector_type(4)));
typedef short bf16x8 __attribute__((ext_vector_type(8)));
typedef GAS unsigned gu32;
typedef GAS unsigned long long gu64;
#define RLX_AGENT __ATOMIC_RELAXED, __HIP_MEMORY_SCOPE_AGENT
#define LDS_WAIT() asm volatile("s_waitcnt lgkmcnt(0)" ::: "memory")
#define VM_WAIT() asm volatile("s_waitcnt vmcnt(0)" ::: "memory")
__device__ __forceinline__ unsigned long long rt() { return __builtin_amdgcn_s_memrealtime(); }

#define XB_TMO      128
#define XB_XCNT(j)  (256  + 64 * (j))
#define XB_XSUB(j)  (1280 + 64 * (j))
#define XB_XGEN(j)  (2304 + 64 * (j))
#define XB_TOP      3328
#define XB_TOPGEN   3392
#define XCD_BAR_WORDS 3456
#define XB_SPIN_CAP (1u << 18)

__device__ __forceinline__ unsigned xb_ld(unsigned* p)              { return __hip_atomic_load(p, __ATOMIC_RELAXED, __HIP_MEMORY_SCOPE_AGENT); }
__device__ __forceinline__ unsigned xb_add(unsigned* p, unsigned v) { return __hip_atomic_fetch_add(p, v, __ATOMIC_RELAXED, __HIP_MEMORY_SCOPE_AGENT); }
__device__ __forceinline__ unsigned xb_xcc_id() { return (unsigned)__builtin_amdgcn_s_getreg((3 << 11) | 20) & 0xFu; }
#define XB_SPIN(cond, bar) do { unsigned _sp = 0; while (cond) { __builtin_amdgcn_s_sleep(1); \
    if ((++_sp & 255u) == 0u) { if (xb_ld(&(bar)[XB_TMO])) break; if (_sp > XB_SPIN_CAP) { atomicAdd(&(bar)[XB_TMO], 1u); break; } } } } while (0)

struct XcdBarrier {
    unsigned* bar; unsigned x;
    volatile LAS unsigned* st;
};

__device__ __forceinline__ XcdBarrier xcd_barrier_post(unsigned* bar, volatile LAS unsigned* st) {
    XcdBarrier b; b.bar = bar; b.x = xb_xcc_id(); b.st = st;
    if (threadIdx.x == 0) (void)xb_add(&bar[XB_XCNT(b.x)], 1u);
    return b;
}
__device__ __forceinline__ void xcd_barrier_complete(unsigned* bar, unsigned x, unsigned& nloc, unsigned& nx) {
    const unsigned G = gridDim.x * gridDim.y * gridDim.z;
    unsigned sum, cnt, mine, sp = 0u;
    for (;;) {
        sum = 0u; cnt = 0u; mine = 0u;
#pragma unroll
        for (unsigned j = 0; j < 16; ++j) { const unsigned c = xb_ld(&bar[XB_XCNT(j)]); sum += c; cnt += (c > 0u) ? 1u : 0u; mine = (j == x) ? c : mine; }
        if (sum == G) break;
        __builtin_amdgcn_s_sleep(1);
        if ((++sp & 255u) == 0u) { if (xb_ld(&bar[XB_TMO])) break; if (sp > XB_SPIN_CAP) { atomicAdd(&bar[XB_TMO], 1u); break; } }
    }
    nloc = mine > 0u ? mine : 1u; nx = cnt > 0u ? cnt : 1u;
}

__device__ __forceinline__ void xcd_barrier(const XcdBarrier& b) {
    asm volatile("s_waitcnt vmcnt(0)" ::: "memory");
    __syncthreads();
    if (threadIdx.x == 0) {
        unsigned* bar = b.bar;
        __builtin_amdgcn_s_waitcnt(0);
        unsigned nloc = b.st[0], nx = b.st[1];
        if (nloc == 0u) { xcd_barrier_complete(bar, b.x, nloc, nx); b.st[0] = nloc; b.st[1] = nx; }
        const unsigned old = xb_add(&bar[XB_XSUB(b.x)], 1u);
        const unsigned gen = old / nloc;
        if (old + 1u == (gen + 1u) * nloc) {
            __builtin_amdgcn_fence(__ATOMIC_RELEASE, "agent");
            asm volatile("s_waitcnt vmcnt(0)" ::: "memory");
            const unsigned og = xb_add(&bar[XB_TOP], 1u);
            const unsigned tg = og / nx;
            if (og + 1u == (tg + 1u) * nx) xb_add(&bar[XB_TOPGEN], 1u);
            else XB_SPIN(xb_ld(&bar[XB_TOPGEN]) == tg, bar);
            __builtin_amdgcn_fence(__ATOMIC_ACQUIRE, "agent");
            xb_add(&bar[XB_XGEN(b.x)], 1u);
            asm volatile("s_waitcnt vmcnt(0)" ::: "memory");
        } else {
            XB_SPIN(xb_ld(&bar[XB_XGEN(b.x)]) == gen, bar);
            __builtin_amdgcn_fence(__ATOMIC_ACQUIRE, "agent");
            asm volatile("s_waitcnt vmcnt(0)" ::: "memory");
        }
    }
    __syncthreads();
}

constexpr int NWAVES = 8;
constexpr int RING_OFF = 0, RING_BYTES = 131072;
constexpr int LDS_BYTES = 163840;
constexpr int LDSCTL_OFF = LDS_BYTES - 512, MISC_OFF = LDSCTL_OFF + 320;
constexpr int CW_BAR = 4096;
constexpr int CW_Q = 16384;
static_assert((CW_BAR + XCD_BAR_WORDS) <= CW_Q && (CW_Q + 64 * 64) * 4 <= (int)CTL_ZERO_BYTES, "CTL words inside the memset region");

struct Frame {
    LAS unsigned char* lds;
    volatile LAS unsigned* MISC;
    gu32* ctl;
    int tid, lane, wave, vcu, G;
    Ins I; float* out;
    bf16 *WinT, *WoutT, *XN, *Q, *K, *V, *AU, *XBC; float *DT, *SSQ;
};

template <class SrcF>
__device__ __forceinline__ void p0_transpose_item(SrcF src, int k0, int n0, bf16* WT, int dst_pitch, int dst_row0, int dst_k0, LAS float* scr, int lane) {
#pragma unroll 8
    for (int i = 0; i < 32; ++i) { const int kk = 2 * i + (lane >> 5); scr[kk * 33 + (lane & 31)] = src(k0 + kk, n0 + (lane & 31)); }
    LDS_WAIT(); asm volatile("" ::: "memory");
    const int c = lane & 7;
#pragma unroll
    for (int j = 0; j < 4; ++j) { const int n = (lane >> 3) + 8 * j; const LAS float* s = scr + (8 * c) * 33 + n;
        v4u o; o.x = pk2(s[0 * 33], s[1 * 33]); o.y = pk2(s[2 * 33], s[3 * 33]); o.z = pk2(s[4 * 33], s[5 * 33]); o.w = pk2(s[6 * 33], s[7 * 33]);
        *(GAS v4u*)(WT + (size_t)(dst_row0 + n) * dst_pitch + dst_k0 + 8 * c) = o; }
    LDS_WAIT(); asm volatile("" ::: "memory");
}
constexpr int P0_SCR_BYTES = 8448, WDT_OFF = NWAVES * P0_SCR_BYTES, WDT_PITCH = 20;
static_assert(WDT_OFF + 1024 * WDT_PITCH * 4 <= LDSCTL_OFF, "prologue LDS");

__device__ __forceinline__ void p0_prologue(Frame& F) {
    const Ins& I = F.I;
    LAS float* scr = (LAS float*)(F.lds + F.wave * P0_SCR_BYTES);
    LAS float* wdt = (LAS float*)(F.lds + WDT_OFF);
    const int gw = F.vcu * NWAVES + F.wave, NGW = F.G * NWAVES;
    for (int idx = F.tid; idx < 1024 * 16; idx += NWAVES * 64) {
        const int k = idx >> 4, j = idx & 15, pos = (((k >> 8) * 4 + (k & 3)) << 6) + ((k >> 2) & 63);
        wdt[pos * WDT_PITCH + j] = I.w_in[(size_t)k * NPROJ + C_DT + j] * I.norm_w[k];
    }
    constexpr int I_IN = (DM / 64) * (NMAIN / 32), I_OUT = (2048 / 64) * (DM / 32);
    for (int it = gw; it < I_IN + I_OUT; it += NGW) {
        if (it < I_IN) {
            const int nblk = NMAIN / 32, kb = it / nblk, nb = it % nblk, k0 = 64 * kb, n0 = 32 * nb;
            p0_transpose_item([&](int k, int n) { return I.w_in[(size_t)k * NPROJ + n] * I.norm_w[k]; }, k0, n0, F.WinT, DM, (n0 & ~255) + vrow_of_col(n0 & 255), k0, scr, F.lane);
        } else {
            const int r = it - I_IN, nblk = DM / 32, kb = r / nblk, nb = r % nblk, k0 = 64 * kb, n0 = 32 * nb;
            p0_transpose_item([&](int k, int n) { return I.w_out[(size_t)k * DM + n] * (k >= 1024 ? I.ssd_norm_w[k - 1024] : 1.f); }, k0, n0, F.WoutT, 2048, (n0 & ~255) + vrow_of_col(n0 & 255), (k0 + 1024) & 2047, scr, F.lane);
        }
    }
    __syncthreads();
    for (int rp = gw; rp < NROWS / 2; rp += NGW) {
        f32x4 v[2][4]; float rstd[2];
#pragma unroll
        for (int q = 0; q < 2; ++q) {
            const GAS f32x4* xr = (const GAS f32x4*)xrow(I, 2 * rp + q) + F.lane; float s = 0.f;
#pragma unroll
            for (int j = 0; j < 4; ++j) { v[q][j] = xr[64 * j]; s += (v[q][j].x * v[q][j].x + v[q][j].y * v[q][j].y) + (v[q][j].z * v[q][j].z + v[q][j].w * v[q][j].w); }
            rstd[q] = rsqrtf(wave_sum(s) * (1.f / DM) + EPS);
            GAS unsigned long long* o8 = (GAS unsigned long long*)(F.XN + (size_t)(2 * rp + q) * DM) + F.lane;
#pragma unroll
            for (int j = 0; j < 4; ++j) o8[64 * j] = (unsigned long long)pk2(v[q][j].x * rstd[q], v[q][j].y * rstd[q]) | ((unsigned long long)pk2(v[q][j].z * rstd[q], v[q][j].w * rstd[q]) << 32);
        }
        float a[32];
#pragma unroll
        for (int i = 0; i < 32; ++i) a[i] = 0.f;
#pragma unroll
        for (int j = 0; j < 4; ++j)
#pragma unroll
            for (int e = 0; e < 4; ++e) {
                const LAS f32x4* wp = (const LAS f32x4*)(wdt + ((j * 4 + e) * 64 + F.lane) * WDT_PITCH);
                const float x0 = v[0][j][e], x1 = v[1][j][e];
#pragma unroll
                for (int c4 = 0; c4 < 4; ++c4) { const f32x4 w = wp[c4];
#pragma unroll
                    for (int i = 0; i < 4; ++i) { a[c4 * 4 + i] += x0 * w[i]; a[16 + c4 * 4 + i] += x1 * w[i]; } }
                asm volatile("" ::: "memory");
            }
#define P0_HALVE(N, X) { const bool up = (F.lane & (X)) != 0; _Pragma("unroll") for (int i = 0; i < (N); ++i) { const float keep = up ? a[i + (N)] : a[i], send = up ? a[i] : a[i + (N)]; a[i] = keep + __shfl_xor(send, (X)); } }
        P0_HALVE(16, 32) P0_HALVE(8, 16) P0_HALVE(4, 8) P0_HALVE(2, 4) P0_HALVE(1, 2)
#undef P0_HALVE
        float tot = a[0] + __shfl_xor(a[0], 1);
        const int idx = F.lane >> 1, q = idx >> 4, c = idx & 15;
        tot = tot * (q ? rstd[1] : rstd[0]) + I.dt_bias[c];
        if ((F.lane & 1) == 0) F.DT[(size_t)(2 * rp + q) * 16 + c] = softplus_f(tot);
    }
    for (int r = NROWS + gw; r < MROWS; r += NGW) { GAS v4u* o = (GAS v4u*)(F.XN + (size_t)r * DM) + F.lane; o[0] = (v4u){0u, 0u, 0u, 0u}; o[64] = (v4u){0u, 0u, 0u, 0u}; }
    for (int i = (F.vcu * NWAVES * 64 + F.tid); i < DB * 2 * CONVD; i += F.G * NWAVES * 64) {
        const int c = i % CONVD, rr = i / CONVD, j = rr & 1, b = rr >> 1;
        F.out[O_CS + ((size_t)b * 3 + j) * CONVD + c] = I.sconv[((size_t)b * 3 + j + 1) * CONVD + c];
    }
}

struct Args { Ins in; float* out; unsigned char* ws; int ph_lo, ph_hi; };
__global__ void __launch_bounds__(NWAVES * 64, 2) mk_fwd(Args args) {
    extern __shared__ __attribute__((aligned(16))) unsigned char lds[];
    Frame F;
    F.lds = (LAS unsigned char*)lds;
    F.MISC = (volatile LAS unsigned*)(F.lds + MISC_OFF);
    F.tid = threadIdx.x; F.lane = F.tid & 63; F.wave = __builtin_amdgcn_readfirstlane(F.tid >> 6);
    F.G = gridDim.x; { const int bx = blockIdx.x; F.vcu = (F.G % 8 == 0) ? (bx % 8) * (F.G / 8) + bx / 8 : bx; }
    unsigned char* ws = args.ws;
    F.ctl = (gu32*)(ws + WS_CTL); F.I = args.in; F.out = args.out;
    F.WinT = (bf16*)(ws + WS_WIN); F.WoutT = (bf16*)(ws + WS_WOUT); F.XN = (bf16*)(ws + WS_XN); F.Q = (bf16*)(ws + WS_Q); F.K = (bf16*)(ws + WS_K); F.V = (bf16*)(ws + WS_V);
    F.AU = (bf16*)(ws + WS_AU); F.XBC = (bf16*)(ws + WS_XBC); F.DT = (float*)(ws + WS_DT); F.SSQ = (float*)(ws + WS_SSQ);
    for (int u = F.tid; u < (LDS_BYTES - LDSCTL_OFF) / 4; u += NWAVES * 64) ((LAS unsigned*)(F.lds + LDSCTL_OFF))[u] = 0u;
    __syncthreads();
    XcdBarrier bar = xcd_barrier_post((unsigned*)(F.ctl + CW_BAR), F.MISC + 8);
    const int lo = args.ph_lo, hi = args.ph_hi;
#define IN(k) (lo <= (k) && (k) < hi)
#define BOTH(k) (IN(k) && IN((k) + 1))
    if (IN(0)) { p0_prologue(F); if (BOTH(0)) xcd_barrier(bar); }
    if (IN(1)) {
        __syncthreads();
        pg8::Gemm g{F.XN, F.WinT, MROWS, NMAIN, DM}; pg8::StaticOrder S; S.init(MROWS, NMAIN, F.G, (int)blockIdx.x);
        pg8::EpiIn E{F.Q, F.K, F.V, F.AU, F.XBC, F.out, F.I.qnw, F.I.knw};
        pg8::gemm_phase<pg8::EpiIn, pg8::StaticOrder, true, true>(F.lds + RING_OFF, g, S, E);
        if (BOTH(1)) xcd_barrier(bar);
    }
    if (IN(3)) {
        __syncthreads();
        pg8::Gemm g{F.AU, F.WoutT, MROWS, DM, 2048}; pg8::StaticOrder S; S.init(MROWS, DM, F.G, (int)blockIdx.x);
        pg8::EpiOut E{F.I.xp, F.I.xs, F.SSQ, F.out};
        pg8::gemm_phase<pg8::EpiOut, pg8::StaticOrder, true, true>(F.lds + RING_OFF, g, S, E);
    }
#undef IN
#undef BOTH
}

namespace hyb {
struct Bufs { const bf16 *Q, *K, *V, *XBC; bf16* AU; const float* DT; float* SSQ; };

__global__ void __launch_bounds__(256) k_attn(Ins I, Bufs B) {
    __shared__ float qs[4][64];
    __shared__ float ps[4][388];
    const int wl = threadIdx.x >> 6, lane = threadIdx.x & 63;
    const int w = blockIdx.x * 4 + wl;
    if (w >= NROWS * NH) return;
    const int r = w >> 4, h = w & 15;
    const bool samp = r >= NTOK;
    const int b = samp ? r - NTOK : r / SEQ, t = samp ? 0 : r % SEQ;
    qs[wl][lane] = bf2f(B.Q[(size_t)r * DM + h * HD + lane]);
    __builtin_amdgcn_wave_barrier();
    float sc[7]; float mx = -INFINITY;
#pragma unroll
    for (int it = 0; it < 7; ++it) {
        const int idx = it * 64 + lane; sc[it] = -INFINITY;
        if (idx < 387) {
            const int pat = idx / 129, j = idx - pat * 129, d = pat == 0 ? 1 : (pat == 1 ? 4 : 16);
            float s = 0.f; bool valid = true;
            if (samp && j > 0) { const float* kp = I.ck + (((size_t)b * WIN + (WIN - j * d)) * NH + h) * HD; for (int e = 0; e < 64; ++e) s += qs[wl][e] * kp[e]; }
            else { const int kt = t - j * d; valid = kt >= 0; const bf16* kp = B.K + (size_t)(samp ? r : b * SEQ + (valid ? kt : 0)) * DM + h * HD; for (int e = 0; e < 64; ++e) s += qs[wl][e] * bf2f(kp[e]); }
            s += I.rel_bias[t5_bucket(j * d) * NH + h] * LOG2E;
            if (valid) sc[it] = s;
        }
        mx = fmaxf(mx, sc[it]);
    }
    mx = wave_max(mx);
    float sum = 0.f;
#pragma unroll
    for (int it = 0; it < 7; ++it) { const int idx = it * 64 + lane; const float p = (sc[it] == -INFINITY) ? 0.f : exp2f(sc[it] - mx); if (idx < 387) ps[wl][idx] = p; sum += p; }
    sum = wave_sum(sum);
    __builtin_amdgcn_wave_barrier();
    float o = 0.f;
    for (int idx = 0; idx < 387; ++idx) {
        const float p = ps[wl][idx];
        if (p != 0.f) {
            const int pat = idx / 129, j = idx - pat * 129, d = pat == 0 ? 1 : (pat == 1 ? 4 : 16);
            if (samp && j > 0) o += p * I.cv[(((size_t)b * WIN + (WIN - j * d)) * NH + h) * HD + lane];
            else o += p * bf2f(B.V[(size_t)(samp ? r : b * SEQ + t - j * d) * DM + h * HD + lane]);
        }
    }
    o /= sum;
    bf16* gp = B.AU + (size_t)r * 2048 + 1024 + h * HD + lane;
    *gp = (bf16)f2bf(o * bf2f(*gp));
}

__global__ void __launch_bounds__(512) k_ssd(Ins I, Bufs B, float* out) {
    constexpr int TB = 8;
    __shared__ float xs_l[TB][64], B_l[TB][128], C_l[TB][128], dt_l[TB], ssq_l[TB];
    const int tid = threadIdx.x, p = tid >> 3, ng = tid & 7;
    const int bh = blockIdx.x; const bool samp = bh >= NB * NH;
    const int b = samp ? (bh - NB * NH) / NH : bh / NH, hd = bh % NH, grp = hd >> 3;
    const int nsteps = samp ? 1 : SEQ;
    const size_t row0 = samp ? (size_t)NTOK + b : (size_t)b * SEQ;
    float h[16];
#pragma unroll
    for (int i = 0; i < 16; ++i) h[i] = samp ? I.sssm[(((size_t)b * NH + hd) * HD + p) * DS + ng * 16 + i] : 0.f;
    const float A = -__expf(I.a_log[hd]), dsk = I.d_skip[hd];
    auto xbc_at = [&](int t, int c) -> float {
        if (t >= 0) return bf2f(B.XBC[(row0 + t) * CONVD + c]);
        if (!samp) return 0.f;
        return I.sconv[((size_t)b * 3 + (3 + t)) * CONVD + c];
    };
    for (int t0 = 0; t0 < nsteps; t0 += TB) {
        const int nb = nsteps - t0 < TB ? nsteps - t0 : TB;
        for (int e = tid; e < nb * 320; e += 512) {
            const int s = e / 320, ci = e % 320;
            const int c = ci < 64 ? hd * 64 + ci : (ci < 192 ? 1024 + grp * 128 + (ci - 64) : 1280 + grp * 128 + (ci - 192));
            const int t = t0 + s;
            float v = I.conv_b[c];
#pragma unroll
            for (int i = 0; i < 4; ++i) v += xbc_at(t + i - 3, c) * I.conv_w[i * CONVD + c];
            v = silu_f(v);
            if (ci < 64) xs_l[s][ci] = v; else if (ci < 192) B_l[s][ci - 64] = v; else C_l[s][ci - 192] = v;
        }
        if (tid < nb) { dt_l[tid] = B.DT[(row0 + t0 + tid) * 16 + hd]; ssq_l[tid] = 0.f; }
        __syncthreads();
        for (int s = 0; s < nb; ++s) {
            const float dt = dt_l[s], x = xs_l[s][p], dec = __expf(dt * A), xdt = x * dt;
            float y = 0.f;
#pragma unroll
            for (int i = 0; i < 16; ++i) { h[i] = h[i] * dec + xdt * B_l[s][ng * 16 + i]; y += h[i] * C_l[s][ng * 16 + i]; }
            y += __shfl_xor(y, 1); y += __shfl_xor(y, 2); y += __shfl_xor(y, 4);
            if (ng == 0) {
                bf16* zp = B.AU + (row0 + t0 + s) * 2048 + hd * 64 + p;
                const float u = (y + dsk * x) * bf2f(*zp);
                *zp = (bf16)f2bf(u);
                atomicAdd(&ssq_l[s], u * u);
            }
        }
        __syncthreads();
        if (tid < nb) B.SSQ[(row0 + t0 + tid) * 16 + hd] = ssq_l[tid];
        __syncthreads();
    }
    float* hout = out + (samp ? O_HS : O_HP) + (((size_t)b * NH + hd) * HD + p) * DS + ng * 16;
#pragma unroll
    for (int i = 0; i < 16; ++i) hout[i] = h[i];
}

template <class LoadA, class LoadB, class Epi>
__device__ __forceinline__ void gemm_tile(int M, int N, int K, int bm, int bn, LoadA la, LoadB lb, Epi epi) {
    __shared__ float As[16][128 + 4];
    __shared__ float Bs[16][128 + 4];
    const int tid = threadIdx.x, tx = tid & 15, ty = tid >> 4;
    float acc[8][8];
#pragma unroll
    for (int i = 0; i < 8; ++i)
#pragma unroll
        for (int j = 0; j < 8; ++j) acc[i][j] = 0.f;
    for (int k0 = 0; k0 < K; k0 += 16) {
#pragma unroll
        for (int e = 0; e < 8; ++e) { const int idx = tid + e * 256, r = idx >> 4, k = idx & 15; const int gr = bm + r; As[k][r] = gr < M ? la(gr, k0 + k) : 0.f; }
#pragma unroll
        for (int e = 0; e < 8; ++e) { const int idx = tid + e * 256, k = idx >> 7, c = idx & 127; const int gc = bn + c; Bs[k][c] = gc < N ? lb(k0 + k, gc) : 0.f; }
        __syncthreads();
#pragma unroll
        for (int k = 0; k < 16; ++k) {
            float a[8], b[8];
#pragma unroll
            for (int i = 0; i < 8; ++i) a[i] = As[k][ty * 8 + i];
#pragma unroll
            for (int j = 0; j < 8; ++j) b[j] = Bs[k][tx + 16 * j];
#pragma unroll
            for (int i = 0; i < 8; ++i)
#pragma unroll
                for (int j = 0; j < 8; ++j) acc[i][j] += a[i] * b[j];
        }
        __syncthreads();
    }
#pragma unroll
    for (int i = 0; i < 8; ++i)
#pragma unroll
        for (int j = 0; j < 8; ++j) { const int gr = bm + ty * 8 + i, gc = bn + tx + 16 * j; if (gr < M && gc < N) epi(gr, gc, acc[i][j]); }
}
__global__ void __launch_bounds__(256) k_outproj(Ins I, Bufs B, float* out) {
    const int bn = blockIdx.x * 128, bm = blockIdx.y * 128;
    gemm_tile(NROWS, DM, 2048, bm, bn,
        [&](int r, int k) { if (k < 1024) return bf2f(B.AU[(size_t)r * 2048 + 1024 + k]);
                            float s = 0.f; for (int i = 0; i < 16; ++i) s += B.SSQ[(size_t)r * 16 + i];
                            return bf2f(B.AU[(size_t)r * 2048 + (k - 1024)]) * rsqrtf(s * (1.f / 1024.f) + EPS) * I.ssd_norm_w[k - 1024]; },
        [&](int k, int c) { return I.w_out[(size_t)k * DM + c]; },
        [&](int r, int c, float v) { const float y = xrow(I, r)[c] + v; if (r < NTOK) out[O_YP + (size_t)r * DM + c] = y; else out[O_YS + (size_t)(r - NTOK) * DM + c] = y; });
}
}

extern "C" void kernel_launch(void* const* d_in, const int* in_sizes, int n_in, void* d_out, int out_size, void* d_ws, size_t ws_size, hipStream_t stream) {
    static int grid = 0;
    if (grid == 0) {
        if (n_in != 18 || out_size != (int)O_END || ws_size < WS_END) { fprintf(stderr, "kernel_launch: unexpected n_in %d / out_size %d / ws_size %zu; nothing launched\n", n_in, out_size, ws_size); grid = -1; return; }
        int dev = 0, cus = 0;
        if (hipGetDevice(&dev) != hipSuccess || hipDeviceGetAttribute(&cus, hipDeviceAttributeMultiprocessorCount, dev) != hipSuccess) { grid = -1; return; }
        if (hipFuncSetAttribute((const void*)mk_fwd, hipFuncAttributeMaxDynamicSharedMemorySize, LDS_BYTES) != hipSuccess) { fprintf(stderr, "kernel_launch: hipFuncSetAttribute failed\n"); grid = -1; return; }
        (void)hipGetLastError();
        grid = cus;
    }
    if (grid < 0) return;
    (void)hipMemsetAsync((char*)d_ws + WS_CTL, 0, CTL_ZERO_BYTES, stream);
    Args a{};
    const float** ip = (const float**)&a.in;
    for (int i = 0; i < 18; ++i) ip[i] = (const float*)d_in[i];
    a.out = (float*)d_out; a.ws = (unsigned char*)d_ws;
    unsigned char* ws = (unsigned char*)d_ws;
    hyb::Bufs B{(const bf16*)(ws + WS_Q), (const bf16*)(ws + WS_K), (const bf16*)(ws + WS_V), (const bf16*)(ws + WS_XBC), (bf16*)(ws + WS_AU), (const float*)(ws + WS_DT), (float*)(ws + WS_SSQ)};
    a.ph_lo = 0; a.ph_hi = 2;
    hipLaunchKernelGGL(mk_fwd, dim3(grid), dim3(NWAVES * 64), LDS_BYTES, stream, a);
    hyb::k_attn<<<(NROWS * NH + 3) / 4, 256, 0, stream>>>(a.in, B);
    hyb::k_ssd<<<NB * NH + DB * NH, 512, 0, stream>>>(a.in, B, (float*)d_out);
#if defined(HYB_OUTPROJ)
    hyb::k_outproj<<<dim3(DM / 128, (NROWS + 127) / 128), 256, 0, stream>>>(a.in, B, (float*)d_out);
#else
    a.ph_lo = 3; a.ph_hi = 4;
    hipLaunchKernelGGL(mk_fwd, dim3(grid), dim3(NWAVES * 64), LDS_BYTES, stream, a);
#endif
}
```

```cpp
#include <hip/hip_runtime.h>
#include <cstdio>
#include <cstdint>

constexpr int DM = 1024, NB = 4, SEQ = 8192, DB = 32, WIN = 2048;
constexpr int NPROJ = 6672, NMAIN = 6656, NTOK = NB * SEQ, NROWS = NTOK + DB;
constexpr int MROWS = 33024;
constexpr int C_Q = 0, C_K = 1024, C_V = 2048, C_G = 3072, C_Z = 4096, C_XBC = 5120, C_DT = 6656;
constexpr int CONVD = 1536, NH = 16, HD = 64, DS = 128;
constexpr float EPS = 1e-6f;
constexpr float QSCALE = 0.125f * 1.4426950408889634f;
constexpr float LOG2E = 1.4426950408889634f;
constexpr size_t O_YP = 0, O_YS = O_YP + (size_t)NTOK * DM, O_KP = O_YS + (size_t)DB * DM, O_VP = O_KP + (size_t)NB * WIN * DM,
                 O_CP = O_VP + (size_t)NB * WIN * DM, O_HP = O_CP + (size_t)NB * 3 * CONVD, O_KS = O_HP + (size_t)NB * NH * HD * DS,
                 O_VS = O_KS + (size_t)DB * DM, O_CS = O_VS + (size_t)DB * DM, O_HS = O_CS + (size_t)DB * 3 * CONVD,
                 O_END = O_HS + (size_t)DB * NH * HD * DS;
static_assert(O_END == 55314432, "output size");

constexpr size_t MiB = 1u << 20;
constexpr size_t WS_CTL = 0, CTL_ZERO_BYTES = 1 * MiB;
constexpr size_t WS_WIN = 2 * MiB;
constexpr size_t WS_WOUT = 16 * MiB;
constexpr size_t WS_DT = 20 * MiB;
constexpr size_t WS_SSQ = 24 * MiB;
constexpr size_t WS_XN = 32 * MiB;
constexpr size_t WS_Q = 100 * MiB;
constexpr size_t WS_K = 168 * MiB;
constexpr size_t WS_V = 236 * MiB;
constexpr size_t WS_AU = 304 * MiB;
constexpr size_t WS_XBC = 436 * MiB;
constexpr size_t WS_END = 536 * MiB;
static_assert(WS_XN + (size_t)MROWS * DM * 2 <= WS_Q && WS_Q + (size_t)MROWS * DM * 2 <= WS_K && WS_K + (size_t)MROWS * DM * 2 <= WS_V && WS_V + (size_t)MROWS * DM * 2 <= WS_AU &&
              WS_AU + (size_t)MROWS * 2048 * 2 <= WS_XBC && WS_XBC + (size_t)MROWS * CONVD * 2 <= WS_END && WS_WIN + (size_t)NMAIN * DM * 2 <= WS_WOUT && WS_WOUT + (size_t)DM * 2048 * 2 <= WS_DT &&
              WS_DT + (size_t)MROWS * 16 * 4 <= WS_SSQ && WS_SSQ + (size_t)MROWS * 16 * 4 <= WS_XN, "d_ws map");

struct Ins {
    const float *xp, *xs, *ck, *cv, *sconv, *sssm, *norm_w, *w_in, *qnw, *knw, *rel_bias, *conv_w, *conv_b, *dt_bias, *a_log, *d_skip, *ssd_norm_w, *w_out;
};

typedef unsigned short bf16;
__device__ __forceinline__ float wave_sum(float v) {
#pragma unroll
    for (int o = 1; o < 64; o <<= 1) v += __shfl_xor(v, o);
    return v;
}
__device__ __forceinline__ float wave_max(float v) {
#pragma unroll
    for (int o = 1; o < 64; o <<= 1) v = fmaxf(v, __shfl_xor(v, o));
    return v;
}
__device__ __forceinline__ float silu_f(float x) { return x / (1.f + __expf(-x)); }
__device__ __forceinline__ float silu_fast(float x) { return x * __builtin_amdgcn_rcpf(1.f + __builtin_amdgcn_exp2f(-LOG2E * x)); }
__device__ __forceinline__ float softplus_f(float x) { return x > 20.f ? x : log1pf(__expf(x)); }
__device__ __forceinline__ int t5_bucket(int d) {
    if (d < 16) return d;
    int b = 16;
    b += d >= 22; b += d >= 30; b += d >= 40; b += d >= 54; b += d >= 73; b += d >= 99; b += d >= 134; b += d >= 182;
    b += d >= 246; b += d >= 332; b += d >= 450; b += d >= 609; b += d >= 825; b += d >= 1117; b += d >= 1513;
    return b;
}
__device__ __forceinline__ const float* xrow(const Ins& I, int r) { return r < NTOK ? I.xp + (size_t)r * DM : I.xs + (size_t)(r - NTOK) * DM; }
__device__ __forceinline__ float bf2f(bf16 v) { return __uint_as_float((unsigned)v << 16); }
__device__ __forceinline__ unsigned f2bf(float f) { unsigned u = __float_as_uint(f); return (u + 0x7fffu + ((u >> 16) & 1u)) >> 16; }
__device__ __forceinline__ unsigned pk2(float lo, float hi) { return f2bf(lo) | (f2bf(hi) << 16); }
__host__ __device__ __forceinline__ int vrow_of_col(int a) { return 128 * ((a >> 5) & 1) + 32 * ((a >> 6) & 3) + (a & 31); }

namespace pg8 {
#define PG8_LAS __attribute__((address_space(3)))
typedef unsigned short bf16_t;
typedef short bf16x8 __attribute__((ext_vector_type(8)));
typedef float f32x4 __attribute__((ext_vector_type(4)));
typedef unsigned u32x4 __attribute__((ext_vector_type(4)));
constexpr int BM = 256, BK = 64, HALF = 128, HTB = HALF * BK * 2  , STAGE_BYTES = 8 * HTB, NXCD = 8, WGM = 8;

__host__ __device__ __forceinline__ int lds_byte(int r, int c) { const int st = (r >> 4) * 2 + (c >> 5), rr = r & 15, cc = c & 31, ob = rr * 64 + cc * 2; return st * 1024 + (ob ^ (((ob >> 9) & 1) << 5)); }
__host__ __device__ __forceinline__ void stage_rc(int b, int& R, int& C) { const int st = b / 1024, sb = b % 1024, swz = sb ^ (((sb >> 9) & 1) << 5); R = (st >> 1) * 16 + swz / 64; C = (st & 1) * 32 + (swz % 64) / 2; }
__host__ __device__ __forceinline__ int perm32(int rho) { const int n = rho >> 4, i = rho & 15; return 8 * (i >> 2) + 4 * n + (i & 3); }

struct Unit { int pm, pn; };
struct Gemm { const bf16_t* A; const bf16_t* Bt; int M, N, K; };

struct StaticOrder {
    int nM, nN, nwg, G, c;
    __host__ __device__ void init(int M, int N, int G_, int c_) { nM = M / BM; nN = N / BM; nwg = nM * nN; G = G_; c = c_; }
    __host__ __device__ bool next(int i, Unit& u) const {
        const long L = (long)i * G + c; if (L >= nwg) return false;
        int wgid = (int)L; { const int q = nwg / NXCD, r = nwg % NXCD, xcd = wgid % NXCD, off = wgid / NXCD; wgid = (xcd < r ? xcd * (q + 1) : r * (q + 1) + (xcd - r) * q) + off; }
        const int nig = WGM * nN, gid = wgid / nig, fm = gid * WGM, gsz = (nM - fm) < WGM ? (nM - fm) : WGM;
        u.pm = fm + ((wgid % nig) % gsz); u.pn = (wgid % nig) / gsz; return true;
    }
    __device__ __forceinline__ void a_ready(const Unit&) const {}
    __device__ __forceinline__ void done(const Unit&) const {}
};

__device__ __forceinline__ unsigned cvt_pk_bf16(float lo, float hi) { unsigned r; asm volatile("v_cvt_pk_bf16_f32 %0, %1, %2" : "=v"(r) : "v"(lo), "v"(hi)); return r; }

struct EpiIn {
    static constexpr bool PERM = true, AFTER_DRAIN = false, MIDK = false;
    bf16_t *Q, *K, *V, *AU, *XBC; float* out; const float *qnw, *knw;
    __device__ __forceinline__ void mid(f32x4 (&)[2][2][4][2], const Unit&, int, int, int, int, int) const {}
    __device__ __forceinline__ void operator()(const f32x4 (&acc)[2][2][4][2], const Unit& u, int wr, int wc, int fr, int fq) const {
        const int pn = u.pn;
        const int rowb = u.pm * BM + wr * 64 + fr;
        const int cl = wc * 64 + 8 * fq;
        if (pn < 8) {
            const bool isq = pn < 4; const float* nw = isq ? qnw : knw;
            f32x4 w[2][2];
#pragma unroll
            for (int bj = 0; bj < 2; ++bj)
#pragma unroll
                for (int n = 0; n < 2; ++n) w[bj][n] = *(const f32x4*)(nw + 8 * fq + 32 * bj + 4 * n);
            bf16_t* dstb = (isq ? Q : K) + (pn & 3) * 256 + cl;
#pragma unroll
            for (int ai = 0; ai < 2; ++ai)
#pragma unroll
                for (int m = 0; m < 4; ++m) {
                    const int r = rowb + ai * HALF + m * 16;
                    float ss = 0.f;
#pragma unroll
                    for (int bj = 0; bj < 2; ++bj)
#pragma unroll
                        for (int n = 0; n < 2; ++n) { const f32x4 v = acc[ai][bj][m][n]; ss += (v[0] * v[0] + v[1] * v[1]) + (v[2] * v[2] + v[3] * v[3]); }
                    ss += __shfl_xor(ss, 16); ss += __shfl_xor(ss, 32);
                    const float sc = rsqrtf(ss * (1.f / 64.f) + EPS), scs = isq ? sc * QSCALE : sc;
                    float* f32dst = nullptr;
                    if (!isq) { if (r < NTOK) { const int t = r & (SEQ - 1); if (t >= SEQ - WIN) f32dst = out + O_KP + ((size_t)((r >> 13) * WIN + t - (SEQ - WIN))) * DM + (pn & 3) * 256 + cl; }
                                else if (r < NROWS) f32dst = out + O_KS + (size_t)(r - NTOK) * DM + (pn & 3) * 256 + cl; }
#pragma unroll
                    for (int bj = 0; bj < 2; ++bj) {
                        const f32x4 a0 = acc[ai][bj][m][0] * w[bj][0], a1 = acc[ai][bj][m][1] * w[bj][1];
                        u32x4 o; o.x = cvt_pk_bf16(a0[0] * scs, a0[1] * scs); o.y = cvt_pk_bf16(a0[2] * scs, a0[3] * scs); o.z = cvt_pk_bf16(a1[0] * scs, a1[1] * scs); o.w = cvt_pk_bf16(a1[2] * scs, a1[3] * scs);
                        *(u32x4*)(dstb + (size_t)r * DM + 32 * bj) = o;
                        if (f32dst) { *(f32x4*)(f32dst + 32 * bj) = a0 * sc; *(f32x4*)(f32dst + 32 * bj + 4) = a1 * sc; }
                    }
                }
        } else if (pn < 12) {
            bf16_t* dstb = V + (pn & 3) * 256 + cl;
#pragma unroll
            for (int ai = 0; ai < 2; ++ai)
#pragma unroll
                for (int m = 0; m < 4; ++m) {
                    const int r = rowb + ai * HALF + m * 16;
                    float* f32dst = nullptr;
                    if (r < NTOK) { const int t = r & (SEQ - 1); if (t >= SEQ - WIN) f32dst = out + O_VP + ((size_t)((r >> 13) * WIN + t - (SEQ - WIN))) * DM + (pn & 3) * 256 + cl; }
                    else if (r < NROWS) f32dst = out + O_VS + (size_t)(r - NTOK) * DM + (pn & 3) * 256 + cl;
#pragma unroll
                    for (int bj = 0; bj < 2; ++bj) {
                        const f32x4 a0 = acc[ai][bj][m][0], a1 = acc[ai][bj][m][1];
                        u32x4 o; o.x = cvt_pk_bf16(a0[0], a0[1]); o.y = cvt_pk_bf16(a0[2], a0[3]); o.z = cvt_pk_bf16(a1[0], a1[1]); o.w = cvt_pk_bf16(a1[2], a1[3]);
                        *(u32x4*)(dstb + (size_t)r * DM + 32 * bj) = o;
                        if (f32dst) { *(f32x4*)(f32dst + 32 * bj) = a0; *(f32x4*)(f32dst + 32 * bj + 4) = a1; }
                    }
                }
        } else if (pn < 20) {
            bf16_t* dstb = AU + (pn < 16 ? 1024 : 0) + (pn & 3) * 256 + cl;
#pragma unroll
            for (int ai = 0; ai < 2; ++ai)
#pragma unroll
                for (int m = 0; m < 4; ++m) {
                    const int r = rowb + ai * HALF + m * 16;
#pragma unroll
                    for (int bj = 0; bj < 2; ++bj) {
                        f32x4 a0 = acc[ai][bj][m][0], a1 = acc[ai][bj][m][1];
#pragma unroll
                        for (int i = 0; i < 4; ++i) { a0[i] = silu_fast(a0[i]); a1[i] = silu_fast(a1[i]); }
                        u32x4 o; o.x = cvt_pk_bf16(a0[0], a0[1]); o.y = cvt_pk_bf16(a0[2], a0[3]); o.z = cvt_pk_bf16(a1[0], a1[1]); o.w = cvt_pk_bf16(a1[2], a1[3]);
                        *(u32x4*)(dstb + (size_t)r * 2048 + 32 * bj) = o;
                    }
                }
        } else {
            const int cb = (pn - 20) * 256 + cl;
            bf16_t* dstb = XBC + cb;
#pragma unroll
            for (int ai = 0; ai < 2; ++ai)
#pragma unroll
                for (int m = 0; m < 4; ++m) {
                    const int r = rowb + ai * HALF + m * 16;
                    float* f32dst = nullptr;
                    if (r < NTOK) { const int t = r & (SEQ - 1); if (t >= SEQ - 3) f32dst = out + O_CP + ((size_t)((r >> 13) * 3 + t - (SEQ - 3))) * CONVD + cb; }
                    else if (r < NROWS) f32dst = out + O_CS + ((size_t)(r - NTOK) * 3 + 2) * CONVD + cb;
#pragma unroll
                    for (int bj = 0; bj < 2; ++bj) {
                        const f32x4 a0 = acc[ai][bj][m][0], a1 = acc[ai][bj][m][1];
                        u32x4 o; o.x = cvt_pk_bf16(a0[0], a0[1]); o.y = cvt_pk_bf16(a0[2], a0[3]); o.z = cvt_pk_bf16(a1[0], a1[1]); o.w = cvt_pk_bf16(a1[2], a1[3]);
                        *(u32x4*)(dstb + (size_t)r * CONVD + 32 * bj) = o;
                        if (f32dst) { *(f32x4*)(f32dst + 32 * bj) = a0; *(f32x4*)(f32dst + 32 * bj + 4) = a1; }
                    }
                }
        }
    }
};

struct EpiOut {
    static constexpr bool PERM = true, AFTER_DRAIN = false, MIDK = true;
    const float* xp; const float* xs; const PG8_LAS float* rs; float* out;
    __device__ __forceinline__ void mid(f32x4 (&acc)[2][2][4][2], const Unit& u, int ui, int wr, int wc, int fr, int fq) const {
        const PG8_LAS float* rp = rs + ui * 256 + wr * 64 + fr;
#pragma unroll
        for (int ai = 0; ai < 2; ++ai)
#pragma unroll
            for (int m = 0; m < 4; ++m) {
                const float r = rp[ai * HALF + m * 16];
#pragma unroll
                for (int bj = 0; bj < 2; ++bj)
#pragma unroll
                    for (int n = 0; n < 2; ++n) acc[ai][bj][m][n] *= r;
            }
    }
    __device__ __forceinline__ void operator()(const f32x4 (&acc)[2][2][4][2], const Unit& u, int wr, int wc, int fr, int fq) const {
        const int rowb = u.pm * BM + wr * 64 + fr, col = u.pn * BM + wc * 64 + 8 * fq;
#pragma unroll
        for (int ai = 0; ai < 2; ++ai)
#pragma unroll
            for (int m = 0; m < 4; ++m) {
                const int r = rowb + ai * HALF + m * 16;
                if (r >= NROWS) continue;
                const float* xr = (r < NTOK ? xp + (size_t)r * DM : xs + (size_t)(r - NTOK) * DM) + col;
                float* yr = out + (r < NTOK ? O_YP + (size_t)r * DM : O_YS + (size_t)(r - NTOK) * DM) + col;
#pragma unroll
                for (int bj = 0; bj < 2; ++bj) {
                    *(f32x4*)(yr + 32 * bj) = *(const f32x4*)(xr + 32 * bj) + acc[ai][bj][m][0];
                    *(f32x4*)(yr + 32 * bj + 4) = *(const f32x4*)(xr + 32 * bj + 4) + acc[ai][bj][m][1];
                }
            }
    }
};

template <class Epi, class Sched, bool ALIGN_EPI = false, bool SP2 = false>
__device__ __forceinline__ void gemm_phase(PG8_LAS unsigned char* lds, const Gemm g, const Sched& S, const Epi& E) {
    const int tid = threadIdx.x, wid = __builtin_amdgcn_readfirstlane(tid >> 6), lane = tid & 63, wr = wid >> 2, wc = wid & 3, fr = lane & 15, fq = lane >> 4;
    const int K = g.K, nt = K / BK;
    unsigned voffA[2], voffB[2];
#pragma unroll
    for (int i = 0; i < 2; ++i) { int R, C; stage_rc(tid * 16 + i * 8192, R, C); const int Rb = Epi::PERM ? ((R & ~31) + perm32(R & 31)) : R;
        voffA[i] = (unsigned)(R * K + C) * 2u; voffB[i] = (unsigned)(Rb * K + C) * 2u; }
    const size_t kstep = (size_t)(BK * 2);
    const size_t hstep = (size_t)HALF * K * 2;
    const size_t tstep = 2 * hstep;
    const unsigned ldsw = (unsigned)wid * 1024u;
    const int aoff = lds_byte(wr * 64 + fr, fq * 8), boff = lds_byte(wc * 32 + fr, fq * 8);
#define PG8_SA(b, h) (((b) * 2 + (h)) * HTB)
#define PG8_SB(b, h) ((4 + (b) * 2 + (h)) * HTB)
#define PG8_STAGE(bufoff, gbase, voff) do { _Pragma("unroll") for (int _i = 0; _i < 2; ++_i) \
        __builtin_amdgcn_global_load_lds((const unsigned*)((const char*)(gbase) + (voff)[_i]), (PG8_LAS unsigned*)(lds + (bufoff) + ldsw + _i * 8192), 16, 0, 0); } while (0)
#define PG8_LDA(dst, b, h) do { _Pragma("unroll") for (int m = 0; m < 4; ++m) _Pragma("unroll") for (int k = 0; k < 2; ++k) dst[m][k] = *(const PG8_LAS bf16x8*)(lds + PG8_SA(b, h) + aoff + m * 2048 + k * 1024); } while (0)
#define PG8_LDB(dst, b, h) do { _Pragma("unroll") for (int n = 0; n < 2; ++n) _Pragma("unroll") for (int k = 0; k < 2; ++k) dst[n][k] = *(const PG8_LAS bf16x8*)(lds + PG8_SB(b, h) + boff + n * 2048 + k * 1024); } while (0)
#define PG8_MMA(ai, bj, At, Bt) do { __builtin_amdgcn_s_setprio(1); _Pragma("unroll") for (int m = 0; m < 4; ++m) _Pragma("unroll") for (int n = 0; n < 2; ++n) _Pragma("unroll") for (int k = 0; k < 2; ++k) \
        acc[ai][bj][m][n] = __builtin_amdgcn_mfma_f32_16x16x32_bf16(Bt[n][k], At[m][k], acc[ai][bj][m][n], 0, 0, 0); __builtin_amdgcn_s_setprio(0); } while (0)
#define PG8_WAIT_V(n) asm volatile("s_waitcnt vmcnt(" #n ")" ::: "memory")
#define PG8_WAIT_L(n) asm volatile("s_waitcnt lgkmcnt(" #n ")" ::: "memory")
#define PG8_BAR __builtin_amdgcn_s_barrier()
#define PG8_SCHED __builtin_amdgcn_sched_barrier(0)
    Unit cur, nxt; int ui = 0;
    if (!S.next(0, cur)) return;
    f32x4 acc[2][2][4][2];
#pragma unroll
    for (int a = 0; a < 2; ++a)
#pragma unroll
        for (int b = 0; b < 2; ++b)
#pragma unroll
            for (int m = 0; m < 4; ++m)
#pragma unroll
                for (int n = 0; n < 2; ++n) acc[a][b][m][n] = (f32x4){0.f, 0.f, 0.f, 0.f};
    bf16x8 At[4][2], B0[2][2], B1[2][2];
    const char* cA = (const char*)g.A + (size_t)cur.pm * tstep; const char* cB = (const char*)g.Bt + (size_t)cur.pn * tstep;
    S.a_ready(cur);
    if constexpr (SP2) {
        PG8_STAGE(PG8_SB(0, 0), cB, voffB); PG8_STAGE(PG8_SB(0, 1), cB + hstep, voffB); PG8_STAGE(PG8_SA(0, 0), cA, voffA); PG8_STAGE(PG8_SA(0, 1), cA + hstep, voffA);
        if (wr == 1) PG8_BAR;
        PG8_WAIT_V(2); PG8_BAR;
        PG8_STAGE(PG8_SB(1, 0), cB + kstep, voffB); PG8_STAGE(PG8_SA(1, 0), cA + kstep, voffA); PG8_STAGE(PG8_SB(1, 1), cB + hstep + kstep, voffB);
        PG8_WAIT_V(6); PG8_BAR;
    } else {
        PG8_STAGE(PG8_SB(0, 0), cB, voffB); PG8_STAGE(PG8_SA(0, 0), cA, voffA); PG8_STAGE(PG8_SB(0, 1), cB + hstep, voffB); PG8_STAGE(PG8_SA(0, 1), cA + hstep, voffA);
        if (wr == 1) PG8_BAR;
        PG8_WAIT_V(4); PG8_BAR;
        PG8_STAGE(PG8_SB(1, 0), cB + kstep, voffB); PG8_STAGE(PG8_SA(1, 0), cA + kstep, voffA); PG8_STAGE(PG8_SB(1, 1), cB + hstep + kstep, voffB);
        PG8_WAIT_V(6); PG8_BAR;
    }
    for (;;) {
        const bool has_next = S.next(ui + 1, nxt);
        const char* nA = has_next ? (const char*)g.A + (size_t)nxt.pm * tstep : cA; const char* nB = has_next ? (const char*)g.Bt + (size_t)nxt.pn * tstep : cB;
        for (int t = 0; t < nt; t += 2) {
            const bool last = (t == nt - 2);
            if constexpr (Epi::MIDK) { if (t == (nt >> 1)) E.mid(acc, cur, ui, wr, wc, fr, fq); }
            const char* a1 = cA + (size_t)(t + 1) * kstep;
            const char* a2 = last ? nA : cA + (size_t)(t + 2) * kstep; const char* b2 = last ? nB : cB + (size_t)(t + 2) * kstep;
            const char* a3 = a2 + kstep; const char* b3 = b2 + kstep;
            if (last && has_next) S.a_ready(nxt);
            if constexpr (SP2) {
            PG8_LDB(B0, 0, 0); PG8_LDB(B1, 0, 1); PG8_SCHED; PG8_LDA(At, 0, 0); PG8_STAGE(PG8_SA(1, 1), a1 + hstep, voffA);
            PG8_WAIT_V(8); PG8_WAIT_L(0); PG8_BAR; PG8_MMA(0, 0, At, B0); PG8_MMA(0, 1, At, B1); PG8_BAR; PG8_SCHED;
            PG8_LDA(At, 0, 1); PG8_STAGE(PG8_SB(0, 0), b2, voffB); PG8_STAGE(PG8_SB(0, 1), b2 + hstep, voffB); PG8_STAGE(PG8_SA(0, 0), a2, voffA);
            PG8_WAIT_V(8); PG8_WAIT_L(0); PG8_BAR; PG8_MMA(1, 0, At, B0); PG8_MMA(1, 1, At, B1); PG8_BAR; PG8_SCHED;
            PG8_LDB(B0, 1, 0); PG8_LDB(B1, 1, 1); PG8_SCHED; PG8_LDA(At, 1, 0); PG8_STAGE(PG8_SA(0, 1), a2 + hstep, voffA);
            PG8_WAIT_V(8); PG8_WAIT_L(0); PG8_BAR; PG8_MMA(0, 0, At, B0); PG8_MMA(0, 1, At, B1); PG8_BAR; PG8_SCHED;
            PG8_LDA(At, 1, 1); PG8_STAGE(PG8_SB(1, 0), b3, voffB); PG8_STAGE(PG8_SB(1, 1), b3 + hstep, voffB); PG8_STAGE(PG8_SA(1, 0), a3, voffA);
            PG8_WAIT_V(8); PG8_WAIT_L(0); PG8_BAR; PG8_MMA(1, 0, At, B0); PG8_MMA(1, 1, At, B1); PG8_BAR; PG8_SCHED;
            } else {
            PG8_LDB(B0, 0, 0); PG8_SCHED; PG8_LDA(At, 0, 0); PG8_STAGE(PG8_SA(1, 1), a1 + hstep, voffA);
            PG8_WAIT_L(8); PG8_BAR; PG8_WAIT_L(0); PG8_MMA(0, 0, At, B0); PG8_BAR; PG8_SCHED;
            PG8_LDB(B1, 0, 1); PG8_STAGE(PG8_SB(0, 0), b2, voffB);
            PG8_BAR; PG8_WAIT_L(0); PG8_MMA(0, 1, At, B1); PG8_BAR;
            PG8_LDA(At, 0, 1); PG8_STAGE(PG8_SA(0, 0), a2, voffA);
            PG8_BAR; PG8_WAIT_L(0); PG8_MMA(1, 0, At, B0); PG8_BAR; PG8_SCHED;
            PG8_STAGE(PG8_SB(0, 1), b2 + hstep, voffB);
            PG8_WAIT_V(6); PG8_BAR; PG8_MMA(1, 1, At, B1); PG8_BAR;
            PG8_LDB(B0, 1, 0); PG8_SCHED; PG8_LDA(At, 1, 0); PG8_STAGE(PG8_SA(0, 1), a2 + hstep, voffA);
            PG8_WAIT_L(8); PG8_BAR; PG8_WAIT_L(0); PG8_MMA(0, 0, At, B0); PG8_BAR; PG8_SCHED;
            PG8_LDB(B1, 1, 1); PG8_STAGE(PG8_SB(1, 0), b3, voffB);
            PG8_BAR; PG8_WAIT_L(0); PG8_MMA(0, 1, At, B1); PG8_BAR;
            PG8_LDA(At, 1, 1); PG8_STAGE(PG8_SA(1, 0), a3, voffA);
            PG8_BAR; PG8_WAIT_L(0); PG8_MMA(1, 0, At, B0); PG8_BAR; PG8_SCHED;
            PG8_STAGE(PG8_SB(1, 1), b3 + hstep, voffB);
            PG8_WAIT_V(6); PG8_BAR; PG8_MMA(1, 1, At, B1); PG8_BAR;
            }
        }
        if constexpr (ALIGN_EPI) { if (wr == 0) PG8_BAR; }
        if constexpr (!Epi::AFTER_DRAIN) { E(acc, cur, wr, wc, fr, fq); S.done(cur); }
        if (!has_next) break;
#pragma unroll
        for (int a = 0; a < 2; ++a)
#pragma unroll
            for (int b = 0; b < 2; ++b)
#pragma unroll
                for (int m = 0; m < 4; ++m)
#pragma unroll
                    for (int n = 0; n < 2; ++n) acc[a][b][m][n] = (f32x4){0.f, 0.f, 0.f, 0.f};
        cur = nxt; cA = nA; cB = nB; ++ui;
        if constexpr (ALIGN_EPI) { if (wr == 1) PG8_BAR; }
    }
    PG8_WAIT_V(0);
    if constexpr (!ALIGN_EPI) { if (wr == 0) PG8_BAR; }
    PG8_BAR;
    if constexpr (Epi::AFTER_DRAIN) { E.fused(acc, cur, wr, wc, fr, fq, lds, wid, lane); S.done(cur); }
#undef PG8_SA
#undef PG8_SB
#undef PG8_STAGE
#undef PG8_LDA
#undef PG8_LDB
#undef PG8_MMA
#undef PG8_WAIT_V
#undef PG8_WAIT_L
#undef PG8_BAR
#undef PG8_SCHED
}
}
#define GAS __attribute__((address_space(1)))
#define LAS __attribute__((address_space(3)))
typedef unsigned v4u __attribute__((ext_vector_type(4)));
typedef float f32x4 __attribute__((ext_vector_type(4)));
typedef short bf16x8 __attribute__((ext_vector_type(8)));
typedef GAS unsigned gu32;
typedef GAS unsigned long long gu64;
#define RLX_AGENT __ATOMIC_RELAXED, __HIP_MEMORY_SCOPE_AGENT
#define LDS_WAIT() asm volatile("s_waitcnt lgkmcnt(0)" ::: "memory")
#define VM_WAIT() asm volatile("s_waitcnt vmcnt(0)" ::: "memory")
__device__ __forceinline__ unsigned long long rt() { return __builtin_amdgcn_s_memrealtime(); }

#define XB_TMO      128
#define XB_XCNT(j)  (256  + 64 * (j))
#define XB_XSUB(j)  (1280 + 64 * (j))
#define XB_XGEN(j)  (2304 + 64 * (j))
#define XB_TOP      3328
#define XB_TOPGEN   3392
#define XCD_BAR_WORDS 3456
#define XB_SPIN_CAP (1u << 18)

__device__ __forceinline__ unsigned xb_ld(unsigned* p)              { return __hip_atomic_load(p, __ATOMIC_RELAXED, __HIP_MEMORY_SCOPE_AGENT); }
__device__ __forceinline__ unsigned xb_add(unsigned* p, unsigned v) { return __hip_atomic_fetch_add(p, v, __ATOMIC_RELAXED, __HIP_MEMORY_SCOPE_AGENT); }
__device__ __forceinline__ unsigned xb_xcc_id() { return (unsigned)__builtin_amdgcn_s_getreg((3 << 11) | 20) & 0xFu; }
#define XB_SPIN(cond, bar) do { unsigned _sp = 0; while (cond) { __builtin_amdgcn_s_sleep(1); \
    if ((++_sp & 255u) == 0u) { if (xb_ld(&(bar)[XB_TMO])) break; if (_sp > XB_SPIN_CAP) { atomicAdd(&(bar)[XB_TMO], 1u); break; } } } } while (0)

struct XcdBarrier {
    unsigned* bar; unsigned x;
    volatile LAS unsigned* st;
};

__device__ __forceinline__ XcdBarrier xcd_barrier_post(unsigned* bar, volatile LAS unsigned* st) {
    XcdBarrier b; b.bar = bar; b.x = xb_xcc_id(); b.st = st;
    if (threadIdx.x == 0) (void)xb_add(&bar[XB_XCNT(b.x)], 1u);
    return b;
}
__device__ __forceinline__ void xcd_barrier_complete(unsigned* bar, unsigned x, unsigned& nloc, unsigned& nx) {
    const unsigned G = gridDim.x * gridDim.y * gridDim.z;
    unsigned sum, cnt, mine, sp = 0u;
    for (;;) {
        sum = 0u; cnt = 0u; mine = 0u;
#pragma unroll
        for (unsigned j = 0; j < 16; ++j) { const unsigned c = xb_ld(&bar[XB_XCNT(j)]); sum += c; cnt += (c > 0u) ? 1u : 0u; mine = (j == x) ? c : mine; }
        if (sum == G) break;
        __builtin_amdgcn_s_sleep(1);
        if ((++sp & 255u) == 0u) { if (xb_ld(&bar[XB_TMO])) break; if (sp > XB_SPIN_CAP) { atomicAdd(&bar[XB_TMO], 1u); break; } }
    }
    nloc = mine > 0u ? mine : 1u; nx = cnt > 0u ? cnt : 1u;
}

__device__ __forceinline__ void xcd_barrier(const XcdBarrier& b) {
    asm volatile("s_waitcnt vmcnt(0)" ::: "memory");
    __syncthreads();
    if (threadIdx.x == 0) {
        unsigned* bar = b.bar;
        __builtin_amdgcn_s_waitcnt(0);
        unsigned nloc = b.st[0], nx = b.st[1];
        if (nloc == 0u) { xcd_barrier_complete(bar, b.x, nloc, nx); b.st[0] = nloc; b.st[1] = nx; }
        const unsigned old = xb_add(&bar[XB_XSUB(b.x)], 1u);
        const unsigned gen = old / nloc;
        if (old + 1u == (gen + 1u) * nloc) {
            __builtin_amdgcn_fence(__ATOMIC_RELEASE, "agent");
            asm volatile("s_waitcnt vmcnt(0)" ::: "memory");
            const unsigned og = xb_add(&bar[XB_TOP], 1u);
            const unsigned tg = og / nx;
            if (og + 1u == (tg + 1u) * nx) xb_add(&bar[XB_TOPGEN], 1u);
            else XB_SPIN(xb_ld(&bar[XB_TOPGEN]) == tg, bar);
            __builtin_amdgcn_fence(__ATOMIC_ACQUIRE, "agent");
            xb_add(&bar[XB_XGEN(b.x)], 1u);
            asm volatile("s_waitcnt vmcnt(0)" ::: "memory");
        } else {
            XB_SPIN(xb_ld(&bar[XB_XGEN(b.x)]) == gen, bar);
            __builtin_amdgcn_fence(__ATOMIC_ACQUIRE, "agent");
            asm volatile("s_waitcnt vmcnt(0)" ::: "memory");
        }
    }
    __syncthreads();
}

constexpr int NWAVES = 8;
constexpr int RING_OFF = 0, RING_BYTES = 131072;
constexpr int LDS_BYTES = 163840;
constexpr int LDSCTL_OFF = LDS_BYTES - 512, MISC_OFF = LDSCTL_OFF + 320;
constexpr int CW_BAR = 4096;
constexpr int CW_Q = 16384;
static_assert((CW_BAR + XCD_BAR_WORDS) <= CW_Q && (CW_Q + 64 * 64) * 4 <= (int)CTL_ZERO_BYTES, "CTL words inside the memset region");

struct Frame {
    LAS unsigned char* lds;
    volatile LAS unsigned* MISC;
    gu32* ctl;
    int tid, lane, wave, vcu, G;
    Ins I; float* out;
    bf16 *WinT, *WoutT, *XN, *Q, *K, *V, *AU, *XBC; float *DT, *SSQ;
};

template <class SrcF>
__device__ __forceinline__ void p0_transpose_item(SrcF src, int k0, int n0, bf16* WT, int dst_pitch, int dst_row0, int dst_k0, LAS float* scr, int lane) {
#pragma unroll 8
    for (int i = 0; i < 32; ++i) { const int kk = 2 * i + (lane >> 5); scr[kk * 33 + (lane & 31)] = src(k0 + kk, n0 + (lane & 31)); }
    LDS_WAIT(); asm volatile("" ::: "memory");
    const int c = lane & 7;
#pragma unroll
    for (int j = 0; j < 4; ++j) { const int n = (lane >> 3) + 8 * j; const LAS float* s = scr + (8 * c) * 33 + n;
        v4u o; o.x = pk2(s[0 * 33], s[1 * 33]); o.y = pk2(s[2 * 33], s[3 * 33]); o.z = pk2(s[4 * 33], s[5 * 33]); o.w = pk2(s[6 * 33], s[7 * 33]);
        *(GAS v4u*)(WT + (size_t)(dst_row0 + n) * dst_pitch + dst_k0 + 8 * c) = o; }
    LDS_WAIT(); asm volatile("" ::: "memory");
}
constexpr int P0_SCR_BYTES = 8448, WDT_OFF = NWAVES * P0_SCR_BYTES, WDT_PITCH = 20;
static_assert(WDT_OFF + 1024 * WDT_PITCH * 4 <= LDSCTL_OFF, "prologue LDS");

__device__ __forceinline__ void p0_prologue(Frame& F) {
    const Ins& I = F.I;
    LAS float* scr = (LAS float*)(F.lds + F.wave * P0_SCR_BYTES);
    LAS float* wdt = (LAS float*)(F.lds + WDT_OFF);
    const int gw = F.vcu * NWAVES + F.wave, NGW = F.G * NWAVES;
    for (int idx = F.tid; idx < 1024 * 16; idx += NWAVES * 64) {
        const int k = idx >> 4, j = idx & 15, pos = (((k >> 8) * 4 + (k & 3)) << 6) + ((k >> 2) & 63);
        wdt[pos * WDT_PITCH + j] = I.w_in[(size_t)k * NPROJ + C_DT + j] * I.norm_w[k];
    }
    constexpr int I_IN = (DM / 64) * (NMAIN / 32), I_OUT = (2048 / 64) * (DM / 32);
    for (int it = gw; it < I_IN + I_OUT; it += NGW) {
        if (it < I_IN) {
            const int nblk = NMAIN / 32, kb = it / nblk, nb = it % nblk, k0 = 64 * kb, n0 = 32 * nb;
            p0_transpose_item([&](int k, int n) { return I.w_in[(size_t)k * NPROJ + n] * I.norm_w[k]; }, k0, n0, F.WinT, DM, (n0 & ~255) + vrow_of_col(n0 & 255), k0, scr, F.lane);
        } else {
            const int r = it - I_IN, nblk = DM / 32, kb = r / nblk, nb = r % nblk, k0 = 64 * kb, n0 = 32 * nb;
            p0_transpose_item([&](int k, int n) { return I.w_out[(size_t)k * DM + n] * (k >= 1024 ? I.ssd_norm_w[k - 1024] : 1.f); }, k0, n0, F.WoutT, 2048, (n0 & ~255) + vrow_of_col(n0 & 255), (k0 + 1024) & 2047, scr, F.lane);
        }
    }
    __syncthreads();
    for (int rp = gw; rp < NROWS / 2; rp += NGW) {
        f32x4 v[2][4]; float rstd[2];
#pragma unroll
        for (int q = 0; q < 2; ++q) {
            const GAS f32x4* xr = (const GAS f32x4*)xrow(I, 2 * rp + q) + F.lane; float s = 0.f;
#pragma unroll
            for (int j = 0; j < 4; ++j) { v[q][j] = xr[64 * j]; s += (v[q][j].x * v[q][j].x + v[q][j].y * v[q][j].y) + (v[q][j].z * v[q][j].z + v[q][j].w * v[q][j].w); }
            rstd[q] = rsqrtf(wave_sum(s) * (1.f / DM) + EPS);
            GAS unsigned long long* o8 = (GAS unsigned long long*)(F.XN + (size_t)(2 * rp + q) * DM) + F.lane;
#pragma unroll
            for (int j = 0; j < 4; ++j) o8[64 * j] = (unsigned long long)pk2(v[q][j].x * rstd[q], v[q][j].y * rstd[q]) | ((unsigned long long)pk2(v[q][j].z * rstd[q], v[q][j].w * rstd[q]) << 32);
        }
        float a[32];
#pragma unroll
        for (int i = 0; i < 32; ++i) a[i] = 0.f;
#pragma unroll
        for (int j = 0; j < 4; ++j)
#pragma unroll
            for (int e = 0; e < 4; ++e) {
                const LAS f32x4* wp = (const LAS f32x4*)(wdt + ((j * 4 + e) * 64 + F.lane) * WDT_PITCH);
                const float x0 = v[0][j][e], x1 = v[1][j][e];
#pragma unroll
                for (int c4 = 0; c4 < 4; ++c4) { const f32x4 w = wp[c4];
#pragma unroll
                    for (int i = 0; i < 4; ++i) { a[c4 * 4 + i] += x0 * w[i]; a[16 + c4 * 4 + i] += x1 * w[i]; } }
                asm volatile("" ::: "memory");
            }
#define P0_HALVE(N, X) { const bool up = (F.lane & (X)) != 0; _Pragma("unroll") for (int i = 0; i < (N); ++i) { const float keep = up ? a[i + (N)] : a[i], send = up ? a[i] : a[i + (N)]; a[i] = keep + __shfl_xor(send, (X)); } }
        P0_HALVE(16, 32) P0_HALVE(8, 16) P0_HALVE(4, 8) P0_HALVE(2, 4) P0_HALVE(1, 2)
#undef P0_HALVE
        float tot = a[0] + __shfl_xor(a[0], 1);
        const int idx = F.lane >> 1, q = idx >> 4, c = idx & 15;
        tot = tot * (q ? rstd[1] : rstd[0]) + I.dt_bias[c];
        if ((F.lane & 1) == 0) F.DT[(size_t)(2 * rp + q) * 16 + c] = softplus_f(tot);
    }
    for (int r = NROWS + gw; r < MROWS; r += NGW) { GAS v4u* o = (GAS v4u*)(F.XN + (size_t)r * DM) + F.lane; o[0] = (v4u){0u, 0u, 0u, 0u}; o[64] = (v4u){0u, 0u, 0u, 0u}; }
    for (int i = (F.vcu * NWAVES * 64 + F.tid); i < DB * 2 * CONVD; i += F.G * NWAVES * 64) {
        const int c = i % CONVD, rr = i / CONVD, j = rr & 1, b = rr >> 1;
        F.out[O_CS + ((size_t)b * 3 + j) * CONVD + c] = I.sconv[((size_t)b * 3 + j + 1) * CONVD + c];
    }
}

namespace att {
typedef float f32x16 __attribute__((ext_vector_type(16)));
typedef short v4i16_t __attribute__((ext_vector_type(4)));
typedef unsigned u32x4 __attribute__((ext_vector_type(4)));
constexpr int SPAN = 256, NSPAN = SEQ / SPAN, NUNITS = NB * NH * NSPAN;
constexpr int OACC_OFF = 0, LACC_OFF = 65536, LUT_OFF = 66560, VST_OFF = 68608, VST_BYTES = 4096, ATT_LDS_END = VST_OFF + NWAVES * VST_BYTES;
static_assert(ATT_LDS_END <= LDSCTL_OFF, "attention LDS");
__device__ __forceinline__ int crow(int r, int hi) { return (r & 3) + 8 * (r >> 2) + 4 * hi; }

template <int NQ>
__device__ __forceinline__ void item(const bf16* Qb, const bf16* Kb, const bf16* Vb, int tq0, int d, int pat, int toff, LAS unsigned char* lds, int wave, int lane) {
    const int c = lane & 31, hi = lane >> 5;
    LAS unsigned char* vst = lds + VST_OFF + wave * VST_BYTES;
    const LAS float* lut = (const LAS float*)(lds + LUT_OFF) + pat * 129;
    bf16x8 qf[4];
    { const bf16* qp = Qb + (size_t)(tq0 + (NQ == 32 ? c : (c & 15)) * d) * DM + 8 * hi;
#pragma unroll
      for (int ks = 0; ks < 4; ++ks) qf[ks] = *(const bf16x8*)(qp + 16 * ks); }
    f32x16 o0 = {}, o1 = {};
    float lsum = 0.f;
    const int vtr = ((lane >> 4) & 1) * 32 + (lane & 3) * 8 + (4 * hi + ((lane & 15) >> 2)) * 64;
    bf16x8 kf[4], vr[4];
#define ATT_LOAD_TILE(KT) do { \
        { int tk_ = tq0 + (-128 + 32 * (KT) + c) * d; tk_ = tk_ < 0 ? 0 : tk_; const bf16* kp_ = Kb + (size_t)tk_ * DM + 8 * hi; \
          _Pragma("unroll") for (int ks = 0; ks < 4; ++ks) kf[ks] = *(const bf16x8*)(kp_ + 16 * ks); } \
        _Pragma("unroll") for (int pc = 0; pc < 4; ++pc) { int tk_ = tq0 + (-128 + 32 * (KT) + 16 * (pc & 1) + (lane >> 2)) * d; tk_ = tk_ < 0 ? 0 : tk_; \
            vr[pc] = *(const bf16x8*)(Vb + (size_t)tk_ * DM + 32 * (pc >> 1) + 8 * (lane & 3)); } } while (0)
    ATT_LOAD_TILE(0);
#pragma unroll 1
    for (int kt = 0; kt < 5; ++kt) {
        f32x16 st = {};
#pragma unroll
        for (int ks = 0; ks < 4; ++ks) st = __builtin_amdgcn_mfma_f32_32x32x16_bf16(kf[ks], qf[ks], st, 0, 0, 0);
#pragma unroll
        for (int pc = 0; pc < 4; ++pc) *(LAS bf16x8*)(vst + pc * 1024 + lane * 16) = vr[pc];
        if (kt < 4) ATT_LOAD_TILE(kt + 1);
        const int relb = c + 128 - 32 * kt - 4 * hi, tkb = tq0 + (-128 + 32 * kt + 4 * hi) * d;
#pragma unroll
        for (int r = 0; r < 16; ++r) {
            const int kk = (r & 3) + 8 * (r >> 2), rel = relb - kk;
            const bool valid = (rel >= 0) && (rel <= 128) && (tkb + kk * d >= 0);
            const float bias = lut[valid ? rel : 0];
            const float p = valid ? __builtin_amdgcn_exp2f(st[r] + bias) : 0.f;
            st[r] = p; lsum += p;
        }
        u32x4 pw0, pw1;
        pw0.x = pg8::cvt_pk_bf16(st[0], st[1]); pw0.y = pg8::cvt_pk_bf16(st[2], st[3]); pw0.z = pg8::cvt_pk_bf16(st[4], st[5]); pw0.w = pg8::cvt_pk_bf16(st[6], st[7]);
        pw1.x = pg8::cvt_pk_bf16(st[8], st[9]); pw1.y = pg8::cvt_pk_bf16(st[10], st[11]); pw1.z = pg8::cvt_pk_bf16(st[12], st[13]); pw1.w = pg8::cvt_pk_bf16(st[14], st[15]);
        const bf16x8 pa0 = __builtin_bit_cast(bf16x8, pw0), pa1 = __builtin_bit_cast(bf16x8, pw1);
#pragma unroll
        for (int dh = 0; dh < 2; ++dh)
#pragma unroll
            for (int s = 0; s < 2; ++s) {
                const LAS unsigned char* vp = vst + (dh * 2 + s) * 1024 + vtr;
                const v4i16_t lo = __builtin_amdgcn_ds_read_tr16_b64_v4i16((LAS v4i16_t*)vp), hh = __builtin_amdgcn_ds_read_tr16_b64_v4i16((LAS v4i16_t*)(vp + 512));
                const bf16x8 vb = (bf16x8){lo[0], lo[1], lo[2], lo[3], hh[0], hh[1], hh[2], hh[3]};
                if (dh == 0) o0 = __builtin_amdgcn_mfma_f32_32x32x16_bf16(s == 0 ? pa0 : pa1, vb, o0, 0, 0, 0);
                else         o1 = __builtin_amdgcn_mfma_f32_32x32x16_bf16(s == 0 ? pa0 : pa1, vb, o1, 0, 0, 0);
            }
    }
    lsum += __shfl_xor(lsum, 32);
    LAS float* oacc = (LAS float*)(lds + OACC_OFF); LAS float* lacc = (LAS float*)(lds + LACC_OFF);
    if (hi == 0 && c < NQ) __hip_atomic_fetch_add(lacc + toff + c * d, lsum, __ATOMIC_RELAXED, __HIP_MEMORY_SCOPE_WORKGROUP);
#pragma unroll
    for (int r = 0; r < (NQ == 32 ? 16 : 8); ++r) {
        const int q = crow(r, hi); LAS float* row = oacc + (toff + q * d) * 64 + c;
        __hip_atomic_fetch_add(row, o0[r], __ATOMIC_RELAXED, __HIP_MEMORY_SCOPE_WORKGROUP);
        __hip_atomic_fetch_add(row + 32, o1[r], __ATOMIC_RELAXED, __HIP_MEMORY_SCOPE_WORKGROUP);
    }
}

__device__ __forceinline__ void unit(Frame& F, int uidx) {
    const int span = uidx % NSPAN, bh = uidx / NSPAN, h = bh % NH, b = bh / NH, t0 = span * SPAN;
    LAS unsigned char* lds = F.lds;
    LAS float* oacc = (LAS float*)(lds + OACC_OFF); LAS float* lacc = (LAS float*)(lds + LACC_OFF); LAS float* lut = (LAS float*)(lds + LUT_OFF);
    for (int i = F.tid; i < (SPAN * 64 + SPAN) / 4; i += NWAVES * 64) ((LAS f32x4*)oacc)[i] = (f32x4){0.f, 0.f, 0.f, 0.f};
    if (F.tid < 387) { const int pat = F.tid / 129, rel = F.tid - pat * 129, d = pat == 0 ? 1 : (pat == 1 ? 4 : 16); lut[F.tid] = F.I.rel_bias[t5_bucket(rel * d) * NH + h] * LOG2E; }
    __syncthreads();
    const size_t boff = (size_t)b * SEQ * DM + h * HD;
    const bf16 *Qb = F.Q + boff, *Kb = F.K + boff, *Vb = F.V + boff;
    const int w = F.wave;
    item<32>(Qb, Kb, Vb, t0 + 32 * w, 1, 0, 32 * w, lds, w, F.lane);
    __builtin_amdgcn_sched_barrier(0);
    item<32>(Qb, Kb, Vb, t0 + (w & 3) + 128 * (w >> 2), 4, 1, (w & 3) + 128 * (w >> 2), lds, w, F.lane);
    __builtin_amdgcn_sched_barrier(0);
    item<16>(Qb, Kb, Vb, t0 + w, 16, 2, w, lds, w, F.lane);
    __builtin_amdgcn_sched_barrier(0);
    item<16>(Qb, Kb, Vb, t0 + w + 8, 16, 2, w + 8, lds, w, F.lane);
    __syncthreads();
    bf16* ap = F.AU + ((size_t)b * SEQ + t0 + 32 * w) * 2048 + 1024 + h * HD + F.lane;
#pragma unroll 4
    for (int i = 0; i < 32; ++i) {
        const float o = oacc[(32 * w + i) * 64 + F.lane], l = lacc[32 * w + i];
        bf16* gp = ap + (size_t)i * 2048;
        *gp = (bf16)f2bf(o * __builtin_amdgcn_rcpf(l) * bf2f(*gp));
    }
    __syncthreads();
}

__device__ __forceinline__ void phase(Frame& F) {
    const unsigned x = xb_xcc_id() & 7u;
    constexpr int PER_Q = NUNITS / 8;
    for (unsigned k = 0; k < 8; ++k) {
        const unsigned qx = (x + k) & 7u;
        for (;;) {
            if (F.tid == 0) F.MISC[16] = __hip_atomic_fetch_add(F.ctl + CW_Q + 64 * qx, 1u, RLX_AGENT);
            __syncthreads();
            const unsigned idx = F.MISC[16];
            __syncthreads();
            if (idx >= (unsigned)PER_Q) break;
            unit(F, (int)(qx * PER_Q + idx));
        }
    }
}
}

struct Args { Ins in; float* out; unsigned char* ws; int ph_lo, ph_hi; };
__global__ void __launch_bounds__(NWAVES * 64, 2) mk_fwd(Args args) {
    extern __shared__ __attribute__((aligned(16))) unsigned char lds[];
    Frame F;
    F.lds = (LAS unsigned char*)lds;
    F.MISC = (volatile LAS unsigned*)(F.lds + MISC_OFF);
    F.tid = threadIdx.x; F.lane = F.tid & 63; F.wave = __builtin_amdgcn_readfirstlane(F.tid >> 6);
    F.G = gridDim.x; { const int bx = blockIdx.x; F.vcu = (F.G % 8 == 0) ? (bx % 8) * (F.G / 8) + bx / 8 : bx; }
    unsigned char* ws = args.ws;
    F.ctl = (gu32*)(ws + WS_CTL); F.I = args.in; F.out = args.out;
    F.WinT = (bf16*)(ws + WS_WIN); F.WoutT = (bf16*)(ws + WS_WOUT); F.XN = (bf16*)(ws + WS_XN); F.Q = (bf16*)(ws + WS_Q); F.K = (bf16*)(ws + WS_K); F.V = (bf16*)(ws + WS_V);
    F.AU = (bf16*)(ws + WS_AU); F.XBC = (bf16*)(ws + WS_XBC); F.DT = (float*)(ws + WS_DT); F.SSQ = (float*)(ws + WS_SSQ);
    for (int u = F.tid; u < (LDS_BYTES - LDSCTL_OFF) / 4; u += NWAVES * 64) ((LAS unsigned*)(F.lds + LDSCTL_OFF))[u] = 0u;
    __syncthreads();
    XcdBarrier bar = xcd_barrier_post((unsigned*)(F.ctl + CW_BAR), F.MISC + 8);
    const int lo = args.ph_lo, hi = args.ph_hi;
#define IN(k) (lo <= (k) && (k) < hi)
#define BOTH(k) (IN(k) && IN((k) + 1))
    if (IN(0)) { p0_prologue(F); if (BOTH(0)) xcd_barrier(bar); }
    if (IN(1)) {
        __syncthreads();
        pg8::Gemm g{F.XN, F.WinT, MROWS, NMAIN, DM}; pg8::StaticOrder S; S.init(MROWS, NMAIN, F.G, (int)blockIdx.x);
        pg8::EpiIn E{F.Q, F.K, F.V, F.AU, F.XBC, F.out, F.I.qnw, F.I.knw};
        pg8::gemm_phase<pg8::EpiIn, pg8::StaticOrder, true, true>(F.lds + RING_OFF, g, S, E);
        if (BOTH(1)) xcd_barrier(bar);
    }
    if (IN(2)) { __syncthreads(); att::phase(F); if (BOTH(2)) xcd_barrier(bar); }
    if (IN(3)) {
        __syncthreads();
        pg8::Gemm g{F.AU, F.WoutT, MROWS, DM, 2048}; pg8::StaticOrder S; S.init(MROWS, DM, F.G, (int)blockIdx.x);
        LAS float* rs = (LAS float*)(F.lds + RING_BYTES);
        { pg8::Unit u;
          for (int ui = 0; ui < 4 && S.next(ui, u); ++ui)
              for (int r = F.tid; r < 256; r += NWAVES * 64) {
                  const f32x4* sp = (const f32x4*)(F.SSQ + (size_t)(u.pm * 256 + r) * 16);
                  const f32x4 s0 = sp[0], s1 = sp[1], s2 = sp[2], s3 = sp[3];
                  const float s = ((s0[0] + s0[1]) + (s0[2] + s0[3])) + ((s1[0] + s1[1]) + (s1[2] + s1[3])) + ((s2[0] + s2[1]) + (s2[2] + s2[3])) + ((s3[0] + s3[1]) + (s3[2] + s3[3]));
                  rs[ui * 256 + r] = rsqrtf(s * (1.f / 1024.f) + EPS);
              }
          __syncthreads(); }
        pg8::EpiOut E{F.I.xp, F.I.xs, rs, F.out};
        pg8::gemm_phase<pg8::EpiOut, pg8::StaticOrder, true, true>(F.lds + RING_OFF, g, S, E);
    }
#undef IN
#undef BOTH
}

namespace hyb {
struct Bufs { const bf16 *Q, *K, *V, *XBC; bf16* AU; const float* DT; float* SSQ; };

__global__ void __launch_bounds__(256) k_attn(Ins I, Bufs B, int row_lo) {
    __shared__ float qs[4][64];
    __shared__ float ps[4][388];
    const int wl = threadIdx.x >> 6, lane = threadIdx.x & 63;
    const int w = blockIdx.x * 4 + wl;
    const int r = row_lo + (w >> 4), h = w & 15;
    if (r >= NROWS) return;
    const bool samp = r >= NTOK;
    const int b = samp ? r - NTOK : r / SEQ, t = samp ? 0 : r % SEQ;
    qs[wl][lane] = bf2f(B.Q[(size_t)r * DM + h * HD + lane]);
    __builtin_amdgcn_wave_barrier();
    float sc[7]; float mx = -INFINITY;
#pragma unroll
    for (int it = 0; it < 7; ++it) {
        const int idx = it * 64 + lane; sc[it] = -INFINITY;
        if (idx < 387) {
            const int pat = idx / 129, j = idx - pat * 129, d = pat == 0 ? 1 : (pat == 1 ? 4 : 16);
            float s = 0.f; bool valid = true;
            if (samp && j > 0) { const float* kp = I.ck + (((size_t)b * WIN + (WIN - j * d)) * NH + h) * HD; for (int e = 0; e < 64; ++e) s += qs[wl][e] * kp[e]; }
            else { const int kt = t - j * d; valid = kt >= 0; const bf16* kp = B.K + (size_t)(samp ? r : b * SEQ + (valid ? kt : 0)) * DM + h * HD; for (int e = 0; e < 64; ++e) s += qs[wl][e] * bf2f(kp[e]); }
            s += I.rel_bias[t5_bucket(j * d) * NH + h] * LOG2E;
            if (valid) sc[it] = s;
        }
        mx = fmaxf(mx, sc[it]);
    }
    mx = wave_max(mx);
    float sum = 0.f;
#pragma unroll
    for (int it = 0; it < 7; ++it) { const int idx = it * 64 + lane; const float p = (sc[it] == -INFINITY) ? 0.f : exp2f(sc[it] - mx); if (idx < 387) ps[wl][idx] = p; sum += p; }
    sum = wave_sum(sum);
    __builtin_amdgcn_wave_barrier();
    float o = 0.f;
    for (int idx = 0; idx < 387; ++idx) {
        const float p = ps[wl][idx];
        if (p != 0.f) {
            const int pat = idx / 129, j = idx - pat * 129, d = pat == 0 ? 1 : (pat == 1 ? 4 : 16);
            if (samp && j > 0) o += p * I.cv[(((size_t)b * WIN + (WIN - j * d)) * NH + h) * HD + lane];
            else o += p * bf2f(B.V[(size_t)(samp ? r : b * SEQ + t - j * d) * DM + h * HD + lane]);
        }
    }
    o /= sum;
    bf16* gp = B.AU + (size_t)r * 2048 + 1024 + h * HD + lane;
    *gp = (bf16)f2bf(o * bf2f(*gp));
}

__global__ void __launch_bounds__(512) k_ssd(Ins I, Bufs B, float* out) {
    constexpr int TB = 8;
    __shared__ float xs_l[TB][64], B_l[TB][128], C_l[TB][128], dt_l[TB], ssq_l[TB];
    const int tid = threadIdx.x, p = tid >> 3, ng = tid & 7;
    const int bh = blockIdx.x; const bool samp = bh >= NB * NH;
    const int b = samp ? (bh - NB * NH) / NH : bh / NH, hd = bh % NH, grp = hd >> 3;
    const int nsteps = samp ? 1 : SEQ;
    const size_t row0 = samp ? (size_t)NTOK + b : (size_t)b * SEQ;
    float h[16];
#pragma unroll
    for (int i = 0; i < 16; ++i) h[i] = samp ? I.sssm[(((size_t)b * NH + hd) * HD + p) * DS + ng * 16 + i] : 0.f;
    const float A = -__expf(I.a_log[hd]), dsk = I.d_skip[hd];
    auto xbc_at = [&](int t, int c) -> float {
        if (t >= 0) return bf2f(B.XBC[(row0 + t) * CONVD + c]);
        if (!samp) return 0.f;
        return I.sconv[((size_t)b * 3 + (3 + t)) * CONVD + c];
    };
    for (int t0 = 0; t0 < nsteps; t0 += TB) {
        const int nb = nsteps - t0 < TB ? nsteps - t0 : TB;
        for (int e = tid; e < nb * 320; e += 512) {
            const int s = e / 320, ci = e % 320;
            const int c = ci < 64 ? hd * 64 + ci : (ci < 192 ? 1024 + grp * 128 + (ci - 64) : 1280 + grp * 128 + (ci - 192));
            const int t = t0 + s;
            float v = I.conv_b[c];
#pragma unroll
            for (int i = 0; i < 4; ++i) v += xbc_at(t + i - 3, c) * I.conv_w[i * CONVD + c];
            v = silu_f(v);
            if (ci < 64) xs_l[s][ci] = v; else if (ci < 192) B_l[s][ci - 64] = v; else C_l[s][ci - 192] = v;
        }
        if (tid < nb) { dt_l[tid] = B.DT[(row0 + t0 + tid) * 16 + hd]; ssq_l[tid] = 0.f; }
        __syncthreads();
        for (int s = 0; s < nb; ++s) {
            const float dt = dt_l[s], x = xs_l[s][p], dec = __expf(dt * A), xdt = x * dt;
            float y = 0.f;
#pragma unroll
            for (int i = 0; i < 16; ++i) { h[i] = h[i] * dec + xdt * B_l[s][ng * 16 + i]; y += h[i] * C_l[s][ng * 16 + i]; }
            y += __shfl_xor(y, 1); y += __shfl_xor(y, 2); y += __shfl_xor(y, 4);
            if (ng == 0) {
                bf16* zp = B.AU + (row0 + t0 + s) * 2048 + hd * 64 + p;
                const float u = (y + dsk * x) * bf2f(*zp);
                *zp = (bf16)f2bf(u);
                atomicAdd(&ssq_l[s], u * u);
            }
        }
        __syncthreads();
        if (tid < nb) B.SSQ[(row0 + t0 + tid) * 16 + hd] = ssq_l[tid];
        __syncthreads();
    }
    float* hout = out + (samp ? O_HS : O_HP) + (((size_t)b * NH + hd) * HD + p) * DS + ng * 16;
#pragma unroll
    for (int i = 0; i < 16; ++i) hout[i] = h[i];
}

template <class LoadA, class LoadB, class Epi>
__device__ __forceinline__ void gemm_tile(int M, int N, int K, int bm, int bn, LoadA la, LoadB lb, Epi epi) {
    __shared__ float As[16][128 + 4];
    __shared__ float Bs[16][128 + 4];
    const int tid = threadIdx.x, tx = tid & 15, ty = tid >> 4;
    float acc[8][8];
#pragma unroll
    for (int i = 0; i < 8; ++i)
#pragma unroll
        for (int j = 0; j < 8; ++j) acc[i][j] = 0.f;
    for (int k0 = 0; k0 < K; k0 += 16) {
#pragma unroll
        for (int e = 0; e < 8; ++e) { const int idx = tid + e * 256, r = idx >> 4, k = idx & 15; const int gr = bm + r; As[k][r] = gr < M ? la(gr, k0 + k) : 0.f; }
#pragma unroll
        for (int e = 0; e < 8; ++e) { const int idx = tid + e * 256, k = idx >> 7, c = idx & 127; const int gc = bn + c; Bs[k][c] = gc < N ? lb(k0 + k, gc) : 0.f; }
        __syncthreads();
#pragma unroll
        for (int k = 0; k < 16; ++k) {
            float a[8], b[8];
#pragma unroll
            for (int i = 0; i < 8; ++i) a[i] = As[k][ty * 8 + i];
#pragma unroll
            for (int j = 0; j < 8; ++j) b[j] = Bs[k][tx + 16 * j];
#pragma unroll
            for (int i = 0; i < 8; ++i)
#pragma unroll
                for (int j = 0; j < 8; ++j) acc[i][j] += a[i] * b[j];
        }
        __syncthreads();
    }
#pragma unroll
    for (int i = 0; i < 8; ++i)
#pragma unroll
        for (int j = 0; j < 8; ++j) { const int gr = bm + ty * 8 + i, gc = bn + tx + 16 * j; if (gr < M && gc < N) epi(gr, gc, acc[i][j]); }
}
__global__ void __launch_bounds__(256) k_outproj(Ins I, Bufs B, float* out) {
    const int bn = blockIdx.x * 128, bm = blockIdx.y * 128;
    gemm_tile(NROWS, DM, 2048, bm, bn,
        [&](int r, int k) { if (k < 1024) return bf2f(B.AU[(size_t)r * 2048 + 1024 + k]);
                            float s = 0.f; for (int i = 0; i < 16; ++i) s += B.SSQ[(size_t)r * 16 + i];
                            return bf2f(B.AU[(size_t)r * 2048 + (k - 1024)]) * rsqrtf(s * (1.f / 1024.f) + EPS) * I.ssd_norm_w[k - 1024]; },
        [&](int k, int c) { return I.w_out[(size_t)k * DM + c]; },
        [&](int r, int c, float v) { const float y = xrow(I, r)[c] + v; if (r < NTOK) out[O_YP + (size_t)r * DM + c] = y; else out[O_YS + (size_t)(r - NTOK) * DM + c] = y; });
}
}

extern "C" void kernel_launch(void* const* d_in, const int* in_sizes, int n_in, void* d_out, int out_size, void* d_ws, size_t ws_size, hipStream_t stream) {
    static int grid = 0;
    if (grid == 0) {
        if (n_in != 18 || out_size != (int)O_END || ws_size < WS_END) { fprintf(stderr, "kernel_launch: unexpected n_in %d / out_size %d / ws_size %zu; nothing launched\n", n_in, out_size, ws_size); grid = -1; return; }
        int dev = 0, cus = 0;
        if (hipGetDevice(&dev) != hipSuccess || hipDeviceGetAttribute(&cus, hipDeviceAttributeMultiprocessorCount, dev) != hipSuccess) { grid = -1; return; }
        if (hipFuncSetAttribute((const void*)mk_fwd, hipFuncAttributeMaxDynamicSharedMemorySize, LDS_BYTES) != hipSuccess) { fprintf(stderr, "kernel_launch: hipFuncSetAttribute failed\n"); grid = -1; return; }
        (void)hipGetLastError();
        grid = cus;
    }
    if (grid < 0) return;
    (void)hipMemsetAsync((char*)d_ws + WS_CTL, 0, CTL_ZERO_BYTES, stream);
    Args a{};
    const float** ip = (const float**)&a.in;
    for (int i = 0; i < 18; ++i) ip[i] = (const float*)d_in[i];
    a.out = (float*)d_out; a.ws = (unsigned char*)d_ws;
    unsigned char* ws = (unsigned char*)d_ws;
    hyb::Bufs B{(const bf16*)(ws + WS_Q), (const bf16*)(ws + WS_K), (const bf16*)(ws + WS_V), (const bf16*)(ws + WS_XBC), (bf16*)(ws + WS_AU), (const float*)(ws + WS_DT), (float*)(ws + WS_SSQ)};
    a.ph_lo = 0; a.ph_hi = 3;
    hipLaunchKernelGGL(mk_fwd, dim3(grid), dim3(NWAVES * 64), LDS_BYTES, stream, a);
    hyb::k_attn<<<(DB * NH + 3) / 4, 256, 0, stream>>>(a.in, B, NTOK);
    hyb::k_ssd<<<NB * NH + DB * NH, 512, 0, stream>>>(a.in, B, (float*)d_out);
#if defined(HYB_OUTPROJ)
    hyb::k_outproj<<<dim3(DM / 128, (NROWS + 127) / 128), 256, 0, stream>>>(a.in, B, (float*)d_out);
#else
    a.ph_lo = 3; a.ph_hi = 4;
    hipLaunchKernelGGL(mk_fwd, dim3(grid), dim3(NWAVES * 64), LDS_BYTES, stream, a);
#endif
}
```

```cpp
#include <hip/hip_runtime.h>
#include <cstdio>
#include <cstdint>

constexpr int DM = 1024, NB = 4, SEQ = 8192, DB = 32, WIN = 2048;
constexpr int NPROJ = 6672, NMAIN = 6656, NTOK = NB * SEQ, NROWS = NTOK + DB;
constexpr int MROWS = 33024;
constexpr int C_Q = 0, C_K = 1024, C_V = 2048, C_G = 3072, C_Z = 4096, C_XBC = 5120, C_DT = 6656;
constexpr int CONVD = 1536, NH = 16, HD = 64, DS = 128;
constexpr float EPS = 1e-6f;
constexpr float QSCALE = 0.125f * 1.4426950408889634f;
constexpr float LOG2E = 1.4426950408889634f;
constexpr size_t O_YP = 0, O_YS = O_YP + (size_t)NTOK * DM, O_KP = O_YS + (size_t)DB * DM, O_VP = O_KP + (size_t)NB * WIN * DM,
                 O_CP = O_VP + (size_t)NB * WIN * DM, O_HP = O_CP + (size_t)NB * 3 * CONVD, O_KS = O_HP + (size_t)NB * NH * HD * DS,
                 O_VS = O_KS + (size_t)DB * DM, O_CS = O_VS + (size_t)DB * DM, O_HS = O_CS + (size_t)DB * 3 * CONVD,
                 O_END = O_HS + (size_t)DB * NH * HD * DS;
static_assert(O_END == 55314432, "output size");

constexpr size_t MiB = 1u << 20;
constexpr size_t WS_CTL = 0, CTL_ZERO_BYTES = 1 * MiB;
constexpr size_t WS_WIN = 2 * MiB;
constexpr size_t WS_WOUT = 16 * MiB;
constexpr size_t WS_DT = 20 * MiB;
constexpr size_t WS_SSQ = 24 * MiB;
constexpr size_t WS_XN = 32 * MiB;
constexpr size_t WS_Q = 100 * MiB;
constexpr size_t WS_K = 168 * MiB;
constexpr size_t WS_V = 236 * MiB;
constexpr size_t WS_AU = 304 * MiB;
constexpr size_t WS_XBC = 436 * MiB;
constexpr size_t WS_END = 536 * MiB;
static_assert(WS_XN + (size_t)MROWS * DM * 2 <= WS_Q && WS_Q + (size_t)MROWS * DM * 2 <= WS_K && WS_K + (size_t)MROWS * DM * 2 <= WS_V && WS_V + (size_t)MROWS * DM * 2 <= WS_AU &&
              WS_AU + (size_t)MROWS * 2048 * 2 <= WS_XBC && WS_XBC + (size_t)MROWS * CONVD * 2 <= WS_END && WS_WIN + (size_t)NMAIN * DM * 2 <= WS_WOUT && WS_WOUT + (size_t)DM * 2048 * 2 <= WS_DT &&
              WS_DT + (size_t)MROWS * 16 * 4 <= WS_SSQ && WS_SSQ + (size_t)MROWS * 16 * 4 <= WS_XN, "d_ws map");

struct Ins {
    const float *xp, *xs, *ck, *cv, *sconv, *sssm, *norm_w, *w_in, *qnw, *knw, *rel_bias, *conv_w, *conv_b, *dt_bias, *a_log, *d_skip, *ssd_norm_w, *w_out;
};

typedef unsigned short bf16;
__device__ __forceinline__ float wave_sum(float v) {
#pragma unroll
    for (int o = 1; o < 64; o <<= 1) v += __shfl_xor(v, o);
    return v;
}
__device__ __forceinline__ float wave_max(float v) {
#pragma unroll
    for (int o = 1; o < 64; o <<= 1) v = fmaxf(v, __shfl_xor(v, o));
    return v;
}
__device__ __forceinline__ float silu_f(float x) { return x / (1.f + __expf(-x)); }
__device__ __forceinline__ float silu_fast(float x) { return x * __builtin_amdgcn_rcpf(1.f + __builtin_amdgcn_exp2f(-LOG2E * x)); }
__device__ __forceinline__ float softplus_f(float x) { return x > 20.f ? x : log1pf(__expf(x)); }
__device__ __forceinline__ int t5_bucket(int d) {
    if (d < 16) return d;
    int b = 16;
    b += d >= 22; b += d >= 30; b += d >= 40; b += d >= 54; b += d >= 73; b += d >= 99; b += d >= 134; b += d >= 182;
    b += d >= 246; b += d >= 332; b += d >= 450; b += d >= 609; b += d >= 825; b += d >= 1117; b += d >= 1513;
    return b;
}
__device__ __forceinline__ const float* xrow(const Ins& I, int r) { return r < NTOK ? I.xp + (size_t)r * DM : I.xs + (size_t)(r - NTOK) * DM; }
__device__ __forceinline__ float bf2f(bf16 v) { return __uint_as_float((unsigned)v << 16); }
__device__ __forceinline__ unsigned f2bf(float f) { unsigned u = __float_as_uint(f); return (u + 0x7fffu + ((u >> 16) & 1u)) >> 16; }
__device__ __forceinline__ unsigned pk2(float lo, float hi) { return f2bf(lo) | (f2bf(hi) << 16); }
__host__ __device__ __forceinline__ int vrow_of_col(int a) { return 128 * ((a >> 5) & 1) + 32 * ((a >> 6) & 3) + (a & 31); }

namespace pg8 {
#define PG8_LAS __attribute__((address_space(3)))
typedef unsigned short bf16_t;
typedef short bf16x8 __attribute__((ext_vector_type(8)));
typedef float f32x4 __attribute__((ext_vector_type(4)));
typedef unsigned u32x4 __attribute__((ext_vector_type(4)));
constexpr int BM = 256, BK = 64, HALF = 128, HTB = HALF * BK * 2  , STAGE_BYTES = 8 * HTB, NXCD = 8, WGM = 8;

__host__ __device__ __forceinline__ int lds_byte(int r, int c) { const int st = (r >> 4) * 2 + (c >> 5), rr = r & 15, cc = c & 31, ob = rr * 64 + cc * 2; return st * 1024 + (ob ^ (((ob >> 9) & 1) << 5)); }
__host__ __device__ __forceinline__ void stage_rc(int b, int& R, int& C) { const int st = b / 1024, sb = b % 1024, swz = sb ^ (((sb >> 9) & 1) << 5); R = (st >> 1) * 16 + swz / 64; C = (st & 1) * 32 + (swz % 64) / 2; }
__host__ __device__ __forceinline__ int perm32(int rho) { const int n = rho >> 4, i = rho & 15; return 8 * (i >> 2) + 4 * n + (i & 3); }

struct Unit { int pm, pn; };
struct Gemm { const bf16_t* A; const bf16_t* Bt; int M, N, K; };

struct StaticOrder {
    int nM, nN, nwg, G, c;
    __host__ __device__ void init(int M, int N, int G_, int c_) { nM = M / BM; nN = N / BM; nwg = nM * nN; G = G_; c = c_; }
    __host__ __device__ bool next(int i, Unit& u) const {
        const long L = (long)i * G + c; if (L >= nwg) return false;
        int wgid = (int)L; { const int q = nwg / NXCD, r = nwg % NXCD, xcd = wgid % NXCD, off = wgid / NXCD; wgid = (xcd < r ? xcd * (q + 1) : r * (q + 1) + (xcd - r) * q) + off; }
        const int nig = WGM * nN, gid = wgid / nig, fm = gid * WGM, gsz = (nM - fm) < WGM ? (nM - fm) : WGM;
        u.pm = fm + ((wgid % nig) % gsz); u.pn = (wgid % nig) / gsz; return true;
    }
    __device__ __forceinline__ void a_ready(const Unit&) const {}
    __device__ __forceinline__ void done(const Unit&) const {}
};

__device__ __forceinline__ unsigned cvt_pk_bf16(float lo, float hi) { unsigned r; asm volatile("v_cvt_pk_bf16_f32 %0, %1, %2" : "=v"(r) : "v"(lo), "v"(hi)); return r; }

struct EpiIn {
    static constexpr bool PERM = true, AFTER_DRAIN = false, MIDK = false;
    bf16_t *Q, *K, *V, *AU, *XBC; float* out; const float *qnw, *knw;
    __device__ __forceinline__ void mid(f32x4 (&)[2][2][4][2], const Unit&, int, int, int, int, int) const {}
    __device__ __forceinline__ void operator()(const f32x4 (&acc)[2][2][4][2], const Unit& u, int wr, int wc, int fr, int fq) const {
        const int pn = u.pn;
        const int rowb = u.pm * BM + wr * 64 + fr;
        const int cl = wc * 64 + 8 * fq;
        if (pn < 8) {
            const bool isq = pn < 4; const float* nw = isq ? qnw : knw;
            f32x4 w[2][2];
#pragma unroll
            for (int bj = 0; bj < 2; ++bj)
#pragma unroll
                for (int n = 0; n < 2; ++n) w[bj][n] = *(const f32x4*)(nw + 8 * fq + 32 * bj + 4 * n);
            bf16_t* dstb = (isq ? Q : K) + (pn & 3) * 256 + cl;
#pragma unroll
            for (int ai = 0; ai < 2; ++ai)
#pragma unroll
                for (int m = 0; m < 4; ++m) {
                    const int r = rowb + ai * HALF + m * 16;
                    float ss = 0.f;
#pragma unroll
                    for (int bj = 0; bj < 2; ++bj)
#pragma unroll
                        for (int n = 0; n < 2; ++n) { const f32x4 v = acc[ai][bj][m][n]; ss += (v[0] * v[0] + v[1] * v[1]) + (v[2] * v[2] + v[3] * v[3]); }
                    ss += __shfl_xor(ss, 16); ss += __shfl_xor(ss, 32);
                    const float sc = rsqrtf(ss * (1.f / 64.f) + EPS), scs = isq ? sc * QSCALE : sc;
                    float* f32dst = nullptr;
                    if (!isq) { if (r < NTOK) { const int t = r & (SEQ - 1); if (t >= SEQ - WIN) f32dst = out + O_KP + ((size_t)((r >> 13) * WIN + t - (SEQ - WIN))) * DM + (pn & 3) * 256 + cl; }
                                else if (r < NROWS) f32dst = out + O_KS + (size_t)(r - NTOK) * DM + (pn & 3) * 256 + cl; }
#pragma unroll
                    for (int bj = 0; bj < 2; ++bj) {
                        const f32x4 a0 = acc[ai][bj][m][0] * w[bj][0], a1 = acc[ai][bj][m][1] * w[bj][1];
                        u32x4 o; o.x = cvt_pk_bf16(a0[0] * scs, a0[1] * scs); o.y = cvt_pk_bf16(a0[2] * scs, a0[3] * scs); o.z = cvt_pk_bf16(a1[0] * scs, a1[1] * scs); o.w = cvt_pk_bf16(a1[2] * scs, a1[3] * scs);
                        *(u32x4*)(dstb + (size_t)r * DM + 32 * bj) = o;
                        if (f32dst) { *(f32x4*)(f32dst + 32 * bj) = a0 * sc; *(f32x4*)(f32dst + 32 * bj + 4) = a1 * sc; }
                    }
                }
        } else if (pn < 12) {
            bf16_t* dstb = V + (pn & 3) * 256 + cl;
#pragma unroll
            for (int ai = 0; ai < 2; ++ai)
#pragma unroll
                for (int m = 0; m < 4; ++m) {
                    const int r = rowb + ai * HALF + m * 16;
                    float* f32dst = nullptr;
                    if (r < NTOK) { const int t = r & (SEQ - 1); if (t >= SEQ - WIN) f32dst = out + O_VP + ((size_t)((r >> 13) * WIN + t - (SEQ - WIN))) * DM + (pn & 3) * 256 + cl; }
                    else if (r < NROWS) f32dst = out + O_VS + (size_t)(r - NTOK) * DM + (pn & 3) * 256 + cl;
#pragma unroll
                    for (int bj = 0; bj < 2; ++bj) {
                        const f32x4 a0 = acc[ai][bj][m][0], a1 = acc[ai][bj][m][1];
                        u32x4 o; o.x = cvt_pk_bf16(a0[0], a0[1]); o.y = cvt_pk_bf16(a0[2], a0[3]); o.z = cvt_pk_bf16(a1[0], a1[1]); o.w = cvt_pk_bf16(a1[2], a1[3]);
                        *(u32x4*)(dstb + (size_t)r * DM + 32 * bj) = o;
                        if (f32dst) { *(f32x4*)(f32dst + 32 * bj) = a0; *(f32x4*)(f32dst + 32 * bj + 4) = a1; }
                    }
                }
        } else if (pn < 20) {
            bf16_t* dstb = AU + (pn < 16 ? 1024 : 0) + (pn & 3) * 256 + cl;
#pragma unroll
            for (int ai = 0; ai < 2; ++ai)
#pragma unroll
                for (int m = 0; m < 4; ++m) {
                    const int r = rowb + ai * HALF + m * 16;
#pragma unroll
                    for (int bj = 0; bj < 2; ++bj) {
                        f32x4 a0 = acc[ai][bj][m][0], a1 = acc[ai][bj][m][1];
#pragma unroll
                        for (int i = 0; i < 4; ++i) { a0[i] = silu_fast(a0[i]); a1[i] = silu_fast(a1[i]); }
                        u32x4 o; o.x = cvt_pk_bf16(a0[0], a0[1]); o.y = cvt_pk_bf16(a0[2], a0[3]); o.z = cvt_pk_bf16(a1[0], a1[1]); o.w = cvt_pk_bf16(a1[2], a1[3]);
                        *(u32x4*)(dstb + (size_t)r * 2048 + 32 * bj) = o;
                    }
                }
        } else {
            const int cb = (pn - 20) * 256 + cl;
            bf16_t* dstb = XBC + cb;
#pragma unroll
            for (int ai = 0; ai < 2; ++ai)
#pragma unroll
                for (int m = 0; m < 4; ++m) {
                    const int r = rowb + ai * HALF + m * 16;
                    float* f32dst = nullptr;
                    if (r < NTOK) { const int t = r & (SEQ - 1); if (t >= SEQ - 3) f32dst = out + O_CP + ((size_t)((r >> 13) * 3 + t - (SEQ - 3))) * CONVD + cb; }
                    else if (r < NROWS) f32dst = out + O_CS + ((size_t)(r - NTOK) * 3 + 2) * CONVD + cb;
#pragma unroll
                    for (int bj = 0; bj < 2; ++bj) {
                        const f32x4 a0 = acc[ai][bj][m][0], a1 = acc[ai][bj][m][1];
                        u32x4 o; o.x = cvt_pk_bf16(a0[0], a0[1]); o.y = cvt_pk_bf16(a0[2], a0[3]); o.z = cvt_pk_bf16(a1[0], a1[1]); o.w = cvt_pk_bf16(a1[2], a1[3]);
                        *(u32x4*)(dstb + (size_t)r * CONVD + 32 * bj) = o;
                        if (f32dst) { *(f32x4*)(f32dst + 32 * bj) = a0; *(f32x4*)(f32dst + 32 * bj + 4) = a1; }
                    }
                }
        }
    }
};

struct EpiOut {
    static constexpr bool PERM = true, AFTER_DRAIN = false, MIDK = true;
    const float* xp; const float* xs; const PG8_LAS float* rs; float* out;
    __device__ __forceinline__ void mid(f32x4 (&acc)[2][2][4][2], const Unit& u, int ui, int wr, int wc, int fr, int fq) const {
        const PG8_LAS float* rp = rs + ui * 256 + wr * 64 + fr;
#pragma unroll
        for (int ai = 0; ai < 2; ++ai)
#pragma unroll
            for (int m = 0; m < 4; ++m) {
                const float r = rp[ai * HALF + m * 16];
#pragma unroll
                for (int bj = 0; bj < 2; ++bj)
#pragma unroll
                    for (int n = 0; n < 2; ++n) acc[ai][bj][m][n] *= r;
            }
    }
    __device__ __forceinline__ void operator()(const f32x4 (&acc)[2][2][4][2], const Unit& u, int wr, int wc, int fr, int fq) const {
        const int rowb = u.pm * BM + wr * 64 + fr, col = u.pn * BM + wc * 64 + 8 * fq;
#pragma unroll
        for (int ai = 0; ai < 2; ++ai)
#pragma unroll
            for (int m = 0; m < 4; ++m) {
                const int r = rowb + ai * HALF + m * 16;
                if (r >= NROWS) continue;
                const float* xr = (r < NTOK ? xp + (size_t)r * DM : xs + (size_t)(r - NTOK) * DM) + col;
                float* yr = out + (r < NTOK ? O_YP + (size_t)r * DM : O_YS + (size_t)(r - NTOK) * DM) + col;
#pragma unroll
                for (int bj = 0; bj < 2; ++bj) {
                    *(f32x4*)(yr + 32 * bj) = *(const f32x4*)(xr + 32 * bj) + acc[ai][bj][m][0];
                    *(f32x4*)(yr + 32 * bj + 4) = *(const f32x4*)(xr + 32 * bj + 4) + acc[ai][bj][m][1];
                }
            }
    }
};

template <class Epi, class Sched, bool ALIGN_EPI = false, bool SP2 = false>
__device__ __forceinline__ void gemm_phase(PG8_LAS unsigned char* lds, const Gemm g, const Sched& S, const Epi& E) {
    const int tid = threadIdx.x, wid = __builtin_amdgcn_readfirstlane(tid >> 6), lane = tid & 63, wr = wid >> 2, wc = wid & 3, fr = lane & 15, fq = lane >> 4;
    const int K = g.K, nt = K / BK;
    unsigned voffA[2], voffB[2];
#pragma unroll
    for (int i = 0; i < 2; ++i) { int R, C; stage_rc(tid * 16 + i * 8192, R, C); const int Rb = Epi::PERM ? ((R & ~31) + perm32(R & 31)) : R;
        voffA[i] = (unsigned)(R * K + C) * 2u; voffB[i] = (unsigned)(Rb * K + C) * 2u; }
    const size_t kstep = (size_t)(BK * 2);
    const size_t hstep = (size_t)HALF * K * 2;
    const size_t tstep = 2 * hstep;
    const unsigned ldsw = (unsigned)wid * 1024u;
    const int aoff = lds_byte(wr * 64 + fr, fq * 8), boff = lds_byte(wc * 32 + fr, fq * 8);
#define PG8_SA(b, h) (((b) * 2 + (h)) * HTB)
#define PG8_SB(b, h) ((4 + (b) * 2 + (h)) * HTB)
#define PG8_STAGE(bufoff, gbase, voff) do { _Pragma("unroll") for (int _i = 0; _i < 2; ++_i) \
        __builtin_amdgcn_global_load_lds((const unsigned*)((const char*)(gbase) + (voff)[_i]), (PG8_LAS unsigned*)(lds + (bufoff) + ldsw + _i * 8192), 16, 0, 0); } while (0)
#define PG8_LDA(dst, b, h) do { _Pragma("unroll") for (int m = 0; m < 4; ++m) _Pragma("unroll") for (int k = 0; k < 2; ++k) dst[m][k] = *(const PG8_LAS bf16x8*)(lds + PG8_SA(b, h) + aoff + m * 2048 + k * 1024); } while (0)
#define PG8_LDB(dst, b, h) do { _Pragma("unroll") for (int n = 0; n < 2; ++n) _Pragma("unroll") for (int k = 0; k < 2; ++k) dst[n][k] = *(const PG8_LAS bf16x8*)(lds + PG8_SB(b, h) + boff + n * 2048 + k * 1024); } while (0)
#define PG8_MMA(ai, bj, At, Bt) do { __builtin_amdgcn_s_setprio(1); _Pragma("unroll") for (int m = 0; m < 4; ++m) _Pragma("unroll") for (int n = 0; n < 2; ++n) _Pragma("unroll") for (int k = 0; k < 2; ++k) \
        acc[ai][bj][m][n] = __builtin_amdgcn_mfma_f32_16x16x32_bf16(Bt[n][k], At[m][k], acc[ai][bj][m][n], 0, 0, 0); __builtin_amdgcn_s_setprio(0); } while (0)
#define PG8_WAIT_V(n) asm volatile("s_waitcnt vmcnt(" #n ")" ::: "memory")
#define PG8_WAIT_L(n) asm volatile("s_waitcnt lgkmcnt(" #n ")" ::: "memory")
#define PG8_BAR __builtin_amdgcn_s_barrier()
#define PG8_SCHED __builtin_amdgcn_sched_barrier(0)
    Unit cur, nxt; int ui = 0;
    if (!S.next(0, cur)) return;
    f32x4 acc[2][2][4][2];
#pragma unroll
    for (int a = 0; a < 2; ++a)
#pragma unroll
        for (int b = 0; b < 2; ++b)
#pragma unroll
            for (int m = 0; m < 4; ++m)
#pragma unroll
                for (int n = 0; n < 2; ++n) acc[a][b][m][n] = (f32x4){0.f, 0.f, 0.f, 0.f};
    bf16x8 At[4][2], B0[2][2], B1[2][2];
    const char* cA = (const char*)g.A + (size_t)cur.pm * tstep; const char* cB = (const char*)g.Bt + (size_t)cur.pn * tstep;
    S.a_ready(cur);
    if constexpr (SP2) {
        PG8_STAGE(PG8_SB(0, 0), cB, voffB); PG8_STAGE(PG8_SB(0, 1), cB + hstep, voffB); PG8_STAGE(PG8_SA(0, 0), cA, voffA); PG8_STAGE(PG8_SA(0, 1), cA + hstep, voffA);
        if (wr == 1) PG8_BAR;
        PG8_WAIT_V(2); PG8_BAR;
        PG8_STAGE(PG8_SB(1, 0), cB + kstep, voffB); PG8_STAGE(PG8_SA(1, 0), cA + kstep, voffA); PG8_STAGE(PG8_SB(1, 1), cB + hstep + kstep, voffB);
        PG8_WAIT_V(6); PG8_BAR;
    } else {
        PG8_STAGE(PG8_SB(0, 0), cB, voffB); PG8_STAGE(PG8_SA(0, 0), cA, voffA); PG8_STAGE(PG8_SB(0, 1), cB + hstep, voffB); PG8_STAGE(PG8_SA(0, 1), cA + hstep, voffA);
        if (wr == 1) PG8_BAR;
        PG8_WAIT_V(4); PG8_BAR;
        PG8_STAGE(PG8_SB(1, 0), cB + kstep, voffB); PG8_STAGE(PG8_SA(1, 0), cA + kstep, voffA); PG8_STAGE(PG8_SB(1, 1), cB + hstep + kstep, voffB);
        PG8_WAIT_V(6); PG8_BAR;
    }
    for (;;) {
        const bool has_next = S.next(ui + 1, nxt);
        const char* nA = has_next ? (const char*)g.A + (size_t)nxt.pm * tstep : cA; const char* nB = has_next ? (const char*)g.Bt + (size_t)nxt.pn * tstep : cB;
        for (int t = 0; t < nt; t += 2) {
            const bool last = (t == nt - 2);
            if constexpr (Epi::MIDK) { if (t == (nt >> 1)) E.mid(acc, cur, ui, wr, wc, fr, fq); }
            const char* a1 = cA + (size_t)(t + 1) * kstep;
            const char* a2 = last ? nA : cA + (size_t)(t + 2) * kstep; const char* b2 = last ? nB : cB + (size_t)(t + 2) * kstep;
            const char* a3 = a2 + kstep; const char* b3 = b2 + kstep;
            if (last && has_next) S.a_ready(nxt);
            if constexpr (SP2) {
            PG8_LDB(B0, 0, 0); PG8_LDB(B1, 0, 1); PG8_SCHED; PG8_LDA(At, 0, 0); PG8_STAGE(PG8_SA(1, 1), a1 + hstep, voffA);
            PG8_WAIT_V(8); PG8_WAIT_L(0); PG8_BAR; PG8_MMA(0, 0, At, B0); PG8_MMA(0, 1, At, B1); PG8_BAR; PG8_SCHED;
            PG8_LDA(At, 0, 1); PG8_STAGE(PG8_SB(0, 0), b2, voffB); PG8_STAGE(PG8_SB(0, 1), b2 + hstep, voffB); PG8_STAGE(PG8_SA(0, 0), a2, voffA);
            PG8_WAIT_V(8); PG8_WAIT_L(0); PG8_BAR; PG8_MMA(1, 0, At, B0); PG8_MMA(1, 1, At, B1); PG8_BAR; PG8_SCHED;
            PG8_LDB(B0, 1, 0); PG8_LDB(B1, 1, 1); PG8_SCHED; PG8_LDA(At, 1, 0); PG8_STAGE(PG8_SA(0, 1), a2 + hstep, voffA);
            PG8_WAIT_V(8); PG8_WAIT_L(0); PG8_BAR; PG8_MMA(0, 0, At, B0); PG8_MMA(0, 1, At, B1); PG8_BAR; PG8_SCHED;
            PG8_LDA(At, 1, 1); PG8_STAGE(PG8_SB(1, 0), b3, voffB); PG8_STAGE(PG8_SB(1, 1), b3 + hstep, voffB); PG8_STAGE(PG8_SA(1, 0), a3, voffA);
            PG8_WAIT_V(8); PG8_WAIT_L(0); PG8_BAR; PG8_MMA(1, 0, At, B0); PG8_MMA(1, 1, At, B1); PG8_BAR; PG8_SCHED;
            } else {
            PG8_LDB(B0, 0, 0); PG8_SCHED; PG8_LDA(At, 0, 0); PG8_STAGE(PG8_SA(1, 1), a1 + hstep, voffA);
            PG8_WAIT_L(8); PG8_BAR; PG8_WAIT_L(0); PG8_MMA(0, 0, At, B0); PG8_BAR; PG8_SCHED;
            PG8_LDB(B1, 0, 1); PG8_STAGE(PG8_SB(0, 0), b2, voffB);
            PG8_BAR; PG8_WAIT_L(0); PG8_MMA(0, 1, At, B1); PG8_BAR;
            PG8_LDA(At, 0, 1); PG8_STAGE(PG8_SA(0, 0), a2, voffA);
            PG8_BAR; PG8_WAIT_L(0); PG8_MMA(1, 0, At, B0); PG8_BAR; PG8_SCHED;
            PG8_STAGE(PG8_SB(0, 1), b2 + hstep, voffB);
            PG8_WAIT_V(6); PG8_BAR; PG8_MMA(1, 1, At, B1); PG8_BAR;
            PG8_LDB(B0, 1, 0); PG8_SCHED; PG8_LDA(At, 1, 0); PG8_STAGE(PG8_SA(0, 1), a2 + hstep, voffA);
            PG8_WAIT_L(8); PG8_BAR; PG8_WAIT_L(0); PG8_MMA(0, 0, At, B0); PG8_BAR; PG8_SCHED;
            PG8_LDB(B1, 1, 1); PG8_STAGE(PG8_SB(1, 0), b3, voffB);
            PG8_BAR; PG8_WAIT_L(0); PG8_MMA(0, 1, At, B1); PG8_BAR;
            PG8_LDA(At, 1, 1); PG8_STAGE(PG8_SA(1, 0), a3, voffA);
            PG8_BAR; PG8_WAIT_L(0); PG8_MMA(1, 0, At, B0); PG8_BAR; PG8_SCHED;
            PG8_STAGE(PG8_SB(1, 1), b3 + hstep, voffB);
            PG8_WAIT_V(6); PG8_BAR; PG8_MMA(1, 1, At, B1); PG8_BAR;
            }
        }
        if constexpr (ALIGN_EPI) { if (wr == 0) PG8_BAR; }
        if constexpr (!Epi::AFTER_DRAIN) { E(acc, cur, wr, wc, fr, fq); S.done(cur); }
        if (!has_next) break;
#pragma unroll
        for (int a = 0; a < 2; ++a)
#pragma unroll
            for (int b = 0; b < 2; ++b)
#pragma unroll
                for (int m = 0; m < 4; ++m)
#pragma unroll
                    for (int n = 0; n < 2; ++n) acc[a][b][m][n] = (f32x4){0.f, 0.f, 0.f, 0.f};
        cur = nxt; cA = nA; cB = nB; ++ui;
        if constexpr (ALIGN_EPI) { if (wr == 1) PG8_BAR; }
    }
    PG8_WAIT_V(0);
    if constexpr (!ALIGN_EPI) { if (wr == 0) PG8_BAR; }
    PG8_BAR;
    if constexpr (Epi::AFTER_DRAIN) { E.fused(acc, cur, wr, wc, fr, fq, lds, wid, lane); S.done(cur); }
#undef PG8_SA
#undef PG8_SB
#undef PG8_STAGE
#undef PG8_LDA
#undef PG8_LDB
#undef PG8_MMA
#undef PG8_WAIT_V
#undef PG8_WAIT_L
#undef PG8_BAR
#undef PG8_SCHED
}
}
#define GAS __attribute__((address_space(1)))
#define LAS __attribute__((address_space(3)))
typedef unsigned v4u __attribute__((ext_vector_type(4)));
typedef float f32x4 __attribute__((ext_vector_type(4)));
typedef short bf16x8 __attribute__((ext_vector_type(8)));
typedef GAS unsigned gu32;
typedef GAS unsigned long long gu64;
#define RLX_AGENT __ATOMIC_RELAXED, __HIP_MEMORY_SCOPE_AGENT
#define LDS_WAIT() asm volatile("s_waitcnt lgkmcnt(0)" ::: "memory")
#define VM_WAIT() asm volatile("s_waitcnt vmcnt(0)" ::: "memory")
__device__ __forceinline__ unsigned long long rt() { return __builtin_amdgcn_s_memrealtime(); }

#define XB_TMO      128
#define XB_XCNT(j)  (256  + 64 * (j))
#define XB_XSUB(j)  (1280 + 64 * (j))
#define XB_XGEN(j)  (2304 + 64 * (j))
#define XB_TOP      3328
#define XB_TOPGEN   3392
#define XCD_BAR_WORDS 3456
#define XB_SPIN_CAP (1u << 18)

__device__ __forceinline__ unsigned xb_ld(unsigned* p)              { return __hip_atomic_load(p, __ATOMIC_RELAXED, __HIP_MEMORY_SCOPE_AGENT); }
__device__ __forceinline__ unsigned xb_add(unsigned* p, unsigned v) { return __hip_atomic_fetch_add(p, v, __ATOMIC_RELAXED, __HIP_MEMORY_SCOPE_AGENT); }
__device__ __forceinline__ unsigned xb_xcc_id() { return (unsigned)__builtin_amdgcn_s_getreg((3 << 11) | 20) & 0xFu; }
#define XB_SPIN(cond, bar) do { unsigned _sp = 0; while (cond) { __builtin_amdgcn_s_sleep(1); \
    if ((++_sp & 255u) == 0u) { if (xb_ld(&(bar)[XB_TMO])) break; if (_sp > XB_SPIN_CAP) { atomicAdd(&(bar)[XB_TMO], 1u); break; } } } } while (0)

struct XcdBarrier {
    unsigned* bar; unsigned x;
    volatile LAS unsigned* st;
};

__device__ __forceinline__ XcdBarrier xcd_barrier_post(unsigned* bar, volatile LAS unsigned* st) {
    XcdBarrier b; b.bar = bar; b.x = xb_xcc_id(); b.st = st;
    if (threadIdx.x == 0) (void)xb_add(&bar[XB_XCNT(b.x)], 1u);
    return b;
}
__device__ __forceinline__ void xcd_barrier_complete(unsigned* bar, unsigned x, unsigned& nloc, unsigned& nx) {
    const unsigned G = gridDim.x * gridDim.y * gridDim.z;
    unsigned sum, cnt, mine, sp = 0u;
    for (;;) {
        sum = 0u; cnt = 0u; mine = 0u;
#pragma unroll
        for (unsigned j = 0; j < 16; ++j) { const unsigned c = xb_ld(&bar[XB_XCNT(j)]); sum += c; cnt += (c > 0u) ? 1u : 0u; mine = (j == x) ? c : mine; }
        if (sum == G) break;
        __builtin_amdgcn_s_sleep(1);
        if ((++sp & 255u) == 0u) { if (xb_ld(&bar[XB_TMO])) break; if (sp > XB_SPIN_CAP) { atomicAdd(&bar[XB_TMO], 1u); break; } }
    }
    nloc = mine > 0u ? mine : 1u; nx = cnt > 0u ? cnt : 1u;
}

__device__ __forceinline__ void xcd_barrier(const XcdBarrier& b) {
    asm volatile("s_waitcnt vmcnt(0)" ::: "memory");
    __syncthreads();
    if (threadIdx.x == 0) {
        unsigned* bar = b.bar;
        __builtin_amdgcn_s_waitcnt(0);
        unsigned nloc = b.st[0], nx = b.st[1];
        if (nloc == 0u) { xcd_barrier_complete(bar, b.x, nloc, nx); b.st[0] = nloc; b.st[1] = nx; }
        const unsigned old = xb_add(&bar[XB_XSUB(b.x)], 1u);
        const unsigned gen = old / nloc;
        if (old + 1u == (gen + 1u) * nloc) {
            __builtin_amdgcn_fence(__ATOMIC_RELEASE, "agent");
            asm volatile("s_waitcnt vmcnt(0)" ::: "memory");
            const unsigned og = xb_add(&bar[XB_TOP], 1u);
            const unsigned tg = og / nx;
            if (og + 1u == (tg + 1u) * nx) xb_add(&bar[XB_TOPGEN], 1u);
            else XB_SPIN(xb_ld(&bar[XB_TOPGEN]) == tg, bar);
            __builtin_amdgcn_fence(__ATOMIC_ACQUIRE, "agent");
            xb_add(&bar[XB_XGEN(b.x)], 1u);
            asm volatile("s_waitcnt vmcnt(0)" ::: "memory");
        } else {
            XB_SPIN(xb_ld(&bar[XB_XGEN(b.x)]) == gen, bar);
            __builtin_amdgcn_fence(__ATOMIC_ACQUIRE, "agent");
            asm volatile("s_waitcnt vmcnt(0)" ::: "memory");
        }
    }
    __syncthreads();
}

constexpr int NWAVES = 8;
constexpr int RING_OFF = 0, RING_BYTES = 131072;
constexpr int LDS_BYTES = 163840;
constexpr int LDSCTL_OFF = LDS_BYTES - 512, MISC_OFF = LDSCTL_OFF + 320;
constexpr int CW_BAR = 4096;
constexpr int CW_Q = 16384;
static_assert((CW_BAR + XCD_BAR_WORDS) <= CW_Q && (CW_Q + 64 * 64) * 4 <= (int)CTL_ZERO_BYTES, "CTL words inside the memset region");

struct Frame {
    LAS unsigned char* lds;
    volatile LAS unsigned* MISC;
    gu32* ctl;
    int tid, lane, wave, vcu, G;
    Ins I; float* out;
    bf16 *WinT, *WoutT, *XN, *Q, *K, *V, *AU, *XBC; float *DT, *SSQ;
};

template <class SrcF>
__device__ __forceinline__ void p0_transpose_item(SrcF src, int k0, int n0, bf16* WT, int dst_pitch, int dst_row0, int dst_k0, LAS float* scr, int lane) {
#pragma unroll 8
    for (int i = 0; i < 32; ++i) { const int kk = 2 * i + (lane >> 5); scr[kk * 33 + (lane & 31)] = src(k0 + kk, n0 + (lane & 31)); }
    LDS_WAIT(); asm volatile("" ::: "memory");
    const int c = lane & 7;
#pragma unroll
    for (int j = 0; j < 4; ++j) { const int n = (lane >> 3) + 8 * j; const LAS float* s = scr + (8 * c) * 33 + n;
        v4u o; o.x = pk2(s[0 * 33], s[1 * 33]); o.y = pk2(s[2 * 33], s[3 * 33]); o.z = pk2(s[4 * 33], s[5 * 33]); o.w = pk2(s[6 * 33], s[7 * 33]);
        *(GAS v4u*)(WT + (size_t)(dst_row0 + n) * dst_pitch + dst_k0 + 8 * c) = o; }
    LDS_WAIT(); asm volatile("" ::: "memory");
}
constexpr int P0_SCR_BYTES = 8448, WDT_OFF = NWAVES * P0_SCR_BYTES, WDT_PITCH = 20;
static_assert(WDT_OFF + 1024 * WDT_PITCH * 4 <= LDSCTL_OFF, "prologue LDS");

__device__ __forceinline__ void p0_prologue(Frame& F) {
    const Ins& I = F.I;
    LAS float* scr = (LAS float*)(F.lds + F.wave * P0_SCR_BYTES);
    LAS float* wdt = (LAS float*)(F.lds + WDT_OFF);
    const int gw = F.vcu * NWAVES + F.wave, NGW = F.G * NWAVES;
    for (int idx = F.tid; idx < 1024 * 16; idx += NWAVES * 64) {
        const int k = idx >> 4, j = idx & 15, pos = (((k >> 8) * 4 + (k & 3)) << 6) + ((k >> 2) & 63);
        wdt[pos * WDT_PITCH + j] = I.w_in[(size_t)k * NPROJ + C_DT + j] * I.norm_w[k];
    }
    constexpr int I_IN = (DM / 64) * (NMAIN / 32), I_OUT = (2048 / 64) * (DM / 32);
    for (int it = gw; it < I_IN + I_OUT; it += NGW) {
        if (it < I_IN) {
            const int nblk = NMAIN / 32, kb = it / nblk, nb = it % nblk, k0 = 64 * kb, n0 = 32 * nb;
            p0_transpose_item([&](int k, int n) { return I.w_in[(size_t)k * NPROJ + n] * I.norm_w[k]; }, k0, n0, F.WinT, DM, (n0 & ~255) + vrow_of_col(n0 & 255), k0, scr, F.lane);
        } else {
            const int r = it - I_IN, nblk = DM / 32, kb = r / nblk, nb = r % nblk, k0 = 64 * kb, n0 = 32 * nb;
            p0_transpose_item([&](int k, int n) { return I.w_out[(size_t)k * DM + n] * (k >= 1024 ? I.ssd_norm_w[k - 1024] : 1.f); }, k0, n0, F.WoutT, 2048, (n0 & ~255) + vrow_of_col(n0 & 255), (k0 + 1024) & 2047, scr, F.lane);
        }
    }
    __syncthreads();
    for (int rp = gw; rp < NROWS / 2; rp += NGW) {
        f32x4 v[2][4]; float rstd[2];
#pragma unroll
        for (int q = 0; q < 2; ++q) {
            const GAS f32x4* xr = (const GAS f32x4*)xrow(I, 2 * rp + q) + F.lane; float s = 0.f;
#pragma unroll
            for (int j = 0; j < 4; ++j) { v[q][j] = xr[64 * j]; s += (v[q][j].x * v[q][j].x + v[q][j].y * v[q][j].y) + (v[q][j].z * v[q][j].z + v[q][j].w * v[q][j].w); }
            rstd[q] = rsqrtf(wave_sum(s) * (1.f / DM) + EPS);
            GAS unsigned long long* o8 = (GAS unsigned long long*)(F.XN + (size_t)(2 * rp + q) * DM) + F.lane;
#pragma unroll
            for (int j = 0; j < 4; ++j) o8[64 * j] = (unsigned long long)pk2(v[q][j].x * rstd[q], v[q][j].y * rstd[q]) | ((unsigned long long)pk2(v[q][j].z * rstd[q], v[q][j].w * rstd[q]) << 32);
        }
        float a[32];
#pragma unroll
        for (int i = 0; i < 32; ++i) a[i] = 0.f;
#pragma unroll
        for (int j = 0; j < 4; ++j)
#pragma unroll
            for (int e = 0; e < 4; ++e) {
                const LAS f32x4* wp = (const LAS f32x4*)(wdt + ((j * 4 + e) * 64 + F.lane) * WDT_PITCH);
                const float x0 = v[0][j][e], x1 = v[1][j][e];
#pragma unroll
                for (int c4 = 0; c4 < 4; ++c4) { const f32x4 w = wp[c4];
#pragma unroll
                    for (int i = 0; i < 4; ++i) { a[c4 * 4 + i] += x0 * w[i]; a[16 + c4 * 4 + i] += x1 * w[i]; } }
                asm volatile("" ::: "memory");
            }
#define P0_HALVE(N, X) { const bool up = (F.lane & (X)) != 0; _Pragma("unroll") for (int i = 0; i < (N); ++i) { const float keep = up ? a[i + (N)] : a[i], send = up ? a[i] : a[i + (N)]; a[i] = keep + __shfl_xor(send, (X)); } }
        P0_HALVE(16, 32) P0_HALVE(8, 16) P0_HALVE(4, 8) P0_HALVE(2, 4) P0_HALVE(1, 2)
#undef P0_HALVE
        float tot = a[0] + __shfl_xor(a[0], 1);
        const int idx = F.lane >> 1, q = idx >> 4, c = idx & 15;
        tot = tot * (q ? rstd[1] : rstd[0]) + I.dt_bias[c];
        if ((F.lane & 1) == 0) F.DT[(size_t)(2 * rp + q) * 16 + c] = softplus_f(tot);
    }
    for (int r = NROWS + gw; r < MROWS; r += NGW) { GAS v4u* o = (GAS v4u*)(F.XN + (size_t)r * DM) + F.lane; o[0] = (v4u){0u, 0u, 0u, 0u}; o[64] = (v4u){0u, 0u, 0u, 0u}; }
    for (int i = (F.vcu * NWAVES * 64 + F.tid); i < DB * 2 * CONVD; i += F.G * NWAVES * 64) {
        const int c = i % CONVD, rr = i / CONVD, j = rr & 1, b = rr >> 1;
        F.out[O_CS + ((size_t)b * 3 + j) * CONVD + c] = I.sconv[((size_t)b * 3 + j + 1) * CONVD + c];
    }
}

namespace att {
typedef float f32x16 __attribute__((ext_vector_type(16)));
typedef short v4i16_t __attribute__((ext_vector_type(4)));
typedef unsigned u32x4 __attribute__((ext_vector_type(4)));
constexpr int SPAN = 256, NSPAN = SEQ / SPAN, NUNITS = NB * NH * NSPAN;
constexpr int OACC_OFF = 0, LACC_OFF = 65536, LUT_OFF = 66560, VST_OFF = 68608, VST_BYTES = 4096, ATT_LDS_END = VST_OFF + NWAVES * VST_BYTES;
static_assert(ATT_LDS_END <= LDSCTL_OFF, "attention LDS");
__device__ __forceinline__ int crow(int r, int hi) { return (r & 3) + 8 * (r >> 2) + 4 * hi; }

template <int NQ>
__device__ __forceinline__ void item(const bf16* Qb, const bf16* Kb, const bf16* Vb, int tq0, int d, int pat, int toff, LAS unsigned char* lds, int wave, int lane) {
    const int c = lane & 31, hi = lane >> 5;
    LAS unsigned char* vst = lds + VST_OFF + wave * VST_BYTES;
    const LAS float* lut = (const LAS float*)(lds + LUT_OFF) + pat * 129;
    bf16x8 qf[4];
    { const bf16* qp = Qb + (size_t)(tq0 + (NQ == 32 ? c : (c & 15)) * d) * DM + 8 * hi;
#pragma unroll
      for (int ks = 0; ks < 4; ++ks) qf[ks] = *(const bf16x8*)(qp + 16 * ks); }
    f32x16 o0 = {}, o1 = {};
    float lsum = 0.f;
    const int vtr = ((lane >> 4) & 1) * 32 + (lane & 3) * 8 + (4 * hi + ((lane & 15) >> 2)) * 64;
    bf16x8 kf[4], vr[4];
#define ATT_LOAD_TILE(KT) do { \
        { int tk_ = tq0 + (-128 + 32 * (KT) + c) * d; tk_ = tk_ < 0 ? 0 : tk_; const bf16* kp_ = Kb + (size_t)tk_ * DM + 8 * hi; \
          _Pragma("unroll") for (int ks = 0; ks < 4; ++ks) kf[ks] = *(const bf16x8*)(kp_ + 16 * ks); } \
        _Pragma("unroll") for (int pc = 0; pc < 4; ++pc) { int tk_ = tq0 + (-128 + 32 * (KT) + 16 * (pc & 1) + (lane >> 2)) * d; tk_ = tk_ < 0 ? 0 : tk_; \
            vr[pc] = *(const bf16x8*)(Vb + (size_t)tk_ * DM + 32 * (pc >> 1) + 8 * (lane & 3)); } } while (0)
    ATT_LOAD_TILE(0);
#pragma unroll 1
    for (int kt = 0; kt < 5; ++kt) {
        f32x16 st = {};
#pragma unroll
        for (int ks = 0; ks < 4; ++ks) st = __builtin_amdgcn_mfma_f32_32x32x16_bf16(kf[ks], qf[ks], st, 0, 0, 0);
#pragma unroll
        for (int pc = 0; pc < 4; ++pc) *(LAS bf16x8*)(vst + pc * 1024 + lane * 16) = vr[pc];
        if (kt < 4) ATT_LOAD_TILE(kt + 1);
        const int relb = c + 128 - 32 * kt - 4 * hi, tkb = tq0 + (-128 + 32 * kt + 4 * hi) * d;
#pragma unroll
        for (int r = 0; r < 16; ++r) {
            const int kk = (r & 3) + 8 * (r >> 2), rel = relb - kk;
            const bool valid = (rel >= 0) && (rel <= 128) && (tkb + kk * d >= 0);
            const float bias = lut[valid ? rel : 0];
            const float p = valid ? __builtin_amdgcn_exp2f(st[r] + bias) : 0.f;
            st[r] = p; lsum += p;
        }
        u32x4 pw0, pw1;
        pw0.x = pg8::cvt_pk_bf16(st[0], st[1]); pw0.y = pg8::cvt_pk_bf16(st[2], st[3]); pw0.z = pg8::cvt_pk_bf16(st[4], st[5]); pw0.w = pg8::cvt_pk_bf16(st[6], st[7]);
        pw1.x = pg8::cvt_pk_bf16(st[8], st[9]); pw1.y = pg8::cvt_pk_bf16(st[10], st[11]); pw1.z = pg8::cvt_pk_bf16(st[12], st[13]); pw1.w = pg8::cvt_pk_bf16(st[14], st[15]);
        const bf16x8 pa0 = __builtin_bit_cast(bf16x8, pw0), pa1 = __builtin_bit_cast(bf16x8, pw1);
#pragma unroll
        for (int dh = 0; dh < 2; ++dh)
#pragma unroll
            for (int s = 0; s < 2; ++s) {
                const LAS unsigned char* vp = vst + (dh * 2 + s) * 1024 + vtr;
                const v4i16_t lo = __builtin_amdgcn_ds_read_tr16_b64_v4i16((LAS v4i16_t*)vp), hh = __builtin_amdgcn_ds_read_tr16_b64_v4i16((LAS v4i16_t*)(vp + 512));
                const bf16x8 vb = (bf16x8){lo[0], lo[1], lo[2], lo[3], hh[0], hh[1], hh[2], hh[3]};
                if (dh == 0) o0 = __builtin_amdgcn_mfma_f32_32x32x16_bf16(s == 0 ? pa0 : pa1, vb, o0, 0, 0, 0);
                else         o1 = __builtin_amdgcn_mfma_f32_32x32x16_bf16(s == 0 ? pa0 : pa1, vb, o1, 0, 0, 0);
            }
    }
    lsum += __shfl_xor(lsum, 32);
    LAS float* oacc = (LAS float*)(lds + OACC_OFF); LAS float* lacc = (LAS float*)(lds + LACC_OFF);
    if (hi == 0 && c < NQ) __hip_atomic_fetch_add(lacc + toff + c * d, lsum, __ATOMIC_RELAXED, __HIP_MEMORY_SCOPE_WORKGROUP);
#pragma unroll
    for (int r = 0; r < (NQ == 32 ? 16 : 8); ++r) {
        const int q = crow(r, hi); LAS float* row = oacc + (toff + q * d) * 64 + c;
        __hip_atomic_fetch_add(row, o0[r], __ATOMIC_RELAXED, __HIP_MEMORY_SCOPE_WORKGROUP);
        __hip_atomic_fetch_add(row + 32, o1[r], __ATOMIC_RELAXED, __HIP_MEMORY_SCOPE_WORKGROUP);
    }
}

__device__ __forceinline__ void unit(Frame& F, int uidx) {
    const int span = uidx % NSPAN, bh = uidx / NSPAN, h = bh % NH, b = bh / NH, t0 = span * SPAN;
    LAS unsigned char* lds = F.lds;
    LAS float* oacc = (LAS float*)(lds + OACC_OFF); LAS float* lacc = (LAS float*)(lds + LACC_OFF); LAS float* lut = (LAS float*)(lds + LUT_OFF);
    for (int i = F.tid; i < (SPAN * 64 + SPAN) / 4; i += NWAVES * 64) ((LAS f32x4*)oacc)[i] = (f32x4){0.f, 0.f, 0.f, 0.f};
    if (F.tid < 387) { const int pat = F.tid / 129, rel = F.tid - pat * 129, d = pat == 0 ? 1 : (pat == 1 ? 4 : 16); lut[F.tid] = F.I.rel_bias[t5_bucket(rel * d) * NH + h] * LOG2E; }
    __syncthreads();
    const size_t boff = (size_t)b * SEQ * DM + h * HD;
    const bf16 *Qb = F.Q + boff, *Kb = F.K + boff, *Vb = F.V + boff;
    const int w = F.wave;
    item<32>(Qb, Kb, Vb, t0 + 32 * w, 1, 0, 32 * w, lds, w, F.lane);
    __builtin_amdgcn_sched_barrier(0);
    item<32>(Qb, Kb, Vb, t0 + (w & 3) + 128 * (w >> 2), 4, 1, (w & 3) + 128 * (w >> 2), lds, w, F.lane);
    __builtin_amdgcn_sched_barrier(0);
    item<16>(Qb, Kb, Vb, t0 + w, 16, 2, w, lds, w, F.lane);
    __builtin_amdgcn_sched_barrier(0);
    item<16>(Qb, Kb, Vb, t0 + w + 8, 16, 2, w + 8, lds, w, F.lane);
    __syncthreads();
    bf16* ap = F.AU + ((size_t)b * SEQ + t0 + 32 * w) * 2048 + 1024 + h * HD + F.lane;
#pragma unroll 4
    for (int i = 0; i < 32; ++i) {
        const float o = oacc[(32 * w + i) * 64 + F.lane], l = lacc[32 * w + i];
        bf16* gp = ap + (size_t)i * 2048;
        *gp = (bf16)f2bf(o * __builtin_amdgcn_rcpf(l) * bf2f(*gp));
    }
    __syncthreads();
}

__device__ __forceinline__ void phase(Frame& F) {
    const unsigned x = xb_xcc_id() & 7u;
    constexpr int PER_Q = NUNITS / 8;
    for (unsigned k = 0; k < 8; ++k) {
        const unsigned qx = (x + k) & 7u;
        for (;;) {
            if (F.tid == 0) F.MISC[16] = __hip_atomic_fetch_add(F.ctl + CW_Q + 64 * qx, 1u, RLX_AGENT);
            __syncthreads();
            const unsigned idx = F.MISC[16];
            __syncthreads();
            if (idx >= (unsigned)PER_Q) break;
            unit(F, (int)(qx * PER_Q + idx));
        }
    }
}
}

namespace ssd {
typedef float f32x16 __attribute__((ext_vector_type(16)));
typedef short v4i16_t __attribute__((ext_vector_type(4)));
typedef unsigned u32x2 __attribute__((ext_vector_type(2)));
constexpr int PITCH = 272;
constexpr int BT_OFF = 0, CT_OFF = 34816, G_OFF = 69632, HB_OFF = 104448, XD_OFF = 121856, XH_OFF = 138240, ACS_OFF = 154624, DTL_OFF = ACS_OFF + 512, SSQL_OFF = DTL_OFF + 512, SSD_LDS_END = SSQL_OFF + 512;
static_assert(SSD_LDS_END <= LDSCTL_OFF, "SSD LDS");
__device__ __forceinline__ int crow(int r, int hi) { return (r & 3) + 8 * (r >> 2) + 4 * hi; }
__device__ __forceinline__ bf16x8 trfrag(const LAS unsigned char* p0, const LAS unsigned char* p1) {
    const v4i16_t lo = __builtin_amdgcn_ds_read_tr16_b64_v4i16((LAS v4i16_t*)p0), hh = __builtin_amdgcn_ds_read_tr16_b64_v4i16((LAS v4i16_t*)p1);
    return (bf16x8){lo[0], lo[1], lo[2], lo[3], hh[0], hh[1], hh[2], hh[3]};
}

__device__ __forceinline__ void chain(Frame& F, int bh) {
    const Ins& I = F.I;
    const int b = bh >> 4, hd = bh & 15, grp = hd >> 3;
    const int tid = F.tid, lane = F.lane, w = F.wave, c = lane & 31, hi = lane >> 5;
    LAS unsigned char* lds = F.lds;
    LAS float* acs = (LAS float*)(lds + ACS_OFF); LAS float* dtl = (LAS float*)(lds + DTL_OFF); LAS float* ssql = (LAS float*)(lds + SSQL_OFF);
    const float A = -__expf(I.a_log[hd]), dsk = I.d_skip[hd];
    const size_t row0 = (size_t)b * SEQ;
    for (int i = tid; i < 17408 / 16; i += NWAVES * 64) ((LAS v4u*)(lds + HB_OFF))[i] = (v4u){0u, 0u, 0u, 0u};
    f32x16 hacc = {};
    const int pt = w & 1, jt = w >> 1;
    const int q4 = (lane & 15) >> 2, odd = (lane >> 4) & 1, p4 = lane & 3;
    const int xtr = (8 * hi + q4) * 64 + (16 * odd + 4 * p4) * 2;
#pragma unroll 1
    for (int ch = 0; ch < SEQ / 128; ++ch) {
        const int t0 = ch * 128;
        if (w == 0) {
            if (ch > 0) { F.SSQ[(row0 + t0 - 128 + lane) * 16 + hd] = ssql[lane]; F.SSQ[(row0 + t0 - 64 + lane) * 16 + hd] = ssql[64 + lane]; }
            const float d0 = F.DT[(row0 + t0 + 2 * lane) * 16 + hd], d1 = F.DT[(row0 + t0 + 2 * lane + 1) * 16 + hd];
            const float v0 = d0 * A, v1 = d1 * A; float s = v0 + v1;
#pragma unroll
            for (int o = 1; o < 64; o <<= 1) { const float t = __shfl_up(s, o); if (lane >= o) s += t; }
            acs[2 * lane] = s - v1; acs[2 * lane + 1] = s; dtl[2 * lane] = d0; dtl[2 * lane + 1] = d1; ssql[lane] = 0.f; ssql[64 + lane] = 0.f;
        }
        __syncthreads();
        const float aend = acs[127];
        for (int task = tid; task < 640; task += NWAVES * 64) {
            const int cg = task % 40, rr = task / 40, s0 = 8 * rr;
            const int chn = cg < 8 ? hd * 64 + 8 * cg : (cg < 24 ? 1024 + grp * 128 + 8 * (cg - 8) : 1280 + grp * 128 + 8 * (cg - 24));
            float wt[4][8], bs[8];
#pragma unroll
            for (int t = 0; t < 4; ++t) { const f32x4 a0 = *(const f32x4*)(I.conv_w + t * CONVD + chn), a1 = *(const f32x4*)(I.conv_w + t * CONVD + chn + 4);
#pragma unroll
                for (int i = 0; i < 4; ++i) { wt[t][i] = a0[i]; wt[t][4 + i] = a1[i]; } }
            { const f32x4 a0 = *(const f32x4*)(I.conv_b + chn), a1 = *(const f32x4*)(I.conv_b + chn + 4);
#pragma unroll
              for (int i = 0; i < 4; ++i) { bs[i] = a0[i]; bs[4 + i] = a1[i]; } }
            bf16x8 raw[11];
#pragma unroll
            for (int j = 0; j < 11; ++j) { const int t = t0 + s0 - 3 + j; raw[j] = t >= 0 ? *(const bf16x8*)(F.XBC + (row0 + t) * CONVD + chn) : (bf16x8){0, 0, 0, 0, 0, 0, 0, 0}; }
#pragma unroll
            for (int i = 0; i < 8; ++i) {
                const int s = s0 + i; float v[8];
#pragma unroll
                for (int e = 0; e < 8; ++e) { float a = bs[e];
#pragma unroll
                    for (int t = 0; t < 4; ++t) a += wt[t][e] * bf2f((bf16)raw[i + t][e]);
                    v[e] = silu_fast(a); }
                if (cg < 8) {
                    const float dt = dtl[s], de = dt * __expf(aend - acs[s]);
                    const int off = (((s >> 4) * 2 + (cg >> 2)) << 10) + (s & 15) * 64 + (cg & 3) * 16;
                    v4u o; o.x = pk2(v[0] * dt, v[1] * dt); o.y = pk2(v[2] * dt, v[3] * dt); o.z = pk2(v[4] * dt, v[5] * dt); o.w = pk2(v[6] * dt, v[7] * dt);
                    *(LAS v4u*)(lds + XD_OFF + off) = o;
                    o.x = pk2(v[0] * de, v[1] * de); o.y = pk2(v[2] * de, v[3] * de); o.z = pk2(v[4] * de, v[5] * de); o.w = pk2(v[6] * de, v[7] * de);
                    *(LAS v4u*)(lds + XH_OFF + off) = o;
                } else {
                    v4u o; o.x = pk2(v[0], v[1]); o.y = pk2(v[2], v[3]); o.z = pk2(v[4], v[5]); o.w = pk2(v[6], v[7]);
                    *(LAS v4u*)(lds + (cg < 24 ? BT_OFF + 16 * (cg - 8) : CT_OFF + 16 * (cg - 24)) + s * PITCH) = o;
                }
            }
        }
        __syncthreads();
        {
            const int j = w & 3; const float al = acs[32 * j + c];
#pragma unroll
            for (int ii = 0; ii < 2; ++ii) {
                const int i = 2 * (w >> 2) + ii;
                if (i <= j) {
                    f32x16 x = {};
                    const LAS unsigned char* ap = lds + BT_OFF + (32 * i + c) * PITCH + 16 * hi;
                    const LAS unsigned char* bp = lds + CT_OFF + (32 * j + c) * PITCH + 16 * hi;
#pragma unroll
                    for (int ks = 0; ks < 8; ++ks) x = __builtin_amdgcn_mfma_f32_32x32x16_bf16(*(const LAS bf16x8*)(ap + 32 * ks), *(const LAS bf16x8*)(bp + 32 * ks), x, 0, 0, 0);
                    const int l = 32 * j + c;
#pragma unroll
                    for (int g4 = 0; g4 < 4; ++g4) {
                        const int sb = 32 * i + 8 * g4 + 4 * hi; float gv[4];
#pragma unroll
                        for (int e = 0; e < 4; ++e) { const int s = sb + e; gv[e] = s <= l ? x[4 * g4 + e] * __expf(al - acs[s]) : 0.f; }
                        u32x2 o; o.x = pk2(gv[0], gv[1]); o.y = pk2(gv[2], gv[3]);
                        *(LAS u32x2*)(lds + G_OFF + l * PITCH + sb * 2) = o;
                    }
                } else {
                }
            }
        }
        f32x16 yt = {};
        {
            const LAS unsigned char* ap = lds + HB_OFF + (32 * pt + c) * PITCH + 16 * hi;
            const LAS unsigned char* bp = lds + CT_OFF + (32 * jt + c) * PITCH + 16 * hi;
#pragma unroll
            for (int ks = 0; ks < 8; ++ks) yt = __builtin_amdgcn_mfma_f32_32x32x16_bf16(*(const LAS bf16x8*)(ap + 32 * ks), *(const LAS bf16x8*)(bp + 32 * ks), yt, 0, 0, 0);
            const float el = __expf(acs[32 * jt + c]);
#pragma unroll
            for (int r = 0; r < 16; ++r) yt[r] *= el;
        }
        __syncthreads();
        {
            const LAS unsigned char* bp = lds + G_OFF + (32 * jt + c) * PITCH + 16 * hi;
            for (int ks = 0; ks < 2 * jt + 2; ++ks) {
                const LAS unsigned char* xp = lds + XD_OFF + ((ks * 2 + pt) << 10) + xtr;
                yt = __builtin_amdgcn_mfma_f32_32x32x16_bf16(trfrag(xp, xp + 256), *(const LAS bf16x8*)(bp + 32 * ks), yt, 0, 0, 0);
            }
        }
        {
            const int l = 32 * jt + c; const float rdt = dsk * __builtin_amdgcn_rcpf(dtl[l]);
            bf16* up = F.AU + (row0 + t0 + l) * 2048 + hd * 64 + 32 * pt;
            float sq = 0.f;
#pragma unroll
            for (int g4 = 0; g4 < 4; ++g4) {
                const int pl = 8 * g4 + 4 * hi;
                const u32x2 xw = *(const LAS u32x2*)(lds + XD_OFF + (((l >> 4) * 2 + pt) << 10) + (l & 15) * 64 + pl * 2);
                const u32x2 zw = *(const u32x2*)(up + pl);
                const float x0 = __uint_as_float(xw.x << 16), x1 = __uint_as_float(xw.x & 0xffff0000u), x2 = __uint_as_float(xw.y << 16), x3 = __uint_as_float(xw.y & 0xffff0000u);
                const float z0 = __uint_as_float(zw.x << 16), z1 = __uint_as_float(zw.x & 0xffff0000u), z2 = __uint_as_float(zw.y << 16), z3 = __uint_as_float(zw.y & 0xffff0000u);
                const float u0 = (yt[4 * g4] + rdt * x0) * z0, u1 = (yt[4 * g4 + 1] + rdt * x1) * z1, u2 = (yt[4 * g4 + 2] + rdt * x2) * z2, u3 = (yt[4 * g4 + 3] + rdt * x3) * z3;
                sq += (u0 * u0 + u1 * u1) + (u2 * u2 + u3 * u3);
                u32x2 o; o.x = pk2(u0, u1); o.y = pk2(u2, u3);
                *(u32x2*)(up + pl) = o;
            }
            sq += __shfl_xor(sq, 32);
            if (hi == 0) __hip_atomic_fetch_add(ssql + l, sq, __ATOMIC_RELAXED, __HIP_MEMORY_SCOPE_WORKGROUP);
        }
        {
            const float ea = __expf(aend);
#pragma unroll
            for (int r = 0; r < 16; ++r) hacc[r] *= ea;
            const int btr = (8 * hi + q4) * PITCH + (32 * jt + 16 * odd + 4 * p4) * 2;
#pragma unroll
            for (int ks = 0; ks < 8; ++ks) {
                const LAS unsigned char* xp = lds + XH_OFF + ((ks * 2 + pt) << 10) + xtr;
                const LAS unsigned char* bp = lds + BT_OFF + 16 * ks * PITCH + btr;
                hacc = __builtin_amdgcn_mfma_f32_32x32x16_bf16(trfrag(xp, xp + 256), trfrag(bp, bp + 4 * PITCH), hacc, 0, 0, 0);
            }
        }
        __syncthreads();
#pragma unroll
        for (int r = 0; r < 16; ++r) *(LAS bf16*)(lds + HB_OFF + (32 * pt + crow(r, hi)) * PITCH + (32 * jt + c) * 2) = (bf16)f2bf(hacc[r]);
    }
    if (w == 0) { const int t0 = SEQ; F.SSQ[(row0 + t0 - 128 + lane) * 16 + hd] = ssql[lane]; F.SSQ[(row0 + t0 - 64 + lane) * 16 + hd] = ssql[64 + lane]; }
    float* ho = F.out + O_HP + (((size_t)b * NH + hd) * HD + 32 * pt) * DS + 32 * jt + c;
#pragma unroll
    for (int r = 0; r < 16; ++r) ho[(size_t)crow(r, hi) * DS] = hacc[r];
    __syncthreads();
}
}

struct Args { Ins in; float* out; unsigned char* ws; int ph_lo, ph_hi; };
__global__ void __launch_bounds__(NWAVES * 64, 2) mk_fwd(Args args) {
    extern __shared__ __attribute__((aligned(16))) unsigned char lds[];
    Frame F;
    F.lds = (LAS unsigned char*)lds;
    F.MISC = (volatile LAS unsigned*)(F.lds + MISC_OFF);
    F.tid = threadIdx.x; F.lane = F.tid & 63; F.wave = __builtin_amdgcn_readfirstlane(F.tid >> 6);
    F.G = gridDim.x; { const int bx = blockIdx.x; F.vcu = (F.G % 8 == 0) ? (bx % 8) * (F.G / 8) + bx / 8 : bx; }
    unsigned char* ws = args.ws;
    F.ctl = (gu32*)(ws + WS_CTL); F.I = args.in; F.out = args.out;
    F.WinT = (bf16*)(ws + WS_WIN); F.WoutT = (bf16*)(ws + WS_WOUT); F.XN = (bf16*)(ws + WS_XN); F.Q = (bf16*)(ws + WS_Q); F.K = (bf16*)(ws + WS_K); F.V = (bf16*)(ws + WS_V);
    F.AU = (bf16*)(ws + WS_AU); F.XBC = (bf16*)(ws + WS_XBC); F.DT = (float*)(ws + WS_DT); F.SSQ = (float*)(ws + WS_SSQ);
    for (int u = F.tid; u < (LDS_BYTES - LDSCTL_OFF) / 4; u += NWAVES * 64) ((LAS unsigned*)(F.lds + LDSCTL_OFF))[u] = 0u;
    __syncthreads();
    XcdBarrier bar = xcd_barrier_post((unsigned*)(F.ctl + CW_BAR), F.MISC + 8);
    const int lo = args.ph_lo, hi = args.ph_hi;
#define IN(k) (lo <= (k) && (k) < hi)
#define BOTH(k) (IN(k) && IN((k) + 1))
    if (IN(0)) { p0_prologue(F); if (BOTH(0)) xcd_barrier(bar); }
    if (IN(1)) {
        __syncthreads();
        pg8::Gemm g{F.XN, F.WinT, MROWS, NMAIN, DM}; pg8::StaticOrder S; S.init(MROWS, NMAIN, F.G, (int)blockIdx.x);
        pg8::EpiIn E{F.Q, F.K, F.V, F.AU, F.XBC, F.out, F.I.qnw, F.I.knw};
        pg8::gemm_phase<pg8::EpiIn, pg8::StaticOrder, true, true>(F.lds + RING_OFF, g, S, E);
        if (BOTH(1)) xcd_barrier(bar);
    }
    if (IN(2)) { __syncthreads(); if (F.vcu < NB * NH) ssd::chain(F, F.vcu); att::phase(F); if (BOTH(2)) xcd_barrier(bar); }
    if (IN(3)) {
        __syncthreads();
        pg8::Gemm g{F.AU, F.WoutT, MROWS, DM, 2048}; pg8::StaticOrder S; S.init(MROWS, DM, F.G, (int)blockIdx.x);
        LAS float* rs = (LAS float*)(F.lds + RING_BYTES);
        { pg8::Unit u;
          for (int ui = 0; ui < 4 && S.next(ui, u); ++ui)
              for (int r = F.tid; r < 256; r += NWAVES * 64) {
                  const f32x4* sp = (const f32x4*)(F.SSQ + (size_t)(u.pm * 256 + r) * 16);
                  const f32x4 s0 = sp[0], s1 = sp[1], s2 = sp[2], s3 = sp[3];
                  const float s = ((s0[0] + s0[1]) + (s0[2] + s0[3])) + ((s1[0] + s1[1]) + (s1[2] + s1[3])) + ((s2[0] + s2[1]) + (s2[2] + s2[3])) + ((s3[0] + s3[1]) + (s3[2] + s3[3]));
                  rs[ui * 256 + r] = rsqrtf(s * (1.f / 1024.f) + EPS);
              }
          __syncthreads(); }
        pg8::EpiOut E{F.I.xp, F.I.xs, rs, F.out};
        pg8::gemm_phase<pg8::EpiOut, pg8::StaticOrder, true, true>(F.lds + RING_OFF, g, S, E);
    }
#undef IN
#undef BOTH
}

namespace hyb {
struct Bufs { const bf16 *Q, *K, *V, *XBC; bf16* AU; const float* DT; float* SSQ; };

__global__ void __launch_bounds__(256) k_attn(Ins I, Bufs B, int row_lo) {
    __shared__ float qs[4][64];
    __shared__ float ps[4][388];
    const int wl = threadIdx.x >> 6, lane = threadIdx.x & 63;
    const int w = blockIdx.x * 4 + wl;
    const int r = row_lo + (w >> 4), h = w & 15;
    if (r >= NROWS) return;
    const bool samp = r >= NTOK;
    const int b = samp ? r - NTOK : r / SEQ, t = samp ? 0 : r % SEQ;
    qs[wl][lane] = bf2f(B.Q[(size_t)r * DM + h * HD + lane]);
    __builtin_amdgcn_wave_barrier();
    float sc[7]; float mx = -INFINITY;
#pragma unroll
    for (int it = 0; it < 7; ++it) {
        const int idx = it * 64 + lane; sc[it] = -INFINITY;
        if (idx < 387) {
            const int pat = idx / 129, j = idx - pat * 129, d = pat == 0 ? 1 : (pat == 1 ? 4 : 16);
            float s = 0.f; bool valid = true;
            if (samp && j > 0) { const float* kp = I.ck + (((size_t)b * WIN + (WIN - j * d)) * NH + h) * HD; for (int e = 0; e < 64; ++e) s += qs[wl][e] * kp[e]; }
            else { const int kt = t - j * d; valid = kt >= 0; const bf16* kp = B.K + (size_t)(samp ? r : b * SEQ + (valid ? kt : 0)) * DM + h * HD; for (int e = 0; e < 64; ++e) s += qs[wl][e] * bf2f(kp[e]); }
            s += I.rel_bias[t5_bucket(j * d) * NH + h] * LOG2E;
            if (valid) sc[it] = s;
        }
        mx = fmaxf(mx, sc[it]);
    }
    mx = wave_max(mx);
    float sum = 0.f;
#pragma unroll
    for (int it = 0; it < 7; ++it) { const int idx = it * 64 + lane; const float p = (sc[it] == -INFINITY) ? 0.f : exp2f(sc[it] - mx); if (idx < 387) ps[wl][idx] = p; sum += p; }
    sum = wave_sum(sum);
    __builtin_amdgcn_wave_barrier();
    float o = 0.f;
    for (int idx = 0; idx < 387; ++idx) {
        const float p = ps[wl][idx];
        if (p != 0.f) {
            const int pat = idx / 129, j = idx - pat * 129, d = pat == 0 ? 1 : (pat == 1 ? 4 : 16);
            if (samp && j > 0) o += p * I.cv[(((size_t)b * WIN + (WIN - j * d)) * NH + h) * HD + lane];
            else o += p * bf2f(B.V[(size_t)(samp ? r : b * SEQ + t - j * d) * DM + h * HD + lane]);
        }
    }
    o /= sum;
    bf16* gp = B.AU + (size_t)r * 2048 + 1024 + h * HD + lane;
    *gp = (bf16)f2bf(o * bf2f(*gp));
}

__global__ void __launch_bounds__(512) k_ssd(Ins I, Bufs B, float* out, int bh0) {
    constexpr int TB = 8;
    __shared__ float xs_l[TB][64], B_l[TB][128], C_l[TB][128], dt_l[TB], ssq_l[TB];
    const int tid = threadIdx.x, p = tid >> 3, ng = tid & 7;
    const int bh = blockIdx.x + bh0; const bool samp = bh >= NB * NH;
    const int b = samp ? (bh - NB * NH) / NH : bh / NH, hd = bh % NH, grp = hd >> 3;
    const int nsteps = samp ? 1 : SEQ;
    const size_t row0 = samp ? (size_t)NTOK + b : (size_t)b * SEQ;
    float h[16];
#pragma unroll
    for (int i = 0; i < 16; ++i) h[i] = samp ? I.sssm[(((size_t)b * NH + hd) * HD + p) * DS + ng * 16 + i] : 0.f;
    const float A = -__expf(I.a_log[hd]), dsk = I.d_skip[hd];
    auto xbc_at = [&](int t, int c) -> float {
        if (t >= 0) return bf2f(B.XBC[(row0 + t) * CONVD + c]);
        if (!samp) return 0.f;
        return I.sconv[((size_t)b * 3 + (3 + t)) * CONVD + c];
    };
    for (int t0 = 0; t0 < nsteps; t0 += TB) {
        const int nb = nsteps - t0 < TB ? nsteps - t0 : TB;
        for (int e = tid; e < nb * 320; e += 512) {
            const int s = e / 320, ci = e % 320;
            const int c = ci < 64 ? hd * 64 + ci : (ci < 192 ? 1024 + grp * 128 + (ci - 64) : 1280 + grp * 128 + (ci - 192));
            const int t = t0 + s;
            float v = I.conv_b[c];
#pragma unroll
            for (int i = 0; i < 4; ++i) v += xbc_at(t + i - 3, c) * I.conv_w[i * CONVD + c];
            v = silu_f(v);
            if (ci < 64) xs_l[s][ci] = v; else if (ci < 192) B_l[s][ci - 64] = v; else C_l[s][ci - 192] = v;
        }
        if (tid < nb) { dt_l[tid] = B.DT[(row0 + t0 + tid) * 16 + hd]; ssq_l[tid] = 0.f; }
        __syncthreads();
        for (int s = 0; s < nb; ++s) {
            const float dt = dt_l[s], x = xs_l[s][p], dec = __expf(dt * A), xdt = x * dt;
            float y = 0.f;
#pragma unroll
            for (int i = 0; i < 16; ++i) { h[i] = h[i] * dec + xdt * B_l[s][ng * 16 + i]; y += h[i] * C_l[s][ng * 16 + i]; }
            y += __shfl_xor(y, 1); y += __shfl_xor(y, 2); y += __shfl_xor(y, 4);
            if (ng == 0) {
                bf16* zp = B.AU + (row0 + t0 + s) * 2048 + hd * 64 + p;
                const float u = (y + dsk * x) * bf2f(*zp);
                *zp = (bf16)f2bf(u);
                atomicAdd(&ssq_l[s], u * u);
            }
        }
        __syncthreads();
        if (tid < nb) B.SSQ[(row0 + t0 + tid) * 16 + hd] = ssq_l[tid];
        __syncthreads();
    }
    float* hout = out + (samp ? O_HS : O_HP) + (((size_t)b * NH + hd) * HD + p) * DS + ng * 16;
#pragma unroll
    for (int i = 0; i < 16; ++i) hout[i] = h[i];
}

template <class LoadA, class LoadB, class Epi>
__device__ __forceinline__ void gemm_tile(int M, int N, int K, int bm, int bn, LoadA la, LoadB lb, Epi epi) {
    __shared__ float As[16][128 + 4];
    __shared__ float Bs[16][128 + 4];
    const int tid = threadIdx.x, tx = tid & 15, ty = tid >> 4;
    float acc[8][8];
#pragma unroll
    for (int i = 0; i < 8; ++i)
#pragma unroll
        for (int j = 0; j < 8; ++j) acc[i][j] = 0.f;
    for (int k0 = 0; k0 < K; k0 += 16) {
#pragma unroll
        for (int e = 0; e < 8; ++e) { const int idx = tid + e * 256, r = idx >> 4, k = idx & 15; const int gr = bm + r; As[k][r] = gr < M ? la(gr, k0 + k) : 0.f; }
#pragma unroll
        for (int e = 0; e < 8; ++e) { const int idx = tid + e * 256, k = idx >> 7, c = idx & 127; const int gc = bn + c; Bs[k][c] = gc < N ? lb(k0 + k, gc) : 0.f; }
        __syncthreads();
#pragma unroll
        for (int k = 0; k < 16; ++k) {
            float a[8], b[8];
#pragma unroll
            for (int i = 0; i < 8; ++i) a[i] = As[k][ty * 8 + i];
#pragma unroll
            for (int j = 0; j < 8; ++j) b[j] = Bs[k][tx + 16 * j];
#pragma unroll
            for (int i = 0; i < 8; ++i)
#pragma unroll
                for (int j = 0; j < 8; ++j) acc[i][j] += a[i] * b[j];
        }
        __syncthreads();
    }
#pragma unroll
    for (int i = 0; i < 8; ++i)
#pragma unroll
        for (int j = 0; j < 8; ++j) { const int gr = bm + ty * 8 + i, gc = bn + tx + 16 * j; if (gr < M && gc < N) epi(gr, gc, acc[i][j]); }
}
__global__ void __launch_bounds__(256) k_outproj(Ins I, Bufs B, float* out) {
    const int bn = blockIdx.x * 128, bm = blockIdx.y * 128;
    gemm_tile(NROWS, DM, 2048, bm, bn,
        [&](int r, int k) { if (k < 1024) return bf2f(B.AU[(size_t)r * 2048 + 1024 + k]);
                            float s = 0.f; for (int i = 0; i < 16; ++i) s += B.SSQ[(size_t)r * 16 + i];
                            return bf2f(B.AU[(size_t)r * 2048 + (k - 1024)]) * rsqrtf(s * (1.f / 1024.f) + EPS) * I.ssd_norm_w[k - 1024]; },
        [&](int k, int c) { return I.w_out[(size_t)k * DM + c]; },
        [&](int r, int c, float v) { const float y = xrow(I, r)[c] + v; if (r < NTOK) out[O_YP + (size_t)r * DM + c] = y; else out[O_YS + (size_t)(r - NTOK) * DM + c] = y; });
}
}

extern "C" void kernel_launch(void* const* d_in, const int* in_sizes, int n_in, void* d_out, int out_size, void* d_ws, size_t ws_size, hipStream_t stream) {
    static int grid = 0;
    if (grid == 0) {
        if (n_in != 18 || out_size != (int)O_END || ws_size < WS_END) { fprintf(stderr, "kernel_launch: unexpected n_in %d / out_size %d / ws_size %zu; nothing launched\n", n_in, out_size, ws_size); grid = -1; return; }
        int dev = 0, cus = 0;
        if (hipGetDevice(&dev) != hipSuccess || hipDeviceGetAttribute(&cus, hipDeviceAttributeMultiprocessorCount, dev) != hipSuccess) { grid = -1; return; }
        if (hipFuncSetAttribute((const void*)mk_fwd, hipFuncAttributeMaxDynamicSharedMemorySize, LDS_BYTES) != hipSuccess) { fprintf(stderr, "kernel_launch: hipFuncSetAttribute failed\n"); grid = -1; return; }
        (void)hipGetLastError();
        grid = cus;
    }
    if (grid < 0) return;
    (void)hipMemsetAsync((char*)d_ws + WS_CTL, 0, CTL_ZERO_BYTES, stream);
    Args a{};
    const float** ip = (const float**)&a.in;
    for (int i = 0; i < 18; ++i) ip[i] = (const float*)d_in[i];
    a.out = (float*)d_out; a.ws = (unsigned char*)d_ws;
    unsigned char* ws = (unsigned char*)d_ws;
    hyb::Bufs B{(const bf16*)(ws + WS_Q), (const bf16*)(ws + WS_K), (const bf16*)(ws + WS_V), (const bf16*)(ws + WS_XBC), (bf16*)(ws + WS_AU), (const float*)(ws + WS_DT), (float*)(ws + WS_SSQ)};
    a.ph_lo = 0; a.ph_hi = 3;
    hipLaunchKernelGGL(mk_fwd, dim3(grid), dim3(NWAVES * 64), LDS_BYTES, stream, a);
    hyb::k_attn<<<(DB * NH + 3) / 4, 256, 0, stream>>>(a.in, B, NTOK);
    hyb::k_ssd<<<DB * NH, 512, 0, stream>>>(a.in, B, (float*)d_out, NB * NH);
#if defined(HYB_OUTPROJ)
    hyb::k_outproj<<<dim3(DM / 128, (NROWS + 127) / 128), 256, 0, stream>>>(a.in, B, (float*)d_out);
#else
    a.ph_lo = 3; a.ph_hi = 4;
    hipLaunchKernelGGL(mk_fwd, dim3(grid), dim3(NWAVES * 64), LDS_BYTES, stream, a);
#endif
}
```

```cpp
#include <hip/hip_runtime.h>
#include <cstdio>
#include <cstdint>

constexpr int DM = 1024, NB = 4, SEQ = 8192, DB = 32, WIN = 2048;
constexpr int NPROJ = 6672, NMAIN = 6656, NTOK = NB * SEQ, NROWS = NTOK + DB;
constexpr int MROWS = 33024;
constexpr int C_Q = 0, C_K = 1024, C_V = 2048, C_G = 3072, C_Z = 4096, C_XBC = 5120, C_DT = 6656;
constexpr int CONVD = 1536, NH = 16, HD = 64, DS = 128;
constexpr float EPS = 1e-6f;
constexpr float QSCALE = 0.125f * 1.4426950408889634f;
constexpr float LOG2E = 1.4426950408889634f;
constexpr size_t O_YP = 0, O_YS = O_YP + (size_t)NTOK * DM, O_KP = O_YS + (size_t)DB * DM, O_VP = O_KP + (size_t)NB * WIN * DM,
                 O_CP = O_VP + (size_t)NB * WIN * DM, O_HP = O_CP + (size_t)NB * 3 * CONVD, O_KS = O_HP + (size_t)NB * NH * HD * DS,
                 O_VS = O_KS + (size_t)DB * DM, O_CS = O_VS + (size_t)DB * DM, O_HS = O_CS + (size_t)DB * 3 * CONVD,
                 O_END = O_HS + (size_t)DB * NH * HD * DS;
static_assert(O_END == 55314432, "output size");

constexpr size_t MiB = 1u << 20;
constexpr size_t WS_CTL = 0, CTL_ZERO_BYTES = 1 * MiB;
constexpr size_t WS_WIN = 2 * MiB;
constexpr size_t WS_WOUT = 16 * MiB;
constexpr size_t WS_DT = 20 * MiB;
constexpr size_t WS_SSQ = 24 * MiB;
constexpr size_t WS_XN = 32 * MiB;
constexpr size_t WS_Q = 100 * MiB;
constexpr size_t WS_K = 168 * MiB;
constexpr size_t WS_V = 236 * MiB;
constexpr size_t WS_AU = 304 * MiB;
constexpr size_t WS_XBC = 436 * MiB;
constexpr size_t WS_END = 536 * MiB;
static_assert(WS_XN + (size_t)MROWS * DM * 2 <= WS_Q && WS_Q + (size_t)MROWS * DM * 2 <= WS_K && WS_K + (size_t)MROWS * DM * 2 <= WS_V && WS_V + (size_t)MROWS * DM * 2 <= WS_AU &&
              WS_AU + (size_t)MROWS * 2048 * 2 <= WS_XBC && WS_XBC + (size_t)MROWS * CONVD * 2 <= WS_END && WS_WIN + (size_t)NMAIN * DM * 2 <= WS_WOUT && WS_WOUT + (size_t)DM * 2048 * 2 <= WS_DT &&
              WS_DT + (size_t)MROWS * 16 * 4 <= WS_SSQ && WS_SSQ + (size_t)MROWS * 16 * 4 <= WS_XN, "d_ws map");

struct Ins {
    const float *xp, *xs, *ck, *cv, *sconv, *sssm, *norm_w, *w_in, *qnw, *knw, *rel_bias, *conv_w, *conv_b, *dt_bias, *a_log, *d_skip, *ssd_norm_w, *w_out;
};

typedef unsigned short bf16;
__device__ __forceinline__ float wave_sum(float v) {
#pragma unroll
    for (int o = 1; o < 64; o <<= 1) v += __shfl_xor(v, o);
    return v;
}
__device__ __forceinline__ float wave_max(float v) {
#pragma unroll
    for (int o = 1; o < 64; o <<= 1) v = fmaxf(v, __shfl_xor(v, o));
    return v;
}
__device__ __forceinline__ float silu_f(float x) { return x / (1.f + __expf(-x)); }
__device__ __forceinline__ float silu_fast(float x) { return x * __builtin_amdgcn_rcpf(1.f + __builtin_amdgcn_exp2f(-LOG2E * x)); }
__device__ __forceinline__ float softplus_f(float x) { return x > 20.f ? x : log1pf(__expf(x)); }
__device__ __forceinline__ int t5_bucket(int d) {
    if (d < 16) return d;
    int b = 16;
    b += d >= 22; b += d >= 30; b += d >= 40; b += d >= 54; b += d >= 73; b += d >= 99; b += d >= 134; b += d >= 182;
    b += d >= 246; b += d >= 332; b += d >= 450; b += d >= 609; b += d >= 825; b += d >= 1117; b += d >= 1513;
    return b;
}
__device__ __forceinline__ const float* xrow(const Ins& I, int r) { return r < NTOK ? I.xp + (size_t)r * DM : I.xs + (size_t)(r - NTOK) * DM; }
__device__ __forceinline__ float bf2f(bf16 v) { return __uint_as_float((unsigned)v << 16); }
__device__ __forceinline__ unsigned f2bf(float f) { unsigned u = __float_as_uint(f); return (u + 0x7fffu + ((u >> 16) & 1u)) >> 16; }
__device__ __forceinline__ unsigned pk2(float lo, float hi) { return f2bf(lo) | (f2bf(hi) << 16); }
__host__ __device__ __forceinline__ int vrow_of_col(int a) { return 128 * ((a >> 5) & 1) + 32 * ((a >> 6) & 3) + (a & 31); }

namespace pg8 {
#define PG8_LAS __attribute__((address_space(3)))
typedef unsigned short bf16_t;
typedef short bf16x8 __attribute__((ext_vector_type(8)));
typedef float f32x4 __attribute__((ext_vector_type(4)));
typedef unsigned u32x4 __attribute__((ext_vector_type(4)));
constexpr int BM = 256, BK = 64, HALF = 128, HTB = HALF * BK * 2  , STAGE_BYTES = 8 * HTB, NXCD = 8, WGM = 8;

__host__ __device__ __forceinline__ int lds_byte(int r, int c) { const int st = (r >> 4) * 2 + (c >> 5), rr = r & 15, cc = c & 31, ob = rr * 64 + cc * 2; return st * 1024 + (ob ^ (((ob >> 9) & 1) << 5)); }
__host__ __device__ __forceinline__ void stage_rc(int b, int& R, int& C) { const int st = b / 1024, sb = b % 1024, swz = sb ^ (((sb >> 9) & 1) << 5); R = (st >> 1) * 16 + swz / 64; C = (st & 1) * 32 + (swz % 64) / 2; }
__host__ __device__ __forceinline__ int perm32(int rho) { const int n = rho >> 4, i = rho & 15; return 8 * (i >> 2) + 4 * n + (i & 3); }

struct Unit { int pm, pn; };
struct Gemm { const bf16_t* A; const bf16_t* Bt; int M, N, K; };

struct StaticOrder {
    int nM, nN, nwg, G, c;
    __host__ __device__ void init(int M, int N, int G_, int c_) { nM = M / BM; nN = N / BM; nwg = nM * nN; G = G_; c = c_; }
    __host__ __device__ bool next(int i, Unit& u) const {
        const long L = (long)i * G + c; if (L >= nwg) return false;
        int wgid = (int)L; { const int q = nwg / NXCD, r = nwg % NXCD, xcd = wgid % NXCD, off = wgid / NXCD; wgid = (xcd < r ? xcd * (q + 1) : r * (q + 1) + (xcd - r) * q) + off; }
        const int nig = WGM * nN, gid = wgid / nig, fm = gid * WGM, gsz = (nM - fm) < WGM ? (nM - fm) : WGM;
        u.pm = fm + ((wgid % nig) % gsz); u.pn = (wgid % nig) / gsz; return true;
    }
    __device__ __forceinline__ void a_ready(const Unit&) const {}
    __device__ __forceinline__ void done(const Unit&) const {}
};

__device__ __forceinline__ unsigned cvt_pk_bf16(float lo, float hi) { unsigned r; asm volatile("v_cvt_pk_bf16_f32 %0, %1, %2" : "=v"(r) : "v"(lo), "v"(hi)); return r; }

struct EpiIn {
    static constexpr bool PERM = true, AFTER_DRAIN = false, MIDK = false;
    bf16_t *Q, *K, *V, *AU, *XBC; float* out; const float *qnw, *knw;
    __device__ __forceinline__ void mid(f32x4 (&)[2][2][4][2], const Unit&, int, int, int, int, int) const {}
    __device__ __forceinline__ void operator()(const f32x4 (&acc)[2][2][4][2], const Unit& u, int wr, int wc, int fr, int fq) const {
        const int pn = u.pn;
        const int rowb = u.pm * BM + wr * 64 + fr;
        const int cl = wc * 64 + 8 * fq;
        if (pn < 8) {
            const bool isq = pn < 4; const float* nw = isq ? qnw : knw;
            f32x4 w[2][2];
#pragma unroll
            for (int bj = 0; bj < 2; ++bj)
#pragma unroll
                for (int n = 0; n < 2; ++n) w[bj][n] = *(const f32x4*)(nw + 8 * fq + 32 * bj + 4 * n);
            bf16_t* dstb = (isq ? Q : K) + (pn & 3) * 256 + cl;
#pragma unroll
            for (int ai = 0; ai < 2; ++ai)
#pragma unroll
                for (int m = 0; m < 4; ++m) {
                    const int r = rowb + ai * HALF + m * 16;
                    float ss = 0.f;
#pragma unroll
                    for (int bj = 0; bj < 2; ++bj)
#pragma unroll
                        for (int n = 0; n < 2; ++n) { const f32x4 v = acc[ai][bj][m][n]; ss += (v[0] * v[0] + v[1] * v[1]) + (v[2] * v[2] + v[3] * v[3]); }
                    ss += __shfl_xor(ss, 16); ss += __shfl_xor(ss, 32);
                    const float sc = rsqrtf(ss * (1.f / 64.f) + EPS), scs = isq ? sc * QSCALE : sc;
                    float* f32dst = nullptr;
                    if (!isq) { if (r < NTOK) { const int t = r & (SEQ - 1); if (t >= SEQ - WIN) f32dst = out + O_KP + ((size_t)((r >> 13) * WIN + t - (SEQ - WIN))) * DM + (pn & 3) * 256 + cl; }
                                else if (r < NROWS) f32dst = out + O_KS + (size_t)(r - NTOK) * DM + (pn & 3) * 256 + cl; }
#pragma unroll
                    for (int bj = 0; bj < 2; ++bj) {
                        const f32x4 a0 = acc[ai][bj][m][0] * w[bj][0], a1 = acc[ai][bj][m][1] * w[bj][1];
                        u32x4 o; o.x = cvt_pk_bf16(a0[0] * scs, a0[1] * scs); o.y = cvt_pk_bf16(a0[2] * scs, a0[3] * scs); o.z = cvt_pk_bf16(a1[0] * scs, a1[1] * scs); o.w = cvt_pk_bf16(a1[2] * scs, a1[3] * scs);
                        *(u32x4*)(dstb + (size_t)r * DM + 32 * bj) = o;
                        if (f32dst) { *(f32x4*)(f32dst + 32 * bj) = a0 * sc; *(f32x4*)(f32dst + 32 * bj + 4) = a1 * sc; }
                    }
                }
        } else if (pn < 12) {
            bf16_t* dstb = V + (pn & 3) * 256 + cl;
#pragma unroll
            for (int ai = 0; ai < 2; ++ai)
#pragma unroll
                for (int m = 0; m < 4; ++m) {
                    const int r = rowb + ai * HALF + m * 16;
                    float* f32dst = nullptr;
                    if (r < NTOK) { const int t = r & (SEQ - 1); if (t >= SEQ - WIN) f32dst = out + O_VP + ((size_t)((r >> 13) * WIN + t - (SEQ - WIN))) * DM + (pn & 3) * 256 + cl; }
                    else if (r < NROWS) f32dst = out + O_VS + (size_t)(r - NTOK) * DM + (pn & 3) * 256 + cl;
#pragma unroll
                    for (int bj = 0; bj < 2; ++bj) {
                        const f32x4 a0 = acc[ai][bj][m][0], a1 = acc[ai][bj][m][1];
                        u32x4 o; o.x = cvt_pk_bf16(a0[0], a0[1]); o.y = cvt_pk_bf16(a0[2], a0[3]); o.z = cvt_pk_bf16(a1[0], a1[1]); o.w = cvt_pk_bf16(a1[2], a1[3]);
                        *(u32x4*)(dstb + (size_t)r * DM + 32 * bj) = o;
                        if (f32dst) { *(f32x4*)(f32dst + 32 * bj) = a0; *(f32x4*)(f32dst + 32 * bj + 4) = a1; }
                    }
                }
        } else if (pn < 20) {
            bf16_t* dstb = AU + (pn < 16 ? 1024 : 0) + (pn & 3) * 256 + cl;
#pragma unroll
            for (int ai = 0; ai < 2; ++ai)
#pragma unroll
                for (int m = 0; m < 4; ++m) {
                    const int r = rowb + ai * HALF + m * 16;
#pragma unroll
                    for (int bj = 0; bj < 2; ++bj) {
                        f32x4 a0 = acc[ai][bj][m][0], a1 = acc[ai][bj][m][1];
#pragma unroll
                        for (int i = 0; i < 4; ++i) { a0[i] = silu_fast(a0[i]); a1[i] = silu_fast(a1[i]); }
                        u32x4 o; o.x = cvt_pk_bf16(a0[0], a0[1]); o.y = cvt_pk_bf16(a0[2], a0[3]); o.z = cvt_pk_bf16(a1[0], a1[1]); o.w = cvt_pk_bf16(a1[2], a1[3]);
                        *(u32x4*)(dstb + (size_t)r * 2048 + 32 * bj) = o;
                    }
                }
        } else {
            const int cb = (pn - 20) * 256 + cl;
            bf16_t* dstb = XBC + cb;
#pragma unroll
            for (int ai = 0; ai < 2; ++ai)
#pragma unroll
                for (int m = 0; m < 4; ++m) {
                    const int r = rowb + ai * HALF + m * 16;
                    float* f32dst = nullptr;
                    if (r < NTOK) { const int t = r & (SEQ - 1); if (t >= SEQ - 3) f32dst = out + O_CP + ((size_t)((r >> 13) * 3 + t - (SEQ - 3))) * CONVD + cb; }
                    else if (r < NROWS) f32dst = out + O_CS + ((size_t)(r - NTOK) * 3 + 2) * CONVD + cb;
#pragma unroll
                    for (int bj = 0; bj < 2; ++bj) {
                        const f32x4 a0 = acc[ai][bj][m][0], a1 = acc[ai][bj][m][1];
                        u32x4 o; o.x = cvt_pk_bf16(a0[0], a0[1]); o.y = cvt_pk_bf16(a0[2], a0[3]); o.z = cvt_pk_bf16(a1[0], a1[1]); o.w = cvt_pk_bf16(a1[2], a1[3]);
                        *(u32x4*)(dstb + (size_t)r * CONVD + 32 * bj) = o;
                        if (f32dst) { *(f32x4*)(f32dst + 32 * bj) = a0; *(f32x4*)(f32dst + 32 * bj + 4) = a1; }
                    }
                }
        }
    }
};

struct EpiOut {
    static constexpr bool PERM = true, AFTER_DRAIN = false, MIDK = true;
    const float* xp; const float* xs; const PG8_LAS float* rs; float* out;
    __device__ __forceinline__ void mid(f32x4 (&acc)[2][2][4][2], const Unit& u, int ui, int wr, int wc, int fr, int fq) const {
        const PG8_LAS float* rp = rs + ui * 256 + wr * 64 + fr;
#pragma unroll
        for (int ai = 0; ai < 2; ++ai)
#pragma unroll
            for (int m = 0; m < 4; ++m) {
                const float r = rp[ai * HALF + m * 16];
#pragma unroll
                for (int bj = 0; bj < 2; ++bj)
#pragma unroll
                    for (int n = 0; n < 2; ++n) acc[ai][bj][m][n] *= r;
            }
    }
    __device__ __forceinline__ void operator()(const f32x4 (&acc)[2][2][4][2], const Unit& u, int wr, int wc, int fr, int fq) const {
        const int rowb = u.pm * BM + wr * 64 + fr, col = u.pn * BM + wc * 64 + 8 * fq;
#pragma unroll
        for (int ai = 0; ai < 2; ++ai)
#pragma unroll
            for (int m = 0; m < 4; ++m) {
                const int r = rowb + ai * HALF + m * 16;
                if (r >= NROWS) continue;
                const float* xr = (r < NTOK ? xp + (size_t)r * DM : xs + (size_t)(r - NTOK) * DM) + col;
                float* yr = out + (r < NTOK ? O_YP + (size_t)r * DM : O_YS + (size_t)(r - NTOK) * DM) + col;
#pragma unroll
                for (int bj = 0; bj < 2; ++bj) {
                    *(f32x4*)(yr + 32 * bj) = *(const f32x4*)(xr + 32 * bj) + acc[ai][bj][m][0];
                    *(f32x4*)(yr + 32 * bj + 4) = *(const f32x4*)(xr + 32 * bj + 4) + acc[ai][bj][m][1];
                }
            }
    }
};

template <class Epi, class Sched, bool ALIGN_EPI = false, bool SP2 = false>
__device__ __forceinline__ void gemm_phase(PG8_LAS unsigned char* lds, const Gemm g, const Sched& S, const Epi& E) {
    const int tid = threadIdx.x, wid = __builtin_amdgcn_readfirstlane(tid >> 6), lane = tid & 63, wr = wid >> 2, wc = wid & 3, fr = lane & 15, fq = lane >> 4;
    const int K = g.K, nt = K / BK;
    unsigned voffA[2], voffB[2];
#pragma unroll
    for (int i = 0; i < 2; ++i) { int R, C; stage_rc(tid * 16 + i * 8192, R, C); const int Rb = Epi::PERM ? ((R & ~31) + perm32(R & 31)) : R;
        voffA[i] = (unsigned)(R * K + C) * 2u; voffB[i] = (unsigned)(Rb * K + C) * 2u; }
    const size_t kstep = (size_t)(BK * 2);
    const size_t hstep = (size_t)HALF * K * 2;
    const size_t tstep = 2 * hstep;
    const unsigned ldsw = (unsigned)wid * 1024u;
    const int aoff = lds_byte(wr * 64 + fr, fq * 8), boff = lds_byte(wc * 32 + fr, fq * 8);
#define PG8_SA(b, h) (((b) * 2 + (h)) * HTB)
#define PG8_SB(b, h) ((4 + (b) * 2 + (h)) * HTB)
#define PG8_STAGE(bufoff, gbase, voff) do { _Pragma("unroll") for (int _i = 0; _i < 2; ++_i) \
        __builtin_amdgcn_global_load_lds((const unsigned*)((const char*)(gbase) + (voff)[_i]), (PG8_LAS unsigned*)(lds + (bufoff) + ldsw + _i * 8192), 16, 0, 0); } while (0)
#define PG8_LDA(dst, b, h) do { _Pragma("unroll") for (int m = 0; m < 4; ++m) _Pragma("unroll") for (int k = 0; k < 2; ++k) dst[m][k] = *(const PG8_LAS bf16x8*)(lds + PG8_SA(b, h) + aoff + m * 2048 + k * 1024); } while (0)
#define PG8_LDB(dst, b, h) do { _Pragma("unroll") for (int n = 0; n < 2; ++n) _Pragma("unroll") for (int k = 0; k < 2; ++k) dst[n][k] = *(const PG8_LAS bf16x8*)(lds + PG8_SB(b, h) + boff + n * 2048 + k * 1024); } while (0)
#define PG8_MMA(ai, bj, At, Bt) do { __builtin_amdgcn_s_setprio(1); _Pragma("unroll") for (int m = 0; m < 4; ++m) _Pragma("unroll") for (int n = 0; n < 2; ++n) _Pragma("unroll") for (int k = 0; k < 2; ++k) \
        acc[ai][bj][m][n] = __builtin_amdgcn_mfma_f32_16x16x32_bf16(Bt[n][k], At[m][k], acc[ai][bj][m][n], 0, 0, 0); __builtin_amdgcn_s_setprio(0); } while (0)
#define PG8_WAIT_V(n) asm volatile("s_waitcnt vmcnt(" #n ")" ::: "memory")
#define PG8_WAIT_L(n) asm volatile("s_waitcnt lgkmcnt(" #n ")" ::: "memory")
#define PG8_BAR __builtin_amdgcn_s_barrier()
#define PG8_SCHED __builtin_amdgcn_sched_barrier(0)
    Unit cur, nxt; int ui = 0;
    if (!S.next(0, cur)) return;
    f32x4 acc[2][2][4][2];
#pragma unroll
    for (int a = 0; a < 2; ++a)
#pragma unroll
        for (int b = 0; b < 2; ++b)
#pragma unroll
            for (int m = 0; m < 4; ++m)
#pragma unroll
                for (int n = 0; n < 2; ++n) acc[a][b][m][n] = (f32x4){0.f, 0.f, 0.f, 0.f};
    bf16x8 At[4][2], B0[2][2], B1[2][2];
    const char* cA = (const char*)g.A + (size_t)cur.pm * tstep; const char* cB = (const char*)g.Bt + (size_t)cur.pn * tstep;
    S.a_ready(cur);
    if constexpr (SP2) {
        PG8_STAGE(PG8_SB(0, 0), cB, voffB); PG8_STAGE(PG8_SB(0, 1), cB + hstep, voffB); PG8_STAGE(PG8_SA(0, 0), cA, voffA); PG8_STAGE(PG8_SA(0, 1), cA + hstep, voffA);
        if (wr == 1) PG8_BAR;
        PG8_WAIT_V(2); PG8_BAR;
        PG8_STAGE(PG8_SB(1, 0), cB + kstep, voffB); PG8_STAGE(PG8_SA(1, 0), cA + kstep, voffA); PG8_STAGE(PG8_SB(1, 1), cB + hstep + kstep, voffB);
        PG8_WAIT_V(6); PG8_BAR;
    } else {
        PG8_STAGE(PG8_SB(0, 0), cB, voffB); PG8_STAGE(PG8_SA(0, 0), cA, voffA); PG8_STAGE(PG8_SB(0, 1), cB + hstep, voffB); PG8_STAGE(PG8_SA(0, 1), cA + hstep, voffA);
        if (wr == 1) PG8_BAR;
        PG8_WAIT_V(4); PG8_BAR;
        PG8_STAGE(PG8_SB(1, 0), cB + kstep, voffB); PG8_STAGE(PG8_SA(1, 0), cA + kstep, voffA); PG8_STAGE(PG8_SB(1, 1), cB + hstep + kstep, voffB);
        PG8_WAIT_V(6); PG8_BAR;
    }
    for (;;) {
        const bool has_next = S.next(ui + 1, nxt);
        const char* nA = has_next ? (const char*)g.A + (size_t)nxt.pm * tstep : cA; const char* nB = has_next ? (const char*)g.Bt + (size_t)nxt.pn * tstep : cB;
        for (int t = 0; t < nt; t += 2) {
            const bool last = (t == nt - 2);
            if constexpr (Epi::MIDK) { if (t == (nt >> 1)) E.mid(acc, cur, ui, wr, wc, fr, fq); }
            const char* a1 = cA + (size_t)(t + 1) * kstep;
            const char* a2 = last ? nA : cA + (size_t)(t + 2) * kstep; const char* b2 = last ? nB : cB + (size_t)(t + 2) * kstep;
            const char* a3 = a2 + kstep; const char* b3 = b2 + kstep;
            if (last && has_next) S.a_ready(nxt);
            if constexpr (SP2) {
            PG8_LDB(B0, 0, 0); PG8_LDB(B1, 0, 1); PG8_SCHED; PG8_LDA(At, 0, 0); PG8_STAGE(PG8_SA(1, 1), a1 + hstep, voffA);
            PG8_WAIT_V(8); PG8_WAIT_L(0); PG8_BAR; PG8_MMA(0, 0, At, B0); PG8_MMA(0, 1, At, B1); PG8_BAR; PG8_SCHED;
            PG8_LDA(At, 0, 1); PG8_STAGE(PG8_SB(0, 0), b2, voffB); PG8_STAGE(PG8_SB(0, 1), b2 + hstep, voffB); PG8_STAGE(PG8_SA(0, 0), a2, voffA);
            PG8_WAIT_V(8); PG8_WAIT_L(0); PG8_BAR; PG8_MMA(1, 0, At, B0); PG8_MMA(1, 1, At, B1); PG8_BAR; PG8_SCHED;
            PG8_LDB(B0, 1, 0); PG8_LDB(B1, 1, 1); PG8_SCHED; PG8_LDA(At, 1, 0); PG8_STAGE(PG8_SA(0, 1), a2 + hstep, voffA);
            PG8_WAIT_V(8); PG8_WAIT_L(0); PG8_BAR; PG8_MMA(0, 0, At, B0); PG8_MMA(0, 1, At, B1); PG8_BAR; PG8_SCHED;
            PG8_LDA(At, 1, 1); PG8_STAGE(PG8_SB(1, 0), b3, voffB); PG8_STAGE(PG8_SB(1, 1), b3 + hstep, voffB); PG8_STAGE(PG8_SA(1, 0), a3, voffA);
            PG8_WAIT_V(8); PG8_WAIT_L(0); PG8_BAR; PG8_MMA(1, 0, At, B0); PG8_MMA(1, 1, At, B1); PG8_BAR; PG8_SCHED;
            } else {
            PG8_LDB(B0, 0, 0); PG8_SCHED; PG8_LDA(At, 0, 0); PG8_STAGE(PG8_SA(1, 1), a1 + hstep, voffA);
            PG8_WAIT_L(8); PG8_BAR; PG8_WAIT_L(0); PG8_MMA(0, 0, At, B0); PG8_BAR; PG8_SCHED;
            PG8_LDB(B1, 0, 1); PG8_STAGE(PG8_SB(0, 0), b2, voffB);
            PG8_BAR; PG8_WAIT_L(0); PG8_MMA(0, 1, At, B1); PG8_BAR;
            PG8_LDA(At, 0, 1); PG8_STAGE(PG8_SA(0, 0), a2, voffA);
            PG8_BAR; PG8_WAIT_L(0); PG8_MMA(1, 0, At, B0); PG8_BAR; PG8_SCHED;
            PG8_STAGE(PG8_SB(0, 1), b2 + hstep, voffB);
            PG8_WAIT_V(6); PG8_BAR; PG8_MMA(1, 1, At, B1); PG8_BAR;
            PG8_LDB(B0, 1, 0); PG8_SCHED; PG8_LDA(At, 1, 0); PG8_STAGE(PG8_SA(0, 1), a2 + hstep, voffA);
            PG8_WAIT_L(8); PG8_BAR; PG8_WAIT_L(0); PG8_MMA(0, 0, At, B0); PG8_BAR; PG8_SCHED;
            PG8_LDB(B1, 1, 1); PG8_STAGE(PG8_SB(1, 0), b3, voffB);
            PG8_BAR; PG8_WAIT_L(0); PG8_MMA(0, 1, At, B1); PG8_BAR;
            PG8_LDA(At, 1, 1); PG8_STAGE(PG8_SA(1, 0), a3, voffA);
            PG8_BAR; PG8_WAIT_L(0); PG8_MMA(1, 0, At, B0); PG8_BAR; PG8_SCHED;
            PG8_STAGE(PG8_SB(1, 1), b3 + hstep, voffB);
            PG8_WAIT_V(6); PG8_BAR; PG8_MMA(1, 1, At, B1); PG8_BAR;
            }
        }
        if constexpr (ALIGN_EPI) { if (wr == 0) PG8_BAR; }
        if constexpr (!Epi::AFTER_DRAIN) { E(acc, cur, wr, wc, fr, fq); S.done(cur); }
        if (!has_next) break;
#pragma unroll
        for (int a = 0; a < 2; ++a)
#pragma unroll
            for (int b = 0; b < 2; ++b)
#pragma unroll
                for (int m = 0; m < 4; ++m)
#pragma unroll
                    for (int n = 0; n < 2; ++n) acc[a][b][m][n] = (f32x4){0.f, 0.f, 0.f, 0.f};
        cur = nxt; cA = nA; cB = nB; ++ui;
        if constexpr (ALIGN_EPI) { if (wr == 1) PG8_BAR; }
    }
    PG8_WAIT_V(0);
    if constexpr (!ALIGN_EPI) { if (wr == 0) PG8_BAR; }
    PG8_BAR;
    if constexpr (Epi::AFTER_DRAIN) { E.fused(acc, cur, wr, wc, fr, fq, lds, wid, lane); S.done(cur); }
#undef PG8_SA
#undef PG8_SB
#undef PG8_STAGE
#undef PG8_LDA
#undef PG8_LDB
#undef PG8_MMA
#undef PG8_WAIT_V
#undef PG8_WAIT_L
#undef PG8_BAR
#undef PG8_SCHED
}
}
#define GAS __attribute__((address_space(1)))
#define LAS __attribute__((address_space(3)))
typedef unsigned v4u __attribute__((ext_vector_type(4)));
typedef float f32x4 __attribute__((ext_vector_type(4)));
typedef short bf16x8 __attribute__((ext_vector_type(8)));
typedef GAS unsigned gu32;
typedef GAS unsigned long long gu64;
#define RLX_AGENT __ATOMIC_RELAXED, __HIP_MEMORY_SCOPE_AGENT
#define LDS_WAIT() asm volatile("s_waitcnt lgkmcnt(0)" ::: "memory")
#define VM_WAIT() asm volatile("s_waitcnt vmcnt(0)" ::: "memory")
__device__ __forceinline__ unsigned long long rt() { return __builtin_amdgcn_s_memrealtime(); }

#define XB_TMO      128
#define XB_XCNT(j)  (256  + 64 * (j))
#define XB_XSUB(j)  (1280 + 64 * (j))
#define XB_XGEN(j)  (2304 + 64 * (j))
#define XB_TOP      3328
#define XB_TOPGEN   3392
#define XCD_BAR_WORDS 3456
#define XB_SPIN_CAP (1u << 18)

__device__ __forceinline__ unsigned xb_ld(unsigned* p)              { return __hip_atomic_load(p, __ATOMIC_RELAXED, __HIP_MEMORY_SCOPE_AGENT); }
__device__ __forceinline__ unsigned xb_add(unsigned* p, unsigned v) { return __hip_atomic_fetch_add(p, v, __ATOMIC_RELAXED, __HIP_MEMORY_SCOPE_AGENT); }
__device__ __forceinline__ unsigned xb_xcc_id() { return (unsigned)__builtin_amdgcn_s_getreg((3 << 11) | 20) & 0xFu; }
#define XB_SPIN(cond, bar) do { unsigned _sp = 0; while (cond) { __builtin_amdgcn_s_sleep(1); \
    if ((++_sp & 255u) == 0u) { if (xb_ld(&(bar)[XB_TMO])) break; if (_sp > XB_SPIN_CAP) { atomicAdd(&(bar)[XB_TMO], 1u); break; } } } } while (0)

struct XcdBarrier {
    unsigned* bar; unsigned x;
    volatile LAS unsigned* st;
};

__device__ __forceinline__ XcdBarrier xcd_barrier_post(unsigned* bar, volatile LAS unsigned* st) {
    XcdBarrier b; b.bar = bar; b.x = xb_xcc_id(); b.st = st;
    if (threadIdx.x == 0) (void)xb_add(&bar[XB_XCNT(b.x)], 1u);
    return b;
}
__device__ __forceinline__ void xcd_barrier_complete(unsigned* bar, unsigned x, unsigned& nloc, unsigned& nx) {
    const unsigned G = gridDim.x * gridDim.y * gridDim.z;
    unsigned sum, cnt, mine, sp = 0u;
    for (;;) {
        sum = 0u; cnt = 0u; mine = 0u;
#pragma unroll
        for (unsigned j = 0; j < 16; ++j) { const unsigned c = xb_ld(&bar[XB_XCNT(j)]); sum += c; cnt += (c > 0u) ? 1u : 0u; mine = (j == x) ? c : mine; }
        if (sum == G) break;
        __builtin_amdgcn_s_sleep(1);
        if ((++sp & 255u) == 0u) { if (xb_ld(&bar[XB_TMO])) break; if (sp > XB_SPIN_CAP) { atomicAdd(&bar[XB_TMO], 1u); break; } }
    }
    nloc = mine > 0u ? mine : 1u; nx = cnt > 0u ? cnt : 1u;
}

__device__ __forceinline__ void xcd_barrier(const XcdBarrier& b) {
    asm volatile("s_waitcnt vmcnt(0)" ::: "memory");
    __syncthreads();
    if (threadIdx.x == 0) {
        unsigned* bar = b.bar;
        __builtin_amdgcn_s_waitcnt(0);
        unsigned nloc = b.st[0], nx = b.st[1];
        if (nloc == 0u) { xcd_barrier_complete(bar, b.x, nloc, nx); b.st[0] = nloc; b.st[1] = nx; }
        const unsigned old = xb_add(&bar[XB_XSUB(b.x)], 1u);
        const unsigned gen = old / nloc;
        if (old + 1u == (gen + 1u) * nloc) {
            __builtin_amdgcn_fence(__ATOMIC_RELEASE, "agent");
            asm volatile("s_waitcnt vmcnt(0)" ::: "memory");
            const unsigned og = xb_add(&bar[XB_TOP], 1u);
            const unsigned tg = og / nx;
            if (og + 1u == (tg + 1u) * nx) xb_add(&bar[XB_TOPGEN], 1u);
            else XB_SPIN(xb_ld(&bar[XB_TOPGEN]) == tg, bar);
            __builtin_amdgcn_fence(__ATOMIC_ACQUIRE, "agent");
            xb_add(&bar[XB_XGEN(b.x)], 1u);
            asm volatile("s_waitcnt vmcnt(0)" ::: "memory");
        } else {
            XB_SPIN(xb_ld(&bar[XB_XGEN(b.x)]) == gen, bar);
            __builtin_amdgcn_fence(__ATOMIC_ACQUIRE, "agent");
            asm volatile("s_waitcnt vmcnt(0)" ::: "memory");
        }
    }
    __syncthreads();
}

constexpr int NWAVES = 8;
constexpr int RING_OFF = 0, RING_BYTES = 131072;
constexpr int LDS_BYTES = 163840;
constexpr int LDSCTL_OFF = LDS_BYTES - 512, MISC_OFF = LDSCTL_OFF + 320;
constexpr int CW_BAR = 4096;
constexpr int CW_Q = 16384;
static_assert((CW_BAR + XCD_BAR_WORDS) <= CW_Q && (CW_Q + 64 * 64) * 4 <= (int)CTL_ZERO_BYTES, "CTL words inside the memset region");

struct Frame {
    LAS unsigned char* lds;
    volatile LAS unsigned* MISC;
    gu32* ctl;
    int tid, lane, wave, vcu, G;
    Ins I; float* out;
    bf16 *WinT, *WoutT, *XN, *Q, *K, *V, *AU, *XBC; float *DT, *SSQ;
};

template <class SrcF>
__device__ __forceinline__ void p0_transpose_item(SrcF src, int k0, int n0, bf16* WT, int dst_pitch, int dst_row0, int dst_k0, LAS float* scr, int lane) {
#pragma unroll 8
    for (int i = 0; i < 32; ++i) { const int kk = 2 * i + (lane >> 5); scr[kk * 33 + (lane & 31)] = src(k0 + kk, n0 + (lane & 31)); }
    LDS_WAIT(); asm volatile("" ::: "memory");
    const int c = lane & 7;
#pragma unroll
    for (int j = 0; j < 4; ++j) { const int n = (lane >> 3) + 8 * j; const LAS float* s = scr + (8 * c) * 33 + n;
        v4u o; o.x = pk2(s[0 * 33], s[1 * 33]); o.y = pk2(s[2 * 33], s[3 * 33]); o.z = pk2(s[4 * 33], s[5 * 33]); o.w = pk2(s[6 * 33], s[7 * 33]);
        *(GAS v4u*)(WT + (size_t)(dst_row0 + n) * dst_pitch + dst_k0 + 8 * c) = o; }
    LDS_WAIT(); asm volatile("" ::: "memory");
}
constexpr int P0_SCR_BYTES = 8448, WDT_OFF = NWAVES * P0_SCR_BYTES, WDT_PITCH = 20;
static_assert(WDT_OFF + 1024 * WDT_PITCH * 4 <= LDSCTL_OFF, "prologue LDS");

__device__ __forceinline__ void p0_prologue(Frame& F) {
    const Ins& I = F.I;
    LAS float* scr = (LAS float*)(F.lds + F.wave * P0_SCR_BYTES);
    LAS float* wdt = (LAS float*)(F.lds + WDT_OFF);
    const int gw = F.vcu * NWAVES + F.wave, NGW = F.G * NWAVES;
    for (int idx = F.tid; idx < 1024 * 16; idx += NWAVES * 64) {
        const int k = idx >> 4, j = idx & 15, pos = (((k >> 8) * 4 + (k & 3)) << 6) + ((k >> 2) & 63);
        wdt[pos * WDT_PITCH + j] = I.w_in[(size_t)k * NPROJ + C_DT + j] * I.norm_w[k];
    }
    constexpr int I_IN = (DM / 64) * (NMAIN / 32), I_OUT = (2048 / 64) * (DM / 32);
    for (int it = gw; it < I_IN + I_OUT; it += NGW) {
        if (it < I_IN) {
            const int nblk = NMAIN / 32, kb = it / nblk, nb = it % nblk, k0 = 64 * kb, n0 = 32 * nb;
            p0_transpose_item([&](int k, int n) { return I.w_in[(size_t)k * NPROJ + n] * I.norm_w[k]; }, k0, n0, F.WinT, DM, (n0 & ~255) + vrow_of_col(n0 & 255), k0, scr, F.lane);
        } else {
            const int r = it - I_IN, nblk = DM / 32, kb = r / nblk, nb = r % nblk, k0 = 64 * kb, n0 = 32 * nb;
            p0_transpose_item([&](int k, int n) { return I.w_out[(size_t)k * DM + n] * (k >= 1024 ? I.ssd_norm_w[k - 1024] : 1.f); }, k0, n0, F.WoutT, 2048, (n0 & ~255) + vrow_of_col(n0 & 255), (k0 + 1024) & 2047, scr, F.lane);
        }
    }
    __syncthreads();
    for (int rp = gw; rp < NROWS / 2; rp += NGW) {
        f32x4 v[2][4]; float rstd[2];
#pragma unroll
        for (int q = 0; q < 2; ++q) {
            const GAS f32x4* xr = (const GAS f32x4*)xrow(I, 2 * rp + q) + F.lane; float s = 0.f;
#pragma unroll
            for (int j = 0; j < 4; ++j) { v[q][j] = xr[64 * j]; s += (v[q][j].x * v[q][j].x + v[q][j].y * v[q][j].y) + (v[q][j].z * v[q][j].z + v[q][j].w * v[q][j].w); }
            rstd[q] = rsqrtf(wave_sum(s) * (1.f / DM) + EPS);
            GAS unsigned long long* o8 = (GAS unsigned long long*)(F.XN + (size_t)(2 * rp + q) * DM) + F.lane;
#pragma unroll
            for (int j = 0; j < 4; ++j) o8[64 * j] = (unsigned long long)pk2(v[q][j].x * rstd[q], v[q][j].y * rstd[q]) | ((unsigned long long)pk2(v[q][j].z * rstd[q], v[q][j].w * rstd[q]) << 32);
        }
        float a[32];
#pragma unroll
        for (int i = 0; i < 32; ++i) a[i] = 0.f;
#pragma unroll
        for (int j = 0; j < 4; ++j)
#pragma unroll
            for (int e = 0; e < 4; ++e) {
                const LAS f32x4* wp = (const LAS f32x4*)(wdt + ((j * 4 + e) * 64 + F.lane) * WDT_PITCH);
                const float x0 = v[0][j][e], x1 = v[1][j][e];
#pragma unroll
                for (int c4 = 0; c4 < 4; ++c4) { const f32x4 w = wp[c4];
#pragma unroll
                    for (int i = 0; i < 4; ++i) { a[c4 * 4 + i] += x0 * w[i]; a[16 + c4 * 4 + i] += x1 * w[i]; } }
                asm volatile("" ::: "memory");
            }
#define P0_HALVE(N, X) { const bool up = (F.lane & (X)) != 0; _Pragma("unroll") for (int i = 0; i < (N); ++i) { const float keep = up ? a[i + (N)] : a[i], send = up ? a[i] : a[i + (N)]; a[i] = keep + __shfl_xor(send, (X)); } }
        P0_HALVE(16, 32) P0_HALVE(8, 16) P0_HALVE(4, 8) P0_HALVE(2, 4) P0_HALVE(1, 2)
#undef P0_HALVE
        float tot = a[0] + __shfl_xor(a[0], 1);
        const int idx = F.lane >> 1, q = idx >> 4, c = idx & 15;
        tot = tot * (q ? rstd[1] : rstd[0]) + I.dt_bias[c];
        if ((F.lane & 1) == 0) F.DT[(size_t)(2 * rp + q) * 16 + c] = softplus_f(tot);
    }
    for (int r = NROWS + gw; r < MROWS; r += NGW) { GAS v4u* o = (GAS v4u*)(F.XN + (size_t)r * DM) + F.lane; o[0] = (v4u){0u, 0u, 0u, 0u}; o[64] = (v4u){0u, 0u, 0u, 0u}; }
    for (int i = (F.vcu * NWAVES * 64 + F.tid); i < DB * 2 * CONVD; i += F.G * NWAVES * 64) {
        const int c = i % CONVD, rr = i / CONVD, j = rr & 1, b = rr >> 1;
        F.out[O_CS + ((size_t)b * 3 + j) * CONVD + c] = I.sconv[((size_t)b * 3 + j + 1) * CONVD + c];
    }
}

namespace att {
typedef float f32x16 __attribute__((ext_vector_type(16)));
typedef short v4i16_t __attribute__((ext_vector_type(4)));
typedef unsigned u32x4 __attribute__((ext_vector_type(4)));
constexpr int SPAN = 256, NSPAN = SEQ / SPAN, NUNITS = NB * NH * NSPAN;
constexpr int OACC_OFF = 0, LACC_OFF = 65536, LUT_OFF = 66560, VST_OFF = 68608, VST_BYTES = 4096, ATT_LDS_END = VST_OFF + NWAVES * VST_BYTES;
static_assert(ATT_LDS_END <= LDSCTL_OFF, "attention LDS");
__device__ __forceinline__ int crow(int r, int hi) { return (r & 3) + 8 * (r >> 2) + 4 * hi; }

template <int NQ>
__device__ __forceinline__ void item(const bf16* Qb, const bf16* Kb, const bf16* Vb, int tq0, int d, int pat, int toff, LAS unsigned char* lds, int wave, int lane) {
    const int c = lane & 31, hi = lane >> 5;
    LAS unsigned char* vst = lds + VST_OFF + wave * VST_BYTES;
    const LAS float* lut = (const LAS float*)(lds + LUT_OFF) + pat * 129;
    bf16x8 qf[4];
    { const bf16* qp = Qb + (size_t)(tq0 + (NQ == 32 ? c : (c & 15)) * d) * DM + 8 * hi;
#pragma unroll
      for (int ks = 0; ks < 4; ++ks) qf[ks] = *(const bf16x8*)(qp + 16 * ks); }
    f32x16 o0 = {}, o1 = {};
    float lsum = 0.f;
    const int vtr = ((lane >> 4) & 1) * 32 + (lane & 3) * 8 + (4 * hi + ((lane & 15) >> 2)) * 64;
    bf16x8 kf[4], vr[4];
#define ATT_LOAD_TILE(KT) do { \
        { int tk_ = tq0 + (-128 + 32 * (KT) + c) * d; tk_ = tk_ < 0 ? 0 : tk_; const bf16* kp_ = Kb + (size_t)tk_ * DM + 8 * hi; \
          _Pragma("unroll") for (int ks = 0; ks < 4; ++ks) kf[ks] = *(const bf16x8*)(kp_ + 16 * ks); } \
        _Pragma("unroll") for (int pc = 0; pc < 4; ++pc) { int tk_ = tq0 + (-128 + 32 * (KT) + 16 * (pc & 1) + (lane >> 2)) * d; tk_ = tk_ < 0 ? 0 : tk_; \
            vr[pc] = *(const bf16x8*)(Vb + (size_t)tk_ * DM + 32 * (pc >> 1) + 8 * (lane & 3)); } } while (0)
    ATT_LOAD_TILE(0);
#pragma unroll 1
    for (int kt = 0; kt < 5; ++kt) {
        f32x16 st = {};
#pragma unroll
        for (int ks = 0; ks < 4; ++ks) st = __builtin_amdgcn_mfma_f32_32x32x16_bf16(kf[ks], qf[ks], st, 0, 0, 0);
#pragma unroll
        for (int pc = 0; pc < 4; ++pc) *(LAS bf16x8*)(vst + pc * 1024 + lane * 16) = vr[pc];
        if (kt < 4) ATT_LOAD_TILE(kt + 1);
        const int relb = c + 128 - 32 * kt - 4 * hi, tkb = tq0 + (-128 + 32 * kt + 4 * hi) * d;
#pragma unroll
        for (int r = 0; r < 16; ++r) {
            const int kk = (r & 3) + 8 * (r >> 2), rel = relb - kk;
            const bool valid = (rel >= 0) && (rel <= 128) && (tkb + kk * d >= 0);
            const float bias = lut[valid ? rel : 0];
            const float p = valid ? __builtin_amdgcn_exp2f(st[r] + bias) : 0.f;
            st[r] = p; lsum += p;
        }
        u32x4 pw0, pw1;
        pw0.x = pg8::cvt_pk_bf16(st[0], st[1]); pw0.y = pg8::cvt_pk_bf16(st[2], st[3]); pw0.z = pg8::cvt_pk_bf16(st[4], st[5]); pw0.w = pg8::cvt_pk_bf16(st[6], st[7]);
        pw1.x = pg8::cvt_pk_bf16(st[8], st[9]); pw1.y = pg8::cvt_pk_bf16(st[10], st[11]); pw1.z = pg8::cvt_pk_bf16(st[12], st[13]); pw1.w = pg8::cvt_pk_bf16(st[14], st[15]);
        const bf16x8 pa0 = __builtin_bit_cast(bf16x8, pw0), pa1 = __builtin_bit_cast(bf16x8, pw1);
#pragma unroll
        for (int dh = 0; dh < 2; ++dh)
#pragma unroll
            for (int s = 0; s < 2; ++s) {
                const LAS unsigned char* vp = vst + (dh * 2 + s) * 1024 + vtr;
                const v4i16_t lo = __builtin_amdgcn_ds_read_tr16_b64_v4i16((LAS v4i16_t*)vp), hh = __builtin_amdgcn_ds_read_tr16_b64_v4i16((LAS v4i16_t*)(vp + 512));
                const bf16x8 vb = (bf16x8){lo[0], lo[1], lo[2], lo[3], hh[0], hh[1], hh[2], hh[3]};
                if (dh == 0) o0 = __builtin_amdgcn_mfma_f32_32x32x16_bf16(s == 0 ? pa0 : pa1, vb, o0, 0, 0, 0);
                else         o1 = __builtin_amdgcn_mfma_f32_32x32x16_bf16(s == 0 ? pa0 : pa1, vb, o1, 0, 0, 0);
            }
    }
    lsum += __shfl_xor(lsum, 32);
    LAS float* oacc = (LAS float*)(lds + OACC_OFF); LAS float* lacc = (LAS float*)(lds + LACC_OFF);
    if (hi == 0 && c < NQ) __hip_atomic_fetch_add(lacc + toff + c * d, lsum, __ATOMIC_RELAXED, __HIP_MEMORY_SCOPE_WORKGROUP);
#pragma unroll
    for (int r = 0; r < (NQ == 32 ? 16 : 8); ++r) {
        const int q = crow(r, hi); LAS float* row = oacc + (toff + q * d) * 64 + c;
        __hip_atomic_fetch_add(row, o0[r], __ATOMIC_RELAXED, __HIP_MEMORY_SCOPE_WORKGROUP);
        __hip_atomic_fetch_add(row + 32, o1[r], __ATOMIC_RELAXED, __HIP_MEMORY_SCOPE_WORKGROUP);
    }
}

__device__ __forceinline__ void unit(Frame& F, int uidx) {
    const int span = uidx % NSPAN, bh = uidx / NSPAN, h = bh % NH, b = bh / NH, t0 = span * SPAN;
    LAS unsigned char* lds = F.lds;
    LAS float* oacc = (LAS float*)(lds + OACC_OFF); LAS float* lacc = (LAS float*)(lds + LACC_OFF); LAS float* lut = (LAS float*)(lds + LUT_OFF);
    for (int i = F.tid; i < (SPAN * 64 + SPAN) / 4; i += NWAVES * 64) ((LAS f32x4*)oacc)[i] = (f32x4){0.f, 0.f, 0.f, 0.f};
    if (F.tid < 387) { const int pat = F.tid / 129, rel = F.tid - pat * 129, d = pat == 0 ? 1 : (pat == 1 ? 4 : 16); lut[F.tid] = F.I.rel_bias[t5_bucket(rel * d) * NH + h] * LOG2E; }
    __syncthreads();
    const size_t boff = (size_t)b * SEQ * DM + h * HD;
    const bf16 *Qb = F.Q + boff, *Kb = F.K + boff, *Vb = F.V + boff;
    const int w = F.wave;
    item<32>(Qb, Kb, Vb, t0 + 32 * w, 1, 0, 32 * w, lds, w, F.lane);
    __builtin_amdgcn_sched_barrier(0);
    item<32>(Qb, Kb, Vb, t0 + (w & 3) + 128 * (w >> 2), 4, 1, (w & 3) + 128 * (w >> 2), lds, w, F.lane);
    __builtin_amdgcn_sched_barrier(0);
    item<16>(Qb, Kb, Vb, t0 + w, 16, 2, w, lds, w, F.lane);
    __builtin_amdgcn_sched_barrier(0);
    item<16>(Qb, Kb, Vb, t0 + w + 8, 16, 2, w + 8, lds, w, F.lane);
    __syncthreads();
    bf16* ap = F.AU + ((size_t)b * SEQ + t0 + 32 * w) * 2048 + 1024 + h * HD + F.lane;
#pragma unroll 4
    for (int i = 0; i < 32; ++i) {
        const float o = oacc[(32 * w + i) * 64 + F.lane], l = lacc[32 * w + i];
        bf16* gp = ap + (size_t)i * 2048;
        *gp = (bf16)f2bf(o * __builtin_amdgcn_rcpf(l) * bf2f(*gp));
    }
    __syncthreads();
}

}

namespace ssd {
typedef float f32x16 __attribute__((ext_vector_type(16)));
typedef short v4i16_t __attribute__((ext_vector_type(4)));
typedef unsigned u32x2 __attribute__((ext_vector_type(2)));
constexpr int PITCH = 272;
constexpr int BT_OFF = 0, CT_OFF = 34816, G_OFF = 69632, HB_OFF = 104448, XD_OFF = 121856, XH_OFF = 138240, ACS_OFF = 154624, DTL_OFF = ACS_OFF + 512, SSQL_OFF = DTL_OFF + 512, SSD_LDS_END = SSQL_OFF + 512;
static_assert(SSD_LDS_END <= LDSCTL_OFF, "SSD LDS");
__device__ __forceinline__ int crow(int r, int hi) { return (r & 3) + 8 * (r >> 2) + 4 * hi; }
__device__ __forceinline__ bf16x8 trfrag(const LAS unsigned char* p0, const LAS unsigned char* p1) {
    const v4i16_t lo = __builtin_amdgcn_ds_read_tr16_b64_v4i16((LAS v4i16_t*)p0), hh = __builtin_amdgcn_ds_read_tr16_b64_v4i16((LAS v4i16_t*)p1);
    return (bf16x8){lo[0], lo[1], lo[2], lo[3], hh[0], hh[1], hh[2], hh[3]};
}

__device__ __forceinline__ void chain(Frame& F, int bh) {
    const Ins& I = F.I;
    const int b = bh >> 4, hd = bh & 15, grp = hd >> 3;
    const int tid = F.tid, lane = F.lane, w = F.wave, c = lane & 31, hi = lane >> 5;
    LAS unsigned char* lds = F.lds;
    LAS float* acs = (LAS float*)(lds + ACS_OFF); LAS float* dtl = (LAS float*)(lds + DTL_OFF); LAS float* ssql = (LAS float*)(lds + SSQL_OFF);
    const float A = -__expf(I.a_log[hd]), dsk = I.d_skip[hd];
    const size_t row0 = (size_t)b * SEQ;
    for (int i = tid; i < 17408 / 16; i += NWAVES * 64) ((LAS v4u*)(lds + HB_OFF))[i] = (v4u){0u, 0u, 0u, 0u};
    f32x16 hacc = {};
    const int pt = w & 1, jt = w >> 1;
    const int q4 = (lane & 15) >> 2, odd = (lane >> 4) & 1, p4 = lane & 3;
    const int xtr = (8 * hi + q4) * 64 + (16 * odd + 4 * p4) * 2;
#pragma unroll 1
    for (int ch = 0; ch < SEQ / 128; ++ch) {
        const int t0 = ch * 128;
        if (w == 0) {
            if (ch > 0) { F.SSQ[(row0 + t0 - 128 + lane) * 16 + hd] = ssql[lane]; F.SSQ[(row0 + t0 - 64 + lane) * 16 + hd] = ssql[64 + lane]; }
            const float d0 = F.DT[(row0 + t0 + 2 * lane) * 16 + hd], d1 = F.DT[(row0 + t0 + 2 * lane + 1) * 16 + hd];
            const float v0 = d0 * A, v1 = d1 * A; float s = v0 + v1;
#pragma unroll
            for (int o = 1; o < 64; o <<= 1) { const float t = __shfl_up(s, o); if (lane >= o) s += t; }
            acs[2 * lane] = s - v1; acs[2 * lane + 1] = s; dtl[2 * lane] = d0; dtl[2 * lane + 1] = d1; ssql[lane] = 0.f; ssql[64 + lane] = 0.f;
        }
        __syncthreads();
        const float aend = acs[127];
        for (int task = tid; task < 640; task += NWAVES * 64) {
            const int cg = task % 40, rr = task / 40, s0 = 8 * rr;
            const int chn = cg < 8 ? hd * 64 + 8 * cg : (cg < 24 ? 1024 + grp * 128 + 8 * (cg - 8) : 1280 + grp * 128 + 8 * (cg - 24));
            float wt[4][8], bs[8];
#pragma unroll
            for (int t = 0; t < 4; ++t) { const f32x4 a0 = *(const f32x4*)(I.conv_w + t * CONVD + chn), a1 = *(const f32x4*)(I.conv_w + t * CONVD + chn + 4);
#pragma unroll
                for (int i = 0; i < 4; ++i) { wt[t][i] = a0[i]; wt[t][4 + i] = a1[i]; } }
            { const f32x4 a0 = *(const f32x4*)(I.conv_b + chn), a1 = *(const f32x4*)(I.conv_b + chn + 4);
#pragma unroll
              for (int i = 0; i < 4; ++i) { bs[i] = a0[i]; bs[4 + i] = a1[i]; } }
            bf16x8 raw[11];
#pragma unroll
            for (int j = 0; j < 11; ++j) { const int t = t0 + s0 - 3 + j; raw[j] = t >= 0 ? *(const bf16x8*)(F.XBC + (row0 + t) * CONVD + chn) : (bf16x8){0, 0, 0, 0, 0, 0, 0, 0}; }
#pragma unroll
            for (int i = 0; i < 8; ++i) {
                const int s = s0 + i; float v[8];
#pragma unroll
                for (int e = 0; e < 8; ++e) { float a = bs[e];
#pragma unroll
                    for (int t = 0; t < 4; ++t) a += wt[t][e] * bf2f((bf16)raw[i + t][e]);
                    v[e] = silu_fast(a); }
                if (cg < 8) {
                    const float dt = dtl[s], de = dt * __expf(aend - acs[s]);
                    const int off = (((s >> 4) * 2 + (cg >> 2)) << 10) + (s & 15) * 64 + (cg & 3) * 16;
                    v4u o; o.x = pk2(v[0] * dt, v[1] * dt); o.y = pk2(v[2] * dt, v[3] * dt); o.z = pk2(v[4] * dt, v[5] * dt); o.w = pk2(v[6] * dt, v[7] * dt);
                    *(LAS v4u*)(lds + XD_OFF + off) = o;
                    o.x = pk2(v[0] * de, v[1] * de); o.y = pk2(v[2] * de, v[3] * de); o.z = pk2(v[4] * de, v[5] * de); o.w = pk2(v[6] * de, v[7] * de);
                    *(LAS v4u*)(lds + XH_OFF + off) = o;
                } else {
                    v4u o; o.x = pk2(v[0], v[1]); o.y = pk2(v[2], v[3]); o.z = pk2(v[4], v[5]); o.w = pk2(v[6], v[7]);
                    *(LAS v4u*)(lds + (cg < 24 ? BT_OFF + 16 * (cg - 8) : CT_OFF + 16 * (cg - 24)) + s * PITCH) = o;
                }
            }
        }
        __syncthreads();
        {
            const int j = w & 3; const float al = acs[32 * j + c];
#pragma unroll
            for (int ii = 0; ii < 2; ++ii) {
                const int i = 2 * (w >> 2) + ii;
                if (i <= j) {
                    f32x16 x = {};
                    const LAS unsigned char* ap = lds + BT_OFF + (32 * i + c) * PITCH + 16 * hi;
                    const LAS unsigned char* bp = lds + CT_OFF + (32 * j + c) * PITCH + 16 * hi;
#pragma unroll
                    for (int ks = 0; ks < 8; ++ks) x = __builtin_amdgcn_mfma_f32_32x32x16_bf16(*(const LAS bf16x8*)(ap + 32 * ks), *(const LAS bf16x8*)(bp + 32 * ks), x, 0, 0, 0);
                    const int l = 32 * j + c;
#pragma unroll
                    for (int g4 = 0; g4 < 4; ++g4) {
                        const int sb = 32 * i + 8 * g4 + 4 * hi; float gv[4];
#pragma unroll
                        for (int e = 0; e < 4; ++e) { const int s = sb + e; gv[e] = s <= l ? x[4 * g4 + e] * __expf(al - acs[s]) : 0.f; }
                        u32x2 o; o.x = pk2(gv[0], gv[1]); o.y = pk2(gv[2], gv[3]);
                        *(LAS u32x2*)(lds + G_OFF + l * PITCH + sb * 2) = o;
                    }
                } else {
                }
            }
        }
        f32x16 yt = {};
        {
            const LAS unsigned char* ap = lds + HB_OFF + (32 * pt + c) * PITCH + 16 * hi;
            const LAS unsigned char* bp = lds + CT_OFF + (32 * jt + c) * PITCH + 16 * hi;
#pragma unroll
            for (int ks = 0; ks < 8; ++ks) yt = __builtin_amdgcn_mfma_f32_32x32x16_bf16(*(const LAS bf16x8*)(ap + 32 * ks), *(const LAS bf16x8*)(bp + 32 * ks), yt, 0, 0, 0);
            const float el = __expf(acs[32 * jt + c]);
#pragma unroll
            for (int r = 0; r < 16; ++r) yt[r] *= el;
        }
        __syncthreads();
        {
            const LAS unsigned char* bp = lds + G_OFF + (32 * jt + c) * PITCH + 16 * hi;
            for (int ks = 0; ks < 2 * jt + 2; ++ks) {
                const LAS unsigned char* xp = lds + XD_OFF + ((ks * 2 + pt) << 10) + xtr;
                yt = __builtin_amdgcn_mfma_f32_32x32x16_bf16(trfrag(xp, xp + 256), *(const LAS bf16x8*)(bp + 32 * ks), yt, 0, 0, 0);
            }
        }
        {
            const int l = 32 * jt + c; const float rdt = dsk * __builtin_amdgcn_rcpf(dtl[l]);
            bf16* up = F.AU + (row0 + t0 + l) * 2048 + hd * 64 + 32 * pt;
            float sq = 0.f;
#pragma unroll
            for (int g4 = 0; g4 < 4; ++g4) {
                const int pl = 8 * g4 + 4 * hi;
                const u32x2 xw = *(const LAS u32x2*)(lds + XD_OFF + (((l >> 4) * 2 + pt) << 10) + (l & 15) * 64 + pl * 2);
                const u32x2 zw = *(const u32x2*)(up + pl);
                const float x0 = __uint_as_float(xw.x << 16), x1 = __uint_as_float(xw.x & 0xffff0000u), x2 = __uint_as_float(xw.y << 16), x3 = __uint_as_float(xw.y & 0xffff0000u);
                const float z0 = __uint_as_float(zw.x << 16), z1 = __uint_as_float(zw.x & 0xffff0000u), z2 = __uint_as_float(zw.y << 16), z3 = __uint_as_float(zw.y & 0xffff0000u);
                const float u0 = (yt[4 * g4] + rdt * x0) * z0, u1 = (yt[4 * g4 + 1] + rdt * x1) * z1, u2 = (yt[4 * g4 + 2] + rdt * x2) * z2, u3 = (yt[4 * g4 + 3] + rdt * x3) * z3;
                sq += (u0 * u0 + u1 * u1) + (u2 * u2 + u3 * u3);
                u32x2 o; o.x = pk2(u0, u1); o.y = pk2(u2, u3);
                *(u32x2*)(up + pl) = o;
            }
            sq += __shfl_xor(sq, 32);
            if (hi == 0) __hip_atomic_fetch_add(ssql + l, sq, __ATOMIC_RELAXED, __HIP_MEMORY_SCOPE_WORKGROUP);
        }
        {
            const float ea = __expf(aend);
#pragma unroll
            for (int r = 0; r < 16; ++r) hacc[r] *= ea;
            const int btr = (8 * hi + q4) * PITCH + (32 * jt + 16 * odd + 4 * p4) * 2;
#pragma unroll
            for (int ks = 0; ks < 8; ++ks) {
                const LAS unsigned char* xp = lds + XH_OFF + ((ks * 2 + pt) << 10) + xtr;
                const LAS unsigned char* bp = lds + BT_OFF + 16 * ks * PITCH + btr;
                hacc = __builtin_amdgcn_mfma_f32_32x32x16_bf16(trfrag(xp, xp + 256), trfrag(bp, bp + 4 * PITCH), hacc, 0, 0, 0);
            }
        }
        __syncthreads();
#pragma unroll
        for (int r = 0; r < 16; ++r) *(LAS bf16*)(lds + HB_OFF + (32 * pt + crow(r, hi)) * PITCH + (32 * jt + c) * 2) = (bf16)f2bf(hacc[r]);
    }
    if (w == 0) { const int t0 = SEQ; F.SSQ[(row0 + t0 - 128 + lane) * 16 + hd] = ssql[lane]; F.SSQ[(row0 + t0 - 64 + lane) * 16 + hd] = ssql[64 + lane]; }
    float* ho = F.out + O_HP + (((size_t)b * NH + hd) * HD + 32 * pt) * DS + 32 * jt + c;
#pragma unroll
    for (int r = 0; r < 16; ++r) ho[(size_t)crow(r, hi) * DS] = hacc[r];
    __syncthreads();
}
}

namespace smp {
__device__ __forceinline__ void attn_unit(Frame& F, int su) {
    const Ins& I = F.I;
    const int lane = F.lane, w = F.wave, bhs = su * 8 + w, b = bhs >> 4, h = bhs & 15, r = NTOK + b;
    LAS float* qs = (LAS float*)(F.lds + att::VST_OFF + w * att::VST_BYTES); LAS float* ps = qs + 64;
    qs[lane] = bf2f(F.Q[(size_t)r * DM + h * HD + lane]);
    __builtin_amdgcn_wave_barrier();
    float mx = -INFINITY;
#pragma unroll 1
    for (int it = 0; it < 7; ++it) {
        const int idx = it * 64 + lane;
        if (idx < 387) {
            const int pat = idx / 129, j = idx - pat * 129, d = pat == 0 ? 1 : (pat == 1 ? 4 : 16);
            float s = 0.f;
            if (j > 0) { const f32x4* kp = (const f32x4*)(I.ck + (((size_t)b * WIN + (WIN - j * d)) * NH + h) * HD);
#pragma unroll
                for (int e = 0; e < 16; ++e) { const f32x4 kv = kp[e]; s += (qs[4 * e] * kv[0] + qs[4 * e + 1] * kv[1]) + (qs[4 * e + 2] * kv[2] + qs[4 * e + 3] * kv[3]); } }
            else { const bf16* kp = F.K + (size_t)r * DM + h * HD; for (int e = 0; e < 64; ++e) s += qs[e] * bf2f(kp[e]); }
            s += I.rel_bias[t5_bucket(j * d) * NH + h] * LOG2E;
            ps[idx] = s; mx = fmaxf(mx, s);
        }
    }
    mx = wave_max(mx);
    float sum = 0.f;
#pragma unroll 1
    for (int idx = lane; idx < 387; idx += 64) { const float p = __builtin_amdgcn_exp2f(ps[idx] - mx); ps[idx] = p; sum += p; }
    sum = wave_sum(sum);
    __builtin_amdgcn_wave_barrier();
    float o = 0.f;
#pragma unroll 1
    for (int pat = 0; pat < 3; ++pat) {
        const int d = pat == 0 ? 1 : (pat == 1 ? 4 : 16);
        o += ps[pat * 129] * bf2f(F.V[(size_t)r * DM + h * HD + lane]);
        const float* vp = I.cv + (((size_t)b * WIN + WIN) * NH + h) * HD + lane;
#pragma unroll 8
        for (int j = 1; j < 129; ++j) o += ps[pat * 129 + j] * vp[-(ptrdiff_t)j * d * (NH * HD)];
    }
    bf16* gp = F.AU + (size_t)r * 2048 + 1024 + h * HD + lane;
    *gp = (bf16)f2bf(o * __builtin_amdgcn_rcpf(sum) * bf2f(*gp));
}

__device__ __forceinline__ void ssd_unit(Frame& F, int su) {
    const Ins& I = F.I;
    LAS float* xs_l = (LAS float*)F.lds; LAS float* B_l = xs_l + 64; LAS float* C_l = B_l + 128; LAS float* ssq_l = C_l + 128;
    const int tid = F.tid, p = tid >> 3, ng = tid & 7;
#pragma unroll 1
    for (int k = 0; k < 8; ++k) {
        const int bhs = su * 8 + k, b = bhs >> 4, hd = bhs & 15, grp = hd >> 3; const size_t r = (size_t)NTOK + b;
        float h[16];
        { const f32x4* hp = (const f32x4*)(I.sssm + (((size_t)b * NH + hd) * HD + p) * DS + ng * 16);
#pragma unroll
          for (int i = 0; i < 4; ++i) { const f32x4 v = hp[i]; h[4 * i] = v[0]; h[4 * i + 1] = v[1]; h[4 * i + 2] = v[2]; h[4 * i + 3] = v[3]; } }
        if (tid < 320) {
            const int ci = tid, c = ci < 64 ? hd * 64 + ci : (ci < 192 ? 1024 + grp * 128 + (ci - 64) : 1280 + grp * 128 + (ci - 192));
            float v = I.conv_b[c];
#pragma unroll
            for (int i = 0; i < 3; ++i) v += I.sconv[((size_t)b * 3 + i) * CONVD + c] * I.conv_w[i * CONVD + c];
            v += bf2f(F.XBC[r * CONVD + c]) * I.conv_w[3 * CONVD + c];
            xs_l[ci] = silu_f(v);
        }
        if (tid == 0) ssq_l[0] = 0.f;
        __syncthreads();
        const float dt = F.DT[r * 16 + hd], A = -__expf(I.a_log[hd]), x = xs_l[p], dec = __expf(dt * A), xdt = x * dt;
        float y = 0.f;
#pragma unroll
        for (int i = 0; i < 16; ++i) { h[i] = h[i] * dec + xdt * B_l[ng * 16 + i]; y += h[i] * C_l[ng * 16 + i]; }
        y += __shfl_xor(y, 1); y += __shfl_xor(y, 2); y += __shfl_xor(y, 4);
        if (ng == 0) {
            bf16* zp = F.AU + r * 2048 + hd * 64 + p;
            const float u = (y + I.d_skip[hd] * x) * bf2f(*zp);
            *zp = (bf16)f2bf(u);
            __hip_atomic_fetch_add(ssq_l, u * u, __ATOMIC_RELAXED, __HIP_MEMORY_SCOPE_WORKGROUP);
        }
        { f32x4* ho = (f32x4*)(F.out + O_HS + (((size_t)b * NH + hd) * HD + p) * DS + ng * 16);
#pragma unroll
          for (int i = 0; i < 4; ++i) ho[i] = (f32x4){h[4 * i], h[4 * i + 1], h[4 * i + 2], h[4 * i + 3]}; }
        __syncthreads();
        if (tid == 0) F.SSQ[r * 16 + hd] = ssq_l[0];
        __syncthreads();
    }
}
}

__device__ __forceinline__ void phase2_queue(Frame& F) {
    const unsigned x = xb_xcc_id() & 7u;
    constexpr int PER_Q = att::NUNITS / 8;
    for (unsigned k = 0; k < 8; ++k) {
        const unsigned qx = (x + k) & 7u;
        for (;;) {
            if (F.tid == 0) F.MISC[16] = __hip_atomic_fetch_add(F.ctl + CW_Q + 64 * qx, 1u, RLX_AGENT);
            __syncthreads();
            const unsigned idx = F.MISC[16];
            __syncthreads();
            if (idx >= (unsigned)(PER_Q + 16)) break;
            if (idx < 8u) { smp::attn_unit(F, (int)(qx * 8 + idx)); __syncthreads(); }
            else if (idx < 16u) smp::ssd_unit(F, (int)(qx * 8 + idx - 8));
            else att::unit(F, (int)(qx * PER_Q + idx - 16));
        }
    }
}

struct Args { Ins in; float* out; unsigned char* ws; int ph_lo, ph_hi; };
__global__ void __launch_bounds__(NWAVES * 64, 2) mk_fwd(Args args) {
    extern __shared__ __attribute__((aligned(16))) unsigned char lds[];
    Frame F;
    F.lds = (LAS unsigned char*)lds;
    F.MISC = (volatile LAS unsigned*)(F.lds + MISC_OFF);
    F.tid = threadIdx.x; F.lane = F.tid & 63; F.wave = __builtin_amdgcn_readfirstlane(F.tid >> 6);
    F.G = gridDim.x; { const int bx = blockIdx.x; F.vcu = (F.G % 8 == 0) ? (bx % 8) * (F.G / 8) + bx / 8 : bx; }
    unsigned char* ws = args.ws;
    F.ctl = (gu32*)(ws + WS_CTL); F.I = args.in; F.out = args.out;
    F.WinT = (bf16*)(ws + WS_WIN); F.WoutT = (bf16*)(ws + WS_WOUT); F.XN = (bf16*)(ws + WS_XN); F.Q = (bf16*)(ws + WS_Q); F.K = (bf16*)(ws + WS_K); F.V = (bf16*)(ws + WS_V);
    F.AU = (bf16*)(ws + WS_AU); F.XBC = (bf16*)(ws + WS_XBC); F.DT = (float*)(ws + WS_DT); F.SSQ = (float*)(ws + WS_SSQ);
    for (int u = F.tid; u < (LDS_BYTES - LDSCTL_OFF) / 4; u += NWAVES * 64) ((LAS unsigned*)(F.lds + LDSCTL_OFF))[u] = 0u;
    __syncthreads();
    XcdBarrier bar = xcd_barrier_post((unsigned*)(F.ctl + CW_BAR), F.MISC + 8);
    const int lo = args.ph_lo, hi = args.ph_hi;
#define IN(k) (lo <= (k) && (k) < hi)
#define BOTH(k) (IN(k) && IN((k) + 1))
    if (IN(0)) { p0_prologue(F); if (BOTH(0)) xcd_barrier(bar); }
    if (IN(1)) {
        __syncthreads();
        pg8::Gemm g{F.XN, F.WinT, MROWS, NMAIN, DM}; pg8::StaticOrder S; S.init(MROWS, NMAIN, F.G, (int)blockIdx.x);
        pg8::EpiIn E{F.Q, F.K, F.V, F.AU, F.XBC, F.out, F.I.qnw, F.I.knw};
        pg8::gemm_phase<pg8::EpiIn, pg8::StaticOrder, true, true>(F.lds + RING_OFF, g, S, E);
        if (BOTH(1)) xcd_barrier(bar);
    }
    if (IN(2)) { __syncthreads(); if ((F.vcu & 31) < 8 && (F.vcu >> 5) < 8) ssd::chain(F, (F.vcu >> 5) * 8 + (F.vcu & 31)); phase2_queue(F);     if (BOTH(2)) xcd_barrier(bar); }
    if (IN(3)) {
        __syncthreads();
        pg8::Gemm g{F.AU, F.WoutT, MROWS, DM, 2048}; pg8::StaticOrder S; S.init(MROWS, DM, F.G, (int)blockIdx.x);
        LAS float* rs = (LAS float*)(F.lds + RING_BYTES);
        { pg8::Unit u;
          for (int ui = 0; ui < 4 && S.next(ui, u); ++ui)
              for (int r = F.tid; r < 256; r += NWAVES * 64) {
                  const f32x4* sp = (const f32x4*)(F.SSQ + (size_t)(u.pm * 256 + r) * 16);
                  const f32x4 s0 = sp[0], s1 = sp[1], s2 = sp[2], s3 = sp[3];
                  const float s = ((s0[0] + s0[1]) + (s0[2] + s0[3])) + ((s1[0] + s1[1]) + (s1[2] + s1[3])) + ((s2[0] + s2[1]) + (s2[2] + s2[3])) + ((s3[0] + s3[1]) + (s3[2] + s3[3]));
                  rs[ui * 256 + r] = rsqrtf(s * (1.f / 1024.f) + EPS);
              }
          __syncthreads(); }
        pg8::EpiOut E{F.I.xp, F.I.xs, rs, F.out};
        pg8::gemm_phase<pg8::EpiOut, pg8::StaticOrder, true, true>(F.lds + RING_OFF, g, S, E);
    }
#undef IN
#undef BOTH
}

extern "C" void kernel_launch(void* const* d_in, const int* in_sizes, int n_in, void* d_out, int out_size, void* d_ws, size_t ws_size, hipStream_t stream) {
    static int grid = 0;
    if (grid == 0) {
        if (n_in != 18 || out_size != (int)O_END || ws_size < WS_END) { fprintf(stderr, "kernel_launch: unexpected n_in %d / out_size %d / ws_size %zu; nothing launched\n", n_in, out_size, ws_size); grid = -1; return; }
        int dev = 0, cus = 0;
        if (hipGetDevice(&dev) != hipSuccess || hipDeviceGetAttribute(&cus, hipDeviceAttributeMultiprocessorCount, dev) != hipSuccess) { grid = -1; return; }
        if (hipFuncSetAttribute((const void*)mk_fwd, hipFuncAttributeMaxDynamicSharedMemorySize, LDS_BYTES) != hipSuccess) { fprintf(stderr, "kernel_launch: hipFuncSetAttribute failed\n"); grid = -1; return; }
        (void)hipGetLastError();
        grid = cus;
    }
    if (grid < 0) return;
    (void)hipMemsetAsync((char*)d_ws + WS_CTL, 0, CTL_ZERO_BYTES, stream);
    Args a{};
    const float** ip = (const float**)&a.in;
    for (int i = 0; i < 18; ++i) ip[i] = (const float*)d_in[i];
    a.out = (float*)d_out; a.ws = (unsigned char*)d_ws;
    a.ph_lo = 0; a.ph_hi = 4;
    hipLaunchKernelGGL(mk_fwd, dim3(grid), dim3(NWAVES * 64), LDS_BYTES, stream, a);
}
```

```cpp
#include <hip/hip_runtime.h>
#include <cstdio>
#include <cstdint>

constexpr int DM = 1024, NB = 4, SEQ = 8192, DB = 32, WIN = 2048;
constexpr int NPROJ = 6672, NMAIN = 6656, NTOK = NB * SEQ, NROWS = NTOK + DB;
constexpr int MROWS = 33024;
constexpr int C_Q = 0, C_K = 1024, C_V = 2048, C_G = 3072, C_Z = 4096, C_XBC = 5120, C_DT = 6656;
constexpr int CONVD = 1536, NH = 16, HD = 64, DS = 128;
constexpr float EPS = 1e-6f;
constexpr float QSCALE = 0.125f * 1.4426950408889634f;
constexpr float LOG2E = 1.4426950408889634f;
constexpr size_t O_YP = 0, O_YS = O_YP + (size_t)NTOK * DM, O_KP = O_YS + (size_t)DB * DM, O_VP = O_KP + (size_t)NB * WIN * DM,
                 O_CP = O_VP + (size_t)NB * WIN * DM, O_HP = O_CP + (size_t)NB * 3 * CONVD, O_KS = O_HP + (size_t)NB * NH * HD * DS,
                 O_VS = O_KS + (size_t)DB * DM, O_CS = O_VS + (size_t)DB * DM, O_HS = O_CS + (size_t)DB * 3 * CONVD,
                 O_END = O_HS + (size_t)DB * NH * HD * DS;
static_assert(O_END == 55314432, "output size");

constexpr size_t MiB = 1u << 20;
constexpr size_t WS_CTL = 0, CTL_ZERO_BYTES = 1 * MiB;
constexpr size_t WS_WIN = 2 * MiB;
constexpr size_t WS_WOUT = 16 * MiB;
constexpr size_t WS_DT = 20 * MiB;
constexpr size_t WS_SSQ = 24 * MiB;
constexpr size_t WS_XN = 32 * MiB;
constexpr size_t WS_Q = 100 * MiB;
constexpr size_t WS_K = 168 * MiB;
constexpr size_t WS_V = 236 * MiB;
constexpr size_t WS_AU = 304 * MiB;
constexpr size_t WS_XBC = 436 * MiB;
constexpr size_t WS_RAWB = 536 * MiB;
constexpr size_t WS_END = 544 * MiB;
static_assert(WS_XN + (size_t)MROWS * DM * 2 <= WS_Q && WS_Q + (size_t)MROWS * DM * 2 <= WS_K && WS_K + (size_t)MROWS * DM * 2 <= WS_V && WS_V + (size_t)MROWS * DM * 2 <= WS_AU &&
              WS_AU + (size_t)MROWS * 2048 * 2 <= WS_XBC && WS_XBC + (size_t)MROWS * CONVD * 2 <= WS_RAWB && WS_RAWB + (size_t)(MROWS / 64) * 6 * 512 * 4 <= WS_END && WS_WIN + (size_t)NMAIN * DM * 2 <= WS_WOUT && WS_WOUT + (size_t)DM * 2048 * 2 <= WS_DT &&
              WS_DT + (size_t)MROWS * 16 * 4 <= WS_SSQ && WS_SSQ + (size_t)MROWS * 16 * 4 <= WS_XN, "d_ws map");

struct Ins {
    const float *xp, *xs, *ck, *cv, *sconv, *sssm, *norm_w, *w_in, *qnw, *knw, *rel_bias, *conv_w, *conv_b, *dt_bias, *a_log, *d_skip, *ssd_norm_w, *w_out;
};

typedef unsigned short bf16;
__device__ __forceinline__ float wave_sum(float v) {
#pragma unroll
    for (int o = 1; o < 64; o <<= 1) v += __shfl_xor(v, o);
    return v;
}
__device__ __forceinline__ float wave_max(float v) {
#pragma unroll
    for (int o = 1; o < 64; o <<= 1) v = fmaxf(v, __shfl_xor(v, o));
    return v;
}
__device__ __forceinline__ float silu_f(float x) { return x / (1.f + __expf(-x)); }
__device__ __forceinline__ float silu_fast(float x) { return x * __builtin_amdgcn_rcpf(1.f + __builtin_amdgcn_exp2f(-LOG2E * x)); }
__device__ __forceinline__ float softplus_f(float x) { return x > 20.f ? x : log1pf(__expf(x)); }
__device__ __forceinline__ int t5_bucket(int d) {
    if (d < 16) return d;
    int b = 16;
    b += d >= 22; b += d >= 30; b += d >= 40; b += d >= 54; b += d >= 73; b += d >= 99; b += d >= 134; b += d >= 182;
    b += d >= 246; b += d >= 332; b += d >= 450; b += d >= 609; b += d >= 825; b += d >= 1117; b += d >= 1513;
    return b;
}
__device__ __forceinline__ const float* xrow(const Ins& I, int r) { return r < NTOK ? I.xp + (size_t)r * DM : I.xs + (size_t)(r - NTOK) * DM; }
__device__ __forceinline__ float bf2f(bf16 v) { return __uint_as_float((unsigned)v << 16); }
__device__ __forceinline__ unsigned f2bf(float f) { unsigned u = __float_as_uint(f); return (u + 0x7fffu + ((u >> 16) & 1u)) >> 16; }
__device__ __forceinline__ unsigned pk2(float lo, float hi) { return f2bf(lo) | (f2bf(hi) << 16); }
__host__ __device__ __forceinline__ int vrow_of_col(int a) { return 128 * ((a >> 5) & 1) + 32 * ((a >> 6) & 3) + (a & 31); }

namespace pg8 {
#define PG8_LAS __attribute__((address_space(3)))
typedef unsigned short bf16_t;
typedef short bf16x8 __attribute__((ext_vector_type(8)));
typedef float f32x4 __attribute__((ext_vector_type(4)));
typedef unsigned u32x4 __attribute__((ext_vector_type(4)));
constexpr int BM = 256, BK = 64, HALF = 128, HTB = HALF * BK * 2  , STAGE_BYTES = 8 * HTB, NXCD = 8, WGM = 8;

__host__ __device__ __forceinline__ int lds_byte(int r, int c) { const int st = (r >> 4) * 2 + (c >> 5), rr = r & 15, cc = c & 31, ob = rr * 64 + cc * 2; return st * 1024 + (ob ^ (((ob >> 9) & 1) << 5)); }
__host__ __device__ __forceinline__ void stage_rc(int b, int& R, int& C) { const int st = b / 1024, sb = b % 1024, swz = sb ^ (((sb >> 9) & 1) << 5); R = (st >> 1) * 16 + swz / 64; C = (st & 1) * 32 + (swz % 64) / 2; }
__host__ __device__ __forceinline__ int perm32(int rho) { const int n = rho >> 4, i = rho & 15; return 8 * (i >> 2) + 4 * n + (i & 3); }

struct Unit { int pm, pn; };
struct Gemm { const bf16_t* A; const bf16_t* Bt; int M, N, K; };

struct StaticOrder {
    int nM, nN, nwg, G, c;
    __host__ __device__ void init(int M, int N, int G_, int c_) { nM = M / BM; nN = N / BM; nwg = nM * nN; G = G_; c = c_; }
    __host__ __device__ bool next(int i, Unit& u) const {
        const long L = (long)i * G + c; if (L >= nwg) return false;
        int wgid = (int)L; { const int q = nwg / NXCD, r = nwg % NXCD, xcd = wgid % NXCD, off = wgid / NXCD; wgid = (xcd < r ? xcd * (q + 1) : r * (q + 1) + (xcd - r) * q) + off; }
        const int nig = WGM * nN, gid = wgid / nig, fm = gid * WGM, gsz = (nM - fm) < WGM ? (nM - fm) : WGM;
        u.pm = fm + ((wgid % nig) % gsz); u.pn = (wgid % nig) / gsz; return true;
    }
    __device__ __forceinline__ void a_ready(const Unit&) const {}
    __device__ __forceinline__ void done(const Unit&) const {}
};

__device__ __forceinline__ unsigned cvt_pk_bf16(float lo, float hi) { unsigned r; asm volatile("v_cvt_pk_bf16_f32 %0, %1, %2" : "=v"(r) : "v"(lo), "v"(hi)); return r; }

template <int K> __device__ __forceinline__ float rowprev(float cur, float prevm) {
    const int t = __builtin_amdgcn_update_dpp(0, __builtin_bit_cast(int, prevm), 0x100 + (16 - K), 0xf, 0xf, true);
    return __builtin_bit_cast(float, __builtin_amdgcn_update_dpp(t, __builtin_bit_cast(int, cur), 0x110 + K, 0xf, 0xf, false));
}

struct EpiIn {
    static constexpr bool PERM = true, AFTER_DRAIN = false, MIDK = false;
    bf16_t *Q, *K, *V, *AU, *XBC; float* out; const float *qnw, *knw, *conv_w, *conv_b; float* rawb;
    __device__ __forceinline__ void mid(f32x4 (&)[2][2][4][2], const Unit&, int, int, int, int, int) const {}
    __device__ __forceinline__ void operator()(const f32x4 (&acc)[2][2][4][2], const Unit& u, int wr, int wc, int fr, int fq) const {
        const int pn = u.pn;
        const int rowb = u.pm * BM + wr * 64 + fr;
        const int cl = wc * 64 + 8 * fq;
        if (pn < 8) {
            const bool isq = pn < 4; const float* nw = isq ? qnw : knw;
            f32x4 w[2][2];
#pragma unroll
            for (int bj = 0; bj < 2; ++bj)
#pragma unroll
                for (int n = 0; n < 2; ++n) w[bj][n] = *(const f32x4*)(nw + 8 * fq + 32 * bj + 4 * n);
            bf16_t* dstb = (isq ? Q : K) + (pn & 3) * 256 + cl;
#pragma unroll
            for (int ai = 0; ai < 2; ++ai)
#pragma unroll
                for (int m = 0; m < 4; ++m) {
                    const int r = rowb + ai * HALF + m * 16;
                    float ss = 0.f;
#pragma unroll
                    for (int bj = 0; bj < 2; ++bj)
#pragma unroll
                        for (int n = 0; n < 2; ++n) { const f32x4 v = acc[ai][bj][m][n]; ss += (v[0] * v[0] + v[1] * v[1]) + (v[2] * v[2] + v[3] * v[3]); }
                    ss += __shfl_xor(ss, 16); ss += __shfl_xor(ss, 32);
                    const float sc = rsqrtf(ss * (1.f / 64.f) + EPS), scs = isq ? sc * QSCALE : sc;
                    float* f32dst = nullptr;
                    if (!isq) { if (r < NTOK) { const int t = r & (SEQ - 1); if (t >= SEQ - WIN) f32dst = out + O_KP + ((size_t)((r >> 13) * WIN + t - (SEQ - WIN))) * DM + (pn & 3) * 256 + cl; }
                                else if (r < NROWS) f32dst = out + O_KS + (size_t)(r - NTOK) * DM + (pn & 3) * 256 + cl; }
#pragma unroll
                    for (int bj = 0; bj < 2; ++bj) {
                        const f32x4 a0 = acc[ai][bj][m][0] * w[bj][0], a1 = acc[ai][bj][m][1] * w[bj][1];
                        u32x4 o; o.x = cvt_pk_bf16(a0[0] * scs, a0[1] * scs); o.y = cvt_pk_bf16(a0[2] * scs, a0[3] * scs); o.z = cvt_pk_bf16(a1[0] * scs, a1[1] * scs); o.w = cvt_pk_bf16(a1[2] * scs, a1[3] * scs);
                        *(u32x4*)(dstb + (size_t)r * DM + 32 * bj) = o;
                        if (f32dst) { *(f32x4*)(f32dst + 32 * bj) = a0 * sc; *(f32x4*)(f32dst + 32 * bj + 4) = a1 * sc; }
                    }
                }
        } else if (pn < 12) {
            bf16_t* dstb = V + (pn & 3) * 256 + cl;
#pragma unroll
            for (int ai = 0; ai < 2; ++ai)
#pragma unroll
                for (int m = 0; m < 4; ++m) {
                    const int r = rowb + ai * HALF + m * 16;
                    float* f32dst = nullptr;
                    if (r < NTOK) { const int t = r & (SEQ - 1); if (t >= SEQ - WIN) f32dst = out + O_VP + ((size_t)((r >> 13) * WIN + t - (SEQ - WIN))) * DM + (pn & 3) * 256 + cl; }
                    else if (r < NROWS) f32dst = out + O_VS + (size_t)(r - NTOK) * DM + (pn & 3) * 256 + cl;
#pragma unroll
                    for (int bj = 0; bj < 2; ++bj) {
                        const f32x4 a0 = acc[ai][bj][m][0], a1 = acc[ai][bj][m][1];
                        u32x4 o; o.x = cvt_pk_bf16(a0[0], a0[1]); o.y = cvt_pk_bf16(a0[2], a0[3]); o.z = cvt_pk_bf16(a1[0], a1[1]); o.w = cvt_pk_bf16(a1[2], a1[3]);
                        *(u32x4*)(dstb + (size_t)r * DM + 32 * bj) = o;
                        if (f32dst) { *(f32x4*)(f32dst + 32 * bj) = a0; *(f32x4*)(f32dst + 32 * bj + 4) = a1; }
                    }
                }
        } else if (pn < 20) {
            bf16_t* dstb = AU + (pn < 16 ? 1024 : 0) + (pn & 3) * 256 + cl;
#pragma unroll
            for (int ai = 0; ai < 2; ++ai)
#pragma unroll
                for (int m = 0; m < 4; ++m) {
                    const int r = rowb + ai * HALF + m * 16;
#pragma unroll
                    for (int bj = 0; bj < 2; ++bj) {
                        f32x4 a0 = acc[ai][bj][m][0], a1 = acc[ai][bj][m][1];
#pragma unroll
                        for (int i = 0; i < 4; ++i) { a0[i] = silu_fast(a0[i]); a1[i] = silu_fast(a1[i]); }
                        u32x4 o; o.x = cvt_pk_bf16(a0[0], a0[1]); o.y = cvt_pk_bf16(a0[2], a0[3]); o.z = cvt_pk_bf16(a1[0], a1[1]); o.w = cvt_pk_bf16(a1[2], a1[3]);
                        *(u32x4*)(dstb + (size_t)r * 2048 + 32 * bj) = o;
                    }
                }
        } else {
            const int cb = (pn - 20) * 256 + cl;
            bf16_t* dstb = XBC + cb;
            const bool do_conv = pn >= 24 && u.pm < NTOK / BM;
#pragma unroll
            for (int ai = 0; ai < 2; ++ai)
#pragma unroll
                for (int m = 0; m < 4; ++m) {
                    const int r = rowb + ai * HALF + m * 16;
                    float* f32dst = nullptr;
                    if (r < NTOK) { const int t = r & (SEQ - 1); if (t >= SEQ - 3) f32dst = out + O_CP + ((size_t)((r >> 13) * 3 + t - (SEQ - 3))) * CONVD + cb; }
                    else if (r < NROWS) f32dst = out + O_CS + ((size_t)(r - NTOK) * 3 + 2) * CONVD + cb;
                    if (do_conv && (m == 0 || m == 3)) {
                        const int slot = m == 0 ? 3 + fr : fr - 13;
                        if (slot >= 0 && slot < 6) f32dst = rawb + ((size_t)(u.pm * 4 + ai * 2 + wr) * 6 + slot) * 512 + (cb - 1024);
                    }
#pragma unroll
                    for (int bj = 0; bj < 2; ++bj) {
                        const f32x4 a0 = acc[ai][bj][m][0], a1 = acc[ai][bj][m][1];
                        if (!do_conv) { u32x4 o; o.x = cvt_pk_bf16(a0[0], a0[1]); o.y = cvt_pk_bf16(a0[2], a0[3]); o.z = cvt_pk_bf16(a1[0], a1[1]); o.w = cvt_pk_bf16(a1[2], a1[3]);
                                        *(u32x4*)(dstb + (size_t)r * CONVD + 32 * bj) = o; }
                        if (f32dst) { *(f32x4*)(f32dst + 32 * bj) = a0; *(f32x4*)(f32dst + 32 * bj + 4) = a1; }
                    }
                }
            if (do_conv) {
                if ((u.pm & 31) == 31 && wr == 1 && fr >= 13) {
#pragma unroll
                    for (int bj = 0; bj < 2; ++bj) { float* d = out + O_CP + ((size_t)((u.pm >> 5) * 3 + fr - 13)) * CONVD + cb + 32 * bj; *(f32x4*)d = acc[1][bj][3][0]; *(f32x4*)(d + 4) = acc[1][bj][3][1]; }
                }
#pragma unroll
                for (int bj = 0; bj < 2; ++bj) {
                    f32x4 w[4][2], bb[2];
#pragma unroll
                    for (int n = 0; n < 2; ++n) { bb[n] = *(const f32x4*)(conv_b + cb + 32 * bj + 4 * n);
#pragma unroll
                        for (int t = 0; t < 4; ++t) w[t][n] = *(const f32x4*)(conv_w + t * CONVD + cb + 32 * bj + 4 * n); }
#pragma unroll
                    for (int ai = 0; ai < 2; ++ai) {
                        f32x4 pm[2] = {(f32x4){0.f, 0.f, 0.f, 0.f}, (f32x4){0.f, 0.f, 0.f, 0.f}};
#pragma unroll
                        for (int m = 0; m < 4; ++m) {
                            const int r = rowb + ai * HALF + m * 16;
                            unsigned ow[4];
#pragma unroll
                            for (int n = 0; n < 2; ++n) {
                                const f32x4 cur = acc[ai][bj][m][n]; f32x4 v;
#pragma unroll
                                for (int i = 0; i < 4; ++i) {
                                    const float p1 = rowprev<1>(cur[i], pm[n][i]), p2 = rowprev<2>(cur[i], pm[n][i]), p3 = rowprev<3>(cur[i], pm[n][i]);
                                    v[i] = silu_fast(bb[n][i] + w[0][n][i] * p3 + w[1][n][i] * p2 + w[2][n][i] * p1 + w[3][n][i] * cur[i]);
                                }
                                ow[2 * n] = cvt_pk_bf16(v[0], v[1]); ow[2 * n + 1] = cvt_pk_bf16(v[2], v[3]);
                                pm[n] = cur;
                            }
                            *(u32x4*)(dstb + (size_t)r * CONVD + 32 * bj) = (u32x4){ow[0], ow[1], ow[2], ow[3]};
                        }
                    }
                }
            }
        }
    }
};

struct EpiOut {
    static constexpr bool PERM = true, AFTER_DRAIN = false, MIDK = true;
    const float* xp; const float* xs; const PG8_LAS float* rs; float* out;
    __device__ __forceinline__ void mid(f32x4 (&acc)[2][2][4][2], const Unit& u, int ui, int wr, int wc, int fr, int fq) const {
        const PG8_LAS float* rp = rs + ui * 256 + wr * 64 + fr;
#pragma unroll
        for (int ai = 0; ai < 2; ++ai)
#pragma unroll
            for (int m = 0; m < 4; ++m) {
                const float r = rp[ai * HALF + m * 16];
#pragma unroll
                for (int bj = 0; bj < 2; ++bj)
#pragma unroll
                    for (int n = 0; n < 2; ++n) acc[ai][bj][m][n] *= r;
            }
    }
    __device__ __forceinline__ void operator()(const f32x4 (&acc)[2][2][4][2], const Unit& u, int wr, int wc, int fr, int fq) const {
        const int rowb = u.pm * BM + wr * 64 + fr, col = u.pn * BM + wc * 64 + 8 * fq;
#pragma unroll
        for (int ai = 0; ai < 2; ++ai)
#pragma unroll
            for (int m = 0; m < 4; ++m) {
                const int r = rowb + ai * HALF + m * 16;
                if (r >= NROWS) continue;
                const float* xr = (r < NTOK ? xp + (size_t)r * DM : xs + (size_t)(r - NTOK) * DM) + col;
                float* yr = out + (r < NTOK ? O_YP + (size_t)r * DM : O_YS + (size_t)(r - NTOK) * DM) + col;
#pragma unroll
                for (int bj = 0; bj < 2; ++bj) {
                    *(f32x4*)(yr + 32 * bj) = *(const f32x4*)(xr + 32 * bj) + acc[ai][bj][m][0];
                    *(f32x4*)(yr + 32 * bj + 4) = *(const f32x4*)(xr + 32 * bj + 4) + acc[ai][bj][m][1];
                }
            }
    }
};

template <class Epi, class Sched, bool ALIGN_EPI = false, bool SP2 = false>
__device__ __forceinline__ void gemm_phase(PG8_LAS unsigned char* lds, const Gemm g, const Sched& S, const Epi& E) {
    const int tid = threadIdx.x, wid = __builtin_amdgcn_readfirstlane(tid >> 6), lane = tid & 63, wr = wid >> 2, wc = wid & 3, fr = lane & 15, fq = lane >> 4;
    const int K = g.K, nt = K / BK;
    unsigned voffA[2], voffB[2];
#pragma unroll
    for (int i = 0; i < 2; ++i) { int R, C; stage_rc(tid * 16 + i * 8192, R, C); const int Rb = Epi::PERM ? ((R & ~31) + perm32(R & 31)) : R;
        voffA[i] = (unsigned)(R * K + C) * 2u; voffB[i] = (unsigned)(Rb * K + C) * 2u; }
    const size_t kstep = (size_t)(BK * 2);
    const size_t hstep = (size_t)HALF * K * 2;
    const size_t tstep = 2 * hstep;
    const unsigned ldsw = (unsigned)wid * 1024u;
    const int aoff = lds_byte(wr * 64 + fr, fq * 8), boff = lds_byte(wc * 32 + fr, fq * 8);
#define PG8_SA(b, h) (((b) * 2 + (h)) * HTB)
#define PG8_SB(b, h) ((4 + (b) * 2 + (h)) * HTB)
#define PG8_STAGE(bufoff, gbase, voff) do { _Pragma("unroll") for (int _i = 0; _i < 2; ++_i) \
        __builtin_amdgcn_global_load_lds((const unsigned*)((const char*)(gbase) + (voff)[_i]), (PG8_LAS unsigned*)(lds + (bufoff) + ldsw + _i * 8192), 16, 0, 0); } while (0)
#define PG8_LDA(dst, b, h) do { _Pragma("unroll") for (int m = 0; m < 4; ++m) _Pragma("unroll") for (int k = 0; k < 2; ++k) dst[m][k] = *(const PG8_LAS bf16x8*)(lds + PG8_SA(b, h) + aoff + m * 2048 + k * 1024); } while (0)
#define PG8_LDB(dst, b, h) do { _Pragma("unroll") for (int n = 0; n < 2; ++n) _Pragma("unroll") for (int k = 0; k < 2; ++k) dst[n][k] = *(const PG8_LAS bf16x8*)(lds + PG8_SB(b, h) + boff + n * 2048 + k * 1024); } while (0)
#define PG8_MMA(ai, bj, At, Bt) do { __builtin_amdgcn_s_setprio(1); _Pragma("unroll") for (int m = 0; m < 4; ++m) _Pragma("unroll") for (int n = 0; n < 2; ++n) _Pragma("unroll") for (int k = 0; k < 2; ++k) \
        acc[ai][bj][m][n] = __builtin_amdgcn_mfma_f32_16x16x32_bf16(Bt[n][k], At[m][k], acc[ai][bj][m][n], 0, 0, 0); __builtin_amdgcn_s_setprio(0); } while (0)
#define PG8_WAIT_V(n) asm volatile("s_waitcnt vmcnt(" #n ")" ::: "memory")
#define PG8_WAIT_L(n) asm volatile("s_waitcnt lgkmcnt(" #n ")" ::: "memory")
#define PG8_BAR __builtin_amdgcn_s_barrier()
#define PG8_SCHED __builtin_amdgcn_sched_barrier(0)
    Unit cur, nxt; int ui = 0;
    if (!S.next(0, cur)) return;
    f32x4 acc[2][2][4][2];
#pragma unroll
    for (int a = 0; a < 2; ++a)
#pragma unroll
        for (int b = 0; b < 2; ++b)
#pragma unroll
            for (int m = 0; m < 4; ++m)
#pragma unroll
                for (int n = 0; n < 2; ++n) acc[a][b][m][n] = (f32x4){0.f, 0.f, 0.f, 0.f};
    bf16x8 At[4][2], B0[2][2], B1[2][2];
    const char* cA = (const char*)g.A + (size_t)cur.pm * tstep; const char* cB = (const char*)g.Bt + (size_t)cur.pn * tstep;
    S.a_ready(cur);
    if constexpr (SP2) {
        PG8_STAGE(PG8_SB(0, 0), cB, voffB); PG8_STAGE(PG8_SB(0, 1), cB + hstep, voffB); PG8_STAGE(PG8_SA(0, 0), cA, voffA); PG8_STAGE(PG8_SA(0, 1), cA + hstep, voffA);
        if (wr == 1) PG8_BAR;
        PG8_WAIT_V(2); PG8_BAR;
        PG8_STAGE(PG8_SB(1, 0), cB + kstep, voffB); PG8_STAGE(PG8_SA(1, 0), cA + kstep, voffA); PG8_STAGE(PG8_SB(1, 1), cB + hstep + kstep, voffB);
        PG8_WAIT_V(6); PG8_BAR;
    } else {
        PG8_STAGE(PG8_SB(0, 0), cB, voffB); PG8_STAGE(PG8_SA(0, 0), cA, voffA); PG8_STAGE(PG8_SB(0, 1), cB + hstep, voffB); PG8_STAGE(PG8_SA(0, 1), cA + hstep, voffA);
        if (wr == 1) PG8_BAR;
        PG8_WAIT_V(4); PG8_BAR;
        PG8_STAGE(PG8_SB(1, 0), cB + kstep, voffB); PG8_STAGE(PG8_SA(1, 0), cA + kstep, voffA); PG8_STAGE(PG8_SB(1, 1), cB + hstep + kstep, voffB);
        PG8_WAIT_V(6); PG8_BAR;
    }
    for (;;) {
        const bool has_next = S.next(ui + 1, nxt);
        const char* nA = has_next ? (const char*)g.A + (size_t)nxt.pm * tstep : cA; const char* nB = has_next ? (const char*)g.Bt + (size_t)nxt.pn * tstep : cB;
        for (int t = 0; t < nt; t += 2) {
            const bool last = (t == nt - 2);
            if constexpr (Epi::MIDK) { if (t == (nt >> 1)) E.mid(acc, cur, ui, wr, wc, fr, fq); }
            const char* a1 = cA + (size_t)(t + 1) * kstep;
            const char* a2 = last ? nA : cA + (size_t)(t + 2) * kstep; const char* b2 = last ? nB : cB + (size_t)(t + 2) * kstep;
            const char* a3 = a2 + kstep; const char* b3 = b2 + kstep;
            if (last && has_next) S.a_ready(nxt);
            if constexpr (SP2) {
            PG8_LDB(B0, 0, 0); PG8_LDB(B1, 0, 1); PG8_SCHED; PG8_LDA(At, 0, 0); PG8_STAGE(PG8_SA(1, 1), a1 + hstep, voffA);
            PG8_WAIT_V(8); PG8_WAIT_L(0); PG8_BAR; PG8_MMA(0, 0, At, B0); PG8_MMA(0, 1, At, B1); PG8_BAR; PG8_SCHED;
            PG8_LDA(At, 0, 1); PG8_STAGE(PG8_SB(0, 0), b2, voffB); PG8_STAGE(PG8_SB(0, 1), b2 + hstep, voffB); PG8_STAGE(PG8_SA(0, 0), a2, voffA);
            PG8_WAIT_V(8); PG8_WAIT_L(0); PG8_BAR; PG8_MMA(1, 0, At, B0); PG8_MMA(1, 1, At, B1); PG8_BAR; PG8_SCHED;
            PG8_LDB(B0, 1, 0); PG8_LDB(B1, 1, 1); PG8_SCHED; PG8_LDA(At, 1, 0); PG8_STAGE(PG8_SA(0, 1), a2 + hstep, voffA);
            PG8_WAIT_V(8); PG8_WAIT_L(0); PG8_BAR; PG8_MMA(0, 0, At, B0); PG8_MMA(0, 1, At, B1); PG8_BAR; PG8_SCHED;
            PG8_LDA(At, 1, 1); PG8_STAGE(PG8_SB(1, 0), b3, voffB); PG8_STAGE(PG8_SB(1, 1), b3 + hstep, voffB); PG8_STAGE(PG8_SA(1, 0), a3, voffA);
            PG8_WAIT_V(8); PG8_WAIT_L(0); PG8_BAR; PG8_MMA(1, 0, At, B0); PG8_MMA(1, 1, At, B1); PG8_BAR; PG8_SCHED;
            } else {
            PG8_LDB(B0, 0, 0); PG8_SCHED; PG8_LDA(At, 0, 0); PG8_STAGE(PG8_SA(1, 1), a1 + hstep, voffA);
            PG8_WAIT_L(8); PG8_BAR; PG8_WAIT_L(0); PG8_MMA(0, 0, At, B0); PG8_BAR; PG8_SCHED;
            PG8_LDB(B1, 0, 1); PG8_STAGE(PG8_SB(0, 0), b2, voffB);
            PG8_BAR; PG8_WAIT_L(0); PG8_MMA(0, 1, At, B1); PG8_BAR;
            PG8_LDA(At, 0, 1); PG8_STAGE(PG8_SA(0, 0), a2, voffA);
            PG8_BAR; PG8_WAIT_L(0); PG8_MMA(1, 0, At, B0); PG8_BAR; PG8_SCHED;
            PG8_STAGE(PG8_SB(0, 1), b2 + hstep, voffB);
            PG8_WAIT_V(6); PG8_BAR; PG8_MMA(1, 1, At, B1); PG8_BAR;
            PG8_LDB(B0, 1, 0); PG8_SCHED; PG8_LDA(At, 1, 0); PG8_STAGE(PG8_SA(0, 1), a2 + hstep, voffA);
            PG8_WAIT_L(8); PG8_BAR; PG8_WAIT_L(0); PG8_MMA(0, 0, At, B0); PG8_BAR; PG8_SCHED;
            PG8_LDB(B1, 1, 1); PG8_STAGE(PG8_SB(1, 0), b3, voffB);
            PG8_BAR; PG8_WAIT_L(0); PG8_MMA(0, 1, At, B1); PG8_BAR;
            PG8_LDA(At, 1, 1); PG8_STAGE(PG8_SA(1, 0), a3, voffA);
            PG8_BAR; PG8_WAIT_L(0); PG8_MMA(1, 0, At, B0); PG8_BAR; PG8_SCHED;
            PG8_STAGE(PG8_SB(1, 1), b3 + hstep, voffB);
            PG8_WAIT_V(6); PG8_BAR; PG8_MMA(1, 1, At, B1); PG8_BAR;
            }
        }
        if constexpr (ALIGN_EPI) { if (wr == 0) PG8_BAR; }
        if constexpr (!Epi::AFTER_DRAIN) { E(acc, cur, wr, wc, fr, fq); S.done(cur); }
        if (!has_next) break;
#pragma unroll
        for (int a = 0; a < 2; ++a)
#pragma unroll
            for (int b = 0; b < 2; ++b)
#pragma unroll
                for (int m = 0; m < 4; ++m)
#pragma unroll
                    for (int n = 0; n < 2; ++n) acc[a][b][m][n] = (f32x4){0.f, 0.f, 0.f, 0.f};
        cur = nxt; cA = nA; cB = nB; ++ui;
        if constexpr (ALIGN_EPI) { if (wr == 1) PG8_BAR; }
    }
    PG8_WAIT_V(0);
    if constexpr (!ALIGN_EPI) { if (wr == 0) PG8_BAR; }
    PG8_BAR;
    if constexpr (Epi::AFTER_DRAIN) { E.fused(acc, cur, wr, wc, fr, fq, lds, wid, lane); S.done(cur); }
#undef PG8_SA
#undef PG8_SB
#undef PG8_STAGE
#undef PG8_LDA
#undef PG8_LDB
#undef PG8_MMA
#undef PG8_WAIT_V
#undef PG8_WAIT_L
#undef PG8_BAR
#undef PG8_SCHED
}
}
#define GAS __attribute__((address_space(1)))
#define LAS __attribute__((address_space(3)))
typedef unsigned v4u __attribute__((ext_vector_type(4)));
typedef float f32x4 __attribute__((ext_vector_type(4)));
typedef short bf16x8 __attribute__((ext_vector_type(8)));
typedef GAS unsigned gu32;
typedef GAS unsigned long long gu64;
#define RLX_AGENT __ATOMIC_RELAXED, __HIP_MEMORY_SCOPE_AGENT
#define LDS_WAIT() asm volatile("s_waitcnt lgkmcnt(0)" ::: "memory")
#define VM_WAIT() asm volatile("s_waitcnt vmcnt(0)" ::: "memory")
__device__ __forceinline__ unsigned long long rt() { return __builtin_amdgcn_s_memrealtime(); }

#define XB_TMO      128
#define XB_XCNT(j)  (256  + 64 * (j))
#define XB_XSUB(j)  (1280 + 64 * (j))
#define XB_XGEN(j)  (2304 + 64 * (j))
#define XB_TOP      3328
#define XB_TOPGEN   3392
#define XCD_BAR_WORDS 3456
#define XB_SPIN_CAP (1u << 18)

__device__ __forceinline__ unsigned xb_ld(unsigned* p)              { return __hip_atomic_load(p, __ATOMIC_RELAXED, __HIP_MEMORY_SCOPE_AGENT); }
__device__ __forceinline__ unsigned xb_add(unsigned* p, unsigned v) { return __hip_atomic_fetch_add(p, v, __ATOMIC_RELAXED, __HIP_MEMORY_SCOPE_AGENT); }
__device__ __forceinline__ unsigned xb_xcc_id() { return (unsigned)__builtin_amdgcn_s_getreg((3 << 11) | 20) & 0xFu; }
#define XB_SPIN(cond, bar) do { unsigned _sp = 0; while (cond) { __builtin_amdgcn_s_sleep(1); \
    if ((++_sp & 255u) == 0u) { if (xb_ld(&(bar)[XB_TMO])) break; if (_sp > XB_SPIN_CAP) { atomicAdd(&(bar)[XB_TMO], 1u); break; } } } } while (0)

struct XcdBarrier {
    unsigned* bar; unsigned x;
    volatile LAS unsigned* st;
};

__device__ __forceinline__ XcdBarrier xcd_barrier_post(unsigned* bar, volatile LAS unsigned* st) {
    XcdBarrier b; b.bar = bar; b.x = xb_xcc_id(); b.st = st;
    if (threadIdx.x == 0) (void)xb_add(&bar[XB_XCNT(b.x)], 1u);
    return b;
}
__device__ __forceinline__ void xcd_barrier_complete(unsigned* bar, unsigned x, unsigned& nloc, unsigned& nx) {
    const unsigned G = gridDim.x * gridDim.y * gridDim.z;
    unsigned sum, cnt, mine, sp = 0u;
    for (;;) {
        sum = 0u; cnt = 0u; mine = 0u;
#pragma unroll
        for (unsigned j = 0; j < 16; ++j) { const unsigned c = xb_ld(&bar[XB_XCNT(j)]); sum += c; cnt += (c > 0u) ? 1u : 0u; mine = (j == x) ? c : mine; }
        if (sum == G) break;
        __builtin_amdgcn_s_sleep(1);
        if ((++sp & 255u) == 0u) { if (xb_ld(&bar[XB_TMO])) break; if (sp > XB_SPIN_CAP) { atomicAdd(&bar[XB_TMO], 1u); break; } }
    }
    nloc = mine > 0u ? mine : 1u; nx = cnt > 0u ? cnt : 1u;
}

__device__ __forceinline__ void xcd_barrier(const XcdBarrier& b) {
    asm volatile("s_waitcnt vmcnt(0)" ::: "memory");
    __syncthreads();
    if (threadIdx.x == 0) {
        unsigned* bar = b.bar;
        __builtin_amdgcn_s_waitcnt(0);
        unsigned nloc = b.st[0], nx = b.st[1];
        if (nloc == 0u) { xcd_barrier_complete(bar, b.x, nloc, nx); b.st[0] = nloc; b.st[1] = nx; }
        const unsigned old = xb_add(&bar[XB_XSUB(b.x)], 1u);
        const unsigned gen = old / nloc;
        if (old + 1u == (gen + 1u) * nloc) {
            __builtin_amdgcn_fence(__ATOMIC_RELEASE, "agent");
            asm volatile("s_waitcnt vmcnt(0)" ::: "memory");
            const unsigned og = xb_add(&bar[XB_TOP], 1u);
            const unsigned tg = og / nx;
            if (og + 1u == (tg + 1u) * nx) xb_add(&bar[XB_TOPGEN], 1u);
            else XB_SPIN(xb_ld(&bar[XB_TOPGEN]) == tg, bar);
            __builtin_amdgcn_fence(__ATOMIC_ACQUIRE, "agent");
            xb_add(&bar[XB_XGEN(b.x)], 1u);
            asm volatile("s_waitcnt vmcnt(0)" ::: "memory");
        } else {
            XB_SPIN(xb_ld(&bar[XB_XGEN(b.x)]) == gen, bar);
            __builtin_amdgcn_fence(__ATOMIC_ACQUIRE, "agent");
            asm volatile("s_waitcnt vmcnt(0)" ::: "memory");
        }
    }
    __syncthreads();
}

constexpr int NWAVES = 8;
constexpr int RING_OFF = 0, RING_BYTES = 131072;
constexpr int LDS_BYTES = 163840;
constexpr int LDSCTL_OFF = LDS_BYTES - 512, MISC_OFF = LDSCTL_OFF + 320;
constexpr int CW_BAR = 4096;
constexpr int CW_Q = 16384;
static_assert((CW_BAR + XCD_BAR_WORDS) <= CW_Q && (CW_Q + 64 * 64) * 4 <= (int)CTL_ZERO_BYTES, "CTL words inside the memset region");

struct Frame {
    LAS unsigned char* lds;
    volatile LAS unsigned* MISC;
    gu32* ctl;
    int tid, lane, wave, vcu, G;
    Ins I; float* out;
    bf16 *WinT, *WoutT, *XN, *Q, *K, *V, *AU, *XBC; float *DT, *SSQ, *RAWB;
};

template <class SrcF>
__device__ __forceinline__ void p0_transpose_item(SrcF src, int k0, int n0, bf16* WT, int dst_pitch, int dst_row0, int dst_k0, LAS float* scr, int lane) {
#pragma unroll 8
    for (int i = 0; i < 32; ++i) { const int kk = 2 * i + (lane >> 5); scr[kk * 33 + (lane & 31)] = src(k0 + kk, n0 + (lane & 31)); }
    LDS_WAIT(); asm volatile("" ::: "memory");
    const int c = lane & 7;
#pragma unroll
    for (int j = 0; j < 4; ++j) { const int n = (lane >> 3) + 8 * j; const LAS float* s = scr + (8 * c) * 33 + n;
        v4u o; o.x = pk2(s[0 * 33], s[1 * 33]); o.y = pk2(s[2 * 33], s[3 * 33]); o.z = pk2(s[4 * 33], s[5 * 33]); o.w = pk2(s[6 * 33], s[7 * 33]);
        *(GAS v4u*)(WT + (size_t)(dst_row0 + n) * dst_pitch + dst_k0 + 8 * c) = o; }
    LDS_WAIT(); asm volatile("" ::: "memory");
}
constexpr int P0_SCR_BYTES = 8448, WDT_OFF = NWAVES * P0_SCR_BYTES, WDT_PITCH = 20;
static_assert(WDT_OFF + 1024 * WDT_PITCH * 4 <= LDSCTL_OFF, "prologue LDS");

__device__ __forceinline__ void p0_prologue(Frame& F) {
    const Ins& I = F.I;
    LAS float* scr = (LAS float*)(F.lds + F.wave * P0_SCR_BYTES);
    LAS float* wdt = (LAS float*)(F.lds + WDT_OFF);
    const int gw = F.vcu * NWAVES + F.wave, NGW = F.G * NWAVES;
    for (int idx = F.tid; idx < 1024 * 16; idx += NWAVES * 64) {
        const int k = idx >> 4, j = idx & 15, pos = (((k >> 8) * 4 + (k & 3)) << 6) + ((k >> 2) & 63);
        wdt[pos * WDT_PITCH + j] = I.w_in[(size_t)k * NPROJ + C_DT + j] * I.norm_w[k];
    }
    constexpr int I_IN = (DM / 64) * (NMAIN / 32), I_OUT = (2048 / 64) * (DM / 32);
    for (int it = gw; it < I_IN + I_OUT; it += NGW) {
        if (it < I_IN) {
            const int nblk = NMAIN / 32, kb = it / nblk, nb = it % nblk, k0 = 64 * kb, n0 = 32 * nb;
            p0_transpose_item([&](int k, int n) { return I.w_in[(size_t)k * NPROJ + n] * I.norm_w[k]; }, k0, n0, F.WinT, DM, (n0 & ~255) + vrow_of_col(n0 & 255), k0, scr, F.lane);
        } else {
            const int r = it - I_IN, nblk = DM / 32, kb = r / nblk, nb = r % nblk, k0 = 64 * kb, n0 = 32 * nb;
            p0_transpose_item([&](int k, int n) { return I.w_out[(size_t)k * DM + n] * (k >= 1024 ? I.ssd_norm_w[k - 1024] : 1.f); }, k0, n0, F.WoutT, 2048, (n0 & ~255) + vrow_of_col(n0 & 255), (k0 + 1024) & 2047, scr, F.lane);
        }
    }
    __syncthreads();
    for (int rp = gw; rp < NROWS / 2; rp += NGW) {
        f32x4 v[2][4]; float rstd[2];
#pragma unroll
        for (int q = 0; q < 2; ++q) {
            const GAS f32x4* xr = (const GAS f32x4*)xrow(I, 2 * rp + q) + F.lane; float s = 0.f;
#pragma unroll
            for (int j = 0; j < 4; ++j) { v[q][j] = xr[64 * j]; s += (v[q][j].x * v[q][j].x + v[q][j].y * v[q][j].y) + (v[q][j].z * v[q][j].z + v[q][j].w * v[q][j].w); }
            rstd[q] = rsqrtf(wave_sum(s) * (1.f / DM) + EPS);
            GAS unsigned long long* o8 = (GAS unsigned long long*)(F.XN + (size_t)(2 * rp + q) * DM) + F.lane;
#pragma unroll
            for (int j = 0; j < 4; ++j) o8[64 * j] = (unsigned long long)pk2(v[q][j].x * rstd[q], v[q][j].y * rstd[q]) | ((unsigned long long)pk2(v[q][j].z * rstd[q], v[q][j].w * rstd[q]) << 32);
        }
        float a[32];
#pragma unroll
        for (int i = 0; i < 32; ++i) a[i] = 0.f;
#pragma unroll
        for (int j = 0; j < 4; ++j)
#pragma unroll
            for (int e = 0; e < 4; ++e) {
                const LAS f32x4* wp = (const LAS f32x4*)(wdt + ((j * 4 + e) * 64 + F.lane) * WDT_PITCH);
                const float x0 = v[0][j][e], x1 = v[1][j][e];
#pragma unroll
                for (int c4 = 0; c4 < 4; ++c4) { const f32x4 w = wp[c4];
#pragma unroll
                    for (int i = 0; i < 4; ++i) { a[c4 * 4 + i] += x0 * w[i]; a[16 + c4 * 4 + i] += x1 * w[i]; } }
                asm volatile("" ::: "memory");
            }
#define P0_HALVE(N, X) { const bool up = (F.lane & (X)) != 0; _Pragma("unroll") for (int i = 0; i < (N); ++i) { const float keep = up ? a[i + (N)] : a[i], send = up ? a[i] : a[i + (N)]; a[i] = keep + __shfl_xor(send, (X)); } }
        P0_HALVE(16, 32) P0_HALVE(8, 16) P0_HALVE(4, 8) P0_HALVE(2, 4) P0_HALVE(1, 2)
#undef P0_HALVE
        float tot = a[0] + __shfl_xor(a[0], 1);
        const int idx = F.lane >> 1, q = idx >> 4, c = idx & 15;
        tot = tot * (q ? rstd[1] : rstd[0]) + I.dt_bias[c];
        if ((F.lane & 1) == 0) F.DT[(size_t)c * MROWS + 2 * rp + q] = softplus_f(tot);
    }
    for (int r = NROWS + gw; r < MROWS; r += NGW) { GAS v4u* o = (GAS v4u*)(F.XN + (size_t)r * DM) + F.lane; o[0] = (v4u){0u, 0u, 0u, 0u}; o[64] = (v4u){0u, 0u, 0u, 0u}; }
    for (int i = (F.vcu * NWAVES * 64 + F.tid); i < DB * 2 * CONVD; i += F.G * NWAVES * 64) {
        const int c = i % CONVD, rr = i / CONVD, j = rr & 1, b = rr >> 1;
        F.out[O_CS + ((size_t)b * 3 + j) * CONVD + c] = I.sconv[((size_t)b * 3 + j + 1) * CONVD + c];
    }
}

namespace att {
typedef float f32x16 __attribute__((ext_vector_type(16)));
typedef short v4i16_t __attribute__((ext_vector_type(4)));
typedef unsigned u32x4 __attribute__((ext_vector_type(4)));
constexpr int SPAN = 256, NSPAN = SEQ / SPAN, NUNITS = NB * NH * NSPAN;
constexpr int OACC_OFF = 0, LACC_OFF = 65536, LUT_OFF = 66560, VST_OFF = 68608, VST_BYTES = 4096, ATT_LDS_END = VST_OFF + NWAVES * VST_BYTES;
static_assert(ATT_LDS_END <= LDSCTL_OFF, "attention LDS");
__device__ __forceinline__ int crow(int r, int hi) { return (r & 3) + 8 * (r >> 2) + 4 * hi; }

template <int NQ>
__device__ __forceinline__ void item(const bf16* Qb, const bf16* Kb, const bf16* Vb, int tq0, int d, int pat, int toff, LAS unsigned char* lds, int wave, int lane) {
    const int c = lane & 31, hi = lane >> 5;
    LAS unsigned char* vst = lds + VST_OFF + wave * VST_BYTES;
    const LAS float* lut = (const LAS float*)(lds + LUT_OFF) + pat * 129;
    bf16x8 qf[4];
    { const bf16* qp = Qb + (size_t)(tq0 + (NQ == 32 ? c : (c & 15)) * d) * DM + 8 * hi;
#pragma unroll
      for (int ks = 0; ks < 4; ++ks) qf[ks] = *(const bf16x8*)(qp + 16 * ks); }
    f32x16 o0 = {}, o1 = {};
    float lsum = 0.f;
    const int vtr = ((lane >> 4) & 1) * 32 + (lane & 3) * 8 + (4 * hi + ((lane & 15) >> 2)) * 64;
    bf16x8 kf[4], vr[4];
#define ATT_LOAD_TILE(KT) do { \
        { int tk_ = tq0 + (-128 + 32 * (KT) + c) * d; tk_ = tk_ < 0 ? 0 : tk_; const bf16* kp_ = Kb + (size_t)tk_ * DM + 8 * hi; \
          _Pragma("unroll") for (int ks = 0; ks < 4; ++ks) kf[ks] = *(const bf16x8*)(kp_ + 16 * ks); } \
        _Pragma("unroll") for (int pc = 0; pc < 4; ++pc) { int tk_ = tq0 + (-128 + 32 * (KT) + 16 * (pc & 1) + (lane >> 2)) * d; tk_ = tk_ < 0 ? 0 : tk_; \
            vr[pc] = *(const bf16x8*)(Vb + (size_t)tk_ * DM + 32 * (pc >> 1) + 8 * (lane & 3)); } } while (0)
    ATT_LOAD_TILE(0);
#pragma unroll 1
    for (int kt = 0; kt < 5; ++kt) {
        f32x16 st = {};
#pragma unroll
        for (int ks = 0; ks < 4; ++ks) st = __builtin_amdgcn_mfma_f32_32x32x16_bf16(kf[ks], qf[ks], st, 0, 0, 0);
#pragma unroll
        for (int pc = 0; pc < 4; ++pc) *(LAS bf16x8*)(vst + pc * 1024 + lane * 16) = vr[pc];
        if (kt < 4) ATT_LOAD_TILE(kt + 1);
        const int relb = c + 128 - 32 * kt - 4 * hi, tkb = tq0 + (-128 + 32 * kt + 4 * hi) * d;
#pragma unroll
        for (int r = 0; r < 16; ++r) {
            const int kk = (r & 3) + 8 * (r >> 2), rel = relb - kk;
            const bool valid = (rel >= 0) && (rel <= 128) && (tkb + kk * d >= 0);
            const float bias = lut[valid ? rel : 0];
            const float p = valid ? __builtin_amdgcn_exp2f(st[r] + bias) : 0.f;
            st[r] = p; lsum += p;
        }
        u32x4 pw0, pw1;
        pw0.x = pg8::cvt_pk_bf16(st[0], st[1]); pw0.y = pg8::cvt_pk_bf16(st[2], st[3]); pw0.z = pg8::cvt_pk_bf16(st[4], st[5]); pw0.w = pg8::cvt_pk_bf16(st[6], st[7]);
        pw1.x = pg8::cvt_pk_bf16(st[8], st[9]); pw1.y = pg8::cvt_pk_bf16(st[10], st[11]); pw1.z = pg8::cvt_pk_bf16(st[12], st[13]); pw1.w = pg8::cvt_pk_bf16(st[14], st[15]);
        const bf16x8 pa0 = __builtin_bit_cast(bf16x8, pw0), pa1 = __builtin_bit_cast(bf16x8, pw1);
#pragma unroll
        for (int dh = 0; dh < 2; ++dh)
#pragma unroll
            for (int s = 0; s < 2; ++s) {
                const LAS unsigned char* vp = vst + (dh * 2 + s) * 1024 + vtr;
                const v4i16_t lo = __builtin_amdgcn_ds_read_tr16_b64_v4i16((LAS v4i16_t*)vp), hh = __builtin_amdgcn_ds_read_tr16_b64_v4i16((LAS v4i16_t*)(vp + 512));
                const bf16x8 vb = (bf16x8){lo[0], lo[1], lo[2], lo[3], hh[0], hh[1], hh[2], hh[3]};
                if (dh == 0) o0 = __builtin_amdgcn_mfma_f32_32x32x16_bf16(s == 0 ? pa0 : pa1, vb, o0, 0, 0, 0);
                else         o1 = __builtin_amdgcn_mfma_f32_32x32x16_bf16(s == 0 ? pa0 : pa1, vb, o1, 0, 0, 0);
            }
    }
    lsum += __shfl_xor(lsum, 32);
    LAS float* oacc = (LAS float*)(lds + OACC_OFF); LAS float* lacc = (LAS float*)(lds + LACC_OFF);
    if (hi == 0 && c < NQ) __hip_atomic_fetch_add(lacc + toff + c * d, lsum, __ATOMIC_RELAXED, __HIP_MEMORY_SCOPE_WORKGROUP);
#pragma unroll
    for (int r = 0; r < (NQ == 32 ? 16 : 8); ++r) {
        const int q = crow(r, hi); LAS float* row = oacc + (toff + q * d) * 64 + c;
        __hip_atomic_fetch_add(row, o0[r], __ATOMIC_RELAXED, __HIP_MEMORY_SCOPE_WORKGROUP);
        __hip_atomic_fetch_add(row + 32, o1[r], __ATOMIC_RELAXED, __HIP_MEMORY_SCOPE_WORKGROUP);
    }
}

__device__ __forceinline__ void unit(Frame& F, int uidx) {
    const int span = uidx % NSPAN, bh = uidx / NSPAN, h = bh % NH, b = bh / NH, t0 = span * SPAN;
    LAS unsigned char* lds = F.lds;
    LAS float* oacc = (LAS float*)(lds + OACC_OFF); LAS float* lacc = (LAS float*)(lds + LACC_OFF); LAS float* lut = (LAS float*)(lds + LUT_OFF);
    for (int i = F.tid; i < (SPAN * 64 + SPAN) / 4; i += NWAVES * 64) ((LAS f32x4*)oacc)[i] = (f32x4){0.f, 0.f, 0.f, 0.f};
    if (F.tid < 387) { const int pat = F.tid / 129, rel = F.tid - pat * 129, d = pat == 0 ? 1 : (pat == 1 ? 4 : 16); lut[F.tid] = F.I.rel_bias[t5_bucket(rel * d) * NH + h] * LOG2E; }
    __syncthreads();
    const size_t boff = (size_t)b * SEQ * DM + h * HD;
    const bf16 *Qb = F.Q + boff, *Kb = F.K + boff, *Vb = F.V + boff;
    const int w = F.wave;
    item<32>(Qb, Kb, Vb, t0 + 32 * w, 1, 0, 32 * w, lds, w, F.lane);
    __builtin_amdgcn_sched_barrier(0);
    item<32>(Qb, Kb, Vb, t0 + (w & 3) + 128 * (w >> 2), 4, 1, (w & 3) + 128 * (w >> 2), lds, w, F.lane);
    __builtin_amdgcn_sched_barrier(0);
    item<16>(Qb, Kb, Vb, t0 + w, 16, 2, w, lds, w, F.lane);
    __builtin_amdgcn_sched_barrier(0);
    item<16>(Qb, Kb, Vb, t0 + w + 8, 16, 2, w + 8, lds, w, F.lane);
    __syncthreads();
    bf16* ap = F.AU + ((size_t)b * SEQ + t0 + 32 * w) * 2048 + 1024 + h * HD + F.lane;
#pragma unroll 4
    for (int i = 0; i < 32; ++i) {
        const float o = oacc[(32 * w + i) * 64 + F.lane], l = lacc[32 * w + i];
        bf16* gp = ap + (size_t)i * 2048;
        *gp = (bf16)f2bf(o * __builtin_amdgcn_rcpf(l) * bf2f(*gp));
    }
    __syncthreads();
}

}

namespace ssd {
typedef float f32x16 __attribute__((ext_vector_type(16)));
typedef short v4i16_t __attribute__((ext_vector_type(4)));
typedef unsigned u32x2 __attribute__((ext_vector_type(2)));
typedef float f32x2v __attribute__((ext_vector_type(2)));
constexpr int PITCH = 272;
constexpr int BT_OFF = 0, CT_OFF = 34816, G_OFF = 69632, HB_OFF = 104448, XD_OFF = 121856, XH_OFF = 138240, ACS_OFF = 154624, DTL_OFF = ACS_OFF + 512, SSQL_OFF = DTL_OFF + 512, XW_OFF = SSQL_OFF + 512  , FW_OFF = XW_OFF + 1280  , SSD_LDS_END = FW_OFF + 5120;
static_assert(SSD_LDS_END <= LDSCTL_OFF, "SSD LDS");
__device__ __forceinline__ int crow(int r, int hi) { return (r & 3) + 8 * (r >> 2) + 4 * hi; }
__device__ __forceinline__ bf16x8 trfrag(const LAS unsigned char* p0, const LAS unsigned char* p1) {
    const v4i16_t lo = __builtin_amdgcn_ds_read_tr16_b64_v4i16((LAS v4i16_t*)p0), hh = __builtin_amdgcn_ds_read_tr16_b64_v4i16((LAS v4i16_t*)p1);
    return (bf16x8){lo[0], lo[1], lo[2], lo[3], hh[0], hh[1], hh[2], hh[3]};
}
__device__ __forceinline__ float bflo(unsigned w) { return __uint_as_float(w << 16); }
__device__ __forceinline__ float bfhi(unsigned w) { return __uint_as_float(w & 0xffff0000u); }

__device__ __forceinline__ void chain(Frame& F, int bh) {
    const Ins& I = F.I;
    const int b = bh >> 4, hd = bh & 15, grp = hd >> 3;
    const int tid = F.tid, lane = F.lane, w = F.wave, c = lane & 31, hi = lane >> 5;
    LAS unsigned char* lds = F.lds;
    LAS float* acs = (LAS float*)(lds + ACS_OFF); LAS float* dtl = (LAS float*)(lds + DTL_OFF); LAS float* ssql = (LAS float*)(lds + SSQL_OFF);
    const float A = -__expf(I.a_log[hd]), dsk = I.d_skip[hd];
    const size_t row0 = (size_t)b * SEQ;
    for (int i = tid; i < 17408 / 16; i += NWAVES * 64) ((LAS v4u*)(lds + HB_OFF))[i] = (v4u){0u, 0u, 0u, 0u};
    f32x16 hacc = {};
    const int pt = w & 1, jt = w >> 1;
    const int q4 = (lane & 15) >> 2, odd = (lane >> 4) & 1, p4 = lane & 3;
    const int xtr = (8 * hi + q4) * 64 + (16 * odd + 4 * p4) * 2;
    const int xg = tid & 15, xr0 = (tid >> 4) * 4;
    const int fb = tid >> 8, fc = tid & 255;
    for (int i = tid; i < 5 * 64 + 5 * 256; i += NWAVES * 64) {
        if (i < 320) { const int t = i >> 6, e = i & 63; ((LAS float*)(lds + XW_OFF))[i] = t < 4 ? I.conv_w[t * CONVD + hd * 64 + e] : I.conv_b[hd * 64 + e]; }
        else { const int k = i - 320, t = k >> 8, e = k & 255, chn = 1024 + (e < 128 ? grp * 128 + e : 256 + grp * 128 + (e - 128)); ((LAS float*)(lds + FW_OFF))[k] = t < 4 ? I.conv_w[t * CONVD + chn] : I.conv_b[chn]; }
    }
    const int xoff = ((xg >> 3) << 10) + (xg & 7) * 8;
    float dtp0, dtp1; u32x2 xr[7]; v4u bcr[8]; float fxr[6]; u32x2 zr[4];
#define SSD_PREFETCH(T0) do { int t0_ = (T0), tv_ = tid, lv_ = lane; asm volatile("" : "+v"(t0_), "+v"(tv_), "+v"(lv_)); \
        const int xg_ = tv_ & 15, xr0_ = (tv_ >> 4) * 4, fb_ = tv_ >> 8, fc_ = tv_ & 255, fch_ = fc_ < 128 ? grp * 128 + fc_ : 256 + grp * 128 + (fc_ - 128); \
        { const float* dp_ = F.DT + (size_t)hd * MROWS + row0 + t0_ + 2 * lv_; dtp0 = dp_[0]; dtp1 = dp_[1]; } \
        { const bf16* xp_ = F.XBC + (row0 + t0_ + xr0_) * CONVD + hd * 64 + 4 * xg_; \
          _Pragma("unroll") for (int j = 0; j < 7; ++j) xr[j] = (t0_ + xr0_ - 3 + j) >= 0 ? *(const u32x2*)(xp_ + (j - 3) * CONVD) : (u32x2){0u, 0u}; } \
        { const bf16* bp_ = F.XBC + (row0 + t0_ + (tv_ >> 4)) * CONVD + 1024 + grp * 128 + 8 * (tv_ & 15); \
          _Pragma("unroll") for (int k = 0; k < 4; ++k) { bcr[k] = *(const v4u*)(bp_ + (size_t)k * 32 * CONVD); bcr[4 + k] = *(const v4u*)(bp_ + (size_t)k * 32 * CONVD + 256); } } \
        { const size_t blk = (row0 + t0_ + 64 * fb_) >> 6; const bool hasprev = (t0_ + 64 * fb_) > 0; const float* rp_ = F.RAWB + (blk * 6) * 512 + fch_; \
          _Pragma("unroll") for (int j = 0; j < 3; ++j) { fxr[j] = hasprev ? rp_[(j - 6) * 512] : 0.f; fxr[3 + j] = rp_[(3 + j) * 512]; } } \
    } while (0)
#define SSD_PREFETCH_Z(T0) do { int t0_ = (T0), lv_ = lane; asm volatile("" : "+v"(t0_), "+v"(lv_)); \
        const bf16* zp_ = F.AU + (row0 + t0_ + 32 * jt + (lv_ & 31)) * 2048 + hd * 64 + 32 * pt + 4 * (lv_ >> 5); \
        _Pragma("unroll") for (int g4 = 0; g4 < 4; ++g4) zr[g4] = *(const u32x2*)(zp_ + 8 * g4); } while (0)
    SSD_PREFETCH(0); SSD_PREFETCH_Z(0);
    __syncthreads();
#pragma unroll 1
    for (int ch = 0; ch < SEQ / 128; ++ch) {
        const int t0 = ch * 128;
        float aend;
        {
            if (w == 0 && ch > 0) { F.SSQ[(row0 + t0 - 128 + lane) * 16 + hd] = ssql[lane]; F.SSQ[(row0 + t0 - 64 + lane) * 16 + hd] = ssql[64 + lane]; }
            const float v0 = dtp0 * A, v1 = dtp1 * A; float s = v0 + v1;
#pragma unroll
            for (int o = 1; o < 64; o <<= 1) { const float t = __shfl_up(s, o); if (lane >= o) s += t; }
            aend = __shfl(s, 63);
            *(LAS f32x2v*)(acs + 2 * lane) = (f32x2v){s - v1, s}; *(LAS f32x2v*)(dtl + 2 * lane) = (f32x2v){dtp0, dtp1};
            if (w == 0) { ssql[lane] = 0.f; ssql[64 + lane] = 0.f; }
        }
#pragma unroll
        for (int k = 0; k < 4; ++k) { const int idx = tid + 512 * k, row = idx >> 4;
            if ((row & 63) >= 3) { *(LAS v4u*)(lds + BT_OFF + row * PITCH + 16 * (idx & 15)) = bcr[k]; *(LAS v4u*)(lds + CT_OFF + row * PITCH + 16 * (idx & 15)) = bcr[4 + k]; } }
        {
            LAS unsigned char* dst = lds + (fc < 128 ? BT_OFF + 2 * fc : CT_OFF + 2 * (fc - 128)) + 64 * fb * PITCH;
            const LAS float* fwp = (const LAS float*)(lds + FW_OFF) + fc;
            const float fw0 = fwp[0], fw1 = fwp[256], fw2 = fwp[512], fw3 = fwp[768], fbias = fwp[1024];
#pragma unroll
            for (int j = 0; j < 3; ++j) *(LAS bf16*)(dst + j * PITCH) = (bf16)f2bf(silu_fast(fbias + fw0 * fxr[j] + fw1 * fxr[j + 1] + fw2 * fxr[j + 2] + fw3 * fxr[j + 3]));
        }
        {
            const LAS f32x4* xwp = (const LAS f32x4*)(lds + XW_OFF) + xg;
            const f32x4 xw0 = xwp[0], xw1 = xwp[16], xw2 = xwp[32], xw3 = xwp[48], xb = xwp[64];
            float xv[7][4];
#pragma unroll
            for (int j = 0; j < 7; ++j) { xv[j][0] = bflo(xr[j].x); xv[j][1] = bfhi(xr[j].x); xv[j][2] = bflo(xr[j].y); xv[j][3] = bfhi(xr[j].y); }
#pragma unroll
            for (int i = 0; i < 4; ++i) {
                const int s = xr0 + i; const float dt = dtl[s], de = dt * __expf(aend - acs[s]); float v[4];
#pragma unroll
                for (int e = 0; e < 4; ++e) v[e] = silu_fast(xb[e] + xw0[e] * xv[i][e] + xw1[e] * xv[i + 1][e] + xw2[e] * xv[i + 2][e] + xw3[e] * xv[i + 3][e]);
                const int off = ((s >> 4) << 11) + xoff + (s & 15) * 64;
                *(LAS u32x2*)(lds + XD_OFF + off) = (u32x2){pk2(v[0] * dt, v[1] * dt), pk2(v[2] * dt, v[3] * dt)};
                *(LAS u32x2*)(lds + XH_OFF + off) = (u32x2){pk2(v[0] * de, v[1] * de), pk2(v[2] * de, v[3] * de)};
            }
        }
        asm volatile("" ::: "memory"); __builtin_amdgcn_sched_barrier(0);
        if (ch + 1 < SEQ / 128) SSD_PREFETCH(t0 + 128);
        __syncthreads();
        {
            const int j = w & 3; const float al = acs[32 * j + c];
#pragma unroll
            for (int ii = 0; ii < 2; ++ii) {
                const int i = 2 * (w >> 2) + ii;
                if (i <= j) {
                    f32x16 x = {};
                    const LAS unsigned char* ap = lds + BT_OFF + (32 * i + c) * PITCH + 16 * hi;
                    const LAS unsigned char* bp = lds + CT_OFF + (32 * j + c) * PITCH + 16 * hi;
#pragma unroll 4
                    for (int ks = 0; ks < 8; ++ks) x = __builtin_amdgcn_mfma_f32_32x32x16_bf16(*(const LAS bf16x8*)(ap + 32 * ks), *(const LAS bf16x8*)(bp + 32 * ks), x, 0, 0, 0);
                    const int l = 32 * j + c;
#pragma unroll
                    for (int g4 = 0; g4 < 4; ++g4) {
                        const int sb = 32 * i + 8 * g4 + 4 * hi; float gv[4];
                        const f32x4 as4 = *(const LAS f32x4*)(acs + sb);
#pragma unroll
                        for (int e = 0; e < 4; ++e) { const int s = sb + e; gv[e] = s <= l ? x[4 * g4 + e] * __builtin_amdgcn_exp2f((al - as4[e]) * LOG2E) : 0.f; }
                        *(LAS u32x2*)(lds + G_OFF + l * PITCH + sb * 2) = (u32x2){pk2(gv[0], gv[1]), pk2(gv[2], gv[3])};
                    }
                }
            }
        }
        f32x16 yt = {};
        {
            const LAS unsigned char* ap = lds + HB_OFF + (32 * pt + c) * PITCH + 16 * hi;
            const LAS unsigned char* bp = lds + CT_OFF + (32 * jt + c) * PITCH + 16 * hi;
#pragma unroll 4
            for (int ks = 0; ks < 8; ++ks) yt = __builtin_amdgcn_mfma_f32_32x32x16_bf16(*(const LAS bf16x8*)(ap + 32 * ks), *(const LAS bf16x8*)(bp + 32 * ks), yt, 0, 0, 0);
            const float el = __expf(acs[32 * jt + c]);
#pragma unroll
            for (int r = 0; r < 16; ++r) yt[r] *= el;
        }
        __syncthreads();
        {
            const LAS unsigned char* bp = lds + G_OFF + (32 * jt + c) * PITCH + 16 * hi;
            for (int ks = 0; ks < 2 * jt + 2; ++ks) {
                const LAS unsigned char* xp = lds + XD_OFF + ((ks * 2 + pt) << 10) + xtr;
                yt = __builtin_amdgcn_mfma_f32_32x32x16_bf16(trfrag(xp, xp + 256), *(const LAS bf16x8*)(bp + 32 * ks), yt, 0, 0, 0);
            }
        }
        {
            const float ea = __expf(aend);
#pragma unroll
            for (int r = 0; r < 16; ++r) hacc[r] *= ea;
            const int btr = (8 * hi + q4) * PITCH + (32 * jt + 16 * odd + 4 * p4) * 2;
#pragma unroll 4
            for (int ks = 0; ks < 8; ++ks) {
                const LAS unsigned char* xp = lds + XH_OFF + ((ks * 2 + pt) << 10) + xtr;
                const LAS unsigned char* bp = lds + BT_OFF + 16 * ks * PITCH + btr;
                hacc = __builtin_amdgcn_mfma_f32_32x32x16_bf16(trfrag(xp, xp + 256), trfrag(bp, bp + 4 * PITCH), hacc, 0, 0, 0);
            }
        }
        {
            const int l = 32 * jt + c; const float rdt = dsk * __builtin_amdgcn_rcpf(dtl[l]);
            bf16* up = F.AU + (row0 + t0 + l) * 2048 + hd * 64 + 32 * pt;
            float sq = 0.f;
#pragma unroll
            for (int g4 = 0; g4 < 4; ++g4) {
                const int pl = 8 * g4 + 4 * hi;
                const u32x2 xw2 = *(const LAS u32x2*)(lds + XD_OFF + (((l >> 4) * 2 + pt) << 10) + (l & 15) * 64 + pl * 2);
                const u32x2 zw = zr[g4];
                const float u0 = (yt[4 * g4] + rdt * bflo(xw2.x)) * bflo(zw.x), u1 = (yt[4 * g4 + 1] + rdt * bfhi(xw2.x)) * bfhi(zw.x), u2 = (yt[4 * g4 + 2] + rdt * bflo(xw2.y)) * bflo(zw.y), u3 = (yt[4 * g4 + 3] + rdt * bfhi(xw2.y)) * bfhi(zw.y);
                sq += (u0 * u0 + u1 * u1) + (u2 * u2 + u3 * u3);
                *(u32x2*)(up + pl) = (u32x2){pk2(u0, u1), pk2(u2, u3)};
            }
            sq += __shfl_xor(sq, 32);
            if (hi == 0) __hip_atomic_fetch_add(ssql + l, sq, __ATOMIC_RELAXED, __HIP_MEMORY_SCOPE_WORKGROUP);
            if (ch + 1 < SEQ / 128) SSD_PREFETCH_Z(t0 + 128);
        }
        __syncthreads();
#pragma unroll
        for (int r = 0; r < 16; ++r) *(LAS bf16*)(lds + HB_OFF + (32 * pt + crow(r, hi)) * PITCH + (32 * jt + c) * 2) = (bf16)f2bf(hacc[r]);
    }
#undef SSD_PREFETCH
#undef SSD_PREFETCH_Z
    if (w == 0) { const int t0 = SEQ; F.SSQ[(row0 + t0 - 128 + lane) * 16 + hd] = ssql[lane]; F.SSQ[(row0 + t0 - 64 + lane) * 16 + hd] = ssql[64 + lane]; }
    float* ho = F.out + O_HP + (((size_t)b * NH + hd) * HD + 32 * pt) * DS + 32 * jt + c;
#pragma unroll
    for (int r = 0; r < 16; ++r) ho[(size_t)crow(r, hi) * DS] = hacc[r];
    __syncthreads();
}
}

namespace smp {
__device__ __forceinline__ void attn_unit(Frame& F, int su) {
    const Ins& I = F.I;
    const int lane = F.lane, w = F.wave, bhs = su * 8 + w, b = bhs >> 4, h = bhs & 15, r = NTOK + b;
    LAS float* qs = (LAS float*)(F.lds + att::VST_OFF + w * att::VST_BYTES); LAS float* ps = qs + 64;
    qs[lane] = bf2f(F.Q[(size_t)r * DM + h * HD + lane]);
    __builtin_amdgcn_wave_barrier();
    float mx = -INFINITY;
#pragma unroll 1
    for (int it = 0; it < 7; ++it) {
        const int idx = it * 64 + lane;
        if (idx < 387) {
            const int pat = idx / 129, j = idx - pat * 129, d = pat == 0 ? 1 : (pat == 1 ? 4 : 16);
            float s = 0.f;
            if (j > 0) { const f32x4* kp = (const f32x4*)(I.ck + (((size_t)b * WIN + (WIN - j * d)) * NH + h) * HD);
#pragma unroll
                for (int e = 0; e < 16; ++e) { const f32x4 kv = kp[e]; s += (qs[4 * e] * kv[0] + qs[4 * e + 1] * kv[1]) + (qs[4 * e + 2] * kv[2] + qs[4 * e + 3] * kv[3]); } }
            else { const bf16* kp = F.K + (size_t)r * DM + h * HD; for (int e = 0; e < 64; ++e) s += qs[e] * bf2f(kp[e]); }
            s += I.rel_bias[t5_bucket(j * d) * NH + h] * LOG2E;
            ps[idx] = s; mx = fmaxf(mx, s);
        }
    }
    mx = wave_max(mx);
    float sum = 0.f;
#pragma unroll 1
    for (int idx = lane; idx < 387; idx += 64) { const float p = __builtin_amdgcn_exp2f(ps[idx] - mx); ps[idx] = p; sum += p; }
    sum = wave_sum(sum);
    __builtin_amdgcn_wave_barrier();
    float o = 0.f;
#pragma unroll 1
    for (int pat = 0; pat < 3; ++pat) {
        const int d = pat == 0 ? 1 : (pat == 1 ? 4 : 16);
        o += ps[pat * 129] * bf2f(F.V[(size_t)r * DM + h * HD + lane]);
        const float* vp = I.cv + (((size_t)b * WIN + WIN) * NH + h) * HD + lane;
#pragma unroll 8
        for (int j = 1; j < 129; ++j) o += ps[pat * 129 + j] * vp[-(ptrdiff_t)j * d * (NH * HD)];
    }
    bf16* gp = F.AU + (size_t)r * 2048 + 1024 + h * HD + lane;
    *gp = (bf16)f2bf(o * __builtin_amdgcn_rcpf(sum) * bf2f(*gp));
}

__device__ __forceinline__ void ssd_unit(Frame& F, int su) {
    const Ins& I = F.I;
    LAS float* xs_l = (LAS float*)F.lds; LAS float* B_l = xs_l + 64; LAS float* C_l = B_l + 128; LAS float* ssq_l = C_l + 128;
    const int tid = F.tid, p = tid >> 3, ng = tid & 7;
#pragma unroll 1
    for (int k = 0; k < 8; ++k) {
        const int bhs = su * 8 + k, b = bhs >> 4, hd = bhs & 15, grp = hd >> 3; const size_t r = (size_t)NTOK + b;
        float h[16];
        { const f32x4* hp = (const f32x4*)(I.sssm + (((size_t)b * NH + hd) * HD + p) * DS + ng * 16);
#pragma unroll
          for (int i = 0; i < 4; ++i) { const f32x4 v = hp[i]; h[4 * i] = v[0]; h[4 * i + 1] = v[1]; h[4 * i + 2] = v[2]; h[4 * i + 3] = v[3]; } }
        if (tid < 320) {
            const int ci = tid, c = ci < 64 ? hd * 64 + ci : (ci < 192 ? 1024 + grp * 128 + (ci - 64) : 1280 + grp * 128 + (ci - 192));
            float v = I.conv_b[c];
#pragma unroll
            for (int i = 0; i < 3; ++i) v += I.sconv[((size_t)b * 3 + i) * CONVD + c] * I.conv_w[i * CONVD + c];
            v += bf2f(F.XBC[r * CONVD + c]) * I.conv_w[3 * CONVD + c];
            xs_l[ci] = silu_f(v);
        }
        if (tid == 0) ssq_l[0] = 0.f;
        __syncthreads();
        const float dt = F.DT[(size_t)hd * MROWS + r], A = -__expf(I.a_log[hd]), x = xs_l[p], dec = __expf(dt * A), xdt = x * dt;
        float y = 0.f;
#pragma unroll
        for (int i = 0; i < 16; ++i) { h[i] = h[i] * dec + xdt * B_l[ng * 16 + i]; y += h[i] * C_l[ng * 16 + i]; }
        y += __shfl_xor(y, 1); y += __shfl_xor(y, 2); y += __shfl_xor(y, 4);
        if (ng == 0) {
            bf16* zp = F.AU + r * 2048 + hd * 64 + p;
            const float u = (y + I.d_skip[hd] * x) * bf2f(*zp);
            *zp = (bf16)f2bf(u);
            __hip_atomic_fetch_add(ssq_l, u * u, __ATOMIC_RELAXED, __HIP_MEMORY_SCOPE_WORKGROUP);
        }
        { f32x4* ho = (f32x4*)(F.out + O_HS + (((size_t)b * NH + hd) * HD + p) * DS + ng * 16);
#pragma unroll
          for (int i = 0; i < 4; ++i) ho[i] = (f32x4){h[4 * i], h[4 * i + 1], h[4 * i + 2], h[4 * i + 3]}; }
        __syncthreads();
        if (tid == 0) F.SSQ[r * 16 + hd] = ssq_l[0];
        __syncthreads();
    }
}
}

__device__ __forceinline__ void phase2_queue(Frame& F) {
    const unsigned x = xb_xcc_id() & 7u;
    constexpr int PER_Q = att::NUNITS / 8;
    for (unsigned k = 0; k < 8; ++k) {
        const unsigned qx = (x + k) & 7u;
        for (;;) {
            if (F.tid == 0) F.MISC[16] = __hip_atomic_fetch_add(F.ctl + CW_Q + 64 * qx, 1u, RLX_AGENT);
            __syncthreads();
            const unsigned idx = F.MISC[16];
            __syncthreads();
            if (idx >= (unsigned)(PER_Q + 16)) break;
            if (idx < 8u) { smp::attn_unit(F, (int)(qx * 8 + idx)); __syncthreads(); }
            else if (idx < 16u) smp::ssd_unit(F, (int)(qx * 8 + idx - 8));
            else att::unit(F, (int)(qx * PER_Q + idx - 16));
        }
    }
}

struct Args { Ins in; float* out; unsigned char* ws; int ph_lo, ph_hi; };
__global__ void __launch_bounds__(NWAVES * 64, 2) mk_fwd(Args args) {
    extern __shared__ __attribute__((aligned(16))) unsigned char lds[];
    Frame F;
    F.lds = (LAS unsigned char*)lds;
    F.MISC = (volatile LAS unsigned*)(F.lds + MISC_OFF);
    F.tid = threadIdx.x; F.lane = F.tid & 63; F.wave = __builtin_amdgcn_readfirstlane(F.tid >> 6);
    F.G = gridDim.x; { const int bx = blockIdx.x; F.vcu = (F.G % 8 == 0) ? (bx % 8) * (F.G / 8) + bx / 8 : bx; }
    unsigned char* ws = args.ws;
    F.ctl = (gu32*)(ws + WS_CTL); F.I = args.in; F.out = args.out;
    F.WinT = (bf16*)(ws + WS_WIN); F.WoutT = (bf16*)(ws + WS_WOUT); F.XN = (bf16*)(ws + WS_XN); F.Q = (bf16*)(ws + WS_Q); F.K = (bf16*)(ws + WS_K); F.V = (bf16*)(ws + WS_V);
    F.AU = (bf16*)(ws + WS_AU); F.XBC = (bf16*)(ws + WS_XBC); F.DT = (float*)(ws + WS_DT); F.SSQ = (float*)(ws + WS_SSQ); F.RAWB = (float*)(ws + WS_RAWB);
    for (int u = F.tid; u < (LDS_BYTES - LDSCTL_OFF) / 4; u += NWAVES * 64) ((LAS unsigned*)(F.lds + LDSCTL_OFF))[u] = 0u;
    __syncthreads();
    XcdBarrier bar = xcd_barrier_post((unsigned*)(F.ctl + CW_BAR), F.MISC + 8);
    const int lo = args.ph_lo, hi = args.ph_hi;
#define IN(k) (lo <= (k) && (k) < hi)
#define BOTH(k) (IN(k) && IN((k) + 1))
    if (IN(0)) { p0_prologue(F); if (BOTH(0)) xcd_barrier(bar); }
    if (IN(1)) {
        __syncthreads();
        pg8::Gemm g{F.XN, F.WinT, MROWS, NMAIN, DM}; pg8::StaticOrder S; S.init(MROWS, NMAIN, F.G, (int)blockIdx.x);
        pg8::EpiIn E{F.Q, F.K, F.V, F.AU, F.XBC, F.out, F.I.qnw, F.I.knw, F.I.conv_w, F.I.conv_b, F.RAWB};
        pg8::gemm_phase<pg8::EpiIn, pg8::StaticOrder, true, true>(F.lds + RING_OFF, g, S, E);
        if (BOTH(1)) xcd_barrier(bar);
    }
    if (IN(2)) { __syncthreads(); if ((F.vcu & 31) < 8 && (F.vcu >> 5) < 8) ssd::chain(F, (F.vcu >> 5) * 8 + (F.vcu & 31)); phase2_queue(F);     if (BOTH(2)) xcd_barrier(bar); }
    if (IN(3)) {
        __syncthreads();
        pg8::Gemm g{F.AU, F.WoutT, MROWS, DM, 2048}; pg8::StaticOrder S; S.init(MROWS, DM, F.G, (int)blockIdx.x);
        LAS float* rs = (LAS float*)(F.lds + RING_BYTES);
        { pg8::Unit u;
          for (int ui = 0; ui < 4 && S.next(ui, u); ++ui)
              for (int r = F.tid; r < 256; r += NWAVES * 64) {
                  const f32x4* sp = (const f32x4*)(F.SSQ + (size_t)(u.pm * 256 + r) * 16);
                  const f32x4 s0 = sp[0], s1 = sp[1], s2 = sp[2], s3 = sp[3];
                  const float s = ((s0[0] + s0[1]) + (s0[2] + s0[3])) + ((s1[0] + s1[1]) + (s1[2] + s1[3])) + ((s2[0] + s2[1]) + (s2[2] + s2[3])) + ((s3[0] + s3[1]) + (s3[2] + s3[3]));
                  rs[ui * 256 + r] = rsqrtf(s * (1.f / 1024.f) + EPS);
              }
          __syncthreads(); }
        pg8::EpiOut E{F.I.xp, F.I.xs, rs, F.out};
        pg8::gemm_phase<pg8::EpiOut, pg8::StaticOrder, true, true>(F.lds + RING_OFF, g, S, E);
    }
#undef IN
#undef BOTH
}

extern "C" void kernel_launch(void* const* d_in, const int* in_sizes, int n_in, void* d_out, int out_size, void* d_ws, size_t ws_size, hipStream_t stream) {
    static int grid = 0;
    if (grid == 0) {
        if (n_in != 18 || out_size != (int)O_END || ws_size < WS_END) { fprintf(stderr, "kernel_launch: unexpected n_in %d / out_size %d / ws_size %zu; nothing launched\n", n_in, out_size, ws_size); grid = -1; return; }
        int dev = 0, cus = 0;
        if (hipGetDevice(&dev) != hipSuccess || hipDeviceGetAttribute(&cus, hipDeviceAttributeMultiprocessorCount, dev) != hipSuccess) { grid = -1; return; }
        if (hipFuncSetAttribute((const void*)mk_fwd, hipFuncAttributeMaxDynamicSharedMemorySize, LDS_BYTES) != hipSuccess) { fprintf(stderr, "kernel_launch: hipFuncSetAttribute failed\n"); grid = -1; return; }
        (void)hipGetLastError();
        grid = cus;
    }
    if (grid < 0) return;
    (void)hipMemsetAsync((char*)d_ws + WS_CTL, 0, CTL_ZERO_BYTES, stream);
    Args a{};
    const float** ip = (const float**)&a.in;
    for (int i = 0; i < 18; ++i) ip[i] = (const float*)d_in[i];
    a.out = (float*)d_out; a.ws = (unsigned char*)d_ws;
    a.ph_lo = 0; a.ph_hi = 4;
    hipLaunchKernelGGL(mk_fwd, dim3(grid), dim3(NWAVES * 64), LDS_BYTES, stream, a);
}
```

```cpp
#include <hip/hip_runtime.h>
#include <cstdio>
#include <cstdint>

constexpr int DM = 1024, NB = 4, SEQ = 8192, DB = 32, WIN = 2048;
constexpr int NPROJ = 6672, NMAIN = 6656, NTOK = NB * SEQ, NROWS = NTOK + DB;
constexpr int MROWS = 33024;
constexpr int C_Q = 0, C_K = 1024, C_V = 2048, C_G = 3072, C_Z = 4096, C_XBC = 5120, C_DT = 6656;
constexpr int CONVD = 1536, NH = 16, HD = 64, DS = 128;
constexpr float EPS = 1e-6f;
constexpr float QSCALE = 0.125f * 1.4426950408889634f;
constexpr float LOG2E = 1.4426950408889634f;
constexpr size_t O_YP = 0, O_YS = O_YP + (size_t)NTOK * DM, O_KP = O_YS + (size_t)DB * DM, O_VP = O_KP + (size_t)NB * WIN * DM,
                 O_CP = O_VP + (size_t)NB * WIN * DM, O_HP = O_CP + (size_t)NB * 3 * CONVD, O_KS = O_HP + (size_t)NB * NH * HD * DS,
                 O_VS = O_KS + (size_t)DB * DM, O_CS = O_VS + (size_t)DB * DM, O_HS = O_CS + (size_t)DB * 3 * CONVD,
                 O_END = O_HS + (size_t)DB * NH * HD * DS;
static_assert(O_END == 55314432, "output size");

constexpr size_t MiB = 1u << 20;
constexpr size_t WS_CTL = 0, CTL_ZERO_BYTES = 1 * MiB;
constexpr size_t WS_WIN = 2 * MiB;
constexpr size_t WS_WOUT = 16 * MiB;
constexpr size_t WS_DT = 20 * MiB;
constexpr size_t WS_SSQ = 24 * MiB;
constexpr size_t WS_XN = 32 * MiB;
constexpr size_t WS_Q = 100 * MiB;
constexpr size_t WS_K = 168 * MiB;
constexpr size_t WS_V = 236 * MiB;
constexpr size_t WS_AU = 304 * MiB;
constexpr size_t WS_XBC = 436 * MiB;
constexpr size_t WS_RAWB = 536 * MiB;
constexpr size_t WS_G = 544 * MiB;
constexpr size_t WS_Z = 612 * MiB;
constexpr size_t WS_END = 680 * MiB;
static_assert(WS_XN + (size_t)MROWS * DM * 2 <= WS_Q && WS_Q + (size_t)MROWS * DM * 2 <= WS_K && WS_K + (size_t)MROWS * DM * 2 <= WS_V && WS_V + (size_t)MROWS * DM * 2 <= WS_AU &&
              WS_AU + (size_t)MROWS * 2048 * 2 <= WS_XBC && WS_XBC + (size_t)MROWS * CONVD * 2 <= WS_RAWB && WS_RAWB + (size_t)(MROWS / 64) * 6 * 512 * 4 <= WS_G && WS_G + (size_t)MROWS * DM * 2 <= WS_Z && WS_Z + (size_t)MROWS * DM * 2 <= WS_END && WS_WIN + (size_t)NMAIN * DM * 2 <= WS_WOUT && WS_WOUT + (size_t)DM * 2048 * 2 <= WS_DT &&
              WS_DT + (size_t)MROWS * 16 * 4 <= WS_SSQ && WS_SSQ + (size_t)MROWS * 16 * 4 <= WS_XN, "d_ws map");

struct Ins {
    const float *xp, *xs, *ck, *cv, *sconv, *sssm, *norm_w, *w_in, *qnw, *knw, *rel_bias, *conv_w, *conv_b, *dt_bias, *a_log, *d_skip, *ssd_norm_w, *w_out;
};

typedef unsigned short bf16;
__device__ __forceinline__ float wave_sum(float v) {
#pragma unroll
    for (int o = 1; o < 64; o <<= 1) v += __shfl_xor(v, o);
    return v;
}
__device__ __forceinline__ float wave_max(float v) {
#pragma unroll
    for (int o = 1; o < 64; o <<= 1) v = fmaxf(v, __shfl_xor(v, o));
    return v;
}
__device__ __forceinline__ float silu_f(float x) { return x / (1.f + __expf(-x)); }
__device__ __forceinline__ float silu_fast(float x) { return x * __builtin_amdgcn_rcpf(1.f + __builtin_amdgcn_exp2f(-LOG2E * x)); }
__device__ __forceinline__ float softplus_f(float x) { return x > 20.f ? x : log1pf(__expf(x)); }
__device__ __forceinline__ int t5_bucket(int d) {
    if (d < 16) return d;
    int b = 16;
    b += d >= 22; b += d >= 30; b += d >= 40; b += d >= 54; b += d >= 73; b += d >= 99; b += d >= 134; b += d >= 182;
    b += d >= 246; b += d >= 332; b += d >= 450; b += d >= 609; b += d >= 825; b += d >= 1117; b += d >= 1513;
    return b;
}
__device__ __forceinline__ const float* xrow(const Ins& I, int r) { return r < NTOK ? I.xp + (size_t)r * DM : I.xs + (size_t)(r - NTOK) * DM; }
__device__ __forceinline__ float bf2f(bf16 v) { return __uint_as_float((unsigned)v << 16); }
__device__ __forceinline__ unsigned f2bf(float f) { unsigned u = __float_as_uint(f); return (u + 0x7fffu + ((u >> 16) & 1u)) >> 16; }
__device__ __forceinline__ unsigned pk2(float lo, float hi) { return f2bf(lo) | (f2bf(hi) << 16); }
__host__ __device__ __forceinline__ int vrow_of_col(int a) { return 128 * ((a >> 5) & 1) + 32 * ((a >> 6) & 3) + (a & 31); }

namespace pg8 {
#define PG8_LAS __attribute__((address_space(3)))
typedef unsigned short bf16_t;
typedef short bf16x8 __attribute__((ext_vector_type(8)));
typedef float f32x4 __attribute__((ext_vector_type(4)));
typedef unsigned u32x4 __attribute__((ext_vector_type(4)));
constexpr int BM = 256, BK = 64, HALF = 128, HTB = HALF * BK * 2  , STAGE_BYTES = 8 * HTB, NXCD = 8, WGM = 8;

__host__ __device__ __forceinline__ int lds_byte(int r, int c) { const int st = (r >> 4) * 2 + (c >> 5), rr = r & 15, cc = c & 31, ob = rr * 64 + cc * 2; return st * 1024 + (ob ^ (((ob >> 9) & 1) << 5)); }
__host__ __device__ __forceinline__ void stage_rc(int b, int& R, int& C) { const int st = b / 1024, sb = b % 1024, swz = sb ^ (((sb >> 9) & 1) << 5); R = (st >> 1) * 16 + swz / 64; C = (st & 1) * 32 + (swz % 64) / 2; }
__host__ __device__ __forceinline__ int perm32(int rho) { const int n = rho >> 4, i = rho & 15; return 8 * (i >> 2) + 4 * n + (i & 3); }

struct Unit { int pm, pn; };
struct Gemm { const bf16_t* A; const bf16_t* Bt; int M, N, K; };

struct StaticOrder {
    int nM, nN, nwg, G, c;
    __host__ __device__ void init(int M, int N, int G_, int c_) { nM = M / BM; nN = N / BM; nwg = nM * nN; G = G_; c = c_; }
    __host__ __device__ bool next(int i, Unit& u) const {
        const long L = (long)i * G + c; if (L >= nwg) return false;
        int wgid = (int)L; { const int q = nwg / NXCD, r = nwg % NXCD, xcd = wgid % NXCD, off = wgid / NXCD; wgid = (xcd < r ? xcd * (q + 1) : r * (q + 1) + (xcd - r) * q) + off; }
        const int nig = WGM * nN, gid = wgid / nig, fm = gid * WGM, gsz = (nM - fm) < WGM ? (nM - fm) : WGM;
        u.pm = fm + ((wgid % nig) % gsz); u.pn = (wgid % nig) / gsz; return true;
    }
    __device__ __forceinline__ void a_ready(const Unit&) const {}
    __device__ __forceinline__ void done(const Unit&) const {}
};

__device__ __forceinline__ unsigned cvt_pk_bf16(float lo, float hi) { unsigned r; asm volatile("v_cvt_pk_bf16_f32 %0, %1, %2" : "=v"(r) : "v"(lo), "v"(hi)); return r; }

template <int K> __device__ __forceinline__ float rowprev(float cur, float prevm) {
    const int t = __builtin_amdgcn_update_dpp(0, __builtin_bit_cast(int, prevm), 0x100 + (16 - K), 0xf, 0xf, true);
    return __builtin_bit_cast(float, __builtin_amdgcn_update_dpp(t, __builtin_bit_cast(int, cur), 0x110 + K, 0xf, 0xf, false));
}

struct EpiIn {
    static constexpr bool PERM = true, AFTER_DRAIN = false, MIDK = false;
    bf16_t *Q, *K, *V, *Gb, *Zb, *XBC; float* out; const float *qnw, *knw, *conv_w, *conv_b; float* rawb;
    __device__ __forceinline__ void mid(f32x4 (&)[2][2][4][2], const Unit&, int, int, int, int, int) const {}
    __device__ __forceinline__ void operator()(const f32x4 (&acc)[2][2][4][2], const Unit& u, int wr, int wc, int fr, int fq) const {
        const int pn = u.pn;
        const int rowb = u.pm * BM + wr * 64 + fr;
        const int cl = wc * 64 + 8 * fq;
        if (pn < 8) {
            const bool isq = pn < 4; const float* nw = isq ? qnw : knw;
            f32x4 w[2][2];
#pragma unroll
            for (int bj = 0; bj < 2; ++bj)
#pragma unroll
                for (int n = 0; n < 2; ++n) w[bj][n] = *(const f32x4*)(nw + 8 * fq + 32 * bj + 4 * n);
            bf16_t* dstb = (isq ? Q : K) + (pn & 3) * 256 + cl;
#pragma unroll
            for (int ai = 0; ai < 2; ++ai)
#pragma unroll
                for (int m = 0; m < 4; ++m) {
                    const int r = rowb + ai * HALF + m * 16;
                    float ss = 0.f;
#pragma unroll
                    for (int bj = 0; bj < 2; ++bj)
#pragma unroll
                        for (int n = 0; n < 2; ++n) { const f32x4 v = acc[ai][bj][m][n]; ss += (v[0] * v[0] + v[1] * v[1]) + (v[2] * v[2] + v[3] * v[3]); }
                    ss += __shfl_xor(ss, 16); ss += __shfl_xor(ss, 32);
                    const float sc = rsqrtf(ss * (1.f / 64.f) + EPS), scs = isq ? sc * QSCALE : sc;
                    float* f32dst = nullptr;
                    if (!isq) { if (r < NTOK) { const int t = r & (SEQ - 1); if (t >= SEQ - WIN) f32dst = out + O_KP + ((size_t)((r >> 13) * WIN + t - (SEQ - WIN))) * DM + (pn & 3) * 256 + cl; }
                                else if (r < NROWS) f32dst = out + O_KS + (size_t)(r - NTOK) * DM + (pn & 3) * 256 + cl; }
#pragma unroll
                    for (int bj = 0; bj < 2; ++bj) {
                        const f32x4 a0 = acc[ai][bj][m][0] * w[bj][0], a1 = acc[ai][bj][m][1] * w[bj][1];
                        u32x4 o; o.x = cvt_pk_bf16(a0[0] * scs, a0[1] * scs); o.y = cvt_pk_bf16(a0[2] * scs, a0[3] * scs); o.z = cvt_pk_bf16(a1[0] * scs, a1[1] * scs); o.w = cvt_pk_bf16(a1[2] * scs, a1[3] * scs);
                        *(u32x4*)(dstb + (size_t)r * DM + 32 * bj) = o;
                        if (f32dst) { *(f32x4*)(f32dst + 32 * bj) = a0 * sc; *(f32x4*)(f32dst + 32 * bj + 4) = a1 * sc; }
                    }
                }
        } else if (pn < 12) {
            bf16_t* dstb = V + (pn & 3) * 256 + cl;
#pragma unroll
            for (int ai = 0; ai < 2; ++ai)
#pragma unroll
                for (int m = 0; m < 4; ++m) {
                    const int r = rowb + ai * HALF + m * 16;
                    float* f32dst = nullptr;
                    if (r < NTOK) { const int t = r & (SEQ - 1); if (t >= SEQ - WIN) f32dst = out + O_VP + ((size_t)((r >> 13) * WIN + t - (SEQ - WIN))) * DM + (pn & 3) * 256 + cl; }
                    else if (r < NROWS) f32dst = out + O_VS + (size_t)(r - NTOK) * DM + (pn & 3) * 256 + cl;
#pragma unroll
                    for (int bj = 0; bj < 2; ++bj) {
                        const f32x4 a0 = acc[ai][bj][m][0], a1 = acc[ai][bj][m][1];
                        u32x4 o; o.x = cvt_pk_bf16(a0[0], a0[1]); o.y = cvt_pk_bf16(a0[2], a0[3]); o.z = cvt_pk_bf16(a1[0], a1[1]); o.w = cvt_pk_bf16(a1[2], a1[3]);
                        *(u32x4*)(dstb + (size_t)r * DM + 32 * bj) = o;
                        if (f32dst) { *(f32x4*)(f32dst + 32 * bj) = a0; *(f32x4*)(f32dst + 32 * bj + 4) = a1; }
                    }
                }
        } else if (pn < 20) {
            bf16_t* dstb = (pn < 16 ? Gb : Zb) + (pn & 3) * 256 + cl;
#pragma unroll
            for (int ai = 0; ai < 2; ++ai)
#pragma unroll
                for (int m = 0; m < 4; ++m) {
                    const int r = rowb + ai * HALF + m * 16;
#pragma unroll
                    for (int bj = 0; bj < 2; ++bj) {
                        f32x4 a0 = acc[ai][bj][m][0], a1 = acc[ai][bj][m][1];
#pragma unroll
                        for (int i = 0; i < 4; ++i) { a0[i] = silu_fast(a0[i]); a1[i] = silu_fast(a1[i]); }
                        u32x4 o; o.x = cvt_pk_bf16(a0[0], a0[1]); o.y = cvt_pk_bf16(a0[2], a0[3]); o.z = cvt_pk_bf16(a1[0], a1[1]); o.w = cvt_pk_bf16(a1[2], a1[3]);
                        *(u32x4*)(dstb + (size_t)r * DM + 32 * bj) = o;
                    }
                }
        } else {
            const int cb = (pn - 20) * 256 + cl;
            bf16_t* dstb = XBC + cb;
            const bool do_conv = pn >= 24 && u.pm < NTOK / BM;
#pragma unroll
            for (int ai = 0; ai < 2; ++ai)
#pragma unroll
                for (int m = 0; m < 4; ++m) {
                    const int r = rowb + ai * HALF + m * 16;
                    float* f32dst = nullptr;
                    if (r < NTOK) { const int t = r & (SEQ - 1); if (t >= SEQ - 3) f32dst = out + O_CP + ((size_t)((r >> 13) * 3 + t - (SEQ - 3))) * CONVD + cb; }
                    else if (r < NROWS) f32dst = out + O_CS + ((size_t)(r - NTOK) * 3 + 2) * CONVD + cb;
                    if (do_conv && (m == 0 || m == 3)) {
                        const int slot = m == 0 ? 3 + fr : fr - 13;
                        if (slot >= 0 && slot < 6) f32dst = rawb + ((size_t)(u.pm * 4 + ai * 2 + wr) * 6 + slot) * 512 + (cb - 1024);
                    }
#pragma unroll
                    for (int bj = 0; bj < 2; ++bj) {
                        const f32x4 a0 = acc[ai][bj][m][0], a1 = acc[ai][bj][m][1];
                        if (!do_conv) { u32x4 o; o.x = cvt_pk_bf16(a0[0], a0[1]); o.y = cvt_pk_bf16(a0[2], a0[3]); o.z = cvt_pk_bf16(a1[0], a1[1]); o.w = cvt_pk_bf16(a1[2], a1[3]);
                                        *(u32x4*)(dstb + (size_t)r * CONVD + 32 * bj) = o; }
                        if (f32dst) { *(f32x4*)(f32dst + 32 * bj) = a0; *(f32x4*)(f32dst + 32 * bj + 4) = a1; }
                    }
                }
            if (do_conv) {
                if ((u.pm & 31) == 31 && wr == 1 && fr >= 13) {
#pragma unroll
                    for (int bj = 0; bj < 2; ++bj) { float* d = out + O_CP + ((size_t)((u.pm >> 5) * 3 + fr - 13)) * CONVD + cb + 32 * bj; *(f32x4*)d = acc[1][bj][3][0]; *(f32x4*)(d + 4) = acc[1][bj][3][1]; }
                }
#pragma unroll
                for (int bj = 0; bj < 2; ++bj) {
                    f32x4 w[4][2], bb[2];
#pragma unroll
                    for (int n = 0; n < 2; ++n) { bb[n] = *(const f32x4*)(conv_b + cb + 32 * bj + 4 * n);
#pragma unroll
                        for (int t = 0; t < 4; ++t) w[t][n] = *(const f32x4*)(conv_w + t * CONVD + cb + 32 * bj + 4 * n); }
#pragma unroll
                    for (int ai = 0; ai < 2; ++ai) {
                        f32x4 pm[2] = {(f32x4){0.f, 0.f, 0.f, 0.f}, (f32x4){0.f, 0.f, 0.f, 0.f}};
#pragma unroll
                        for (int m = 0; m < 4; ++m) {
                            const int r = rowb + ai * HALF + m * 16;
                            unsigned ow[4];
#pragma unroll
                            for (int n = 0; n < 2; ++n) {
                                const f32x4 cur = acc[ai][bj][m][n]; f32x4 v;
#pragma unroll
                                for (int i = 0; i < 4; ++i) {
                                    const float p1 = rowprev<1>(cur[i], pm[n][i]), p2 = rowprev<2>(cur[i], pm[n][i]), p3 = rowprev<3>(cur[i], pm[n][i]);
                                    v[i] = silu_fast(bb[n][i] + w[0][n][i] * p3 + w[1][n][i] * p2 + w[2][n][i] * p1 + w[3][n][i] * cur[i]);
                                }
                                ow[2 * n] = cvt_pk_bf16(v[0], v[1]); ow[2 * n + 1] = cvt_pk_bf16(v[2], v[3]);
                                pm[n] = cur;
                            }
                            *(u32x4*)(dstb + (size_t)r * CONVD + 32 * bj) = (u32x4){ow[0], ow[1], ow[2], ow[3]};
                        }
                    }
                }
            }
        }
    }
};

struct EpiOut {
    static constexpr bool PERM = true, AFTER_DRAIN = false, MIDK = true;
    const float* xp; const float* xs; const PG8_LAS float* rs; float* out;
    __device__ __forceinline__ void mid(f32x4 (&acc)[2][2][4][2], const Unit& u, int ui, int wr, int wc, int fr, int fq) const {
        const PG8_LAS float* rp = rs + ui * 256 + wr * 64 + fr;
#pragma unroll
        for (int ai = 0; ai < 2; ++ai)
#pragma unroll
            for (int m = 0; m < 4; ++m) {
                const float r = rp[ai * HALF + m * 16];
#pragma unroll
                for (int bj = 0; bj < 2; ++bj)
#pragma unroll
                    for (int n = 0; n < 2; ++n) acc[ai][bj][m][n] *= r;
            }
    }
    __device__ __forceinline__ void operator()(const f32x4 (&acc)[2][2][4][2], const Unit& u, int wr, int wc, int fr, int fq) const {
        const int rowb = u.pm * BM + wr * 64 + fr, col = u.pn * BM + wc * 64 + 8 * fq;
#pragma unroll
        for (int ai = 0; ai < 2; ++ai)
#pragma unroll
            for (int m = 0; m < 4; ++m) {
                const int r = rowb + ai * HALF + m * 16;
                if (r >= NROWS) continue;
                const float* xr = (r < NTOK ? xp + (size_t)r * DM : xs + (size_t)(r - NTOK) * DM) + col;
                float* yr = out + (r < NTOK ? O_YP + (size_t)r * DM : O_YS + (size_t)(r - NTOK) * DM) + col;
#pragma unroll
                for (int bj = 0; bj < 2; ++bj) {
                    *(f32x4*)(yr + 32 * bj) = *(const f32x4*)(xr + 32 * bj) + acc[ai][bj][m][0];
                    *(f32x4*)(yr + 32 * bj + 4) = *(const f32x4*)(xr + 32 * bj + 4) + acc[ai][bj][m][1];
                }
            }
    }
};

template <class Epi, class Sched, bool ALIGN_EPI = false, bool SP2 = false>
__device__ __forceinline__ void gemm_phase(PG8_LAS unsigned char* lds, const Gemm g, const Sched& S, const Epi& E) {
    const int tid = threadIdx.x, wid = __builtin_amdgcn_readfirstlane(tid >> 6), lane = tid & 63, wr = wid >> 2, wc = wid & 3, fr = lane & 15, fq = lane >> 4;
    const int K = g.K, nt = K / BK;
    unsigned voffA[2], voffB[2];
#pragma unroll
    for (int i = 0; i < 2; ++i) { int R, C; stage_rc(tid * 16 + i * 8192, R, C); const int Rb = Epi::PERM ? ((R & ~31) + perm32(R & 31)) : R;
        voffA[i] = (unsigned)(R * K + C) * 2u; voffB[i] = (unsigned)(Rb * K + C) * 2u; }
    const size_t kstep = (size_t)(BK * 2);
    const size_t hstep = (size_t)HALF * K * 2;
    const size_t tstep = 2 * hstep;
    const unsigned ldsw = (unsigned)wid * 1024u;
    const int aoff = lds_byte(wr * 64 + fr, fq * 8), boff = lds_byte(wc * 32 + fr, fq * 8);
#define PG8_SA(b, h) (((b) * 2 + (h)) * HTB)
#define PG8_SB(b, h) ((4 + (b) * 2 + (h)) * HTB)
#define PG8_STAGE(bufoff, gbase, voff) do { _Pragma("unroll") for (int _i = 0; _i < 2; ++_i) \
        __builtin_amdgcn_global_load_lds((const unsigned*)((const char*)(gbase) + (voff)[_i]), (PG8_LAS unsigned*)(lds + (bufoff) + ldsw + _i * 8192), 16, 0, 0); } while (0)
#define PG8_LDA(dst, b, h) do { _Pragma("unroll") for (int m = 0; m < 4; ++m) _Pragma("unroll") for (int k = 0; k < 2; ++k) dst[m][k] = *(const PG8_LAS bf16x8*)(lds + PG8_SA(b, h) + aoff + m * 2048 + k * 1024); } while (0)
#define PG8_LDB(dst, b, h) do { _Pragma("unroll") for (int n = 0; n < 2; ++n) _Pragma("unroll") for (int k = 0; k < 2; ++k) dst[n][k] = *(const PG8_LAS bf16x8*)(lds + PG8_SB(b, h) + boff + n * 2048 + k * 1024); } while (0)
#define PG8_MMA(ai, bj, At, Bt) do { __builtin_amdgcn_s_setprio(1); _Pragma("unroll") for (int m = 0; m < 4; ++m) _Pragma("unroll") for (int n = 0; n < 2; ++n) _Pragma("unroll") for (int k = 0; k < 2; ++k) \
        acc[ai][bj][m][n] = __builtin_amdgcn_mfma_f32_16x16x32_bf16(Bt[n][k], At[m][k], acc[ai][bj][m][n], 0, 0, 0); __builtin_amdgcn_s_setprio(0); } while (0)
#define PG8_WAIT_V(n) asm volatile("s_waitcnt vmcnt(" #n ")" ::: "memory")
#define PG8_WAIT_L(n) asm volatile("s_waitcnt lgkmcnt(" #n ")" ::: "memory")
#define PG8_BAR __builtin_amdgcn_s_barrier()
#define PG8_SCHED __builtin_amdgcn_sched_barrier(0)
    Unit cur, nxt; int ui = 0;
    if (!S.next(0, cur)) return;
    f32x4 acc[2][2][4][2];
#pragma unroll
    for (int a = 0; a < 2; ++a)
#pragma unroll
        for (int b = 0; b < 2; ++b)
#pragma unroll
            for (int m = 0; m < 4; ++m)
#pragma unroll
                for (int n = 0; n < 2; ++n) acc[a][b][m][n] = (f32x4){0.f, 0.f, 0.f, 0.f};
    bf16x8 At[4][2], B0[2][2], B1[2][2];
    const char* cA = (const char*)g.A + (size_t)cur.pm * tstep; const char* cB = (const char*)g.Bt + (size_t)cur.pn * tstep;
    S.a_ready(cur);
    if constexpr (SP2) {
        PG8_STAGE(PG8_SB(0, 0), cB, voffB); PG8_STAGE(PG8_SB(0, 1), cB + hstep, voffB); PG8_STAGE(PG8_SA(0, 0), cA, voffA); PG8_STAGE(PG8_SA(0, 1), cA + hstep, voffA);
        if (wr == 1) PG8_BAR;
        PG8_WAIT_V(2); PG8_BAR;
        PG8_STAGE(PG8_SB(1, 0), cB + kstep, voffB); PG8_STAGE(PG8_SA(1, 0), cA + kstep, voffA); PG8_STAGE(PG8_SB(1, 1), cB + hstep + kstep, voffB);
        PG8_WAIT_V(6); PG8_BAR;
    } else {
        PG8_STAGE(PG8_SB(0, 0), cB, voffB); PG8_STAGE(PG8_SA(0, 0), cA, voffA); PG8_STAGE(PG8_SB(0, 1), cB + hstep, voffB); PG8_STAGE(PG8_SA(0, 1), cA + hstep, voffA);
        if (wr == 1) PG8_BAR;
        PG8_WAIT_V(4); PG8_BAR;
        PG8_STAGE(PG8_SB(1, 0), cB + kstep, voffB); PG8_STAGE(PG8_SA(1, 0), cA + kstep, voffA); PG8_STAGE(PG8_SB(1, 1), cB + hstep + kstep, voffB);
        PG8_WAIT_V(6); PG8_BAR;
    }
    for (;;) {
        const bool has_next = S.next(ui + 1, nxt);
        const char* nA = has_next ? (const char*)g.A + (size_t)nxt.pm * tstep : cA; const char* nB = has_next ? (const char*)g.Bt + (size_t)nxt.pn * tstep : cB;
        for (int t = 0; t < nt; t += 2) {
            const bool last = (t == nt - 2);
            if constexpr (Epi::MIDK) { if (t == (nt >> 1)) E.mid(acc, cur, ui, wr, wc, fr, fq); }
            const char* a1 = cA + (size_t)(t + 1) * kstep;
            const char* a2 = last ? nA : cA + (size_t)(t + 2) * kstep; const char* b2 = last ? nB : cB + (size_t)(t + 2) * kstep;
            const char* a3 = a2 + kstep; const char* b3 = b2 + kstep;
            if (last && has_next) S.a_ready(nxt);
            if constexpr (SP2) {
            PG8_LDB(B0, 0, 0); PG8_LDB(B1, 0, 1); PG8_SCHED; PG8_LDA(At, 0, 0); PG8_STAGE(PG8_SA(1, 1), a1 + hstep, voffA);
            PG8_WAIT_V(8); PG8_WAIT_L(0); PG8_BAR; PG8_MMA(0, 0, At, B0); PG8_MMA(0, 1, At, B1); PG8_BAR; PG8_SCHED;
            PG8_LDA(At, 0, 1); PG8_STAGE(PG8_SB(0, 0), b2, voffB); PG8_STAGE(PG8_SB(0, 1), b2 + hstep, voffB); PG8_STAGE(PG8_SA(0, 0), a2, voffA);
            PG8_WAIT_V(8); PG8_WAIT_L(0); PG8_BAR; PG8_MMA(1, 0, At, B0); PG8_MMA(1, 1, At, B1); PG8_BAR; PG8_SCHED;
            PG8_LDB(B0, 1, 0); PG8_LDB(B1, 1, 1); PG8_SCHED; PG8_LDA(At, 1, 0); PG8_STAGE(PG8_SA(0, 1), a2 + hstep, voffA);
            PG8_WAIT_V(8); PG8_WAIT_L(0); PG8_BAR; PG8_MMA(0, 0, At, B0); PG8_MMA(0, 1, At, B1); PG8_BAR; PG8_SCHED;
            PG8_LDA(At, 1, 1); PG8_STAGE(PG8_SB(1, 0), b3, voffB); PG8_STAGE(PG8_SB(1, 1), b3 + hstep, voffB); PG8_STAGE(PG8_SA(1, 0), a3, voffA);
            PG8_WAIT_V(8); PG8_WAIT_L(0); PG8_BAR; PG8_MMA(1, 0, At, B0); PG8_MMA(1, 1, At, B1); PG8_BAR; PG8_SCHED;
            } else {
            PG8_LDB(B0, 0, 0); PG8_SCHED; PG8_LDA(At, 0, 0); PG8_STAGE(PG8_SA(1, 1), a1 + hstep, voffA);
            PG8_WAIT_L(8); PG8_BAR; PG8_WAIT_L(0); PG8_MMA(0, 0, At, B0); PG8_BAR; PG8_SCHED;
            PG8_LDB(B1, 0, 1); PG8_STAGE(PG8_SB(0, 0), b2, voffB);
            PG8_BAR; PG8_WAIT_L(0); PG8_MMA(0, 1, At, B1); PG8_BAR;
            PG8_LDA(At, 0, 1); PG8_STAGE(PG8_SA(0, 0), a2, voffA);
            PG8_BAR; PG8_WAIT_L(0); PG8_MMA(1, 0, At, B0); PG8_BAR; PG8_SCHED;
            PG8_STAGE(PG8_SB(0, 1), b2 + hstep, voffB);
            PG8_WAIT_V(6); PG8_BAR; PG8_MMA(1, 1, At, B1); PG8_BAR;
            PG8_LDB(B0, 1, 0); PG8_SCHED; PG8_LDA(At, 1, 0); PG8_STAGE(PG8_SA(0, 1), a2 + hstep, voffA);
            PG8_WAIT_L(8); PG8_BAR; PG8_WAIT_L(0); PG8_MMA(0, 0, At, B0); PG8_BAR; PG8_SCHED;
            PG8_LDB(B1, 1, 1); PG8_STAGE(PG8_SB(1, 0), b3, voffB);
            PG8_BAR; PG8_WAIT_L(0); PG8_MMA(0, 1, At, B1); PG8_BAR;
            PG8_LDA(At, 1, 1); PG8_STAGE(PG8_SA(1, 0), a3, voffA);
            PG8_BAR; PG8_WAIT_L(0); PG8_MMA(1, 0, At, B0); PG8_BAR; PG8_SCHED;
            PG8_STAGE(PG8_SB(1, 1), b3 + hstep, voffB);
            PG8_WAIT_V(6); PG8_BAR; PG8_MMA(1, 1, At, B1); PG8_BAR;
            }
        }
        if constexpr (ALIGN_EPI) { if (wr == 0) PG8_BAR; }
        if constexpr (!Epi::AFTER_DRAIN) { E(acc, cur, wr, wc, fr, fq); S.done(cur); }
        if (!has_next) break;
#pragma unroll
        for (int a = 0; a < 2; ++a)
#pragma unroll
            for (int b = 0; b < 2; ++b)
#pragma unroll
                for (int m = 0; m < 4; ++m)
#pragma unroll
                    for (int n = 0; n < 2; ++n) acc[a][b][m][n] = (f32x4){0.f, 0.f, 0.f, 0.f};
        cur = nxt; cA = nA; cB = nB; ++ui;
        if constexpr (ALIGN_EPI) { if (wr == 1) PG8_BAR; }
    }
    PG8_WAIT_V(0);
    if constexpr (!ALIGN_EPI) { if (wr == 0) PG8_BAR; }
    PG8_BAR;
    if constexpr (Epi::AFTER_DRAIN) { E.fused(acc, cur, wr, wc, fr, fq, lds, wid, lane); S.done(cur); }
#undef PG8_SA
#undef PG8_SB
#undef PG8_STAGE
#undef PG8_LDA
#undef PG8_LDB
#undef PG8_MMA
#undef PG8_WAIT_V
#undef PG8_WAIT_L
#undef PG8_BAR
#undef PG8_SCHED
}
}
#define GAS __attribute__((address_space(1)))
#define LAS __attribute__((address_space(3)))
typedef unsigned v4u __attribute__((ext_vector_type(4)));
typedef float f32x4 __attribute__((ext_vector_type(4)));
typedef short bf16x8 __attribute__((ext_vector_type(8)));
typedef GAS unsigned gu32;
typedef GAS unsigned long long gu64;
#define RLX_AGENT __ATOMIC_RELAXED, __HIP_MEMORY_SCOPE_AGENT
#define LDS_WAIT() asm volatile("s_waitcnt lgkmcnt(0)" ::: "memory")
#define VM_WAIT() asm volatile("s_waitcnt vmcnt(0)" ::: "memory")
__device__ __forceinline__ unsigned long long rt() { return __builtin_amdgcn_s_memrealtime(); }

#define XB_TMO      128
#define XB_XCNT(j)  (256  + 64 * (j))
#define XB_XSUB(j)  (1280 + 64 * (j))
#define XB_XGEN(j)  (2304 + 64 * (j))
#define XB_TOP      3328
#define XB_TOPGEN   3392
#define XCD_BAR_WORDS 3456
#define XB_SPIN_CAP (1u << 18)

__device__ __forceinline__ unsigned xb_ld(unsigned* p)              { return __hip_atomic_load(p, __ATOMIC_RELAXED, __HIP_MEMORY_SCOPE_AGENT); }
__device__ __forceinline__ unsigned xb_add(unsigned* p, unsigned v) { return __hip_atomic_fetch_add(p, v, __ATOMIC_RELAXED, __HIP_MEMORY_SCOPE_AGENT); }
__device__ __forceinline__ unsigned xb_xcc_id() { return (unsigned)__builtin_amdgcn_s_getreg((3 << 11) | 20) & 0xFu; }
#define XB_SPIN(cond, bar) do { unsigned _sp = 0; while (cond) { __builtin_amdgcn_s_sleep(1); \
    if ((++_sp & 255u) == 0u) { if (xb_ld(&(bar)[XB_TMO])) break; if (_sp > XB_SPIN_CAP) { atomicAdd(&(bar)[XB_TMO], 1u); break; } } } } while (0)

struct XcdBarrier {
    unsigned* bar; unsigned x;
    volatile LAS unsigned* st;
};

__device__ __forceinline__ XcdBarrier xcd_barrier_post(unsigned* bar, volatile LAS unsigned* st) {
    XcdBarrier b; b.bar = bar; b.x = xb_xcc_id(); b.st = st;
    if (threadIdx.x == 0) (void)xb_add(&bar[XB_XCNT(b.x)], 1u);
    return b;
}
__device__ __forceinline__ void xcd_barrier_complete(unsigned* bar, unsigned x, unsigned& nloc, unsigned& nx) {
    const unsigned G = gridDim.x * gridDim.y * gridDim.z;
    unsigned sum, cnt, mine, sp = 0u;
    for (;;) {
        sum = 0u; cnt = 0u; mine = 0u;
#pragma unroll
        for (unsigned j = 0; j < 16; ++j) { const unsigned c = xb_ld(&bar[XB_XCNT(j)]); sum += c; cnt += (c > 0u) ? 1u : 0u; mine = (j == x) ? c : mine; }
        if (sum == G) break;
        __builtin_amdgcn_s_sleep(1);
        if ((++sp & 255u) == 0u) { if (xb_ld(&bar[XB_TMO])) break; if (sp > XB_SPIN_CAP) { atomicAdd(&bar[XB_TMO], 1u); break; } }
    }
    nloc = mine > 0u ? mine : 1u; nx = cnt > 0u ? cnt : 1u;
}

__device__ __forceinline__ void xcd_barrier(const XcdBarrier& b) {
    asm volatile("s_waitcnt vmcnt(0)" ::: "memory");
    __syncthreads();
    if (threadIdx.x == 0) {
        unsigned* bar = b.bar;
        __builtin_amdgcn_s_waitcnt(0);
        unsigned nloc = b.st[0], nx = b.st[1];
        if (nloc == 0u) { xcd_barrier_complete(bar, b.x, nloc, nx); b.st[0] = nloc; b.st[1] = nx; }
        const unsigned old = xb_add(&bar[XB_XSUB(b.x)], 1u);
        const unsigned gen = old / nloc;
        if (old + 1u == (gen + 1u) * nloc) {
            __builtin_amdgcn_fence(__ATOMIC_RELEASE, "agent");
            asm volatile("s_waitcnt vmcnt(0)" ::: "memory");
            const unsigned og = xb_add(&bar[XB_TOP], 1u);
            const unsigned tg = og / nx;
            if (og + 1u == (tg + 1u) * nx) xb_add(&bar[XB_TOPGEN], 1u);
            else XB_SPIN(xb_ld(&bar[XB_TOPGEN]) == tg, bar);
            __builtin_amdgcn_fence(__ATOMIC_ACQUIRE, "agent");
            xb_add(&bar[XB_XGEN(b.x)], 1u);
            asm volatile("s_waitcnt vmcnt(0)" ::: "memory");
        } else {
            XB_SPIN(xb_ld(&bar[XB_XGEN(b.x)]) == gen, bar);
            __builtin_amdgcn_fence(__ATOMIC_ACQUIRE, "agent");
            asm volatile("s_waitcnt vmcnt(0)" ::: "memory");
        }
    }
    __syncthreads();
}

constexpr int NWAVES = 8;
constexpr int RING_OFF = 0, RING_BYTES = 131072;
constexpr int LDS_BYTES = 163840;
constexpr int LDSCTL_OFF = LDS_BYTES - 512, MISC_OFF = LDSCTL_OFF + 320;
constexpr int CW_BAR = 4096;
constexpr int CW_Q = 16384;
static_assert((CW_BAR + XCD_BAR_WORDS) <= CW_Q && (CW_Q + 64 * 64) * 4 <= (int)CTL_ZERO_BYTES, "CTL words inside the memset region");

constexpr int PROBE_ID = 0;
#define PB_BEGIN(id) long long pb_t0_ = 0; if (PROBE_ID == (id)) pb_t0_ = clock64();
#define PB_END(id) if (PROBE_ID == (id)) { const long long t1_ = clock64(), dt_ = t1_ - pb_t0_; while (clock64() - t1_ < dt_) __builtin_amdgcn_s_sleep(2); }
struct Frame {
    LAS unsigned char* lds;
    volatile LAS unsigned* MISC;
    gu32* ctl;
    int tid, lane, wave, vcu, G;
    Ins I; float* out;
    bf16 *WinT, *WoutT, *XN, *Q, *K, *V, *AU, *XBC, *Gb, *Zb; float *DT, *SSQ, *RAWB;
};

template <class SrcF>
__device__ __forceinline__ void p0_transpose_item(SrcF src, int k0, int n0, bf16* WT, int dst_pitch, int dst_row0, int dst_k0, LAS float* scr, int lane) {
#pragma unroll 8
    for (int i = 0; i < 32; ++i) { const int kk = 2 * i + (lane >> 5); scr[kk * 33 + (lane & 31)] = src(k0 + kk, n0 + (lane & 31)); }
    LDS_WAIT(); asm volatile("" ::: "memory");
    const int c = lane & 7;
#pragma unroll
    for (int j = 0; j < 4; ++j) { const int n = (lane >> 3) + 8 * j; const LAS float* s = scr + (8 * c) * 33 + n;
        v4u o; o.x = pk2(s[0 * 33], s[1 * 33]); o.y = pk2(s[2 * 33], s[3 * 33]); o.z = pk2(s[4 * 33], s[5 * 33]); o.w = pk2(s[6 * 33], s[7 * 33]);
        *(GAS v4u*)(WT + (size_t)(dst_row0 + n) * dst_pitch + dst_k0 + 8 * c) = o; }
    LDS_WAIT(); asm volatile("" ::: "memory");
}
constexpr int P0_SCR_BYTES = 8448, WDT_OFF = NWAVES * P0_SCR_BYTES, WDT_PITCH = 20;
static_assert(WDT_OFF + 1024 * WDT_PITCH * 4 <= LDSCTL_OFF, "prologue LDS");

__device__ __forceinline__ void p0_prologue(Frame& F) {
    const Ins& I = F.I;
    LAS float* scr = (LAS float*)(F.lds + F.wave * P0_SCR_BYTES);
    LAS float* wdt = (LAS float*)(F.lds + WDT_OFF);
    const int gw = F.vcu * NWAVES + F.wave, NGW = F.G * NWAVES;
    for (int idx = F.tid; idx < 1024 * 16; idx += NWAVES * 64) {
        const int k = idx >> 4, j = idx & 15, pos = (((k >> 8) * 4 + (k & 3)) << 6) + ((k >> 2) & 63);
        wdt[pos * WDT_PITCH + j] = I.w_in[(size_t)k * NPROJ + C_DT + j] * I.norm_w[k];
    }
    constexpr int I_IN = (DM / 64) * (NMAIN / 32), I_OUT = (2048 / 64) * (DM / 32);
    for (int it = gw; it < I_IN + I_OUT; it += NGW) {
        if (it < I_IN) {
            const int nblk = NMAIN / 32, kb = it / nblk, nb = it % nblk, k0 = 64 * kb, n0 = 32 * nb;
            p0_transpose_item([&](int k, int n) { return I.w_in[(size_t)k * NPROJ + n] * I.norm_w[k]; }, k0, n0, F.WinT, DM, (n0 & ~255) + vrow_of_col(n0 & 255), k0, scr, F.lane);
        } else {
            const int r = it - I_IN, nblk = DM / 32, kb = r / nblk, nb = r % nblk, k0 = 64 * kb, n0 = 32 * nb;
            p0_transpose_item([&](int k, int n) { return I.w_out[(size_t)k * DM + n] * (k >= 1024 ? I.ssd_norm_w[k - 1024] : 1.f); }, k0, n0, F.WoutT, 2048, (n0 & ~255) + vrow_of_col(n0 & 255), (k0 + 1024) & 2047, scr, F.lane);
        }
    }
    __syncthreads();
    for (int rp = gw; rp < NROWS / 2; rp += NGW) {
        f32x4 v[2][4]; float rstd[2];
#pragma unroll
        for (int q = 0; q < 2; ++q) {
            const GAS f32x4* xr = (const GAS f32x4*)xrow(I, 2 * rp + q) + F.lane; float s = 0.f;
#pragma unroll
            for (int j = 0; j < 4; ++j) { v[q][j] = xr[64 * j]; s += (v[q][j].x * v[q][j].x + v[q][j].y * v[q][j].y) + (v[q][j].z * v[q][j].z + v[q][j].w * v[q][j].w); }
            rstd[q] = rsqrtf(wave_sum(s) * (1.f / DM) + EPS);
            GAS unsigned long long* o8 = (GAS unsigned long long*)(F.XN + (size_t)(2 * rp + q) * DM) + F.lane;
#pragma unroll
            for (int j = 0; j < 4; ++j) o8[64 * j] = (unsigned long long)pk2(v[q][j].x * rstd[q], v[q][j].y * rstd[q]) | ((unsigned long long)pk2(v[q][j].z * rstd[q], v[q][j].w * rstd[q]) << 32);
        }
        float a[32];
#pragma unroll
        for (int i = 0; i < 32; ++i) a[i] = 0.f;
#pragma unroll
        for (int j = 0; j < 4; ++j)
#pragma unroll
            for (int e = 0; e < 4; ++e) {
                const LAS f32x4* wp = (const LAS f32x4*)(wdt + ((j * 4 + e) * 64 + F.lane) * WDT_PITCH);
                const float x0 = v[0][j][e], x1 = v[1][j][e];
#pragma unroll
                for (int c4 = 0; c4 < 4; ++c4) { const f32x4 w = wp[c4];
#pragma unroll
                    for (int i = 0; i < 4; ++i) { a[c4 * 4 + i] += x0 * w[i]; a[16 + c4 * 4 + i] += x1 * w[i]; } }
                asm volatile("" ::: "memory");
            }
#define P0_HALVE(N, X) { const bool up = (F.lane & (X)) != 0; _Pragma("unroll") for (int i = 0; i < (N); ++i) { const float keep = up ? a[i + (N)] : a[i], send = up ? a[i] : a[i + (N)]; a[i] = keep + __shfl_xor(send, (X)); } }
        P0_HALVE(16, 32) P0_HALVE(8, 16) P0_HALVE(4, 8) P0_HALVE(2, 4) P0_HALVE(1, 2)
#undef P0_HALVE
        float tot = a[0] + __shfl_xor(a[0], 1);
        const int idx = F.lane >> 1, q = idx >> 4, c = idx & 15;
        tot = tot * (q ? rstd[1] : rstd[0]) + I.dt_bias[c];
        if ((F.lane & 1) == 0) F.DT[(size_t)c * MROWS + 2 * rp + q] = softplus_f(tot);
    }
    for (int r = NROWS + gw; r < MROWS; r += NGW) { GAS v4u* o = (GAS v4u*)(F.XN + (size_t)r * DM) + F.lane; o[0] = (v4u){0u, 0u, 0u, 0u}; o[64] = (v4u){0u, 0u, 0u, 0u}; }
    for (int i = (F.vcu * NWAVES * 64 + F.tid); i < DB * 2 * CONVD; i += F.G * NWAVES * 64) {
        const int c = i % CONVD, rr = i / CONVD, j = rr & 1, b = rr >> 1;
        F.out[O_CS + ((size_t)b * 3 + j) * CONVD + c] = I.sconv[((size_t)b * 3 + j + 1) * CONVD + c];
    }
}

namespace att {
typedef float f32x16 __attribute__((ext_vector_type(16)));
typedef short v4i16_t __attribute__((ext_vector_type(4)));
typedef unsigned u32x4 __attribute__((ext_vector_type(4)));
constexpr int SPAN = 256, NSPAN = SEQ / SPAN, NUNITS = NB * NH * NSPAN;
constexpr int OACC_OFF = 0, LACC_OFF = 65536, LUT_OFF = 66560, VST_OFF = 68608, VST_BYTES = 8192, ATT_LDS_END = VST_OFF + NWAVES * VST_BYTES;
static_assert(ATT_LDS_END <= LDSCTL_OFF, "attention LDS");
__device__ __forceinline__ int crow(int r, int hi) { return (r & 3) + 8 * (r >> 2) + 4 * hi; }

template <int NQ, bool ACC>
__device__ __forceinline__ void item(const bf16* Qb, const bf16* Kb, const bf16* Vb, int tq0, int d, int pat, int toff, LAS unsigned char* lds, int wave, int lane) {
    const int c = lane & 31, hi = lane >> 5;
    LAS unsigned char* kst = lds + VST_OFF + wave * VST_BYTES;
    LAS unsigned char* vst = kst + 4096;
    const LAS float* lut = (const LAS float*)(lds + LUT_OFF) + pat * 129;
    bf16x8 qf[4];
    { const bf16* qp = Qb + (size_t)(tq0 + (NQ == 32 ? c : (c & 15)) * d) * DM + 8 * hi;
#pragma unroll
      for (int ks = 0; ks < 4; ++ks) qf[ks] = *(const bf16x8*)(qp + 16 * ks); }
    f32x16 o0 = {}, o1 = {};
    float lsum = 0.f;
    const int lrow = lane >> 3, lch = lane & 7;
    const int stoff = lrow * 128 + ((lch ^ lrow) << 4);
    const int kfo = c * 128;
    const int q4 = (lane & 15) >> 2, odd = (lane >> 4) & 1, p4 = lane & 3;
    v4u kreg[4], vreg[4];
#define ATT_LOAD_K(KT) do { _Pragma("unroll") for (int i = 0; i < 4; ++i) { int tk_ = tq0 + (-128 + 32 * (KT) + 8 * i + lrow) * d; tk_ = tk_ < 0 ? 0 : tk_; \
        kreg[i] = *(const v4u*)(Kb + (size_t)tk_ * DM + 8 * lch); } } while (0)
#define ATT_LOAD_V(KT) do { _Pragma("unroll") for (int i = 0; i < 4; ++i) { int tk_ = tq0 + (-128 + 32 * (KT) + 8 * i + lrow) * d; tk_ = tk_ < 0 ? 0 : tk_; \
        vreg[i] = *(const v4u*)(Vb + (size_t)tk_ * DM + 8 * lch); } } while (0)
    ATT_LOAD_K(0); ATT_LOAD_V(0);
#pragma unroll 1
    for (int kt = 0; kt < 5; ++kt) {
#pragma unroll
        for (int i = 0; i < 4; ++i) { *(LAS v4u*)(kst + i * 1024 + stoff) = kreg[i]; *(LAS v4u*)(vst + i * 1024 + stoff) = vreg[i]; }
        asm volatile("" ::: "memory");
        if (kt < 4) { ATT_LOAD_K(kt + 1); ATT_LOAD_V(kt + 1); }
        bf16x8 kf[4];
#pragma unroll
        for (int ks = 0; ks < 4; ++ks) kf[ks] = *(const LAS bf16x8*)(kst + kfo + (((2 * ks + hi) ^ (c & 7)) << 4));
        f32x16 st = {};
#pragma unroll
        for (int ks = 0; ks < 4; ++ks) st = __builtin_amdgcn_mfma_f32_32x32x16_bf16(kf[ks], qf[ks], st, 0, 0, 0);
        const int relb = c + 128 - 32 * kt - 4 * hi, tkb = tq0 + (-128 + 32 * kt + 4 * hi) * d;
        if (kt == 0 || kt == 4 || tkb < 0) {
#pragma unroll
            for (int r = 0; r < 16; ++r) {
                const int kk = (r & 3) + 8 * (r >> 2), rel = relb - kk;
                const bool valid = (rel >= 0) && (rel <= 128) && (tkb + kk * d >= 0);
                const float bias = lut[rel < 0 ? 0 : (rel > 128 ? 128 : rel)];
                const float pe = __builtin_amdgcn_exp2f(st[r] + bias), p = valid ? pe : 0.f;
                st[r] = p; lsum += p;
            }
        } else {
#pragma unroll
            for (int r = 0; r < 16; ++r) { const float p = __builtin_amdgcn_exp2f(st[r] + lut[relb - ((r & 3) + 8 * (r >> 2))]); st[r] = p; lsum += p; }
        }
        u32x4 pw0, pw1;
        pw0.x = pg8::cvt_pk_bf16(st[0], st[1]); pw0.y = pg8::cvt_pk_bf16(st[2], st[3]); pw0.z = pg8::cvt_pk_bf16(st[4], st[5]); pw0.w = pg8::cvt_pk_bf16(st[6], st[7]);
        pw1.x = pg8::cvt_pk_bf16(st[8], st[9]); pw1.y = pg8::cvt_pk_bf16(st[10], st[11]); pw1.z = pg8::cvt_pk_bf16(st[12], st[13]); pw1.w = pg8::cvt_pk_bf16(st[14], st[15]);
        const bf16x8 pa0 = __builtin_bit_cast(bf16x8, pw0), pa1 = __builtin_bit_cast(bf16x8, pw1);
#pragma unroll
        for (int dh = 0; dh < 2; ++dh)
#pragma unroll
            for (int s = 0; s < 2; ++s) {
                const int kr = 16 * s + 4 * hi + q4, ch16 = 4 * dh + 2 * odd + (p4 >> 1);
                const LAS unsigned char* vp0 = vst + kr * 128 + ((ch16 ^ (kr & 7)) << 4) + (p4 & 1) * 8;
                const LAS unsigned char* vp1 = vst + (kr + 8) * 128 + ((ch16 ^ (kr & 7)) << 4) + (p4 & 1) * 8;
                const v4i16_t lo = __builtin_amdgcn_ds_read_tr16_b64_v4i16((LAS v4i16_t*)vp0), hh = __builtin_amdgcn_ds_read_tr16_b64_v4i16((LAS v4i16_t*)vp1);
                const bf16x8 vb = (bf16x8){lo[0], lo[1], lo[2], lo[3], hh[0], hh[1], hh[2], hh[3]};
                if (dh == 0) o0 = __builtin_amdgcn_mfma_f32_32x32x16_bf16(s == 0 ? pa0 : pa1, vb, o0, 0, 0, 0);
                else         o1 = __builtin_amdgcn_mfma_f32_32x32x16_bf16(s == 0 ? pa0 : pa1, vb, o1, 0, 0, 0);
            }
    }
#undef ATT_LOAD_K
#undef ATT_LOAD_V
    lsum += __shfl_xor(lsum, 32);
    LAS float* oacc = (LAS float*)(lds + OACC_OFF); LAS float* lacc = (LAS float*)(lds + LACC_OFF);
    if (hi == 0 && c < NQ) { LAS float* lp = lacc + toff + c * d; *lp = ACC ? *lp + lsum : lsum; }
#pragma unroll
    for (int r = 0; r < (NQ == 32 ? 16 : 8); ++r) {
        const int q = crow(r, hi); LAS float* row = oacc + (toff + q * d) * 64 + c;
        if (ACC) { row[0] += o0[r]; row[32] += o1[r]; } else { row[0] = o0[r]; row[32] = o1[r]; }
    }
}

__device__ __forceinline__ void unit(Frame& F, int uidx) {
    const int span = uidx % NSPAN, bh = uidx / NSPAN, h = bh % NH, b = bh / NH, t0 = span * SPAN;
    LAS unsigned char* lds = F.lds;
    LAS float* oacc = (LAS float*)(lds + OACC_OFF); LAS float* lacc = (LAS float*)(lds + LACC_OFF); LAS float* lut = (LAS float*)(lds + LUT_OFF);
    if (F.tid < 387) { const int pat = F.tid / 129, rel = F.tid - pat * 129, d = pat == 0 ? 1 : (pat == 1 ? 4 : 16); lut[F.tid] = F.I.rel_bias[t5_bucket(rel * d) * NH + h] * LOG2E; }
    __syncthreads();
    const size_t boff = (size_t)b * SEQ * DM + h * HD;
    const bf16 *Qb = F.Q + boff, *Kb = F.K + boff, *Vb = F.V + boff;
    const int w = F.wave;
    item<32, false>(Qb, Kb, Vb, t0 + 32 * w, 1, 0, 32 * w, lds, w, F.lane);
    __syncthreads();
    item<32, true>(Qb, Kb, Vb, t0 + (w & 3) + 128 * (w >> 2), 4, 1, (w & 3) + 128 * (w >> 2), lds, w, F.lane);
    __syncthreads();
    item<16, true>(Qb, Kb, Vb, t0 + w, 16, 2, w, lds, w, F.lane);
    __builtin_amdgcn_sched_barrier(0);
    item<16, true>(Qb, Kb, Vb, t0 + w + 8, 16, 2, w + 8, lds, w, F.lane);
    __syncthreads();

    bf16* ap = F.AU + ((size_t)b * SEQ + t0 + 32 * w) * 2048 + 1024 + h * HD + F.lane;
    const bf16* gp = F.Gb + ((size_t)b * SEQ + t0 + 32 * w) * DM + h * HD + F.lane;
#pragma unroll 4
    for (int i = 0; i < 32; ++i) {
        const float o = oacc[(32 * w + i) * 64 + F.lane], l = lacc[32 * w + i];
        ap[(size_t)i * 2048] = (bf16)f2bf(o * __builtin_amdgcn_rcpf(l) * bf2f(gp[(size_t)i * DM]));
    }
    __syncthreads();
}

}

namespace ssd {
typedef float f32x16 __attribute__((ext_vector_type(16)));
typedef short v4i16_t __attribute__((ext_vector_type(4)));
typedef unsigned u32x2 __attribute__((ext_vector_type(2)));
typedef float f32x2v __attribute__((ext_vector_type(2)));
constexpr int PITCH = 272;
constexpr int BT_OFF = 0, CT_OFF = 34816, G_OFF = 69632, HB_OFF = 104448, XD_OFF = 121856, XH_OFF = 138240, ACS_OFF = 154624, DTL_OFF = ACS_OFF + 512, SSQL_OFF = DTL_OFF + 512, XW_OFF = SSQL_OFF + 512  , FW_OFF = XW_OFF + 1280  , SSD_LDS_END = FW_OFF + 5120;
static_assert(SSD_LDS_END <= LDSCTL_OFF, "SSD LDS");
__device__ __forceinline__ int crow(int r, int hi) { return (r & 3) + 8 * (r >> 2) + 4 * hi; }
__device__ __forceinline__ bf16x8 trfrag(const LAS unsigned char* p0, const LAS unsigned char* p1) {
    const v4i16_t lo = __builtin_amdgcn_ds_read_tr16_b64_v4i16((LAS v4i16_t*)p0), hh = __builtin_amdgcn_ds_read_tr16_b64_v4i16((LAS v4i16_t*)p1);
    return (bf16x8){lo[0], lo[1], lo[2], lo[3], hh[0], hh[1], hh[2], hh[3]};
}
__device__ __forceinline__ float bflo(unsigned w) { return __uint_as_float(w << 16); }
__device__ __forceinline__ float bfhi(unsigned w) { return __uint_as_float(w & 0xffff0000u); }

__device__ __forceinline__ void chain(Frame& F, int bh) {
    const Ins& I = F.I;
    const int b = bh >> 4, hd = bh & 15, grp = hd >> 3;
    const int tid = F.tid, lane = F.lane, w = F.wave, c = lane & 31, hi = lane >> 5;
    LAS unsigned char* lds = F.lds;
    LAS float* acs = (LAS float*)(lds + ACS_OFF); LAS float* dtl = (LAS float*)(lds + DTL_OFF); LAS float* ssql = (LAS float*)(lds + SSQL_OFF);
    const float A = -__expf(I.a_log[hd]), dsk = I.d_skip[hd];
    const size_t row0 = (size_t)b * SEQ;
    for (int i = tid; i < 17408 / 16; i += NWAVES * 64) ((LAS v4u*)(lds + HB_OFF))[i] = (v4u){0u, 0u, 0u, 0u};
    f32x16 hacc = {};
    const int pt = w & 1, jt = w >> 1;
    const int q4 = (lane & 15) >> 2, odd = (lane >> 4) & 1, p4 = lane & 3;
    const int xtr = (8 * hi + q4) * 64 + (16 * odd + 4 * p4) * 2;
    const int xg = tid & 15, xr0 = (tid >> 4) * 4;
    const int fb = tid >> 8, fc = tid & 255;
    for (int i = tid; i < 5 * 64 + 5 * 256; i += NWAVES * 64) {
        if (i < 320) { const int t = i >> 6, e = i & 63; ((LAS float*)(lds + XW_OFF))[i] = t < 4 ? I.conv_w[t * CONVD + hd * 64 + e] : I.conv_b[hd * 64 + e]; }
        else { const int k = i - 320, t = k >> 8, e = k & 255, chn = 1024 + (e < 128 ? grp * 128 + e : 256 + grp * 128 + (e - 128)); ((LAS float*)(lds + FW_OFF))[k] = t < 4 ? I.conv_w[t * CONVD + chn] : I.conv_b[chn]; }
    }
    const int xoff = ((xg >> 3) << 10) + (xg & 7) * 8;
    float dtp0, dtp1; u32x2 xr[7]; v4u bcr[8]; float fxr[6]; u32x2 zr[4];
#define SSD_PREFETCH(T0) do { int t0_ = (T0), tv_ = tid, lv_ = lane; asm volatile("" : "+v"(t0_), "+v"(tv_), "+v"(lv_)); \
        const int xg_ = tv_ & 15, xr0_ = (tv_ >> 4) * 4, fb_ = tv_ >> 8, fc_ = tv_ & 255, fch_ = fc_ < 128 ? grp * 128 + fc_ : 256 + grp * 128 + (fc_ - 128); \
        { const float* dp_ = F.DT + (size_t)hd * MROWS + row0 + t0_ + 2 * lv_; dtp0 = dp_[0]; dtp1 = dp_[1]; } \
        { const bf16* xp_ = F.XBC + (row0 + t0_ + xr0_) * CONVD + hd * 64 + 4 * xg_; \
          _Pragma("unroll") for (int j = 0; j < 7; ++j) xr[j] = (t0_ + xr0_ - 3 + j) >= 0 ? *(const u32x2*)(xp_ + (j - 3) * CONVD) : (u32x2){0u, 0u}; } \
        { const bf16* bp_ = F.XBC + (row0 + t0_ + (tv_ >> 4)) * CONVD + 1024 + grp * 128 + 8 * (tv_ & 15); \
          _Pragma("unroll") for (int k = 0; k < 4; ++k) { bcr[k] = *(const v4u*)(bp_ + (size_t)k * 32 * CONVD); bcr[4 + k] = *(const v4u*)(bp_ + (size_t)k * 32 * CONVD + 256); } } \
        { const size_t blk = (row0 + t0_ + 64 * fb_) >> 6; const bool hasprev = (t0_ + 64 * fb_) > 0; const float* rp_ = F.RAWB + (blk * 6) * 512 + fch_; \
          _Pragma("unroll") for (int j = 0; j < 3; ++j) { fxr[j] = hasprev ? rp_[(j - 6) * 512] : 0.f; fxr[3 + j] = rp_[(3 + j) * 512]; } } \
    } while (0)
#define SSD_PREFETCH_Z(T0) do { int t0_ = (T0), lv_ = lane; asm volatile("" : "+v"(t0_), "+v"(lv_)); \
        const bf16* zp_ = F.Zb + (row0 + t0_ + 32 * jt + (lv_ & 31)) * DM + hd * 64 + 32 * pt + 4 * (lv_ >> 5); \
        _Pragma("unroll") for (int g4 = 0; g4 < 4; ++g4) zr[g4] = *(const u32x2*)(zp_ + 8 * g4); } while (0)
    SSD_PREFETCH(0); SSD_PREFETCH_Z(0);
    __syncthreads();
#pragma unroll 1
    for (int ch = 0; ch < SEQ / 128; ++ch) {
        const int t0 = ch * 128;
        float aend;
        {
            if (w == 0 && ch > 0) { F.SSQ[(row0 + t0 - 128 + lane) * 16 + hd] = ssql[lane]; F.SSQ[(row0 + t0 - 64 + lane) * 16 + hd] = ssql[64 + lane]; }
            const float v0 = dtp0 * A, v1 = dtp1 * A; float s = v0 + v1;
#pragma unroll
            for (int o = 1; o < 64; o <<= 1) { const float t = __shfl_up(s, o); if (lane >= o) s += t; }
            aend = __shfl(s, 63);
            *(LAS f32x2v*)(acs + 2 * lane) = (f32x2v){s - v1, s}; *(LAS f32x2v*)(dtl + 2 * lane) = (f32x2v){dtp0, dtp1};
            if (w == 0) { ssql[lane] = 0.f; ssql[64 + lane] = 0.f; }
        }
#pragma unroll
        for (int k = 0; k < 4; ++k) { const int idx = tid + 512 * k, row = idx >> 4;
            if ((row & 63) >= 3) { *(LAS v4u*)(lds + BT_OFF + row * PITCH + 16 * (idx & 15)) = bcr[k]; *(LAS v4u*)(lds + CT_OFF + row * PITCH + 16 * (idx & 15)) = bcr[4 + k]; } }
        {
            LAS unsigned char* dst = lds + (fc < 128 ? BT_OFF + 2 * fc : CT_OFF + 2 * (fc - 128)) + 64 * fb * PITCH;
            const LAS float* fwp = (const LAS float*)(lds + FW_OFF) + fc;
            const float fw0 = fwp[0], fw1 = fwp[256], fw2 = fwp[512], fw3 = fwp[768], fbias = fwp[1024];
#pragma unroll
            for (int j = 0; j < 3; ++j) *(LAS bf16*)(dst + j * PITCH) = (bf16)f2bf(silu_fast(fbias + fw0 * fxr[j] + fw1 * fxr[j + 1] + fw2 * fxr[j + 2] + fw3 * fxr[j + 3]));
        }
        {
            const LAS f32x4* xwp = (const LAS f32x4*)(lds + XW_OFF) + xg;
            const f32x4 xw0 = xwp[0], xw1 = xwp[16], xw2 = xwp[32], xw3 = xwp[48], xb = xwp[64];
            float xv[7][4];
#pragma unroll
            for (int j = 0; j < 7; ++j) { xv[j][0] = bflo(xr[j].x); xv[j][1] = bfhi(xr[j].x); xv[j][2] = bflo(xr[j].y); xv[j][3] = bfhi(xr[j].y); }
#pragma unroll
            for (int i = 0; i < 4; ++i) {
                const int s = xr0 + i; const float dt = dtl[s], de = dt * __expf(aend - acs[s]); float v[4];
#pragma unroll
                for (int e = 0; e < 4; ++e) v[e] = silu_fast(xb[e] + xw0[e] * xv[i][e] + xw1[e] * xv[i + 1][e] + xw2[e] * xv[i + 2][e] + xw3[e] * xv[i + 3][e]);
                const int off = ((s >> 4) << 11) + xoff + (s & 15) * 64;
                *(LAS u32x2*)(lds + XD_OFF + off) = (u32x2){pk2(v[0] * dt, v[1] * dt), pk2(v[2] * dt, v[3] * dt)};
                *(LAS u32x2*)(lds + XH_OFF + off) = (u32x2){pk2(v[0] * de, v[1] * de), pk2(v[2] * de, v[3] * de)};
            }
        }
        asm volatile("" ::: "memory"); __builtin_amdgcn_sched_barrier(0);
        if (ch + 1 < SEQ / 128) SSD_PREFETCH(t0 + 128);
        __syncthreads();
        {
            const int j = w & 3; const float al = acs[32 * j + c];
#pragma unroll
            for (int ii = 0; ii < 2; ++ii) {
                const int i = 2 * (w >> 2) + ii;
                if (i <= j) {
                    f32x16 x = {};
                    const LAS unsigned char* ap = lds + BT_OFF + (32 * i + c) * PITCH + 16 * hi;
                    const LAS unsigned char* bp = lds + CT_OFF + (32 * j + c) * PITCH + 16 * hi;
#pragma unroll 4
                    for (int ks = 0; ks < 8; ++ks) x = __builtin_amdgcn_mfma_f32_32x32x16_bf16(*(const LAS bf16x8*)(ap + 32 * ks), *(const LAS bf16x8*)(bp + 32 * ks), x, 0, 0, 0);
                    const int l = 32 * j + c;
#pragma unroll
                    for (int g4 = 0; g4 < 4; ++g4) {
                        const int sb = 32 * i + 8 * g4 + 4 * hi; float gv[4];
                        const f32x4 as4 = *(const LAS f32x4*)(acs + sb);
#pragma unroll
                        for (int e = 0; e < 4; ++e) { const int s = sb + e; gv[e] = s <= l ? x[4 * g4 + e] * __builtin_amdgcn_exp2f((al - as4[e]) * LOG2E) : 0.f; }
                        *(LAS u32x2*)(lds + G_OFF + l * PITCH + sb * 2) = (u32x2){pk2(gv[0], gv[1]), pk2(gv[2], gv[3])};
                    }
                }
            }
        }
        f32x16 yt = {};
        {
            const LAS unsigned char* ap = lds + HB_OFF + (32 * pt + c) * PITCH + 16 * hi;
            const LAS unsigned char* bp = lds + CT_OFF + (32 * jt + c) * PITCH + 16 * hi;
#pragma unroll 4
            for (int ks = 0; ks < 8; ++ks) yt = __builtin_amdgcn_mfma_f32_32x32x16_bf16(*(const LAS bf16x8*)(ap + 32 * ks), *(const LAS bf16x8*)(bp + 32 * ks), yt, 0, 0, 0);
            const float el = __expf(acs[32 * jt + c]);
#pragma unroll
            for (int r = 0; r < 16; ++r) yt[r] *= el;
        }
        __syncthreads();
        {
            const LAS unsigned char* bp = lds + G_OFF + (32 * jt + c) * PITCH + 16 * hi;
            for (int ks = 0; ks < 2 * jt + 2; ++ks) {
                const LAS unsigned char* xp = lds + XD_OFF + ((ks * 2 + pt) << 10) + xtr;
                yt = __builtin_amdgcn_mfma_f32_32x32x16_bf16(trfrag(xp, xp + 256), *(const LAS bf16x8*)(bp + 32 * ks), yt, 0, 0, 0);
            }
        }
        {
            const float ea = __expf(aend);
#pragma unroll
            for (int r = 0; r < 16; ++r) hacc[r] *= ea;
            const int btr = (8 * hi + q4) * PITCH + (32 * jt + 16 * odd + 4 * p4) * 2;
#pragma unroll 4
            for (int ks = 0; ks < 8; ++ks) {
                const LAS unsigned char* xp = lds + XH_OFF + ((ks * 2 + pt) << 10) + xtr;
                const LAS unsigned char* bp = lds + BT_OFF + 16 * ks * PITCH + btr;
                hacc = __builtin_amdgcn_mfma_f32_32x32x16_bf16(trfrag(xp, xp + 256), trfrag(bp, bp + 4 * PITCH), hacc, 0, 0, 0);
            }
        }
        {
            const int l = 32 * jt + c; const float rdt = dsk * __builtin_amdgcn_rcpf(dtl[l]);
            bf16* up = F.AU + (row0 + t0 + l) * 2048 + hd * 64 + 32 * pt;
            float sq = 0.f;
#pragma unroll
            for (int g4 = 0; g4 < 4; ++g4) {
                const int pl = 8 * g4 + 4 * hi;
                const u32x2 xw2 = *(const LAS u32x2*)(lds + XD_OFF + (((l >> 4) * 2 + pt) << 10) + (l & 15) * 64 + pl * 2);
                const u32x2 zw = zr[g4];
                const float u0 = (yt[4 * g4] + rdt * bflo(xw2.x)) * bflo(zw.x), u1 = (yt[4 * g4 + 1] + rdt * bfhi(xw2.x)) * bfhi(zw.x), u2 = (yt[4 * g4 + 2] + rdt * bflo(xw2.y)) * bflo(zw.y), u3 = (yt[4 * g4 + 3] + rdt * bfhi(xw2.y)) * bfhi(zw.y);
                sq += (u0 * u0 + u1 * u1) + (u2 * u2 + u3 * u3);
                *(u32x2*)(up + pl) = (u32x2){pk2(u0, u1), pk2(u2, u3)};
            }
            sq += __shfl_xor(sq, 32);
            if (hi == 0) __hip_atomic_fetch_add(ssql + l, sq, __ATOMIC_RELAXED, __HIP_MEMORY_SCOPE_WORKGROUP);
            if (ch + 1 < SEQ / 128) SSD_PREFETCH_Z(t0 + 128);
        }
        __syncthreads();
#pragma unroll
        for (int r = 0; r < 16; ++r) *(LAS bf16*)(lds + HB_OFF + (32 * pt + crow(r, hi)) * PITCH + (32 * jt + c) * 2) = (bf16)f2bf(hacc[r]);
    }
#undef SSD_PREFETCH
#undef SSD_PREFETCH_Z
    if (w == 0) { const int t0 = SEQ; F.SSQ[(row0 + t0 - 128 + lane) * 16 + hd] = ssql[lane]; F.SSQ[(row0 + t0 - 64 + lane) * 16 + hd] = ssql[64 + lane]; }
    float* ho = F.out + O_HP + (((size_t)b * NH + hd) * HD + 32 * pt) * DS + 32 * jt + c;
#pragma unroll
    for (int r = 0; r < 16; ++r) ho[(size_t)crow(r, hi) * DS] = hacc[r];
    __syncthreads();
}
}

namespace smp {
__device__ __forceinline__ void attn_unit(Frame& F, int bhs) {
    const Ins& I = F.I;
    const int lane = F.lane, w = F.wave, b = bhs >> 4, h = bhs & 15, r = NTOK + b;
    LAS float* qs = (LAS float*)(F.lds + 4096); LAS float* acc = (LAS float*)F.lds;
    LAS float* ps = (LAS float*)(F.lds + 8192) + w * 64;
    if (F.tid < 64) qs[F.tid] = bf2f(F.Q[(size_t)r * DM + h * HD + F.tid]);
    if (F.tid < 65) acc[F.tid] = 0.f;
    __syncthreads();
    const int k0 = 49 * w, nk = (387 - k0) < 49 ? (387 - k0) : 49;
    float p = 0.f;
    if (lane < nk) {
        const int idx = k0 + lane, pat = idx / 129, j = idx - pat * 129, d = pat == 0 ? 1 : (pat == 1 ? 4 : 16);
        float s = 0.f;
        if (j > 0) { const f32x4* kp = (const f32x4*)(I.ck + (((size_t)b * WIN + (WIN - j * d)) * NH + h) * HD);
#pragma unroll
            for (int e = 0; e < 16; ++e) { const f32x4 kv = kp[e]; const f32x4 qv = *(const LAS f32x4*)(qs + 4 * e); s += (qv[0] * kv[0] + qv[1] * kv[1]) + (qv[2] * kv[2] + qv[3] * kv[3]); } }
        else { const bf16* kp = F.K + (size_t)r * DM + h * HD; for (int e = 0; e < 64; ++e) s += qs[e] * bf2f(kp[e]); }
        p = __builtin_amdgcn_exp2f(s + I.rel_bias[t5_bucket(j * d) * NH + h] * LOG2E);
    }
    ps[lane] = p;
    const float lsum = wave_sum(p);
    __builtin_amdgcn_wave_barrier();
    float o0 = 0.f, o1 = 0.f, o2 = 0.f, o3 = 0.f;
    const float vnew = bf2f(F.V[(size_t)r * DM + h * HD + lane]);
    const float* vbase = I.cv + ((size_t)b * WIN * NH + h) * HD + lane;
#define SMP_V(K) ({ const int idx_ = k0 + (K), pat_ = idx_ / 129, j_ = idx_ - pat_ * 129, d_ = pat_ == 0 ? 1 : (pat_ == 1 ? 4 : 16); \
                    (K) < nk ? ps[(K)] * (j_ > 0 ? vbase[(size_t)(WIN - j_ * d_) * (NH * HD)] : vnew) : 0.f; })
#pragma unroll
    for (int k = 0; k < 48; k += 4) { o0 += SMP_V(k); o1 += SMP_V(k + 1); o2 += SMP_V(k + 2); o3 += SMP_V(k + 3); }
    o0 += SMP_V(48);
#undef SMP_V
    __hip_atomic_fetch_add(acc + lane, (o0 + o1) + (o2 + o3), __ATOMIC_RELAXED, __HIP_MEMORY_SCOPE_WORKGROUP);
    if (lane == 0) __hip_atomic_fetch_add(acc + 64, lsum, __ATOMIC_RELAXED, __HIP_MEMORY_SCOPE_WORKGROUP);
    __syncthreads();
    if (F.tid < 64) F.AU[(size_t)r * 2048 + 1024 + h * HD + F.tid] = (bf16)f2bf(acc[F.tid] * __builtin_amdgcn_rcpf(acc[64]) * bf2f(F.Gb[(size_t)r * DM + h * HD + F.tid]));
    __syncthreads();
}

__device__ __forceinline__ void ssd_unit(Frame& F, int bhs) {
    const Ins& I = F.I;
    LAS float* xs_l = (LAS float*)F.lds; LAS float* B_l = xs_l + 64; LAS float* C_l = B_l + 128; LAS float* ssq_l = C_l + 128;
    const int tid = F.tid, p = tid >> 3, ng = tid & 7;
    const int b = bhs >> 4, hd = bhs & 15, grp = hd >> 3; const size_t r = (size_t)NTOK + b;
    float h[16];
    { const f32x4* hp = (const f32x4*)(I.sssm + (((size_t)b * NH + hd) * HD + p) * DS + ng * 16);
#pragma unroll
      for (int i = 0; i < 4; ++i) { const f32x4 v = hp[i]; h[4 * i] = v[0]; h[4 * i + 1] = v[1]; h[4 * i + 2] = v[2]; h[4 * i + 3] = v[3]; } }
    if (tid < 320) {
        const int ci = tid, c = ci < 64 ? hd * 64 + ci : (ci < 192 ? 1024 + grp * 128 + (ci - 64) : 1280 + grp * 128 + (ci - 192));
        float v = I.conv_b[c];
#pragma unroll
        for (int i = 0; i < 3; ++i) v += I.sconv[((size_t)b * 3 + i) * CONVD + c] * I.conv_w[i * CONVD + c];
        v += bf2f(F.XBC[r * CONVD + c]) * I.conv_w[3 * CONVD + c];
        xs_l[ci] = silu_f(v);
    }
    if (tid == 0) ssq_l[0] = 0.f;
    __syncthreads();
    const float dt = F.DT[(size_t)hd * MROWS + r], A = -__expf(I.a_log[hd]), x = xs_l[p], dec = __expf(dt * A), xdt = x * dt;
    float y = 0.f;
#pragma unroll
    for (int i = 0; i < 16; ++i) { h[i] = h[i] * dec + xdt * B_l[ng * 16 + i]; y += h[i] * C_l[ng * 16 + i]; }
    y += __shfl_xor(y, 1); y += __shfl_xor(y, 2); y += __shfl_xor(y, 4);
    if (ng == 0) {
        const float u = (y + I.d_skip[hd] * x) * bf2f(F.Zb[r * DM + hd * 64 + p]);
        F.AU[r * 2048 + hd * 64 + p] = (bf16)f2bf(u);
        __hip_atomic_fetch_add(ssq_l, u * u, __ATOMIC_RELAXED, __HIP_MEMORY_SCOPE_WORKGROUP);
    }
    { f32x4* ho = (f32x4*)(F.out + O_HS + (((size_t)b * NH + hd) * HD + p) * DS + ng * 16);
#pragma unroll
      for (int i = 0; i < 4; ++i) ho[i] = (f32x4){h[4 * i], h[4 * i + 1], h[4 * i + 2], h[4 * i + 3]}; }
    __syncthreads();
    if (tid == 0) F.SSQ[r * 16 + hd] = ssq_l[0];
    __syncthreads();
}
}

__device__ __forceinline__ void phase2_queue(Frame& F, int qset) {
    const unsigned x = xb_xcc_id() & 7u;
    constexpr int PER_Q = att::NUNITS / 8;
    for (unsigned k = 0; k < 8; ++k) {
        const unsigned qx = (x + k) & 7u;
        for (;;) {
            if (F.tid == 0) F.MISC[16] = __hip_atomic_fetch_add(F.ctl + CW_Q + 64 * (8 * qset + qx), 1u, RLX_AGENT);
            __syncthreads();
            const unsigned idx = F.MISC[16];
            __syncthreads();
            if (idx >= (unsigned)(PER_Q + 128)) break;
            if (idx < 64u) smp::attn_unit(F, (int)(qx * 64 + idx));
            else if (idx < 128u) smp::ssd_unit(F, (int)(qx * 64 + idx - 64));
            else att::unit(F, (int)(qx * PER_Q + idx - 128));
        }
    }
}

constexpr int PROBE_REP_SSD = 1, PROBE_REP_ATT = 1;
struct Args { Ins in; float* out; unsigned char* ws; int ph_lo, ph_hi; };
__global__ void __launch_bounds__(NWAVES * 64, 2) mk_fwd(Args args) {
    extern __shared__ __attribute__((aligned(16))) unsigned char lds[];
    Frame F;
    F.lds = (LAS unsigned char*)lds;
    F.MISC = (volatile LAS unsigned*)(F.lds + MISC_OFF);
    F.tid = threadIdx.x; F.lane = F.tid & 63; F.wave = __builtin_amdgcn_readfirstlane(F.tid >> 6);
    F.G = gridDim.x; { const int bx = blockIdx.x; F.vcu = (F.G % 8 == 0) ? (bx % 8) * (F.G / 8) + bx / 8 : bx; }
    unsigned char* ws = args.ws;
    F.ctl = (gu32*)(ws + WS_CTL); F.I = args.in; F.out = args.out;
    F.WinT = (bf16*)(ws + WS_WIN); F.WoutT = (bf16*)(ws + WS_WOUT); F.XN = (bf16*)(ws + WS_XN); F.Q = (bf16*)(ws + WS_Q); F.K = (bf16*)(ws + WS_K); F.V = (bf16*)(ws + WS_V);
    F.AU = (bf16*)(ws + WS_AU); F.XBC = (bf16*)(ws + WS_XBC); F.DT = (float*)(ws + WS_DT); F.SSQ = (float*)(ws + WS_SSQ); F.RAWB = (float*)(ws + WS_RAWB); F.Gb = (bf16*)(ws + WS_G); F.Zb = (bf16*)(ws + WS_Z);
    for (int u = F.tid; u < (LDS_BYTES - LDSCTL_OFF) / 4; u += NWAVES * 64) ((LAS unsigned*)(F.lds + LDSCTL_OFF))[u] = 0u;
    __syncthreads();
    XcdBarrier bar = xcd_barrier_post((unsigned*)(F.ctl + CW_BAR), F.MISC + 8);
    const int lo = args.ph_lo, hi = args.ph_hi;
#define IN(k) (lo <= (k) && (k) < hi)
#define BOTH(k) (IN(k) && IN((k) + 1))
    if (IN(0)) { p0_prologue(F); if (BOTH(0)) xcd_barrier(bar); }
    if (IN(1)) {
        __syncthreads();
        pg8::Gemm g{F.XN, F.WinT, MROWS, NMAIN, DM}; pg8::StaticOrder S; S.init(MROWS, NMAIN, F.G, (int)blockIdx.x);
        pg8::EpiIn E{F.Q, F.K, F.V, F.Gb, F.Zb, F.XBC, F.out, F.I.qnw, F.I.knw, F.I.conv_w, F.I.conv_b, F.RAWB};
        pg8::gemm_phase<pg8::EpiIn, pg8::StaticOrder, true, true>(F.lds + RING_OFF, g, S, E);
        if (BOTH(1)) xcd_barrier(bar);
    }
    if (IN(2)) { __syncthreads(); if ((F.vcu & 31) < 8 && (F.vcu >> 5) < 8) for (int rep = 0; rep < PROBE_REP_SSD; ++rep) ssd::chain(F, (F.vcu >> 5) * 8 + (F.vcu & 31)); for (int rep = 0; rep < PROBE_REP_ATT; ++rep) phase2_queue(F, rep);     if (BOTH(2)) xcd_barrier(bar); }
    if (IN(3)) {
        __syncthreads();
        pg8::Gemm g{F.AU, F.WoutT, MROWS, DM, 2048}; pg8::StaticOrder S; S.init(MROWS, DM, F.G, (int)blockIdx.x);
        LAS float* rs = (LAS float*)(F.lds + RING_BYTES);
        { pg8::Unit u;
          for (int ui = 0; ui < 4 && S.next(ui, u); ++ui)
              for (int r = F.tid; r < 256; r += NWAVES * 64) {
                  const f32x4* sp = (const f32x4*)(F.SSQ + (size_t)(u.pm * 256 + r) * 16);
                  const f32x4 s0 = sp[0], s1 = sp[1], s2 = sp[2], s3 = sp[3];
                  const float s = ((s0[0] + s0[1]) + (s0[2] + s0[3])) + ((s1[0] + s1[1]) + (s1[2] + s1[3])) + ((s2[0] + s2[1]) + (s2[2] + s2[3])) + ((s3[0] + s3[1]) + (s3[2] + s3[3]));
                  rs[ui * 256 + r] = rsqrtf(s * (1.f / 1024.f) + EPS);
              }
          __syncthreads(); }
        pg8::EpiOut E{F.I.xp, F.I.xs, rs, F.out};
        pg8::gemm_phase<pg8::EpiOut, pg8::StaticOrder, true, true>(F.lds + RING_OFF, g, S, E);
    }
#undef IN
#undef BOTH
}

extern "C" void kernel_launch(void* const* d_in, const int* in_sizes, int n_in, void* d_out, int out_size, void* d_ws, size_t ws_size, hipStream_t stream) {
    static int grid = 0;
    if (grid == 0) {
        if (n_in != 18 || out_size != (int)O_END || ws_size < WS_END) { fprintf(stderr, "kernel_launch: unexpected n_in %d / out_size %d / ws_size %zu; nothing launched\n", n_in, out_size, ws_size); grid = -1; return; }
        int dev = 0, cus = 0;
        if (hipGetDevice(&dev) != hipSuccess || hipDeviceGetAttribute(&cus, hipDeviceAttributeMultiprocessorCount, dev) != hipSuccess) { grid = -1; return; }
        if (hipFuncSetAttribute((const void*)mk_fwd, hipFuncAttributeMaxDynamicSharedMemorySize, LDS_BYTES) != hipSuccess) { fprintf(stderr, "kernel_launch: hipFuncSetAttribute failed\n"); grid = -1; return; }
        (void)hipGetLastError();
        grid = cus;
    }
    if (grid < 0) return;
    (void)hipMemsetAsync((char*)d_ws + WS_CTL, 0, CTL_ZERO_BYTES, stream);
    Args a{};
    const float** ip = (const float**)&a.in;
    for (int i = 0; i < 18; ++i) ip[i] = (const float*)d_in[i];
    a.out = (float*)d_out; a.ws = (unsigned char*)d_ws;
    a.ph_lo = 0; a.ph_hi = 4;
    hipLaunchKernelGGL(mk_fwd, dim3(grid), dim3(NWAVES * 64), LDS_BYTES, stream, a);
}
```

```cpp
#include <hip/hip_runtime.h>
#include <cstdio>
#include <cstdint>

constexpr int DM = 1024, NB = 4, SEQ = 8192, DB = 32, WIN = 2048;
constexpr int NPROJ = 6672, NMAIN = 6656, NTOK = NB * SEQ, NROWS = NTOK + DB;
constexpr int MROWS = 33024;
constexpr int C_Q = 0, C_K = 1024, C_V = 2048, C_G = 3072, C_Z = 4096, C_XBC = 5120, C_DT = 6656;
constexpr int CONVD = 1536, NH = 16, HD = 64, DS = 128;
constexpr float EPS = 1e-6f;
constexpr float QSCALE = 0.125f * 1.4426950408889634f;
constexpr float LOG2E = 1.4426950408889634f;
constexpr size_t O_YP = 0, O_YS = O_YP + (size_t)NTOK * DM, O_KP = O_YS + (size_t)DB * DM, O_VP = O_KP + (size_t)NB * WIN * DM,
                 O_CP = O_VP + (size_t)NB * WIN * DM, O_HP = O_CP + (size_t)NB * 3 * CONVD, O_KS = O_HP + (size_t)NB * NH * HD * DS,
                 O_VS = O_KS + (size_t)DB * DM, O_CS = O_VS + (size_t)DB * DM, O_HS = O_CS + (size_t)DB * 3 * CONVD,
                 O_END = O_HS + (size_t)DB * NH * HD * DS;
static_assert(O_END == 55314432, "output size");

constexpr size_t MiB = 1u << 20;
constexpr size_t WS_CTL = 0, CTL_ZERO_BYTES = 1 * MiB;
constexpr size_t WS_WIN = 2 * MiB;
constexpr size_t WS_WOUT = 16 * MiB;
constexpr size_t WS_DT = 20 * MiB;
constexpr size_t WS_SSQ = 24 * MiB;
constexpr size_t WS_XN = 32 * MiB;
constexpr size_t WS_Q = 100 * MiB;
constexpr size_t WS_K = 168 * MiB;
constexpr size_t WS_V = 236 * MiB;
constexpr size_t WS_AU = 304 * MiB;
constexpr size_t WS_XBC = 436 * MiB;
constexpr size_t WS_RAWB = 536 * MiB;
constexpr size_t WS_G = 544 * MiB;
constexpr size_t WS_Z = 612 * MiB;
constexpr size_t WS_END = 680 * MiB;
static_assert(WS_XN + (size_t)MROWS * DM * 2 <= WS_Q && WS_Q + (size_t)MROWS * DM * 2 <= WS_K && WS_K + (size_t)MROWS * DM * 2 <= WS_V && WS_V + (size_t)MROWS * DM * 2 <= WS_AU &&
              WS_AU + (size_t)MROWS * 2048 * 2 <= WS_XBC && WS_XBC + (size_t)MROWS * CONVD * 2 <= WS_RAWB && WS_RAWB + (size_t)(MROWS / 64) * 6 * 512 * 4 <= WS_G && WS_G + (size_t)MROWS * DM * 2 <= WS_Z && WS_Z + (size_t)MROWS * DM * 2 <= WS_END && WS_WIN + (size_t)NMAIN * DM * 2 <= WS_WOUT && WS_WOUT + (size_t)DM * 2048 * 2 <= WS_DT &&
              WS_DT + (size_t)MROWS * 16 * 4 <= WS_SSQ && WS_SSQ + (size_t)MROWS * 16 * 4 <= WS_XN, "d_ws map");

struct Ins {
    const float *xp, *xs, *ck, *cv, *sconv, *sssm, *norm_w, *w_in, *qnw, *knw, *rel_bias, *conv_w, *conv_b, *dt_bias, *a_log, *d_skip, *ssd_norm_w, *w_out;
};

typedef unsigned short bf16;
__device__ __forceinline__ float wave_sum(float v) {
#pragma unroll
    for (int o = 1; o < 64; o <<= 1) v += __shfl_xor(v, o);
    return v;
}
__device__ __forceinline__ float wave_max(float v) {
#pragma unroll
    for (int o = 1; o < 64; o <<= 1) v = fmaxf(v, __shfl_xor(v, o));
    return v;
}
__device__ __forceinline__ float silu_f(float x) { return x / (1.f + __expf(-x)); }
__device__ __forceinline__ float silu_fast(float x) { return x * __builtin_amdgcn_rcpf(1.f + __builtin_amdgcn_exp2f(-LOG2E * x)); }
__device__ __forceinline__ float softplus_f(float x) { return x > 20.f ? x : log1pf(__expf(x)); }
__device__ __forceinline__ int t5_bucket(int d) {
    if (d < 16) return d;
    int b = 16;
    b += d >= 22; b += d >= 30; b += d >= 40; b += d >= 54; b += d >= 73; b += d >= 99; b += d >= 134; b += d >= 182;
    b += d >= 246; b += d >= 332; b += d >= 450; b += d >= 609; b += d >= 825; b += d >= 1117; b += d >= 1513;
    return b;
}
__device__ __forceinline__ const float* xrow(const Ins& I, int r) { return r < NTOK ? I.xp + (size_t)r * DM : I.xs + (size_t)(r - NTOK) * DM; }
__device__ __forceinline__ float bf2f(bf16 v) { return __uint_as_float((unsigned)v << 16); }
__device__ __forceinline__ unsigned f2bf(float f) { unsigned u = __float_as_uint(f); return (u + 0x7fffu + ((u >> 16) & 1u)) >> 16; }
__device__ __forceinline__ unsigned pk2(float lo, float hi) { return f2bf(lo) | (f2bf(hi) << 16); }
__host__ __device__ __forceinline__ int vrow_of_col(int a) { return 128 * ((a >> 5) & 1) + 32 * ((a >> 6) & 3) + (a & 31); }

namespace pg8 {
#define PG8_LAS __attribute__((address_space(3)))
typedef unsigned short bf16_t;
typedef short bf16x8 __attribute__((ext_vector_type(8)));
typedef float f32x4 __attribute__((ext_vector_type(4)));
typedef unsigned u32x4 __attribute__((ext_vector_type(4)));
constexpr int BM = 256, BK = 64, HALF = 128, HTB = HALF * BK * 2  , STAGE_BYTES = 8 * HTB, NXCD = 8, WGM = 8;

__host__ __device__ __forceinline__ int lds_byte(int r, int c) { const int st = (r >> 4) * 2 + (c >> 5), rr = r & 15, cc = c & 31, ob = rr * 64 + cc * 2; return st * 1024 + (ob ^ (((ob >> 9) & 1) << 5)); }
__host__ __device__ __forceinline__ void stage_rc(int b, int& R, int& C) { const int st = b / 1024, sb = b % 1024, swz = sb ^ (((sb >> 9) & 1) << 5); R = (st >> 1) * 16 + swz / 64; C = (st & 1) * 32 + (swz % 64) / 2; }
__host__ __device__ __forceinline__ int perm32(int rho) { const int n = rho >> 4, i = rho & 15; return 8 * (i >> 2) + 4 * n + (i & 3); }

struct Unit { int pm, pn; };
struct Gemm { const bf16_t* A; const bf16_t* Bt; int M, N, K; };

struct StaticOrder {
    int nM, nN, nwg, G, c;
    __host__ __device__ void init(int M, int N, int G_, int c_) { nM = M / BM; nN = N / BM; nwg = nM * nN; G = G_; c = c_; }
    __host__ __device__ bool next(int i, Unit& u) const {
        const long L = (long)i * G + c; if (L >= nwg) return false;
        int wgid = (int)L; { const int q = nwg / NXCD, r = nwg % NXCD, xcd = wgid % NXCD, off = wgid / NXCD; wgid = (xcd < r ? xcd * (q + 1) : r * (q + 1) + (xcd - r) * q) + off; }
        const int nig = WGM * nN, gid = wgid / nig, fm = gid * WGM, gsz = (nM - fm) < WGM ? (nM - fm) : WGM;
        u.pm = fm + ((wgid % nig) % gsz); u.pn = (wgid % nig) / gsz; return true;
    }
    __device__ __forceinline__ void a_ready(const Unit&) const {}
    __device__ __forceinline__ void done(const Unit&) const {}
};

__device__ __forceinline__ unsigned cvt_pk_bf16(float lo, float hi) { unsigned r; asm volatile("v_cvt_pk_bf16_f32 %0, %1, %2" : "=v"(r) : "v"(lo), "v"(hi)); return r; }

template <int K> __device__ __forceinline__ float rowprev(float cur, float prevm) {
    const int t = __builtin_amdgcn_update_dpp(0, __builtin_bit_cast(int, prevm), 0x100 + (16 - K), 0xf, 0xf, true);
    return __builtin_bit_cast(float, __builtin_amdgcn_update_dpp(t, __builtin_bit_cast(int, cur), 0x110 + K, 0xf, 0xf, false));
}

struct EpiIn {
    static constexpr bool PERM = true, AFTER_DRAIN = false, MIDK = false;
    bf16_t *Q, *K, *V, *Gb, *Zb, *XBC; float* out; const float *qnw, *knw, *conv_w, *conv_b; float* rawb;
    __device__ __forceinline__ void mid(f32x4 (&)[2][2][4][2], const Unit&, int, int, int, int, int) const {}
    __device__ __forceinline__ void operator()(const f32x4 (&acc)[2][2][4][2], const Unit& u, int wr, int wc, int fr, int fq) const {
        const int pn = u.pn;
        const int rowb = u.pm * BM + wr * 64 + fr;
        const int cl = wc * 64 + 8 * fq;
        if (pn < 8) {
            const bool isq = pn < 4; const float* nw = isq ? qnw : knw;
            f32x4 w[2][2];
#pragma unroll
            for (int bj = 0; bj < 2; ++bj)
#pragma unroll
                for (int n = 0; n < 2; ++n) w[bj][n] = *(const f32x4*)(nw + 8 * fq + 32 * bj + 4 * n);
            bf16_t* dstb = (isq ? Q : K) + (pn & 3) * 256 + cl;
#pragma unroll
            for (int ai = 0; ai < 2; ++ai)
#pragma unroll
                for (int m = 0; m < 4; ++m) {
                    const int r = rowb + ai * HALF + m * 16;
                    float ss = 0.f;
#pragma unroll
                    for (int bj = 0; bj < 2; ++bj)
#pragma unroll
                        for (int n = 0; n < 2; ++n) { const f32x4 v = acc[ai][bj][m][n]; ss += (v[0] * v[0] + v[1] * v[1]) + (v[2] * v[2] + v[3] * v[3]); }
                    ss += __shfl_xor(ss, 16); ss += __shfl_xor(ss, 32);
                    const float sc = rsqrtf(ss * (1.f / 64.f) + EPS), scs = isq ? sc * QSCALE : sc;
                    float* f32dst = nullptr;
                    if (!isq) { if (r < NTOK) { const int t = r & (SEQ - 1); if (t >= SEQ - WIN) f32dst = out + O_KP + ((size_t)((r >> 13) * WIN + t - (SEQ - WIN))) * DM + (pn & 3) * 256 + cl; }
                                else if (r < NROWS) f32dst = out + O_KS + (size_t)(r - NTOK) * DM + (pn & 3) * 256 + cl; }
#pragma unroll
                    for (int bj = 0; bj < 2; ++bj) {
                        const f32x4 a0 = acc[ai][bj][m][0] * w[bj][0], a1 = acc[ai][bj][m][1] * w[bj][1];
                        u32x4 o; o.x = cvt_pk_bf16(a0[0] * scs, a0[1] * scs); o.y = cvt_pk_bf16(a0[2] * scs, a0[3] * scs); o.z = cvt_pk_bf16(a1[0] * scs, a1[1] * scs); o.w = cvt_pk_bf16(a1[2] * scs, a1[3] * scs);
                        *(u32x4*)(dstb + (size_t)r * DM + 32 * bj) = o;
                        if (f32dst) { *(f32x4*)(f32dst + 32 * bj) = a0 * sc; *(f32x4*)(f32dst + 32 * bj + 4) = a1 * sc; }
                    }
                }
        } else if (pn < 12) {
            bf16_t* dstb = V + (pn & 3) * 256 + cl;
#pragma unroll
            for (int ai = 0; ai < 2; ++ai)
#pragma unroll
                for (int m = 0; m < 4; ++m) {
                    const int r = rowb + ai * HALF + m * 16;
                    float* f32dst = nullptr;
                    if (r < NTOK) { const int t = r & (SEQ - 1); if (t >= SEQ - WIN) f32dst = out + O_VP + ((size_t)((r >> 13) * WIN + t - (SEQ - WIN))) * DM + (pn & 3) * 256 + cl; }
                    else if (r < NROWS) f32dst = out + O_VS + (size_t)(r - NTOK) * DM + (pn & 3) * 256 + cl;
#pragma unroll
                    for (int bj = 0; bj < 2; ++bj) {
                        const f32x4 a0 = acc[ai][bj][m][0], a1 = acc[ai][bj][m][1];
                        u32x4 o; o.x = cvt_pk_bf16(a0[0], a0[1]); o.y = cvt_pk_bf16(a0[2], a0[3]); o.z = cvt_pk_bf16(a1[0], a1[1]); o.w = cvt_pk_bf16(a1[2], a1[3]);
                        *(u32x4*)(dstb + (size_t)r * DM + 32 * bj) = o;
                        if (f32dst) { *(f32x4*)(f32dst + 32 * bj) = a0; *(f32x4*)(f32dst + 32 * bj + 4) = a1; }
                    }
                }
        } else if (pn < 20) {
            bf16_t* dstb = (pn < 16 ? Gb : Zb) + (pn & 3) * 256 + cl;
#pragma unroll
            for (int ai = 0; ai < 2; ++ai)
#pragma unroll
                for (int m = 0; m < 4; ++m) {
                    const int r = rowb + ai * HALF + m * 16;
#pragma unroll
                    for (int bj = 0; bj < 2; ++bj) {
                        f32x4 a0 = acc[ai][bj][m][0], a1 = acc[ai][bj][m][1];
#pragma unroll
                        for (int i = 0; i < 4; ++i) { a0[i] = silu_fast(a0[i]); a1[i] = silu_fast(a1[i]); }
                        u32x4 o; o.x = cvt_pk_bf16(a0[0], a0[1]); o.y = cvt_pk_bf16(a0[2], a0[3]); o.z = cvt_pk_bf16(a1[0], a1[1]); o.w = cvt_pk_bf16(a1[2], a1[3]);
                        *(u32x4*)(dstb + (size_t)r * DM + 32 * bj) = o;
                    }
                }
        } else {
            const int cb = (pn - 20) * 256 + cl;
            bf16_t* dstb = XBC + cb;
            const bool do_conv = pn >= 24 && u.pm < NTOK / BM;
#pragma unroll
            for (int ai = 0; ai < 2; ++ai)
#pragma unroll
                for (int m = 0; m < 4; ++m) {
                    const int r = rowb + ai * HALF + m * 16;
                    float* f32dst = nullptr;
                    if (r < NTOK) { const int t = r & (SEQ - 1); if (t >= SEQ - 3) f32dst = out + O_CP + ((size_t)((r >> 13) * 3 + t - (SEQ - 3))) * CONVD + cb; }
                    else if (r < NROWS) f32dst = out + O_CS + ((size_t)(r - NTOK) * 3 + 2) * CONVD + cb;
                    if (do_conv && (m == 0 || m == 3)) {
                        const int slot = m == 0 ? 3 + fr : fr - 13;
                        if (slot >= 0 && slot < 6) f32dst = rawb + ((size_t)(u.pm * 4 + ai * 2 + wr) * 6 + slot) * 512 + (cb - 1024);
                    }
#pragma unroll
                    for (int bj = 0; bj < 2; ++bj) {
                        const f32x4 a0 = acc[ai][bj][m][0], a1 = acc[ai][bj][m][1];
                        if (!do_conv) { u32x4 o; o.x = cvt_pk_bf16(a0[0], a0[1]); o.y = cvt_pk_bf16(a0[2], a0[3]); o.z = cvt_pk_bf16(a1[0], a1[1]); o.w = cvt_pk_bf16(a1[2], a1[3]);
                                        *(u32x4*)(dstb + (size_t)r * CONVD + 32 * bj) = o; }
                        if (f32dst) { *(f32x4*)(f32dst + 32 * bj) = a0; *(f32x4*)(f32dst + 32 * bj + 4) = a1; }
                    }
                }
            if (do_conv) {
                if ((u.pm & 31) == 31 && wr == 1 && fr >= 13) {
#pragma unroll
                    for (int bj = 0; bj < 2; ++bj) { float* d = out + O_CP + ((size_t)((u.pm >> 5) * 3 + fr - 13)) * CONVD + cb + 32 * bj; *(f32x4*)d = acc[1][bj][3][0]; *(f32x4*)(d + 4) = acc[1][bj][3][1]; }
                }
#pragma unroll
                for (int bj = 0; bj < 2; ++bj) {
                    f32x4 w[4][2], bb[2];
#pragma unroll
                    for (int n = 0; n < 2; ++n) { bb[n] = *(const f32x4*)(conv_b + cb + 32 * bj + 4 * n);
#pragma unroll
                        for (int t = 0; t < 4; ++t) w[t][n] = *(const f32x4*)(conv_w + t * CONVD + cb + 32 * bj + 4 * n); }
#pragma unroll
                    for (int ai = 0; ai < 2; ++ai) {
                        f32x4 pm[2] = {(f32x4){0.f, 0.f, 0.f, 0.f}, (f32x4){0.f, 0.f, 0.f, 0.f}};
#pragma unroll
                        for (int m = 0; m < 4; ++m) {
                            const int r = rowb + ai * HALF + m * 16;
                            unsigned ow[4];
#pragma unroll
                            for (int n = 0; n < 2; ++n) {
                                const f32x4 cur = acc[ai][bj][m][n]; f32x4 v;
#pragma unroll
                                for (int i = 0; i < 4; ++i) {
                                    const float p1 = rowprev<1>(cur[i], pm[n][i]), p2 = rowprev<2>(cur[i], pm[n][i]), p3 = rowprev<3>(cur[i], pm[n][i]);
                                    v[i] = silu_fast(bb[n][i] + w[0][n][i] * p3 + w[1][n][i] * p2 + w[2][n][i] * p1 + w[3][n][i] * cur[i]);
                                }
                                ow[2 * n] = cvt_pk_bf16(v[0], v[1]); ow[2 * n + 1] = cvt_pk_bf16(v[2], v[3]);
                                pm[n] = cur;
                            }
                            *(u32x4*)(dstb + (size_t)r * CONVD + 32 * bj) = (u32x4){ow[0], ow[1], ow[2], ow[3]};
                        }
                    }
                }
            }
        }
    }
};

struct EpiOut {
    static constexpr bool PERM = true, AFTER_DRAIN = false, MIDK = true;
    const float* xp; const float* xs; const PG8_LAS float* rs; float* out;
    __device__ __forceinline__ void mid(f32x4 (&acc)[2][2][4][2], const Unit& u, int ui, int wr, int wc, int fr, int fq) const {
        const PG8_LAS float* rp = rs + ui * 256 + wr * 64 + fr;
#pragma unroll
        for (int ai = 0; ai < 2; ++ai)
#pragma unroll
            for (int m = 0; m < 4; ++m) {
                const float r = rp[ai * HALF + m * 16];
#pragma unroll
                for (int bj = 0; bj < 2; ++bj)
#pragma unroll
                    for (int n = 0; n < 2; ++n) acc[ai][bj][m][n] *= r;
            }
    }
    __device__ __forceinline__ void operator()(const f32x4 (&acc)[2][2][4][2], const Unit& u, int wr, int wc, int fr, int fq) const {
        const int rowb = u.pm * BM + wr * 64 + fr, col = u.pn * BM + wc * 64 + 8 * fq;
#pragma unroll
        for (int ai = 0; ai < 2; ++ai)
#pragma unroll
            for (int m = 0; m < 4; ++m) {
                const int r = rowb + ai * HALF + m * 16;
                if (r >= NROWS) continue;
                const float* xr = (r < NTOK ? xp + (size_t)r * DM : xs + (size_t)(r - NTOK) * DM) + col;
                float* yr = out + (r < NTOK ? O_YP + (size_t)r * DM : O_YS + (size_t)(r - NTOK) * DM) + col;
#pragma unroll
                for (int bj = 0; bj < 2; ++bj) {
                    *(f32x4*)(yr + 32 * bj) = *(const f32x4*)(xr + 32 * bj) + acc[ai][bj][m][0];
                    *(f32x4*)(yr + 32 * bj + 4) = *(const f32x4*)(xr + 32 * bj + 4) + acc[ai][bj][m][1];
                }
            }
    }
};

template <class Epi, class Sched, bool ALIGN_EPI = false, bool SP2 = false>
__device__ __forceinline__ void gemm_phase(PG8_LAS unsigned char* lds, const Gemm g, const Sched& S, const Epi& E) {
    const int tid = threadIdx.x, wid = __builtin_amdgcn_readfirstlane(tid >> 6), lane = tid & 63, wr = wid >> 2, wc = wid & 3, fr = lane & 15, fq = lane >> 4;
    const int K = g.K, nt = K / BK;
    unsigned voffA[2], voffB[2];
#pragma unroll
    for (int i = 0; i < 2; ++i) { int R, C; stage_rc(tid * 16 + i * 8192, R, C); const int Rb = Epi::PERM ? ((R & ~31) + perm32(R & 31)) : R;
        voffA[i] = (unsigned)(R * K + C) * 2u; voffB[i] = (unsigned)(Rb * K + C) * 2u; }
    const size_t kstep = (size_t)(BK * 2);
    const size_t hstep = (size_t)HALF * K * 2;
    const size_t tstep = 2 * hstep;
    const unsigned ldsw = (unsigned)wid * 1024u;
    const int aoff = lds_byte(wr * 64 + fr, fq * 8), boff = lds_byte(wc * 32 + fr, fq * 8);
#define PG8_SA(b, h) (((b) * 2 + (h)) * HTB)
#define PG8_SB(b, h) ((4 + (b) * 2 + (h)) * HTB)
#define PG8_STAGE(bufoff, gbase, voff) do { _Pragma("unroll") for (int _i = 0; _i < 2; ++_i) \
        __builtin_amdgcn_global_load_lds((const unsigned*)((const char*)(gbase) + (voff)[_i]), (PG8_LAS unsigned*)(lds + (bufoff) + ldsw + _i * 8192), 16, 0, 0); } while (0)
#define PG8_LDA(dst, b, h) do { _Pragma("unroll") for (int m = 0; m < 4; ++m) _Pragma("unroll") for (int k = 0; k < 2; ++k) dst[m][k] = *(const PG8_LAS bf16x8*)(lds + PG8_SA(b, h) + aoff + m * 2048 + k * 1024); } while (0)
#define PG8_LDB(dst, b, h) do { _Pragma("unroll") for (int n = 0; n < 2; ++n) _Pragma("unroll") for (int k = 0; k < 2; ++k) dst[n][k] = *(const PG8_LAS bf16x8*)(lds + PG8_SB(b, h) + boff + n * 2048 + k * 1024); } while (0)
#define PG8_MMA(ai, bj, At, Bt) do { __builtin_amdgcn_s_setprio(1); _Pragma("unroll") for (int m = 0; m < 4; ++m) _Pragma("unroll") for (int n = 0; n < 2; ++n) _Pragma("unroll") for (int k = 0; k < 2; ++k) \
        acc[ai][bj][m][n] = __builtin_amdgcn_mfma_f32_16x16x32_bf16(Bt[n][k], At[m][k], acc[ai][bj][m][n], 0, 0, 0); __builtin_amdgcn_s_setprio(0); } while (0)
#define PG8_WAIT_V(n) asm volatile("s_waitcnt vmcnt(" #n ")" ::: "memory")
#define PG8_WAIT_L(n) asm volatile("s_waitcnt lgkmcnt(" #n ")" ::: "memory")
#define PG8_BAR __builtin_amdgcn_s_barrier()
#define PG8_SCHED __builtin_amdgcn_sched_barrier(0)
    Unit cur, nxt; int ui = 0;
    if (!S.next(0, cur)) return;
    f32x4 acc[2][2][4][2];
#pragma unroll
    for (int a = 0; a < 2; ++a)
#pragma unroll
        for (int b = 0; b < 2; ++b)
#pragma unroll
            for (int m = 0; m < 4; ++m)
#pragma unroll
                for (int n = 0; n < 2; ++n) acc[a][b][m][n] = (f32x4){0.f, 0.f, 0.f, 0.f};
    bf16x8 At[4][2], B0[2][2], B1[2][2];
    const char* cA = (const char*)g.A + (size_t)cur.pm * tstep; const char* cB = (const char*)g.Bt + (size_t)cur.pn * tstep;
    S.a_ready(cur);
    if constexpr (SP2) {
        PG8_STAGE(PG8_SB(0, 0), cB, voffB); PG8_STAGE(PG8_SB(0, 1), cB + hstep, voffB); PG8_STAGE(PG8_SA(0, 0), cA, voffA); PG8_STAGE(PG8_SA(0, 1), cA + hstep, voffA);
        if (wr == 1) PG8_BAR;
        PG8_WAIT_V(2); PG8_BAR;
        PG8_STAGE(PG8_SB(1, 0), cB + kstep, voffB); PG8_STAGE(PG8_SA(1, 0), cA + kstep, voffA); PG8_STAGE(PG8_SB(1, 1), cB + hstep + kstep, voffB);
        PG8_WAIT_V(6); PG8_BAR;
    } else {
        PG8_STAGE(PG8_SB(0, 0), cB, voffB); PG8_STAGE(PG8_SA(0, 0), cA, voffA); PG8_STAGE(PG8_SB(0, 1), cB + hstep, voffB); PG8_STAGE(PG8_SA(0, 1), cA + hstep, voffA);
        if (wr == 1) PG8_BAR;
        PG8_WAIT_V(4); PG8_BAR;
        PG8_STAGE(PG8_SB(1, 0), cB + kstep, voffB); PG8_STAGE(PG8_SA(1, 0), cA + kstep, voffA); PG8_STAGE(PG8_SB(1, 1), cB + hstep + kstep, voffB);
        PG8_WAIT_V(6); PG8_BAR;
    }
    for (;;) {
        const bool has_next = S.next(ui + 1, nxt);
        const char* nA = has_next ? (const char*)g.A + (size_t)nxt.pm * tstep : cA; const char* nB = has_next ? (const char*)g.Bt + (size_t)nxt.pn * tstep : cB;
        for (int t = 0; t < nt; t += 2) {
            const bool last = (t == nt - 2);
            if constexpr (Epi::MIDK) { if (t == (nt >> 1)) E.mid(acc, cur, ui, wr, wc, fr, fq); }
            const char* a1 = cA + (size_t)(t + 1) * kstep;
            const char* a2 = last ? nA : cA + (size_t)(t + 2) * kstep; const char* b2 = last ? nB : cB + (size_t)(t + 2) * kstep;
            const char* a3 = a2 + kstep; const char* b3 = b2 + kstep;
            if (last && has_next) S.a_ready(nxt);
            if constexpr (SP2) {
            PG8_LDB(B0, 0, 0); PG8_LDB(B1, 0, 1); PG8_SCHED; PG8_LDA(At, 0, 0); PG8_STAGE(PG8_SA(1, 1), a1 + hstep, voffA);
            PG8_WAIT_V(8); PG8_WAIT_L(0); PG8_BAR; PG8_MMA(0, 0, At, B0); PG8_MMA(0, 1, At, B1); PG8_BAR; PG8_SCHED;
            PG8_LDA(At, 0, 1); PG8_STAGE(PG8_SB(0, 0), b2, voffB); PG8_STAGE(PG8_SB(0, 1), b2 + hstep, voffB); PG8_STAGE(PG8_SA(0, 0), a2, voffA);
            PG8_WAIT_V(8); PG8_WAIT_L(0); PG8_BAR; PG8_MMA(1, 0, At, B0); PG8_MMA(1, 1, At, B1); PG8_BAR; PG8_SCHED;
            PG8_LDB(B0, 1, 0); PG8_LDB(B1, 1, 1); PG8_SCHED; PG8_LDA(At, 1, 0); PG8_STAGE(PG8_SA(0, 1), a2 + hstep, voffA);
            PG8_WAIT_V(8); PG8_WAIT_L(0); PG8_BAR; PG8_MMA(0, 0, At, B0); PG8_MMA(0, 1, At, B1); PG8_BAR; PG8_SCHED;
            PG8_LDA(At, 1, 1); PG8_STAGE(PG8_SB(1, 0), b3, voffB); PG8_STAGE(PG8_SB(1, 1), b3 + hstep, voffB); PG8_STAGE(PG8_SA(1, 0), a3, voffA);
            PG8_WAIT_V(8); PG8_WAIT_L(0); PG8_BAR; PG8_MMA(1, 0, At, B0); PG8_MMA(1, 1, At, B1); PG8_BAR; PG8_SCHED;
            } else {
            PG8_LDB(B0, 0, 0); PG8_SCHED; PG8_LDA(At, 0, 0); PG8_STAGE(PG8_SA(1, 1), a1 + hstep, voffA);
            PG8_WAIT_L(8); PG8_BAR; PG8_WAIT_L(0); PG8_MMA(0, 0, At, B0); PG8_BAR; PG8_SCHED;
            PG8_LDB(B1, 0, 1); PG8_STAGE(PG8_SB(0, 0), b2, voffB);
            PG8_BAR; PG8_WAIT_L(0); PG8_MMA(0, 1, At, B1); PG8_BAR;
            PG8_LDA(At, 0, 1); PG8_STAGE(PG8_SA(0, 0), a2, voffA);
            PG8_BAR; PG8_WAIT_L(0); PG8_MMA(1, 0, At, B0); PG8_BAR; PG8_SCHED;
            PG8_STAGE(PG8_SB(0, 1), b2 + hstep, voffB);
            PG8_WAIT_V(6); PG8_BAR; PG8_MMA(1, 1, At, B1); PG8_BAR;
            PG8_LDB(B0, 1, 0); PG8_SCHED; PG8_LDA(At, 1, 0); PG8_STAGE(PG8_SA(0, 1), a2 + hstep, voffA);
            PG8_WAIT_L(8); PG8_BAR; PG8_WAIT_L(0); PG8_MMA(0, 0, At, B0); PG8_BAR; PG8_SCHED;
            PG8_LDB(B1, 1, 1); PG8_STAGE(PG8_SB(1, 0), b3, voffB);
            PG8_BAR; PG8_WAIT_L(0); PG8_MMA(0, 1, At, B1); PG8_BAR;
            PG8_LDA(At, 1, 1); PG8_STAGE(PG8_SA(1, 0), a3, voffA);
            PG8_BAR; PG8_WAIT_L(0); PG8_MMA(1, 0, At, B0); PG8_BAR; PG8_SCHED;
            PG8_STAGE(PG8_SB(1, 1), b3 + hstep, voffB);
            PG8_WAIT_V(6); PG8_BAR; PG8_MMA(1, 1, At, B1); PG8_BAR;
            }
        }
        if constexpr (ALIGN_EPI) { if (wr == 0) PG8_BAR; }
        if constexpr (!Epi::AFTER_DRAIN) { E(acc, cur, wr, wc, fr, fq); S.done(cur); }
        if (!has_next) break;
#pragma unroll
        for (int a = 0; a < 2; ++a)
#pragma unroll
            for (int b = 0; b < 2; ++b)
#pragma unroll
                for (int m = 0; m < 4; ++m)
#pragma unroll
                    for (int n = 0; n < 2; ++n) acc[a][b][m][n] = (f32x4){0.f, 0.f, 0.f, 0.f};
        cur = nxt; cA = nA; cB = nB; ++ui;
        if constexpr (ALIGN_EPI) { if (wr == 1) PG8_BAR; }
    }
    PG8_WAIT_V(0);
    if constexpr (!ALIGN_EPI) { if (wr == 0) PG8_BAR; }
    PG8_BAR;
    if constexpr (Epi::AFTER_DRAIN) { E.fused(acc, cur, wr, wc, fr, fq, lds, wid, lane); S.done(cur); }
#undef PG8_SA
#undef PG8_SB
#undef PG8_STAGE
#undef PG8_LDA
#undef PG8_LDB
#undef PG8_MMA
#undef PG8_WAIT_V
#undef PG8_WAIT_L
#undef PG8_BAR
#undef PG8_SCHED
}
}
#define GAS __attribute__((address_space(1)))
#define LAS __attribute__((address_space(3)))
typedef unsigned v4u __attribute__((ext_vector_type(4)));
typedef float f32x4 __attribute__((ext_vector_type(4)));
typedef short bf16x8 __attribute__((ext_vector_type(8)));
typedef GAS unsigned gu32;
typedef GAS unsigned long long gu64;
#define RLX_AGENT __ATOMIC_RELAXED, __HIP_MEMORY_SCOPE_AGENT
#define LDS_WAIT() asm volatile("s_waitcnt lgkmcnt(0)" ::: "memory")
#define VM_WAIT() asm volatile("s_waitcnt vmcnt(0)" ::: "memory")
__device__ __forceinline__ unsigned long long rt() { return __builtin_amdgcn_s_memrealtime(); }

#define XB_TMO      128
#define XB_XCNT(j)  (256  + 64 * (j))
#define XB_XSUB(j)  (1280 + 64 * (j))
#define XB_XGEN(j)  (2304 + 64 * (j))
#define XB_TOP      3328
#define XB_TOPGEN   3392
#define XCD_BAR_WORDS 3456
#define XB_SPIN_CAP (1u << 18)

__device__ __forceinline__ unsigned xb_ld(unsigned* p)              { return __hip_atomic_load(p, __ATOMIC_RELAXED, __HIP_MEMORY_SCOPE_AGENT); }
__device__ __forceinline__ unsigned xb_add(unsigned* p, unsigned v) { return __hip_atomic_fetch_add(p, v, __ATOMIC_RELAXED, __HIP_MEMORY_SCOPE_AGENT); }
__device__ __forceinline__ unsigned xb_xcc_id() { return (unsigned)__builtin_amdgcn_s_getreg((3 << 11) | 20) & 0xFu; }
#define XB_SPIN(cond, bar) do { unsigned _sp = 0; while (cond) { __builtin_amdgcn_s_sleep(1); \
    if ((++_sp & 255u) == 0u) { if (xb_ld(&(bar)[XB_TMO])) break; if (_sp > XB_SPIN_CAP) { atomicAdd(&(bar)[XB_TMO], 1u); break; } } } } while (0)

struct XcdBarrier {
    unsigned* bar; unsigned x;
    volatile LAS unsigned* st;
};

__device__ __forceinline__ XcdBarrier xcd_barrier_post(unsigned* bar, volatile LAS unsigned* st) {
    XcdBarrier b; b.bar = bar; b.x = xb_xcc_id(); b.st = st;
    if (threadIdx.x == 0) (void)xb_add(&bar[XB_XCNT(b.x)], 1u);
    return b;
}
__device__ __forceinline__ void xcd_barrier_complete(unsigned* bar, unsigned x, unsigned& nloc, unsigned& nx) {
    const unsigned G = gridDim.x * gridDim.y * gridDim.z;
    unsigned sum, cnt, mine, sp = 0u;
    for (;;) {
        sum = 0u; cnt = 0u; mine = 0u;
#pragma unroll
        for (unsigned j = 0; j < 16; ++j) { const unsigned c = xb_ld(&bar[XB_XCNT(j)]); sum += c; cnt += (c > 0u) ? 1u : 0u; mine = (j == x) ? c : mine; }
        if (sum == G) break;
        __builtin_amdgcn_s_sleep(1);
        if ((++sp & 255u) == 0u) { if (xb_ld(&bar[XB_TMO])) break; if (sp > XB_SPIN_CAP) { atomicAdd(&bar[XB_TMO], 1u); break; } }
    }
    nloc = mine > 0u ? mine : 1u; nx = cnt > 0u ? cnt : 1u;
}

__device__ __forceinline__ void xcd_barrier(const XcdBarrier& b) {
    asm volatile("s_waitcnt vmcnt(0)" ::: "memory");
    __syncthreads();
    if (threadIdx.x == 0) {
        unsigned* bar = b.bar;
        __builtin_amdgcn_s_waitcnt(0);
        unsigned nloc = b.st[0], nx = b.st[1];
        if (nloc == 0u) { xcd_barrier_complete(bar, b.x, nloc, nx); b.st[0] = nloc; b.st[1] = nx; }
        const unsigned old = xb_add(&bar[XB_XSUB(b.x)], 1u);
        const unsigned gen = old / nloc;
        if (old + 1u == (gen + 1u) * nloc) {
            __builtin_amdgcn_fence(__ATOMIC_RELEASE, "agent");
            asm volatile("s_waitcnt vmcnt(0)" ::: "memory");
            const unsigned og = xb_add(&bar[XB_TOP], 1u);
            const unsigned tg = og / nx;
            if (og + 1u == (tg + 1u) * nx) xb_add(&bar[XB_TOPGEN], 1u);
            else XB_SPIN(xb_ld(&bar[XB_TOPGEN]) == tg, bar);
            __builtin_amdgcn_fence(__ATOMIC_ACQUIRE, "agent");
            xb_add(&bar[XB_XGEN(b.x)], 1u);
            asm volatile("s_waitcnt vmcnt(0)" ::: "memory");
        } else {
            XB_SPIN(xb_ld(&bar[XB_XGEN(b.x)]) == gen, bar);
            __builtin_amdgcn_fence(__ATOMIC_ACQUIRE, "agent");
            asm volatile("s_waitcnt vmcnt(0)" ::: "memory");
        }
    }
    __syncthreads();
}

constexpr int NWAVES = 8;
constexpr int RING_OFF = 0, RING_BYTES = 131072;
constexpr int LDS_BYTES = 163840;
constexpr int LDSCTL_OFF = LDS_BYTES - 512, MISC_OFF = LDSCTL_OFF + 320;
constexpr int CW_BAR = 4096;
constexpr int CW_Q = 16384;
static_assert((CW_BAR + XCD_BAR_WORDS) <= CW_Q && (CW_Q + 64 * 64) * 4 <= (int)CTL_ZERO_BYTES, "CTL words inside the memset region");

constexpr int PROBE_ID = 0;
#define PB_BEGIN(id) long long pb_t0_ = 0; if (PROBE_ID == (id)) pb_t0_ = clock64();
#define PB_END(id) if (PROBE_ID == (id)) { const long long t1_ = clock64(), dt_ = t1_ - pb_t0_; while (clock64() - t1_ < dt_) __builtin_amdgcn_s_sleep(2); }
struct Frame {
    LAS unsigned char* lds;
    volatile LAS unsigned* MISC;
    gu32* ctl;
    int tid, lane, wave, vcu, G;
    Ins I; float* out;
    bf16 *WinT, *WoutT, *XN, *Q, *K, *V, *AU, *XBC, *Gb, *Zb; float *DT, *SSQ, *RAWB;
};

template <class SrcF>
__device__ __forceinline__ void p0_transpose_item(SrcF src, int k0, int n0, bf16* WT, int dst_pitch, int dst_row0, int dst_k0, LAS float* scr, int lane) {
#pragma unroll 8
    for (int i = 0; i < 32; ++i) { const int kk = 2 * i + (lane >> 5); scr[kk * 33 + (lane & 31)] = src(k0 + kk, n0 + (lane & 31)); }
    LDS_WAIT(); asm volatile("" ::: "memory");
    const int c = lane & 7;
#pragma unroll
    for (int j = 0; j < 4; ++j) { const int n = (lane >> 3) + 8 * j; const LAS float* s = scr + (8 * c) * 33 + n;
        v4u o; o.x = pk2(s[0 * 33], s[1 * 33]); o.y = pk2(s[2 * 33], s[3 * 33]); o.z = pk2(s[4 * 33], s[5 * 33]); o.w = pk2(s[6 * 33], s[7 * 33]);
        *(GAS v4u*)(WT + (size_t)(dst_row0 + n) * dst_pitch + dst_k0 + 8 * c) = o; }
    LDS_WAIT(); asm volatile("" ::: "memory");
}
constexpr int P0_SCR_BYTES = 8448, WDT_OFF = NWAVES * P0_SCR_BYTES, WDT_PITCH = 20;
static_assert(WDT_OFF + 1024 * WDT_PITCH * 4 <= LDSCTL_OFF, "prologue LDS");

__device__ __forceinline__ void p0_prologue(Frame& F) {
    const Ins& I = F.I;
    LAS float* scr = (LAS float*)(F.lds + F.wave * P0_SCR_BYTES);
    LAS float* wdt = (LAS float*)(F.lds + WDT_OFF);
    const int gw = F.vcu * NWAVES + F.wave, NGW = F.G * NWAVES;
    for (int idx = F.tid; idx < 1024 * 16; idx += NWAVES * 64) {
        const int k = idx >> 4, j = idx & 15, pos = (((k >> 8) * 4 + (k & 3)) << 6) + ((k >> 2) & 63);
        wdt[pos * WDT_PITCH + j] = I.w_in[(size_t)k * NPROJ + C_DT + j] * I.norm_w[k];
    }
    constexpr int I_IN = (DM / 64) * (NMAIN / 32), I_OUT = (2048 / 64) * (DM / 32);
    for (int it = gw; it < I_IN + I_OUT; it += NGW) {
        if (it < I_IN) {
            const int nblk = NMAIN / 32, kb = it / nblk, nb = it % nblk, k0 = 64 * kb, n0 = 32 * nb;
            p0_transpose_item([&](int k, int n) { return I.w_in[(size_t)k * NPROJ + n] * I.norm_w[k]; }, k0, n0, F.WinT, DM, (n0 & ~255) + vrow_of_col(n0 & 255), k0, scr, F.lane);
        } else {
            const int r = it - I_IN, nblk = DM / 32, kb = r / nblk, nb = r % nblk, k0 = 64 * kb, n0 = 32 * nb;
            p0_transpose_item([&](int k, int n) { return I.w_out[(size_t)k * DM + n] * (k >= 1024 ? I.ssd_norm_w[k - 1024] : 1.f); }, k0, n0, F.WoutT, 2048, (n0 & ~255) + vrow_of_col(n0 & 255), (k0 + 1024) & 2047, scr, F.lane);
        }
    }
    __syncthreads();
    for (int rp = gw; rp < NROWS / 2; rp += NGW) {
        f32x4 v[2][4]; float rstd[2];
#pragma unroll
        for (int q = 0; q < 2; ++q) {
            const GAS f32x4* xr = (const GAS f32x4*)xrow(I, 2 * rp + q) + F.lane; float s = 0.f;
#pragma unroll
            for (int j = 0; j < 4; ++j) { v[q][j] = xr[64 * j]; s += (v[q][j].x * v[q][j].x + v[q][j].y * v[q][j].y) + (v[q][j].z * v[q][j].z + v[q][j].w * v[q][j].w); }
            rstd[q] = rsqrtf(wave_sum(s) * (1.f / DM) + EPS);
            GAS unsigned long long* o8 = (GAS unsigned long long*)(F.XN + (size_t)(2 * rp + q) * DM) + F.lane;
#pragma unroll
            for (int j = 0; j < 4; ++j) o8[64 * j] = (unsigned long long)pk2(v[q][j].x * rstd[q], v[q][j].y * rstd[q]) | ((unsigned long long)pk2(v[q][j].z * rstd[q], v[q][j].w * rstd[q]) << 32);
        }
        float a[32];
#pragma unroll
        for (int i = 0; i < 32; ++i) a[i] = 0.f;
#pragma unroll
        for (int j = 0; j < 4; ++j)
#pragma unroll
            for (int e = 0; e < 4; ++e) {
                const LAS f32x4* wp = (const LAS f32x4*)(wdt + ((j * 4 + e) * 64 + F.lane) * WDT_PITCH);
                const float x0 = v[0][j][e], x1 = v[1][j][e];
#pragma unroll
                for (int c4 = 0; c4 < 4; ++c4) { const f32x4 w = wp[c4];
#pragma unroll
                    for (int i = 0; i < 4; ++i) { a[c4 * 4 + i] += x0 * w[i]; a[16 + c4 * 4 + i] += x1 * w[i]; } }
                asm volatile("" ::: "memory");
            }
#define P0_HALVE(N, X) { const bool up = (F.lane & (X)) != 0; _Pragma("unroll") for (int i = 0; i < (N); ++i) { const float keep = up ? a[i + (N)] : a[i], send = up ? a[i] : a[i + (N)]; a[i] = keep + __shfl_xor(send, (X)); } }
        P0_HALVE(16, 32) P0_HALVE(8, 16) P0_HALVE(4, 8) P0_HALVE(2, 4) P0_HALVE(1, 2)
#undef P0_HALVE
        float tot = a[0] + __shfl_xor(a[0], 1);
        const int idx = F.lane >> 1, q = idx >> 4, c = idx & 15;
        tot = tot * (q ? rstd[1] : rstd[0]) + I.dt_bias[c];
        if ((F.lane & 1) == 0) F.DT[(size_t)c * MROWS + 2 * rp + q] = softplus_f(tot);
    }
    for (int r = NROWS + gw; r < MROWS; r += NGW) { GAS v4u* o = (GAS v4u*)(F.XN + (size_t)r * DM) + F.lane; o[0] = (v4u){0u, 0u, 0u, 0u}; o[64] = (v4u){0u, 0u, 0u, 0u}; }
    for (int i = (F.vcu * NWAVES * 64 + F.tid); i < DB * 2 * CONVD; i += F.G * NWAVES * 64) {
        const int c = i % CONVD, rr = i / CONVD, j = rr & 1, b = rr >> 1;
        F.out[O_CS + ((size_t)b * 3 + j) * CONVD + c] = I.sconv[((size_t)b * 3 + j + 1) * CONVD + c];
    }
}

namespace att {
typedef float f32x16 __attribute__((ext_vector_type(16)));
typedef short v4i16_t __attribute__((ext_vector_type(4)));
typedef unsigned u32x4 __attribute__((ext_vector_type(4)));
constexpr int SPAN = 256, NSPAN = SEQ / SPAN, NUNITS = NB * NH * NSPAN;
constexpr int OPITCH = 68  , OACC_OFF = 0, LACC_OFF = SPAN * OPITCH * 4, LUT_OFF = LACC_OFF + 1024, VST_OFF = LUT_OFF + 2048, VST_BYTES = 8192, ATT_LDS_END = VST_OFF + NWAVES * VST_BYTES;
static_assert(ATT_LDS_END <= LDSCTL_OFF, "attention LDS");
__device__ __forceinline__ int crow(int r, int hi) { return (r & 3) + 8 * (r >> 2) + 4 * hi; }

struct ItemRegs { bf16x8 qf[4]; v4u kreg[4], vreg[4]; };
struct ItemOut { f32x16 o0, o1; float lsum; };
#define ATT_LOAD_K(R, KT) do { _Pragma("unroll") for (int i = 0; i < 4; ++i) { int tk_ = tq0 + (-128 + 32 * (KT) + 8 * i + (lane >> 3)) * d; tk_ = tk_ < 0 ? 0 : tk_; \
        (R).kreg[i] = *(const v4u*)(Kb + (size_t)tk_ * DM + 8 * (lane & 7)); } } while (0)
#define ATT_LOAD_V(R, KT) do { _Pragma("unroll") for (int i = 0; i < 4; ++i) { int tk_ = tq0 + (-128 + 32 * (KT) + 8 * i + (lane >> 3)) * d; tk_ = tk_ < 0 ? 0 : tk_; \
        (R).vreg[i] = *(const v4u*)(Vb + (size_t)tk_ * DM + 8 * (lane & 7)); } } while (0)
template <int NQ>
__device__ __forceinline__ void item_load(ItemRegs& R, const bf16* Qb, const bf16* Kb, const bf16* Vb, int tq0, int d, int lane) {
    const int c = lane & 31, hi = lane >> 5;
    const bf16* qp = Qb + (size_t)(tq0 + (NQ == 32 ? c : (c & 15)) * d) * DM + 8 * hi;
#pragma unroll
    for (int ks = 0; ks < 4; ++ks) R.qf[ks] = *(const bf16x8*)(qp + 16 * ks);
    ATT_LOAD_K(R, 0); ATT_LOAD_V(R, 0);
}
template <int NQ>
__device__ __forceinline__ void item_tiles(ItemRegs& R, ItemOut& O, const bf16* Kb, const bf16* Vb, int tq0, int d, int pat, LAS unsigned char* lds, int wave, int lane) {
    const int c = lane & 31, hi = lane >> 5;
    LAS unsigned char* kst = lds + VST_OFF + wave * VST_BYTES;
    LAS unsigned char* vst = kst + 4096;
    const LAS float* lut = (const LAS float*)(lds + LUT_OFF) + pat * 129;
    f32x16 o0 = {}, o1 = {};
    float lsum = 0.f;
    const int lrow = lane >> 3, lch = lane & 7;
    const int stoff = lrow * 128 + ((lch ^ lrow) << 4);
    const int kfo = c * 128;
    const int q4 = (lane & 15) >> 2, odd = (lane >> 4) & 1, p4 = lane & 3;
#pragma unroll 1
    for (int kt = 0; kt < 5; ++kt) {
#pragma unroll
        for (int i = 0; i < 4; ++i) { *(LAS v4u*)(kst + i * 1024 + stoff) = R.kreg[i]; *(LAS v4u*)(vst + i * 1024 + stoff) = R.vreg[i]; }
        asm volatile("" ::: "memory");
        if (kt < 4) { ATT_LOAD_K(R, kt + 1); ATT_LOAD_V(R, kt + 1); }
        bf16x8 kf[4];
#pragma unroll
        for (int ks = 0; ks < 4; ++ks) kf[ks] = *(const LAS bf16x8*)(kst + kfo + (((2 * ks + hi) ^ (c & 7)) << 4));
        f32x16 st = {};
#pragma unroll
        for (int ks = 0; ks < 4; ++ks) st = __builtin_amdgcn_mfma_f32_32x32x16_bf16(kf[ks], R.qf[ks], st, 0, 0, 0);
        const int relb = c + 128 - 32 * kt - 4 * hi, tkb = tq0 + (-128 + 32 * kt + 4 * hi) * d;
        if (kt == 0 || kt == 4 || tkb < 0) {
#pragma unroll
            for (int r = 0; r < 16; ++r) {
                const int kk = (r & 3) + 8 * (r >> 2), rel = relb - kk;
                const bool valid = (rel >= 0) && (rel <= 128) && (tkb + kk * d >= 0);
                const float bias = lut[rel < 0 ? 0 : (rel > 128 ? 128 : rel)];
                const float pe = __builtin_amdgcn_exp2f(st[r] + bias), p = valid ? pe : 0.f;
                st[r] = p; lsum += p;
            }
        } else {
#pragma unroll
            for (int r = 0; r < 16; ++r) { const float p = __builtin_amdgcn_exp2f(st[r] + lut[relb - ((r & 3) + 8 * (r >> 2))]); st[r] = p; lsum += p; }
        }
        u32x4 pw0, pw1;
        pw0.x = pg8::cvt_pk_bf16(st[0], st[1]); pw0.y = pg8::cvt_pk_bf16(st[2], st[3]); pw0.z = pg8::cvt_pk_bf16(st[4], st[5]); pw0.w = pg8::cvt_pk_bf16(st[6], st[7]);
        pw1.x = pg8::cvt_pk_bf16(st[8], st[9]); pw1.y = pg8::cvt_pk_bf16(st[10], st[11]); pw1.z = pg8::cvt_pk_bf16(st[12], st[13]); pw1.w = pg8::cvt_pk_bf16(st[14], st[15]);
        const bf16x8 pa0 = __builtin_bit_cast(bf16x8, pw0), pa1 = __builtin_bit_cast(bf16x8, pw1);
#pragma unroll
        for (int dh = 0; dh < 2; ++dh)
#pragma unroll
            for (int s = 0; s < 2; ++s) {
                const int kr = 16 * s + 4 * hi + q4, ch16 = 4 * dh + 2 * odd + (p4 >> 1);
                const LAS unsigned char* vp0 = vst + kr * 128 + ((ch16 ^ (kr & 7)) << 4) + (p4 & 1) * 8;
                const LAS unsigned char* vp1 = vst + (kr + 8) * 128 + ((ch16 ^ (kr & 7)) << 4) + (p4 & 1) * 8;
                const v4i16_t lo = __builtin_amdgcn_ds_read_tr16_b64_v4i16((LAS v4i16_t*)vp0), hh = __builtin_amdgcn_ds_read_tr16_b64_v4i16((LAS v4i16_t*)vp1);
                const bf16x8 vb = (bf16x8){lo[0], lo[1], lo[2], lo[3], hh[0], hh[1], hh[2], hh[3]};
                if (dh == 0) o0 = __builtin_amdgcn_mfma_f32_32x32x16_bf16(s == 0 ? pa0 : pa1, vb, o0, 0, 0, 0);
                else         o1 = __builtin_amdgcn_mfma_f32_32x32x16_bf16(s == 0 ? pa0 : pa1, vb, o1, 0, 0, 0);
            }
    }
    lsum += __shfl_xor(lsum, 32);
    O.o0 = o0; O.o1 = o1; O.lsum = lsum;
}
template <int NQ, bool ACC>
__device__ __forceinline__ void item_acc(const ItemOut& O, int toff, int d, LAS unsigned char* lds, int lane) {
    const int c = lane & 31, hi = lane >> 5;
    LAS float* oacc = (LAS float*)(lds + OACC_OFF); LAS float* lacc = (LAS float*)(lds + LACC_OFF);
    if (hi == 0 && c < NQ) { LAS float* lp = lacc + toff + c * d; *lp = ACC ? *lp + O.lsum : O.lsum; }
#pragma unroll
    for (int r = 0; r < (NQ == 32 ? 16 : 8); ++r) {
        const int q = crow(r, hi); LAS float* row = oacc + (toff + q * d) * OPITCH + c;
        if (ACC) { row[0] += O.o0[r]; row[32] += O.o1[r]; } else { row[0] = O.o0[r]; row[32] = O.o1[r]; }
    }
}

__device__ __forceinline__ void unit(Frame& F, int uidx) {
    const int span = uidx % NSPAN, bh = uidx / NSPAN, h = bh % NH, b = bh / NH, t0 = span * SPAN;
    LAS unsigned char* lds = F.lds;
    LAS float* oacc = (LAS float*)(lds + OACC_OFF); LAS float* lacc = (LAS float*)(lds + LACC_OFF); LAS float* lut = (LAS float*)(lds + LUT_OFF);
    if (F.tid < 387) { const int pat = F.tid / 129, rel = F.tid - pat * 129, d = pat == 0 ? 1 : (pat == 1 ? 4 : 16); lut[F.tid] = F.I.rel_bias[t5_bucket(rel * d) * NH + h] * LOG2E; }
    const size_t boff = (size_t)b * SEQ * DM + h * HD;
    const bf16 *Qb = F.Q + boff, *Kb = F.K + boff, *Vb = F.V + boff;
    const int w = F.wave, lane = F.lane;
    ItemRegs R; ItemOut O;
    const int tqA = t0 + 32 * w, tqB = t0 + (w & 3) + 128 * (w >> 2), tqC = t0 + w, tqD = t0 + w + 8;
    item_load<32>(R, Qb, Kb, Vb, tqA, 1, lane);
    __syncthreads();
    item_tiles<32>(R, O, Kb, Vb, tqA, 1, 0, lds, w, lane);
    item_load<32>(R, Qb, Kb, Vb, tqB, 4, lane);
    item_acc<32, false>(O, tqA - t0, 1, lds, lane);
    __syncthreads();
    item_tiles<32>(R, O, Kb, Vb, tqB, 4, 1, lds, w, lane);
    item_load<16>(R, Qb, Kb, Vb, tqC, 16, lane);
    item_acc<32, true>(O, tqB - t0, 4, lds, lane);
    __syncthreads();
    item_tiles<16>(R, O, Kb, Vb, tqC, 16, 2, lds, w, lane);
    item_load<16>(R, Qb, Kb, Vb, tqD, 16, lane);
    item_acc<16, true>(O, tqC - t0, 16, lds, lane);
    item_tiles<16>(R, O, Kb, Vb, tqD, 16, 2, lds, w, lane);
    item_acc<16, true>(O, tqD - t0, 16, lds, lane);
    __syncthreads();
    {
        const int tl = 32 * w + (F.lane >> 1), hf = F.lane & 1;
        const bf16* gp = F.Gb + ((size_t)b * SEQ + t0 + tl) * DM + h * HD + 32 * hf;
        bf16* ap = F.AU + ((size_t)b * SEQ + t0 + tl) * 2048 + 1024 + h * HD + 32 * hf;
        v4u g[4];
#pragma unroll
        for (int j4 = 0; j4 < 4; ++j4) g[j4] = *(const v4u*)(gp + 8 * j4);
        const float rl = __builtin_amdgcn_rcpf(lacc[tl]);
        const LAS f32x4* op = (const LAS f32x4*)(oacc + tl * OPITCH + 32 * hf);
#pragma unroll
        for (int j4 = 0; j4 < 4; ++j4) {
            const f32x4 a = op[2 * j4], bq = op[2 * j4 + 1]; const v4u gg = g[j4];
            v4u o;
            o.x = pk2(a[0] * rl * __uint_as_float(gg.x << 16), a[1] * rl * __uint_as_float(gg.x & 0xffff0000u));
            o.y = pk2(a[2] * rl * __uint_as_float(gg.y << 16), a[3] * rl * __uint_as_float(gg.y & 0xffff0000u));
            o.z = pk2(bq[0] * rl * __uint_as_float(gg.z << 16), bq[1] * rl * __uint_as_float(gg.z & 0xffff0000u));
            o.w = pk2(bq[2] * rl * __uint_as_float(gg.w << 16), bq[3] * rl * __uint_as_float(gg.w & 0xffff0000u));
            *(v4u*)(ap + 8 * j4) = o;
        }
    }
    __syncthreads();
}

}

namespace ssd {
typedef float f32x16 __attribute__((ext_vector_type(16)));
typedef short v4i16_t __attribute__((ext_vector_type(4)));
typedef unsigned u32x2 __attribute__((ext_vector_type(2)));
typedef float f32x2v __attribute__((ext_vector_type(2)));
constexpr int PITCH = 272;
constexpr int BT_OFF = 0, CT_OFF = 34816, G_OFF = 69632, HB_OFF = 104448, XD_OFF = 121856, XH_OFF = 138240, ACS_OFF = 154624, DTL_OFF = ACS_OFF + 512, SSQL_OFF = DTL_OFF + 512, XW_OFF = SSQL_OFF + 512  , FW_OFF = XW_OFF + 1280  , SSD_LDS_END = FW_OFF + 5120;
static_assert(SSD_LDS_END <= LDSCTL_OFF, "SSD LDS");
__device__ __forceinline__ int crow(int r, int hi) { return (r & 3) + 8 * (r >> 2) + 4 * hi; }
__device__ __forceinline__ bf16x8 trfrag(const LAS unsigned char* p0, const LAS unsigned char* p1) {
    const v4i16_t lo = __builtin_amdgcn_ds_read_tr16_b64_v4i16((LAS v4i16_t*)p0), hh = __builtin_amdgcn_ds_read_tr16_b64_v4i16((LAS v4i16_t*)p1);
    return (bf16x8){lo[0], lo[1], lo[2], lo[3], hh[0], hh[1], hh[2], hh[3]};
}
__device__ __forceinline__ float bflo(unsigned w) { return __uint_as_float(w << 16); }
__device__ __forceinline__ float bfhi(unsigned w) { return __uint_as_float(w & 0xffff0000u); }

__device__ __forceinline__ void chain(Frame& F, int bh) {
    const Ins& I = F.I;
    const int b = bh >> 4, hd = bh & 15, grp = hd >> 3;
    const int tid = F.tid, lane = F.lane, w = F.wave, c = lane & 31, hi = lane >> 5;
    LAS unsigned char* lds = F.lds;
    LAS float* acs = (LAS float*)(lds + ACS_OFF); LAS float* dtl = (LAS float*)(lds + DTL_OFF); LAS float* ssql = (LAS float*)(lds + SSQL_OFF);
    const float A = -__expf(I.a_log[hd]), dsk = I.d_skip[hd];
    const size_t row0 = (size_t)b * SEQ;
    for (int i = tid; i < 17408 / 16; i += NWAVES * 64) ((LAS v4u*)(lds + HB_OFF))[i] = (v4u){0u, 0u, 0u, 0u};
    f32x16 hacc = {};
    const int pt = w & 1, jt = w >> 1;
    const int q4 = (lane & 15) >> 2, odd = (lane >> 4) & 1, p4 = lane & 3;
    const int xtr = (8 * hi + q4) * 64 + (16 * odd + 4 * p4) * 2;
    const int xg = tid & 15, xr0 = (tid >> 4) * 4;
    const int fb = tid >> 8, fc = tid & 255;
    for (int i = tid; i < 5 * 64 + 5 * 256; i += NWAVES * 64) {
        if (i < 320) { const int t = i >> 6, e = i & 63; ((LAS float*)(lds + XW_OFF))[i] = t < 4 ? I.conv_w[t * CONVD + hd * 64 + e] : I.conv_b[hd * 64 + e]; }
        else { const int k = i - 320, t = k >> 8, e = k & 255, chn = 1024 + (e < 128 ? grp * 128 + e : 256 + grp * 128 + (e - 128)); ((LAS float*)(lds + FW_OFF))[k] = t < 4 ? I.conv_w[t * CONVD + chn] : I.conv_b[chn]; }
    }
    const int xoff = ((xg >> 3) << 10) + (xg & 7) * 8;
    float dtp0, dtp1; u32x2 xr[7]; v4u bcr[8]; float fxr[6]; u32x2 zr[4];
#define SSD_PREFETCH(T0) do { int t0_ = (T0), tv_ = tid, lv_ = lane; asm volatile("" : "+v"(t0_), "+v"(tv_), "+v"(lv_)); \
        const int xg_ = tv_ & 15, xr0_ = (tv_ >> 4) * 4, fb_ = tv_ >> 8, fc_ = tv_ & 255, fch_ = fc_ < 128 ? grp * 128 + fc_ : 256 + grp * 128 + (fc_ - 128); \
        { const float* dp_ = F.DT + (size_t)hd * MROWS + row0 + t0_ + 2 * lv_; dtp0 = dp_[0]; dtp1 = dp_[1]; } \
        { const bf16* xp_ = F.XBC + (row0 + t0_ + xr0_) * CONVD + hd * 64 + 4 * xg_; \
          _Pragma("unroll") for (int j = 0; j < 7; ++j) xr[j] = (t0_ + xr0_ - 3 + j) >= 0 ? *(const u32x2*)(xp_ + (j - 3) * CONVD) : (u32x2){0u, 0u}; } \
        { const bf16* bp_ = F.XBC + (row0 + t0_ + (tv_ >> 4)) * CONVD + 1024 + grp * 128 + 8 * (tv_ & 15); \
          _Pragma("unroll") for (int k = 0; k < 4; ++k) { bcr[k] = *(const v4u*)(bp_ + (size_t)k * 32 * CONVD); bcr[4 + k] = *(const v4u*)(bp_ + (size_t)k * 32 * CONVD + 256); } } \
        { const size_t blk = (row0 + t0_ + 64 * fb_) >> 6; const bool hasprev = (t0_ + 64 * fb_) > 0; const float* rp_ = F.RAWB + (blk * 6) * 512 + fch_; \
          _Pragma("unroll") for (int j = 0; j < 3; ++j) { fxr[j] = hasprev ? rp_[(j - 6) * 512] : 0.f; fxr[3 + j] = rp_[(3 + j) * 512]; } } \
    } while (0)
#define SSD_PREFETCH_Z(T0) do { int t0_ = (T0), lv_ = lane; asm volatile("" : "+v"(t0_), "+v"(lv_)); \
        const bf16* zp_ = F.Zb + (row0 + t0_ + 32 * jt + (lv_ & 31)) * DM + hd * 64 + 32 * pt + 4 * (lv_ >> 5); \
        _Pragma("unroll") for (int g4 = 0; g4 < 4; ++g4) zr[g4] = *(const u32x2*)(zp_ + 8 * g4); } while (0)
    SSD_PREFETCH(0); SSD_PREFETCH_Z(0);
    __syncthreads();
#pragma unroll 1
    for (int ch = 0; ch < SEQ / 128; ++ch) {
        const int t0 = ch * 128;
        float aend;
        {
            if (w == 0 && ch > 0) { F.SSQ[(row0 + t0 - 128 + lane) * 16 + hd] = ssql[lane]; F.SSQ[(row0 + t0 - 64 + lane) * 16 + hd] = ssql[64 + lane]; }
            const float v0 = dtp0 * A, v1 = dtp1 * A; float s = v0 + v1;
#pragma unroll
            for (int o = 1; o < 64; o <<= 1) { const float t = __shfl_up(s, o); if (lane >= o) s += t; }
            aend = __shfl(s, 63);
            *(LAS f32x2v*)(acs + 2 * lane) = (f32x2v){s - v1, s}; *(LAS f32x2v*)(dtl + 2 * lane) = (f32x2v){dtp0, dtp1};
            if (w == 0) { ssql[lane] = 0.f; ssql[64 + lane] = 0.f; }
        }
#pragma unroll
        for (int k = 0; k < 4; ++k) { const int idx = tid + 512 * k, row = idx >> 4;
            if ((row & 63) >= 3) { *(LAS v4u*)(lds + BT_OFF + row * PITCH + 16 * (idx & 15)) = bcr[k]; *(LAS v4u*)(lds + CT_OFF + row * PITCH + 16 * (idx & 15)) = bcr[4 + k]; } }
        {
            LAS unsigned char* dst = lds + (fc < 128 ? BT_OFF + 2 * fc : CT_OFF + 2 * (fc - 128)) + 64 * fb * PITCH;
            const LAS float* fwp = (const LAS float*)(lds + FW_OFF) + fc;
            const float fw0 = fwp[0], fw1 = fwp[256], fw2 = fwp[512], fw3 = fwp[768], fbias = fwp[1024];
#pragma unroll
            for (int j = 0; j < 3; ++j) *(LAS bf16*)(dst + j * PITCH) = (bf16)f2bf(silu_fast(fbias + fw0 * fxr[j] + fw1 * fxr[j + 1] + fw2 * fxr[j + 2] + fw3 * fxr[j + 3]));
        }
        {
            const LAS f32x4* xwp = (const LAS f32x4*)(lds + XW_OFF) + xg;
            const f32x4 xw0 = xwp[0], xw1 = xwp[16], xw2 = xwp[32], xw3 = xwp[48], xb = xwp[64];
            float xv[7][4];
#pragma unroll
            for (int j = 0; j < 7; ++j) { xv[j][0] = bflo(xr[j].x); xv[j][1] = bfhi(xr[j].x); xv[j][2] = bflo(xr[j].y); xv[j][3] = bfhi(xr[j].y); }
#pragma unroll
            for (int i = 0; i < 4; ++i) {
                const int s = xr0 + i; const float dt = dtl[s], de = dt * __expf(aend - acs[s]); float v[4];
#pragma unroll
                for (int e = 0; e < 4; ++e) v[e] = silu_fast(xb[e] + xw0[e] * xv[i][e] + xw1[e] * xv[i + 1][e] + xw2[e] * xv[i + 2][e] + xw3[e] * xv[i + 3][e]);
                const int off = ((s >> 4) << 11) + xoff + (s & 15) * 64;
                *(LAS u32x2*)(lds + XD_OFF + off) = (u32x2){pk2(v[0] * dt, v[1] * dt), pk2(v[2] * dt, v[3] * dt)};
                *(LAS u32x2*)(lds + XH_OFF + off) = (u32x2){pk2(v[0] * de, v[1] * de), pk2(v[2] * de, v[3] * de)};
            }
        }
        asm volatile("" ::: "memory"); __builtin_amdgcn_sched_barrier(0);
        if (ch + 1 < SEQ / 128) SSD_PREFETCH(t0 + 128);
        __syncthreads();
        {
            const int j = w & 3; const float al = acs[32 * j + c];
#pragma unroll
            for (int ii = 0; ii < 2; ++ii) {
                const int i = 2 * (w >> 2) + ii;
                if (i <= j) {
                    f32x16 x = {};
                    const LAS unsigned char* ap = lds + BT_OFF + (32 * i + c) * PITCH + 16 * hi;
                    const LAS unsigned char* bp = lds + CT_OFF + (32 * j + c) * PITCH + 16 * hi;
#pragma unroll 4
                    for (int ks = 0; ks < 8; ++ks) x = __builtin_amdgcn_mfma_f32_32x32x16_bf16(*(const LAS bf16x8*)(ap + 32 * ks), *(const LAS bf16x8*)(bp + 32 * ks), x, 0, 0, 0);
                    const int l = 32 * j + c;
#pragma unroll
                    for (int g4 = 0; g4 < 4; ++g4) {
                        const int sb = 32 * i + 8 * g4 + 4 * hi; float gv[4];
                        const f32x4 as4 = *(const LAS f32x4*)(acs + sb);
#pragma unroll
                        for (int e = 0; e < 4; ++e) { const int s = sb + e; gv[e] = s <= l ? x[4 * g4 + e] * __builtin_amdgcn_exp2f((al - as4[e]) * LOG2E) : 0.f; }
                        *(LAS u32x2*)(lds + G_OFF + l * PITCH + sb * 2) = (u32x2){pk2(gv[0], gv[1]), pk2(gv[2], gv[3])};
                    }
                }
            }
        }
        f32x16 yt = {};
        {
            const LAS unsigned char* ap = lds + HB_OFF + (32 * pt + c) * PITCH + 16 * hi;
            const LAS unsigned char* bp = lds + CT_OFF + (32 * jt + c) * PITCH + 16 * hi;
#pragma unroll 4
            for (int ks = 0; ks < 8; ++ks) yt = __builtin_amdgcn_mfma_f32_32x32x16_bf16(*(const LAS bf16x8*)(ap + 32 * ks), *(const LAS bf16x8*)(bp + 32 * ks), yt, 0, 0, 0);
            const float el = __expf(acs[32 * jt + c]);
#pragma unroll
            for (int r = 0; r < 16; ++r) yt[r] *= el;
        }
        __syncthreads();
        {
            const LAS unsigned char* bp = lds + G_OFF + (32 * jt + c) * PITCH + 16 * hi;
            for (int ks = 0; ks < 2 * jt + 2; ++ks) {
                const LAS unsigned char* xp = lds + XD_OFF + ((ks * 2 + pt) << 10) + xtr;
                yt = __builtin_amdgcn_mfma_f32_32x32x16_bf16(trfrag(xp, xp + 256), *(const LAS bf16x8*)(bp + 32 * ks), yt, 0, 0, 0);
            }
        }
        {
            const float ea = __expf(aend);
#pragma unroll
            for (int r = 0; r < 16; ++r) hacc[r] *= ea;
            const int btr = (8 * hi + q4) * PITCH + (32 * jt + 16 * odd + 4 * p4) * 2;
#pragma unroll 4
            for (int ks = 0; ks < 8; ++ks) {
                const LAS unsigned char* xp = lds + XH_OFF + ((ks * 2 + pt) << 10) + xtr;
                const LAS unsigned char* bp = lds + BT_OFF + 16 * ks * PITCH + btr;
                hacc = __builtin_amdgcn_mfma_f32_32x32x16_bf16(trfrag(xp, xp + 256), trfrag(bp, bp + 4 * PITCH), hacc, 0, 0, 0);
            }
        }
        {
            const int l = 32 * jt + c; const float rdt = dsk * __builtin_amdgcn_rcpf(dtl[l]);
            bf16* up = F.AU + (row0 + t0 + l) * 2048 + hd * 64 + 32 * pt;
            float sq = 0.f;
#pragma unroll
            for (int g4 = 0; g4 < 4; ++g4) {
                const int pl = 8 * g4 + 4 * hi;
                const u32x2 xw2 = *(const LAS u32x2*)(lds + XD_OFF + (((l >> 4) * 2 + pt) << 10) + (l & 15) * 64 + pl * 2);
                const u32x2 zw = zr[g4];
                const float u0 = (yt[4 * g4] + rdt * bflo(xw2.x)) * bflo(zw.x), u1 = (yt[4 * g4 + 1] + rdt * bfhi(xw2.x)) * bfhi(zw.x), u2 = (yt[4 * g4 + 2] + rdt * bflo(xw2.y)) * bflo(zw.y), u3 = (yt[4 * g4 + 3] + rdt * bfhi(xw2.y)) * bfhi(zw.y);
                sq += (u0 * u0 + u1 * u1) + (u2 * u2 + u3 * u3);
                *(u32x2*)(up + pl) = (u32x2){pk2(u0, u1), pk2(u2, u3)};
            }
            sq += __shfl_xor(sq, 32);
            if (hi == 0) __hip_atomic_fetch_add(ssql + l, sq, __ATOMIC_RELAXED, __HIP_MEMORY_SCOPE_WORKGROUP);
            if (ch + 1 < SEQ / 128) SSD_PREFETCH_Z(t0 + 128);
        }
        __syncthreads();
#pragma unroll
        for (int r = 0; r < 16; ++r) *(LAS bf16*)(lds + HB_OFF + (32 * pt + crow(r, hi)) * PITCH + (32 * jt + c) * 2) = (bf16)f2bf(hacc[r]);
    }
#undef SSD_PREFETCH
#undef SSD_PREFETCH_Z
    if (w == 0) { const int t0 = SEQ; F.SSQ[(row0 + t0 - 128 + lane) * 16 + hd] = ssql[lane]; F.SSQ[(row0 + t0 - 64 + lane) * 16 + hd] = ssql[64 + lane]; }
    float* ho = F.out + O_HP + (((size_t)b * NH + hd) * HD + 32 * pt) * DS + 32 * jt + c;
#pragma unroll
    for (int r = 0; r < 16; ++r) ho[(size_t)crow(r, hi) * DS] = hacc[r];
    __syncthreads();
}
}

namespace smp {
__device__ __forceinline__ void attn_unit(Frame& F, int bhs) {
    const Ins& I = F.I;
    const int lane = F.lane, w = F.wave, b = bhs >> 4, h = bhs & 15, r = NTOK + b;
    LAS float* qs = (LAS float*)(F.lds + 4096); LAS float* acc = (LAS float*)F.lds;
    LAS float* ps = (LAS float*)(F.lds + 8192) + w * 64;
    if (F.tid < 64) qs[F.tid] = bf2f(F.Q[(size_t)r * DM + h * HD + F.tid]);
    if (F.tid < 65) acc[F.tid] = 0.f;
    __syncthreads();
    const int k0 = 49 * w, nk = (387 - k0) < 49 ? (387 - k0) : 49;
    float p = 0.f;
    if (lane < nk) {
        const int idx = k0 + lane, pat = idx / 129, j = idx - pat * 129, d = pat == 0 ? 1 : (pat == 1 ? 4 : 16);
        float s = 0.f;
        if (j > 0) { const f32x4* kp = (const f32x4*)(I.ck + (((size_t)b * WIN + (WIN - j * d)) * NH + h) * HD);
#pragma unroll
            for (int e = 0; e < 16; ++e) { const f32x4 kv = kp[e]; const f32x4 qv = *(const LAS f32x4*)(qs + 4 * e); s += (qv[0] * kv[0] + qv[1] * kv[1]) + (qv[2] * kv[2] + qv[3] * kv[3]); } }
        else { const bf16* kp = F.K + (size_t)r * DM + h * HD; for (int e = 0; e < 64; ++e) s += qs[e] * bf2f(kp[e]); }
        p = __builtin_amdgcn_exp2f(s + I.rel_bias[t5_bucket(j * d) * NH + h] * LOG2E);
    }
    ps[lane] = p;
    const float lsum = wave_sum(p);
    __builtin_amdgcn_wave_barrier();
    float o0 = 0.f, o1 = 0.f, o2 = 0.f, o3 = 0.f;
    const float vnew = bf2f(F.V[(size_t)r * DM + h * HD + lane]);
    const float* vbase = I.cv + ((size_t)b * WIN * NH + h) * HD + lane;
#define SMP_V(K) ({ const int idx_ = k0 + (K), pat_ = idx_ / 129, j_ = idx_ - pat_ * 129, d_ = pat_ == 0 ? 1 : (pat_ == 1 ? 4 : 16); \
                    (K) < nk ? ps[(K)] * (j_ > 0 ? vbase[(size_t)(WIN - j_ * d_) * (NH * HD)] : vnew) : 0.f; })
#pragma unroll
    for (int k = 0; k < 48; k += 4) { o0 += SMP_V(k); o1 += SMP_V(k + 1); o2 += SMP_V(k + 2); o3 += SMP_V(k + 3); }
    o0 += SMP_V(48);
#undef SMP_V
    __hip_atomic_fetch_add(acc + lane, (o0 + o1) + (o2 + o3), __ATOMIC_RELAXED, __HIP_MEMORY_SCOPE_WORKGROUP);
    if (lane == 0) __hip_atomic_fetch_add(acc + 64, lsum, __ATOMIC_RELAXED, __HIP_MEMORY_SCOPE_WORKGROUP);
    __syncthreads();
    if (F.tid < 64) F.AU[(size_t)r * 2048 + 1024 + h * HD + F.tid] = (bf16)f2bf(acc[F.tid] * __builtin_amdgcn_rcpf(acc[64]) * bf2f(F.Gb[(size_t)r * DM + h * HD + F.tid]));
    __syncthreads();
}

__device__ __forceinline__ void ssd_unit(Frame& F, int bhs) {
    const Ins& I = F.I;
    LAS float* xs_l = (LAS float*)F.lds; LAS float* B_l = xs_l + 64; LAS float* C_l = B_l + 128; LAS float* ssq_l = C_l + 128;
    const int tid = F.tid, p = tid >> 3, ng = tid & 7;
    const int b = bhs >> 4, hd = bhs & 15, grp = hd >> 3; const size_t r = (size_t)NTOK + b;
    float h[16];
    { const f32x4* hp = (const f32x4*)(I.sssm + (((size_t)b * NH + hd) * HD + p) * DS + ng * 16);
#pragma unroll
      for (int i = 0; i < 4; ++i) { const f32x4 v = hp[i]; h[4 * i] = v[0]; h[4 * i + 1] = v[1]; h[4 * i + 2] = v[2]; h[4 * i + 3] = v[3]; } }
    if (tid < 320) {
        const int ci = tid, c = ci < 64 ? hd * 64 + ci : (ci < 192 ? 1024 + grp * 128 + (ci - 64) : 1280 + grp * 128 + (ci - 192));
        float v = I.conv_b[c];
#pragma unroll
        for (int i = 0; i < 3; ++i) v += I.sconv[((size_t)b * 3 + i) * CONVD + c] * I.conv_w[i * CONVD + c];
        v += bf2f(F.XBC[r * CONVD + c]) * I.conv_w[3 * CONVD + c];
        xs_l[ci] = silu_f(v);
    }
    if (tid == 0) ssq_l[0] = 0.f;
    __syncthreads();
    const float dt = F.DT[(size_t)hd * MROWS + r], A = -__expf(I.a_log[hd]), x = xs_l[p], dec = __expf(dt * A), xdt = x * dt;
    float y = 0.f;
#pragma unroll
    for (int i = 0; i < 16; ++i) { h[i] = h[i] * dec + xdt * B_l[ng * 16 + i]; y += h[i] * C_l[ng * 16 + i]; }
    y += __shfl_xor(y, 1); y += __shfl_xor(y, 2); y += __shfl_xor(y, 4);
    if (ng == 0) {
        const float u = (y + I.d_skip[hd] * x) * bf2f(F.Zb[r * DM + hd * 64 + p]);
        F.AU[r * 2048 + hd * 64 + p] = (bf16)f2bf(u);
        __hip_atomic_fetch_add(ssq_l, u * u, __ATOMIC_RELAXED, __HIP_MEMORY_SCOPE_WORKGROUP);
    }
    { f32x4* ho = (f32x4*)(F.out + O_HS + (((size_t)b * NH + hd) * HD + p) * DS + ng * 16);
#pragma unroll
      for (int i = 0; i < 4; ++i) ho[i] = (f32x4){h[4 * i], h[4 * i + 1], h[4 * i + 2], h[4 * i + 3]}; }
    __syncthreads();
    if (tid == 0) F.SSQ[r * 16 + hd] = ssq_l[0];
    __syncthreads();
}
}

namespace smp {
typedef float f32x16s __attribute__((ext_vector_type(16)));
__device__ __forceinline__ void mm64x32(Frame& F, const bf16* WT, int wrow0  , const bf16* A, int apitch, int K) {
    const int lane = F.lane, w = F.wave, c = lane & 31, hi = lane >> 5, half = w & 1, kq = w >> 1, kseg = K / 4;
    const bf16* ap = WT + (size_t)(wrow0 + 128 * half + c) * K + kq * kseg + 8 * hi;
    const bf16* bp = A + (size_t)c * apitch + kq * kseg + 8 * hi;
    f32x16s acc = {};
#pragma unroll 8
    for (int ks = 0; ks < kseg / 16; ++ks) acc = __builtin_amdgcn_mfma_f32_32x32x16_bf16(*(const bf16x8*)(ap + 16 * ks), *(const bf16x8*)(bp + 16 * ks), acc, 0, 0, 0);
    LAS float* red = (LAS float*)F.lds + (kq * 64 + 32 * half) * 32;
#pragma unroll
    for (int r = 0; r < 16; ++r) red[((r & 3) + 8 * (r >> 2) + 4 * hi) * 32 + c] = acc[r];
    __syncthreads();
}
__device__ __forceinline__ void inproj_unit(Frame& F, int ht) {
    const Ins& I = F.I;
    const int a0 = 64 * ht;
    mm64x32(F, F.WinT, (a0 & ~255) + vrow_of_col(a0 & 255), F.XN + (size_t)NTOK * DM, DM, DM);
    const LAS float* red = (const LAS float*)F.lds;
    const int lane = F.lane, w = F.wave;
#pragma unroll 1
    for (int rr = 0; rr < 4; ++rr) {
        const int r = 4 * w + rr;
        const float v = (red[(0 * 64 + lane) * 32 + r] + red[(1 * 64 + lane) * 32 + r]) + (red[(2 * 64 + lane) * 32 + r] + red[(3 * 64 + lane) * 32 + r]);
        const size_t row = (size_t)NTOK + r; const int col = a0 + lane;
        if (col < C_V) {
            const float sc = rsqrtf(wave_sum(v * v) * (1.f / 64.f) + EPS);
            if (col < C_K) F.Q[row * DM + col] = (bf16)f2bf(v * sc * I.qnw[lane] * QSCALE);
            else { const float kv = v * sc * I.knw[lane]; F.K[row * DM + col - C_K] = (bf16)f2bf(kv); F.out[O_KS + (size_t)r * DM + col - C_K] = kv; }
        } else if (col < C_G) { F.V[row * DM + col - C_V] = (bf16)f2bf(v); F.out[O_VS + (size_t)r * DM + col - C_V] = v; }
        else if (col < C_Z) F.Gb[row * DM + col - C_G] = (bf16)f2bf(silu_fast(v));
        else if (col < C_XBC) F.Zb[row * DM + col - C_Z] = (bf16)f2bf(silu_fast(v));
        else { F.XBC[row * CONVD + col - C_XBC] = (bf16)f2bf(v); F.out[O_CS + ((size_t)r * 3 + 2) * CONVD + col - C_XBC] = v; }
    }
    __syncthreads();
}
__device__ __forceinline__ void outproj_unit(Frame& F, int ct) {
    const Ins& I = F.I;
    const int a0 = 64 * ct;
    mm64x32(F, F.WoutT, (a0 & ~255) + vrow_of_col(a0 & 255), F.AU + (size_t)NTOK * 2048, 2048, 2048);
    const LAS float* red = (const LAS float*)F.lds;
    const int lane = F.lane, w = F.wave;
#pragma unroll 1
    for (int rr = 0; rr < 4; ++rr) {
        const int r = 4 * w + rr;
        float s = lane < 16 ? F.SSQ[((size_t)NTOK + r) * 16 + lane] : 0.f;
        s = wave_sum(s);
        const float rs = rsqrtf(s * (1.f / 1024.f) + EPS);
        const float v = (red[(0 * 64 + lane) * 32 + r] + red[(1 * 64 + lane) * 32 + r]) * rs + (red[(2 * 64 + lane) * 32 + r] + red[(3 * 64 + lane) * 32 + r]);
        F.out[O_YS + (size_t)r * DM + a0 + lane] = I.xs[(size_t)r * DM + a0 + lane] + v;
    }
    __syncthreads();
}
}

__device__ __forceinline__ void phase2_queue(Frame& F, int qset) {
    const unsigned x = xb_xcc_id() & 7u;
    constexpr int PER_Q = att::NUNITS / 8;
    for (unsigned k = 0; k < 8; ++k) {
        const unsigned qx = (x + k) & 7u;
        for (;;) {
            if (F.tid == 0) F.MISC[16] = __hip_atomic_fetch_add(F.ctl + CW_Q + 64 * (8 * qset + qx), 1u, RLX_AGENT);
            __syncthreads();
            const unsigned idx = F.MISC[16];
            __syncthreads();
            if (idx >= (unsigned)(PER_Q + 128)) break;
            if (idx < 64u) smp::attn_unit(F, (int)(qx * 64 + idx));
            else if (idx < 128u) smp::ssd_unit(F, (int)(qx * 64 + idx - 64));
            else att::unit(F, (int)(qx * PER_Q + idx - 128));
        }
    }
}

constexpr int PROBE_REP_SSD = 1, PROBE_REP_ATT = 1;
struct Args { Ins in; float* out; unsigned char* ws; int ph_lo, ph_hi; };
__global__ void __launch_bounds__(NWAVES * 64, 2) mk_fwd(Args args) {
    extern __shared__ __attribute__((aligned(16))) unsigned char lds[];
    Frame F;
    F.lds = (LAS unsigned char*)lds;
    F.MISC = (volatile LAS unsigned*)(F.lds + MISC_OFF);
    F.tid = threadIdx.x; F.lane = F.tid & 63; F.wave = __builtin_amdgcn_readfirstlane(F.tid >> 6);
    F.G = gridDim.x; { const int bx = blockIdx.x; F.vcu = (F.G % 8 == 0) ? (bx % 8) * (F.G / 8) + bx / 8 : bx; }
    unsigned char* ws = args.ws;
    F.ctl = (gu32*)(ws + WS_CTL); F.I = args.in; F.out = args.out;
    F.WinT = (bf16*)(ws + WS_WIN); F.WoutT = (bf16*)(ws + WS_WOUT); F.XN = (bf16*)(ws + WS_XN); F.Q = (bf16*)(ws + WS_Q); F.K = (bf16*)(ws + WS_K); F.V = (bf16*)(ws + WS_V);
    F.AU = (bf16*)(ws + WS_AU); F.XBC = (bf16*)(ws + WS_XBC); F.DT = (float*)(ws + WS_DT); F.SSQ = (float*)(ws + WS_SSQ); F.RAWB = (float*)(ws + WS_RAWB); F.Gb = (bf16*)(ws + WS_G); F.Zb = (bf16*)(ws + WS_Z);
    for (int u = F.tid; u < (LDS_BYTES - LDSCTL_OFF) / 4; u += NWAVES * 64) ((LAS unsigned*)(F.lds + LDSCTL_OFF))[u] = 0u;
    __syncthreads();
    XcdBarrier bar = xcd_barrier_post((unsigned*)(F.ctl + CW_BAR), F.MISC + 8);
    const int lo = args.ph_lo, hi = args.ph_hi;
#define IN(k) (lo <= (k) && (k) < hi)
#define BOTH(k) (IN(k) && IN((k) + 1))
    if (IN(0)) { p0_prologue(F); if (BOTH(0)) xcd_barrier(bar); }
    if (IN(1)) {
        __syncthreads();
        pg8::Gemm g{F.XN, F.WinT, NTOK, NMAIN, DM}; pg8::StaticOrder S; S.init(NTOK, NMAIN, F.G, (int)blockIdx.x);
        pg8::EpiIn E{F.Q, F.K, F.V, F.Gb, F.Zb, F.XBC, F.out, F.I.qnw, F.I.knw, F.I.conv_w, F.I.conv_b, F.RAWB};
        pg8::gemm_phase<pg8::EpiIn, pg8::StaticOrder, true, true>(F.lds + RING_OFF, g, S, E);
        __syncthreads();
        for (int ht = F.vcu; ht < NMAIN / 64; ht += F.G) smp::inproj_unit(F, ht);
        if (BOTH(1)) xcd_barrier(bar);
    }
    if (IN(2)) { __syncthreads(); if ((F.vcu & 31) < 8 && (F.vcu >> 5) < 8) { PB_BEGIN(9) ssd::chain(F, (F.vcu >> 5) * 8 + (F.vcu & 31)); PB_END(9) } for (int rep = 0; rep < PROBE_REP_ATT; ++rep) phase2_queue(F, rep);     if (BOTH(2)) xcd_barrier(bar); }
    if (IN(3)) {
        __syncthreads();
        pg8::Gemm g{F.AU, F.WoutT, NTOK, DM, 2048}; pg8::StaticOrder S; S.init(NTOK, DM, F.G, (int)blockIdx.x);
        LAS float* rs = (LAS float*)(F.lds + RING_BYTES);
        { pg8::Unit u;
          for (int ui = 0; ui < 4 && S.next(ui, u); ++ui)
              for (int r = F.tid; r < 256; r += NWAVES * 64) {
                  const f32x4* sp = (const f32x4*)(F.SSQ + (size_t)(u.pm * 256 + r) * 16);
                  const f32x4 s0 = sp[0], s1 = sp[1], s2 = sp[2], s3 = sp[3];
                  const float s = ((s0[0] + s0[1]) + (s0[2] + s0[3])) + ((s1[0] + s1[1]) + (s1[2] + s1[3])) + ((s2[0] + s2[1]) + (s2[2] + s2[3])) + ((s3[0] + s3[1]) + (s3[2] + s3[3]));
                  rs[ui * 256 + r] = rsqrtf(s * (1.f / 1024.f) + EPS);
              }
          __syncthreads(); }
        pg8::EpiOut E{F.I.xp, F.I.xs, rs, F.out};
        pg8::gemm_phase<pg8::EpiOut, pg8::StaticOrder, true, true>(F.lds + RING_OFF, g, S, E);
        __syncthreads();
        for (int ct = F.G - 1 - F.vcu; ct >= 0 && ct < DM / 64; ct += F.G) smp::outproj_unit(F, ct);
    }
#undef IN
#undef BOTH
}

extern "C" void kernel_launch(void* const* d_in, const int* in_sizes, int n_in, void* d_out, int out_size, void* d_ws, size_t ws_size, hipStream_t stream) {
    static int grid = 0;
    if (grid == 0) {
        if (n_in != 18 || out_size != (int)O_END || ws_size < WS_END) { fprintf(stderr, "kernel_launch: unexpected n_in %d / out_size %d / ws_size %zu; nothing launched\n", n_in, out_size, ws_size); grid = -1; return; }
        int dev = 0, cus = 0;
        if (hipGetDevice(&dev) != hipSuccess || hipDeviceGetAttribute(&cus, hipDeviceAttributeMultiprocessorCount, dev) != hipSuccess) { grid = -1; return; }
        if (hipFuncSetAttribute((const void*)mk_fwd, hipFuncAttributeMaxDynamicSharedMemorySize, LDS_BYTES) != hipSuccess) { fprintf(stderr, "kernel_launch: hipFuncSetAttribute failed\n"); grid = -1; return; }
        (void)hipGetLastError();
        grid = cus;
    }
    if (grid < 0) return;
    (void)hipMemsetAsync((char*)d_ws + WS_CTL, 0, CTL_ZERO_BYTES, stream);
    Args a{};
    const float** ip = (const float**)&a.in;
    for (int i = 0; i < 18; ++i) ip[i] = (const float*)d_in[i];
    a.out = (float*)d_out; a.ws = (unsigned char*)d_ws;
    a.ph_lo = 0; a.ph_hi = 4;
    hipLaunchKernelGGL(mk_fwd, dim3(grid), dim3(NWAVES * 64), LDS_BYTES, stream, a);
}
```

```cpp
#include <hip/hip_runtime.h>
#include <cstdio>
#include <cstdint>

constexpr int DM = 1024, NB = 4, SEQ = 8192, DB = 32, WIN = 2048;
constexpr int NPROJ = 6672, NMAIN = 6656, NTOK = NB * SEQ, NROWS = NTOK + DB;
constexpr int MROWS = 33024;
constexpr int C_Q = 0, C_K = 1024, C_V = 2048, C_G = 3072, C_Z = 4096, C_XBC = 5120, C_DT = 6656;
constexpr int CONVD = 1536, NH = 16, HD = 64, DS = 128;
constexpr float EPS = 1e-6f;
constexpr float QSCALE = 0.125f * 1.4426950408889634f;
constexpr float LOG2E = 1.4426950408889634f;
constexpr size_t O_YP = 0, O_YS = O_YP + (size_t)NTOK * DM, O_KP = O_YS + (size_t)DB * DM, O_VP = O_KP + (size_t)NB * WIN * DM,
                 O_CP = O_VP + (size_t)NB * WIN * DM, O_HP = O_CP + (size_t)NB * 3 * CONVD, O_KS = O_HP + (size_t)NB * NH * HD * DS,
                 O_VS = O_KS + (size_t)DB * DM, O_CS = O_VS + (size_t)DB * DM, O_HS = O_CS + (size_t)DB * 3 * CONVD,
                 O_END = O_HS + (size_t)DB * NH * HD * DS;
static_assert(O_END == 55314432, "output size");

constexpr size_t MiB = 1u << 20;
constexpr size_t WS_CTL = 0, CTL_ZERO_BYTES = 1 * MiB;
constexpr size_t WS_WIN = 2 * MiB;
constexpr size_t WS_WOUT = 16 * MiB;
constexpr size_t WS_DT = 20 * MiB;
constexpr size_t WS_SSQ = 24 * MiB;
constexpr size_t WS_XN = 32 * MiB;
constexpr size_t WS_Q = 100 * MiB;
constexpr size_t WS_K = 168 * MiB;
constexpr size_t WS_V = 236 * MiB;
constexpr size_t WS_AU = 304 * MiB;
constexpr size_t WS_XBC = 436 * MiB;
constexpr size_t WS_RAWB = 536 * MiB;
constexpr size_t WS_G = 544 * MiB;
constexpr size_t WS_Z = 612 * MiB;
constexpr size_t WS_END = 680 * MiB;
static_assert(WS_XN + (size_t)MROWS * DM * 2 <= WS_Q && WS_Q + (size_t)MROWS * DM * 2 <= WS_K && WS_K + (size_t)MROWS * DM * 2 <= WS_V && WS_V + (size_t)MROWS * DM * 2 <= WS_AU &&
              WS_AU + (size_t)MROWS * 2048 * 2 <= WS_XBC && WS_XBC + (size_t)MROWS * CONVD * 2 <= WS_RAWB && WS_RAWB + (size_t)(MROWS / 64) * 6 * 512 * 4 <= WS_G && WS_G + (size_t)MROWS * DM * 2 <= WS_Z && WS_Z + (size_t)MROWS * DM * 2 <= WS_END && WS_WIN + (size_t)NMAIN * DM * 2 <= WS_WOUT && WS_WOUT + (size_t)DM * 2048 * 2 <= WS_DT &&
              WS_DT + (size_t)MROWS * 16 * 4 <= WS_SSQ && WS_SSQ + (size_t)MROWS * 32 * 4 <= WS_XN, "d_ws map");

struct Ins {
    const float *xp, *xs, *ck, *cv, *sconv, *sssm, *norm_w, *w_in, *qnw, *knw, *rel_bias, *conv_w, *conv_b, *dt_bias, *a_log, *d_skip, *ssd_norm_w, *w_out;
};

typedef unsigned short bf16;
__device__ __forceinline__ float wave_sum(float v) {
#pragma unroll
    for (int o = 1; o < 64; o <<= 1) v += __shfl_xor(v, o);
    return v;
}
__device__ __forceinline__ float wave_max(float v) {
#pragma unroll
    for (int o = 1; o < 64; o <<= 1) v = fmaxf(v, __shfl_xor(v, o));
    return v;
}
__device__ __forceinline__ float silu_f(float x) { return x / (1.f + __expf(-x)); }
__device__ __forceinline__ float silu_fast(float x) { return x * __builtin_amdgcn_rcpf(1.f + __builtin_amdgcn_exp2f(-LOG2E * x)); }
__device__ __forceinline__ float softplus_f(float x) { return x > 20.f ? x : log1pf(__expf(x)); }
__device__ __forceinline__ int t5_bucket(int d) {
    if (d < 16) return d;
    int b = 16;
    b += d >= 22; b += d >= 30; b += d >= 40; b += d >= 54; b += d >= 73; b += d >= 99; b += d >= 134; b += d >= 182;
    b += d >= 246; b += d >= 332; b += d >= 450; b += d >= 609; b += d >= 825; b += d >= 1117; b += d >= 1513;
    return b;
}
__device__ __forceinline__ const float* xrow(const Ins& I, int r) { return r < NTOK ? I.xp + (size_t)r * DM : I.xs + (size_t)(r - NTOK) * DM; }
__device__ __forceinline__ float bf2f(bf16 v) { return __uint_as_float((unsigned)v << 16); }
__device__ __forceinline__ unsigned f2bf(float f) { unsigned u = __float_as_uint(f); return (u + 0x7fffu + ((u >> 16) & 1u)) >> 16; }
__device__ __forceinline__ unsigned pk2(float lo, float hi) { return f2bf(lo) | (f2bf(hi) << 16); }
__host__ __device__ __forceinline__ int vrow_of_col(int a) { return 128 * ((a >> 5) & 1) + 32 * ((a >> 6) & 3) + (a & 31); }

namespace pg8 {
#define PG8_LAS __attribute__((address_space(3)))
typedef unsigned short bf16_t;
typedef short bf16x8 __attribute__((ext_vector_type(8)));
typedef float f32x4 __attribute__((ext_vector_type(4)));
typedef unsigned u32x4 __attribute__((ext_vector_type(4)));
constexpr int BM = 256, BK = 64, HALF = 128, HTB = HALF * BK * 2  , STAGE_BYTES = 8 * HTB, NXCD = 8, WGM = 8;

__host__ __device__ __forceinline__ int lds_byte(int r, int c) { const int st = (r >> 4) * 2 + (c >> 5), rr = r & 15, cc = c & 31, ob = rr * 64 + cc * 2; return st * 1024 + (ob ^ (((ob >> 9) & 1) << 5)); }
__host__ __device__ __forceinline__ void stage_rc(int b, int& R, int& C) { const int st = b / 1024, sb = b % 1024, swz = sb ^ (((sb >> 9) & 1) << 5); R = (st >> 1) * 16 + swz / 64; C = (st & 1) * 32 + (swz % 64) / 2; }
__host__ __device__ __forceinline__ int perm32(int rho) { const int n = rho >> 4, i = rho & 15; return 8 * (i >> 2) + 4 * n + (i & 3); }

struct Unit { int pm, pn; };
struct Gemm { const bf16_t* A; const bf16_t* Bt; int M, N, K; };

struct StaticOrder {
    int nM, nN, nwg, G, c;
    __host__ __device__ void init(int M, int N, int G_, int c_) { nM = M / BM; nN = N / BM; nwg = nM * nN; G = G_; c = c_; }
    __host__ __device__ bool next(int i, Unit& u) const {
        const long L = (long)i * G + c; if (L >= nwg) return false;
        int wgid = (int)L; { const int q = nwg / NXCD, r = nwg % NXCD, xcd = wgid % NXCD, off = wgid / NXCD; wgid = (xcd < r ? xcd * (q + 1) : r * (q + 1) + (xcd - r) * q) + off; }
        const int nig = WGM * nN, gid = wgid / nig, fm = gid * WGM, gsz = (nM - fm) < WGM ? (nM - fm) : WGM;
        u.pm = fm + ((wgid % nig) % gsz); u.pn = (wgid % nig) / gsz; return true;
    }
    __device__ __forceinline__ void a_ready(const Unit&) const {}
    __device__ __forceinline__ void done(const Unit&) const {}
};

__device__ __forceinline__ unsigned cvt_pk_bf16(float lo, float hi) { unsigned r; asm volatile("v_cvt_pk_bf16_f32 %0, %1, %2" : "=v"(r) : "v"(lo), "v"(hi)); return r; }

template <int K> __device__ __forceinline__ float rowprev(float cur, float prevm) {
    const int t = __builtin_amdgcn_update_dpp(0, __builtin_bit_cast(int, prevm), 0x100 + (16 - K), 0xf, 0xf, true);
    return __builtin_bit_cast(float, __builtin_amdgcn_update_dpp(t, __builtin_bit_cast(int, cur), 0x110 + K, 0xf, 0xf, false));
}

struct EpiIn {
    static constexpr bool PERM = true, AFTER_DRAIN = false, MIDK = false;
    bf16_t *Q, *K, *V, *Gb, *Zb, *XBC; float* out; const float *qnw, *knw, *conv_w, *conv_b; float* rawb;
    __device__ __forceinline__ void mid(f32x4 (&)[2][2][4][2], const Unit&, int, int, int, int, int) const {}
    __device__ __forceinline__ void operator()(const f32x4 (&acc)[2][2][4][2], const Unit& u, int wr, int wc, int fr, int fq) const {
        const int pn = u.pn;
        const int rowb = u.pm * BM + wr * 64 + fr;
        const int cl = wc * 64 + 8 * fq;
        if (pn < 8) {
            const bool isq = pn < 4; const float* nw = isq ? qnw : knw;
            f32x4 w[2][2];
#pragma unroll
            for (int bj = 0; bj < 2; ++bj)
#pragma unroll
                for (int n = 0; n < 2; ++n) w[bj][n] = *(const f32x4*)(nw + 8 * fq + 32 * bj + 4 * n);
            bf16_t* dstb = (isq ? Q : K) + (pn & 3) * 256 + cl;
#pragma unroll
            for (int ai = 0; ai < 2; ++ai)
#pragma unroll
                for (int m = 0; m < 4; ++m) {
                    const int r = rowb + ai * HALF + m * 16;
                    float ss = 0.f;
#pragma unroll
                    for (int bj = 0; bj < 2; ++bj)
#pragma unroll
                        for (int n = 0; n < 2; ++n) { const f32x4 v = acc[ai][bj][m][n]; ss += (v[0] * v[0] + v[1] * v[1]) + (v[2] * v[2] + v[3] * v[3]); }
                    ss += __shfl_xor(ss, 16); ss += __shfl_xor(ss, 32);
                    const float sc = rsqrtf(ss * (1.f / 64.f) + EPS), scs = isq ? sc * QSCALE : sc;
                    float* f32dst = nullptr;
                    if (!isq) { if (r < NTOK) { const int t = r & (SEQ - 1); if (t >= SEQ - WIN) f32dst = out + O_KP + ((size_t)((r >> 13) * WIN + t - (SEQ - WIN))) * DM + (pn & 3) * 256 + cl; }
                                else if (r < NROWS) f32dst = out + O_KS + (size_t)(r - NTOK) * DM + (pn & 3) * 256 + cl; }
#pragma unroll
                    for (int bj = 0; bj < 2; ++bj) {
                        const f32x4 a0 = acc[ai][bj][m][0] * w[bj][0], a1 = acc[ai][bj][m][1] * w[bj][1];
                        u32x4 o; o.x = cvt_pk_bf16(a0[0] * scs, a0[1] * scs); o.y = cvt_pk_bf16(a0[2] * scs, a0[3] * scs); o.z = cvt_pk_bf16(a1[0] * scs, a1[1] * scs); o.w = cvt_pk_bf16(a1[2] * scs, a1[3] * scs);
                        *(u32x4*)(dstb + (size_t)r * DM + 32 * bj) = o;
                        if (f32dst) { *(f32x4*)(f32dst + 32 * bj) = a0 * sc; *(f32x4*)(f32dst + 32 * bj + 4) = a1 * sc; }
                    }
                }
        } else if (pn < 12) {
            bf16_t* dstb = V + (pn & 3) * 256 + cl;
#pragma unroll
            for (int ai = 0; ai < 2; ++ai)
#pragma unroll
                for (int m = 0; m < 4; ++m) {
                    const int r = rowb + ai * HALF + m * 16;
                    float* f32dst = nullptr;
                    if (r < NTOK) { const int t = r & (SEQ - 1); if (t >= SEQ - WIN) f32dst = out + O_VP + ((size_t)((r >> 13) * WIN + t - (SEQ - WIN))) * DM + (pn & 3) * 256 + cl; }
                    else if (r < NROWS) f32dst = out + O_VS + (size_t)(r - NTOK) * DM + (pn & 3) * 256 + cl;
#pragma unroll
                    for (int bj = 0; bj < 2; ++bj) {
                        const f32x4 a0 = acc[ai][bj][m][0], a1 = acc[ai][bj][m][1];
                        u32x4 o; o.x = cvt_pk_bf16(a0[0], a0[1]); o.y = cvt_pk_bf16(a0[2], a0[3]); o.z = cvt_pk_bf16(a1[0], a1[1]); o.w = cvt_pk_bf16(a1[2], a1[3]);
                        *(u32x4*)(dstb + (size_t)r * DM + 32 * bj) = o;
                        if (f32dst) { *(f32x4*)(f32dst + 32 * bj) = a0; *(f32x4*)(f32dst + 32 * bj + 4) = a1; }
                    }
                }
        } else if (pn < 20) {
            bf16_t* dstb = (pn < 16 ? Gb : Zb) + (pn & 3) * 256 + cl;
#pragma unroll
            for (int ai = 0; ai < 2; ++ai)
#pragma unroll
                for (int m = 0; m < 4; ++m) {
                    const int r = rowb + ai * HALF + m * 16;
#pragma unroll
                    for (int bj = 0; bj < 2; ++bj) {
                        f32x4 a0 = acc[ai][bj][m][0], a1 = acc[ai][bj][m][1];
#pragma unroll
                        for (int i = 0; i < 4; ++i) { a0[i] = silu_fast(a0[i]); a1[i] = silu_fast(a1[i]); }
                        u32x4 o; o.x = cvt_pk_bf16(a0[0], a0[1]); o.y = cvt_pk_bf16(a0[2], a0[3]); o.z = cvt_pk_bf16(a1[0], a1[1]); o.w = cvt_pk_bf16(a1[2], a1[3]);
                        *(u32x4*)(dstb + (size_t)r * DM + 32 * bj) = o;
                    }
                }
        } else {
            const int cb = (pn - 20) * 256 + cl;
            bf16_t* dstb = XBC + cb;
            const bool do_conv = pn >= 24 && u.pm < NTOK / BM;
#pragma unroll
            for (int ai = 0; ai < 2; ++ai)
#pragma unroll
                for (int m = 0; m < 4; ++m) {
                    const int r = rowb + ai * HALF + m * 16;
                    float* f32dst = nullptr;
                    if (r < NTOK) { const int t = r & (SEQ - 1); if (t >= SEQ - 3) f32dst = out + O_CP + ((size_t)((r >> 13) * 3 + t - (SEQ - 3))) * CONVD + cb; }
                    else if (r < NROWS) f32dst = out + O_CS + ((size_t)(r - NTOK) * 3 + 2) * CONVD + cb;
                    if (do_conv && (m == 0 || m == 3)) {
                        const int slot = m == 0 ? 3 + fr : fr - 13;
                        if (slot >= 0 && slot < 6) f32dst = rawb + ((size_t)(u.pm * 4 + ai * 2 + wr) * 6 + slot) * 512 + (cb - 1024);
                    }
#pragma unroll
                    for (int bj = 0; bj < 2; ++bj) {
                        const f32x4 a0 = acc[ai][bj][m][0], a1 = acc[ai][bj][m][1];
                        if (!do_conv) { u32x4 o; o.x = cvt_pk_bf16(a0[0], a0[1]); o.y = cvt_pk_bf16(a0[2], a0[3]); o.z = cvt_pk_bf16(a1[0], a1[1]); o.w = cvt_pk_bf16(a1[2], a1[3]);
                                        *(u32x4*)(dstb + (size_t)r * CONVD + 32 * bj) = o; }
                        if (f32dst) { *(f32x4*)(f32dst + 32 * bj) = a0; *(f32x4*)(f32dst + 32 * bj + 4) = a1; }
                    }
                }
            if (do_conv) {
                if ((u.pm & 31) == 31 && wr == 1 && fr >= 13) {
#pragma unroll
                    for (int bj = 0; bj < 2; ++bj) { float* d = out + O_CP + ((size_t)((u.pm >> 5) * 3 + fr - 13)) * CONVD + cb + 32 * bj; *(f32x4*)d = acc[1][bj][3][0]; *(f32x4*)(d + 4) = acc[1][bj][3][1]; }
                }
#pragma unroll
                for (int bj = 0; bj < 2; ++bj) {
                    f32x4 w[4][2], bb[2];
#pragma unroll
                    for (int n = 0; n < 2; ++n) { bb[n] = *(const f32x4*)(conv_b + cb + 32 * bj + 4 * n);
#pragma unroll
                        for (int t = 0; t < 4; ++t) w[t][n] = *(const f32x4*)(conv_w + t * CONVD + cb + 32 * bj + 4 * n); }
#pragma unroll
                    for (int ai = 0; ai < 2; ++ai) {
                        f32x4 pm[2] = {(f32x4){0.f, 0.f, 0.f, 0.f}, (f32x4){0.f, 0.f, 0.f, 0.f}};
#pragma unroll
                        for (int m = 0; m < 4; ++m) {
                            const int r = rowb + ai * HALF + m * 16;
                            unsigned ow[4];
#pragma unroll
                            for (int n = 0; n < 2; ++n) {
                                const f32x4 cur = acc[ai][bj][m][n]; f32x4 v;
#pragma unroll
                                for (int i = 0; i < 4; ++i) {
                                    const float p1 = rowprev<1>(cur[i], pm[n][i]), p2 = rowprev<2>(cur[i], pm[n][i]), p3 = rowprev<3>(cur[i], pm[n][i]);
                                    v[i] = silu_fast(bb[n][i] + w[0][n][i] * p3 + w[1][n][i] * p2 + w[2][n][i] * p1 + w[3][n][i] * cur[i]);
                                }
                                ow[2 * n] = cvt_pk_bf16(v[0], v[1]); ow[2 * n + 1] = cvt_pk_bf16(v[2], v[3]);
                                pm[n] = cur;
                            }
                            *(u32x4*)(dstb + (size_t)r * CONVD + 32 * bj) = (u32x4){ow[0], ow[1], ow[2], ow[3]};
                        }
                    }
                }
            }
        }
    }
};

struct EpiOut {
    static constexpr bool PERM = true, AFTER_DRAIN = false, MIDK = true;
    const float* xp; const float* xs; const PG8_LAS float* rs; float* out;
    __device__ __forceinline__ void mid(f32x4 (&acc)[2][2][4][2], const Unit& u, int ui, int wr, int wc, int fr, int fq) const {
        const PG8_LAS float* rp = rs + ui * 256 + wr * 64 + fr;
#pragma unroll
        for (int ai = 0; ai < 2; ++ai)
#pragma unroll
            for (int m = 0; m < 4; ++m) {
                const float r = rp[ai * HALF + m * 16];
#pragma unroll
                for (int bj = 0; bj < 2; ++bj)
#pragma unroll
                    for (int n = 0; n < 2; ++n) acc[ai][bj][m][n] *= r;
            }
    }
    __device__ __forceinline__ void operator()(const f32x4 (&acc)[2][2][4][2], const Unit& u, int wr, int wc, int fr, int fq) const {
        const int rowb = u.pm * BM + wr * 64 + fr, col = u.pn * BM + wc * 64 + 8 * fq;
#pragma unroll
        for (int ai = 0; ai < 2; ++ai)
#pragma unroll
            for (int m = 0; m < 4; ++m) {
                const int r = rowb + ai * HALF + m * 16;
                if (r >= NROWS) continue;
                const float* xr = (r < NTOK ? xp + (size_t)r * DM : xs + (size_t)(r - NTOK) * DM) + col;
                float* yr = out + (r < NTOK ? O_YP + (size_t)r * DM : O_YS + (size_t)(r - NTOK) * DM) + col;
#pragma unroll
                for (int bj = 0; bj < 2; ++bj) {
                    *(f32x4*)(yr + 32 * bj) = *(const f32x4*)(xr + 32 * bj) + acc[ai][bj][m][0];
                    *(f32x4*)(yr + 32 * bj + 4) = *(const f32x4*)(xr + 32 * bj + 4) + acc[ai][bj][m][1];
                }
            }
    }
};

template <class Epi, class Sched, bool ALIGN_EPI = false, bool SP2 = false>
__device__ __forceinline__ void gemm_phase(PG8_LAS unsigned char* lds, const Gemm g, const Sched& S, const Epi& E) {
    const int tid = threadIdx.x, wid = __builtin_amdgcn_readfirstlane(tid >> 6), lane = tid & 63, wr = wid >> 2, wc = wid & 3, fr = lane & 15, fq = lane >> 4;
    const int K = g.K, nt = K / BK;
    unsigned voffA[2], voffB[2];
#pragma unroll
    for (int i = 0; i < 2; ++i) { int R, C; stage_rc(tid * 16 + i * 8192, R, C); const int Rb = Epi::PERM ? ((R & ~31) + perm32(R & 31)) : R;
        voffA[i] = (unsigned)(R * K + C) * 2u; voffB[i] = (unsigned)(Rb * K + C) * 2u; }
    const size_t kstep = (size_t)(BK * 2);
    const size_t hstep = (size_t)HALF * K * 2;
    const size_t tstep = 2 * hstep;
    const unsigned ldsw = (unsigned)wid * 1024u;
    const int aoff = lds_byte(wr * 64 + fr, fq * 8), boff = lds_byte(wc * 32 + fr, fq * 8);
#define PG8_SA(b, h) (((b) * 2 + (h)) * HTB)
#define PG8_SB(b, h) ((4 + (b) * 2 + (h)) * HTB)
#define PG8_STAGE(bufoff, gbase, voff) do { _Pragma("unroll") for (int _i = 0; _i < 2; ++_i) \
        __builtin_amdgcn_global_load_lds((const unsigned*)((const char*)(gbase) + (voff)[_i]), (PG8_LAS unsigned*)(lds + (bufoff) + ldsw + _i * 8192), 16, 0, 0); } while (0)
#define PG8_LDA(dst, b, h) do { _Pragma("unroll") for (int m = 0; m < 4; ++m) _Pragma("unroll") for (int k = 0; k < 2; ++k) dst[m][k] = *(const PG8_LAS bf16x8*)(lds + PG8_SA(b, h) + aoff + m * 2048 + k * 1024); } while (0)
#define PG8_LDB(dst, b, h) do { _Pragma("unroll") for (int n = 0; n < 2; ++n) _Pragma("unroll") for (int k = 0; k < 2; ++k) dst[n][k] = *(const PG8_LAS bf16x8*)(lds + PG8_SB(b, h) + boff + n * 2048 + k * 1024); } while (0)
#define PG8_MMA(ai, bj, At, Bt) do { __builtin_amdgcn_s_setprio(1); _Pragma("unroll") for (int m = 0; m < 4; ++m) _Pragma("unroll") for (int n = 0; n < 2; ++n) _Pragma("unroll") for (int k = 0; k < 2; ++k) \
        acc[ai][bj][m][n] = __builtin_amdgcn_mfma_f32_16x16x32_bf16(Bt[n][k], At[m][k], acc[ai][bj][m][n], 0, 0, 0); __builtin_amdgcn_s_setprio(0); } while (0)
#define PG8_WAIT_V(n) asm volatile("s_waitcnt vmcnt(" #n ")" ::: "memory")
#define PG8_WAIT_L(n) asm volatile("s_waitcnt lgkmcnt(" #n ")" ::: "memory")
#define PG8_BAR __builtin_amdgcn_s_barrier()
#define PG8_SCHED __builtin_amdgcn_sched_barrier(0)
    Unit cur, nxt; int ui = 0;
    if (!S.next(0, cur)) return;
    f32x4 acc[2][2][4][2];
#pragma unroll
    for (int a = 0; a < 2; ++a)
#pragma unroll
        for (int b = 0; b < 2; ++b)
#pragma unroll
            for (int m = 0; m < 4; ++m)
#pragma unroll
                for (int n = 0; n < 2; ++n) acc[a][b][m][n] = (f32x4){0.f, 0.f, 0.f, 0.f};
    bf16x8 At[4][2], B0[2][2], B1[2][2];
    const char* cA = (const char*)g.A + (size_t)cur.pm * tstep; const char* cB = (const char*)g.Bt + (size_t)cur.pn * tstep;
    S.a_ready(cur);
    if constexpr (SP2) {
        PG8_STAGE(PG8_SB(0, 0), cB, voffB); PG8_STAGE(PG8_SB(0, 1), cB + hstep, voffB); PG8_STAGE(PG8_SA(0, 0), cA, voffA); PG8_STAGE(PG8_SA(0, 1), cA + hstep, voffA);
        if (wr == 1) PG8_BAR;
        PG8_WAIT_V(2); PG8_BAR;
        PG8_STAGE(PG8_SB(1, 0), cB + kstep, voffB); PG8_STAGE(PG8_SA(1, 0), cA + kstep, voffA); PG8_STAGE(PG8_SB(1, 1), cB + hstep + kstep, voffB);
        PG8_WAIT_V(6); PG8_BAR;
    } else {
        PG8_STAGE(PG8_SB(0, 0), cB, voffB); PG8_STAGE(PG8_SA(0, 0), cA, voffA); PG8_STAGE(PG8_SB(0, 1), cB + hstep, voffB); PG8_STAGE(PG8_SA(0, 1), cA + hstep, voffA);
        if (wr == 1) PG8_BAR;
        PG8_WAIT_V(4); PG8_BAR;
        PG8_STAGE(PG8_SB(1, 0), cB + kstep, voffB); PG8_STAGE(PG8_SA(1, 0), cA + kstep, voffA); PG8_STAGE(PG8_SB(1, 1), cB + hstep + kstep, voffB);
        PG8_WAIT_V(6); PG8_BAR;
    }
    for (;;) {
        const bool has_next = S.next(ui + 1, nxt);
        const char* nA = has_next ? (const char*)g.A + (size_t)nxt.pm * tstep : cA; const char* nB = has_next ? (const char*)g.Bt + (size_t)nxt.pn * tstep : cB;
        for (int t = 0; t < nt; t += 2) {
            const bool last = (t == nt - 2);
            if constexpr (Epi::MIDK) { if (t == (nt >> 1)) E.mid(acc, cur, ui, wr, wc, fr, fq); }
            const char* a1 = cA + (size_t)(t + 1) * kstep;
            const char* a2 = last ? nA : cA + (size_t)(t + 2) * kstep; const char* b2 = last ? nB : cB + (size_t)(t + 2) * kstep;
            const char* a3 = a2 + kstep; const char* b3 = b2 + kstep;
            if (last && has_next) S.a_ready(nxt);
            if constexpr (SP2) {
            PG8_LDB(B0, 0, 0); PG8_LDB(B1, 0, 1); PG8_SCHED; PG8_LDA(At, 0, 0); PG8_STAGE(PG8_SA(1, 1), a1 + hstep, voffA);
            PG8_WAIT_V(8); PG8_WAIT_L(0); PG8_BAR; PG8_MMA(0, 0, At, B0); PG8_MMA(0, 1, At, B1); PG8_BAR; PG8_SCHED;
            PG8_LDA(At, 0, 1); PG8_STAGE(PG8_SB(0, 0), b2, voffB); PG8_STAGE(PG8_SB(0, 1), b2 + hstep, voffB); PG8_STAGE(PG8_SA(0, 0), a2, voffA);
            PG8_WAIT_V(8); PG8_WAIT_L(0); PG8_BAR; PG8_MMA(1, 0, At, B0); PG8_MMA(1, 1, At, B1); PG8_BAR; PG8_SCHED;
            PG8_LDB(B0, 1, 0); PG8_LDB(B1, 1, 1); PG8_SCHED; PG8_LDA(At, 1, 0); PG8_STAGE(PG8_SA(0, 1), a2 + hstep, voffA);
            PG8_WAIT_V(8); PG8_WAIT_L(0); PG8_BAR; PG8_MMA(0, 0, At, B0); PG8_MMA(0, 1, At, B1); PG8_BAR; PG8_SCHED;
            PG8_LDA(At, 1, 1); PG8_STAGE(PG8_SB(1, 0), b3, voffB); PG8_STAGE(PG8_SB(1, 1), b3 + hstep, voffB); PG8_STAGE(PG8_SA(1, 0), a3, voffA);
            PG8_WAIT_V(8); PG8_WAIT_L(0); PG8_BAR; PG8_MMA(1, 0, At, B0); PG8_MMA(1, 1, At, B1); PG8_BAR; PG8_SCHED;
            } else {
            PG8_LDB(B0, 0, 0); PG8_SCHED; PG8_LDA(At, 0, 0); PG8_STAGE(PG8_SA(1, 1), a1 + hstep, voffA);
            PG8_WAIT_L(8); PG8_BAR; PG8_WAIT_L(0); PG8_MMA(0, 0, At, B0); PG8_BAR; PG8_SCHED;
            PG8_LDB(B1, 0, 1); PG8_STAGE(PG8_SB(0, 0), b2, voffB);
            PG8_BAR; PG8_WAIT_L(0); PG8_MMA(0, 1, At, B1); PG8_BAR;
            PG8_LDA(At, 0, 1); PG8_STAGE(PG8_SA(0, 0), a2, voffA);
            PG8_BAR; PG8_WAIT_L(0); PG8_MMA(1, 0, At, B0); PG8_BAR; PG8_SCHED;
            PG8_STAGE(PG8_SB(0, 1), b2 + hstep, voffB);
            PG8_WAIT_V(6); PG8_BAR; PG8_MMA(1, 1, At, B1); PG8_BAR;
            PG8_LDB(B0, 1, 0); PG8_SCHED; PG8_LDA(At, 1, 0); PG8_STAGE(PG8_SA(0, 1), a2 + hstep, voffA);
            PG8_WAIT_L(8); PG8_BAR; PG8_WAIT_L(0); PG8_MMA(0, 0, At, B0); PG8_BAR; PG8_SCHED;
            PG8_LDB(B1, 1, 1); PG8_STAGE(PG8_SB(1, 0), b3, voffB);
            PG8_BAR; PG8_WAIT_L(0); PG8_MMA(0, 1, At, B1); PG8_BAR;
            PG8_LDA(At, 1, 1); PG8_STAGE(PG8_SA(1, 0), a3, voffA);
            PG8_BAR; PG8_WAIT_L(0); PG8_MMA(1, 0, At, B0); PG8_BAR; PG8_SCHED;
            PG8_STAGE(PG8_SB(1, 1), b3 + hstep, voffB);
            PG8_WAIT_V(6); PG8_BAR; PG8_MMA(1, 1, At, B1); PG8_BAR;
            }
        }
        if constexpr (ALIGN_EPI) { if (wr == 0) PG8_BAR; }
        if constexpr (!Epi::AFTER_DRAIN) { E(acc, cur, wr, wc, fr, fq); S.done(cur); }
        if (!has_next) break;
#pragma unroll
        for (int a = 0; a < 2; ++a)
#pragma unroll
            for (int b = 0; b < 2; ++b)
#pragma unroll
                for (int m = 0; m < 4; ++m)
#pragma unroll
                    for (int n = 0; n < 2; ++n) acc[a][b][m][n] = (f32x4){0.f, 0.f, 0.f, 0.f};
        cur = nxt; cA = nA; cB = nB; ++ui;
        if constexpr (ALIGN_EPI) { if (wr == 1) PG8_BAR; }
    }
    PG8_WAIT_V(0);
    if constexpr (!ALIGN_EPI) { if (wr == 0) PG8_BAR; }
    PG8_BAR;
    if constexpr (Epi::AFTER_DRAIN) { E.fused(acc, cur, wr, wc, fr, fq, lds, wid, lane); S.done(cur); }
#undef PG8_SA
#undef PG8_SB
#undef PG8_STAGE
#undef PG8_LDA
#undef PG8_LDB
#undef PG8_MMA
#undef PG8_WAIT_V
#undef PG8_WAIT_L
#undef PG8_BAR
#undef PG8_SCHED
}
}
#define GAS __attribute__((address_space(1)))
#define LAS __attribute__((address_space(3)))
typedef unsigned v4u __attribute__((ext_vector_type(4)));
typedef float f32x4 __attribute__((ext_vector_type(4)));
typedef short bf16x8 __attribute__((ext_vector_type(8)));
typedef GAS unsigned gu32;
typedef GAS unsigned long long gu64;
#define RLX_AGENT __ATOMIC_RELAXED, __HIP_MEMORY_SCOPE_AGENT
#define LDS_WAIT() asm volatile("s_waitcnt lgkmcnt(0)" ::: "memory")
#define VM_WAIT() asm volatile("s_waitcnt vmcnt(0)" ::: "memory")
__device__ __forceinline__ unsigned long long rt() { return __builtin_amdgcn_s_memrealtime(); }

#define XB_TMO      128
#define XB_XCNT(j)  (256  + 64 * (j))
#define XB_XSUB(j)  (1280 + 64 * (j))
#define XB_XGEN(j)  (2304 + 64 * (j))
#define XB_TOP      3328
#define XB_TOPGEN   3392
#define XCD_BAR_WORDS 3456
#define XB_SPIN_CAP (1u << 18)

__device__ __forceinline__ unsigned xb_ld(unsigned* p)              { return __hip_atomic_load(p, __ATOMIC_RELAXED, __HIP_MEMORY_SCOPE_AGENT); }
__device__ __forceinline__ unsigned xb_add(unsigned* p, unsigned v) { return __hip_atomic_fetch_add(p, v, __ATOMIC_RELAXED, __HIP_MEMORY_SCOPE_AGENT); }
__device__ __forceinline__ unsigned xb_xcc_id() { return (unsigned)__builtin_amdgcn_s_getreg((3 << 11) | 20) & 0xFu; }
#define XB_SPIN(cond, bar) do { unsigned _sp = 0; while (cond) { __builtin_amdgcn_s_sleep(1); \
    if ((++_sp & 255u) == 0u) { if (xb_ld(&(bar)[XB_TMO])) break; if (_sp > XB_SPIN_CAP) { atomicAdd(&(bar)[XB_TMO], 1u); break; } } } } while (0)

struct XcdBarrier {
    unsigned* bar; unsigned x;
    volatile LAS unsigned* st;
};

__device__ __forceinline__ XcdBarrier xcd_barrier_post(unsigned* bar, volatile LAS unsigned* st) {
    XcdBarrier b; b.bar = bar; b.x = xb_xcc_id(); b.st = st;
    if (threadIdx.x == 0) (void)xb_add(&bar[XB_XCNT(b.x)], 1u);
    return b;
}
__device__ __forceinline__ void xcd_barrier_complete(unsigned* bar, unsigned x, unsigned& nloc, unsigned& nx) {
    const unsigned G = gridDim.x * gridDim.y * gridDim.z;
    unsigned sum, cnt, mine, sp = 0u;
    for (;;) {
        sum = 0u; cnt = 0u; mine = 0u;
#pragma unroll
        for (unsigned j = 0; j < 16; ++j) { const unsigned c = xb_ld(&bar[XB_XCNT(j)]); sum += c; cnt += (c > 0u) ? 1u : 0u; mine = (j == x) ? c : mine; }
        if (sum == G) break;
        __builtin_amdgcn_s_sleep(1);
        if ((++sp & 255u) == 0u) { if (xb_ld(&bar[XB_TMO])) break; if (sp > XB_SPIN_CAP) { atomicAdd(&bar[XB_TMO], 1u); break; } }
    }
    nloc = mine > 0u ? mine : 1u; nx = cnt > 0u ? cnt : 1u;
}

__device__ __forceinline__ void xcd_barrier(const XcdBarrier& b) {
    asm volatile("s_waitcnt vmcnt(0)" ::: "memory");
    __syncthreads();
    if (threadIdx.x == 0) {
        unsigned* bar = b.bar;
        __builtin_amdgcn_s_waitcnt(0);
        unsigned nloc = b.st[0], nx = b.st[1];
        if (nloc == 0u) { xcd_barrier_complete(bar, b.x, nloc, nx); b.st[0] = nloc; b.st[1] = nx; }
        const unsigned old = xb_add(&bar[XB_XSUB(b.x)], 1u);
        const unsigned gen = old / nloc;
        if (old + 1u == (gen + 1u) * nloc) {
            __builtin_amdgcn_fence(__ATOMIC_RELEASE, "agent");
            asm volatile("s_waitcnt vmcnt(0)" ::: "memory");
            const unsigned og = xb_add(&bar[XB_TOP], 1u);
            const unsigned tg = og / nx;
            if (og + 1u == (tg + 1u) * nx) xb_add(&bar[XB_TOPGEN], 1u);
            else XB_SPIN(xb_ld(&bar[XB_TOPGEN]) == tg, bar);
            __builtin_amdgcn_fence(__ATOMIC_ACQUIRE, "agent");
            xb_add(&bar[XB_XGEN(b.x)], 1u);
            asm volatile("s_waitcnt vmcnt(0)" ::: "memory");
        } else {
            XB_SPIN(xb_ld(&bar[XB_XGEN(b.x)]) == gen, bar);
            __builtin_amdgcn_fence(__ATOMIC_ACQUIRE, "agent");
            asm volatile("s_waitcnt vmcnt(0)" ::: "memory");
        }
    }
    __syncthreads();
}

constexpr int NWAVES = 8;
constexpr int RING_OFF = 0, RING_BYTES = 131072;
constexpr int LDS_BYTES = 163840;
constexpr int LDSCTL_OFF = LDS_BYTES - 512, MISC_OFF = LDSCTL_OFF + 320;
constexpr int CW_BAR = 4096;
constexpr int CW_Q = 16384;
static_assert((CW_BAR + XCD_BAR_WORDS) <= CW_Q && (CW_Q + 64 * 64) * 4 <= (int)CTL_ZERO_BYTES, "CTL words inside the memset region");

constexpr int PROBE_ID = 0;
#define PB_BEGIN(id) long long pb_t0_##id = 0; if (PROBE_ID == (id)) pb_t0_##id = clock64();
#define PB_END(id) if (PROBE_ID == (id)) { const long long t1_ = clock64(), dt_ = t1_ - pb_t0_##id; while (clock64() - t1_ < dt_) __builtin_amdgcn_s_sleep(2); }
struct Frame {
    LAS unsigned char* lds;
    volatile LAS unsigned* MISC;
    gu32* ctl;
    int tid, lane, wave, vcu, G;
    Ins I; float* out;
    bf16 *WinT, *WoutT, *XN, *Q, *K, *V, *AU, *XBC, *Gb, *Zb; float *DT, *SSQ, *RAWB;
};

template <class SrcF>
__device__ __forceinline__ void p0_transpose_item(SrcF src, int k0, int n0, bf16* WT, int dst_pitch, int dst_row0, int dst_k0, LAS float* scr, int lane) {
#pragma unroll 8
    for (int i = 0; i < 32; ++i) { const int kk = 2 * i + (lane >> 5); scr[kk * 33 + (lane & 31)] = src(k0 + kk, n0 + (lane & 31)); }
    LDS_WAIT(); asm volatile("" ::: "memory");
    const int c = lane & 7;
#pragma unroll
    for (int j = 0; j < 4; ++j) { const int n = (lane >> 3) + 8 * j; const LAS float* s = scr + (8 * c) * 33 + n;
        v4u o; o.x = pk2(s[0 * 33], s[1 * 33]); o.y = pk2(s[2 * 33], s[3 * 33]); o.z = pk2(s[4 * 33], s[5 * 33]); o.w = pk2(s[6 * 33], s[7 * 33]);
        *(GAS v4u*)(WT + (size_t)(dst_row0 + n) * dst_pitch + dst_k0 + 8 * c) = o; }
    LDS_WAIT(); asm volatile("" ::: "memory");
}
constexpr int P0_SCR_BYTES = 8448, WDT_OFF = NWAVES * P0_SCR_BYTES, WDT_PITCH = 20;
static_assert(WDT_OFF + 1024 * WDT_PITCH * 4 <= LDSCTL_OFF, "prologue LDS");

__device__ __forceinline__ void p0_prologue(Frame& F) {
    const Ins& I = F.I;
    LAS float* scr = (LAS float*)(F.lds + F.wave * P0_SCR_BYTES);
    LAS float* wdt = (LAS float*)(F.lds + WDT_OFF);
    const int gw = F.vcu * NWAVES + F.wave, NGW = F.G * NWAVES;
    for (int idx = F.tid; idx < 1024 * 16; idx += NWAVES * 64) {
        const int k = idx >> 4, j = idx & 15, pos = (((k >> 8) * 4 + (k & 3)) << 6) + ((k >> 2) & 63);
        wdt[pos * WDT_PITCH + j] = I.w_in[(size_t)k * NPROJ + C_DT + j] * I.norm_w[k];
    }
    constexpr int I_IN = (DM / 64) * (NMAIN / 32), I_OUT = (2048 / 64) * (DM / 32);
    for (int it = gw; it < I_IN + I_OUT; it += NGW) {
        if (it < I_IN) {
            const int nblk = NMAIN / 32, kb = it / nblk, nb = it % nblk, k0 = 64 * kb, n0 = 32 * nb;
            p0_transpose_item([&](int k, int n) { return I.w_in[(size_t)k * NPROJ + n] * I.norm_w[k]; }, k0, n0, F.WinT, DM, (n0 & ~255) + vrow_of_col(n0 & 255), k0, scr, F.lane);
        } else {
            const int r = it - I_IN, nblk = DM / 32, kb = r / nblk, nb = r % nblk, k0 = 64 * kb, n0 = 32 * nb;
            p0_transpose_item([&](int k, int n) { return I.w_out[(size_t)k * DM + n] * (k >= 1024 ? I.ssd_norm_w[k - 1024] : 1.f); }, k0, n0, F.WoutT, 2048, (n0 & ~255) + vrow_of_col(n0 & 255), (k0 + 1024) & 2047, scr, F.lane);
        }
    }
    __syncthreads();
    for (int rp = gw; rp < NROWS / 2; rp += NGW) {
        f32x4 v[2][4]; float rstd[2];
#pragma unroll
        for (int q = 0; q < 2; ++q) {
            const GAS f32x4* xr = (const GAS f32x4*)xrow(I, 2 * rp + q) + F.lane; float s = 0.f;
#pragma unroll
            for (int j = 0; j < 4; ++j) { v[q][j] = xr[64 * j]; s += (v[q][j].x * v[q][j].x + v[q][j].y * v[q][j].y) + (v[q][j].z * v[q][j].z + v[q][j].w * v[q][j].w); }
            rstd[q] = rsqrtf(wave_sum(s) * (1.f / DM) + EPS);
            GAS unsigned long long* o8 = (GAS unsigned long long*)(F.XN + (size_t)(2 * rp + q) * DM) + F.lane;
#pragma unroll
            for (int j = 0; j < 4; ++j) o8[64 * j] = (unsigned long long)pk2(v[q][j].x * rstd[q], v[q][j].y * rstd[q]) | ((unsigned long long)pk2(v[q][j].z * rstd[q], v[q][j].w * rstd[q]) << 32);
        }
        float a[32];
#pragma unroll
        for (int i = 0; i < 32; ++i) a[i] = 0.f;
#pragma unroll
        for (int j = 0; j < 4; ++j)
#pragma unroll
            for (int e = 0; e < 4; ++e) {
                const LAS f32x4* wp = (const LAS f32x4*)(wdt + ((j * 4 + e) * 64 + F.lane) * WDT_PITCH);
                const float x0 = v[0][j][e], x1 = v[1][j][e];
#pragma unroll
                for (int c4 = 0; c4 < 4; ++c4) { const f32x4 w = wp[c4];
#pragma unroll
                    for (int i = 0; i < 4; ++i) { a[c4 * 4 + i] += x0 * w[i]; a[16 + c4 * 4 + i] += x1 * w[i]; } }
                asm volatile("" ::: "memory");
            }
#define P0_HALVE(N, X) { const bool up = (F.lane & (X)) != 0; _Pragma("unroll") for (int i = 0; i < (N); ++i) { const float keep = up ? a[i + (N)] : a[i], send = up ? a[i] : a[i + (N)]; a[i] = keep + __shfl_xor(send, (X)); } }
        P0_HALVE(16, 32) P0_HALVE(8, 16) P0_HALVE(4, 8) P0_HALVE(2, 4) P0_HALVE(1, 2)
#undef P0_HALVE
        float tot = a[0] + __shfl_xor(a[0], 1);
        const int idx = F.lane >> 1, q = idx >> 4, c = idx & 15;
        tot = tot * (q ? rstd[1] : rstd[0]) + I.dt_bias[c];
        if ((F.lane & 1) == 0) F.DT[(size_t)c * MROWS + 2 * rp + q] = softplus_f(tot);
    }
    for (int r = NROWS + gw; r < MROWS; r += NGW) { GAS v4u* o = (GAS v4u*)(F.XN + (size_t)r * DM) + F.lane; o[0] = (v4u){0u, 0u, 0u, 0u}; o[64] = (v4u){0u, 0u, 0u, 0u}; }
    for (int i = (F.vcu * NWAVES * 64 + F.tid); i < DB * 2 * CONVD; i += F.G * NWAVES * 64) {
        const int c = i % CONVD, rr = i / CONVD, j = rr & 1, b = rr >> 1;
        F.out[O_CS + ((size_t)b * 3 + j) * CONVD + c] = I.sconv[((size_t)b * 3 + j + 1) * CONVD + c];
    }
}

namespace att {
typedef float f32x16 __attribute__((ext_vector_type(16)));
typedef short v4i16_t __attribute__((ext_vector_type(4)));
typedef unsigned u32x4 __attribute__((ext_vector_type(4)));
constexpr int SPAN = 512, NSPAN = SEQ / SPAN, NUNITS = NB * NH * NSPAN;
constexpr int OPITCH = 64  , OACC_OFF = 0, LACC_OFF = SPAN * OPITCH * 4, LUT_OFF = LACC_OFF + 2048, VST_OFF = LUT_OFF + 2048, VST_BYTES = 2048  , ATT_LDS_END = VST_OFF + NWAVES * VST_BYTES;
static_assert(ATT_LDS_END <= LDSCTL_OFF, "attention LDS");
__device__ __forceinline__ int crow(int r, int hi) { return (r & 3) + 8 * (r >> 2) + 4 * hi; }

struct ItemRegs { bf16x8 qf[4]; v4u kreg[4], vreg[4]; };
struct ItemOut { f32x16 o0, o1; float lsum; };
#define ATT_LOAD_K(R, KT) do { int tk_ = tq0 + (-128 + 32 * (KT) + (lane & 31)) * d; tk_ = tk_ < 0 ? 0 : tk_; const bf16* kp_ = Kb + (size_t)tk_ * DM + 8 * (lane >> 5); \
        _Pragma("unroll") for (int i = 0; i < 4; ++i) (R).kreg[i] = *(const v4u*)(kp_ + 16 * i); } while (0)
#define ATT_LOAD_V(R, KT) do { _Pragma("unroll") for (int i = 0; i < 4; ++i) { int tk_ = tq0 + (-128 + 32 * (KT) + 8 * i + (lane >> 3)) * d; tk_ = tk_ < 0 ? 0 : tk_; \
        (R).vreg[i] = *(const v4u*)(Vb + (size_t)tk_ * DM + 8 * (lane & 7)); } } while (0)
template <int NQ>
__device__ __forceinline__ void item_load(ItemRegs& R, const bf16* Qb, const bf16* Kb, const bf16* Vb, int tq0, int d, int lane) {
    const int c = lane & 31, hi = lane >> 5;
    const bf16* qp = Qb + (size_t)(tq0 + (NQ == 32 ? c : (c & 15)) * d) * DM + 8 * hi;
#pragma unroll
    for (int ks = 0; ks < 4; ++ks) R.qf[ks] = *(const bf16x8*)(qp + 16 * ks);
    ATT_LOAD_K(R, 0); ATT_LOAD_V(R, 0);
}
template <int NQ>
__device__ __forceinline__ void item_tiles(ItemRegs& R, ItemOut& O, const bf16* Kb, const bf16* Vb, int tq0, int d, int pat, LAS unsigned char* lds, int wave, int lane) {
    const int c = lane & 31, hi = lane >> 5;
    LAS unsigned char* vst = lds + VST_OFF + wave * VST_BYTES;
    const LAS float* lut = (const LAS float*)(lds + LUT_OFF) + pat * 129;
    f32x16 o0 = {}, o1 = {};
    float lsum = 0.f;
    const int lrow = lane >> 3, lch = lane & 7;
    const int stoff = lrow * 128 + ((lch ^ lrow) << 4);
    const int q4 = (lane & 15) >> 2, odd = (lane >> 4) & 1, p4 = lane & 3;
#pragma unroll 1
    for (int kt = 0; kt < 5; ++kt) {
        v4u vhold[2] = {R.vreg[2], R.vreg[3]};
#pragma unroll
        for (int i = 0; i < 2; ++i) *(LAS v4u*)(vst + i * 1024 + stoff) = R.vreg[i];
        bf16x8 kf[4];
#pragma unroll
        for (int ks = 0; ks < 4; ++ks) kf[ks] = __builtin_bit_cast(bf16x8, R.kreg[ks]);
        asm volatile("" ::: "memory");
        if (kt < 4) { ATT_LOAD_K(R, kt + 1); ATT_LOAD_V(R, kt + 1); }
        f32x16 st = {};
#pragma unroll
        for (int ks = 0; ks < 4; ++ks) st = __builtin_amdgcn_mfma_f32_32x32x16_bf16(kf[ks], R.qf[ks], st, 0, 0, 0);
        const int relb = c + 128 - 32 * kt - 4 * hi, tkb = tq0 + (-128 + 32 * kt + 4 * hi) * d;
        if (kt == 0 || kt == 4 || tkb < 0) {
#pragma unroll
            for (int r = 0; r < 16; ++r) {
                const int kk = (r & 3) + 8 * (r >> 2), rel = relb - kk;
                const bool valid = (rel >= 0) && (rel <= 128) && (tkb + kk * d >= 0);
                const float bias = lut[rel < 0 ? 0 : (rel > 128 ? 128 : rel)];
                const float pe = __builtin_amdgcn_exp2f(st[r] + bias), p = valid ? pe : 0.f;
                st[r] = p; lsum += p;
            }
        } else {
#pragma unroll
            for (int r = 0; r < 16; ++r) { const float p = __builtin_amdgcn_exp2f(st[r] + lut[relb - ((r & 3) + 8 * (r >> 2))]); st[r] = p; lsum += p; }
        }
        u32x4 pw0, pw1;
        pw0.x = pg8::cvt_pk_bf16(st[0], st[1]); pw0.y = pg8::cvt_pk_bf16(st[2], st[3]); pw0.z = pg8::cvt_pk_bf16(st[4], st[5]); pw0.w = pg8::cvt_pk_bf16(st[6], st[7]);
        pw1.x = pg8::cvt_pk_bf16(st[8], st[9]); pw1.y = pg8::cvt_pk_bf16(st[10], st[11]); pw1.z = pg8::cvt_pk_bf16(st[12], st[13]); pw1.w = pg8::cvt_pk_bf16(st[14], st[15]);
        const bf16x8 pa0 = __builtin_bit_cast(bf16x8, pw0), pa1 = __builtin_bit_cast(bf16x8, pw1);
#pragma unroll
        for (int s = 0; s < 2; ++s) {
            if (s == 1) {
#pragma unroll
                for (int i = 0; i < 2; ++i) *(LAS v4u*)(vst + i * 1024 + stoff) = vhold[i];
            }
#pragma unroll
            for (int dh = 0; dh < 2; ++dh) {
                const int kr = 4 * hi + q4, ch16 = 4 * dh + 2 * odd + (p4 >> 1);
                const LAS unsigned char* vp0 = vst + kr * 128 + ((ch16 ^ (kr & 7)) << 4) + (p4 & 1) * 8;
                const LAS unsigned char* vp1 = vst + (kr + 8) * 128 + ((ch16 ^ (kr & 7)) << 4) + (p4 & 1) * 8;
                const v4i16_t lo = __builtin_amdgcn_ds_read_tr16_b64_v4i16((LAS v4i16_t*)vp0), hh = __builtin_amdgcn_ds_read_tr16_b64_v4i16((LAS v4i16_t*)vp1);
                const bf16x8 vb = (bf16x8){lo[0], lo[1], lo[2], lo[3], hh[0], hh[1], hh[2], hh[3]};
                if (dh == 0) o0 = __builtin_amdgcn_mfma_f32_32x32x16_bf16(s == 0 ? pa0 : pa1, vb, o0, 0, 0, 0);
                else         o1 = __builtin_amdgcn_mfma_f32_32x32x16_bf16(s == 0 ? pa0 : pa1, vb, o1, 0, 0, 0);
            }
        }
    }
    lsum += __shfl_xor(lsum, 32);
    O.o0 = o0; O.o1 = o1; O.lsum = lsum;
}
template <int NQ, bool ACC>
__device__ __forceinline__ void item_acc(const ItemOut& O, int toff, int d, LAS unsigned char* lds, int lane) {
    const int c = lane & 31, hi = lane >> 5;
    LAS float* oacc = (LAS float*)(lds + OACC_OFF); LAS float* lacc = (LAS float*)(lds + LACC_OFF);
    constexpr int NR = NQ == 32 ? 16 : 8;
    LAS float* base = oacc + (toff + 4 * hi * d) * OPITCH + c;
    float a0[NR], a1[NR], lo = 0.f;
    if (ACC) {
#pragma unroll
        for (int r = 0; r < NR; ++r) { const LAS float* row = base + ((r & 3) + 8 * (r >> 2)) * d * OPITCH; a0[r] = row[0]; a1[r] = row[32]; }
        if (hi == 0 && c < NQ) lo = lacc[toff + c * d];
        asm volatile("" ::: "memory");
    }
#pragma unroll
    for (int r = 0; r < NR; ++r) { LAS float* row = base + ((r & 3) + 8 * (r >> 2)) * d * OPITCH; row[0] = ACC ? a0[r] + O.o0[r] : O.o0[r]; row[32] = ACC ? a1[r] + O.o1[r] : O.o1[r]; }
    if (hi == 0 && c < NQ) lacc[toff + c * d] = ACC ? lo + O.lsum : O.lsum;
}

__device__ __forceinline__ void unit(Frame& F, int uidx) {
    const int span = uidx % NSPAN, bh = uidx / NSPAN, h = bh % NH, b = bh / NH, t0 = span * SPAN;
    LAS unsigned char* lds = F.lds;
    LAS float* oacc = (LAS float*)(lds + OACC_OFF); LAS float* lacc = (LAS float*)(lds + LACC_OFF); LAS float* lut = (LAS float*)(lds + LUT_OFF);
    if (F.tid < 387) { const int pat = F.tid / 129, rel = F.tid - pat * 129, d = pat == 0 ? 1 : (pat == 1 ? 4 : 16); lut[F.tid] = F.I.rel_bias[t5_bucket(rel * d) * NH + h] * LOG2E; }
    const size_t boff = (size_t)b * SEQ * DM + h * HD;
    const bf16 *Qb = F.Q + boff, *Kb = F.K + boff, *Vb = F.V + boff;
    const int w = F.wave, lane = F.lane;
    ItemRegs R; ItemOut O;
    const int tqA0 = t0 + 64 * w, tqA1 = tqA0 + 32, tqB0 = t0 + (w & 3) + 256 * (w >> 2), tqB1 = tqB0 + 128, tqC0 = t0 + w, tqC1 = t0 + w + 8;
    item_load<32>(R, Qb, Kb, Vb, tqA0, 1, lane);
    __syncthreads();
    item_tiles<32>(R, O, Kb, Vb, tqA0, 1, 0, lds, w, lane);
    item_load<32>(R, Qb, Kb, Vb, tqA1, 1, lane);
    item_acc<32, false>(O, tqA0 - t0, 1, lds, lane);
    item_tiles<32>(R, O, Kb, Vb, tqA1, 1, 0, lds, w, lane);
    item_load<32>(R, Qb, Kb, Vb, tqB0, 4, lane);
    item_acc<32, false>(O, tqA1 - t0, 1, lds, lane);
    __syncthreads();
    item_tiles<32>(R, O, Kb, Vb, tqB0, 4, 1, lds, w, lane);
    item_load<32>(R, Qb, Kb, Vb, tqB1, 4, lane);
    item_acc<32, true>(O, tqB0 - t0, 4, lds, lane);
    item_tiles<32>(R, O, Kb, Vb, tqB1, 4, 1, lds, w, lane);
    item_load<32>(R, Qb, Kb, Vb, tqC0, 16, lane);
    item_acc<32, true>(O, tqB1 - t0, 4, lds, lane);
    __syncthreads();
    item_tiles<32>(R, O, Kb, Vb, tqC0, 16, 2, lds, w, lane);
    item_load<32>(R, Qb, Kb, Vb, tqC1, 16, lane);
    item_acc<32, true>(O, tqC0 - t0, 16, lds, lane);
    item_tiles<32>(R, O, Kb, Vb, tqC1, 16, 2, lds, w, lane);
    item_acc<32, true>(O, tqC1 - t0, 16, lds, lane);
    __syncthreads();
#pragma unroll 1
    for (int ps = 0; ps < 2; ++ps) {
        const int tl = 64 * w + 32 * ps + (lane >> 1), hf = lane & 1;
        const bf16* gp = F.Gb + ((size_t)b * SEQ + t0 + tl) * DM + h * HD + 32 * hf;
        bf16* ap = F.AU + ((size_t)b * SEQ + t0 + tl) * 2048 + 1024 + h * HD + 32 * hf;
        v4u g[4];
#pragma unroll
        for (int j4 = 0; j4 < 4; ++j4) g[j4] = *(const v4u*)(gp + 8 * j4);
        const float rl = __builtin_amdgcn_rcpf(lacc[tl]);
        const LAS f32x4* op = (const LAS f32x4*)(oacc + tl * OPITCH + 32 * hf);
#pragma unroll
        for (int j4 = 0; j4 < 4; ++j4) {
            const f32x4 a = op[2 * j4], bq = op[2 * j4 + 1]; const v4u gg = g[j4];
            v4u o;
            o.x = pk2(a[0] * rl * __uint_as_float(gg.x << 16), a[1] * rl * __uint_as_float(gg.x & 0xffff0000u));
            o.y = pk2(a[2] * rl * __uint_as_float(gg.y << 16), a[3] * rl * __uint_as_float(gg.y & 0xffff0000u));
            o.z = pk2(bq[0] * rl * __uint_as_float(gg.z << 16), bq[1] * rl * __uint_as_float(gg.z & 0xffff0000u));
            o.w = pk2(bq[2] * rl * __uint_as_float(gg.w << 16), bq[3] * rl * __uint_as_float(gg.w & 0xffff0000u));
            *(v4u*)(ap + 8 * j4) = o;
        }
    }
    __syncthreads();
}

}

namespace ssd {
typedef float f32x16 __attribute__((ext_vector_type(16)));
typedef short v4i16_t __attribute__((ext_vector_type(4)));
typedef unsigned u32x2 __attribute__((ext_vector_type(2)));
typedef float f32x2v __attribute__((ext_vector_type(2)));
constexpr int PITCH = 272;
constexpr int BT_OFF = 0, CT_OFF = 34816, G_OFF = 69632, HB_OFF = 104448  , XD_OFF = 113152  , XH_OFF = 121344, ACS_OFF = 129536, DTL_OFF = ACS_OFF + 512, SSQL_OFF = DTL_OFF + 512, XW_OFF = SSQL_OFF + 512  , FW_OFF = XW_OFF + 640  , SSD_LDS_END = FW_OFF + 5120;
static_assert(SSD_LDS_END <= LDSCTL_OFF, "SSD LDS");
__device__ __forceinline__ int crow(int r, int hi) { return (r & 3) + 8 * (r >> 2) + 4 * hi; }
__device__ __forceinline__ bf16x8 trfrag(const LAS unsigned char* p0, const LAS unsigned char* p1) {
    const v4i16_t lo = __builtin_amdgcn_ds_read_tr16_b64_v4i16((LAS v4i16_t*)p0), hh = __builtin_amdgcn_ds_read_tr16_b64_v4i16((LAS v4i16_t*)p1);
    return (bf16x8){lo[0], lo[1], lo[2], lo[3], hh[0], hh[1], hh[2], hh[3]};
}
__device__ __forceinline__ float bflo(unsigned w) { return __uint_as_float(w << 16); }
__device__ __forceinline__ float bfhi(unsigned w) { return __uint_as_float(w & 0xffff0000u); }

__device__ __forceinline__ void chain(Frame& F, int item) {
    const Ins& I = F.I;
    const int b = item >> 5, hd = (item >> 1) & 15, ph = item & 1, grp = hd >> 3, xc0 = hd * 64 + 32 * ph;
    const int tid = F.tid, lane = F.lane, w = F.wave, c = lane & 31, hi = lane >> 5;
    LAS unsigned char* lds = F.lds;
    LAS float* acs = (LAS float*)(lds + ACS_OFF); LAS float* dtl = (LAS float*)(lds + DTL_OFF); LAS float* ssql = (LAS float*)(lds + SSQL_OFF);
    const float A = -__expf(I.a_log[hd]), dsk = I.d_skip[hd];
    const size_t row0 = (size_t)b * SEQ;
    for (int i = tid; i < 8704 / 16; i += NWAVES * 64) ((LAS v4u*)(lds + HB_OFF))[i] = (v4u){0u, 0u, 0u, 0u};
    f32x16 hacc = {};
    const bool ywave = w < 4; const int jt = w & 3;
    const int q4 = (lane & 15) >> 2, odd = (lane >> 4) & 1, p4 = lane & 3;
    const int xtr = (8 * hi + q4) * 64 + (16 * odd + 4 * p4) * 2;
    const int xg = tid & 7, xr0 = (tid >> 3) * 2;
    const int fb = tid >> 8, fc = tid & 255;
    for (int i = tid; i < 5 * 32 + 5 * 256; i += NWAVES * 64) {
        if (i < 160) { const int t = i >> 5, e = i & 31; ((LAS float*)(lds + XW_OFF))[i] = t < 4 ? I.conv_w[t * CONVD + xc0 + e] : I.conv_b[xc0 + e]; }
        else { const int k = i - 160, t = k >> 8, e = k & 255, chn = 1024 + (e < 128 ? grp * 128 + e : 256 + grp * 128 + (e - 128)); ((LAS float*)(lds + FW_OFF))[k] = t < 4 ? I.conv_w[t * CONVD + chn] : I.conv_b[chn]; }
    }
    const int xoff = xg * 8;
    float dtp0, dtp1; u32x2 xr[5]; v4u bcr[8]; float fxr[6]; u32x2 zr[4];
#define SSD_PREFETCH(T0) do { int t0_ = (T0), tv_ = tid, lv_ = lane; asm volatile("" : "+v"(t0_), "+v"(tv_), "+v"(lv_)); \
        const int xg_ = tv_ & 7, xr0_ = (tv_ >> 3) * 2, fb_ = tv_ >> 8, fc_ = tv_ & 255, fch_ = fc_ < 128 ? grp * 128 + fc_ : 256 + grp * 128 + (fc_ - 128); \
        { const float* dp_ = F.DT + (size_t)hd * MROWS + row0 + t0_ + 2 * lv_; dtp0 = dp_[0]; dtp1 = dp_[1]; } \
        { const bf16* xp_ = F.XBC + (row0 + t0_ + xr0_) * CONVD + xc0 + 4 * xg_; \
          _Pragma("unroll") for (int j = 0; j < 5; ++j) xr[j] = (t0_ + xr0_ - 3 + j) >= 0 ? *(const u32x2*)(xp_ + (j - 3) * CONVD) : (u32x2){0u, 0u}; } \
        { const bf16* bp_ = F.XBC + (row0 + t0_ + (tv_ >> 4)) * CONVD + 1024 + grp * 128 + 8 * (tv_ & 15); \
          _Pragma("unroll") for (int k = 0; k < 4; ++k) { bcr[k] = *(const v4u*)(bp_ + (size_t)k * 32 * CONVD); bcr[4 + k] = *(const v4u*)(bp_ + (size_t)k * 32 * CONVD + 256); } } \
        { const size_t blk = (row0 + t0_ + 64 * fb_) >> 6; const bool hasprev = (t0_ + 64 * fb_) > 0; const float* rp_ = F.RAWB + (blk * 6) * 512 + fch_; \
          _Pragma("unroll") for (int j = 0; j < 3; ++j) { fxr[j] = hasprev ? rp_[(j - 6) * 512] : 0.f; fxr[3 + j] = rp_[(3 + j) * 512]; } } \
    } while (0)
#define SSD_PREFETCH_Z(T0) do { int t0_ = (T0), lv_ = lane; asm volatile("" : "+v"(t0_), "+v"(lv_)); \
        const bf16* zp_ = F.Zb + (row0 + t0_ + 32 * jt + (lv_ & 31)) * DM + xc0 + 4 * (lv_ >> 5); \
        _Pragma("unroll") for (int g4 = 0; g4 < 4; ++g4) zr[g4] = *(const u32x2*)(zp_ + 8 * g4); } while (0)
    SSD_PREFETCH(0); if (ywave) SSD_PREFETCH_Z(0);
    __syncthreads();
#pragma unroll 1
    for (int ch = 0; ch < SEQ / 128; ++ch) {
        const int t0 = ch * 128;
        float aend;
        {
            if (w == 0 && ch > 0) { F.SSQ[(row0 + t0 - 128 + lane) * 32 + 2 * hd + ph] = ssql[lane]; F.SSQ[(row0 + t0 - 64 + lane) * 32 + 2 * hd + ph] = ssql[64 + lane]; }
            const float v0 = dtp0 * A, v1 = dtp1 * A; float s = v0 + v1;
#define SSD_DPP_ADD(CTRL, RMASK, BC) s += __builtin_bit_cast(float, __builtin_amdgcn_update_dpp(0, __builtin_bit_cast(int, s), CTRL, RMASK, 0xf, BC))
            SSD_DPP_ADD(0x111, 0xf, true); SSD_DPP_ADD(0x112, 0xf, true); SSD_DPP_ADD(0x114, 0xf, true); SSD_DPP_ADD(0x118, 0xf, true);
            SSD_DPP_ADD(0x142, 0xa, false); SSD_DPP_ADD(0x143, 0xc, false);
#undef SSD_DPP_ADD
            aend = __builtin_bit_cast(float, __builtin_amdgcn_readlane(__builtin_bit_cast(int, s), 63));
            *(LAS f32x2v*)(acs + 2 * lane) = (f32x2v){s - v1, s}; *(LAS f32x2v*)(dtl + 2 * lane) = (f32x2v){dtp0, dtp1};
            if (w == 0) { ssql[lane] = 0.f; ssql[64 + lane] = 0.f; }
        }
#pragma unroll
        for (int k = 0; k < 4; ++k) { const int idx = tid + 512 * k, row = idx >> 4;
            if ((row & 63) >= 3) { *(LAS v4u*)(lds + BT_OFF + row * PITCH + 16 * (idx & 15)) = bcr[k]; *(LAS v4u*)(lds + CT_OFF + row * PITCH + 16 * (idx & 15)) = bcr[4 + k]; } }
        {
            LAS unsigned char* dst = lds + (fc < 128 ? BT_OFF + 2 * fc : CT_OFF + 2 * (fc - 128)) + 64 * fb * PITCH;
            const LAS float* fwp = (const LAS float*)(lds + FW_OFF) + fc;
            const float fw0 = fwp[0], fw1 = fwp[256], fw2 = fwp[512], fw3 = fwp[768], fbias = fwp[1024];
#pragma unroll
            for (int j = 0; j < 3; ++j) *(LAS bf16*)(dst + j * PITCH) = (bf16)f2bf(silu_fast(fbias + fw0 * fxr[j] + fw1 * fxr[j + 1] + fw2 * fxr[j + 2] + fw3 * fxr[j + 3]));
        }
        {
            const LAS f32x4* xwp = (const LAS f32x4*)(lds + XW_OFF) + xg;
            const f32x4 xw0 = xwp[0], xw1 = xwp[8], xw2 = xwp[16], xw3 = xwp[24], xb = xwp[32];
            float xv[5][4];
#pragma unroll
            for (int j = 0; j < 5; ++j) { xv[j][0] = bflo(xr[j].x); xv[j][1] = bfhi(xr[j].x); xv[j][2] = bflo(xr[j].y); xv[j][3] = bfhi(xr[j].y); }
#pragma unroll
            for (int i = 0; i < 2; ++i) {
                const int s = xr0 + i; const float dt = dtl[s], de = dt * __expf(aend - acs[s]); float v[4];
#pragma unroll
                for (int e = 0; e < 4; ++e) v[e] = silu_fast(xb[e] + xw0[e] * xv[i][e] + xw1[e] * xv[i + 1][e] + xw2[e] * xv[i + 2][e] + xw3[e] * xv[i + 3][e]);
                const int off = ((s >> 4) << 10) + xoff + (s & 15) * 64;
                *(LAS u32x2*)(lds + XD_OFF + off) = (u32x2){pg8::cvt_pk_bf16(v[0] * dt, v[1] * dt), pg8::cvt_pk_bf16(v[2] * dt, v[3] * dt)};
                *(LAS u32x2*)(lds + XH_OFF + off) = (u32x2){pg8::cvt_pk_bf16(v[0] * de, v[1] * de), pg8::cvt_pk_bf16(v[2] * de, v[3] * de)};
            }
        }
        __syncthreads();
        asm volatile("" ::: "memory"); __builtin_amdgcn_sched_barrier(0);
        if (ch + 1 < SEQ / 128) SSD_PREFETCH(t0 + 128);
        {
            const int j = w & 3; const float al = acs[32 * j + c];
#pragma unroll
            for (int ii = 0; ii < 2; ++ii) {
                const int i = 2 * (w >> 2) + ii;
                if (i <= j) {
                    f32x16 x = {};
                    const LAS unsigned char* ap = lds + BT_OFF + (32 * i + c) * PITCH + 16 * hi;
                    const LAS unsigned char* bp = lds + CT_OFF + (32 * j + c) * PITCH + 16 * hi;
#pragma unroll 4
                    for (int ks = 0; ks < 8; ++ks) x = __builtin_amdgcn_mfma_f32_32x32x16_bf16(*(const LAS bf16x8*)(ap + 32 * ks), *(const LAS bf16x8*)(bp + 32 * ks), x, 0, 0, 0);
                    const int l = 32 * j + c;
#pragma unroll
                    for (int g4 = 0; g4 < 4; ++g4) {
                        const int sb = 32 * i + 8 * g4 + 4 * hi; float gv[4];
                        const f32x4 as4 = *(const LAS f32x4*)(acs + sb);
#pragma unroll
                        for (int e = 0; e < 4; ++e) { const int s = sb + e; gv[e] = s <= l ? x[4 * g4 + e] * __builtin_amdgcn_exp2f((al - as4[e]) * LOG2E) : 0.f; }
                        *(LAS u32x2*)(lds + G_OFF + l * PITCH + sb * 2) = (u32x2){pg8::cvt_pk_bf16(gv[0], gv[1]), pg8::cvt_pk_bf16(gv[2], gv[3])};
                    }
                }
            }
        }
        f32x16 yt = {};
        if (ywave) {
            const LAS unsigned char* ap = lds + HB_OFF + c * PITCH + 16 * hi;
            const LAS unsigned char* bp = lds + CT_OFF + (32 * jt + c) * PITCH + 16 * hi;
#pragma unroll 4
            for (int ks = 0; ks < 8; ++ks) yt = __builtin_amdgcn_mfma_f32_32x32x16_bf16(*(const LAS bf16x8*)(ap + 32 * ks), *(const LAS bf16x8*)(bp + 32 * ks), yt, 0, 0, 0);
            const float el = __expf(acs[32 * jt + c]);
#pragma unroll
            for (int r = 0; r < 16; ++r) yt[r] *= el;
        }
        __syncthreads();
        if (ywave) {
            {
                const LAS unsigned char* bp = lds + G_OFF + (32 * jt + c) * PITCH + 16 * hi;
                for (int ks = 0; ks < 2 * jt + 2; ++ks) {
                    const LAS unsigned char* xp = lds + XD_OFF + (ks << 10) + xtr;
                    yt = __builtin_amdgcn_mfma_f32_32x32x16_bf16(trfrag(xp, xp + 256), *(const LAS bf16x8*)(bp + 32 * ks), yt, 0, 0, 0);
                }
            }
            const int l = 32 * jt + c; const float rdt = dsk * __builtin_amdgcn_rcpf(dtl[l]);
            bf16* up = F.AU + (row0 + t0 + l) * 2048 + xc0;
            float sq = 0.f;
#pragma unroll
            for (int g4 = 0; g4 < 4; ++g4) {
                const int pl = 8 * g4 + 4 * hi;
                const u32x2 xw2 = *(const LAS u32x2*)(lds + XD_OFF + ((l >> 4) << 10) + (l & 15) * 64 + pl * 2);
                const u32x2 zw = zr[g4];
                const float u0 = (yt[4 * g4] + rdt * bflo(xw2.x)) * bflo(zw.x), u1 = (yt[4 * g4 + 1] + rdt * bfhi(xw2.x)) * bfhi(zw.x), u2 = (yt[4 * g4 + 2] + rdt * bflo(xw2.y)) * bflo(zw.y), u3 = (yt[4 * g4 + 3] + rdt * bfhi(xw2.y)) * bfhi(zw.y);
                sq += (u0 * u0 + u1 * u1) + (u2 * u2 + u3 * u3);
                *(u32x2*)(up + pl) = (u32x2){pg8::cvt_pk_bf16(u0, u1), pg8::cvt_pk_bf16(u2, u3)};
            }
            sq += __shfl_xor(sq, 32);
            if (hi == 0) ssql[l] = sq;
            if (ch + 1 < SEQ / 128) SSD_PREFETCH_Z(t0 + 128);
        } else {
            const float ea = __expf(aend);
#pragma unroll
            for (int r = 0; r < 16; ++r) hacc[r] *= ea;
            const int btr = (8 * hi + q4) * PITCH + (32 * jt + 16 * odd + 4 * p4) * 2;
#pragma unroll 4
            for (int ks = 0; ks < 8; ++ks) {
                const LAS unsigned char* xp = lds + XH_OFF + (ks << 10) + xtr;
                const LAS unsigned char* bp = lds + BT_OFF + 16 * ks * PITCH + btr;
                hacc = __builtin_amdgcn_mfma_f32_32x32x16_bf16(trfrag(xp, xp + 256), trfrag(bp, bp + 4 * PITCH), hacc, 0, 0, 0);
            }
#pragma unroll
            for (int r = 0; r < 16; ++r) *(LAS bf16*)(lds + HB_OFF + crow(r, hi) * PITCH + (32 * jt + c) * 2) = (bf16)f2bf(hacc[r]);
        }
        __syncthreads();
    }
#undef SSD_PREFETCH
#undef SSD_PREFETCH_Z
    if (w == 0) { const int t0 = SEQ; F.SSQ[(row0 + t0 - 128 + lane) * 32 + 2 * hd + ph] = ssql[lane]; F.SSQ[(row0 + t0 - 64 + lane) * 32 + 2 * hd + ph] = ssql[64 + lane]; }
    if (!ywave) {
        float* ho = F.out + O_HP + (((size_t)b * NH + hd) * HD + 32 * ph) * DS + 32 * jt + c;
#pragma unroll
        for (int r = 0; r < 16; ++r) ho[(size_t)crow(r, hi) * DS] = hacc[r];
    }
    __syncthreads();
}
}

namespace smp {
__device__ __forceinline__ void attn_unit(Frame& F, int bhs) {
    const Ins& I = F.I;
    const int lane = F.lane, w = F.wave, b = bhs >> 4, h = bhs & 15, r = NTOK + b;
    LAS float* qs = (LAS float*)(F.lds + 4096); LAS float* acc = (LAS float*)F.lds;
    LAS float* ps = (LAS float*)(F.lds + 8192) + w * 64;
    if (F.tid < 64) qs[F.tid] = bf2f(F.Q[(size_t)r * DM + h * HD + F.tid]);
    if (F.tid < 65) acc[F.tid] = 0.f;
    __syncthreads();
    const int k0 = 49 * w, nk = (387 - k0) < 49 ? (387 - k0) : 49;
    float p = 0.f;
    if (lane < nk) {
        const int idx = k0 + lane, pat = idx / 129, j = idx - pat * 129, d = pat == 0 ? 1 : (pat == 1 ? 4 : 16);
        float s = 0.f;
        if (j > 0) { const f32x4* kp = (const f32x4*)(I.ck + (((size_t)b * WIN + (WIN - j * d)) * NH + h) * HD);
#pragma unroll
            for (int e = 0; e < 16; ++e) { const f32x4 kv = kp[e]; const f32x4 qv = *(const LAS f32x4*)(qs + 4 * e); s += (qv[0] * kv[0] + qv[1] * kv[1]) + (qv[2] * kv[2] + qv[3] * kv[3]); } }
        else { const bf16* kp = F.K + (size_t)r * DM + h * HD; for (int e = 0; e < 64; ++e) s += qs[e] * bf2f(kp[e]); }
        p = __builtin_amdgcn_exp2f(s + I.rel_bias[t5_bucket(j * d) * NH + h] * LOG2E);
    }
    ps[lane] = p;
    const float lsum = wave_sum(p);
    __builtin_amdgcn_wave_barrier();
    float o0 = 0.f, o1 = 0.f, o2 = 0.f, o3 = 0.f;
    const float vnew = bf2f(F.V[(size_t)r * DM + h * HD + lane]);
    const float* vbase = I.cv + ((size_t)b * WIN * NH + h) * HD + lane;
#define SMP_V(K) ({ const int idx_ = k0 + (K), pat_ = idx_ / 129, j_ = idx_ - pat_ * 129, d_ = pat_ == 0 ? 1 : (pat_ == 1 ? 4 : 16); \
                    (K) < nk ? ps[(K)] * (j_ > 0 ? vbase[(size_t)(WIN - j_ * d_) * (NH * HD)] : vnew) : 0.f; })
#pragma unroll
    for (int k = 0; k < 48; k += 4) { o0 += SMP_V(k); o1 += SMP_V(k + 1); o2 += SMP_V(k + 2); o3 += SMP_V(k + 3); }
    o0 += SMP_V(48);
#undef SMP_V
    __hip_atomic_fetch_add(acc + lane, (o0 + o1) + (o2 + o3), __ATOMIC_RELAXED, __HIP_MEMORY_SCOPE_WORKGROUP);
    if (lane == 0) __hip_atomic_fetch_add(acc + 64, lsum, __ATOMIC_RELAXED, __HIP_MEMORY_SCOPE_WORKGROUP);
    __syncthreads();
    if (F.tid < 64) F.AU[(size_t)r * 2048 + 1024 + h * HD + F.tid] = (bf16)f2bf(acc[F.tid] * __builtin_amdgcn_rcpf(acc[64]) * bf2f(F.Gb[(size_t)r * DM + h * HD + F.tid]));
    __syncthreads();
}

__device__ __forceinline__ void ssd_unit(Frame& F, int bhs) {
    const Ins& I = F.I;
    LAS float* xs_l = (LAS float*)F.lds; LAS float* B_l = xs_l + 64; LAS float* C_l = B_l + 128; LAS float* ssq_l = C_l + 128;
    const int tid = F.tid, p = tid >> 3, ng = tid & 7;
    const int b = bhs >> 4, hd = bhs & 15, grp = hd >> 3; const size_t r = (size_t)NTOK + b;
    float h[16];
    { const f32x4* hp = (const f32x4*)(I.sssm + (((size_t)b * NH + hd) * HD + p) * DS + ng * 16);
#pragma unroll
      for (int i = 0; i < 4; ++i) { const f32x4 v = hp[i]; h[4 * i] = v[0]; h[4 * i + 1] = v[1]; h[4 * i + 2] = v[2]; h[4 * i + 3] = v[3]; } }
    if (tid < 320) {
        const int ci = tid, c = ci < 64 ? hd * 64 + ci : (ci < 192 ? 1024 + grp * 128 + (ci - 64) : 1280 + grp * 128 + (ci - 192));
        float v = I.conv_b[c];
#pragma unroll
        for (int i = 0; i < 3; ++i) v += I.sconv[((size_t)b * 3 + i) * CONVD + c] * I.conv_w[i * CONVD + c];
        v += bf2f(F.XBC[r * CONVD + c]) * I.conv_w[3 * CONVD + c];
        xs_l[ci] = silu_f(v);
    }
    if (tid == 0) ssq_l[0] = 0.f;
    __syncthreads();
    const float dt = F.DT[(size_t)hd * MROWS + r], A = -__expf(I.a_log[hd]), x = xs_l[p], dec = __expf(dt * A), xdt = x * dt;
    float y = 0.f;
#pragma unroll
    for (int i = 0; i < 16; ++i) { h[i] = h[i] * dec + xdt * B_l[ng * 16 + i]; y += h[i] * C_l[ng * 16 + i]; }
    y += __shfl_xor(y, 1); y += __shfl_xor(y, 2); y += __shfl_xor(y, 4);
    if (ng == 0) {
        const float u = (y + I.d_skip[hd] * x) * bf2f(F.Zb[r * DM + hd * 64 + p]);
        F.AU[r * 2048 + hd * 64 + p] = (bf16)f2bf(u);
        __hip_atomic_fetch_add(ssq_l, u * u, __ATOMIC_RELAXED, __HIP_MEMORY_SCOPE_WORKGROUP);
    }
    { f32x4* ho = (f32x4*)(F.out + O_HS + (((size_t)b * NH + hd) * HD + p) * DS + ng * 16);
#pragma unroll
      for (int i = 0; i < 4; ++i) ho[i] = (f32x4){h[4 * i], h[4 * i + 1], h[4 * i + 2], h[4 * i + 3]}; }
    __syncthreads();
    if (tid == 0) { F.SSQ[r * 32 + 2 * hd] = ssq_l[0]; F.SSQ[r * 32 + 2 * hd + 1] = 0.f; }
    __syncthreads();
}
}

namespace smp {
typedef float f32x16s __attribute__((ext_vector_type(16)));
__device__ __forceinline__ void mm64x32(Frame& F, const bf16* WT, int wrow0  , const bf16* A, int apitch, int K) {
    const int lane = F.lane, w = F.wave, c = lane & 31, hi = lane >> 5, half = w & 1, kq = w >> 1, kseg = K / 4;
    const bf16* ap = WT + (size_t)(wrow0 + 128 * half + c) * K + kq * kseg + 8 * hi;
    const bf16* bp = A + (size_t)c * apitch + kq * kseg + 8 * hi;
    f32x16s acc = {};
#pragma unroll 8
    for (int ks = 0; ks < kseg / 16; ++ks) acc = __builtin_amdgcn_mfma_f32_32x32x16_bf16(*(const bf16x8*)(ap + 16 * ks), *(const bf16x8*)(bp + 16 * ks), acc, 0, 0, 0);
    LAS float* red = (LAS float*)F.lds + (kq * 64 + 32 * half) * 32;
#pragma unroll
    for (int r = 0; r < 16; ++r) red[((r & 3) + 8 * (r >> 2) + 4 * hi) * 32 + c] = acc[r];
    __syncthreads();
}
__device__ __forceinline__ void inproj_unit(Frame& F, int ht) {
    const Ins& I = F.I;
    const int a0 = 64 * ht;
    mm64x32(F, F.WinT, (a0 & ~255) + vrow_of_col(a0 & 255), F.XN + (size_t)NTOK * DM, DM, DM);
    const LAS float* red = (const LAS float*)F.lds;
    const int lane = F.lane, w = F.wave;
#pragma unroll 1
    for (int rr = 0; rr < 4; ++rr) {
        const int r = 4 * w + rr;
        const float v = (red[(0 * 64 + lane) * 32 + r] + red[(1 * 64 + lane) * 32 + r]) + (red[(2 * 64 + lane) * 32 + r] + red[(3 * 64 + lane) * 32 + r]);
        const size_t row = (size_t)NTOK + r; const int col = a0 + lane;
        if (col < C_V) {
            const float sc = rsqrtf(wave_sum(v * v) * (1.f / 64.f) + EPS);
            if (col < C_K) F.Q[row * DM + col] = (bf16)f2bf(v * sc * I.qnw[lane] * QSCALE);
            else { const float kv = v * sc * I.knw[lane]; F.K[row * DM + col - C_K] = (bf16)f2bf(kv); F.out[O_KS + (size_t)r * DM + col - C_K] = kv; }
        } else if (col < C_G) { F.V[row * DM + col - C_V] = (bf16)f2bf(v); F.out[O_VS + (size_t)r * DM + col - C_V] = v; }
        else if (col < C_Z) F.Gb[row * DM + col - C_G] = (bf16)f2bf(silu_fast(v));
        else if (col < C_XBC) F.Zb[row * DM + col - C_Z] = (bf16)f2bf(silu_fast(v));
        else { F.XBC[row * CONVD + col - C_XBC] = (bf16)f2bf(v); F.out[O_CS + ((size_t)r * 3 + 2) * CONVD + col - C_XBC] = v; }
    }
    __syncthreads();
}
__device__ __forceinline__ void outproj_unit(Frame& F, int ct) {
    const Ins& I = F.I;
    const int a0 = 64 * ct;
    mm64x32(F, F.WoutT, (a0 & ~255) + vrow_of_col(a0 & 255), F.AU + (size_t)NTOK * 2048, 2048, 2048);
    const LAS float* red = (const LAS float*)F.lds;
    const int lane = F.lane, w = F.wave;
#pragma unroll 1
    for (int rr = 0; rr < 4; ++rr) {
        const int r = 4 * w + rr;
        float s = lane < 32 ? F.SSQ[((size_t)NTOK + r) * 32 + lane] : 0.f;
        s = wave_sum(s);
        const float rs = rsqrtf(s * (1.f / 1024.f) + EPS);
        const float v = (red[(0 * 64 + lane) * 32 + r] + red[(1 * 64 + lane) * 32 + r]) * rs + (red[(2 * 64 + lane) * 32 + r] + red[(3 * 64 + lane) * 32 + r]);
        F.out[O_YS + (size_t)r * DM + a0 + lane] = I.xs[(size_t)r * DM + a0 + lane] + v;
    }
    __syncthreads();
}
}

__device__ __forceinline__ void phase2_queue(Frame& F, int qset) {
    const unsigned x = xb_xcc_id() & 7u;
    constexpr int PER_Q = att::NUNITS / 8;
    for (unsigned k = 0; k < 8; ++k) {
        const unsigned qx = (x + k) & 7u;
        gu32* qw = F.ctl + CW_Q + 64 * (8 * qset + qx);
        if (F.tid == 0) F.MISC[16] = __hip_atomic_fetch_add(qw, 1u, RLX_AGENT);
        __syncthreads();
        unsigned idx = F.MISC[16];
        while (idx < (unsigned)(PER_Q + 128)) {
            unsigned nxt = 0u;
            if (F.tid == 0) nxt = __hip_atomic_fetch_add(qw, 1u, RLX_AGENT);
            if (idx < 64u) smp::attn_unit(F, (int)(qx * 64 + idx));
            else if (idx < 128u) smp::ssd_unit(F, (int)(qx * 64 + idx - 64));
            else att::unit(F, (int)(qx * PER_Q + idx - 128));
            if (F.tid == 0) F.MISC[16] = nxt;
            __syncthreads();
            idx = F.MISC[16];
        }
        __syncthreads();
    }
}

constexpr int PROBE_REP_SSD = 1, PROBE_REP_ATT = 1;
struct Args { Ins in; float* out; unsigned char* ws; int ph_lo, ph_hi; };
__global__ void __launch_bounds__(NWAVES * 64, 2) mk_fwd(Args args) {
    extern __shared__ __attribute__((aligned(16))) unsigned char lds[];
    Frame F;
    F.lds = (LAS unsigned char*)lds;
    F.MISC = (volatile LAS unsigned*)(F.lds + MISC_OFF);
    F.tid = threadIdx.x; F.lane = F.tid & 63; F.wave = __builtin_amdgcn_readfirstlane(F.tid >> 6);
    F.G = gridDim.x; { const int bx = blockIdx.x; F.vcu = (F.G % 8 == 0) ? (bx % 8) * (F.G / 8) + bx / 8 : bx; }
    unsigned char* ws = args.ws;
    F.ctl = (gu32*)(ws + WS_CTL); F.I = args.in; F.out = args.out;
    F.WinT = (bf16*)(ws + WS_WIN); F.WoutT = (bf16*)(ws + WS_WOUT); F.XN = (bf16*)(ws + WS_XN); F.Q = (bf16*)(ws + WS_Q); F.K = (bf16*)(ws + WS_K); F.V = (bf16*)(ws + WS_V);
    F.AU = (bf16*)(ws + WS_AU); F.XBC = (bf16*)(ws + WS_XBC); F.DT = (float*)(ws + WS_DT); F.SSQ = (float*)(ws + WS_SSQ); F.RAWB = (float*)(ws + WS_RAWB); F.Gb = (bf16*)(ws + WS_G); F.Zb = (bf16*)(ws + WS_Z);
    for (int u = F.tid; u < (LDS_BYTES - LDSCTL_OFF) / 4; u += NWAVES * 64) ((LAS unsigned*)(F.lds + LDSCTL_OFF))[u] = 0u;
    __syncthreads();
    XcdBarrier bar = xcd_barrier_post((unsigned*)(F.ctl + CW_BAR), F.MISC + 8);
    const int lo = args.ph_lo, hi = args.ph_hi;
#define IN(k) (lo <= (k) && (k) < hi)
#define BOTH(k) (IN(k) && IN((k) + 1))
    if (IN(0)) { p0_prologue(F); if (BOTH(0)) xcd_barrier(bar); }
    if (IN(1)) {
        __syncthreads();
        pg8::Gemm g{F.XN, F.WinT, NTOK, NMAIN, DM}; pg8::StaticOrder S; S.init(NTOK, NMAIN, F.G, (int)blockIdx.x);
        pg8::EpiIn E{F.Q, F.K, F.V, F.Gb, F.Zb, F.XBC, F.out, F.I.qnw, F.I.knw, F.I.conv_w, F.I.conv_b, F.RAWB};
        pg8::gemm_phase<pg8::EpiIn, pg8::StaticOrder, true, true>(F.lds + RING_OFF, g, S, E);
        __syncthreads();
        for (int ht = F.vcu; ht < NMAIN / 64; ht += F.G) smp::inproj_unit(F, ht);
        if (BOTH(1)) xcd_barrier(bar);
    }
    if (IN(2)) { __syncthreads(); if ((F.vcu & 31) < 16 && (F.vcu >> 5) < 8) { ssd::chain(F, (F.vcu >> 5) * 16 + (F.vcu & 31)); if (PROBE_ID == 30) { const unsigned long long t0_ = __builtin_amdgcn_s_memrealtime(); while (__builtin_amdgcn_s_memrealtime() - t0_ < 10000ull) __builtin_amdgcn_s_sleep(8); } } for (int rep = 0; rep < PROBE_REP_ATT; ++rep) phase2_queue(F, rep);     if (BOTH(2)) xcd_barrier(bar); }
    if (IN(3)) {
        __syncthreads();
        pg8::Gemm g{F.AU, F.WoutT, NTOK, DM, 2048}; pg8::StaticOrder S; S.init(NTOK, DM, F.G, (int)blockIdx.x);
        LAS float* rs = (LAS float*)(F.lds + RING_BYTES);
        { pg8::Unit u;
          for (int ui = 0; ui < 4 && S.next(ui, u); ++ui)
              for (int r = F.tid; r < 256; r += NWAVES * 64) {
                  const f32x4* sp = (const f32x4*)(F.SSQ + (size_t)(u.pm * 256 + r) * 32);
                  float s = 0.f;
#pragma unroll
                  for (int q = 0; q < 8; ++q) { const f32x4 v = sp[q]; s += (v[0] + v[1]) + (v[2] + v[3]); }
                  rs[ui * 256 + r] = rsqrtf(s * (1.f / 1024.f) + EPS);
              }
          __syncthreads(); }
        pg8::EpiOut E{F.I.xp, F.I.xs, rs, F.out};
        pg8::gemm_phase<pg8::EpiOut, pg8::StaticOrder, true, true>(F.lds + RING_OFF, g, S, E);
        __syncthreads();
        for (int ct = F.G - 1 - F.vcu; ct >= 0 && ct < DM / 64; ct += F.G) smp::outproj_unit(F, ct);
    }
#undef IN
#undef BOTH
}

extern "C" void kernel_launch(void* const* d_in, const int* in_sizes, int n_in, void* d_out, int out_size, void* d_ws, size_t ws_size, hipStream_t stream) {
    static int grid = 0;
    if (grid == 0) {
        if (n_in != 18 || out_size != (int)O_END || ws_size < WS_END) { fprintf(stderr, "kernel_launch: unexpected n_in %d / out_size %d / ws_size %zu; nothing launched\n", n_in, out_size, ws_size); grid = -1; return; }
        int dev = 0, cus = 0;
        if (hipGetDevice(&dev) != hipSuccess || hipDeviceGetAttribute(&cus, hipDeviceAttributeMultiprocessorCount, dev) != hipSuccess) { grid = -1; return; }
        if (hipFuncSetAttribute((const void*)mk_fwd, hipFuncAttributeMaxDynamicSharedMemorySize, LDS_BYTES) != hipSuccess) { fprintf(stderr, "kernel_launch: hipFuncSetAttribute failed\n"); grid = -1; return; }
        (void)hipGetLastError();
        grid = cus;
    }
    if (grid < 0) return;
    (void)hipMemsetAsync((char*)d_ws + WS_CTL, 0, CTL_ZERO_BYTES, stream);
    Args a{};
    const float** ip = (const float**)&a.in;
    for (int i = 0; i < 18; ++i) ip[i] = (const float*)d_in[i];
    a.out = (float*)d_out; a.ws = (unsigned char*)d_ws;
    a.ph_lo = 0; a.ph_hi = 4;
    hipLaunchKernelGGL(mk_fwd, dim3(grid), dim3(NWAVES * 64), LDS_BYTES, stream, a);
}
```

```cpp
#include <hip/hip_runtime.h>
#include <cstdio>
#include <cstdint>

constexpr int DM = 1024, NB = 4, SEQ = 8192, DB = 32, WIN = 2048;
constexpr int NPROJ = 6672, NMAIN = 6656, NTOK = NB * SEQ, NROWS = NTOK + DB;
constexpr int MROWS = 33024;
constexpr int C_Q = 0, C_K = 1024, C_V = 2048, C_G = 3072, C_Z = 4096, C_XBC = 5120, C_DT = 6656;
constexpr int CONVD = 1536, NH = 16, HD = 64, DS = 128;
constexpr float EPS = 1e-6f;
constexpr float QSCALE = 0.125f * 1.4426950408889634f;
constexpr float LOG2E = 1.4426950408889634f;
constexpr size_t O_YP = 0, O_YS = O_YP + (size_t)NTOK * DM, O_KP = O_YS + (size_t)DB * DM, O_VP = O_KP + (size_t)NB * WIN * DM,
                 O_CP = O_VP + (size_t)NB * WIN * DM, O_HP = O_CP + (size_t)NB * 3 * CONVD, O_KS = O_HP + (size_t)NB * NH * HD * DS,
                 O_VS = O_KS + (size_t)DB * DM, O_CS = O_VS + (size_t)DB * DM, O_HS = O_CS + (size_t)DB * 3 * CONVD,
                 O_END = O_HS + (size_t)DB * NH * HD * DS;
static_assert(O_END == 55314432, "output size");

constexpr size_t MiB = 1u << 20;
constexpr size_t WS_CTL = 0, CTL_ZERO_BYTES = 1 * MiB;
constexpr size_t WS_WIN = 2 * MiB;
constexpr size_t WS_WOUT = 16 * MiB;
constexpr size_t WS_DT = 20 * MiB;
constexpr size_t WS_SSQ = 24 * MiB;
constexpr size_t WS_XN = 32 * MiB;
constexpr size_t WS_Q = 100 * MiB;
constexpr size_t WS_K = 168 * MiB;
constexpr size_t WS_V = 236 * MiB;
constexpr size_t WS_AU = 304 * MiB;
constexpr size_t WS_XBC = 436 * MiB;
constexpr size_t WS_RAWB = 536 * MiB;
constexpr size_t WS_G = 544 * MiB;
constexpr size_t WS_Z = 612 * MiB;
constexpr size_t WS_END = 680 * MiB;
static_assert(WS_XN + (size_t)MROWS * DM * 2 <= WS_Q && WS_Q + (size_t)MROWS * DM * 2 <= WS_K && WS_K + (size_t)MROWS * DM * 2 <= WS_V && WS_V + (size_t)MROWS * DM * 2 <= WS_AU &&
              WS_AU + (size_t)MROWS * 2048 * 2 <= WS_XBC && WS_XBC + (size_t)MROWS * CONVD * 2 <= WS_RAWB && WS_RAWB + (size_t)(MROWS / 64) * 6 * 512 * 4 <= WS_G && WS_G + (size_t)MROWS * DM * 2 <= WS_Z && WS_Z + (size_t)MROWS * DM * 2 <= WS_END && WS_WIN + (size_t)NMAIN * DM * 2 <= WS_WOUT && WS_WOUT + (size_t)DM * 2048 * 2 <= WS_DT &&
              WS_DT + (size_t)MROWS * 16 * 4 <= WS_SSQ && WS_SSQ + (size_t)MROWS * 32 * 4 <= WS_XN, "d_ws map");

struct Ins {
    const float *xp, *xs, *ck, *cv, *sconv, *sssm, *norm_w, *w_in, *qnw, *knw, *rel_bias, *conv_w, *conv_b, *dt_bias, *a_log, *d_skip, *ssd_norm_w, *w_out;
};

typedef unsigned short bf16;
__device__ __forceinline__ float wave_sum(float v) {
#pragma unroll
    for (int o = 1; o < 64; o <<= 1) v += __shfl_xor(v, o);
    return v;
}
__device__ __forceinline__ float wave_max(float v) {
#pragma unroll
    for (int o = 1; o < 64; o <<= 1) v = fmaxf(v, __shfl_xor(v, o));
    return v;
}
__device__ __forceinline__ float silu_f(float x) { return x / (1.f + __expf(-x)); }
__device__ __forceinline__ float silu_fast(float x) { return x * __builtin_amdgcn_rcpf(1.f + __builtin_amdgcn_exp2f(-LOG2E * x)); }
__device__ __forceinline__ float softplus_f(float x) { return x > 20.f ? x : log1pf(__expf(x)); }
__device__ __forceinline__ int t5_bucket(int d) {
    if (d < 16) return d;
    int b = 16;
    b += d >= 22; b += d >= 30; b += d >= 40; b += d >= 54; b += d >= 73; b += d >= 99; b += d >= 134; b += d >= 182;
    b += d >= 246; b += d >= 332; b += d >= 450; b += d >= 609; b += d >= 825; b += d >= 1117; b += d >= 1513;
    return b;
}
__device__ __forceinline__ const float* xrow(const Ins& I, int r) { return r < NTOK ? I.xp + (size_t)r * DM : I.xs + (size_t)(r - NTOK) * DM; }
__device__ __forceinline__ float bf2f(bf16 v) { return __uint_as_float((unsigned)v << 16); }
__device__ __forceinline__ unsigned f2bf(float f) { unsigned u = __float_as_uint(f); return (u + 0x7fffu + ((u >> 16) & 1u)) >> 16; }
__device__ __forceinline__ unsigned pk2(float lo, float hi) { return f2bf(lo) | (f2bf(hi) << 16); }
__host__ __device__ __forceinline__ int vrow_of_col(int a) { return 128 * ((a >> 5) & 1) + 32 * ((a >> 6) & 3) + (a & 31); }

namespace pg8 {
#define PG8_LAS __attribute__((address_space(3)))
typedef unsigned short bf16_t;
typedef short bf16x8 __attribute__((ext_vector_type(8)));
typedef float f32x4 __attribute__((ext_vector_type(4)));
typedef unsigned u32x4 __attribute__((ext_vector_type(4)));
constexpr int BM = 256, BK = 64, HALF = 128, HTB = HALF * BK * 2  , STAGE_BYTES = 8 * HTB, NXCD = 8, WGM = 8;

__host__ __device__ __forceinline__ int lds_byte(int r, int c) { const int st = (r >> 4) * 2 + (c >> 5), rr = r & 15, cc = c & 31, ob = rr * 64 + cc * 2; return st * 1024 + (ob ^ (((ob >> 9) & 1) << 5)); }
__host__ __device__ __forceinline__ void stage_rc(int b, int& R, int& C) { const int st = b / 1024, sb = b % 1024, swz = sb ^ (((sb >> 9) & 1) << 5); R = (st >> 1) * 16 + swz / 64; C = (st & 1) * 32 + (swz % 64) / 2; }
__host__ __device__ __forceinline__ int perm32(int rho) { const int n = rho >> 4, i = rho & 15; return 8 * (i >> 2) + 4 * n + (i & 3); }

struct Unit { int pm, pn; };
struct Gemm { const bf16_t* A; const bf16_t* Bt; int M, N, K; };

struct StaticOrder {
    int nM, nN, nwg, G, c;
    __host__ __device__ void init(int M, int N, int G_, int c_) { nM = M / BM; nN = N / BM; nwg = nM * nN; G = G_; c = c_; }
    __host__ __device__ bool next(int i, Unit& u) const {
        const long L = (long)i * G + c; if (L >= nwg) return false;
        int wgid = (int)L; { const int q = nwg / NXCD, r = nwg % NXCD, xcd = wgid % NXCD, off = wgid / NXCD; wgid = (xcd < r ? xcd * (q + 1) : r * (q + 1) + (xcd - r) * q) + off; }
        const int nig = WGM * nN, gid = wgid / nig, fm = gid * WGM, gsz = (nM - fm) < WGM ? (nM - fm) : WGM;
        u.pm = fm + ((wgid % nig) % gsz); u.pn = (wgid % nig) / gsz; return true;
    }
    __device__ __forceinline__ void a_ready(const Unit&) const {}
    __device__ __forceinline__ void done(const Unit&) const {}
};

__device__ __forceinline__ unsigned cvt_pk_bf16(float lo, float hi) { unsigned r; asm volatile("v_cvt_pk_bf16_f32 %0, %1, %2" : "=v"(r) : "v"(lo), "v"(hi)); return r; }

template <int K> __device__ __forceinline__ float rowprev(float cur, float prevm) {
    const int t = __builtin_amdgcn_update_dpp(0, __builtin_bit_cast(int, prevm), 0x100 + (16 - K), 0xf, 0xf, true);
    return __builtin_bit_cast(float, __builtin_amdgcn_update_dpp(t, __builtin_bit_cast(int, cur), 0x110 + K, 0xf, 0xf, false));
}

struct EpiIn {
    static constexpr bool PERM = true, AFTER_DRAIN = false, MIDK = false;
    bf16_t *Q, *K, *V, *Gb, *Zb, *XBC; float* out; const float *qnw, *knw, *conv_w, *conv_b; float* rawb;
    __device__ __forceinline__ void mid(f32x4 (&)[2][2][4][2], const Unit&, int, int, int, int, int) const {}
    __device__ __forceinline__ void operator()(const f32x4 (&acc)[2][2][4][2], const Unit& u, int wr, int wc, int fr, int fq) const {
        const int pn = u.pn;
        const int rowb = u.pm * BM + wr * 64 + fr;
        const int cl = wc * 64 + 8 * fq;
        if (pn < 8) {
            const bool isq = pn < 4; const float* nw = isq ? qnw : knw;
            f32x4 w[2][2];
#pragma unroll
            for (int bj = 0; bj < 2; ++bj)
#pragma unroll
                for (int n = 0; n < 2; ++n) w[bj][n] = *(const f32x4*)(nw + 8 * fq + 32 * bj + 4 * n);
            bf16_t* dstb = (isq ? Q : K) + (pn & 3) * 256 + cl;
#pragma unroll
            for (int ai = 0; ai < 2; ++ai)
#pragma unroll
                for (int m = 0; m < 4; ++m) {
                    const int r = rowb + ai * HALF + m * 16;
                    float ss = 0.f;
#pragma unroll
                    for (int bj = 0; bj < 2; ++bj)
#pragma unroll
                        for (int n = 0; n < 2; ++n) { const f32x4 v = acc[ai][bj][m][n]; ss += (v[0] * v[0] + v[1] * v[1]) + (v[2] * v[2] + v[3] * v[3]); }
                    ss += __shfl_xor(ss, 16); ss += __shfl_xor(ss, 32);
                    const float sc = rsqrtf(ss * (1.f / 64.f) + EPS), scs = isq ? sc * QSCALE : sc;
                    float* f32dst = nullptr;
                    if (!isq) { if (r < NTOK) { const int t = r & (SEQ - 1); if (t >= SEQ - WIN) f32dst = out + O_KP + ((size_t)((r >> 13) * WIN + t - (SEQ - WIN))) * DM + (pn & 3) * 256 + cl; }
                                else if (r < NROWS) f32dst = out + O_KS + (size_t)(r - NTOK) * DM + (pn & 3) * 256 + cl; }
#pragma unroll
                    for (int bj = 0; bj < 2; ++bj) {
                        const f32x4 a0 = acc[ai][bj][m][0] * w[bj][0], a1 = acc[ai][bj][m][1] * w[bj][1];
                        u32x4 o; o.x = cvt_pk_bf16(a0[0] * scs, a0[1] * scs); o.y = cvt_pk_bf16(a0[2] * scs, a0[3] * scs); o.z = cvt_pk_bf16(a1[0] * scs, a1[1] * scs); o.w = cvt_pk_bf16(a1[2] * scs, a1[3] * scs);
                        *(u32x4*)(dstb + (size_t)r * DM + 32 * bj) = o;
                        if (f32dst) { *(f32x4*)(f32dst + 32 * bj) = a0 * sc; *(f32x4*)(f32dst + 32 * bj + 4) = a1 * sc; }
                    }
                }
        } else if (pn < 12) {
            bf16_t* dstb = V + (pn & 3) * 256 + cl;
#pragma unroll
            for (int ai = 0; ai < 2; ++ai)
#pragma unroll
                for (int m = 0; m < 4; ++m) {
                    const int r = rowb + ai * HALF + m * 16;
                    float* f32dst = nullptr;
                    if (r < NTOK) { const int t = r & (SEQ - 1); if (t >= SEQ - WIN) f32dst = out + O_VP + ((size_t)((r >> 13) * WIN + t - (SEQ - WIN))) * DM + (pn & 3) * 256 + cl; }
                    else if (r < NROWS) f32dst = out + O_VS + (size_t)(r - NTOK) * DM + (pn & 3) * 256 + cl;
#pragma unroll
                    for (int bj = 0; bj < 2; ++bj) {
                        const f32x4 a0 = acc[ai][bj][m][0], a1 = acc[ai][bj][m][1];
                        u32x4 o; o.x = cvt_pk_bf16(a0[0], a0[1]); o.y = cvt_pk_bf16(a0[2], a0[3]); o.z = cvt_pk_bf16(a1[0], a1[1]); o.w = cvt_pk_bf16(a1[2], a1[3]);
                        *(u32x4*)(dstb + (size_t)r * DM + 32 * bj) = o;
                        if (f32dst) { *(f32x4*)(f32dst + 32 * bj) = a0; *(f32x4*)(f32dst + 32 * bj + 4) = a1; }
                    }
                }
        } else if (pn < 20) {
            bf16_t* dstb = (pn < 16 ? Gb : Zb) + (pn & 3) * 256 + cl;
#pragma unroll
            for (int ai = 0; ai < 2; ++ai)
#pragma unroll
                for (int m = 0; m < 4; ++m) {
                    const int r = rowb + ai * HALF + m * 16;
#pragma unroll
                    for (int bj = 0; bj < 2; ++bj) {
                        f32x4 a0 = acc[ai][bj][m][0], a1 = acc[ai][bj][m][1];
#pragma unroll
                        for (int i = 0; i < 4; ++i) { a0[i] = silu_fast(a0[i]); a1[i] = silu_fast(a1[i]); }
                        u32x4 o; o.x = cvt_pk_bf16(a0[0], a0[1]); o.y = cvt_pk_bf16(a0[2], a0[3]); o.z = cvt_pk_bf16(a1[0], a1[1]); o.w = cvt_pk_bf16(a1[2], a1[3]);
                        *(u32x4*)(dstb + (size_t)r * DM + 32 * bj) = o;
                    }
                }
        } else {
            const int cb = (pn - 20) * 256 + cl;
            bf16_t* dstb = XBC + cb;
            const bool do_conv = pn >= 24 && u.pm < NTOK / BM;
#pragma unroll
            for (int ai = 0; ai < 2; ++ai)
#pragma unroll
                for (int m = 0; m < 4; ++m) {
                    const int r = rowb + ai * HALF + m * 16;
                    float* f32dst = nullptr;
                    if (r < NTOK) { const int t = r & (SEQ - 1); if (t >= SEQ - 3) f32dst = out + O_CP + ((size_t)((r >> 13) * 3 + t - (SEQ - 3))) * CONVD + cb; }
                    else if (r < NROWS) f32dst = out + O_CS + ((size_t)(r - NTOK) * 3 + 2) * CONVD + cb;
                    if (do_conv && (m == 0 || m == 3)) {
                        const int slot = m == 0 ? 3 + fr : fr - 13;
                        if (slot >= 0 && slot < 6) f32dst = rawb + ((size_t)(u.pm * 4 + ai * 2 + wr) * 6 + slot) * 512 + (cb - 1024);
                    }
#pragma unroll
                    for (int bj = 0; bj < 2; ++bj) {
                        const f32x4 a0 = acc[ai][bj][m][0], a1 = acc[ai][bj][m][1];
                        if (!do_conv) { u32x4 o; o.x = cvt_pk_bf16(a0[0], a0[1]); o.y = cvt_pk_bf16(a0[2], a0[3]); o.z = cvt_pk_bf16(a1[0], a1[1]); o.w = cvt_pk_bf16(a1[2], a1[3]);
                                        *(u32x4*)(dstb + (size_t)r * CONVD + 32 * bj) = o; }
                        if (f32dst) { *(f32x4*)(f32dst + 32 * bj) = a0; *(f32x4*)(f32dst + 32 * bj + 4) = a1; }
                    }
                }
            if (do_conv) {
                if ((u.pm & 31) == 31 && wr == 1 && fr >= 13) {
#pragma unroll
                    for (int bj = 0; bj < 2; ++bj) { float* d = out + O_CP + ((size_t)((u.pm >> 5) * 3 + fr - 13)) * CONVD + cb + 32 * bj; *(f32x4*)d = acc[1][bj][3][0]; *(f32x4*)(d + 4) = acc[1][bj][3][1]; }
                }
#pragma unroll
                for (int bj = 0; bj < 2; ++bj) {
                    f32x4 w[4][2], bb[2];
#pragma unroll
                    for (int n = 0; n < 2; ++n) { bb[n] = *(const f32x4*)(conv_b + cb + 32 * bj + 4 * n);
#pragma unroll
                        for (int t = 0; t < 4; ++t) w[t][n] = *(const f32x4*)(conv_w + t * CONVD + cb + 32 * bj + 4 * n); }
#pragma unroll
                    for (int ai = 0; ai < 2; ++ai) {
                        f32x4 pm[2] = {(f32x4){0.f, 0.f, 0.f, 0.f}, (f32x4){0.f, 0.f, 0.f, 0.f}};
#pragma unroll
                        for (int m = 0; m < 4; ++m) {
                            const int r = rowb + ai * HALF + m * 16;
                            unsigned ow[4];
#pragma unroll
                            for (int n = 0; n < 2; ++n) {
                                const f32x4 cur = acc[ai][bj][m][n]; f32x4 v;
#pragma unroll
                                for (int i = 0; i < 4; ++i) {
                                    const float p1 = rowprev<1>(cur[i], pm[n][i]), p2 = rowprev<2>(cur[i], pm[n][i]), p3 = rowprev<3>(cur[i], pm[n][i]);
                                    v[i] = silu_fast(bb[n][i] + w[0][n][i] * p3 + w[1][n][i] * p2 + w[2][n][i] * p1 + w[3][n][i] * cur[i]);
                                }
                                ow[2 * n] = cvt_pk_bf16(v[0], v[1]); ow[2 * n + 1] = cvt_pk_bf16(v[2], v[3]);
                                pm[n] = cur;
                            }
                            *(u32x4*)(dstb + (size_t)r * CONVD + 32 * bj) = (u32x4){ow[0], ow[1], ow[2], ow[3]};
                        }
                    }
                }
            }
        }
    }
};

struct EpiOut {
    static constexpr bool PERM = true, AFTER_DRAIN = false, MIDK = true;
    const float* xp; const float* xs; const PG8_LAS float* rs; float* out;
    __device__ __forceinline__ void mid(f32x4 (&acc)[2][2][4][2], const Unit& u, int ui, int wr, int wc, int fr, int fq) const {
        const PG8_LAS float* rp = rs + ui * 256 + wr * 64 + fr;
#pragma unroll
        for (int ai = 0; ai < 2; ++ai)
#pragma unroll
            for (int m = 0; m < 4; ++m) {
                const float r = rp[ai * HALF + m * 16];
#pragma unroll
                for (int bj = 0; bj < 2; ++bj)
#pragma unroll
                    for (int n = 0; n < 2; ++n) acc[ai][bj][m][n] *= r;
            }
    }
    __device__ __forceinline__ void operator()(const f32x4 (&acc)[2][2][4][2], const Unit& u, int wr, int wc, int fr, int fq) const {
        const int rowb = u.pm * BM + wr * 64 + fr, col = u.pn * BM + wc * 64 + 8 * fq;
#pragma unroll
        for (int ai = 0; ai < 2; ++ai)
#pragma unroll
            for (int m = 0; m < 4; ++m) {
                const int r = rowb + ai * HALF + m * 16;
                if (r >= NROWS) continue;
                const float* xr = (r < NTOK ? xp + (size_t)r * DM : xs + (size_t)(r - NTOK) * DM) + col;
                float* yr = out + (r < NTOK ? O_YP + (size_t)r * DM : O_YS + (size_t)(r - NTOK) * DM) + col;
#pragma unroll
                for (int bj = 0; bj < 2; ++bj) {
                    *(f32x4*)(yr + 32 * bj) = *(const f32x4*)(xr + 32 * bj) + acc[ai][bj][m][0];
                    *(f32x4*)(yr + 32 * bj + 4) = *(const f32x4*)(xr + 32 * bj + 4) + acc[ai][bj][m][1];
                }
            }
    }
};

template <class Epi, class Sched, bool ALIGN_EPI = false, bool SP2 = false>
__device__ __forceinline__ void gemm_phase(PG8_LAS unsigned char* lds, const Gemm g, const Sched& S, const Epi& E) {
    const int tid = threadIdx.x, wid = __builtin_amdgcn_readfirstlane(tid >> 6), lane = tid & 63, wr = wid >> 2, wc = wid & 3, fr = lane & 15, fq = lane >> 4;
    const int K = g.K, nt = K / BK;
    unsigned voffA[2], voffB[2];
#pragma unroll
    for (int i = 0; i < 2; ++i) { int R, C; stage_rc(tid * 16 + i * 8192, R, C); const int Rb = Epi::PERM ? ((R & ~31) + perm32(R & 31)) : R;
        voffA[i] = (unsigned)(R * K + C) * 2u; voffB[i] = (unsigned)(Rb * K + C) * 2u; }
    const size_t kstep = (size_t)(BK * 2);
    const size_t hstep = (size_t)HALF * K * 2;
    const size_t tstep = 2 * hstep;
    const unsigned ldsw = (unsigned)wid * 1024u;
    const int aoff = lds_byte(wr * 64 + fr, fq * 8), boff = lds_byte(wc * 32 + fr, fq * 8);
#define PG8_SA(b, h) (((b) * 2 + (h)) * HTB)
#define PG8_SB(b, h) ((4 + (b) * 2 + (h)) * HTB)
#define PG8_STAGE(bufoff, gbase, voff) do { _Pragma("unroll") for (int _i = 0; _i < 2; ++_i) \
        __builtin_amdgcn_global_load_lds((const unsigned*)((const char*)(gbase) + (voff)[_i]), (PG8_LAS unsigned*)(lds + (bufoff) + ldsw + _i * 8192), 16, 0, 0); } while (0)
#define PG8_LDA(dst, b, h) do { _Pragma("unroll") for (int m = 0; m < 4; ++m) _Pragma("unroll") for (int k = 0; k < 2; ++k) dst[m][k] = *(const PG8_LAS bf16x8*)(lds + PG8_SA(b, h) + aoff + m * 2048 + k * 1024); } while (0)
#define PG8_LDB(dst, b, h) do { _Pragma("unroll") for (int n = 0; n < 2; ++n) _Pragma("unroll") for (int k = 0; k < 2; ++k) dst[n][k] = *(const PG8_LAS bf16x8*)(lds + PG8_SB(b, h) + boff + n * 2048 + k * 1024); } while (0)
#define PG8_MMA(ai, bj, At, Bt) do { __builtin_amdgcn_s_setprio(1); _Pragma("unroll") for (int m = 0; m < 4; ++m) _Pragma("unroll") for (int n = 0; n < 2; ++n) _Pragma("unroll") for (int k = 0; k < 2; ++k) \
        acc[ai][bj][m][n] = __builtin_amdgcn_mfma_f32_16x16x32_bf16(Bt[n][k], At[m][k], acc[ai][bj][m][n], 0, 0, 0); __builtin_amdgcn_s_setprio(0); } while (0)
#define PG8_WAIT_V(n) asm volatile("s_waitcnt vmcnt(" #n ")" ::: "memory")
#define PG8_WAIT_L(n) asm volatile("s_waitcnt lgkmcnt(" #n ")" ::: "memory")
#define PG8_BAR __builtin_amdgcn_s_barrier()
#define PG8_SCHED __builtin_amdgcn_sched_barrier(0)
    Unit cur, nxt; int ui = 0;
    if (!S.next(0, cur)) return;
    f32x4 acc[2][2][4][2];
#pragma unroll
    for (int a = 0; a < 2; ++a)
#pragma unroll
        for (int b = 0; b < 2; ++b)
#pragma unroll
            for (int m = 0; m < 4; ++m)
#pragma unroll
                for (int n = 0; n < 2; ++n) acc[a][b][m][n] = (f32x4){0.f, 0.f, 0.f, 0.f};
    bf16x8 At[4][2], B0[2][2], B1[2][2];
    const char* cA = (const char*)g.A + (size_t)cur.pm * tstep; const char* cB = (const char*)g.Bt + (size_t)cur.pn * tstep;
    S.a_ready(cur);
    if constexpr (SP2) {
        PG8_STAGE(PG8_SB(0, 0), cB, voffB); PG8_STAGE(PG8_SB(0, 1), cB + hstep, voffB); PG8_STAGE(PG8_SA(0, 0), cA, voffA); PG8_STAGE(PG8_SA(0, 1), cA + hstep, voffA);
        if (wr == 1) PG8_BAR;
        PG8_WAIT_V(2); PG8_BAR;
        PG8_STAGE(PG8_SB(1, 0), cB + kstep, voffB); PG8_STAGE(PG8_SA(1, 0), cA + kstep, voffA); PG8_STAGE(PG8_SB(1, 1), cB + hstep + kstep, voffB);
        PG8_WAIT_V(6); PG8_BAR;
    } else {
        PG8_STAGE(PG8_SB(0, 0), cB, voffB); PG8_STAGE(PG8_SA(0, 0), cA, voffA); PG8_STAGE(PG8_SB(0, 1), cB + hstep, voffB); PG8_STAGE(PG8_SA(0, 1), cA + hstep, voffA);
        if (wr == 1) PG8_BAR;
        PG8_WAIT_V(4); PG8_BAR;
        PG8_STAGE(PG8_SB(1, 0), cB + kstep, voffB); PG8_STAGE(PG8_SA(1, 0), cA + kstep, voffA); PG8_STAGE(PG8_SB(1, 1), cB + hstep + kstep, voffB);
        PG8_WAIT_V(6); PG8_BAR;
    }
    for (;;) {
        const bool has_next = S.next(ui + 1, nxt);
        const char* nA = has_next ? (const char*)g.A + (size_t)nxt.pm * tstep : cA; const char* nB = has_next ? (const char*)g.Bt + (size_t)nxt.pn * tstep : cB;
        for (int t = 0; t < nt; t += 2) {
            const bool last = (t == nt - 2);
            if constexpr (Epi::MIDK) { if (t == (nt >> 1)) E.mid(acc, cur, ui, wr, wc, fr, fq); }
            const char* a1 = cA + (size_t)(t + 1) * kstep;
            const char* a2 = last ? nA : cA + (size_t)(t + 2) * kstep; const char* b2 = last ? nB : cB + (size_t)(t + 2) * kstep;
            const char* a3 = a2 + kstep; const char* b3 = b2 + kstep;
            if (last && has_next) S.a_ready(nxt);
            if constexpr (SP2) {
            PG8_LDB(B0, 0, 0); PG8_LDB(B1, 0, 1); PG8_SCHED; PG8_LDA(At, 0, 0); PG8_STAGE(PG8_SA(1, 1), a1 + hstep, voffA);
            PG8_WAIT_V(8); PG8_WAIT_L(0); PG8_BAR; PG8_MMA(0, 0, At, B0); PG8_MMA(0, 1, At, B1); PG8_BAR; PG8_SCHED;
            PG8_LDA(At, 0, 1); PG8_STAGE(PG8_SB(0, 0), b2, voffB); PG8_STAGE(PG8_SB(0, 1), b2 + hstep, voffB); PG8_STAGE(PG8_SA(0, 0), a2, voffA);
            PG8_WAIT_V(8); PG8_WAIT_L(0); PG8_BAR; PG8_MMA(1, 0, At, B0); PG8_MMA(1, 1, At, B1); PG8_BAR; PG8_SCHED;
            PG8_LDB(B0, 1, 0); PG8_LDB(B1, 1, 1); PG8_SCHED; PG8_LDA(At, 1, 0); PG8_STAGE(PG8_SA(0, 1), a2 + hstep, voffA);
            PG8_WAIT_V(8); PG8_WAIT_L(0); PG8_BAR; PG8_MMA(0, 0, At, B0); PG8_MMA(0, 1, At, B1); PG8_BAR; PG8_SCHED;
            PG8_LDA(At, 1, 1); PG8_STAGE(PG8_SB(1, 0), b3, voffB); PG8_STAGE(PG8_SB(1, 1), b3 + hstep, voffB); PG8_STAGE(PG8_SA(1, 0), a3, voffA);
            PG8_WAIT_V(8); PG8_WAIT_L(0); PG8_BAR; PG8_MMA(1, 0, At, B0); PG8_MMA(1, 1, At, B1); PG8_BAR; PG8_SCHED;
            } else {
            PG8_LDB(B0, 0, 0); PG8_SCHED; PG8_LDA(At, 0, 0); PG8_STAGE(PG8_SA(1, 1), a1 + hstep, voffA);
            PG8_WAIT_L(8); PG8_BAR; PG8_WAIT_L(0); PG8_MMA(0, 0, At, B0); PG8_BAR; PG8_SCHED;
            PG8_LDB(B1, 0, 1); PG8_STAGE(PG8_SB(0, 0), b2, voffB);
            PG8_BAR; PG8_WAIT_L(0); PG8_MMA(0, 1, At, B1); PG8_BAR;
            PG8_LDA(At, 0, 1); PG8_STAGE(PG8_SA(0, 0), a2, voffA);
            PG8_BAR; PG8_WAIT_L(0); PG8_MMA(1, 0, At, B0); PG8_BAR; PG8_SCHED;
            PG8_STAGE(PG8_SB(0, 1), b2 + hstep, voffB);
            PG8_WAIT_V(6); PG8_BAR; PG8_MMA(1, 1, At, B1); PG8_BAR;
            PG8_LDB(B0, 1, 0); PG8_SCHED; PG8_LDA(At, 1, 0); PG8_STAGE(PG8_SA(0, 1), a2 + hstep, voffA);
            PG8_WAIT_L(8); PG8_BAR; PG8_WAIT_L(0); PG8_MMA(0, 0, At, B0); PG8_BAR; PG8_SCHED;
            PG8_LDB(B1, 1, 1); PG8_STAGE(PG8_SB(1, 0), b3, voffB);
            PG8_BAR; PG8_WAIT_L(0); PG8_MMA(0, 1, At, B1); PG8_BAR;
            PG8_LDA(At, 1, 1); PG8_STAGE(PG8_SA(1, 0), a3, voffA);
            PG8_BAR; PG8_WAIT_L(0); PG8_MMA(1, 0, At, B0); PG8_BAR; PG8_SCHED;
            PG8_STAGE(PG8_SB(1, 1), b3 + hstep, voffB);
            PG8_WAIT_V(6); PG8_BAR; PG8_MMA(1, 1, At, B1); PG8_BAR;
            }
        }
        if constexpr (ALIGN_EPI) { if (wr == 0) PG8_BAR; }
        if constexpr (!Epi::AFTER_DRAIN) { E(acc, cur, wr, wc, fr, fq); S.done(cur); }
        if (!has_next) break;
#pragma unroll
        for (int a = 0; a < 2; ++a)
#pragma unroll
            for (int b = 0; b < 2; ++b)
#pragma unroll
                for (int m = 0; m < 4; ++m)
#pragma unroll
                    for (int n = 0; n < 2; ++n) acc[a][b][m][n] = (f32x4){0.f, 0.f, 0.f, 0.f};
        cur = nxt; cA = nA; cB = nB; ++ui;
        if constexpr (ALIGN_EPI) { if (wr == 1) PG8_BAR; }
    }
    PG8_WAIT_V(0);
    if constexpr (!ALIGN_EPI) { if (wr == 0) PG8_BAR; }
    PG8_BAR;
    if constexpr (Epi::AFTER_DRAIN) { E.fused(acc, cur, wr, wc, fr, fq, lds, wid, lane); S.done(cur); }
#undef PG8_SA
#undef PG8_SB
#undef PG8_STAGE
#undef PG8_LDA
#undef PG8_LDB
#undef PG8_MMA
#undef PG8_WAIT_V
#undef PG8_WAIT_L
#undef PG8_BAR
#undef PG8_SCHED
}
}
#define GAS __attribute__((address_space(1)))
#define LAS __attribute__((address_space(3)))
typedef unsigned v4u __attribute__((ext_vector_type(4)));
typedef float f32x4 __attribute__((ext_vector_type(4)));
typedef short bf16x8 __attribute__((ext_vector_type(8)));
typedef GAS unsigned gu32;
typedef GAS unsigned long long gu64;
#define RLX_AGENT __ATOMIC_RELAXED, __HIP_MEMORY_SCOPE_AGENT
#define LDS_WAIT() asm volatile("s_waitcnt lgkmcnt(0)" ::: "memory")
#define VM_WAIT() asm volatile("s_waitcnt vmcnt(0)" ::: "memory")
__device__ __forceinline__ unsigned long long rt() { return __builtin_amdgcn_s_memrealtime(); }

#define XB_TMO      128
#define XB_XCNT(j)  (256  + 64 * (j))
#define XB_XSUB(j)  (1280 + 64 * (j))
#define XB_XGEN(j)  (2304 + 64 * (j))
#define XB_TOP      3328
#define XB_TOPGEN   3392
#define XCD_BAR_WORDS 3456
#define XB_SPIN_CAP (1u << 18)

__device__ __forceinline__ unsigned xb_ld(unsigned* p)              { return __hip_atomic_load(p, __ATOMIC_RELAXED, __HIP_MEMORY_SCOPE_AGENT); }
__device__ __forceinline__ unsigned xb_add(unsigned* p, unsigned v) { return __hip_atomic_fetch_add(p, v, __ATOMIC_RELAXED, __HIP_MEMORY_SCOPE_AGENT); }
__device__ __forceinline__ unsigned xb_xcc_id() { return (unsigned)__builtin_amdgcn_s_getreg((3 << 11) | 20) & 0xFu; }
#define XB_SPIN(cond, bar) do { unsigned _sp = 0; while (cond) { __builtin_amdgcn_s_sleep(1); \
    if ((++_sp & 255u) == 0u) { if (xb_ld(&(bar)[XB_TMO])) break; if (_sp > XB_SPIN_CAP) { atomicAdd(&(bar)[XB_TMO], 1u); break; } } } } while (0)

struct XcdBarrier {
    unsigned* bar; unsigned x;
    volatile LAS unsigned* st;
};

__device__ __forceinline__ XcdBarrier xcd_barrier_post(unsigned* bar, volatile LAS unsigned* st) {
    XcdBarrier b; b.bar = bar; b.x = xb_xcc_id(); b.st = st;
    if (threadIdx.x == 0) (void)xb_add(&bar[XB_XCNT(b.x)], 1u);
    return b;
}
__device__ __forceinline__ void xcd_barrier_complete(unsigned* bar, unsigned x, unsigned& nloc, unsigned& nx) {
    const unsigned G = gridDim.x * gridDim.y * gridDim.z;
    unsigned sum, cnt, mine, sp = 0u;
    for (;;) {
        sum = 0u; cnt = 0u; mine = 0u;
#pragma unroll
        for (unsigned j = 0; j < 16; ++j) { const unsigned c = xb_ld(&bar[XB_XCNT(j)]); sum += c; cnt += (c > 0u) ? 1u : 0u; mine = (j == x) ? c : mine; }
        if (sum == G) break;
        __builtin_amdgcn_s_sleep(1);
        if ((++sp & 255u) == 0u) { if (xb_ld(&bar[XB_TMO])) break; if (sp > XB_SPIN_CAP) { atomicAdd(&bar[XB_TMO], 1u); break; } }
    }
    nloc = mine > 0u ? mine : 1u; nx = cnt > 0u ? cnt : 1u;
}

__device__ __forceinline__ void xcd_barrier(const XcdBarrier& b) {
    asm volatile("s_waitcnt vmcnt(0)" ::: "memory");
    __syncthreads();
    if (threadIdx.x == 0) {
        unsigned* bar = b.bar;
        __builtin_amdgcn_s_waitcnt(0);
        unsigned nloc = b.st[0], nx = b.st[1];
        if (nloc == 0u) { xcd_barrier_complete(bar, b.x, nloc, nx); b.st[0] = nloc; b.st[1] = nx; }
        const unsigned old = xb_add(&bar[XB_XSUB(b.x)], 1u);
        const unsigned gen = old / nloc;
        if (old + 1u == (gen + 1u) * nloc) {
            __builtin_amdgcn_fence(__ATOMIC_RELEASE, "agent");
            asm volatile("s_waitcnt vmcnt(0)" ::: "memory");
            const unsigned og = xb_add(&bar[XB_TOP], 1u);
            const unsigned tg = og / nx;
            if (og + 1u == (tg + 1u) * nx) xb_add(&bar[XB_TOPGEN], 1u);
            else XB_SPIN(xb_ld(&bar[XB_TOPGEN]) == tg, bar);
            __builtin_amdgcn_fence(__ATOMIC_ACQUIRE, "agent");
            xb_add(&bar[XB_XGEN(b.x)], 1u);
            asm volatile("s_waitcnt vmcnt(0)" ::: "memory");
        } else {
            XB_SPIN(xb_ld(&bar[XB_XGEN(b.x)]) == gen, bar);
            __builtin_amdgcn_fence(__ATOMIC_ACQUIRE, "agent");
            asm volatile("s_waitcnt vmcnt(0)" ::: "memory");
        }
    }
    __syncthreads();
}

constexpr int NWAVES = 8;
constexpr int RING_OFF = 0, RING_BYTES = 131072;
constexpr int LDS_BYTES = 163840;
constexpr int LDSCTL_OFF = LDS_BYTES - 512, MISC_OFF = LDSCTL_OFF + 320;
constexpr int CW_BAR = 4096;
constexpr int CW_Q = 16384;
static_assert((CW_BAR + XCD_BAR_WORDS) <= CW_Q && (CW_Q + 64 * 64) * 4 <= (int)CTL_ZERO_BYTES, "CTL words inside the memset region");

constexpr int PROBE_ID = 0;
#define PB_BEGIN(id) long long pb_t0_##id = 0; if (PROBE_ID == (id)) pb_t0_##id = clock64();
#define PB_END(id) if (PROBE_ID == (id)) { const long long t1_ = clock64(), dt_ = t1_ - pb_t0_##id; while (clock64() - t1_ < dt_) __builtin_amdgcn_s_sleep(2); }
struct Frame {
    LAS unsigned char* lds;
    volatile LAS unsigned* MISC;
    gu32* ctl;
    int tid, lane, wave, vcu, G;
    Ins I; float* out;
    bf16 *WinT, *WoutT, *XN, *Q, *K, *V, *AU, *XBC, *Gb, *Zb; float *DT, *SSQ, *RAWB;
};

template <class SrcF>
__device__ __forceinline__ void p0_transpose_item(SrcF src, int k0, int n0, bf16* WT, int dst_pitch, int dst_row0, int dst_k0, LAS float* scr, int lane) {
#pragma unroll 8
    for (int i = 0; i < 32; ++i) { const int kk = 2 * i + (lane >> 5); scr[kk * 33 + (lane & 31)] = src(k0 + kk, n0 + (lane & 31)); }
    LDS_WAIT(); asm volatile("" ::: "memory");
    const int c = lane & 7;
#pragma unroll
    for (int j = 0; j < 4; ++j) { const int n = (lane >> 3) + 8 * j; const LAS float* s = scr + (8 * c) * 33 + n;
        v4u o; o.x = pk2(s[0 * 33], s[1 * 33]); o.y = pk2(s[2 * 33], s[3 * 33]); o.z = pk2(s[4 * 33], s[5 * 33]); o.w = pk2(s[6 * 33], s[7 * 33]);
        *(GAS v4u*)(WT + (size_t)(dst_row0 + n) * dst_pitch + dst_k0 + 8 * c) = o; }
    LDS_WAIT(); asm volatile("" ::: "memory");
}
constexpr int P0_SCR_BYTES = 8448, WDT_OFF = NWAVES * P0_SCR_BYTES, WDT_PITCH = 20;
static_assert(WDT_OFF + 1024 * WDT_PITCH * 4 <= LDSCTL_OFF, "prologue LDS");

__device__ __forceinline__ void p0_prologue(Frame& F) {
    const Ins& I = F.I;
    LAS float* scr = (LAS float*)(F.lds + F.wave * P0_SCR_BYTES);
    LAS float* wdt = (LAS float*)(F.lds + WDT_OFF);
    const int gw = F.vcu * NWAVES + F.wave, NGW = F.G * NWAVES;
    for (int idx = F.tid; idx < 1024 * 16; idx += NWAVES * 64) {
        const int k = idx >> 4, j = idx & 15, pos = (((k >> 8) * 4 + (k & 3)) << 6) + ((k >> 2) & 63);
        wdt[pos * WDT_PITCH + j] = I.w_in[(size_t)k * NPROJ + C_DT + j] * I.norm_w[k];
    }
    constexpr int I_IN = (DM / 64) * (NMAIN / 32), I_OUT = (2048 / 64) * (DM / 32);
    for (int it = gw; it < I_IN + I_OUT; it += NGW) {
        if (it < I_IN) {
            const int nblk = NMAIN / 32, kb = it / nblk, nb = it % nblk, k0 = 64 * kb, n0 = 32 * nb;
            p0_transpose_item([&](int k, int n) { return I.w_in[(size_t)k * NPROJ + n] * I.norm_w[k]; }, k0, n0, F.WinT, DM, (n0 & ~255) + vrow_of_col(n0 & 255), k0, scr, F.lane);
        } else {
            const int r = it - I_IN, nblk = DM / 32, kb = r / nblk, nb = r % nblk, k0 = 64 * kb, n0 = 32 * nb;
            p0_transpose_item([&](int k, int n) { return I.w_out[(size_t)k * DM + n] * (k >= 1024 ? I.ssd_norm_w[k - 1024] : 1.f); }, k0, n0, F.WoutT, 2048, (n0 & ~255) + vrow_of_col(n0 & 255), (k0 + 1024) & 2047, scr, F.lane);
        }
    }
    __syncthreads();
    for (int rp = gw; rp < NROWS / 2; rp += NGW) {
        f32x4 v[2][4]; float rstd[2];
#pragma unroll
        for (int q = 0; q < 2; ++q) {
            const GAS f32x4* xr = (const GAS f32x4*)xrow(I, 2 * rp + q) + F.lane; float s = 0.f;
#pragma unroll
            for (int j = 0; j < 4; ++j) { v[q][j] = xr[64 * j]; s += (v[q][j].x * v[q][j].x + v[q][j].y * v[q][j].y) + (v[q][j].z * v[q][j].z + v[q][j].w * v[q][j].w); }
            rstd[q] = rsqrtf(wave_sum(s) * (1.f / DM) + EPS);
            GAS unsigned long long* o8 = (GAS unsigned long long*)(F.XN + (size_t)(2 * rp + q) * DM) + F.lane;
#pragma unroll
            for (int j = 0; j < 4; ++j) o8[64 * j] = (unsigned long long)pk2(v[q][j].x * rstd[q], v[q][j].y * rstd[q]) | ((unsigned long long)pk2(v[q][j].z * rstd[q], v[q][j].w * rstd[q]) << 32);
        }
        float a[32];
#pragma unroll
        for (int i = 0; i < 32; ++i) a[i] = 0.f;
#pragma unroll
        for (int j = 0; j < 4; ++j)
#pragma unroll
            for (int e = 0; e < 4; ++e) {
                const LAS f32x4* wp = (const LAS f32x4*)(wdt + ((j * 4 + e) * 64 + F.lane) * WDT_PITCH);
                const float x0 = v[0][j][e], x1 = v[1][j][e];
#pragma unroll
                for (int c4 = 0; c4 < 4; ++c4) { const f32x4 w = wp[c4];
#pragma unroll
                    for (int i = 0; i < 4; ++i) { a[c4 * 4 + i] += x0 * w[i]; a[16 + c4 * 4 + i] += x1 * w[i]; } }
                asm volatile("" ::: "memory");
            }
#define P0_HALVE(N, X) { const bool up = (F.lane & (X)) != 0; _Pragma("unroll") for (int i = 0; i < (N); ++i) { const float keep = up ? a[i + (N)] : a[i], send = up ? a[i] : a[i + (N)]; a[i] = keep + __shfl_xor(send, (X)); } }
        P0_HALVE(16, 32) P0_HALVE(8, 16) P0_HALVE(4, 8) P0_HALVE(2, 4) P0_HALVE(1, 2)
#undef P0_HALVE
        float tot = a[0] + __shfl_xor(a[0], 1);
        const int idx = F.lane >> 1, q = idx >> 4, c = idx & 15;
        tot = tot * (q ? rstd[1] : rstd[0]) + I.dt_bias[c];
        if ((F.lane & 1) == 0) F.DT[(size_t)c * MROWS + 2 * rp + q] = softplus_f(tot);
    }
    { v4u* zk = (v4u*)((unsigned char*)F.K - 4 * MiB); v4u* zv = (v4u*)((unsigned char*)F.V - 4 * MiB);
      for (size_t i = (size_t)F.vcu * NWAVES * 64 + F.tid; i < 4 * MiB / 16; i += (size_t)F.G * NWAVES * 64) {
          if (i * 16 >= 4 * MiB - (WS_K - (WS_Q + (size_t)MROWS * DM * 2))) zk[i] = (v4u){0u, 0u, 0u, 0u};
          if (i * 16 >= 4 * MiB - (WS_V - (WS_K + (size_t)MROWS * DM * 2))) zv[i] = (v4u){0u, 0u, 0u, 0u}; } }
    for (int r = NROWS + gw; r < MROWS; r += NGW) { GAS v4u* o = (GAS v4u*)(F.XN + (size_t)r * DM) + F.lane; o[0] = (v4u){0u, 0u, 0u, 0u}; o[64] = (v4u){0u, 0u, 0u, 0u};
                                                   GAS v4u* k = (GAS v4u*)(F.K + (size_t)r * DM) + F.lane; k[0] = (v4u){0u, 0u, 0u, 0u}; k[64] = (v4u){0u, 0u, 0u, 0u}; }
    for (int i = (F.vcu * NWAVES * 64 + F.tid); i < DB * 2 * CONVD; i += F.G * NWAVES * 64) {
        const int c = i % CONVD, rr = i / CONVD, j = rr & 1, b = rr >> 1;
        F.out[O_CS + ((size_t)b * 3 + j) * CONVD + c] = I.sconv[((size_t)b * 3 + j + 1) * CONVD + c];
    }
}

namespace att {
typedef float f32x16 __attribute__((ext_vector_type(16)));
typedef short v4i16_t __attribute__((ext_vector_type(4)));
typedef unsigned u32x4 __attribute__((ext_vector_type(4)));
constexpr int SPAN = 512, NSPAN = SEQ / SPAN, NUNITS = NB * NH * NSPAN;
constexpr int OPITCH = 64  , OACC_OFF = 0, LACC_OFF = SPAN * OPITCH * 4, LUT_OFF = LACC_OFF + 2048, VST_OFF = LUT_OFF + 2048, VST_BYTES = 2048  , ATT_LDS_END = VST_OFF + NWAVES * VST_BYTES;
static_assert(ATT_LDS_END <= LDSCTL_OFF, "attention LDS");
__device__ __forceinline__ int crow(int r, int hi) { return (r & 3) + 8 * (r >> 2) + 4 * hi; }

struct ItemRegs { bf16x8 qf[4]; v4u kreg[4], vreg[4]; unsigned koff, voff; };
struct ItemOut { f32x16 o0, o1; float lsum; };
#define ATT_LOAD_K(R, KT) do { const char* kb_ = (const char*)Kb + ((long)(tq0 + (-128 + 32 * (KT)) * d) * DM) * 2; \
        _Pragma("unroll") for (int i = 0; i < 4; ++i) (R).kreg[i] = *(const v4u*)(kb_ + (R).koff + 32 * i); } while (0)
#define ATT_LOAD_V(R, KT) do { const char* vb_ = (const char*)Vb + ((long)(tq0 + (-128 + 32 * (KT)) * d) * DM) * 2; \
        _Pragma("unroll") for (int i = 0; i < 4; ++i) (R).vreg[i] = *(const v4u*)(vb_ + (R).voff + (unsigned)(i * 8 * d * DM * 2)); } while (0)
template <int NQ>
__device__ __forceinline__ void item_load(ItemRegs& R, const bf16* Qb, const bf16* Kb, const bf16* Vb, int tq0, int d, int lane) {
    const int c = lane & 31, hi = lane >> 5;
    const bf16* qp = Qb + (size_t)(tq0 + (NQ == 32 ? c : (c & 15)) * d) * DM + 8 * hi;
#pragma unroll
    for (int ks = 0; ks < 4; ++ks) R.qf[ks] = *(const bf16x8*)(qp + 16 * ks);
    R.koff = (unsigned)((c * d * DM + 8 * hi) * 2); R.voff = (unsigned)(((lane >> 3) * d * DM + 8 * (lane & 7)) * 2);
    ATT_LOAD_K(R, 0); ATT_LOAD_V(R, 0);
}
template <int NQ>
__device__ __forceinline__ void item_tiles(ItemRegs& R, ItemOut& O, const bf16* Kb, const bf16* Vb, int tq0, int d, int pat, LAS unsigned char* lds, int wave, int lane) {
    const int c = lane & 31, hi = lane >> 5;
    LAS unsigned char* vst = lds + VST_OFF + wave * VST_BYTES;
    const LAS float* lut = (const LAS float*)(lds + LUT_OFF) + pat * 129;
    f32x16 o0 = {}, o1 = {};
    float lsum = 0.f;
    const int lrow = lane >> 3, lch = lane & 7;
    const int stoff = lrow * 128 + ((lch ^ lrow) << 4);
    const int q4 = (lane & 15) >> 2, odd = (lane >> 4) & 1, p4 = lane & 3;
#pragma unroll 1
    for (int kt = 0; kt < 5; ++kt) {
        bf16x8 vb[2][2];
#pragma unroll
        for (int s = 0; s < 2; ++s) {
#pragma unroll
            for (int i = 0; i < 2; ++i) *(LAS v4u*)(vst + i * 1024 + stoff) = R.vreg[2 * s + i];
#pragma unroll
            for (int dh = 0; dh < 2; ++dh) {
                const int kr = 4 * hi + q4, ch16 = 4 * dh + 2 * odd + (p4 >> 1);
                const LAS unsigned char* vp0 = vst + kr * 128 + ((ch16 ^ (kr & 7)) << 4) + (p4 & 1) * 8;
                const LAS unsigned char* vp1 = vst + (kr + 8) * 128 + ((ch16 ^ (kr & 7)) << 4) + (p4 & 1) * 8;
                const v4i16_t lo = __builtin_amdgcn_ds_read_tr16_b64_v4i16((LAS v4i16_t*)vp0), hh = __builtin_amdgcn_ds_read_tr16_b64_v4i16((LAS v4i16_t*)vp1);
                vb[s][dh] = (bf16x8){lo[0], lo[1], lo[2], lo[3], hh[0], hh[1], hh[2], hh[3]};
            }
        }
        bf16x8 kf[4];
#pragma unroll
        for (int ks = 0; ks < 4; ++ks) kf[ks] = __builtin_bit_cast(bf16x8, R.kreg[ks]);
        asm volatile("" ::: "memory");
        if (kt < 4) { ATT_LOAD_K(R, kt + 1); ATT_LOAD_V(R, kt + 1); }
        const int relb = c + 128 - 32 * kt - 4 * hi, tkb = tq0 + (-128 + 32 * kt + 4 * hi) * d;
        const bool edge = (kt == 0 || kt == 4 || tkb < 0);
        f32x16 st;
        if (edge) {
#pragma unroll
            for (int r = 0; r < 16; ++r) { const int rel = relb - ((r & 3) + 8 * (r >> 2)); st[r] = lut[rel < 0 ? 0 : (rel > 128 ? 128 : rel)]; }
        } else {
#pragma unroll
            for (int r = 0; r < 16; ++r) st[r] = lut[relb - ((r & 3) + 8 * (r >> 2))];
        }
#pragma unroll
        for (int ks = 0; ks < 4; ++ks) st = __builtin_amdgcn_mfma_f32_32x32x16_bf16(kf[ks], R.qf[ks], st, 0, 0, 0);
        if (edge) {
#pragma unroll
            for (int r = 0; r < 16; ++r) {
                const int kk = (r & 3) + 8 * (r >> 2), rel = relb - kk;
                const bool valid = (rel >= 0) && (rel <= 128) && (tkb + kk * d >= 0);
                const float pe = __builtin_amdgcn_exp2f(st[r]), p = valid ? pe : 0.f;
                st[r] = p; lsum += p;
            }
        } else {
#pragma unroll
            for (int r = 0; r < 16; ++r) { const float p = __builtin_amdgcn_exp2f(st[r]); st[r] = p; lsum += p; }
        }
        u32x4 pw0, pw1;
        pw0.x = pg8::cvt_pk_bf16(st[0], st[1]); pw0.y = pg8::cvt_pk_bf16(st[2], st[3]); pw0.z = pg8::cvt_pk_bf16(st[4], st[5]); pw0.w = pg8::cvt_pk_bf16(st[6], st[7]);
        pw1.x = pg8::cvt_pk_bf16(st[8], st[9]); pw1.y = pg8::cvt_pk_bf16(st[10], st[11]); pw1.z = pg8::cvt_pk_bf16(st[12], st[13]); pw1.w = pg8::cvt_pk_bf16(st[14], st[15]);
        const bf16x8 pa0 = __builtin_bit_cast(bf16x8, pw0), pa1 = __builtin_bit_cast(bf16x8, pw1);
        o0 = __builtin_amdgcn_mfma_f32_32x32x16_bf16(pa0, vb[0][0], o0, 0, 0, 0);
        o1 = __builtin_amdgcn_mfma_f32_32x32x16_bf16(pa0, vb[0][1], o1, 0, 0, 0);
        o0 = __builtin_amdgcn_mfma_f32_32x32x16_bf16(pa1, vb[1][0], o0, 0, 0, 0);
        o1 = __builtin_amdgcn_mfma_f32_32x32x16_bf16(pa1, vb[1][1], o1, 0, 0, 0);
    }
    lsum += __shfl_xor(lsum, 32);
    O.o0 = o0; O.o1 = o1; O.lsum = lsum;
}
template <int NQ, bool ACC>
__device__ __forceinline__ void item_acc(const ItemOut& O, int toff, int d, LAS unsigned char* lds, int lane) {
    const int c = lane & 31, hi = lane >> 5;
    LAS float* oacc = (LAS float*)(lds + OACC_OFF); LAS float* lacc = (LAS float*)(lds + LACC_OFF);
    constexpr int NR = NQ == 32 ? 16 : 8;
    LAS float* base = oacc + (toff + 4 * hi * d) * OPITCH + c;
    float a0[NR], a1[NR], lo = 0.f;
    if (ACC) {
#pragma unroll
        for (int r = 0; r < NR; ++r) { const LAS float* row = base + ((r & 3) + 8 * (r >> 2)) * d * OPITCH; a0[r] = row[0]; a1[r] = row[32]; }
        if (hi == 0 && c < NQ) lo = lacc[toff + c * d];
        asm volatile("" ::: "memory");
    }
#pragma unroll
    for (int r = 0; r < NR; ++r) { LAS float* row = base + ((r & 3) + 8 * (r >> 2)) * d * OPITCH; row[0] = ACC ? a0[r] + O.o0[r] : O.o0[r]; row[32] = ACC ? a1[r] + O.o1[r] : O.o1[r]; }
    if (hi == 0 && c < NQ) lacc[toff + c * d] = ACC ? lo + O.lsum : O.lsum;
}

__device__ __forceinline__ void unit(Frame& F, int uidx) {
    const int span = uidx % NSPAN, bh = uidx / NSPAN, h = bh % NH, b = bh / NH, t0 = span * SPAN;
    LAS unsigned char* lds = F.lds;
    LAS float* oacc = (LAS float*)(lds + OACC_OFF); LAS float* lacc = (LAS float*)(lds + LACC_OFF); LAS float* lut = (LAS float*)(lds + LUT_OFF);
    if (F.tid < 387) { const int pat = F.tid / 129, rel = F.tid - pat * 129, d = pat == 0 ? 1 : (pat == 1 ? 4 : 16); lut[F.tid] = F.I.rel_bias[t5_bucket(rel * d) * NH + h] * LOG2E; }
    const size_t boff = (size_t)b * SEQ * DM + h * HD;
    const bf16 *Qb = F.Q + boff, *Kb = F.K + boff, *Vb = F.V + boff;
    const int w = F.wave, lane = F.lane;
    ItemRegs R; ItemOut O;
    const int tqA0 = t0 + 64 * w, tqA1 = tqA0 + 32, tqB0 = t0 + (w & 3) + 256 * (w >> 2), tqB1 = tqB0 + 128, tqC0 = t0 + w, tqC1 = t0 + w + 8;
    item_load<32>(R, Qb, Kb, Vb, tqA0, 1, lane);
    __syncthreads();
    item_tiles<32>(R, O, Kb, Vb, tqA0, 1, 0, lds, w, lane);
    item_load<32>(R, Qb, Kb, Vb, tqA1, 1, lane);
    item_acc<32, false>(O, tqA0 - t0, 1, lds, lane);
    item_tiles<32>(R, O, Kb, Vb, tqA1, 1, 0, lds, w, lane);
    item_load<32>(R, Qb, Kb, Vb, tqB0, 4, lane);
    item_acc<32, false>(O, tqA1 - t0, 1, lds, lane);
    __syncthreads();
    item_tiles<32>(R, O, Kb, Vb, tqB0, 4, 1, lds, w, lane);
    item_load<32>(R, Qb, Kb, Vb, tqB1, 4, lane);
    item_acc<32, true>(O, tqB0 - t0, 4, lds, lane);
    item_tiles<32>(R, O, Kb, Vb, tqB1, 4, 1, lds, w, lane);
    item_load<32>(R, Qb, Kb, Vb, tqC0, 16, lane);
    item_acc<32, true>(O, tqB1 - t0, 4, lds, lane);
    __syncthreads();
    item_tiles<32>(R, O, Kb, Vb, tqC0, 16, 2, lds, w, lane);
    item_load<32>(R, Qb, Kb, Vb, tqC1, 16, lane);
    item_acc<32, true>(O, tqC0 - t0, 16, lds, lane);
    item_tiles<32>(R, O, Kb, Vb, tqC1, 16, 2, lds, w, lane);
    item_acc<32, true>(O, tqC1 - t0, 16, lds, lane);
    __syncthreads();
#pragma unroll 1
    for (int ps = 0; ps < 2; ++ps) {
        const int tl = 64 * w + 32 * ps + (lane >> 1), hf = lane & 1;
        const bf16* gp = F.Gb + ((size_t)b * SEQ + t0 + tl) * DM + h * HD + 32 * hf;
        bf16* ap = F.AU + ((size_t)b * SEQ + t0 + tl) * 2048 + 1024 + h * HD + 32 * hf;
        v4u g[4];
#pragma unroll
        for (int j4 = 0; j4 < 4; ++j4) g[j4] = *(const v4u*)(gp + 8 * j4);
        const float rl = __builtin_amdgcn_rcpf(lacc[tl]);
        const LAS f32x4* op = (const LAS f32x4*)(oacc + tl * OPITCH + 32 * hf);
#pragma unroll
        for (int j4 = 0; j4 < 4; ++j4) {
            const f32x4 a = op[2 * j4], bq = op[2 * j4 + 1]; const v4u gg = g[j4];
            v4u o;
            o.x = pk2(a[0] * rl * __uint_as_float(gg.x << 16), a[1] * rl * __uint_as_float(gg.x & 0xffff0000u));
            o.y = pk2(a[2] * rl * __uint_as_float(gg.y << 16), a[3] * rl * __uint_as_float(gg.y & 0xffff0000u));
            o.z = pk2(bq[0] * rl * __uint_as_float(gg.z << 16), bq[1] * rl * __uint_as_float(gg.z & 0xffff0000u));
            o.w = pk2(bq[2] * rl * __uint_as_float(gg.w << 16), bq[3] * rl * __uint_as_float(gg.w & 0xffff0000u));
            *(v4u*)(ap + 8 * j4) = o;
        }
    }
    __syncthreads();
}

}

namespace ssd {
typedef float f32x16 __attribute__((ext_vector_type(16)));
typedef short v4i16_t __attribute__((ext_vector_type(4)));
typedef unsigned u32x2 __attribute__((ext_vector_type(2)));
typedef float f32x2v __attribute__((ext_vector_type(2)));
constexpr int PITCH = 272;
constexpr int BT_OFF = 0, CT_OFF = 34816, G_OFF = 69632, HB_OFF = 104448, XD_OFF = 121856, XH_OFF = 138240, ACS_OFF = 154624, DTL_OFF = ACS_OFF + 512, SSQL_OFF = DTL_OFF + 512  , XW_OFF = SSQL_OFF + 1024  , FW_OFF = XW_OFF + 1280  , SSD_LDS_END = FW_OFF + 5120;
static_assert(SSD_LDS_END <= LDSCTL_OFF, "SSD LDS");
__device__ __forceinline__ int crow(int r, int hi) { return (r & 3) + 8 * (r >> 2) + 4 * hi; }
__device__ __forceinline__ bf16x8 trfrag(const LAS unsigned char* p0, const LAS unsigned char* p1) {
    const v4i16_t lo = __builtin_amdgcn_ds_read_tr16_b64_v4i16((LAS v4i16_t*)p0), hh = __builtin_amdgcn_ds_read_tr16_b64_v4i16((LAS v4i16_t*)p1);
    return (bf16x8){lo[0], lo[1], lo[2], lo[3], hh[0], hh[1], hh[2], hh[3]};
}
__device__ __forceinline__ float bflo(unsigned w) { return __uint_as_float(w << 16); }
__device__ __forceinline__ float bfhi(unsigned w) { return __uint_as_float(w & 0xffff0000u); }

__device__ __forceinline__ void chain(Frame& F, int item) {
    const Ins& I = F.I;
    const int b = item >> 5, hd = (item >> 1) & 15, seg = item & 1, grp = hd >> 3;
    constexpr int NCH = SEQ / 128, HALF_CH = NCH / 2; const int ch_end = seg ? NCH : HALF_CH;
    const int tid = F.tid, lane = F.lane, w = F.wave, c = lane & 31, hi = lane >> 5;
    LAS unsigned char* lds = F.lds;
    LAS float* acs = (LAS float*)(lds + ACS_OFF); LAS float* dtl = (LAS float*)(lds + DTL_OFF); LAS float* ssql = (LAS float*)(lds + SSQL_OFF);
    const float A = -__expf(I.a_log[hd]), dsk = I.d_skip[hd];
    const size_t row0 = (size_t)b * SEQ;
    for (int i = tid; i < 17408 / 16; i += NWAVES * 64) ((LAS v4u*)(lds + HB_OFF))[i] = (v4u){0u, 0u, 0u, 0u};
    f32x16 hacc = {};
    const int pt = w & 1, jt = w >> 1;
    const int q4 = (lane & 15) >> 2, odd = (lane >> 4) & 1, p4 = lane & 3;
    const int xtr = (8 * hi + q4) * 64 + (16 * odd + 4 * p4) * 2;
    const int xg = tid & 15, xr0 = (tid >> 4) * 4;
    const int fb = tid >> 8, fc = tid & 255;
    for (int i = tid; i < 5 * 64 + 5 * 256; i += NWAVES * 64) {
        if (i < 320) { const int t = i >> 6, e = i & 63; ((LAS float*)(lds + XW_OFF))[i] = t < 4 ? I.conv_w[t * CONVD + hd * 64 + e] : I.conv_b[hd * 64 + e]; }
        else { const int k = i - 320, t = k >> 8, e = k & 255, chn = 1024 + (e < 128 ? grp * 128 + e : 256 + grp * 128 + (e - 128)); ((LAS float*)(lds + FW_OFF))[k] = t < 4 ? I.conv_w[t * CONVD + chn] : I.conv_b[chn]; }
    }
    const int xoff = ((xg >> 3) << 10) + (xg & 7) * 8;
    float dtp0, dtp1; u32x2 xr[7]; v4u bcr[8]; float fxr[6]; u32x2 zr[4];
#define SSD_PREFETCH(T0) do { int t0_ = (T0), tv_ = tid, lv_ = lane; asm volatile("" : "+v"(t0_), "+v"(tv_), "+v"(lv_)); \
        const int xg_ = tv_ & 15, xr0_ = (tv_ >> 4) * 4, fb_ = tv_ >> 8, fc_ = tv_ & 255, fch_ = fc_ < 128 ? grp * 128 + fc_ : 256 + grp * 128 + (fc_ - 128); \
        { const float* dp_ = F.DT + (size_t)hd * MROWS + row0 + t0_ + 2 * lv_; dtp0 = dp_[0]; dtp1 = dp_[1]; } \
        { const bf16* xp_ = F.XBC + (row0 + t0_ + xr0_) * CONVD + hd * 64 + 4 * xg_; \
          _Pragma("unroll") for (int j = 0; j < 7; ++j) xr[j] = (t0_ + xr0_ - 3 + j) >= 0 ? *(const u32x2*)(xp_ + (j - 3) * CONVD) : (u32x2){0u, 0u}; } \
        { const bf16* bp_ = F.XBC + (row0 + t0_ + (tv_ >> 4)) * CONVD + 1024 + grp * 128 + 8 * (tv_ & 15); \
          _Pragma("unroll") for (int k = 0; k < 4; ++k) { bcr[k] = *(const v4u*)(bp_ + (size_t)k * 32 * CONVD); bcr[4 + k] = *(const v4u*)(bp_ + (size_t)k * 32 * CONVD + 256); } } \
        { const size_t blk = (row0 + t0_ + 64 * fb_) >> 6; const bool hasprev = (t0_ + 64 * fb_) > 0; const float* rp_ = F.RAWB + (blk * 6) * 512 + fch_; \
          _Pragma("unroll") for (int j = 0; j < 3; ++j) { fxr[j] = hasprev ? rp_[(j - 6) * 512] : 0.f; fxr[3 + j] = rp_[(3 + j) * 512]; } } \
    } while (0)
#define SSD_PREFETCH_Z(T0) do { int t0_ = (T0), lv_ = lane; asm volatile("" : "+v"(t0_), "+v"(lv_)); \
        const bf16* zp_ = F.Zb + (row0 + t0_ + 32 * jt + (lv_ & 31)) * DM + hd * 64 + 32 * pt + 4 * (lv_ >> 5); \
        _Pragma("unroll") for (int g4 = 0; g4 < 4; ++g4) zr[g4] = *(const u32x2*)(zp_ + 8 * g4); } while (0)
    SSD_PREFETCH(0); if (!seg) SSD_PREFETCH_Z(0);
    __syncthreads();
#pragma unroll 1
    for (int ch = 0; ch < ch_end; ++ch) {
        const int t0 = ch * 128;
        const bool pre = seg && ch < HALF_CH, prevfull = ch > 0 && !(seg && ch - 1 < HALF_CH);
        float aend;
        {
            if (w < 2 && prevfull) { F.SSQ[(row0 + t0 - 128 + lane) * 32 + 2 * hd + w] = ssql[128 * w + lane]; F.SSQ[(row0 + t0 - 64 + lane) * 32 + 2 * hd + w] = ssql[128 * w + 64 + lane]; }
            const float v0 = dtp0 * A, v1 = dtp1 * A; float s = v0 + v1;
#define SSD_DPP_ADD(CTRL, RMASK, BC) s += __builtin_bit_cast(float, __builtin_amdgcn_update_dpp(0, __builtin_bit_cast(int, s), CTRL, RMASK, 0xf, BC))
            SSD_DPP_ADD(0x111, 0xf, true); SSD_DPP_ADD(0x112, 0xf, true); SSD_DPP_ADD(0x114, 0xf, true); SSD_DPP_ADD(0x118, 0xf, true);
            SSD_DPP_ADD(0x142, 0xa, false); SSD_DPP_ADD(0x143, 0xc, false);
#undef SSD_DPP_ADD
            aend = __builtin_bit_cast(float, __builtin_amdgcn_readlane(__builtin_bit_cast(int, s), 63));
            *(LAS f32x2v*)(acs + 2 * lane) = (f32x2v){s - v1, s}; *(LAS f32x2v*)(dtl + 2 * lane) = (f32x2v){dtp0, dtp1};
        }
#pragma unroll
        for (int k = 0; k < 4; ++k) { const int idx = tid + 512 * k, row = idx >> 4;
            if ((row & 63) >= 3) { *(LAS v4u*)(lds + BT_OFF + row * PITCH + 16 * (idx & 15)) = bcr[k]; if (!pre) *(LAS v4u*)(lds + CT_OFF + row * PITCH + 16 * (idx & 15)) = bcr[4 + k]; } }
        if (!pre || fc < 128) {
            LAS unsigned char* dst = lds + (fc < 128 ? BT_OFF + 2 * fc : CT_OFF + 2 * (fc - 128)) + 64 * fb * PITCH;
            const LAS float* fwp = (const LAS float*)(lds + FW_OFF) + fc;
            const float fw0 = fwp[0], fw1 = fwp[256], fw2 = fwp[512], fw3 = fwp[768], fbias = fwp[1024];
#pragma unroll
            for (int j = 0; j < 3; ++j) *(LAS bf16*)(dst + j * PITCH) = (bf16)f2bf(silu_fast(fbias + fw0 * fxr[j] + fw1 * fxr[j + 1] + fw2 * fxr[j + 2] + fw3 * fxr[j + 3]));
        }
        {
            const LAS f32x4* xwp = (const LAS f32x4*)(lds + XW_OFF) + xg;
            const f32x4 xw0 = xwp[0], xw1 = xwp[16], xw2 = xwp[32], xw3 = xwp[48], xb = xwp[64];
            float xv[7][4];
#pragma unroll
            for (int j = 0; j < 7; ++j) { xv[j][0] = bflo(xr[j].x); xv[j][1] = bfhi(xr[j].x); xv[j][2] = bflo(xr[j].y); xv[j][3] = bfhi(xr[j].y); }
#pragma unroll
            for (int i = 0; i < 4; ++i) {
                const int s = xr0 + i; const float dt = dtl[s], de = dt * __expf(aend - acs[s]); float v[4];
#pragma unroll
                for (int e = 0; e < 4; ++e) v[e] = silu_fast(xb[e] + xw0[e] * xv[i][e] + xw1[e] * xv[i + 1][e] + xw2[e] * xv[i + 2][e] + xw3[e] * xv[i + 3][e]);
                const int off = ((s >> 4) << 11) + xoff + (s & 15) * 64;
                *(LAS u32x2*)(lds + XD_OFF + off) = (u32x2){pg8::cvt_pk_bf16(v[0] * dt, v[1] * dt), pg8::cvt_pk_bf16(v[2] * dt, v[3] * dt)};
                *(LAS u32x2*)(lds + XH_OFF + off) = (u32x2){pg8::cvt_pk_bf16(v[0] * de, v[1] * de), pg8::cvt_pk_bf16(v[2] * de, v[3] * de)};
            }
        }
        asm volatile("" ::: "memory"); __builtin_amdgcn_sched_barrier(0);
        if (ch + 1 < ch_end) SSD_PREFETCH(t0 + 128);
        __syncthreads();
        f32x16 yt = {};
        if (!pre) {
        {
            const int j = w & 3; const float al = acs[32 * j + c];
#pragma unroll
            for (int ii = 0; ii < 2; ++ii) {
                const int i = 2 * (w >> 2) + ii;
                if (i <= j) {
                    f32x16 x = {};
                    const LAS unsigned char* ap = lds + BT_OFF + (32 * i + c) * PITCH + 16 * hi;
                    const LAS unsigned char* bp = lds + CT_OFF + (32 * j + c) * PITCH + 16 * hi;
#pragma unroll 4
                    for (int ks = 0; ks < 8; ++ks) x = __builtin_amdgcn_mfma_f32_32x32x16_bf16(*(const LAS bf16x8*)(ap + 32 * ks), *(const LAS bf16x8*)(bp + 32 * ks), x, 0, 0, 0);
                    const int l = 32 * j + c;
#pragma unroll
                    for (int g4 = 0; g4 < 4; ++g4) {
                        const int sb = 32 * i + 8 * g4 + 4 * hi; float gv[4];
                        const f32x4 as4 = *(const LAS f32x4*)(acs + sb);
#pragma unroll
                        for (int e = 0; e < 4; ++e) { const int s = sb + e; gv[e] = s <= l ? x[4 * g4 + e] * __builtin_amdgcn_exp2f((al - as4[e]) * LOG2E) : 0.f; }
                        *(LAS u32x2*)(lds + G_OFF + l * PITCH + sb * 2) = (u32x2){pg8::cvt_pk_bf16(gv[0], gv[1]), pg8::cvt_pk_bf16(gv[2], gv[3])};
                    }
                }
            }
        }
        {
            const LAS unsigned char* ap = lds + HB_OFF + (32 * pt + c) * PITCH + 16 * hi;
            const LAS unsigned char* bp = lds + CT_OFF + (32 * jt + c) * PITCH + 16 * hi;
#pragma unroll 4
            for (int ks = 0; ks < 8; ++ks) yt = __builtin_amdgcn_mfma_f32_32x32x16_bf16(*(const LAS bf16x8*)(ap + 32 * ks), *(const LAS bf16x8*)(bp + 32 * ks), yt, 0, 0, 0);
            const float el = __expf(acs[32 * jt + c]);
#pragma unroll
            for (int r = 0; r < 16; ++r) yt[r] *= el;
        }
        __syncthreads();
        {
            const LAS unsigned char* bp = lds + G_OFF + (32 * jt + c) * PITCH + 16 * hi;
            for (int ks = 0; ks < 2 * jt + 2; ++ks) {
                const LAS unsigned char* xp = lds + XD_OFF + ((ks * 2 + pt) << 10) + xtr;
                yt = __builtin_amdgcn_mfma_f32_32x32x16_bf16(trfrag(xp, xp + 256), *(const LAS bf16x8*)(bp + 32 * ks), yt, 0, 0, 0);
            }
        }
        }
        {
            const float ea = __expf(aend);
#pragma unroll
            for (int r = 0; r < 16; ++r) hacc[r] *= ea;
            const int btr = (8 * hi + q4) * PITCH + (32 * jt + 16 * odd + 4 * p4) * 2;
#pragma unroll 4
            for (int ks = 0; ks < 8; ++ks) {
                const LAS unsigned char* xp = lds + XH_OFF + ((ks * 2 + pt) << 10) + xtr;
                const LAS unsigned char* bp = lds + BT_OFF + 16 * ks * PITCH + btr;
                hacc = __builtin_amdgcn_mfma_f32_32x32x16_bf16(trfrag(xp, xp + 256), trfrag(bp, bp + 4 * PITCH), hacc, 0, 0, 0);
            }
        }
        if (!pre) {
            const int l = 32 * jt + c; const float rdt = dsk * __builtin_amdgcn_rcpf(dtl[l]);
            bf16* up = F.AU + (row0 + t0 + l) * 2048 + hd * 64 + 32 * pt;
            float sq = 0.f;
#pragma unroll
            for (int g4 = 0; g4 < 4; ++g4) {
                const int pl = 8 * g4 + 4 * hi;
                const u32x2 xw2 = *(const LAS u32x2*)(lds + XD_OFF + (((l >> 4) * 2 + pt) << 10) + (l & 15) * 64 + pl * 2);
                const u32x2 zw = zr[g4];
                const float u0 = (yt[4 * g4] + rdt * bflo(xw2.x)) * bflo(zw.x), u1 = (yt[4 * g4 + 1] + rdt * bfhi(xw2.x)) * bfhi(zw.x), u2 = (yt[4 * g4 + 2] + rdt * bflo(xw2.y)) * bflo(zw.y), u3 = (yt[4 * g4 + 3] + rdt * bfhi(xw2.y)) * bfhi(zw.y);
                sq += (u0 * u0 + u1 * u1) + (u2 * u2 + u3 * u3);
                *(u32x2*)(up + pl) = (u32x2){pg8::cvt_pk_bf16(u0, u1), pg8::cvt_pk_bf16(u2, u3)};
            }
            sq += __shfl_xor(sq, 32);
            if (hi == 0) ssql[128 * pt + l] = sq;
        }
        if (ch + 1 < ch_end && !(seg && ch + 1 < HALF_CH)) SSD_PREFETCH_Z(t0 + 128);
        __syncthreads();
        if (!(seg && ch + 1 < HALF_CH))
#pragma unroll
        for (int r = 0; r < 16; ++r) *(LAS bf16*)(lds + HB_OFF + (32 * pt + crow(r, hi)) * PITCH + (32 * jt + c) * 2) = (bf16)f2bf(hacc[r]);
    }
#undef SSD_PREFETCH
#undef SSD_PREFETCH_Z
    if (w < 2) { const int t0 = ch_end * 128; F.SSQ[(row0 + t0 - 128 + lane) * 32 + 2 * hd + w] = ssql[128 * w + lane]; F.SSQ[(row0 + t0 - 64 + lane) * 32 + 2 * hd + w] = ssql[128 * w + 64 + lane]; }
    if (seg) {
    float* ho = F.out + O_HP + (((size_t)b * NH + hd) * HD + 32 * pt) * DS + 32 * jt + c;
#pragma unroll
    for (int r = 0; r < 16; ++r) ho[(size_t)crow(r, hi) * DS] = hacc[r];
    }
    __syncthreads();
}
}

namespace smp {
__device__ __forceinline__ void attn_unit(Frame& F, int bhs) {
    const Ins& I = F.I;
    const int lane = F.lane, w = F.wave, b = bhs >> 4, h = bhs & 15, r = NTOK + b;
    LAS float* qs = (LAS float*)(F.lds + 4096); LAS float* acc = (LAS float*)F.lds;
    LAS float* ps = (LAS float*)(F.lds + 8192) + w * 64;
    if (F.tid < 64) qs[F.tid] = bf2f(F.Q[(size_t)r * DM + h * HD + F.tid]);
    if (F.tid < 65) acc[F.tid] = 0.f;
    __syncthreads();
    const int k0 = 49 * w, nk = (387 - k0) < 49 ? (387 - k0) : 49;
    float p = 0.f;
    if (lane < nk) {
        const int idx = k0 + lane, pat = idx / 129, j = idx - pat * 129, d = pat == 0 ? 1 : (pat == 1 ? 4 : 16);
        float s = 0.f;
        if (j > 0) { const f32x4* kp = (const f32x4*)(I.ck + (((size_t)b * WIN + (WIN - j * d)) * NH + h) * HD);
#pragma unroll
            for (int e = 0; e < 16; ++e) { const f32x4 kv = kp[e]; const f32x4 qv = *(const LAS f32x4*)(qs + 4 * e); s += (qv[0] * kv[0] + qv[1] * kv[1]) + (qv[2] * kv[2] + qv[3] * kv[3]); } }
        else { const bf16* kp = F.K + (size_t)r * DM + h * HD; for (int e = 0; e < 64; ++e) s += qs[e] * bf2f(kp[e]); }
        p = __builtin_amdgcn_exp2f(s + I.rel_bias[t5_bucket(j * d) * NH + h] * LOG2E);
    }
    ps[lane] = p;
    const float lsum = wave_sum(p);
    __builtin_amdgcn_wave_barrier();
    float o0 = 0.f, o1 = 0.f, o2 = 0.f, o3 = 0.f;
    const float vnew = bf2f(F.V[(size_t)r * DM + h * HD + lane]);
    const float* vbase = I.cv + ((size_t)b * WIN * NH + h) * HD + lane;
#define SMP_V(K) ({ const int idx_ = k0 + (K), pat_ = idx_ / 129, j_ = idx_ - pat_ * 129, d_ = pat_ == 0 ? 1 : (pat_ == 1 ? 4 : 16); \
                    (K) < nk ? ps[(K)] * (j_ > 0 ? vbase[(size_t)(WIN - j_ * d_) * (NH * HD)] : vnew) : 0.f; })
#pragma unroll
    for (int k = 0; k < 48; k += 4) { o0 += SMP_V(k); o1 += SMP_V(k + 1); o2 += SMP_V(k + 2); o3 += SMP_V(k + 3); }
    o0 += SMP_V(48);
#undef SMP_V
    __hip_atomic_fetch_add(acc + lane, (o0 + o1) + (o2 + o3), __ATOMIC_RELAXED, __HIP_MEMORY_SCOPE_WORKGROUP);
    if (lane == 0) __hip_atomic_fetch_add(acc + 64, lsum, __ATOMIC_RELAXED, __HIP_MEMORY_SCOPE_WORKGROUP);
    __syncthreads();
    if (F.tid < 64) F.AU[(size_t)r * 2048 + 1024 + h * HD + F.tid] = (bf16)f2bf(acc[F.tid] * __builtin_amdgcn_rcpf(acc[64]) * bf2f(F.Gb[(size_t)r * DM + h * HD + F.tid]));
    __syncthreads();
}

__device__ __forceinline__ void ssd_unit(Frame& F, int bhs) {
    const Ins& I = F.I;
    LAS float* xs_l = (LAS float*)F.lds; LAS float* B_l = xs_l + 64; LAS float* C_l = B_l + 128; LAS float* ssq_l = C_l + 128;
    const int tid = F.tid, p = tid >> 3, ng = tid & 7;
    const int b = bhs >> 4, hd = bhs & 15, grp = hd >> 3; const size_t r = (size_t)NTOK + b;
    float h[16];
    { const f32x4* hp = (const f32x4*)(I.sssm + (((size_t)b * NH + hd) * HD + p) * DS + ng * 16);
#pragma unroll
      for (int i = 0; i < 4; ++i) { const f32x4 v = hp[i]; h[4 * i] = v[0]; h[4 * i + 1] = v[1]; h[4 * i + 2] = v[2]; h[4 * i + 3] = v[3]; } }
    if (tid < 320) {
        const int ci = tid, c = ci < 64 ? hd * 64 + ci : (ci < 192 ? 1024 + grp * 128 + (ci - 64) : 1280 + grp * 128 + (ci - 192));
        float v = I.conv_b[c];
#pragma unroll
        for (int i = 0; i < 3; ++i) v += I.sconv[((size_t)b * 3 + i) * CONVD + c] * I.conv_w[i * CONVD + c];
        v += bf2f(F.XBC[r * CONVD + c]) * I.conv_w[3 * CONVD + c];
        xs_l[ci] = silu_f(v);
    }
    if (tid == 0) ssq_l[0] = 0.f;
    __syncthreads();
    const float dt = F.DT[(size_t)hd * MROWS + r], A = -__expf(I.a_log[hd]), x = xs_l[p], dec = __expf(dt * A), xdt = x * dt;
    float y = 0.f;
#pragma unroll
    for (int i = 0; i < 16; ++i) { h[i] = h[i] * dec + xdt * B_l[ng * 16 + i]; y += h[i] * C_l[ng * 16 + i]; }
    y += __shfl_xor(y, 1); y += __shfl_xor(y, 2); y += __shfl_xor(y, 4);
    if (ng == 0) {
        const float u = (y + I.d_skip[hd] * x) * bf2f(F.Zb[r * DM + hd * 64 + p]);
        F.AU[r * 2048 + hd * 64 + p] = (bf16)f2bf(u);
        __hip_atomic_fetch_add(ssq_l, u * u, __ATOMIC_RELAXED, __HIP_MEMORY_SCOPE_WORKGROUP);
    }
    { f32x4* ho = (f32x4*)(F.out + O_HS + (((size_t)b * NH + hd) * HD + p) * DS + ng * 16);
#pragma unroll
      for (int i = 0; i < 4; ++i) ho[i] = (f32x4){h[4 * i], h[4 * i + 1], h[4 * i + 2], h[4 * i + 3]}; }
    __syncthreads();
    if (tid == 0) { F.SSQ[r * 32 + 2 * hd] = ssq_l[0]; F.SSQ[r * 32 + 2 * hd + 1] = 0.f; }
    __syncthreads();
}
}

namespace smp {
typedef float f32x16s __attribute__((ext_vector_type(16)));
__device__ __forceinline__ void mm64x32(Frame& F, const bf16* WT, int wrow0  , const bf16* A, int apitch, int K) {
    const int lane = F.lane, w = F.wave, c = lane & 31, hi = lane >> 5, half = w & 1, kq = w >> 1, kseg = K / 4;
    const bf16* ap = WT + (size_t)(wrow0 + 128 * half + c) * K + kq * kseg + 8 * hi;
    const bf16* bp = A + (size_t)c * apitch + kq * kseg + 8 * hi;
    f32x16s acc = {};
#pragma unroll 8
    for (int ks = 0; ks < kseg / 16; ++ks) acc = __builtin_amdgcn_mfma_f32_32x32x16_bf16(*(const bf16x8*)(ap + 16 * ks), *(const bf16x8*)(bp + 16 * ks), acc, 0, 0, 0);
    LAS float* red = (LAS float*)F.lds + (kq * 64 + 32 * half) * 32;
#pragma unroll
    for (int r = 0; r < 16; ++r) red[((r & 3) + 8 * (r >> 2) + 4 * hi) * 32 + c] = acc[r];
    __syncthreads();
}
__device__ __forceinline__ void inproj_unit(Frame& F, int ht) {
    const Ins& I = F.I;
    const int a0 = 64 * ht;
    mm64x32(F, F.WinT, (a0 & ~255) + vrow_of_col(a0 & 255), F.XN + (size_t)NTOK * DM, DM, DM);
    const LAS float* red = (const LAS float*)F.lds;
    const int lane = F.lane, w = F.wave;
#pragma unroll 1
    for (int rr = 0; rr < 4; ++rr) {
        const int r = 4 * w + rr;
        const float v = (red[(0 * 64 + lane) * 32 + r] + red[(1 * 64 + lane) * 32 + r]) + (red[(2 * 64 + lane) * 32 + r] + red[(3 * 64 + lane) * 32 + r]);
        const size_t row = (size_t)NTOK + r; const int col = a0 + lane;
        if (col < C_V) {
            const float sc = rsqrtf(wave_sum(v * v) * (1.f / 64.f) + EPS);
            if (col < C_K) F.Q[row * DM + col] = (bf16)f2bf(v * sc * I.qnw[lane] * QSCALE);
            else { const float kv = v * sc * I.knw[lane]; F.K[row * DM + col - C_K] = (bf16)f2bf(kv); F.out[O_KS + (size_t)r * DM + col - C_K] = kv; }
        } else if (col < C_G) { F.V[row * DM + col - C_V] = (bf16)f2bf(v); F.out[O_VS + (size_t)r * DM + col - C_V] = v; }
        else if (col < C_Z) F.Gb[row * DM + col - C_G] = (bf16)f2bf(silu_fast(v));
        else if (col < C_XBC) F.Zb[row * DM + col - C_Z] = (bf16)f2bf(silu_fast(v));
        else { F.XBC[row * CONVD + col - C_XBC] = (bf16)f2bf(v); F.out[O_CS + ((size_t)r * 3 + 2) * CONVD + col - C_XBC] = v; }
    }
    __syncthreads();
}
__device__ __forceinline__ void outproj_unit(Frame& F, int ct) {
    const Ins& I = F.I;
    const int a0 = 64 * ct;
    mm64x32(F, F.WoutT, (a0 & ~255) + vrow_of_col(a0 & 255), F.AU + (size_t)NTOK * 2048, 2048, 2048);
    const LAS float* red = (const LAS float*)F.lds;
    const int lane = F.lane, w = F.wave;
#pragma unroll 1
    for (int rr = 0; rr < 4; ++rr) {
        const int r = 4 * w + rr;
        float s = lane < 32 ? F.SSQ[((size_t)NTOK + r) * 32 + lane] : 0.f;
        s = wave_sum(s);
        const float rs = rsqrtf(s * (1.f / 1024.f) + EPS);
        const float v = (red[(0 * 64 + lane) * 32 + r] + red[(1 * 64 + lane) * 32 + r]) * rs + (red[(2 * 64 + lane) * 32 + r] + red[(3 * 64 + lane) * 32 + r]);
        F.out[O_YS + (size_t)r * DM + a0 + lane] = I.xs[(size_t)r * DM + a0 + lane] + v;
    }
    __syncthreads();
}
}

__device__ __forceinline__ void phase2_queue(Frame& F, int qset) {
    const unsigned x = xb_xcc_id() & 7u;
    constexpr int PER_Q = att::NUNITS / 8;
    for (unsigned k = 0; k < 8; ++k) {
        const unsigned qx = (x + k) & 7u;
        gu32* qw = F.ctl + CW_Q + 64 * (8 * qset + qx);
        if (F.tid == 0) F.MISC[16] = __hip_atomic_fetch_add(qw, 1u, RLX_AGENT);
        __syncthreads();
        unsigned idx = F.MISC[16];
        while (idx < (unsigned)(PER_Q + 128)) {
            unsigned nxt = 0u;
            if (F.tid == 0) nxt = __hip_atomic_fetch_add(qw, 1u, RLX_AGENT);
            if (idx < 64u) smp::attn_unit(F, (int)(qx * 64 + idx));
            else if (idx < 128u) smp::ssd_unit(F, (int)(qx * 64 + idx - 64));
            else { { PB_BEGIN(32) att::unit(F, (int)(qx * PER_Q + idx - 128)); PB_END(32) } if (PROBE_ID == 31) { const unsigned long long t0_ = __builtin_amdgcn_s_memrealtime(); while (__builtin_amdgcn_s_memrealtime() - t0_ < 2000ull) __builtin_amdgcn_s_sleep(8); } }
            if (F.tid == 0) F.MISC[16] = nxt;
            __syncthreads();
            idx = F.MISC[16];
        }
        __syncthreads();
    }
}

constexpr int PROBE_REP_SSD = 1, PROBE_REP_ATT = 1;
struct Args { Ins in; float* out; unsigned char* ws; int ph_lo, ph_hi; };
__global__ void __launch_bounds__(NWAVES * 64, 2) mk_fwd(Args args) {
    extern __shared__ __attribute__((aligned(16))) unsigned char lds[];
    Frame F;
    F.lds = (LAS unsigned char*)lds;
    F.MISC = (volatile LAS unsigned*)(F.lds + MISC_OFF);
    F.tid = threadIdx.x; F.lane = F.tid & 63; F.wave = __builtin_amdgcn_readfirstlane(F.tid >> 6);
    F.G = gridDim.x; { const int bx = blockIdx.x; F.vcu = (F.G % 8 == 0) ? (bx % 8) * (F.G / 8) + bx / 8 : bx; }
    unsigned char* ws = args.ws;
    F.ctl = (gu32*)(ws + WS_CTL); F.I = args.in; F.out = args.out;
    F.WinT = (bf16*)(ws + WS_WIN); F.WoutT = (bf16*)(ws + WS_WOUT); F.XN = (bf16*)(ws + WS_XN); F.Q = (bf16*)(ws + WS_Q); F.K = (bf16*)(ws + WS_K); F.V = (bf16*)(ws + WS_V);
    F.AU = (bf16*)(ws + WS_AU); F.XBC = (bf16*)(ws + WS_XBC); F.DT = (float*)(ws + WS_DT); F.SSQ = (float*)(ws + WS_SSQ); F.RAWB = (float*)(ws + WS_RAWB); F.Gb = (bf16*)(ws + WS_G); F.Zb = (bf16*)(ws + WS_Z);
    for (int u = F.tid; u < (LDS_BYTES - LDSCTL_OFF) / 4; u += NWAVES * 64) ((LAS unsigned*)(F.lds + LDSCTL_OFF))[u] = 0u;
    __syncthreads();
    XcdBarrier bar = xcd_barrier_post((unsigned*)(F.ctl + CW_BAR), F.MISC + 8);
    const int lo = args.ph_lo, hi = args.ph_hi;
#define IN(k) (lo <= (k) && (k) < hi)
#define BOTH(k) (IN(k) && IN((k) + 1))
    if (IN(0)) { p0_prologue(F); if (BOTH(0)) xcd_barrier(bar); }
    if (IN(1)) {
        __syncthreads();
        pg8::Gemm g{F.XN, F.WinT, NTOK, NMAIN, DM}; pg8::StaticOrder S; S.init(NTOK, NMAIN, F.G, (int)blockIdx.x);
        pg8::EpiIn E{F.Q, F.K, F.V, F.Gb, F.Zb, F.XBC, F.out, F.I.qnw, F.I.knw, F.I.conv_w, F.I.conv_b, F.RAWB};
        pg8::gemm_phase<pg8::EpiIn, pg8::StaticOrder, true, true>(F.lds + RING_OFF, g, S, E);
        __syncthreads();
        for (int ht = F.vcu; ht < NMAIN / 64; ht += F.G) smp::inproj_unit(F, ht);
        if (BOTH(1)) xcd_barrier(bar);
    }
    if (IN(2)) { __syncthreads(); if ((F.vcu & 31) < 16 && (F.vcu >> 5) < 8) { ssd::chain(F, (F.vcu >> 5) * 16 + (F.vcu & 31)); if (PROBE_ID == 30) { const unsigned long long t0_ = __builtin_amdgcn_s_memrealtime(); while (__builtin_amdgcn_s_memrealtime() - t0_ < 10000ull) __builtin_amdgcn_s_sleep(8); } } for (int rep = 0; rep < PROBE_REP_ATT; ++rep) phase2_queue(F, rep);     if (BOTH(2)) xcd_barrier(bar); }
    if (IN(3)) {
        __syncthreads();
        pg8::Gemm g{F.AU, F.WoutT, NTOK, DM, 2048}; pg8::StaticOrder S; S.init(NTOK, DM, F.G, (int)blockIdx.x);
        LAS float* rs = (LAS float*)(F.lds + RING_BYTES);
        { pg8::Unit u;
          for (int ui = 0; ui < 4 && S.next(ui, u); ++ui)
              for (int r = F.tid; r < 256; r += NWAVES * 64) {
                  const f32x4* sp = (const f32x4*)(F.SSQ + (size_t)(u.pm * 256 + r) * 32);
                  float s = 0.f;
#pragma unroll
                  for (int q = 0; q < 8; ++q) { const f32x4 v = sp[q]; s += (v[0] + v[1]) + (v[2] + v[3]); }
                  rs[ui * 256 + r] = rsqrtf(s * (1.f / 1024.f) + EPS);
              }
          __syncthreads(); }
        pg8::EpiOut E{F.I.xp, F.I.xs, rs, F.out};
        pg8::gemm_phase<pg8::EpiOut, pg8::StaticOrder, true, true>(F.lds + RING_OFF, g, S, E);
        __syncthreads();
        for (int ct = F.G - 1 - F.vcu; ct >= 0 && ct < DM / 64; ct += F.G) smp::outproj_unit(F, ct);
    }
#undef IN
#undef BOTH
}

extern "C" void kernel_launch(void* const* d_in, const int* in_sizes, int n_in, void* d_out, int out_size, void* d_ws, size_t ws_size, hipStream_t stream) {
    static int grid = 0;
    if (grid == 0) {
        if (n_in != 18 || out_size != (int)O_END || ws_size < WS_END) { fprintf(stderr, "kernel_launch: unexpected n_in %d / out_size %d / ws_size %zu; nothing launched\n", n_in, out_size, ws_size); grid = -1; return; }
        int dev = 0, cus = 0;
        if (hipGetDevice(&dev) != hipSuccess || hipDeviceGetAttribute(&cus, hipDeviceAttributeMultiprocessorCount, dev) != hipSuccess) { grid = -1; return; }
        if (hipFuncSetAttribute((const void*)mk_fwd, hipFuncAttributeMaxDynamicSharedMemorySize, LDS_BYTES) != hipSuccess) { fprintf(stderr, "kernel_launch: hipFuncSetAttribute failed\n"); grid = -1; return; }
        (void)hipGetLastError();
        grid = cus;
    }
    if (grid < 0) return;
    (void)hipMemsetAsync((char*)d_ws + WS_CTL, 0, CTL_ZERO_BYTES, stream);
    Args a{};
    const float** ip = (const float**)&a.in;
    for (int i = 0; i < 18; ++i) ip[i] = (const float*)d_in[i];
    a.out = (float*)d_out; a.ws = (unsigned char*)d_ws;
    a.ph_lo = 0; a.ph_hi = 4;
    hipLaunchKernelGGL(mk_fwd, dim3(grid), dim3(NWAVES * 64), LDS_BYTES, stream, a);
}
```

```cpp
#include <hip/hip_runtime.h>
#include <cstdio>
#include <cstdint>

constexpr int DM = 1024, NB = 4, SEQ = 8192, DB = 32, WIN = 2048;
constexpr int NPROJ = 6672, NMAIN = 6656, NTOK = NB * SEQ, NROWS = NTOK + DB;
constexpr int MROWS = 33024;
constexpr int C_Q = 0, C_K = 1024, C_V = 2048, C_G = 3072, C_Z = 4096, C_XBC = 5120, C_DT = 6656;
constexpr int CONVD = 1536, NH = 16, HD = 64, DS = 128;
constexpr float EPS = 1e-6f;
constexpr float QSCALE = 0.125f * 1.4426950408889634f;
constexpr float LOG2E = 1.4426950408889634f;
constexpr size_t O_YP = 0, O_YS = O_YP + (size_t)NTOK * DM, O_KP = O_YS + (size_t)DB * DM, O_VP = O_KP + (size_t)NB * WIN * DM,
                 O_CP = O_VP + (size_t)NB * WIN * DM, O_HP = O_CP + (size_t)NB * 3 * CONVD, O_KS = O_HP + (size_t)NB * NH * HD * DS,
                 O_VS = O_KS + (size_t)DB * DM, O_CS = O_VS + (size_t)DB * DM, O_HS = O_CS + (size_t)DB * 3 * CONVD,
                 O_END = O_HS + (size_t)DB * NH * HD * DS;
static_assert(O_END == 55314432, "output size");

constexpr size_t MiB = 1u << 20;
constexpr size_t WS_CTL = 0, CTL_ZERO_BYTES = 1 * MiB;
constexpr size_t WS_WIN = 2 * MiB;
constexpr size_t WS_WOUT = 16 * MiB;
constexpr size_t WS_DT = 20 * MiB;
constexpr size_t WS_SSQ = 24 * MiB;
constexpr size_t WS_XN = 32 * MiB;
constexpr size_t WS_Q = 100 * MiB;
constexpr size_t WS_K = 168 * MiB;
constexpr size_t WS_V = 236 * MiB;
constexpr size_t WS_AU = 304 * MiB;
constexpr size_t WS_XBC = 436 * MiB;
constexpr size_t WS_RAWB = 536 * MiB;
constexpr size_t WS_G = 544 * MiB;
constexpr size_t WS_Z = 612 * MiB;
constexpr size_t WS_END = 680 * MiB;
static_assert(WS_XN + (size_t)MROWS * DM * 2 <= WS_Q && WS_Q + (size_t)MROWS * DM * 2 <= WS_K && WS_K + (size_t)MROWS * DM * 2 <= WS_V && WS_V + (size_t)MROWS * DM * 2 <= WS_AU &&
              WS_AU + (size_t)MROWS * 2048 * 2 <= WS_XBC && WS_XBC + (size_t)MROWS * CONVD * 2 <= WS_RAWB && WS_RAWB + (size_t)(MROWS / 64) * 6 * 512 * 4 <= WS_G && WS_G + (size_t)MROWS * DM * 2 <= WS_Z && WS_Z + (size_t)MROWS * DM * 2 <= WS_END && WS_WIN + (size_t)NMAIN * DM * 2 <= WS_WOUT && WS_WOUT + (size_t)DM * 2048 * 2 <= WS_DT &&
              WS_DT + (size_t)MROWS * 16 * 4 <= WS_SSQ && WS_SSQ + (size_t)MROWS * 32 * 4 <= WS_XN, "d_ws map");

struct Ins {
    const float *xp, *xs, *ck, *cv, *sconv, *sssm, *norm_w, *w_in, *qnw, *knw, *rel_bias, *conv_w, *conv_b, *dt_bias, *a_log, *d_skip, *ssd_norm_w, *w_out;
};

typedef unsigned short bf16;
__device__ __forceinline__ float wave_sum(float v) {
#pragma unroll
    for (int o = 1; o < 64; o <<= 1) v += __shfl_xor(v, o);
    return v;
}
__device__ __forceinline__ float wave_max(float v) {
#pragma unroll
    for (int o = 1; o < 64; o <<= 1) v = fmaxf(v, __shfl_xor(v, o));
    return v;
}
__device__ __forceinline__ float silu_f(float x) { return x / (1.f + __expf(-x)); }
__device__ __forceinline__ float silu_fast(float x) { return x * __builtin_amdgcn_rcpf(1.f + __builtin_amdgcn_exp2f(-LOG2E * x)); }
__device__ __forceinline__ float softplus_f(float x) { return x > 20.f ? x : log1pf(__expf(x)); }
__device__ __forceinline__ int t5_bucket(int d) {
    if (d < 16) return d;
    int b = 16;
    b += d >= 22; b += d >= 30; b += d >= 40; b += d >= 54; b += d >= 73; b += d >= 99; b += d >= 134; b += d >= 182;
    b += d >= 246; b += d >= 332; b += d >= 450; b += d >= 609; b += d >= 825; b += d >= 1117; b += d >= 1513;
    return b;
}
__device__ __forceinline__ const float* xrow(const Ins& I, int r) { return r < NTOK ? I.xp + (size_t)r * DM : I.xs + (size_t)(r - NTOK) * DM; }
__device__ __forceinline__ float bf2f(bf16 v) { return __uint_as_float((unsigned)v << 16); }
__device__ __forceinline__ unsigned f2bf(float f) { unsigned u = __float_as_uint(f); return (u + 0x7fffu + ((u >> 16) & 1u)) >> 16; }
__device__ __forceinline__ unsigned pk2(float lo, float hi) { return f2bf(lo) | (f2bf(hi) << 16); }
typedef float f32x2_cv __attribute__((ext_vector_type(2))); typedef __bf16 bf16x2_cv __attribute__((ext_vector_type(2)));
__device__ __forceinline__ unsigned cvtpk_s(float lo, float hi) { const f32x2_cv v = {lo, hi}; const bf16x2_cv b = __builtin_convertvector(v, bf16x2_cv); return __builtin_bit_cast(unsigned, b); }
__host__ __device__ __forceinline__ int vrow_of_col(int a) { return 128 * ((a >> 5) & 1) + 32 * ((a >> 6) & 3) + (a & 31); }

namespace pg8 {
#define PG8_LAS __attribute__((address_space(3)))
typedef unsigned short bf16_t;
typedef short bf16x8 __attribute__((ext_vector_type(8)));
typedef float f32x4 __attribute__((ext_vector_type(4)));
typedef unsigned u32x4 __attribute__((ext_vector_type(4)));
constexpr int BM = 256, BK = 64, HALF = 128, HTB = HALF * BK * 2  , STAGE_BYTES = 8 * HTB, NXCD = 8, WGM = 8;

__host__ __device__ __forceinline__ int lds_byte(int r, int c) { const int st = (r >> 4) * 2 + (c >> 5), rr = r & 15, cc = c & 31, ob = rr * 64 + cc * 2; return st * 1024 + (ob ^ (((ob >> 9) & 1) << 5)); }
__host__ __device__ __forceinline__ void stage_rc(int b, int& R, int& C) { const int st = b / 1024, sb = b % 1024, swz = sb ^ (((sb >> 9) & 1) << 5); R = (st >> 1) * 16 + swz / 64; C = (st & 1) * 32 + (swz % 64) / 2; }
__host__ __device__ __forceinline__ int perm32(int rho) { const int n = rho >> 4, i = rho & 15; return 8 * (i >> 2) + 4 * n + (i & 3); }

struct Unit { int pm, pn; };
struct Gemm { const bf16_t* A; const bf16_t* Bt; int M, N, K; };

struct StaticOrder {
    int nM, nN, nwg, G, c;
    __host__ __device__ void init(int M, int N, int G_, int c_) { nM = M / BM; nN = N / BM; nwg = nM * nN; G = G_; c = c_; }
    __host__ __device__ bool next(int i, Unit& u) const {
        const long L = (long)i * G + c; if (L >= nwg) return false;
        int wgid = (int)L; { const int q = nwg / NXCD, r = nwg % NXCD, xcd = wgid % NXCD, off = wgid / NXCD; wgid = (xcd < r ? xcd * (q + 1) : r * (q + 1) + (xcd - r) * q) + off; }
        const int nig = WGM * nN, gid = wgid / nig, fm = gid * WGM, gsz = (nM - fm) < WGM ? (nM - fm) : WGM;
        u.pm = fm + ((wgid % nig) % gsz); u.pn = (wgid % nig) / gsz; return true;
    }
    __device__ __forceinline__ void a_ready(const Unit&) const {}
    __device__ __forceinline__ void done(const Unit&) const {}
};

__device__ __forceinline__ unsigned cvt_pk_bf16(float lo, float hi) { unsigned r; asm volatile("v_cvt_pk_bf16_f32 %0, %1, %2" : "=v"(r) : "v"(lo), "v"(hi)); return r; }

template <int K> __device__ __forceinline__ float rowprev(float cur, float prevm) {
    const int t = __builtin_amdgcn_update_dpp(0, __builtin_bit_cast(int, prevm), 0x100 + (16 - K), 0xf, 0xf, true);
    return __builtin_bit_cast(float, __builtin_amdgcn_update_dpp(t, __builtin_bit_cast(int, cur), 0x110 + K, 0xf, 0xf, false));
}

struct EpiIn {
    static constexpr bool PERM = true, AFTER_DRAIN = false, MIDK = false;
    bf16_t *Q, *K, *V, *Gb, *Zb, *XBC; float* out; const float *qnw, *knw, *conv_w, *conv_b; float* rawb;
    __device__ __forceinline__ void mid(f32x4 (&)[2][2][4][2], const Unit&, int, int, int, int, int) const {}
    __device__ __forceinline__ void operator()(const f32x4 (&acc)[2][2][4][2], const Unit& u, int wr, int wc, int fr, int fq) const {
        const int pn = u.pn;
        const int rowb = u.pm * BM + wr * 64 + fr;
        const int cl = wc * 64 + 8 * fq;
        if (pn < 8) {
            const bool isq = pn < 4; const float* nw = isq ? qnw : knw;
            f32x4 w[2][2];
#pragma unroll
            for (int bj = 0; bj < 2; ++bj)
#pragma unroll
                for (int n = 0; n < 2; ++n) w[bj][n] = *(const f32x4*)(nw + 8 * fq + 32 * bj + 4 * n);
            bf16_t* dstb = (isq ? Q : K) + (pn & 3) * 256 + cl;
#pragma unroll
            for (int ai = 0; ai < 2; ++ai)
#pragma unroll
                for (int m = 0; m < 4; ++m) {
                    const int r = rowb + ai * HALF + m * 16;
                    float ss = 0.f;
#pragma unroll
                    for (int bj = 0; bj < 2; ++bj)
#pragma unroll
                        for (int n = 0; n < 2; ++n) { const f32x4 v = acc[ai][bj][m][n]; ss += (v[0] * v[0] + v[1] * v[1]) + (v[2] * v[2] + v[3] * v[3]); }
                    ss += __shfl_xor(ss, 16); ss += __shfl_xor(ss, 32);
                    const float sc = rsqrtf(ss * (1.f / 64.f) + EPS), scs = isq ? sc * QSCALE : sc;
                    float* f32dst = nullptr;
                    if (!isq) { if (r < NTOK) { const int t = r & (SEQ - 1); if (t >= SEQ - WIN) f32dst = out + O_KP + ((size_t)((r >> 13) * WIN + t - (SEQ - WIN))) * DM + (pn & 3) * 256 + cl; }
                                else if (r < NROWS) f32dst = out + O_KS + (size_t)(r - NTOK) * DM + (pn & 3) * 256 + cl; }
#pragma unroll
                    for (int bj = 0; bj < 2; ++bj) {
                        const f32x4 a0 = acc[ai][bj][m][0] * w[bj][0], a1 = acc[ai][bj][m][1] * w[bj][1];
                        u32x4 o; o.x = cvt_pk_bf16(a0[0] * scs, a0[1] * scs); o.y = cvt_pk_bf16(a0[2] * scs, a0[3] * scs); o.z = cvt_pk_bf16(a1[0] * scs, a1[1] * scs); o.w = cvt_pk_bf16(a1[2] * scs, a1[3] * scs);
                        *(u32x4*)(dstb + (size_t)r * DM + 32 * bj) = o;
                        if (f32dst) { *(f32x4*)(f32dst + 32 * bj) = a0 * sc; *(f32x4*)(f32dst + 32 * bj + 4) = a1 * sc; }
                    }
                }
        } else if (pn < 12) {
            bf16_t* dstb = V + (pn & 3) * 256 + cl;
#pragma unroll
            for (int ai = 0; ai < 2; ++ai)
#pragma unroll
                for (int m = 0; m < 4; ++m) {
                    const int r = rowb + ai * HALF + m * 16;
                    float* f32dst = nullptr;
                    if (r < NTOK) { const int t = r & (SEQ - 1); if (t >= SEQ - WIN) f32dst = out + O_VP + ((size_t)((r >> 13) * WIN + t - (SEQ - WIN))) * DM + (pn & 3) * 256 + cl; }
                    else if (r < NROWS) f32dst = out + O_VS + (size_t)(r - NTOK) * DM + (pn & 3) * 256 + cl;
#pragma unroll
                    for (int bj = 0; bj < 2; ++bj) {
                        const f32x4 a0 = acc[ai][bj][m][0], a1 = acc[ai][bj][m][1];
                        u32x4 o; o.x = cvt_pk_bf16(a0[0], a0[1]); o.y = cvt_pk_bf16(a0[2], a0[3]); o.z = cvt_pk_bf16(a1[0], a1[1]); o.w = cvt_pk_bf16(a1[2], a1[3]);
                        *(u32x4*)(dstb + (size_t)r * DM + 32 * bj) = o;
                        if (f32dst) { *(f32x4*)(f32dst + 32 * bj) = a0; *(f32x4*)(f32dst + 32 * bj + 4) = a1; }
                    }
                }
        } else if (pn < 20) {
            bf16_t* dstb = (pn < 16 ? Gb : Zb) + (pn & 3) * 256 + cl;
#pragma unroll
            for (int ai = 0; ai < 2; ++ai)
#pragma unroll
                for (int m = 0; m < 4; ++m) {
                    const int r = rowb + ai * HALF + m * 16;
#pragma unroll
                    for (int bj = 0; bj < 2; ++bj) {
                        f32x4 a0 = acc[ai][bj][m][0], a1 = acc[ai][bj][m][1];
#pragma unroll
                        for (int i = 0; i < 4; ++i) { a0[i] = silu_fast(a0[i]); a1[i] = silu_fast(a1[i]); }
                        u32x4 o; o.x = cvt_pk_bf16(a0[0], a0[1]); o.y = cvt_pk_bf16(a0[2], a0[3]); o.z = cvt_pk_bf16(a1[0], a1[1]); o.w = cvt_pk_bf16(a1[2], a1[3]);
                        *(u32x4*)(dstb + (size_t)r * DM + 32 * bj) = o;
                    }
                }
        } else {
            const int cb = (pn - 20) * 256 + cl;
            bf16_t* dstb = XBC + cb;
            const bool do_conv = pn >= 24 && u.pm < NTOK / BM;
#pragma unroll
            for (int ai = 0; ai < 2; ++ai)
#pragma unroll
                for (int m = 0; m < 4; ++m) {
                    const int r = rowb + ai * HALF + m * 16;
                    float* f32dst = nullptr;
                    if (r < NTOK) { const int t = r & (SEQ - 1); if (t >= SEQ - 3) f32dst = out + O_CP + ((size_t)((r >> 13) * 3 + t - (SEQ - 3))) * CONVD + cb; }
                    else if (r < NROWS) f32dst = out + O_CS + ((size_t)(r - NTOK) * 3 + 2) * CONVD + cb;
                    if (do_conv && (m == 0 || m == 3)) {
                        const int slot = m == 0 ? 3 + fr : fr - 13;
                        if (slot >= 0 && slot < 6) f32dst = rawb + ((size_t)(u.pm * 4 + ai * 2 + wr) * 6 + slot) * 512 + (cb - 1024);
                    }
#pragma unroll
                    for (int bj = 0; bj < 2; ++bj) {
                        const f32x4 a0 = acc[ai][bj][m][0], a1 = acc[ai][bj][m][1];
                        if (!do_conv) { u32x4 o; o.x = cvt_pk_bf16(a0[0], a0[1]); o.y = cvt_pk_bf16(a0[2], a0[3]); o.z = cvt_pk_bf16(a1[0], a1[1]); o.w = cvt_pk_bf16(a1[2], a1[3]);
                                        *(u32x4*)(dstb + (size_t)r * CONVD + 32 * bj) = o; }
                        if (f32dst) { *(f32x4*)(f32dst + 32 * bj) = a0; *(f32x4*)(f32dst + 32 * bj + 4) = a1; }
                    }
                }
            if (do_conv) {
                if ((u.pm & 31) == 31 && wr == 1 && fr >= 13) {
#pragma unroll
                    for (int bj = 0; bj < 2; ++bj) { float* d = out + O_CP + ((size_t)((u.pm >> 5) * 3 + fr - 13)) * CONVD + cb + 32 * bj; *(f32x4*)d = acc[1][bj][3][0]; *(f32x4*)(d + 4) = acc[1][bj][3][1]; }
                }
#pragma unroll
                for (int bj = 0; bj < 2; ++bj) {
                    f32x4 w[4][2], bb[2];
#pragma unroll
                    for (int n = 0; n < 2; ++n) { bb[n] = *(const f32x4*)(conv_b + cb + 32 * bj + 4 * n);
#pragma unroll
                        for (int t = 0; t < 4; ++t) w[t][n] = *(const f32x4*)(conv_w + t * CONVD + cb + 32 * bj + 4 * n); }
#pragma unroll
                    for (int ai = 0; ai < 2; ++ai) {
                        f32x4 pm[2] = {(f32x4){0.f, 0.f, 0.f, 0.f}, (f32x4){0.f, 0.f, 0.f, 0.f}};
#pragma unroll
                        for (int m = 0; m < 4; ++m) {
                            const int r = rowb + ai * HALF + m * 16;
                            unsigned ow[4];
#pragma unroll
                            for (int n = 0; n < 2; ++n) {
                                const f32x4 cur = acc[ai][bj][m][n]; f32x4 v;
#pragma unroll
                                for (int i = 0; i < 4; ++i) {
                                    const float p1 = rowprev<1>(cur[i], pm[n][i]), p2 = rowprev<2>(cur[i], pm[n][i]), p3 = rowprev<3>(cur[i], pm[n][i]);
                                    v[i] = silu_fast(bb[n][i] + w[0][n][i] * p3 + w[1][n][i] * p2 + w[2][n][i] * p1 + w[3][n][i] * cur[i]);
                                }
                                ow[2 * n] = cvt_pk_bf16(v[0], v[1]); ow[2 * n + 1] = cvt_pk_bf16(v[2], v[3]);
                                pm[n] = cur;
                            }
                            *(u32x4*)(dstb + (size_t)r * CONVD + 32 * bj) = (u32x4){ow[0], ow[1], ow[2], ow[3]};
                        }
                    }
                }
            }
        }
    }
};

struct EpiOut {
    static constexpr bool PERM = true, AFTER_DRAIN = false, MIDK = true;
    const float* xp; const float* xs; const PG8_LAS float* rs; float* out;
    __device__ __forceinline__ void mid(f32x4 (&acc)[2][2][4][2], const Unit& u, int ui, int wr, int wc, int fr, int fq) const {
        const PG8_LAS float* rp = rs + ui * 256 + wr * 64 + fr;
#pragma unroll
        for (int ai = 0; ai < 2; ++ai)
#pragma unroll
            for (int m = 0; m < 4; ++m) {
                const float r = rp[ai * HALF + m * 16];
#pragma unroll
                for (int bj = 0; bj < 2; ++bj)
#pragma unroll
                    for (int n = 0; n < 2; ++n) acc[ai][bj][m][n] *= r;
            }
    }
    __device__ __forceinline__ void operator()(const f32x4 (&acc)[2][2][4][2], const Unit& u, int wr, int wc, int fr, int fq) const {
        const int rowb = u.pm * BM + wr * 64 + fr, col = u.pn * BM + wc * 64 + 8 * fq;
#pragma unroll
        for (int ai = 0; ai < 2; ++ai)
#pragma unroll
            for (int m = 0; m < 4; ++m) {
                const int r = rowb + ai * HALF + m * 16;
                if (r >= NROWS) continue;
                const float* xr = (r < NTOK ? xp + (size_t)r * DM : xs + (size_t)(r - NTOK) * DM) + col;
                float* yr = out + (r < NTOK ? O_YP + (size_t)r * DM : O_YS + (size_t)(r - NTOK) * DM) + col;
#pragma unroll
                for (int bj = 0; bj < 2; ++bj) {
                    *(f32x4*)(yr + 32 * bj) = *(const f32x4*)(xr + 32 * bj) + acc[ai][bj][m][0];
                    *(f32x4*)(yr + 32 * bj + 4) = *(const f32x4*)(xr + 32 * bj + 4) + acc[ai][bj][m][1];
                }
            }
    }
};

template <class Epi, class Sched, bool ALIGN_EPI = false, bool SP2 = false>
__device__ __forceinline__ void gemm_phase(PG8_LAS unsigned char* lds, const Gemm g, const Sched& S, const Epi& E) {
    const int tid = threadIdx.x, wid = __builtin_amdgcn_readfirstlane(tid >> 6), lane = tid & 63, wr = wid >> 2, wc = wid & 3, fr = lane & 15, fq = lane >> 4;
    const int K = g.K, nt = K / BK;
    unsigned voffA[2], voffB[2];
#pragma unroll
    for (int i = 0; i < 2; ++i) { int R, C; stage_rc(tid * 16 + i * 8192, R, C); const int Rb = Epi::PERM ? ((R & ~31) + perm32(R & 31)) : R;
        voffA[i] = (unsigned)(R * K + C) * 2u; voffB[i] = (unsigned)(Rb * K + C) * 2u; }
    const size_t kstep = (size_t)(BK * 2);
    const size_t hstep = (size_t)HALF * K * 2;
    const size_t tstep = 2 * hstep;
    const unsigned ldsw = (unsigned)wid * 1024u;
    const int aoff = lds_byte(wr * 64 + fr, fq * 8), boff = lds_byte(wc * 32 + fr, fq * 8);
#define PG8_SA(b, h) (((b) * 2 + (h)) * HTB)
#define PG8_SB(b, h) ((4 + (b) * 2 + (h)) * HTB)
#define PG8_STAGE(bufoff, gbase, voff) do { _Pragma("unroll") for (int _i = 0; _i < 2; ++_i) \
        __builtin_amdgcn_global_load_lds((const unsigned*)((const char*)(gbase) + (voff)[_i]), (PG8_LAS unsigned*)(lds + (bufoff) + ldsw + _i * 8192), 16, 0, 0); } while (0)
#define PG8_LDA(dst, b, h) do { _Pragma("unroll") for (int m = 0; m < 4; ++m) _Pragma("unroll") for (int k = 0; k < 2; ++k) dst[m][k] = *(const PG8_LAS bf16x8*)(lds + PG8_SA(b, h) + aoff + m * 2048 + k * 1024); } while (0)
#define PG8_LDB(dst, b, h) do { _Pragma("unroll") for (int n = 0; n < 2; ++n) _Pragma("unroll") for (int k = 0; k < 2; ++k) dst[n][k] = *(const PG8_LAS bf16x8*)(lds + PG8_SB(b, h) + boff + n * 2048 + k * 1024); } while (0)
#define PG8_MMA(ai, bj, At, Bt) do { __builtin_amdgcn_s_setprio(1); _Pragma("unroll") for (int m = 0; m < 4; ++m) _Pragma("unroll") for (int n = 0; n < 2; ++n) _Pragma("unroll") for (int k = 0; k < 2; ++k) \
        acc[ai][bj][m][n] = __builtin_amdgcn_mfma_f32_16x16x32_bf16(Bt[n][k], At[m][k], acc[ai][bj][m][n], 0, 0, 0); __builtin_amdgcn_s_setprio(0); } while (0)
#define PG8_WAIT_V(n) asm volatile("s_waitcnt vmcnt(" #n ")" ::: "memory")
#define PG8_WAIT_L(n) asm volatile("s_waitcnt lgkmcnt(" #n ")" ::: "memory")
#define PG8_BAR __builtin_amdgcn_s_barrier()
#define PG8_SCHED __builtin_amdgcn_sched_barrier(0)
    Unit cur, nxt; int ui = 0;
    if (!S.next(0, cur)) return;
    f32x4 acc[2][2][4][2];
#pragma unroll
    for (int a = 0; a < 2; ++a)
#pragma unroll
        for (int b = 0; b < 2; ++b)
#pragma unroll
            for (int m = 0; m < 4; ++m)
#pragma unroll
                for (int n = 0; n < 2; ++n) acc[a][b][m][n] = (f32x4){0.f, 0.f, 0.f, 0.f};
    bf16x8 At[4][2], B0[2][2], B1[2][2];
    const char* cA = (const char*)g.A + (size_t)cur.pm * tstep; const char* cB = (const char*)g.Bt + (size_t)cur.pn * tstep;
    S.a_ready(cur);
    if constexpr (SP2) {
        PG8_STAGE(PG8_SB(0, 0), cB, voffB); PG8_STAGE(PG8_SB(0, 1), cB + hstep, voffB); PG8_STAGE(PG8_SA(0, 0), cA, voffA); PG8_STAGE(PG8_SA(0, 1), cA + hstep, voffA);
        if (wr == 1) PG8_BAR;
        PG8_WAIT_V(2); PG8_BAR;
        PG8_STAGE(PG8_SB(1, 0), cB + kstep, voffB); PG8_STAGE(PG8_SA(1, 0), cA + kstep, voffA); PG8_STAGE(PG8_SB(1, 1), cB + hstep + kstep, voffB);
        PG8_WAIT_V(6); PG8_BAR;
    } else {
        PG8_STAGE(PG8_SB(0, 0), cB, voffB); PG8_STAGE(PG8_SA(0, 0), cA, voffA); PG8_STAGE(PG8_SB(0, 1), cB + hstep, voffB); PG8_STAGE(PG8_SA(0, 1), cA + hstep, voffA);
        if (wr == 1) PG8_BAR;
        PG8_WAIT_V(4); PG8_BAR;
        PG8_STAGE(PG8_SB(1, 0), cB + kstep, voffB); PG8_STAGE(PG8_SA(1, 0), cA + kstep, voffA); PG8_STAGE(PG8_SB(1, 1), cB + hstep + kstep, voffB);
        PG8_WAIT_V(6); PG8_BAR;
    }
    for (;;) {
        const bool has_next = S.next(ui + 1, nxt);
        const char* nA = has_next ? (const char*)g.A + (size_t)nxt.pm * tstep : cA; const char* nB = has_next ? (const char*)g.Bt + (size_t)nxt.pn * tstep : cB;
        for (int t = 0; t < nt; t += 2) {
            const bool last = (t == nt - 2);
            if constexpr (Epi::MIDK) { if (t == (nt >> 1)) E.mid(acc, cur, ui, wr, wc, fr, fq); }
            const char* a1 = cA + (size_t)(t + 1) * kstep;
            const char* a2 = last ? nA : cA + (size_t)(t + 2) * kstep; const char* b2 = last ? nB : cB + (size_t)(t + 2) * kstep;
            const char* a3 = a2 + kstep; const char* b3 = b2 + kstep;
            if (last && has_next) S.a_ready(nxt);
            if constexpr (SP2) {
            PG8_LDB(B0, 0, 0); PG8_LDB(B1, 0, 1); PG8_SCHED; PG8_LDA(At, 0, 0); PG8_STAGE(PG8_SA(1, 1), a1 + hstep, voffA);
            PG8_WAIT_V(8); PG8_WAIT_L(0); PG8_BAR; PG8_MMA(0, 0, At, B0); PG8_MMA(0, 1, At, B1); PG8_BAR; PG8_SCHED;
            PG8_LDA(At, 0, 1); PG8_STAGE(PG8_SB(0, 0), b2, voffB); PG8_STAGE(PG8_SB(0, 1), b2 + hstep, voffB); PG8_STAGE(PG8_SA(0, 0), a2, voffA);
            PG8_WAIT_V(8); PG8_WAIT_L(0); PG8_BAR; PG8_MMA(1, 0, At, B0); PG8_MMA(1, 1, At, B1); PG8_BAR; PG8_SCHED;
            PG8_LDB(B0, 1, 0); PG8_LDB(B1, 1, 1); PG8_SCHED; PG8_LDA(At, 1, 0); PG8_STAGE(PG8_SA(0, 1), a2 + hstep, voffA);
            PG8_WAIT_V(8); PG8_WAIT_L(0); PG8_BAR; PG8_MMA(0, 0, At, B0); PG8_MMA(0, 1, At, B1); PG8_BAR; PG8_SCHED;
            PG8_LDA(At, 1, 1); PG8_STAGE(PG8_SB(1, 0), b3, voffB); PG8_STAGE(PG8_SB(1, 1), b3 + hstep, voffB); PG8_STAGE(PG8_SA(1, 0), a3, voffA);
            PG8_WAIT_V(8); PG8_WAIT_L(0); PG8_BAR; PG8_MMA(1, 0, At, B0); PG8_MMA(1, 1, At, B1); PG8_BAR; PG8_SCHED;
            } else {
            PG8_LDB(B0, 0, 0); PG8_SCHED; PG8_LDA(At, 0, 0); PG8_STAGE(PG8_SA(1, 1), a1 + hstep, voffA);
            PG8_WAIT_L(8); PG8_BAR; PG8_WAIT_L(0); PG8_MMA(0, 0, At, B0); PG8_BAR; PG8_SCHED;
            PG8_LDB(B1, 0, 1); PG8_STAGE(PG8_SB(0, 0), b2, voffB);
            PG8_BAR; PG8_WAIT_L(0); PG8_MMA(0, 1, At, B1); PG8_BAR;
            PG8_LDA(At, 0, 1); PG8_STAGE(PG8_SA(0, 0), a2, voffA);
            PG8_BAR; PG8_WAIT_L(0); PG8_MMA(1, 0, At, B0); PG8_BAR; PG8_SCHED;
            PG8_STAGE(PG8_SB(0, 1), b2 + hstep, voffB);
            PG8_WAIT_V(6); PG8_BAR; PG8_MMA(1, 1, At, B1); PG8_BAR;
            PG8_LDB(B0, 1, 0); PG8_SCHED; PG8_LDA(At, 1, 0); PG8_STAGE(PG8_SA(0, 1), a2 + hstep, voffA);
            PG8_WAIT_L(8); PG8_BAR; PG8_WAIT_L(0); PG8_MMA(0, 0, At, B0); PG8_BAR; PG8_SCHED;
            PG8_LDB(B1, 1, 1); PG8_STAGE(PG8_SB(1, 0), b3, voffB);
            PG8_BAR; PG8_WAIT_L(0); PG8_MMA(0, 1, At, B1); PG8_BAR;
            PG8_LDA(At, 1, 1); PG8_STAGE(PG8_SA(1, 0), a3, voffA);
            PG8_BAR; PG8_WAIT_L(0); PG8_MMA(1, 0, At, B0); PG8_BAR; PG8_SCHED;
            PG8_STAGE(PG8_SB(1, 1), b3 + hstep, voffB);
            PG8_WAIT_V(6); PG8_BAR; PG8_MMA(1, 1, At, B1); PG8_BAR;
            }
        }
        if constexpr (ALIGN_EPI) { if (wr == 0) PG8_BAR; }
        if constexpr (!Epi::AFTER_DRAIN) { E(acc, cur, wr, wc, fr, fq); S.done(cur); }
        if (!has_next) break;
#pragma unroll
        for (int a = 0; a < 2; ++a)
#pragma unroll
            for (int b = 0; b < 2; ++b)
#pragma unroll
                for (int m = 0; m < 4; ++m)
#pragma unroll
                    for (int n = 0; n < 2; ++n) acc[a][b][m][n] = (f32x4){0.f, 0.f, 0.f, 0.f};
        cur = nxt; cA = nA; cB = nB; ++ui;
        if constexpr (ALIGN_EPI) { if (wr == 1) PG8_BAR; }
    }
    PG8_WAIT_V(0);
    if constexpr (!ALIGN_EPI) { if (wr == 0) PG8_BAR; }
    PG8_BAR;
    if constexpr (Epi::AFTER_DRAIN) { E.fused(acc, cur, wr, wc, fr, fq, lds, wid, lane); S.done(cur); }
#undef PG8_SA
#undef PG8_SB
#undef PG8_STAGE
#undef PG8_LDA
#undef PG8_LDB
#undef PG8_MMA
#undef PG8_WAIT_V
#undef PG8_WAIT_L
#undef PG8_BAR
#undef PG8_SCHED
}
}
#define GAS __attribute__((address_space(1)))
#define LAS __attribute__((address_space(3)))
typedef unsigned v4u __attribute__((ext_vector_type(4)));
typedef float f32x4 __attribute__((ext_vector_type(4)));
typedef short bf16x8 __attribute__((ext_vector_type(8)));
typedef GAS unsigned gu32;
typedef GAS unsigned long long gu64;
#define RLX_AGENT __ATOMIC_RELAXED, __HIP_MEMORY_SCOPE_AGENT
#define LDS_WAIT() asm volatile("s_waitcnt lgkmcnt(0)" ::: "memory")
#define VM_WAIT() asm volatile("s_waitcnt vmcnt(0)" ::: "memory")
__device__ __forceinline__ unsigned long long rt() { return __builtin_amdgcn_s_memrealtime(); }

#define XB_TMO      128
#define XB_XCNT(j)  (256  + 64 * (j))
#define XB_XSUB(j)  (1280 + 64 * (j))
#define XB_XGEN(j)  (2304 + 64 * (j))
#define XB_TOP      3328
#define XB_TOPGEN   3392
#define XCD_BAR_WORDS 3456
#define XB_SPIN_CAP (1u << 18)

__device__ __forceinline__ unsigned xb_ld(unsigned* p)              { return __hip_atomic_load(p, __ATOMIC_RELAXED, __HIP_MEMORY_SCOPE_AGENT); }
__device__ __forceinline__ unsigned xb_add(unsigned* p, unsigned v) { return __hip_atomic_fetch_add(p, v, __ATOMIC_RELAXED, __HIP_MEMORY_SCOPE_AGENT); }
__device__ __forceinline__ unsigned xb_xcc_id() { return (unsigned)__builtin_amdgcn_s_getreg((3 << 11) | 20) & 0xFu; }
#define XB_SPIN(cond, bar) do { unsigned _sp = 0; while (cond) { __builtin_amdgcn_s_sleep(1); \
    if ((++_sp & 255u) == 0u) { if (xb_ld(&(bar)[XB_TMO])) break; if (_sp > XB_SPIN_CAP) { atomicAdd(&(bar)[XB_TMO], 1u); break; } } } } while (0)

struct XcdBarrier {
    unsigned* bar; unsigned x;
    volatile LAS unsigned* st;
};

__device__ __forceinline__ XcdBarrier xcd_barrier_post(unsigned* bar, volatile LAS unsigned* st) {
    XcdBarrier b; b.bar = bar; b.x = xb_xcc_id(); b.st = st;
    if (threadIdx.x == 0) (void)xb_add(&bar[XB_XCNT(b.x)], 1u);
    return b;
}
__device__ __forceinline__ void xcd_barrier_complete(unsigned* bar, unsigned x, unsigned& nloc, unsigned& nx) {
    const unsigned G = gridDim.x * gridDim.y * gridDim.z;
    unsigned sum, cnt, mine, sp = 0u;
    for (;;) {
        sum = 0u; cnt = 0u; mine = 0u;
#pragma unroll
        for (unsigned j = 0; j < 16; ++j) { const unsigned c = xb_ld(&bar[XB_XCNT(j)]); sum += c; cnt += (c > 0u) ? 1u : 0u; mine = (j == x) ? c : mine; }
        if (sum == G) break;
        __builtin_amdgcn_s_sleep(1);
        if ((++sp & 255u) == 0u) { if (xb_ld(&bar[XB_TMO])) break; if (sp > XB_SPIN_CAP) { atomicAdd(&bar[XB_TMO], 1u); break; } }
    }
    nloc = mine > 0u ? mine : 1u; nx = cnt > 0u ? cnt : 1u;
}

__device__ __forceinline__ void xcd_barrier(const XcdBarrier& b) {
    asm volatile("s_waitcnt vmcnt(0)" ::: "memory");
    __syncthreads();
    if (threadIdx.x == 0) {
        unsigned* bar = b.bar;
        __builtin_amdgcn_s_waitcnt(0);
        unsigned nloc = b.st[0], nx = b.st[1];
        if (nloc == 0u) { xcd_barrier_complete(bar, b.x, nloc, nx); b.st[0] = nloc; b.st[1] = nx; }
        const unsigned old = xb_add(&bar[XB_XSUB(b.x)], 1u);
        const unsigned gen = old / nloc;
        if (old + 1u == (gen + 1u) * nloc) {
            __builtin_amdgcn_fence(__ATOMIC_RELEASE, "agent");
            asm volatile("s_waitcnt vmcnt(0)" ::: "memory");
            const unsigned og = xb_add(&bar[XB_TOP], 1u);
            const unsigned tg = og / nx;
            if (og + 1u == (tg + 1u) * nx) xb_add(&bar[XB_TOPGEN], 1u);
            else XB_SPIN(xb_ld(&bar[XB_TOPGEN]) == tg, bar);
            __builtin_amdgcn_fence(__ATOMIC_ACQUIRE, "agent");
            xb_add(&bar[XB_XGEN(b.x)], 1u);
            asm volatile("s_waitcnt vmcnt(0)" ::: "memory");
        } else {
            XB_SPIN(xb_ld(&bar[XB_XGEN(b.x)]) == gen, bar);
            __builtin_amdgcn_fence(__ATOMIC_ACQUIRE, "agent");
            asm volatile("s_waitcnt vmcnt(0)" ::: "memory");
        }
    }
    __syncthreads();
}

constexpr int NWAVES = 8;
constexpr int RING_OFF = 0, RING_BYTES = 131072;
constexpr int LDS_BYTES = 163840;
constexpr int LDSCTL_OFF = LDS_BYTES - 512, MISC_OFF = LDSCTL_OFF + 320;
constexpr int CW_BAR = 4096;
constexpr int CW_Q = 16384;
static_assert((CW_BAR + XCD_BAR_WORDS) <= CW_Q && (CW_Q + 64 * 64) * 4 <= (int)CTL_ZERO_BYTES, "CTL words inside the memset region");

constexpr int PROBE_ID = 0;
#define PB_BEGIN(id) long long pb_t0_##id = 0; if (PROBE_ID == (id)) pb_t0_##id = clock64();
#define PB_END(id) if (PROBE_ID == (id)) { const long long t1_ = clock64(), dt_ = t1_ - pb_t0_##id; while (clock64() - t1_ < dt_) __builtin_amdgcn_s_sleep(2); }
struct Frame {
    LAS unsigned char* lds;
    volatile LAS unsigned* MISC;
    gu32* ctl;
    int tid, lane, wave, vcu, G;
    Ins I; float* out;
    bf16 *WinT, *WoutT, *XN, *Q, *K, *V, *AU, *XBC, *Gb, *Zb; float *DT, *SSQ, *RAWB;
};

template <class SrcF>
__device__ __forceinline__ void p0_transpose_item(SrcF src, int k0, int n0, bf16* WT, int dst_pitch, int dst_row0, int dst_k0, LAS float* scr, int lane) {
#pragma unroll 8
    for (int i = 0; i < 32; ++i) { const int kk = 2 * i + (lane >> 5); scr[kk * 33 + (lane & 31)] = src(k0 + kk, n0 + (lane & 31)); }
    LDS_WAIT(); asm volatile("" ::: "memory");
    const int c = lane & 7;
#pragma unroll
    for (int j = 0; j < 4; ++j) { const int n = (lane >> 3) + 8 * j; const LAS float* s = scr + (8 * c) * 33 + n;
        v4u o; o.x = pk2(s[0 * 33], s[1 * 33]); o.y = pk2(s[2 * 33], s[3 * 33]); o.z = pk2(s[4 * 33], s[5 * 33]); o.w = pk2(s[6 * 33], s[7 * 33]);
        *(GAS v4u*)(WT + (size_t)(dst_row0 + n) * dst_pitch + dst_k0 + 8 * c) = o; }
    LDS_WAIT(); asm volatile("" ::: "memory");
}
constexpr int P0_SCR_BYTES = 8448, WDT_OFF = NWAVES * P0_SCR_BYTES, WDT_PITCH = 20;
static_assert(WDT_OFF + 1024 * WDT_PITCH * 4 <= LDSCTL_OFF, "prologue LDS");

__device__ __forceinline__ void p0_prologue(Frame& F) {
    const Ins& I = F.I;
    LAS float* scr = (LAS float*)(F.lds + F.wave * P0_SCR_BYTES);
    LAS float* wdt = (LAS float*)(F.lds + WDT_OFF);
    const int gw = F.vcu * NWAVES + F.wave, NGW = F.G * NWAVES;
    for (int idx = F.tid; idx < 1024 * 16; idx += NWAVES * 64) {
        const int k = idx >> 4, j = idx & 15, pos = (((k >> 8) * 4 + (k & 3)) << 6) + ((k >> 2) & 63);
        wdt[pos * WDT_PITCH + j] = I.w_in[(size_t)k * NPROJ + C_DT + j] * I.norm_w[k];
    }
    constexpr int I_IN = (DM / 64) * (NMAIN / 32), I_OUT = (2048 / 64) * (DM / 32);
    for (int it = gw; it < I_IN + I_OUT; it += NGW) {
        if (it < I_IN) {
            const int nblk = NMAIN / 32, kb = it / nblk, nb = it % nblk, k0 = 64 * kb, n0 = 32 * nb;
            p0_transpose_item([&](int k, int n) { return I.w_in[(size_t)k * NPROJ + n] * I.norm_w[k]; }, k0, n0, F.WinT, DM, (n0 & ~255) + vrow_of_col(n0 & 255), k0, scr, F.lane);
        } else {
            const int r = it - I_IN, nblk = DM / 32, kb = r / nblk, nb = r % nblk, k0 = 64 * kb, n0 = 32 * nb;
            p0_transpose_item([&](int k, int n) { return I.w_out[(size_t)k * DM + n] * (k >= 1024 ? I.ssd_norm_w[k - 1024] : 1.f); }, k0, n0, F.WoutT, 2048, (n0 & ~255) + vrow_of_col(n0 & 255), (k0 + 1024) & 2047, scr, F.lane);
        }
    }
    __syncthreads();
    for (int rp = gw; rp < NROWS / 2; rp += NGW) {
        f32x4 v[2][4]; float rstd[2];
#pragma unroll
        for (int q = 0; q < 2; ++q) {
            const GAS f32x4* xr = (const GAS f32x4*)xrow(I, 2 * rp + q) + F.lane; float s = 0.f;
#pragma unroll
            for (int j = 0; j < 4; ++j) { v[q][j] = xr[64 * j]; s += (v[q][j].x * v[q][j].x + v[q][j].y * v[q][j].y) + (v[q][j].z * v[q][j].z + v[q][j].w * v[q][j].w); }
            rstd[q] = rsqrtf(wave_sum(s) * (1.f / DM) + EPS);
            GAS unsigned long long* o8 = (GAS unsigned long long*)(F.XN + (size_t)(2 * rp + q) * DM) + F.lane;
#pragma unroll
            for (int j = 0; j < 4; ++j) o8[64 * j] = (unsigned long long)pk2(v[q][j].x * rstd[q], v[q][j].y * rstd[q]) | ((unsigned long long)pk2(v[q][j].z * rstd[q], v[q][j].w * rstd[q]) << 32);
        }
        float a[32];
#pragma unroll
        for (int i = 0; i < 32; ++i) a[i] = 0.f;
#pragma unroll
        for (int j = 0; j < 4; ++j)
#pragma unroll
            for (int e = 0; e < 4; ++e) {
                const LAS f32x4* wp = (const LAS f32x4*)(wdt + ((j * 4 + e) * 64 + F.lane) * WDT_PITCH);
                const float x0 = v[0][j][e], x1 = v[1][j][e];
#pragma unroll
                for (int c4 = 0; c4 < 4; ++c4) { const f32x4 w = wp[c4];
#pragma unroll
                    for (int i = 0; i < 4; ++i) { a[c4 * 4 + i] += x0 * w[i]; a[16 + c4 * 4 + i] += x1 * w[i]; } }
                asm volatile("" ::: "memory");
            }
#define P0_HALVE(N, X) { const bool up = (F.lane & (X)) != 0; _Pragma("unroll") for (int i = 0; i < (N); ++i) { const float keep = up ? a[i + (N)] : a[i], send = up ? a[i] : a[i + (N)]; a[i] = keep + __shfl_xor(send, (X)); } }
        P0_HALVE(16, 32) P0_HALVE(8, 16) P0_HALVE(4, 8) P0_HALVE(2, 4) P0_HALVE(1, 2)
#undef P0_HALVE
        float tot = a[0] + __shfl_xor(a[0], 1);
        const int idx = F.lane >> 1, q = idx >> 4, c = idx & 15;
        tot = tot * (q ? rstd[1] : rstd[0]) + I.dt_bias[c];
        if ((F.lane & 1) == 0) F.DT[(size_t)c * MROWS + 2 * rp + q] = softplus_f(tot);
    }
    { v4u* zk = (v4u*)((unsigned char*)F.K - 4 * MiB); v4u* zv = (v4u*)((unsigned char*)F.V - 4 * MiB);
      for (size_t i = (size_t)F.vcu * NWAVES * 64 + F.tid; i < 4 * MiB / 16; i += (size_t)F.G * NWAVES * 64) {
          if (i * 16 >= 4 * MiB - (WS_K - (WS_Q + (size_t)MROWS * DM * 2))) zk[i] = (v4u){0u, 0u, 0u, 0u};
          if (i * 16 >= 4 * MiB - (WS_V - (WS_K + (size_t)MROWS * DM * 2))) zv[i] = (v4u){0u, 0u, 0u, 0u}; } }
    for (int r = NROWS + gw; r < MROWS; r += NGW) { GAS v4u* o = (GAS v4u*)(F.XN + (size_t)r * DM) + F.lane; o[0] = (v4u){0u, 0u, 0u, 0u}; o[64] = (v4u){0u, 0u, 0u, 0u};
                                                   GAS v4u* k = (GAS v4u*)(F.K + (size_t)r * DM) + F.lane; k[0] = (v4u){0u, 0u, 0u, 0u}; k[64] = (v4u){0u, 0u, 0u, 0u}; }
    for (int i = (F.vcu * NWAVES * 64 + F.tid); i < DB * 2 * CONVD; i += F.G * NWAVES * 64) {
        const int c = i % CONVD, rr = i / CONVD, j = rr & 1, b = rr >> 1;
        F.out[O_CS + ((size_t)b * 3 + j) * CONVD + c] = I.sconv[((size_t)b * 3 + j + 1) * CONVD + c];
    }
}

namespace att {
typedef float f32x16 __attribute__((ext_vector_type(16)));
typedef short v4i16_t __attribute__((ext_vector_type(4)));
typedef unsigned u32x4 __attribute__((ext_vector_type(4)));
constexpr int SPAN = 512, NSPAN = SEQ / SPAN, NUNITS = NB * NH * NSPAN;
constexpr int OPITCH = 64  , OACC_OFF = 0, LACC_OFF = SPAN * OPITCH * 4, LUT_OFF = LACC_OFF + 2048, VST_OFF = LUT_OFF + 2048, VST_BYTES = 2048  , ATT_LDS_END = VST_OFF + NWAVES * VST_BYTES;
static_assert(ATT_LDS_END <= LDSCTL_OFF, "attention LDS");
__device__ __forceinline__ int crow(int r, int hi) { return (r & 3) + 8 * (r >> 2) + 4 * hi; }

struct ItemRegs { bf16x8 qf[4]; v4u kreg[4], vreg[4]; unsigned koff, voff; };
struct ItemOut { f32x16 o0, o1; float lsum; };
#define ATT_LOAD_K(R, KT) do { const char* kb_ = (const char*)Kb + ((long)(tq0 + (-128 + 32 * (KT)) * d) * DM) * 2; \
        _Pragma("unroll") for (int i = 0; i < 4; ++i) (R).kreg[i] = *(const v4u*)(kb_ + (R).koff + 32 * i); } while (0)
#define ATT_LOAD_V(R, KT) do { const char* vb_ = (const char*)Vb + ((long)(tq0 + (-128 + 32 * (KT)) * d) * DM) * 2; \
        _Pragma("unroll") for (int i = 0; i < 4; ++i) (R).vreg[i] = *(const v4u*)(vb_ + (R).voff + (unsigned)(i * 8 * d * DM * 2)); } while (0)
template <int NQ>
__device__ __forceinline__ void item_load(ItemRegs& R, const bf16* Qb, const bf16* Kb, const bf16* Vb, int tq0, int d, int lane) {
    const int c = lane & 31, hi = lane >> 5;
    const bf16* qp = Qb + (size_t)(tq0 + (NQ == 32 ? c : (c & 15)) * d) * DM + 8 * hi;
#pragma unroll
    for (int ks = 0; ks < 4; ++ks) R.qf[ks] = *(const bf16x8*)(qp + 16 * ks);
    R.koff = (unsigned)((c * d * DM + 8 * hi) * 2); R.voff = (unsigned)(((lane >> 3) * d * DM + 8 * (lane & 7)) * 2);
    ATT_LOAD_K(R, 0); ATT_LOAD_V(R, 0);
}
template <int NQ>
__device__ __forceinline__ void item_tiles(ItemRegs& R, ItemOut& O, const bf16* Kb, const bf16* Vb, int tq0, int d, int pat, LAS unsigned char* lds, int wave, int lane) {
    const int c = lane & 31, hi = lane >> 5;
    LAS unsigned char* vst = lds + VST_OFF + wave * VST_BYTES;
    const LAS float* lut = (const LAS float*)(lds + LUT_OFF) + pat * 129;
    f32x16 o0 = {}, o1 = {};
    float lsum = 0.f;
    const int lrow = lane >> 3, lch = lane & 7;
    const int stoff = lrow * 128 + ((lch ^ lrow) << 4);
    const int q4 = (lane & 15) >> 2, odd = (lane >> 4) & 1, p4 = lane & 3;
#pragma unroll 1
    for (int kt = 0; kt < 5; ++kt) {
        bf16x8 vb[2][2];
#pragma unroll
        for (int s = 0; s < 2; ++s) {
#pragma unroll
            for (int i = 0; i < 2; ++i) *(LAS v4u*)(vst + i * 1024 + stoff) = R.vreg[2 * s + i];
#pragma unroll
            for (int dh = 0; dh < 2; ++dh) {
                const int kr = 4 * hi + q4, ch16 = 4 * dh + 2 * odd + (p4 >> 1);
                const LAS unsigned char* vp0 = vst + kr * 128 + ((ch16 ^ (kr & 7)) << 4) + (p4 & 1) * 8;
                const LAS unsigned char* vp1 = vst + (kr + 8) * 128 + ((ch16 ^ (kr & 7)) << 4) + (p4 & 1) * 8;
                const v4i16_t lo = __builtin_amdgcn_ds_read_tr16_b64_v4i16((LAS v4i16_t*)vp0), hh = __builtin_amdgcn_ds_read_tr16_b64_v4i16((LAS v4i16_t*)vp1);
                vb[s][dh] = (bf16x8){lo[0], lo[1], lo[2], lo[3], hh[0], hh[1], hh[2], hh[3]};
            }
        }
        bf16x8 kf[4];
#pragma unroll
        for (int ks = 0; ks < 4; ++ks) kf[ks] = __builtin_bit_cast(bf16x8, R.kreg[ks]);
        asm volatile("" ::: "memory");
        if (kt < 4) { ATT_LOAD_K(R, kt + 1); ATT_LOAD_V(R, kt + 1); }
        const int relb = c + 128 - 32 * kt - 4 * hi, tkb = tq0 + (-128 + 32 * kt + 4 * hi) * d;
        const bool edge = (kt == 0 || kt == 4 || tkb < 0);
        f32x16 st;
        if (edge) {
#pragma unroll
            for (int r = 0; r < 16; ++r) { const int rel = relb - ((r & 3) + 8 * (r >> 2)); st[r] = lut[rel < 0 ? 0 : (rel > 128 ? 128 : rel)]; }
        } else {
#pragma unroll
            for (int r = 0; r < 16; ++r) st[r] = lut[relb - ((r & 3) + 8 * (r >> 2))];
        }
#pragma unroll
        for (int ks = 0; ks < 4; ++ks) st = __builtin_amdgcn_mfma_f32_32x32x16_bf16(kf[ks], R.qf[ks], st, 0, 0, 0);
        if (edge) {
#pragma unroll
            for (int r = 0; r < 16; ++r) {
                const int kk = (r & 3) + 8 * (r >> 2), rel = relb - kk;
                const bool valid = (rel >= 0) && (rel <= 128) && (tkb + kk * d >= 0);
                const float pe = __builtin_amdgcn_exp2f(st[r]), p = valid ? pe : 0.f;
                st[r] = p; lsum += p;
            }
        } else {
#pragma unroll
            for (int r = 0; r < 16; ++r) { const float p = __builtin_amdgcn_exp2f(st[r]); st[r] = p; lsum += p; }
        }
        u32x4 pw0, pw1;
        pw0.x = cvtpk_s(st[0], st[1]); pw0.y = cvtpk_s(st[2], st[3]); pw0.z = cvtpk_s(st[4], st[5]); pw0.w = cvtpk_s(st[6], st[7]);
        pw1.x = cvtpk_s(st[8], st[9]); pw1.y = cvtpk_s(st[10], st[11]); pw1.z = cvtpk_s(st[12], st[13]); pw1.w = cvtpk_s(st[14], st[15]);
        const bf16x8 pa0 = __builtin_bit_cast(bf16x8, pw0), pa1 = __builtin_bit_cast(bf16x8, pw1);
        o0 = __builtin_amdgcn_mfma_f32_32x32x16_bf16(pa0, vb[0][0], o0, 0, 0, 0);
        o1 = __builtin_amdgcn_mfma_f32_32x32x16_bf16(pa0, vb[0][1], o1, 0, 0, 0);
        o0 = __builtin_amdgcn_mfma_f32_32x32x16_bf16(pa1, vb[1][0], o0, 0, 0, 0);
        o1 = __builtin_amdgcn_mfma_f32_32x32x16_bf16(pa1, vb[1][1], o1, 0, 0, 0);
    }
    lsum += __shfl_xor(lsum, 32);
    O.o0 = o0; O.o1 = o1; O.lsum = lsum;
}
template <int NQ, bool ACC>
__device__ __forceinline__ void item_acc(const ItemOut& O, int toff, int d, LAS unsigned char* lds, int lane) {
    const int c = lane & 31, hi = lane >> 5;
    LAS float* oacc = (LAS float*)(lds + OACC_OFF); LAS float* lacc = (LAS float*)(lds + LACC_OFF);
    constexpr int NR = NQ == 32 ? 16 : 8;
    LAS float* base = oacc + (toff + 4 * hi * d) * OPITCH + c;
    float a0[NR], a1[NR], lo = 0.f;
    if (ACC) {
#pragma unroll
        for (int r = 0; r < NR; ++r) { const LAS float* row = base + ((r & 3) + 8 * (r >> 2)) * d * OPITCH; a0[r] = row[0]; a1[r] = row[32]; }
        if (hi == 0 && c < NQ) lo = lacc[toff + c * d];
        asm volatile("" ::: "memory");
    }
#pragma unroll
    for (int r = 0; r < NR; ++r) { LAS float* row = base + ((r & 3) + 8 * (r >> 2)) * d * OPITCH; row[0] = ACC ? a0[r] + O.o0[r] : O.o0[r]; row[32] = ACC ? a1[r] + O.o1[r] : O.o1[r]; }
    if (hi == 0 && c < NQ) lacc[toff + c * d] = ACC ? lo + O.lsum : O.lsum;
}

__device__ __forceinline__ void unit(Frame& F, int uidx) {
    const int span = uidx % NSPAN, bh = uidx / NSPAN, h = bh % NH, b = bh / NH, t0 = span * SPAN;
    LAS unsigned char* lds = F.lds;
    LAS float* oacc = (LAS float*)(lds + OACC_OFF); LAS float* lacc = (LAS float*)(lds + LACC_OFF); LAS float* lut = (LAS float*)(lds + LUT_OFF);
    if (F.tid < 387) { const int pat = F.tid / 129, rel = F.tid - pat * 129, d = pat == 0 ? 1 : (pat == 1 ? 4 : 16); lut[F.tid] = F.I.rel_bias[t5_bucket(rel * d) * NH + h] * LOG2E; }
    const size_t boff = (size_t)b * SEQ * DM + h * HD;
    const bf16 *Qb = F.Q + boff, *Kb = F.K + boff, *Vb = F.V + boff;
    const int w = F.wave, lane = F.lane;
    ItemRegs R; ItemOut O;
    const int tqA0 = t0 + 64 * w, tqA1 = tqA0 + 32, tqB0 = t0 + (w & 3) + 256 * (w >> 2), tqB1 = tqB0 + 128, tqC0 = t0 + w, tqC1 = t0 + w + 8;
    item_load<32>(R, Qb, Kb, Vb, tqA0, 1, lane);
    __syncthreads();
    item_tiles<32>(R, O, Kb, Vb, tqA0, 1, 0, lds, w, lane);
    item_load<32>(R, Qb, Kb, Vb, tqA1, 1, lane);
    item_acc<32, false>(O, tqA0 - t0, 1, lds, lane);
    item_tiles<32>(R, O, Kb, Vb, tqA1, 1, 0, lds, w, lane);
    item_load<32>(R, Qb, Kb, Vb, tqB0, 4, lane);
    item_acc<32, false>(O, tqA1 - t0, 1, lds, lane);
    __syncthreads();
    item_tiles<32>(R, O, Kb, Vb, tqB0, 4, 1, lds, w, lane);
    item_load<32>(R, Qb, Kb, Vb, tqB1, 4, lane);
    item_acc<32, true>(O, tqB0 - t0, 4, lds, lane);
    item_tiles<32>(R, O, Kb, Vb, tqB1, 4, 1, lds, w, lane);
    item_load<32>(R, Qb, Kb, Vb, tqC0, 16, lane);
    item_acc<32, true>(O, tqB1 - t0, 4, lds, lane);
    __syncthreads();
    item_tiles<32>(R, O, Kb, Vb, tqC0, 16, 2, lds, w, lane);
    item_load<32>(R, Qb, Kb, Vb, tqC1, 16, lane);
    item_acc<32, true>(O, tqC0 - t0, 16, lds, lane);
    item_tiles<32>(R, O, Kb, Vb, tqC1, 16, 2, lds, w, lane);
    item_acc<32, true>(O, tqC1 - t0, 16, lds, lane);
    __syncthreads();
#pragma unroll 1
    for (int ps = 0; ps < 2; ++ps) {
        const int tl = 64 * w + 32 * ps + (lane >> 1), hf = lane & 1;
        const bf16* gp = F.Gb + ((size_t)b * SEQ + t0 + tl) * DM + h * HD + 32 * hf;
        bf16* ap = F.AU + ((size_t)b * SEQ + t0 + tl) * 2048 + 1024 + h * HD + 32 * hf;
        v4u g[4];
#pragma unroll
        for (int j4 = 0; j4 < 4; ++j4) g[j4] = *(const v4u*)(gp + 8 * j4);
        const float rl = __builtin_amdgcn_rcpf(lacc[tl]);
        const LAS f32x4* op = (const LAS f32x4*)(oacc + tl * OPITCH + 32 * hf);
#pragma unroll
        for (int j4 = 0; j4 < 4; ++j4) {
            const f32x4 a = op[2 * j4], bq = op[2 * j4 + 1]; const v4u gg = g[j4];
            v4u o;
            o.x = pk2(a[0] * rl * __uint_as_float(gg.x << 16), a[1] * rl * __uint_as_float(gg.x & 0xffff0000u));
            o.y = pk2(a[2] * rl * __uint_as_float(gg.y << 16), a[3] * rl * __uint_as_float(gg.y & 0xffff0000u));
            o.z = pk2(bq[0] * rl * __uint_as_float(gg.z << 16), bq[1] * rl * __uint_as_float(gg.z & 0xffff0000u));
            o.w = pk2(bq[2] * rl * __uint_as_float(gg.w << 16), bq[3] * rl * __uint_as_float(gg.w & 0xffff0000u));
            *(v4u*)(ap + 8 * j4) = o;
        }
    }
    __syncthreads();
}

}

namespace ssd {
typedef float f32x16 __attribute__((ext_vector_type(16)));
typedef short v4i16_t __attribute__((ext_vector_type(4)));
typedef unsigned u32x2 __attribute__((ext_vector_type(2)));
typedef float f32x2v __attribute__((ext_vector_type(2)));
constexpr int PITCH = 272;
constexpr int BT_OFF = 0, CT_OFF = 34816, G_OFF = 69632, HB_OFF = 104448, XD_OFF = 121856, XH_OFF = 138240, ACS_OFF = 154624, DTL_OFF = ACS_OFF + 512, SSQL_OFF = DTL_OFF + 512  , XW_OFF = SSQL_OFF + 1024  , FW_OFF = XW_OFF + 1280  , SSD_LDS_END = FW_OFF + 5120;
static_assert(SSD_LDS_END <= LDSCTL_OFF, "SSD LDS");
__device__ __forceinline__ int crow(int r, int hi) { return (r & 3) + 8 * (r >> 2) + 4 * hi; }
__device__ __forceinline__ bf16x8 trfrag(const LAS unsigned char* p0, const LAS unsigned char* p1) {
    const v4i16_t lo = __builtin_amdgcn_ds_read_tr16_b64_v4i16((LAS v4i16_t*)p0), hh = __builtin_amdgcn_ds_read_tr16_b64_v4i16((LAS v4i16_t*)p1);
    return (bf16x8){lo[0], lo[1], lo[2], lo[3], hh[0], hh[1], hh[2], hh[3]};
}
__device__ __forceinline__ float bflo(unsigned w) { return __uint_as_float(w << 16); }
__device__ __forceinline__ float bfhi(unsigned w) { return __uint_as_float(w & 0xffff0000u); }

__device__ __forceinline__ void chain(Frame& F, int item) {
    const Ins& I = F.I;
    const int b = item >> 5, hd = (item >> 1) & 15, seg = item & 1, grp = hd >> 3;
    constexpr int NCH = SEQ / 128, HALF_CH = NCH / 2; const int ch_end = seg ? NCH : HALF_CH;
    const int tid = F.tid, lane = F.lane, w = F.wave, c = lane & 31, hi = lane >> 5;
    LAS unsigned char* lds = F.lds;
    LAS float* acs = (LAS float*)(lds + ACS_OFF); LAS float* dtl = (LAS float*)(lds + DTL_OFF); LAS float* ssql = (LAS float*)(lds + SSQL_OFF);
    const float A = -__expf(I.a_log[hd]), dsk = I.d_skip[hd];
    const size_t row0 = (size_t)b * SEQ;
    for (int i = tid; i < 17408 / 16; i += NWAVES * 64) ((LAS v4u*)(lds + HB_OFF))[i] = (v4u){0u, 0u, 0u, 0u};
    f32x16 hacc = {};
    const int pt = w & 1, jt = w >> 1;
    const int q4 = (lane & 15) >> 2, odd = (lane >> 4) & 1, p4 = lane & 3;
    const int xtr = (8 * hi + q4) * 64 + (16 * odd + 4 * p4) * 2;
    const int xg = tid & 15, xr0 = (tid >> 4) * 4;
    const int fb = tid >> 8, fc = tid & 255;
    for (int i = tid; i < 5 * 64 + 5 * 256; i += NWAVES * 64) {
        if (i < 320) { const int t = i >> 6, e = i & 63; ((LAS float*)(lds + XW_OFF))[i] = t < 4 ? I.conv_w[t * CONVD + hd * 64 + e] : I.conv_b[hd * 64 + e]; }
        else { const int k = i - 320, t = k >> 8, e = k & 255, chn = 1024 + (e < 128 ? grp * 128 + e : 256 + grp * 128 + (e - 128)); ((LAS float*)(lds + FW_OFF))[k] = t < 4 ? I.conv_w[t * CONVD + chn] : I.conv_b[chn]; }
    }
    const int xoff = ((xg >> 3) << 10) + (xg & 7) * 8;
    float dtp0, dtp1; u32x2 xr[7]; v4u bcr[8]; float fxr[6]; u32x2 zr[4];
#define SSD_PREFETCH(T0) do { int t0_ = (T0), tv_ = tid, lv_ = lane; asm volatile("" : "+v"(t0_), "+v"(tv_), "+v"(lv_)); \
        const int xg_ = tv_ & 15, xr0_ = (tv_ >> 4) * 4, fb_ = tv_ >> 8, fc_ = tv_ & 255, fch_ = fc_ < 128 ? grp * 128 + fc_ : 256 + grp * 128 + (fc_ - 128); \
        { const float* dp_ = F.DT + (size_t)hd * MROWS + row0 + t0_ + 2 * lv_; dtp0 = dp_[0]; dtp1 = dp_[1]; } \
        { const bf16* xp_ = F.XBC + (row0 + t0_ + xr0_) * CONVD + hd * 64 + 4 * xg_; \
          _Pragma("unroll") for (int j = 0; j < 7; ++j) xr[j] = (t0_ + xr0_ - 3 + j) >= 0 ? *(const u32x2*)(xp_ + (j - 3) * CONVD) : (u32x2){0u, 0u}; } \
        { const bf16* bp_ = F.XBC + (row0 + t0_ + (tv_ >> 4)) * CONVD + 1024 + grp * 128 + 8 * (tv_ & 15); \
          _Pragma("unroll") for (int k = 0; k < 4; ++k) { bcr[k] = *(const v4u*)(bp_ + (size_t)k * 32 * CONVD); bcr[4 + k] = *(const v4u*)(bp_ + (size_t)k * 32 * CONVD + 256); } } \
        { const size_t blk = (row0 + t0_ + 64 * fb_) >> 6; const bool hasprev = (t0_ + 64 * fb_) > 0; const float* rp_ = F.RAWB + (blk * 6) * 512 + fch_; \
          _Pragma("unroll") for (int j = 0; j < 3; ++j) { fxr[j] = hasprev ? rp_[(j - 6) * 512] : 0.f; fxr[3 + j] = rp_[(3 + j) * 512]; } } \
    } while (0)
#define SSD_PREFETCH_Z(T0) do { int t0_ = (T0), lv_ = lane; asm volatile("" : "+v"(t0_), "+v"(lv_)); \
        const bf16* zp_ = F.Zb + (row0 + t0_ + 32 * jt + (lv_ & 31)) * DM + hd * 64 + 32 * pt + 4 * (lv_ >> 5); \
        _Pragma("unroll") for (int g4 = 0; g4 < 4; ++g4) zr[g4] = *(const u32x2*)(zp_ + 8 * g4); } while (0)
    SSD_PREFETCH(0); if (!seg) SSD_PREFETCH_Z(0);
    __syncthreads();
#pragma unroll 1
    for (int ch = 0; ch < ch_end; ++ch) {
        const int t0 = ch * 128;
        const bool pre = seg && ch < HALF_CH, prevfull = ch > 0 && !(seg && ch - 1 < HALF_CH);
        float aend;
        {
            if (w < 2 && prevfull) { F.SSQ[(row0 + t0 - 128 + lane) * 32 + 2 * hd + w] = ssql[128 * w + lane]; F.SSQ[(row0 + t0 - 64 + lane) * 32 + 2 * hd + w] = ssql[128 * w + 64 + lane]; }
            const float v0 = dtp0 * A, v1 = dtp1 * A; float s = v0 + v1;
#define SSD_DPP_ADD(CTRL, RMASK, BC) s += __builtin_bit_cast(float, __builtin_amdgcn_update_dpp(0, __builtin_bit_cast(int, s), CTRL, RMASK, 0xf, BC))
            SSD_DPP_ADD(0x111, 0xf, true); SSD_DPP_ADD(0x112, 0xf, true); SSD_DPP_ADD(0x114, 0xf, true); SSD_DPP_ADD(0x118, 0xf, true);
            SSD_DPP_ADD(0x142, 0xa, false); SSD_DPP_ADD(0x143, 0xc, false);
#undef SSD_DPP_ADD
            aend = __builtin_bit_cast(float, __builtin_amdgcn_readlane(__builtin_bit_cast(int, s), 63));
            *(LAS f32x2v*)(acs + 2 * lane) = (f32x2v){s - v1, s}; *(LAS f32x2v*)(dtl + 2 * lane) = (f32x2v){dtp0, dtp1};
        }
#pragma unroll
        for (int k = 0; k < 4; ++k) { const int idx = tid + 512 * k, row = idx >> 4;
            if ((row & 63) >= 3) { *(LAS v4u*)(lds + BT_OFF + row * PITCH + 16 * (idx & 15)) = bcr[k]; if (!pre) *(LAS v4u*)(lds + CT_OFF + row * PITCH + 16 * (idx & 15)) = bcr[4 + k]; } }
        if (!pre || fc < 128) {
            LAS unsigned char* dst = lds + (fc < 128 ? BT_OFF + 2 * fc : CT_OFF + 2 * (fc - 128)) + 64 * fb * PITCH;
            const LAS float* fwp = (const LAS float*)(lds + FW_OFF) + fc;
            const float fw0 = fwp[0], fw1 = fwp[256], fw2 = fwp[512], fw3 = fwp[768], fbias = fwp[1024];
#pragma unroll
            for (int j = 0; j < 3; ++j) *(LAS bf16*)(dst + j * PITCH) = (bf16)f2bf(silu_fast(fbias + fw0 * fxr[j] + fw1 * fxr[j + 1] + fw2 * fxr[j + 2] + fw3 * fxr[j + 3]));
        }
        {
            const LAS f32x4* xwp = (const LAS f32x4*)(lds + XW_OFF) + xg;
            const f32x4 xw0 = xwp[0], xw1 = xwp[16], xw2 = xwp[32], xw3 = xwp[48], xb = xwp[64];
            float xv[7][4];
#pragma unroll
            for (int j = 0; j < 7; ++j) { xv[j][0] = bflo(xr[j].x); xv[j][1] = bfhi(xr[j].x); xv[j][2] = bflo(xr[j].y); xv[j][3] = bfhi(xr[j].y); }
#pragma unroll
            for (int i = 0; i < 4; ++i) {
                const int s = xr0 + i; const float dt = dtl[s], de = dt * __expf(aend - acs[s]); float v[4];
#pragma unroll
                for (int e = 0; e < 4; ++e) v[e] = silu_fast(xb[e] + xw0[e] * xv[i][e] + xw1[e] * xv[i + 1][e] + xw2[e] * xv[i + 2][e] + xw3[e] * xv[i + 3][e]);
                const int off = ((s >> 4) << 11) + xoff + (s & 15) * 64;
                *(LAS u32x2*)(lds + XD_OFF + off) = (u32x2){cvtpk_s(v[0] * dt, v[1] * dt), cvtpk_s(v[2] * dt, v[3] * dt)};
                *(LAS u32x2*)(lds + XH_OFF + off) = (u32x2){cvtpk_s(v[0] * de, v[1] * de), cvtpk_s(v[2] * de, v[3] * de)};
            }
        }
        asm volatile("" ::: "memory"); __builtin_amdgcn_sched_barrier(0);
        if (ch + 1 < ch_end) SSD_PREFETCH(t0 + 128);
        __syncthreads();
        f32x16 yt = {};
        if (!pre) {
        {
            const int j = w & 3; const float al = acs[32 * j + c];
#pragma unroll
            for (int ii = 0; ii < 2; ++ii) {
                const int i = 2 * (w >> 2) + ii;
                if (i <= j) {
                    f32x16 x = {};
                    const LAS unsigned char* ap = lds + BT_OFF + (32 * i + c) * PITCH + 16 * hi;
                    const LAS unsigned char* bp = lds + CT_OFF + (32 * j + c) * PITCH + 16 * hi;
#pragma unroll 4
                    for (int ks = 0; ks < 8; ++ks) x = __builtin_amdgcn_mfma_f32_32x32x16_bf16(*(const LAS bf16x8*)(ap + 32 * ks), *(const LAS bf16x8*)(bp + 32 * ks), x, 0, 0, 0);
                    const int l = 32 * j + c;
#pragma unroll
                    for (int g4 = 0; g4 < 4; ++g4) {
                        const int sb = 32 * i + 8 * g4 + 4 * hi; float gv[4];
                        const f32x4 as4 = *(const LAS f32x4*)(acs + sb);
#pragma unroll
                        for (int e = 0; e < 4; ++e) { const int s = sb + e; gv[e] = s <= l ? x[4 * g4 + e] * __builtin_amdgcn_exp2f((al - as4[e]) * LOG2E) : 0.f; }
                        *(LAS u32x2*)(lds + G_OFF + l * PITCH + sb * 2) = (u32x2){cvtpk_s(gv[0], gv[1]), cvtpk_s(gv[2], gv[3])};
                    }
                }
            }
        }
        {
            const LAS unsigned char* ap = lds + HB_OFF + (32 * pt + c) * PITCH + 16 * hi;
            const LAS unsigned char* bp = lds + CT_OFF + (32 * jt + c) * PITCH + 16 * hi;
#pragma unroll 4
            for (int ks = 0; ks < 8; ++ks) yt = __builtin_amdgcn_mfma_f32_32x32x16_bf16(*(const LAS bf16x8*)(ap + 32 * ks), *(const LAS bf16x8*)(bp + 32 * ks), yt, 0, 0, 0);
            const float el = __expf(acs[32 * jt + c]);
#pragma unroll
            for (int r = 0; r < 16; ++r) yt[r] *= el;
        }
        __syncthreads();
        {
            const LAS unsigned char* bp = lds + G_OFF + (32 * jt + c) * PITCH + 16 * hi;
            for (int ks = 0; ks < 2 * jt + 2; ++ks) {
                const LAS unsigned char* xp = lds + XD_OFF + ((ks * 2 + pt) << 10) + xtr;
                yt = __builtin_amdgcn_mfma_f32_32x32x16_bf16(trfrag(xp, xp + 256), *(const LAS bf16x8*)(bp + 32 * ks), yt, 0, 0, 0);
            }
        }
        }
        {
            const float ea = __expf(aend);
#pragma unroll
            for (int r = 0; r < 16; ++r) hacc[r] *= ea;
            const int btr = (8 * hi + q4) * PITCH + (32 * jt + 16 * odd + 4 * p4) * 2;
#pragma unroll 4
            for (int ks = 0; ks < 8; ++ks) {
                const LAS unsigned char* xp = lds + XH_OFF + ((ks * 2 + pt) << 10) + xtr;
                const LAS unsigned char* bp = lds + BT_OFF + 16 * ks * PITCH + btr;
                hacc = __builtin_amdgcn_mfma_f32_32x32x16_bf16(trfrag(xp, xp + 256), trfrag(bp, bp + 4 * PITCH), hacc, 0, 0, 0);
            }
        }
        if (!pre) {
            const int l = 32 * jt + c; const float rdt = dsk * __builtin_amdgcn_rcpf(dtl[l]);
            bf16* up = F.AU + (row0 + t0 + l) * 2048 + hd * 64 + 32 * pt;
            float sq = 0.f;
#pragma unroll
            for (int g4 = 0; g4 < 4; ++g4) {
                const int pl = 8 * g4 + 4 * hi;
                const u32x2 xw2 = *(const LAS u32x2*)(lds + XD_OFF + (((l >> 4) * 2 + pt) << 10) + (l & 15) * 64 + pl * 2);
                const u32x2 zw = zr[g4];
                const float u0 = (yt[4 * g4] + rdt * bflo(xw2.x)) * bflo(zw.x), u1 = (yt[4 * g4 + 1] + rdt * bfhi(xw2.x)) * bfhi(zw.x), u2 = (yt[4 * g4 + 2] + rdt * bflo(xw2.y)) * bflo(zw.y), u3 = (yt[4 * g4 + 3] + rdt * bfhi(xw2.y)) * bfhi(zw.y);
                sq += (u0 * u0 + u1 * u1) + (u2 * u2 + u3 * u3);
                *(u32x2*)(up + pl) = (u32x2){cvtpk_s(u0, u1), cvtpk_s(u2, u3)};
            }
            sq += __shfl_xor(sq, 32);
            if (hi == 0) ssql[128 * pt + l] = sq;
        }
        if (ch + 1 < ch_end && !(seg && ch + 1 < HALF_CH)) SSD_PREFETCH_Z(t0 + 128);
        __syncthreads();
        if (!(seg && ch + 1 < HALF_CH))
#pragma unroll
        for (int r = 0; r < 16; ++r) *(LAS bf16*)(lds + HB_OFF + (32 * pt + crow(r, hi)) * PITCH + (32 * jt + c) * 2) = (bf16)f2bf(hacc[r]);
    }
#undef SSD_PREFETCH
#undef SSD_PREFETCH_Z
    if (w < 2) { const int t0 = ch_end * 128; F.SSQ[(row0 + t0 - 128 + lane) * 32 + 2 * hd + w] = ssql[128 * w + lane]; F.SSQ[(row0 + t0 - 64 + lane) * 32 + 2 * hd + w] = ssql[128 * w + 64 + lane]; }
    if (seg) {
    float* ho = F.out + O_HP + (((size_t)b * NH + hd) * HD + 32 * pt) * DS + 32 * jt + c;
#pragma unroll
    for (int r = 0; r < 16; ++r) ho[(size_t)crow(r, hi) * DS] = hacc[r];
    }
    __syncthreads();
}
}

namespace smp {
__device__ __forceinline__ void attn_unit(Frame& F, int bhs) {
    const Ins& I = F.I;
    const int lane = F.lane, w = F.wave, b = bhs >> 4, h = bhs & 15, r = NTOK + b;
    LAS float* qs = (LAS float*)(F.lds + 4096); LAS float* acc = (LAS float*)F.lds;
    LAS float* ps = (LAS float*)(F.lds + 8192) + w * 64;
    if (F.tid < 64) qs[F.tid] = bf2f(F.Q[(size_t)r * DM + h * HD + F.tid]);
    if (F.tid < 65) acc[F.tid] = 0.f;
    __syncthreads();
    const int k0 = 49 * w, nk = (387 - k0) < 49 ? (387 - k0) : 49;
    float p = 0.f;
    if (lane < nk) {
        const int idx = k0 + lane, pat = idx / 129, j = idx - pat * 129, d = pat == 0 ? 1 : (pat == 1 ? 4 : 16);
        float s = 0.f;
        if (j > 0) { const f32x4* kp = (const f32x4*)(I.ck + (((size_t)b * WIN + (WIN - j * d)) * NH + h) * HD);
#pragma unroll
            for (int e = 0; e < 16; ++e) { const f32x4 kv = kp[e]; const f32x4 qv = *(const LAS f32x4*)(qs + 4 * e); s += (qv[0] * kv[0] + qv[1] * kv[1]) + (qv[2] * kv[2] + qv[3] * kv[3]); } }
        else { const bf16* kp = F.K + (size_t)r * DM + h * HD; for (int e = 0; e < 64; ++e) s += qs[e] * bf2f(kp[e]); }
        p = __builtin_amdgcn_exp2f(s + I.rel_bias[t5_bucket(j * d) * NH + h] * LOG2E);
    }
    ps[lane] = p;
    const float lsum = wave_sum(p);
    __builtin_amdgcn_wave_barrier();
    float o0 = 0.f, o1 = 0.f, o2 = 0.f, o3 = 0.f;
    const float vnew = bf2f(F.V[(size_t)r * DM + h * HD + lane]);
    const float* vbase = I.cv + ((size_t)b * WIN * NH + h) * HD + lane;
#define SMP_V(K) ({ const int idx_ = k0 + (K), pat_ = idx_ / 129, j_ = idx_ - pat_ * 129, d_ = pat_ == 0 ? 1 : (pat_ == 1 ? 4 : 16); \
                    (K) < nk ? ps[(K)] * (j_ > 0 ? vbase[(size_t)(WIN - j_ * d_) * (NH * HD)] : vnew) : 0.f; })
#pragma unroll
    for (int k = 0; k < 48; k += 4) { o0 += SMP_V(k); o1 += SMP_V(k + 1); o2 += SMP_V(k + 2); o3 += SMP_V(k + 3); }
    o0 += SMP_V(48);
#undef SMP_V
    __hip_atomic_fetch_add(acc + lane, (o0 + o1) + (o2 + o3), __ATOMIC_RELAXED, __HIP_MEMORY_SCOPE_WORKGROUP);
    if (lane == 0) __hip_atomic_fetch_add(acc + 64, lsum, __ATOMIC_RELAXED, __HIP_MEMORY_SCOPE_WORKGROUP);
    __syncthreads();
    if (F.tid < 64) F.AU[(size_t)r * 2048 + 1024 + h * HD + F.tid] = (bf16)f2bf(acc[F.tid] * __builtin_amdgcn_rcpf(acc[64]) * bf2f(F.Gb[(size_t)r * DM + h * HD + F.tid]));
    __syncthreads();
}

__device__ __forceinline__ void ssd_unit(Frame& F, int bhs) {
    const Ins& I = F.I;
    LAS float* xs_l = (LAS float*)F.lds; LAS float* B_l = xs_l + 64; LAS float* C_l = B_l + 128; LAS float* ssq_l = C_l + 128;
    const int tid = F.tid, p = tid >> 3, ng = tid & 7;
    const int b = bhs >> 4, hd = bhs & 15, grp = hd >> 3; const size_t r = (size_t)NTOK + b;
    float h[16];
    { const f32x4* hp = (const f32x4*)(I.sssm + (((size_t)b * NH + hd) * HD + p) * DS + ng * 16);
#pragma unroll
      for (int i = 0; i < 4; ++i) { const f32x4 v = hp[i]; h[4 * i] = v[0]; h[4 * i + 1] = v[1]; h[4 * i + 2] = v[2]; h[4 * i + 3] = v[3]; } }
    if (tid < 320) {
        const int ci = tid, c = ci < 64 ? hd * 64 + ci : (ci < 192 ? 1024 + grp * 128 + (ci - 64) : 1280 + grp * 128 + (ci - 192));
        float v = I.conv_b[c];
#pragma unroll
        for (int i = 0; i < 3; ++i) v += I.sconv[((size_t)b * 3 + i) * CONVD + c] * I.conv_w[i * CONVD + c];
        v += bf2f(F.XBC[r * CONVD + c]) * I.conv_w[3 * CONVD + c];
        xs_l[ci] = silu_f(v);
    }
    if (tid == 0) ssq_l[0] = 0.f;
    __syncthreads();
    const float dt = F.DT[(size_t)hd * MROWS + r], A = -__expf(I.a_log[hd]), x = xs_l[p], dec = __expf(dt * A), xdt = x * dt;
    float y = 0.f;
#pragma unroll
    for (int i = 0; i < 16; ++i) { h[i] = h[i] * dec + xdt * B_l[ng * 16 + i]; y += h[i] * C_l[ng * 16 + i]; }
    y += __shfl_xor(y, 1); y += __shfl_xor(y, 2); y += __shfl_xor(y, 4);
    if (ng == 0) {
        const float u = (y + I.d_skip[hd] * x) * bf2f(F.Zb[r * DM + hd * 64 + p]);
        F.AU[r * 2048 + hd * 64 + p] = (bf16)f2bf(u);
        __hip_atomic_fetch_add(ssq_l, u * u, __ATOMIC_RELAXED, __HIP_MEMORY_SCOPE_WORKGROUP);
    }
    { f32x4* ho = (f32x4*)(F.out + O_HS + (((size_t)b * NH + hd) * HD + p) * DS + ng * 16);
#pragma unroll
      for (int i = 0; i < 4; ++i) ho[i] = (f32x4){h[4 * i], h[4 * i + 1], h[4 * i + 2], h[4 * i + 3]}; }
    __syncthreads();
    if (tid == 0) { F.SSQ[r * 32 + 2 * hd] = ssq_l[0]; F.SSQ[r * 32 + 2 * hd + 1] = 0.f; }
    __syncthreads();
}
}

namespace smp {
typedef float f32x16s __attribute__((ext_vector_type(16)));
template <int KS>
__device__ __forceinline__ void mm32x32(Frame& F, const bf16* WT, int wrow0, const bf16* A, int apitch, int K) {
    const int lane = F.lane, w = F.wave, c = lane & 31, hi = lane >> 5;
    const bf16* ap = WT + (size_t)(wrow0 + c) * K + w * (16 * KS) + 8 * hi;
    const bf16* bp = A + (size_t)c * apitch + w * (16 * KS) + 8 * hi;
    bf16x8 af[KS], bf[KS];
#pragma unroll
    for (int ks = 0; ks < KS; ++ks) { af[ks] = *(const bf16x8*)(ap + 16 * ks); bf[ks] = *(const bf16x8*)(bp + 16 * ks); }
    f32x16s acc = {};
#pragma unroll
    for (int ks = 0; ks < KS; ++ks) acc = __builtin_amdgcn_mfma_f32_32x32x16_bf16(af[ks], bf[ks], acc, 0, 0, 0);
    LAS float* red = (LAS float*)F.lds + w * 1024;
#pragma unroll
    for (int r = 0; r < 16; ++r) red[((r & 3) + 8 * (r >> 2) + 4 * hi) * 32 + c] = acc[r];
    __syncthreads();
}
__device__ __forceinline__ void inproj_pair(Frame& F, int hp) {
    const Ins& I = F.I;
    const int a0 = 64 * hp;
    LAS float* val = (LAS float*)(F.lds + 32768);
    const int lane = F.lane, w = F.wave;
#pragma unroll 1
    for (int hf = 0; hf < 2; ++hf) {
        const int a = a0 + 32 * hf;
        mm32x32<8>(F, F.WinT, (a & ~255) + vrow_of_col(a & 255), F.XN + (size_t)NTOK * DM, DM, DM);
        const LAS float* red = (const LAS float*)F.lds;
        { const int col = F.tid >> 4, r0 = 2 * (F.tid & 15); float s0 = 0.f, s1 = 0.f;
#pragma unroll
          for (int k = 0; k < 8; ++k) { s0 += red[k * 1024 + col * 32 + r0]; s1 += red[k * 1024 + col * 32 + r0 + 1]; }
          val[r0 * 64 + 32 * hf + col] = s0; val[(r0 + 1) * 64 + 32 * hf + col] = s1; }
        __syncthreads();
    }
#pragma unroll 1
    for (int rr = 0; rr < 4; ++rr) {
        const int r = 4 * w + rr;
        const float v = val[r * 64 + lane];
        const size_t row = (size_t)NTOK + r; const int col = a0 + lane;
        if (col < C_V) {
            const float sc = rsqrtf(wave_sum(v * v) * (1.f / 64.f) + EPS);
            if (col < C_K) F.Q[row * DM + col] = (bf16)f2bf(v * sc * I.qnw[lane] * QSCALE);
            else { const float kv = v * sc * I.knw[lane]; F.K[row * DM + col - C_K] = (bf16)f2bf(kv); F.out[O_KS + (size_t)r * DM + col - C_K] = kv; }
        } else if (col < C_G) { F.V[row * DM + col - C_V] = (bf16)f2bf(v); F.out[O_VS + (size_t)r * DM + col - C_V] = v; }
        else if (col < C_Z) F.Gb[row * DM + col - C_G] = (bf16)f2bf(silu_fast(v));
        else if (col < C_XBC) F.Zb[row * DM + col - C_Z] = (bf16)f2bf(silu_fast(v));
        else { F.XBC[row * CONVD + col - C_XBC] = (bf16)f2bf(v); F.out[O_CS + ((size_t)r * 3 + 2) * CONVD + col - C_XBC] = v; }
    }
    __syncthreads();
}
__device__ __forceinline__ void outproj_unit(Frame& F, int ct) {
    const Ins& I = F.I;
    const int a0 = 32 * ct;
    mm32x32<16>(F, F.WoutT, (a0 & ~255) + vrow_of_col(a0 & 255), F.AU + (size_t)NTOK * 2048, 2048, 2048);
    const LAS float* red = (const LAS float*)F.lds;
    const int col = F.tid >> 4, r0 = 2 * (F.tid & 15);
#pragma unroll
    for (int q = 0; q < 2; ++q) {
        const int r = r0 + q; float su = 0.f, sa = 0.f;
#pragma unroll
        for (int k = 0; k < 4; ++k) { su += red[k * 1024 + col * 32 + r]; sa += red[(4 + k) * 1024 + col * 32 + r]; }
        const f32x4* sp = (const f32x4*)(F.SSQ + ((size_t)NTOK + r) * 32); float s = 0.f;
#pragma unroll
        for (int i = 0; i < 8; ++i) { const f32x4 t = sp[i]; s += (t[0] + t[1]) + (t[2] + t[3]); }
        F.out[O_YS + (size_t)r * DM + a0 + col] = I.xs[(size_t)r * DM + a0 + col] + su * rsqrtf(s * (1.f / 1024.f) + EPS) + sa;
    }
    __syncthreads();
}
}

__device__ __forceinline__ void phase2_queue(Frame& F, int qset) {
    const unsigned x = xb_xcc_id() & 7u;
    constexpr int PER_Q = att::NUNITS / 8;
    for (unsigned k = 0; k < 8; ++k) {
        const unsigned qx = (x + k) & 7u;
        gu32* qw = F.ctl + CW_Q + 64 * (8 * qset + qx);
        if (F.tid == 0) F.MISC[16] = __hip_atomic_fetch_add(qw, 1u, RLX_AGENT);
        __syncthreads();
        unsigned idx = F.MISC[16];
        while (idx < (unsigned)(PER_Q + 128)) {
            unsigned nxt = 0u;
            if (F.tid == 0) nxt = __hip_atomic_fetch_add(qw, 1u, RLX_AGENT);
            if (idx < 64u) smp::attn_unit(F, (int)(qx * 64 + idx));
            else if (idx < 128u) smp::ssd_unit(F, (int)(qx * 64 + idx - 64));
            else { { PB_BEGIN(32) att::unit(F, (int)(qx * PER_Q + idx - 128)); PB_END(32) } if (PROBE_ID == 31) { const unsigned long long t0_ = __builtin_amdgcn_s_memrealtime(); while (__builtin_amdgcn_s_memrealtime() - t0_ < 2000ull) __builtin_amdgcn_s_sleep(8); } }
            if (F.tid == 0) F.MISC[16] = nxt;
            __syncthreads();
            idx = F.MISC[16];
        }
        __syncthreads();
    }
}

constexpr int PROBE_REP_SSD = 1, PROBE_REP_ATT = 1;
struct Args { Ins in; float* out; unsigned char* ws; int ph_lo, ph_hi; };
__global__ void __launch_bounds__(NWAVES * 64, 2) mk_fwd(Args args) {
    extern __shared__ __attribute__((aligned(16))) unsigned char lds[];
    Frame F;
    F.lds = (LAS unsigned char*)lds;
    F.MISC = (volatile LAS unsigned*)(F.lds + MISC_OFF);
    F.tid = threadIdx.x; F.lane = F.tid & 63; F.wave = __builtin_amdgcn_readfirstlane(F.tid >> 6);
    F.G = gridDim.x; { const int bx = blockIdx.x; F.vcu = (F.G % 8 == 0) ? (bx % 8) * (F.G / 8) + bx / 8 : bx; }
    unsigned char* ws = args.ws;
    F.ctl = (gu32*)(ws + WS_CTL); F.I = args.in; F.out = args.out;
    F.WinT = (bf16*)(ws + WS_WIN); F.WoutT = (bf16*)(ws + WS_WOUT); F.XN = (bf16*)(ws + WS_XN); F.Q = (bf16*)(ws + WS_Q); F.K = (bf16*)(ws + WS_K); F.V = (bf16*)(ws + WS_V);
    F.AU = (bf16*)(ws + WS_AU); F.XBC = (bf16*)(ws + WS_XBC); F.DT = (float*)(ws + WS_DT); F.SSQ = (float*)(ws + WS_SSQ); F.RAWB = (float*)(ws + WS_RAWB); F.Gb = (bf16*)(ws + WS_G); F.Zb = (bf16*)(ws + WS_Z);
    for (int u = F.tid; u < (LDS_BYTES - LDSCTL_OFF) / 4; u += NWAVES * 64) ((LAS unsigned*)(F.lds + LDSCTL_OFF))[u] = 0u;
    __syncthreads();
    XcdBarrier bar = xcd_barrier_post((unsigned*)(F.ctl + CW_BAR), F.MISC + 8);
    const int lo = args.ph_lo, hi = args.ph_hi;
#define IN(k) (lo <= (k) && (k) < hi)
#define BOTH(k) (IN(k) && IN((k) + 1))
    if (IN(0)) { p0_prologue(F); if (BOTH(0)) xcd_barrier(bar); }
    if (IN(1)) {
        __syncthreads();
        pg8::Gemm g{F.XN, F.WinT, NTOK, NMAIN, DM}; pg8::StaticOrder S; S.init(NTOK, NMAIN, F.G, (int)blockIdx.x);
        pg8::EpiIn E{F.Q, F.K, F.V, F.Gb, F.Zb, F.XBC, F.out, F.I.qnw, F.I.knw, F.I.conv_w, F.I.conv_b, F.RAWB};
        pg8::gemm_phase<pg8::EpiIn, pg8::StaticOrder, true, true>(F.lds + RING_OFF, g, S, E);
        __syncthreads();
        for (int hp = F.vcu; hp < NMAIN / 64; hp += F.G) smp::inproj_pair(F, hp);
        if (BOTH(1)) xcd_barrier(bar);
    }
    if (IN(2)) { __syncthreads(); if ((F.vcu & 31) < 16 && (F.vcu >> 5) < 8) { ssd::chain(F, (F.vcu >> 5) * 16 + (F.vcu & 31)); if (PROBE_ID == 30 && (F.vcu & 1)) { const unsigned long long t0_ = __builtin_amdgcn_s_memrealtime(); while (__builtin_amdgcn_s_memrealtime() - t0_ < 10000ull) __builtin_amdgcn_s_sleep(8); } } for (int rep = 0; rep < PROBE_REP_ATT; ++rep) phase2_queue(F, rep);     if (BOTH(2)) xcd_barrier(bar); }
    if (IN(3)) {
        __syncthreads();
        pg8::Gemm g{F.AU, F.WoutT, NTOK, DM, 2048}; pg8::StaticOrder S; S.init(NTOK, DM, F.G, (int)blockIdx.x);
        LAS float* rs = (LAS float*)(F.lds + RING_BYTES);
        { pg8::Unit u;
          for (int ui = 0; ui < 4 && S.next(ui, u); ++ui)
              for (int r = F.tid; r < 256; r += NWAVES * 64) {
                  const f32x4* sp = (const f32x4*)(F.SSQ + (size_t)(u.pm * 256 + r) * 32);
                  float s = 0.f;
#pragma unroll
                  for (int q = 0; q < 8; ++q) { const f32x4 v = sp[q]; s += (v[0] + v[1]) + (v[2] + v[3]); }
                  rs[ui * 256 + r] = rsqrtf(s * (1.f / 1024.f) + EPS);
              }
          __syncthreads(); }
        pg8::EpiOut E{F.I.xp, F.I.xs, rs, F.out};
        pg8::gemm_phase<pg8::EpiOut, pg8::StaticOrder, true, true>(F.lds + RING_OFF, g, S, E);
        __syncthreads();
        for (int ct = F.G - 1 - F.vcu; ct >= 0 && ct < DM / 32; ct += F.G) smp::outproj_unit(F, ct);
    }
#undef IN
#undef BOTH
}

extern "C" void kernel_launch(void* const* d_in, const int* in_sizes, int n_in, void* d_out, int out_size, void* d_ws, size_t ws_size, hipStream_t stream) {
    static int grid = 0;
    if (grid == 0) {
        if (n_in != 18 || out_size != (int)O_END || ws_size < WS_END) { fprintf(stderr, "kernel_launch: unexpected n_in %d / out_size %d / ws_size %zu; nothing launched\n", n_in, out_size, ws_size); grid = -1; return; }
        int dev = 0, cus = 0;
        if (hipGetDevice(&dev) != hipSuccess || hipDeviceGetAttribute(&cus, hipDeviceAttributeMultiprocessorCount, dev) != hipSuccess) { grid = -1; return; }
        if (hipFuncSetAttribute((const void*)mk_fwd, hipFuncAttributeMaxDynamicSharedMemorySize, LDS_BYTES) != hipSuccess) { fprintf(stderr, "kernel_launch: hipFuncSetAttribute failed\n"); grid = -1; return; }
        (void)hipGetLastError();
        grid = cus;
    }
    if (grid < 0) return;
    (void)hipMemsetAsync((char*)d_ws + WS_CTL, 0, CTL_ZERO_BYTES, stream);
    Args a{};
    const float** ip = (const float**)&a.in;
    for (int i = 0; i < 18; ++i) ip[i] = (const float*)d_in[i];
    a.out = (float*)d_out; a.ws = (unsigned char*)d_ws;
    a.ph_lo = 0; a.ph_hi = 4;
    hipLaunchKernelGGL(mk_fwd, dim3(grid), dim3(NWAVES * 64), LDS_BYTES, stream, a);
}
```

```cpp
#include <hip/hip_runtime.h>
#include <cstdio>
#include <cstdint>

constexpr int DM = 1024, NB = 4, SEQ = 8192, DB = 32, WIN = 2048;
constexpr int NPROJ = 6672, NMAIN = 6656, NTOK = NB * SEQ, NROWS = NTOK + DB;
constexpr int MROWS = 33024;
constexpr int C_Q = 0, C_K = 1024, C_V = 2048, C_G = 3072, C_Z = 4096, C_XBC = 5120, C_DT = 6656;
constexpr int CONVD = 1536, NH = 16, HD = 64, DS = 128;
constexpr float EPS = 1e-6f;
constexpr float QSCALE = 0.125f * 1.4426950408889634f;
constexpr float LOG2E = 1.4426950408889634f;
constexpr size_t O_YP = 0, O_YS = O_YP + (size_t)NTOK * DM, O_KP = O_YS + (size_t)DB * DM, O_VP = O_KP + (size_t)NB * WIN * DM,
                 O_CP = O_VP + (size_t)NB * WIN * DM, O_HP = O_CP + (size_t)NB * 3 * CONVD, O_KS = O_HP + (size_t)NB * NH * HD * DS,
                 O_VS = O_KS + (size_t)DB * DM, O_CS = O_VS + (size_t)DB * DM, O_HS = O_CS + (size_t)DB * 3 * CONVD,
                 O_END = O_HS + (size_t)DB * NH * HD * DS;
static_assert(O_END == 55314432, "output size");

constexpr size_t MiB = 1u << 20;
constexpr size_t WS_CTL = 0, CTL_ZERO_BYTES = 1 * MiB;
constexpr size_t WS_WIN = 2 * MiB;
constexpr size_t WS_WOUT = 16 * MiB;
constexpr size_t WS_DT = 20 * MiB;
constexpr size_t WS_SSQ = 24 * MiB;
constexpr size_t WS_XN = 32 * MiB;
constexpr size_t WS_Q = 100 * MiB;
constexpr size_t WS_K = 168 * MiB;
constexpr size_t WS_V = 236 * MiB;
constexpr size_t WS_AU = 304 * MiB;
constexpr size_t WS_XBC = 436 * MiB;
constexpr size_t WS_RAWB = 536 * MiB;
constexpr size_t WS_G = 544 * MiB;
constexpr size_t WS_Z = 612 * MiB;
constexpr size_t WS_END = 680 * MiB;
static_assert(WS_XN + (size_t)MROWS * DM * 2 <= WS_Q && WS_Q + (size_t)MROWS * DM * 2 <= WS_K && WS_K + (size_t)MROWS * DM * 2 <= WS_V && WS_V + (size_t)MROWS * DM * 2 <= WS_AU &&
              WS_AU + (size_t)MROWS * 2048 * 2 <= WS_XBC && WS_XBC + (size_t)MROWS * CONVD * 2 <= WS_RAWB && WS_RAWB + (size_t)(MROWS / 64) * 6 * 512 * 4 <= WS_G && WS_G + (size_t)MROWS * DM * 2 <= WS_Z && WS_Z + (size_t)MROWS * DM * 2 <= WS_END && WS_WIN + (size_t)NMAIN * DM * 2 <= WS_WOUT && WS_WOUT + (size_t)DM * 2048 * 2 <= WS_DT &&
              WS_DT + (size_t)MROWS * 16 * 4 <= WS_SSQ && WS_SSQ + (size_t)MROWS * 32 * 4 <= WS_XN, "d_ws map");

struct Ins {
    const float *xp, *xs, *ck, *cv, *sconv, *sssm, *norm_w, *w_in, *qnw, *knw, *rel_bias, *conv_w, *conv_b, *dt_bias, *a_log, *d_skip, *ssd_norm_w, *w_out;
};

typedef unsigned short bf16;
__device__ __forceinline__ float wave_sum(float v) {
#pragma unroll
    for (int o = 1; o < 64; o <<= 1) v += __shfl_xor(v, o);
    return v;
}
__device__ __forceinline__ float wave_max(float v) {
#pragma unroll
    for (int o = 1; o < 64; o <<= 1) v = fmaxf(v, __shfl_xor(v, o));
    return v;
}
__device__ __forceinline__ float silu_f(float x) { return x / (1.f + __expf(-x)); }
__device__ __forceinline__ float silu_fast(float x) { return x * __builtin_amdgcn_rcpf(1.f + __builtin_amdgcn_exp2f(-LOG2E * x)); }
__device__ __forceinline__ float softplus_f(float x) { return x > 20.f ? x : log1pf(__expf(x)); }
__device__ __forceinline__ int t5_bucket(int d) {
    if (d < 16) return d;
    int b = 16;
    b += d >= 22; b += d >= 30; b += d >= 40; b += d >= 54; b += d >= 73; b += d >= 99; b += d >= 134; b += d >= 182;
    b += d >= 246; b += d >= 332; b += d >= 450; b += d >= 609; b += d >= 825; b += d >= 1117; b += d >= 1513;
    return b;
}
__device__ __forceinline__ const float* xrow(const Ins& I, int r) { return r < NTOK ? I.xp + (size_t)r * DM : I.xs + (size_t)(r - NTOK) * DM; }
__device__ __forceinline__ float bf2f(bf16 v) { return __uint_as_float((unsigned)v << 16); }
__device__ __forceinline__ unsigned f2bf(float f) { unsigned u = __float_as_uint(f); return (u + 0x7fffu + ((u >> 16) & 1u)) >> 16; }
__device__ __forceinline__ unsigned pk2(float lo, float hi) { return f2bf(lo) | (f2bf(hi) << 16); }
typedef float f32x2_cv __attribute__((ext_vector_type(2))); typedef __bf16 bf16x2_cv __attribute__((ext_vector_type(2)));
__device__ __forceinline__ unsigned cvtpk_s(float lo, float hi) { const f32x2_cv v = {lo, hi}; const bf16x2_cv b = __builtin_convertvector(v, bf16x2_cv); return __builtin_bit_cast(unsigned, b); }
__host__ __device__ __forceinline__ int vrow_of_col(int a) { return 128 * ((a >> 5) & 1) + 32 * ((a >> 6) & 3) + (a & 31); }

namespace pg8 {
#define PG8_LAS __attribute__((address_space(3)))
typedef unsigned short bf16_t;
typedef short bf16x8 __attribute__((ext_vector_type(8)));
typedef float f32x4 __attribute__((ext_vector_type(4)));
typedef unsigned u32x4 __attribute__((ext_vector_type(4)));
constexpr int BM = 256, BK = 64, HALF = 128, HTB = HALF * BK * 2  , STAGE_BYTES = 8 * HTB, NXCD = 8, WGM = 8;

__host__ __device__ __forceinline__ int lds_byte(int r, int c) { const int st = (r >> 4) * 2 + (c >> 5), rr = r & 15, cc = c & 31, ob = rr * 64 + cc * 2; return st * 1024 + (ob ^ (((ob >> 9) & 1) << 5)); }
__host__ __device__ __forceinline__ void stage_rc(int b, int& R, int& C) { const int st = b / 1024, sb = b % 1024, swz = sb ^ (((sb >> 9) & 1) << 5); R = (st >> 1) * 16 + swz / 64; C = (st & 1) * 32 + (swz % 64) / 2; }
__host__ __device__ __forceinline__ int perm32(int rho) { const int n = rho >> 4, i = rho & 15; return 8 * (i >> 2) + 4 * n + (i & 3); }

struct Unit { int pm, pn; };
struct Gemm { const bf16_t* A; const bf16_t* Bt; int M, N, K; };

struct StaticOrder {
    int nM, nN, nwg, G, c;
    __host__ __device__ void init(int M, int N, int G_, int c_) { nM = M / BM; nN = N / BM; nwg = nM * nN; G = G_; c = c_; }
    __host__ __device__ bool next(int i, Unit& u) const {
        const long L = (long)i * G + c; if (L >= nwg) return false;
        int wgid = (int)L; { const int q = nwg / NXCD, r = nwg % NXCD, xcd = wgid % NXCD, off = wgid / NXCD; wgid = (xcd < r ? xcd * (q + 1) : r * (q + 1) + (xcd - r) * q) + off; }
        const int nig = WGM * nN, gid = wgid / nig, fm = gid * WGM, gsz = (nM - fm) < WGM ? (nM - fm) : WGM;
        u.pm = fm + ((wgid % nig) % gsz); u.pn = (wgid % nig) / gsz; return true;
    }
    __device__ __forceinline__ void a_ready(const Unit&) const {}
    __device__ __forceinline__ void done(const Unit&) const {}
};

__device__ __forceinline__ unsigned cvt_pk_bf16(float lo, float hi) { unsigned r; asm volatile("v_cvt_pk_bf16_f32 %0, %1, %2" : "=v"(r) : "v"(lo), "v"(hi)); return r; }

template <int K> __device__ __forceinline__ float rowprev(float cur, float prevm) {
    const int t = __builtin_amdgcn_update_dpp(0, __builtin_bit_cast(int, prevm), 0x100 + (16 - K), 0xf, 0xf, true);
    return __builtin_bit_cast(float, __builtin_amdgcn_update_dpp(t, __builtin_bit_cast(int, cur), 0x110 + K, 0xf, 0xf, false));
}

struct EpiIn {
    static constexpr bool PERM = true, AFTER_DRAIN = false, MIDK = false;
    bf16_t *Q, *K, *V, *Gb, *Zb, *XBC; float* out; const float *qnw, *knw, *conv_w, *conv_b; float* rawb;
    __device__ __forceinline__ void mid(f32x4 (&)[2][2][4][2], const Unit&, int, int, int, int, int) const {}
    __device__ __forceinline__ void operator()(const f32x4 (&acc)[2][2][4][2], const Unit& u, int wr, int wc, int fr, int fq) const {
        const int pn = u.pn;
        const int rowb = u.pm * BM + wr * 64 + fr;
        const int cl = wc * 64 + 8 * fq;
        if (pn < 8) {
            const bool isq = pn < 4; const float* nw = isq ? qnw : knw;
            f32x4 w[2][2];
#pragma unroll
            for (int bj = 0; bj < 2; ++bj)
#pragma unroll
                for (int n = 0; n < 2; ++n) w[bj][n] = *(const f32x4*)(nw + 8 * fq + 32 * bj + 4 * n);
            bf16_t* dstb = (isq ? Q : K) + (pn & 3) * 256 + cl;
#pragma unroll
            for (int ai = 0; ai < 2; ++ai)
#pragma unroll
                for (int m = 0; m < 4; ++m) {
                    const int r = rowb + ai * HALF + m * 16;
                    float ss = 0.f;
#pragma unroll
                    for (int bj = 0; bj < 2; ++bj)
#pragma unroll
                        for (int n = 0; n < 2; ++n) { const f32x4 v = acc[ai][bj][m][n]; ss += (v[0] * v[0] + v[1] * v[1]) + (v[2] * v[2] + v[3] * v[3]); }
                    ss += __shfl_xor(ss, 16); ss += __shfl_xor(ss, 32);
                    const float sc = rsqrtf(ss * (1.f / 64.f) + EPS), scs = isq ? sc * QSCALE : sc;
                    float* f32dst = nullptr;
                    if (!isq) { if (r < NTOK) { const int t = r & (SEQ - 1); if (t >= SEQ - WIN) f32dst = out + O_KP + ((size_t)((r >> 13) * WIN + t - (SEQ - WIN))) * DM + (pn & 3) * 256 + cl; }
                                else if (r < NROWS) f32dst = out + O_KS + (size_t)(r - NTOK) * DM + (pn & 3) * 256 + cl; }
#pragma unroll
                    for (int bj = 0; bj < 2; ++bj) {
                        const f32x4 a0 = acc[ai][bj][m][0] * w[bj][0], a1 = acc[ai][bj][m][1] * w[bj][1];
                        u32x4 o; o.x = cvt_pk_bf16(a0[0] * scs, a0[1] * scs); o.y = cvt_pk_bf16(a0[2] * scs, a0[3] * scs); o.z = cvt_pk_bf16(a1[0] * scs, a1[1] * scs); o.w = cvt_pk_bf16(a1[2] * scs, a1[3] * scs);
                        *(u32x4*)(dstb + (size_t)r * DM + 32 * bj) = o;
                        if (f32dst) { *(f32x4*)(f32dst + 32 * bj) = a0 * sc; *(f32x4*)(f32dst + 32 * bj + 4) = a1 * sc; }
                    }
                }
        } else if (pn < 12) {
            bf16_t* dstb = V + (pn & 3) * 256 + cl;
#pragma unroll
            for (int ai = 0; ai < 2; ++ai)
#pragma unroll
                for (int m = 0; m < 4; ++m) {
                    const int r = rowb + ai * HALF + m * 16;
                    float* f32dst = nullptr;
                    if (r < NTOK) { const int t = r & (SEQ - 1); if (t >= SEQ - WIN) f32dst = out + O_VP + ((size_t)((r >> 13) * WIN + t - (SEQ - WIN))) * DM + (pn & 3) * 256 + cl; }
                    else if (r < NROWS) f32dst = out + O_VS + (size_t)(r - NTOK) * DM + (pn & 3) * 256 + cl;
#pragma unroll
                    for (int bj = 0; bj < 2; ++bj) {
                        const f32x4 a0 = acc[ai][bj][m][0], a1 = acc[ai][bj][m][1];
                        u32x4 o; o.x = cvt_pk_bf16(a0[0], a0[1]); o.y = cvt_pk_bf16(a0[2], a0[3]); o.z = cvt_pk_bf16(a1[0], a1[1]); o.w = cvt_pk_bf16(a1[2], a1[3]);
                        *(u32x4*)(dstb + (size_t)r * DM + 32 * bj) = o;
                        if (f32dst) { *(f32x4*)(f32dst + 32 * bj) = a0; *(f32x4*)(f32dst + 32 * bj + 4) = a1; }
                    }
                }
        } else if (pn < 20) {
            bf16_t* dstb = (pn < 16 ? Gb : Zb) + (pn & 3) * 256 + cl;
#pragma unroll
            for (int ai = 0; ai < 2; ++ai)
#pragma unroll
                for (int m = 0; m < 4; ++m) {
                    const int r = rowb + ai * HALF + m * 16;
#pragma unroll
                    for (int bj = 0; bj < 2; ++bj) {
                        f32x4 a0 = acc[ai][bj][m][0], a1 = acc[ai][bj][m][1];
#pragma unroll
                        for (int i = 0; i < 4; ++i) { a0[i] = silu_fast(a0[i]); a1[i] = silu_fast(a1[i]); }
                        u32x4 o; o.x = cvt_pk_bf16(a0[0], a0[1]); o.y = cvt_pk_bf16(a0[2], a0[3]); o.z = cvt_pk_bf16(a1[0], a1[1]); o.w = cvt_pk_bf16(a1[2], a1[3]);
                        *(u32x4*)(dstb + (size_t)r * DM + 32 * bj) = o;
                    }
                }
        } else {
            const int cb = (pn - 20) * 256 + cl;
            bf16_t* dstb = XBC + cb;
            const bool do_conv = pn >= 24 && u.pm < NTOK / BM;
#pragma unroll
            for (int ai = 0; ai < 2; ++ai)
#pragma unroll
                for (int m = 0; m < 4; ++m) {
                    const int r = rowb + ai * HALF + m * 16;
                    float* f32dst = nullptr;
                    if (r < NTOK) { const int t = r & (SEQ - 1); if (t >= SEQ - 3) f32dst = out + O_CP + ((size_t)((r >> 13) * 3 + t - (SEQ - 3))) * CONVD + cb; }
                    else if (r < NROWS) f32dst = out + O_CS + ((size_t)(r - NTOK) * 3 + 2) * CONVD + cb;
                    if (do_conv && (m == 0 || m == 3)) {
                        const int slot = m == 0 ? 3 + fr : fr - 13;
                        if (slot >= 0 && slot < 6) f32dst = rawb + ((size_t)(u.pm * 4 + ai * 2 + wr) * 6 + slot) * 512 + (cb - 1024);
                    }
#pragma unroll
                    for (int bj = 0; bj < 2; ++bj) {
                        const f32x4 a0 = acc[ai][bj][m][0], a1 = acc[ai][bj][m][1];
                        if (!do_conv) { u32x4 o; o.x = cvt_pk_bf16(a0[0], a0[1]); o.y = cvt_pk_bf16(a0[2], a0[3]); o.z = cvt_pk_bf16(a1[0], a1[1]); o.w = cvt_pk_bf16(a1[2], a1[3]);
                                        *(u32x4*)(dstb + (size_t)r * CONVD + 32 * bj) = o; }
                        if (f32dst) { *(f32x4*)(f32dst + 32 * bj) = a0; *(f32x4*)(f32dst + 32 * bj + 4) = a1; }
                    }
                }
            if (do_conv) {
                if ((u.pm & 31) == 31 && wr == 1 && fr >= 13) {
#pragma unroll
                    for (int bj = 0; bj < 2; ++bj) { float* d = out + O_CP + ((size_t)((u.pm >> 5) * 3 + fr - 13)) * CONVD + cb + 32 * bj; *(f32x4*)d = acc[1][bj][3][0]; *(f32x4*)(d + 4) = acc[1][bj][3][1]; }
                }
#pragma unroll
                for (int bj = 0; bj < 2; ++bj) {
                    f32x4 w[4][2], bb[2];
#pragma unroll
                    for (int n = 0; n < 2; ++n) { bb[n] = *(const f32x4*)(conv_b + cb + 32 * bj + 4 * n);
#pragma unroll
                        for (int t = 0; t < 4; ++t) w[t][n] = *(const f32x4*)(conv_w + t * CONVD + cb + 32 * bj + 4 * n); }
#pragma unroll
                    for (int ai = 0; ai < 2; ++ai) {
                        f32x4 pm[2] = {(f32x4){0.f, 0.f, 0.f, 0.f}, (f32x4){0.f, 0.f, 0.f, 0.f}};
#pragma unroll
                        for (int m = 0; m < 4; ++m) {
                            const int r = rowb + ai * HALF + m * 16;
                            unsigned ow[4];
#pragma unroll
                            for (int n = 0; n < 2; ++n) {
                                const f32x4 cur = acc[ai][bj][m][n]; f32x4 v;
#pragma unroll
                                for (int i = 0; i < 4; ++i) {
                                    const float p1 = rowprev<1>(cur[i], pm[n][i]), p2 = rowprev<2>(cur[i], pm[n][i]), p3 = rowprev<3>(cur[i], pm[n][i]);
                                    v[i] = silu_fast(bb[n][i] + w[0][n][i] * p3 + w[1][n][i] * p2 + w[2][n][i] * p1 + w[3][n][i] * cur[i]);
                                }
                                ow[2 * n] = cvt_pk_bf16(v[0], v[1]); ow[2 * n + 1] = cvt_pk_bf16(v[2], v[3]);
                                pm[n] = cur;
                            }
                            *(u32x4*)(dstb + (size_t)r * CONVD + 32 * bj) = (u32x4){ow[0], ow[1], ow[2], ow[3]};
                        }
                    }
                }
            }
        }
    }
};

struct EpiOut {
    static constexpr bool PERM = true, AFTER_DRAIN = false, MIDK = true;
    const float* xp; const float* xs; const PG8_LAS float* rs; float* out;
    __device__ __forceinline__ void mid(f32x4 (&acc)[2][2][4][2], const Unit& u, int ui, int wr, int wc, int fr, int fq) const {
        const PG8_LAS float* rp = rs + ui * 256 + wr * 64 + fr;
#pragma unroll
        for (int ai = 0; ai < 2; ++ai)
#pragma unroll
            for (int m = 0; m < 4; ++m) {
                const float r = rp[ai * HALF + m * 16];
#pragma unroll
                for (int bj = 0; bj < 2; ++bj)
#pragma unroll
                    for (int n = 0; n < 2; ++n) acc[ai][bj][m][n] *= r;
            }
    }
    __device__ __forceinline__ void operator()(const f32x4 (&acc)[2][2][4][2], const Unit& u, int wr, int wc, int fr, int fq) const {
        const int rowb = u.pm * BM + wr * 64 + fr, col = u.pn * BM + wc * 64 + 8 * fq;
#pragma unroll
        for (int ai = 0; ai < 2; ++ai)
#pragma unroll
            for (int m = 0; m < 4; ++m) {
                const int r = rowb + ai * HALF + m * 16;
                if (r >= NROWS) continue;
                const float* xr = (r < NTOK ? xp + (size_t)r * DM : xs + (size_t)(r - NTOK) * DM) + col;
                float* yr = out + (r < NTOK ? O_YP + (size_t)r * DM : O_YS + (size_t)(r - NTOK) * DM) + col;
#pragma unroll
                for (int bj = 0; bj < 2; ++bj) {
                    *(f32x4*)(yr + 32 * bj) = *(const f32x4*)(xr + 32 * bj) + acc[ai][bj][m][0];
                    *(f32x4*)(yr + 32 * bj + 4) = *(const f32x4*)(xr + 32 * bj + 4) + acc[ai][bj][m][1];
                }
            }
    }
};

template <class Epi, class Sched, bool ALIGN_EPI = false, bool SP2 = false>
__device__ __forceinline__ void gemm_phase(PG8_LAS unsigned char* lds, const Gemm g, const Sched& S, const Epi& E) {
    const int tid = threadIdx.x, wid = __builtin_amdgcn_readfirstlane(tid >> 6), lane = tid & 63, wr = wid >> 2, wc = wid & 3, fr = lane & 15, fq = lane >> 4;
    const int K = g.K, nt = K / BK;
    unsigned voffA[2], voffB[2];
#pragma unroll
    for (int i = 0; i < 2; ++i) { int R, C; stage_rc(tid * 16 + i * 8192, R, C); const int Rb = Epi::PERM ? ((R & ~31) + perm32(R & 31)) : R;
        voffA[i] = (unsigned)(R * K + C) * 2u; voffB[i] = (unsigned)(Rb * K + C) * 2u; }
    const size_t kstep = (size_t)(BK * 2);
    const size_t hstep = (size_t)HALF * K * 2;
    const size_t tstep = 2 * hstep;
    const unsigned ldsw = (unsigned)wid * 1024u;
    const int aoff = lds_byte(wr * 64 + fr, fq * 8), boff = lds_byte(wc * 32 + fr, fq * 8);
#define PG8_SA(b, h) (((b) * 2 + (h)) * HTB)
#define PG8_SB(b, h) ((4 + (b) * 2 + (h)) * HTB)
#define PG8_STAGE(bufoff, gbase, voff) do { _Pragma("unroll") for (int _i = 0; _i < 2; ++_i) \
        __builtin_amdgcn_global_load_lds((const unsigned*)((const char*)(gbase) + (voff)[_i]), (PG8_LAS unsigned*)(lds + (bufoff) + ldsw + _i * 8192), 16, 0, 0); } while (0)
#define PG8_LDA(dst, b, h) do { _Pragma("unroll") for (int m = 0; m < 4; ++m) _Pragma("unroll") for (int k = 0; k < 2; ++k) dst[m][k] = *(const PG8_LAS bf16x8*)(lds + PG8_SA(b, h) + aoff + m * 2048 + k * 1024); } while (0)
#define PG8_LDB(dst, b, h) do { _Pragma("unroll") for (int n = 0; n < 2; ++n) _Pragma("unroll") for (int k = 0; k < 2; ++k) dst[n][k] = *(const PG8_LAS bf16x8*)(lds + PG8_SB(b, h) + boff + n * 2048 + k * 1024); } while (0)
#define PG8_MMA(ai, bj, At, Bt) do { __builtin_amdgcn_s_setprio(1); _Pragma("unroll") for (int m = 0; m < 4; ++m) _Pragma("unroll") for (int n = 0; n < 2; ++n) _Pragma("unroll") for (int k = 0; k < 2; ++k) \
        acc[ai][bj][m][n] = __builtin_amdgcn_mfma_f32_16x16x32_bf16(Bt[n][k], At[m][k], acc[ai][bj][m][n], 0, 0, 0); __builtin_amdgcn_s_setprio(0); } while (0)
#define PG8_WAIT_V(n) asm volatile("s_waitcnt vmcnt(" #n ")" ::: "memory")
#define PG8_WAIT_L(n) asm volatile("s_waitcnt lgkmcnt(" #n ")" ::: "memory")
#define PG8_BAR __builtin_amdgcn_s_barrier()
#define PG8_SCHED __builtin_amdgcn_sched_barrier(0)
    Unit cur, nxt; int ui = 0;
    if (!S.next(0, cur)) return;
    f32x4 acc[2][2][4][2];
#pragma unroll
    for (int a = 0; a < 2; ++a)
#pragma unroll
        for (int b = 0; b < 2; ++b)
#pragma unroll
            for (int m = 0; m < 4; ++m)
#pragma unroll
                for (int n = 0; n < 2; ++n) acc[a][b][m][n] = (f32x4){0.f, 0.f, 0.f, 0.f};
    bf16x8 At[4][2], B0[2][2], B1[2][2];
    const char* cA = (const char*)g.A + (size_t)cur.pm * tstep; const char* cB = (const char*)g.Bt + (size_t)cur.pn * tstep;
    S.a_ready(cur);
    if constexpr (SP2) {
        PG8_STAGE(PG8_SB(0, 0), cB, voffB); PG8_STAGE(PG8_SB(0, 1), cB + hstep, voffB); PG8_STAGE(PG8_SA(0, 0), cA, voffA); PG8_STAGE(PG8_SA(0, 1), cA + hstep, voffA);
        if (wr == 1) PG8_BAR;
        PG8_WAIT_V(2); PG8_BAR;
        PG8_STAGE(PG8_SB(1, 0), cB + kstep, voffB); PG8_STAGE(PG8_SA(1, 0), cA + kstep, voffA); PG8_STAGE(PG8_SB(1, 1), cB + hstep + kstep, voffB);
        PG8_WAIT_V(6); PG8_BAR;
    } else {
        PG8_STAGE(PG8_SB(0, 0), cB, voffB); PG8_STAGE(PG8_SA(0, 0), cA, voffA); PG8_STAGE(PG8_SB(0, 1), cB + hstep, voffB); PG8_STAGE(PG8_SA(0, 1), cA + hstep, voffA);
        if (wr == 1) PG8_BAR;
        PG8_WAIT_V(4); PG8_BAR;
        PG8_STAGE(PG8_SB(1, 0), cB + kstep, voffB); PG8_STAGE(PG8_SA(1, 0), cA + kstep, voffA); PG8_STAGE(PG8_SB(1, 1), cB + hstep + kstep, voffB);
        PG8_WAIT_V(6); PG8_BAR;
    }
    for (;;) {
        const bool has_next = S.next(ui + 1, nxt);
        const char* nA = has_next ? (const char*)g.A + (size_t)nxt.pm * tstep : cA; const char* nB = has_next ? (const char*)g.Bt + (size_t)nxt.pn * tstep : cB;
        for (int t = 0; t < nt; t += 2) {
            const bool last = (t == nt - 2);
            if constexpr (Epi::MIDK) { if (t == (nt >> 1)) E.mid(acc, cur, ui, wr, wc, fr, fq); }
            const char* a1 = cA + (size_t)(t + 1) * kstep;
            const char* a2 = last ? nA : cA + (size_t)(t + 2) * kstep; const char* b2 = last ? nB : cB + (size_t)(t + 2) * kstep;
            const char* a3 = a2 + kstep; const char* b3 = b2 + kstep;
            if (last && has_next) S.a_ready(nxt);
            if constexpr (SP2) {
            PG8_LDB(B0, 0, 0); PG8_LDB(B1, 0, 1); PG8_SCHED; PG8_LDA(At, 0, 0); PG8_STAGE(PG8_SA(1, 1), a1 + hstep, voffA);
            PG8_WAIT_V(8); PG8_WAIT_L(0); PG8_BAR; PG8_MMA(0, 0, At, B0); PG8_MMA(0, 1, At, B1); PG8_BAR; PG8_SCHED;
            PG8_LDA(At, 0, 1); PG8_STAGE(PG8_SB(0, 0), b2, voffB); PG8_STAGE(PG8_SB(0, 1), b2 + hstep, voffB); PG8_STAGE(PG8_SA(0, 0), a2, voffA);
            PG8_WAIT_V(8); PG8_WAIT_L(0); PG8_BAR; PG8_MMA(1, 0, At, B0); PG8_MMA(1, 1, At, B1); PG8_BAR; PG8_SCHED;
            PG8_LDB(B0, 1, 0); PG8_LDB(B1, 1, 1); PG8_SCHED; PG8_LDA(At, 1, 0); PG8_STAGE(PG8_SA(0, 1), a2 + hstep, voffA);
            PG8_WAIT_V(8); PG8_WAIT_L(0); PG8_BAR; PG8_MMA(0, 0, At, B0); PG8_MMA(0, 1, At, B1); PG8_BAR; PG8_SCHED;
            PG8_LDA(At, 1, 1); PG8_STAGE(PG8_SB(1, 0), b3, voffB); PG8_STAGE(PG8_SB(1, 1), b3 + hstep, voffB); PG8_STAGE(PG8_SA(1, 0), a3, voffA);
            PG8_WAIT_V(8); PG8_WAIT_L(0); PG8_BAR; PG8_MMA(1, 0, At, B0); PG8_MMA(1, 1, At, B1); PG8_BAR; PG8_SCHED;
            } else {
            PG8_LDB(B0, 0, 0); PG8_SCHED; PG8_LDA(At, 0, 0); PG8_STAGE(PG8_SA(1, 1), a1 + hstep, voffA);
            PG8_WAIT_L(8); PG8_BAR; PG8_WAIT_L(0); PG8_MMA(0, 0, At, B0); PG8_BAR; PG8_SCHED;
            PG8_LDB(B1, 0, 1); PG8_STAGE(PG8_SB(0, 0), b2, voffB);
            PG8_BAR; PG8_WAIT_L(0); PG8_MMA(0, 1, At, B1); PG8_BAR;
            PG8_LDA(At, 0, 1); PG8_STAGE(PG8_SA(0, 0), a2, voffA);
            PG8_BAR; PG8_WAIT_L(0); PG8_MMA(1, 0, At, B0); PG8_BAR; PG8_SCHED;
            PG8_STAGE(PG8_SB(0, 1), b2 + hstep, voffB);
            PG8_WAIT_V(6); PG8_BAR; PG8_MMA(1, 1, At, B1); PG8_BAR;
            PG8_LDB(B0, 1, 0); PG8_SCHED; PG8_LDA(At, 1, 0); PG8_STAGE(PG8_SA(0, 1), a2 + hstep, voffA);
            PG8_WAIT_L(8); PG8_BAR; PG8_WAIT_L(0); PG8_MMA(0, 0, At, B0); PG8_BAR; PG8_SCHED;
            PG8_LDB(B1, 1, 1); PG8_STAGE(PG8_SB(1, 0), b3, voffB);
            PG8_BAR; PG8_WAIT_L(0); PG8_MMA(0, 1, At, B1); PG8_BAR;
            PG8_LDA(At, 1, 1); PG8_STAGE(PG8_SA(1, 0), a3, voffA);
            PG8_BAR; PG8_WAIT_L(0); PG8_MMA(1, 0, At, B0); PG8_BAR; PG8_SCHED;
            PG8_STAGE(PG8_SB(1, 1), b3 + hstep, voffB);
            PG8_WAIT_V(6); PG8_BAR; PG8_MMA(1, 1, At, B1); PG8_BAR;
            }
        }
        if constexpr (ALIGN_EPI) { if (wr == 0) PG8_BAR; }
        if constexpr (!Epi::AFTER_DRAIN) { E(acc, cur, wr, wc, fr, fq); S.done(cur); }
        if (!has_next) break;
#pragma unroll
        for (int a = 0; a < 2; ++a)
#pragma unroll
            for (int b = 0; b < 2; ++b)
#pragma unroll
                for (int m = 0; m < 4; ++m)
#pragma unroll
                    for (int n = 0; n < 2; ++n) acc[a][b][m][n] = (f32x4){0.f, 0.f, 0.f, 0.f};
        cur = nxt; cA = nA; cB = nB; ++ui;
        if constexpr (ALIGN_EPI) { if (wr == 1) PG8_BAR; }
    }
    PG8_WAIT_V(0);
    if constexpr (!ALIGN_EPI) { if (wr == 0) PG8_BAR; }
    PG8_BAR;
    if constexpr (Epi::AFTER_DRAIN) { E.fused(acc, cur, wr, wc, fr, fq, lds, wid, lane); S.done(cur); }
#undef PG8_SA
#undef PG8_SB
#undef PG8_STAGE
#undef PG8_LDA
#undef PG8_LDB
#undef PG8_MMA
#undef PG8_WAIT_V
#undef PG8_WAIT_L
#undef PG8_BAR
#undef PG8_SCHED
}
}
#define GAS __attribute__((address_space(1)))
#define LAS __attribute__((address_space(3)))
typedef unsigned v4u __attribute__((ext_vector_type(4)));
typedef float f32x4 __attribute__((ext_vector_type(4)));
typedef short bf16x8 __attribute__((ext_vector_type(8)));
typedef GAS unsigned gu32;
typedef GAS unsigned long long gu64;
#define RLX_AGENT __ATOMIC_RELAXED, __HIP_MEMORY_SCOPE_AGENT
#define LDS_WAIT() asm volatile("s_waitcnt lgkmcnt(0)" ::: "memory")
#define VM_WAIT() asm volatile("s_waitcnt vmcnt(0)" ::: "memory")
__device__ __forceinline__ unsigned long long rt() { return __builtin_amdgcn_s_memrealtime(); }

#define XB_TMO      128
#define XB_XCNT(j)  (256  + 64 * (j))
#define XB_XSUB(j)  (1280 + 64 * (j))
#define XB_XGEN(j)  (2304 + 64 * (j))
#define XB_TOP      3328
#define XB_TOPGEN   3392
#define XCD_BAR_WORDS 3456
#define XB_SPIN_CAP (1u << 18)

__device__ __forceinline__ unsigned xb_ld(unsigned* p)              { return __hip_atomic_load(p, __ATOMIC_RELAXED, __HIP_MEMORY_SCOPE_AGENT); }
__device__ __forceinline__ unsigned xb_add(unsigned* p, unsigned v) { return __hip_atomic_fetch_add(p, v, __ATOMIC_RELAXED, __HIP_MEMORY_SCOPE_AGENT); }
__device__ __forceinline__ unsigned xb_xcc_id() { return (unsigned)__builtin_amdgcn_s_getreg((3 << 11) | 20) & 0xFu; }
#define XB_SPIN(cond, bar) do { unsigned _sp = 0; while (cond) { __builtin_amdgcn_s_sleep(1); \
    if ((++_sp & 255u) == 0u) { if (xb_ld(&(bar)[XB_TMO])) break; if (_sp > XB_SPIN_CAP) { atomicAdd(&(bar)[XB_TMO], 1u); break; } } } } while (0)

struct XcdBarrier {
    unsigned* bar; unsigned x;
    volatile LAS unsigned* st;
};

__device__ __forceinline__ XcdBarrier xcd_barrier_post(unsigned* bar, volatile LAS unsigned* st) {
    XcdBarrier b; b.bar = bar; b.x = xb_xcc_id(); b.st = st;
    if (threadIdx.x == 0) (void)xb_add(&bar[XB_XCNT(b.x)], 1u);
    return b;
}
__device__ __forceinline__ void xcd_barrier_complete(unsigned* bar, unsigned x, unsigned& nloc, unsigned& nx) {
    const unsigned G = gridDim.x * gridDim.y * gridDim.z;
    unsigned sum, cnt, mine, sp = 0u;
    for (;;) {
        sum = 0u; cnt = 0u; mine = 0u;
#pragma unroll
        for (unsigned j = 0; j < 16; ++j) { const unsigned c = xb_ld(&bar[XB_XCNT(j)]); sum += c; cnt += (c > 0u) ? 1u : 0u; mine = (j == x) ? c : mine; }
        if (sum == G) break;
        __builtin_amdgcn_s_sleep(1);
        if ((++sp & 255u) == 0u) { if (xb_ld(&bar[XB_TMO])) break; if (sp > XB_SPIN_CAP) { atomicAdd(&bar[XB_TMO], 1u); break; } }
    }
    nloc = mine > 0u ? mine : 1u; nx = cnt > 0u ? cnt : 1u;
}

__device__ __forceinline__ void xcd_barrier(const XcdBarrier& b) {
    asm volatile("s_waitcnt vmcnt(0)" ::: "memory");
    __syncthreads();
    if (threadIdx.x == 0) {
        unsigned* bar = b.bar;
        __builtin_amdgcn_s_waitcnt(0);
        unsigned nloc = b.st[0], nx = b.st[1];
        if (nloc == 0u) { xcd_barrier_complete(bar, b.x, nloc, nx); b.st[0] = nloc; b.st[1] = nx; }
        const unsigned old = xb_add(&bar[XB_XSUB(b.x)], 1u);
        const unsigned gen = old / nloc;
        if (old + 1u == (gen + 1u) * nloc) {
            __builtin_amdgcn_fence(__ATOMIC_RELEASE, "agent");
            asm volatile("s_waitcnt vmcnt(0)" ::: "memory");
            const unsigned og = xb_add(&bar[XB_TOP], 1u);
            const unsigned tg = og / nx;
            if (og + 1u == (tg + 1u) * nx) xb_add(&bar[XB_TOPGEN], 1u);
            else XB_SPIN(xb_ld(&bar[XB_TOPGEN]) == tg, bar);
            __builtin_amdgcn_fence(__ATOMIC_ACQUIRE, "agent");
            xb_add(&bar[XB_XGEN(b.x)], 1u);
            asm volatile("s_waitcnt vmcnt(0)" ::: "memory");
        } else {
            XB_SPIN(xb_ld(&bar[XB_XGEN(b.x)]) == gen, bar);
            __builtin_amdgcn_fence(__ATOMIC_ACQUIRE, "agent");
            asm volatile("s_waitcnt vmcnt(0)" ::: "memory");
        }
    }
    __syncthreads();
}

constexpr int NWAVES = 8;
constexpr int RING_OFF = 0, RING_BYTES = 131072;
constexpr int LDS_BYTES = 163840;
constexpr int LDSCTL_OFF = LDS_BYTES - 512, MISC_OFF = LDSCTL_OFF + 320;
constexpr int CW_BAR = 4096;
constexpr int CW_Q = 16384;
static_assert((CW_BAR + XCD_BAR_WORDS) <= CW_Q && (CW_Q + 64 * 64) * 4 <= (int)CTL_ZERO_BYTES, "CTL words inside the memset region");

constexpr int PROBE_ID = 0;
#define PB_BEGIN(id) long long pb_t0_##id = 0; if (PROBE_ID == (id)) pb_t0_##id = clock64();
#define PB_END(id) if (PROBE_ID == (id)) { const long long t1_ = clock64(), dt_ = t1_ - pb_t0_##id; while (clock64() - t1_ < dt_) __builtin_amdgcn_s_sleep(2); }
struct Frame {
    LAS unsigned char* lds;
    volatile LAS unsigned* MISC;
    gu32* ctl;
    int tid, lane, wave, vcu, G;
    Ins I; float* out;
    bf16 *WinT, *WoutT, *XN, *Q, *K, *V, *AU, *XBC, *Gb, *Zb; float *DT, *SSQ, *RAWB;
};

template <class SrcF>
__device__ __forceinline__ void p0_transpose_item(SrcF src, int k0, int n0, bf16* WT, int dst_pitch, int dst_row0, int dst_k0, LAS float* scr, int lane) {
#pragma unroll 8
    for (int i = 0; i < 32; ++i) { const int kk = 2 * i + (lane >> 5); scr[kk * 33 + (lane & 31)] = src(k0 + kk, n0 + (lane & 31)); }
    LDS_WAIT(); asm volatile("" ::: "memory");
    const int c = lane & 7;
#pragma unroll
    for (int j = 0; j < 4; ++j) { const int n = (lane >> 3) + 8 * j; const LAS float* s = scr + (8 * c) * 33 + n;
        v4u o; o.x = pk2(s[0 * 33], s[1 * 33]); o.y = pk2(s[2 * 33], s[3 * 33]); o.z = pk2(s[4 * 33], s[5 * 33]); o.w = pk2(s[6 * 33], s[7 * 33]);
        *(GAS v4u*)(WT + (size_t)(dst_row0 + n) * dst_pitch + dst_k0 + 8 * c) = o; }
    LDS_WAIT(); asm volatile("" ::: "memory");
}
constexpr int P0_SCR_BYTES = 8448, WDT_OFF = NWAVES * P0_SCR_BYTES, WDT_PITCH = 20;
static_assert(WDT_OFF + 1024 * WDT_PITCH * 4 <= LDSCTL_OFF, "prologue LDS");

__device__ __forceinline__ void p0_prologue(Frame& F) {
    const Ins& I = F.I;
    LAS float* scr = (LAS float*)(F.lds + F.wave * P0_SCR_BYTES);
    LAS float* wdt = (LAS float*)(F.lds + WDT_OFF);
    const int gw = F.vcu * NWAVES + F.wave, NGW = F.G * NWAVES;
    for (int idx = F.tid; idx < 1024 * 16; idx += NWAVES * 64) {
        const int k = idx >> 4, j = idx & 15, pos = (((k >> 8) * 4 + (k & 3)) << 6) + ((k >> 2) & 63);
        wdt[pos * WDT_PITCH + j] = I.w_in[(size_t)k * NPROJ + C_DT + j] * I.norm_w[k];
    }
    constexpr int I_IN = (DM / 64) * (NMAIN / 32), I_OUT = (2048 / 64) * (DM / 32);
    for (int it = gw; it < I_IN + I_OUT; it += NGW) {
        if (it < I_IN) {
            const int nblk = NMAIN / 32, kb = it / nblk, nb = it % nblk, k0 = 64 * kb, n0 = 32 * nb;
            p0_transpose_item([&](int k, int n) { return I.w_in[(size_t)k * NPROJ + n] * I.norm_w[k]; }, k0, n0, F.WinT, DM, (n0 & ~255) + vrow_of_col(n0 & 255), k0, scr, F.lane);
        } else {
            const int r = it - I_IN, nblk = DM / 32, kb = r / nblk, nb = r % nblk, k0 = 64 * kb, n0 = 32 * nb;
            p0_transpose_item([&](int k, int n) { return I.w_out[(size_t)k * DM + n] * (k >= 1024 ? I.ssd_norm_w[k - 1024] : 1.f); }, k0, n0, F.WoutT, 2048, (n0 & ~255) + vrow_of_col(n0 & 255), (k0 + 1024) & 2047, scr, F.lane);
        }
    }
    __syncthreads();
    for (int rp = gw; rp < NROWS / 2; rp += NGW) {
        f32x4 v[2][4]; float rstd[2];
#pragma unroll
        for (int q = 0; q < 2; ++q) {
            const GAS f32x4* xr = (const GAS f32x4*)xrow(I, 2 * rp + q) + F.lane; float s = 0.f;
#pragma unroll
            for (int j = 0; j < 4; ++j) { v[q][j] = xr[64 * j]; s += (v[q][j].x * v[q][j].x + v[q][j].y * v[q][j].y) + (v[q][j].z * v[q][j].z + v[q][j].w * v[q][j].w); }
            rstd[q] = rsqrtf(wave_sum(s) * (1.f / DM) + EPS);
            GAS unsigned long long* o8 = (GAS unsigned long long*)(F.XN + (size_t)(2 * rp + q) * DM) + F.lane;
#pragma unroll
            for (int j = 0; j < 4; ++j) o8[64 * j] = (unsigned long long)pk2(v[q][j].x * rstd[q], v[q][j].y * rstd[q]) | ((unsigned long long)pk2(v[q][j].z * rstd[q], v[q][j].w * rstd[q]) << 32);
        }
        float a[32];
#pragma unroll
        for (int i = 0; i < 32; ++i) a[i] = 0.f;
#pragma unroll
        for (int j = 0; j < 4; ++j)
#pragma unroll
            for (int e = 0; e < 4; ++e) {
                const LAS f32x4* wp = (const LAS f32x4*)(wdt + ((j * 4 + e) * 64 + F.lane) * WDT_PITCH);
                const float x0 = v[0][j][e], x1 = v[1][j][e];
#pragma unroll
                for (int c4 = 0; c4 < 4; ++c4) { const f32x4 w = wp[c4];
#pragma unroll
                    for (int i = 0; i < 4; ++i) { a[c4 * 4 + i] += x0 * w[i]; a[16 + c4 * 4 + i] += x1 * w[i]; } }
                asm volatile("" ::: "memory");
            }
#define P0_HALVE(N, X) { const bool up = (F.lane & (X)) != 0; _Pragma("unroll") for (int i = 0; i < (N); ++i) { const float keep = up ? a[i + (N)] : a[i], send = up ? a[i] : a[i + (N)]; a[i] = keep + __shfl_xor(send, (X)); } }
        P0_HALVE(16, 32) P0_HALVE(8, 16) P0_HALVE(4, 8) P0_HALVE(2, 4) P0_HALVE(1, 2)
#undef P0_HALVE
        float tot = a[0] + __shfl_xor(a[0], 1);
        const int idx = F.lane >> 1, q = idx >> 4, c = idx & 15;
        tot = tot * (q ? rstd[1] : rstd[0]) + I.dt_bias[c];
        if ((F.lane & 1) == 0) F.DT[(size_t)c * MROWS + 2 * rp + q] = softplus_f(tot);
    }
    { v4u* zk = (v4u*)((unsigned char*)F.K - 4 * MiB); v4u* zv = (v4u*)((unsigned char*)F.V - 4 * MiB);
      for (size_t i = (size_t)F.vcu * NWAVES * 64 + F.tid; i < 4 * MiB / 16; i += (size_t)F.G * NWAVES * 64) {
          if (i * 16 >= 4 * MiB - (WS_K - (WS_Q + (size_t)MROWS * DM * 2))) zk[i] = (v4u){0u, 0u, 0u, 0u};
          if (i * 16 >= 4 * MiB - (WS_V - (WS_K + (size_t)MROWS * DM * 2))) zv[i] = (v4u){0u, 0u, 0u, 0u}; } }
    for (int r = NROWS + gw; r < MROWS; r += NGW) { GAS v4u* o = (GAS v4u*)(F.XN + (size_t)r * DM) + F.lane; o[0] = (v4u){0u, 0u, 0u, 0u}; o[64] = (v4u){0u, 0u, 0u, 0u};
                                                   GAS v4u* k = (GAS v4u*)(F.K + (size_t)r * DM) + F.lane; k[0] = (v4u){0u, 0u, 0u, 0u}; k[64] = (v4u){0u, 0u, 0u, 0u}; }
    for (int i = (F.vcu * NWAVES * 64 + F.tid); i < DB * 2 * CONVD; i += F.G * NWAVES * 64) {
        const int c = i % CONVD, rr = i / CONVD, j = rr & 1, b = rr >> 1;
        F.out[O_CS + ((size_t)b * 3 + j) * CONVD + c] = I.sconv[((size_t)b * 3 + j + 1) * CONVD + c];
    }
}

namespace att {
typedef float f32x16 __attribute__((ext_vector_type(16)));
typedef short v4i16_t __attribute__((ext_vector_type(4)));
typedef unsigned u32x4 __attribute__((ext_vector_type(4)));
constexpr int SPAN = 512, NSPAN = SEQ / SPAN, NUNITS = NB * NH * NSPAN;
constexpr int OPITCH = 64  , OACC_OFF = 0, LACC_OFF = SPAN * OPITCH * 4, LUT_OFF = LACC_OFF + 2048, VST_OFF = LUT_OFF + 2048, VST_BYTES = 2048  , ATT_LDS_END = VST_OFF + NWAVES * VST_BYTES;
static_assert(ATT_LDS_END <= LDSCTL_OFF, "attention LDS");
__device__ __forceinline__ int crow(int r, int hi) { return (r & 3) + 8 * (r >> 2) + 4 * hi; }

struct ItemRegs { bf16x8 qf[4]; v4u kreg[4], vreg[4]; unsigned koff, voff; };
__device__ __forceinline__ int first_tile(int tq0, int d) { const int k = (97 * d - tq0 + 32 * d - 1) / (32 * d); return k < 0 ? 0 : (k > 4 ? 4 : k); }
struct ItemOut { f32x16 o0, o1; float lsum; };
#define ATT_LOAD_K(R, KT) do { const char* kb_ = (const char*)Kb + ((long)(tq0 + (-128 + 32 * (KT)) * d) * DM) * 2; \
        _Pragma("unroll") for (int i = 0; i < 4; ++i) (R).kreg[i] = *(const v4u*)(kb_ + (R).koff + 32 * i); } while (0)
#define ATT_LOAD_V(R, KT) do { const char* vb_ = (const char*)Vb + ((long)(tq0 + (-128 + 32 * (KT)) * d) * DM) * 2; \
        _Pragma("unroll") for (int i = 0; i < 4; ++i) (R).vreg[i] = *(const v4u*)(vb_ + (R).voff + (unsigned)(i * 8 * d * DM * 2)); } while (0)
template <int NQ>
__device__ __forceinline__ void item_load(ItemRegs& R, const bf16* Qb, const bf16* Kb, const bf16* Vb, int tq0, int d, int lane) {
    const int c = lane & 31, hi = lane >> 5;
    const bf16* qp = Qb + (size_t)(tq0 + (NQ == 32 ? c : (c & 15)) * d) * DM + 8 * hi;
#pragma unroll
    for (int ks = 0; ks < 4; ++ks) R.qf[ks] = *(const bf16x8*)(qp + 16 * ks);
    R.koff = (unsigned)((c * d * DM + 8 * hi) * 2); R.voff = (unsigned)(((lane >> 3) * d * DM + 8 * (lane & 7)) * 2);
    { const int kt0 = 97 * d - tq0 > 0 ? first_tile(tq0, d) : 0; ATT_LOAD_K(R, kt0); ATT_LOAD_V(R, kt0); }
}
template <int NQ>
__device__ __forceinline__ void item_tiles(ItemRegs& R, ItemOut& O, const bf16* Kb, const bf16* Vb, int tq0, int d, int pat, LAS unsigned char* lds, int wave, int lane) {
    const int c = lane & 31, hi = lane >> 5;
    LAS unsigned char* vst = lds + VST_OFF + wave * VST_BYTES;
    const LAS float* lut = (const LAS float*)(lds + LUT_OFF) + pat * 129;
    f32x16 o0 = {}, o1 = {};
    float lsum = 0.f;
    const int lrow = lane >> 3, lch = lane & 7;
    const int stoff = lrow * 128 + ((lch ^ lrow) << 4);
    const int q4 = (lane & 15) >> 2, odd = (lane >> 4) & 1, p4 = lane & 3;
#pragma unroll 1
    for (int kt = (97 * d - tq0 > 0 ? first_tile(tq0, d) : 0); kt < 5; ++kt) {
        bf16x8 vb[2][2];
#pragma unroll
        for (int s = 0; s < 2; ++s) {
#pragma unroll
            for (int i = 0; i < 2; ++i) *(LAS v4u*)(vst + i * 1024 + stoff) = R.vreg[2 * s + i];
#pragma unroll
            for (int dh = 0; dh < 2; ++dh) {
                const int kr = 4 * hi + q4, ch16 = 4 * dh + 2 * odd + (p4 >> 1);
                const LAS unsigned char* vp0 = vst + kr * 128 + ((ch16 ^ (kr & 7)) << 4) + (p4 & 1) * 8;
                const LAS unsigned char* vp1 = vst + (kr + 8) * 128 + ((ch16 ^ (kr & 7)) << 4) + (p4 & 1) * 8;
                const v4i16_t lo = __builtin_amdgcn_ds_read_tr16_b64_v4i16((LAS v4i16_t*)vp0), hh = __builtin_amdgcn_ds_read_tr16_b64_v4i16((LAS v4i16_t*)vp1);
                vb[s][dh] = (bf16x8){lo[0], lo[1], lo[2], lo[3], hh[0], hh[1], hh[2], hh[3]};
            }
        }
        bf16x8 kf[4];
#pragma unroll
        for (int ks = 0; ks < 4; ++ks) kf[ks] = __builtin_bit_cast(bf16x8, R.kreg[ks]);
        asm volatile("" ::: "memory");
        if (kt < 4) { ATT_LOAD_K(R, kt + 1); ATT_LOAD_V(R, kt + 1); }
        const int relb = c + 128 - 32 * kt - 4 * hi, tkb = tq0 + (-128 + 32 * kt + 4 * hi) * d;
        const bool edge = (kt == 0 || kt == 4 || tkb < 0);
        f32x16 st;
        if (edge) {
#pragma unroll
            for (int r = 0; r < 16; ++r) { const int rel = relb - ((r & 3) + 8 * (r >> 2)); st[r] = lut[rel < 0 ? 0 : (rel > 128 ? 128 : rel)]; }
        } else {
#pragma unroll
            for (int r = 0; r < 16; ++r) st[r] = lut[relb - ((r & 3) + 8 * (r >> 2))];
        }
#pragma unroll
        for (int ks = 0; ks < 4; ++ks) st = __builtin_amdgcn_mfma_f32_32x32x16_bf16(kf[ks], R.qf[ks], st, 0, 0, 0);
        if (edge) {
#pragma unroll
            for (int r = 0; r < 16; ++r) {
                const int kk = (r & 3) + 8 * (r >> 2), rel = relb - kk;
                const bool valid = (rel >= 0) && (rel <= 128) && (tkb + kk * d >= 0);
                const float pe = __builtin_amdgcn_exp2f(st[r]), p = valid ? pe : 0.f;
                st[r] = p; lsum += p;
            }
        } else {
#pragma unroll
            for (int r = 0; r < 16; ++r) { const float p = __builtin_amdgcn_exp2f(st[r]); st[r] = p; lsum += p; }
        }
        u32x4 pw0, pw1;
        pw0.x = cvtpk_s(st[0], st[1]); pw0.y = cvtpk_s(st[2], st[3]); pw0.z = cvtpk_s(st[4], st[5]); pw0.w = cvtpk_s(st[6], st[7]);
        pw1.x = cvtpk_s(st[8], st[9]); pw1.y = cvtpk_s(st[10], st[11]); pw1.z = cvtpk_s(st[12], st[13]); pw1.w = cvtpk_s(st[14], st[15]);
        const bf16x8 pa0 = __builtin_bit_cast(bf16x8, pw0), pa1 = __builtin_bit_cast(bf16x8, pw1);
        o0 = __builtin_amdgcn_mfma_f32_32x32x16_bf16(pa0, vb[0][0], o0, 0, 0, 0);
        o1 = __builtin_amdgcn_mfma_f32_32x32x16_bf16(pa0, vb[0][1], o1, 0, 0, 0);
        o0 = __builtin_amdgcn_mfma_f32_32x32x16_bf16(pa1, vb[1][0], o0, 0, 0, 0);
        o1 = __builtin_amdgcn_mfma_f32_32x32x16_bf16(pa1, vb[1][1], o1, 0, 0, 0);
    }
    lsum += __shfl_xor(lsum, 32);
    O.o0 = o0; O.o1 = o1; O.lsum = lsum;
}
template <int NQ, bool ACC>
__device__ __forceinline__ void item_acc(const ItemOut& O, int toff, int d, LAS unsigned char* lds, int lane) {
    const int c = lane & 31, hi = lane >> 5;
    LAS float* oacc = (LAS float*)(lds + OACC_OFF); LAS float* lacc = (LAS float*)(lds + LACC_OFF);
    constexpr int NR = NQ == 32 ? 16 : 8;
    LAS float* base = oacc + (toff + 4 * hi * d) * OPITCH + c;
    float a0[NR], a1[NR], lo = 0.f;
    if (ACC) {
#pragma unroll
        for (int r = 0; r < NR; ++r) { const LAS float* row = base + ((r & 3) + 8 * (r >> 2)) * d * OPITCH; a0[r] = row[0]; a1[r] = row[32]; }
        if (hi == 0 && c < NQ) lo = lacc[toff + c * d];
        asm volatile("" ::: "memory");
    }
#pragma unroll
    for (int r = 0; r < NR; ++r) { LAS float* row = base + ((r & 3) + 8 * (r >> 2)) * d * OPITCH; row[0] = ACC ? a0[r] + O.o0[r] : O.o0[r]; row[32] = ACC ? a1[r] + O.o1[r] : O.o1[r]; }
    if (hi == 0 && c < NQ) lacc[toff + c * d] = ACC ? lo + O.lsum : O.lsum;
}

__device__ __forceinline__ void unit(Frame& F, int uidx) {
    const int span = uidx % NSPAN, bh = uidx / NSPAN, h = bh % NH, b = bh / NH, t0 = span * SPAN;
    LAS unsigned char* lds = F.lds;
    LAS float* oacc = (LAS float*)(lds + OACC_OFF); LAS float* lacc = (LAS float*)(lds + LACC_OFF); LAS float* lut = (LAS float*)(lds + LUT_OFF);
    if (F.tid < 387) { const int pat = F.tid / 129, rel = F.tid - pat * 129, d = pat == 0 ? 1 : (pat == 1 ? 4 : 16); lut[F.tid] = F.I.rel_bias[t5_bucket(rel * d) * NH + h] * LOG2E; }
    const size_t boff = (size_t)b * SEQ * DM + h * HD;
    const bf16 *Qb = F.Q + boff, *Kb = F.K + boff, *Vb = F.V + boff;
    const int w = F.wave, lane = F.lane;
    ItemRegs R; ItemOut O;
    const int tqA0 = t0 + 64 * w, tqA1 = tqA0 + 32, tqB0 = t0 + (w & 3) + 256 * (w >> 2), tqB1 = tqB0 + 128, tqC0 = t0 + w, tqC1 = t0 + w + 8;
    item_load<32>(R, Qb, Kb, Vb, tqA0, 1, lane);
    __syncthreads();
    item_tiles<32>(R, O, Kb, Vb, tqA0, 1, 0, lds, w, lane);
    item_load<32>(R, Qb, Kb, Vb, tqA1, 1, lane);
    item_acc<32, false>(O, tqA0 - t0, 1, lds, lane);
    item_tiles<32>(R, O, Kb, Vb, tqA1, 1, 0, lds, w, lane);
    item_load<32>(R, Qb, Kb, Vb, tqB0, 4, lane);
    item_acc<32, false>(O, tqA1 - t0, 1, lds, lane);
    __syncthreads();
    item_tiles<32>(R, O, Kb, Vb, tqB0, 4, 1, lds, w, lane);
    item_load<32>(R, Qb, Kb, Vb, tqB1, 4, lane);
    item_acc<32, true>(O, tqB0 - t0, 4, lds, lane);
    item_tiles<32>(R, O, Kb, Vb, tqB1, 4, 1, lds, w, lane);
    item_load<32>(R, Qb, Kb, Vb, tqC0, 16, lane);
    item_acc<32, true>(O, tqB1 - t0, 4, lds, lane);
    __syncthreads();
    item_tiles<32>(R, O, Kb, Vb, tqC0, 16, 2, lds, w, lane);
    item_load<32>(R, Qb, Kb, Vb, tqC1, 16, lane);
    item_acc<32, true>(O, tqC0 - t0, 16, lds, lane);
    item_tiles<32>(R, O, Kb, Vb, tqC1, 16, 2, lds, w, lane);
    item_acc<32, true>(O, tqC1 - t0, 16, lds, lane);
    __syncthreads();
#pragma unroll 1
    for (int ps = 0; ps < 2; ++ps) {
        const int tl = 64 * w + 32 * ps + (lane >> 1), hf = lane & 1;
        const bf16* gp = F.Gb + ((size_t)b * SEQ + t0 + tl) * DM + h * HD + 32 * hf;
        bf16* ap = F.AU + ((size_t)b * SEQ + t0 + tl) * 2048 + 1024 + h * HD + 32 * hf;
        v4u g[4];
#pragma unroll
        for (int j4 = 0; j4 < 4; ++j4) g[j4] = *(const v4u*)(gp + 8 * j4);
        const float rl = __builtin_amdgcn_rcpf(lacc[tl]);
        const LAS f32x4* op = (const LAS f32x4*)(oacc + tl * OPITCH + 32 * hf);
#pragma unroll
        for (int j4 = 0; j4 < 4; ++j4) {
            const f32x4 a = op[2 * j4], bq = op[2 * j4 + 1]; const v4u gg = g[j4];
            v4u o;
            o.x = pk2(a[0] * rl * __uint_as_float(gg.x << 16), a[1] * rl * __uint_as_float(gg.x & 0xffff0000u));
            o.y = pk2(a[2] * rl * __uint_as_float(gg.y << 16), a[3] * rl * __uint_as_float(gg.y & 0xffff0000u));
            o.z = pk2(bq[0] * rl * __uint_as_float(gg.z << 16), bq[1] * rl * __uint_as_float(gg.z & 0xffff0000u));
            o.w = pk2(bq[2] * rl * __uint_as_float(gg.w << 16), bq[3] * rl * __uint_as_float(gg.w & 0xffff0000u));
            *(v4u*)(ap + 8 * j4) = o;
        }
    }
    __syncthreads();
}

}

namespace ssd {
typedef float f32x16 __attribute__((ext_vector_type(16)));
typedef short v4i16_t __attribute__((ext_vector_type(4)));
typedef unsigned u32x2 __attribute__((ext_vector_type(2)));
typedef float f32x2v __attribute__((ext_vector_type(2)));
constexpr int PITCH = 272;
constexpr int BT_OFF = 0, CT_OFF = 34816, G_OFF = 69632, HB_OFF = 104448, XD_OFF = 121856, XH_OFF = 138240, ACS_OFF = 154624, DTL_OFF = ACS_OFF + 512, SSQL_OFF = DTL_OFF + 512  , XW_OFF = SSQL_OFF + 1024  , FW_OFF = XW_OFF + 1280  , SSD_LDS_END = FW_OFF + 5120;
static_assert(SSD_LDS_END <= LDSCTL_OFF, "SSD LDS");
__device__ __forceinline__ int crow(int r, int hi) { return (r & 3) + 8 * (r >> 2) + 4 * hi; }
__device__ __forceinline__ bf16x8 trfrag(const LAS unsigned char* p0, const LAS unsigned char* p1) {
    const v4i16_t lo = __builtin_amdgcn_ds_read_tr16_b64_v4i16((LAS v4i16_t*)p0), hh = __builtin_amdgcn_ds_read_tr16_b64_v4i16((LAS v4i16_t*)p1);
    return (bf16x8){lo[0], lo[1], lo[2], lo[3], hh[0], hh[1], hh[2], hh[3]};
}
__device__ __forceinline__ float bflo(unsigned w) { return __uint_as_float(w << 16); }
__device__ __forceinline__ float bfhi(unsigned w) { return __uint_as_float(w & 0xffff0000u); }

__device__ __forceinline__ void chain(Frame& F, int item) {
    const Ins& I = F.I;
    const int b = item >> 5, hd = (item >> 1) & 15, seg = item & 1, grp = hd >> 3;
    constexpr int NCH = SEQ / 128, HALF_CH = NCH / 2; const int ch_end = seg ? NCH : HALF_CH;
    const int tid = F.tid, lane = F.lane, w = F.wave, c = lane & 31, hi = lane >> 5;
    LAS unsigned char* lds = F.lds;
    LAS float* acs = (LAS float*)(lds + ACS_OFF); LAS float* dtl = (LAS float*)(lds + DTL_OFF); LAS float* ssql = (LAS float*)(lds + SSQL_OFF);
    const float A = -__expf(I.a_log[hd]), dsk = I.d_skip[hd];
    const size_t row0 = (size_t)b * SEQ;
    for (int i = tid; i < 17408 / 16; i += NWAVES * 64) ((LAS v4u*)(lds + HB_OFF))[i] = (v4u){0u, 0u, 0u, 0u};
    f32x16 hacc = {};
    const int pt = w & 1, jt = w >> 1;
    const int q4 = (lane & 15) >> 2, odd = (lane >> 4) & 1, p4 = lane & 3;
    const int xtr = (8 * hi + q4) * 64 + (16 * odd + 4 * p4) * 2;
    const int xg = tid & 15, xr0 = (tid >> 4) * 4;
    const int fb = tid >> 8, fc = tid & 255;
    for (int i = tid; i < 5 * 64 + 5 * 256; i += NWAVES * 64) {
        if (i < 320) { const int t = i >> 6, e = i & 63; ((LAS float*)(lds + XW_OFF))[i] = t < 4 ? I.conv_w[t * CONVD + hd * 64 + e] : I.conv_b[hd * 64 + e]; }
        else { const int k = i - 320, t = k >> 8, e = k & 255, chn = 1024 + (e < 128 ? grp * 128 + e : 256 + grp * 128 + (e - 128)); ((LAS float*)(lds + FW_OFF))[k] = t < 4 ? I.conv_w[t * CONVD + chn] : I.conv_b[chn]; }
    }
    const int xoff = ((xg >> 3) << 10) + (xg & 7) * 8;
    float dtp0, dtp1; u32x2 xr[7]; v4u bcr[8]; float fxr[6]; u32x2 zr[4];
#define SSD_PREFETCH(T0) do { int t0_ = (T0), tv_ = tid, lv_ = lane; asm volatile("" : "+v"(t0_), "+v"(tv_), "+v"(lv_)); \
        const int xg_ = tv_ & 15, xr0_ = (tv_ >> 4) * 4, fb_ = tv_ >> 8, fc_ = tv_ & 255, fch_ = fc_ < 128 ? grp * 128 + fc_ : 256 + grp * 128 + (fc_ - 128); \
        { const float* dp_ = F.DT + (size_t)hd * MROWS + row0 + t0_ + 2 * lv_; dtp0 = dp_[0]; dtp1 = dp_[1]; } \
        { const bf16* xp_ = F.XBC + (row0 + t0_ + xr0_) * CONVD + hd * 64 + 4 * xg_; \
          _Pragma("unroll") for (int j = 0; j < 7; ++j) xr[j] = (t0_ + xr0_ - 3 + j) >= 0 ? *(const u32x2*)(xp_ + (j - 3) * CONVD) : (u32x2){0u, 0u}; } \
        { const bf16* bp_ = F.XBC + (row0 + t0_ + (tv_ >> 4)) * CONVD + 1024 + grp * 128 + 8 * (tv_ & 15); \
          _Pragma("unroll") for (int k = 0; k < 4; ++k) { bcr[k] = *(const v4u*)(bp_ + (size_t)k * 32 * CONVD); bcr[4 + k] = *(const v4u*)(bp_ + (size_t)k * 32 * CONVD + 256); } } \
        { const size_t blk = (row0 + t0_ + 64 * fb_) >> 6; const bool hasprev = (t0_ + 64 * fb_) > 0; const float* rp_ = F.RAWB + (blk * 6) * 512 + fch_; \
          _Pragma("unroll") for (int j = 0; j < 3; ++j) { fxr[j] = hasprev ? rp_[(j - 6) * 512] : 0.f; fxr[3 + j] = rp_[(3 + j) * 512]; } } \
    } while (0)
#define SSD_PREFETCH_Z(T0) do { int t0_ = (T0), lv_ = lane; asm volatile("" : "+v"(t0_), "+v"(lv_)); \
        const bf16* zp_ = F.Zb + (row0 + t0_ + 32 * jt + (lv_ & 31)) * DM + hd * 64 + 32 * pt + 4 * (lv_ >> 5); \
        _Pragma("unroll") for (int g4 = 0; g4 < 4; ++g4) zr[g4] = *(const u32x2*)(zp_ + 8 * g4); } while (0)
    SSD_PREFETCH(0); if (!seg) SSD_PREFETCH_Z(0);
    __syncthreads();
#pragma unroll 1
    for (int ch = 0; ch < ch_end; ++ch) {
        const int t0 = ch * 128;
        const bool pre = seg && ch < HALF_CH, prevfull = ch > 0 && !(seg && ch - 1 < HALF_CH);
        float aend;
        {
            if (w < 2 && prevfull) { F.SSQ[(row0 + t0 - 128 + lane) * 32 + 2 * hd + w] = ssql[128 * w + lane]; F.SSQ[(row0 + t0 - 64 + lane) * 32 + 2 * hd + w] = ssql[128 * w + 64 + lane]; }
            const float v0 = dtp0 * A, v1 = dtp1 * A; float s = v0 + v1;
#define SSD_DPP_ADD(CTRL, RMASK, BC) s += __builtin_bit_cast(float, __builtin_amdgcn_update_dpp(0, __builtin_bit_cast(int, s), CTRL, RMASK, 0xf, BC))
            SSD_DPP_ADD(0x111, 0xf, true); SSD_DPP_ADD(0x112, 0xf, true); SSD_DPP_ADD(0x114, 0xf, true); SSD_DPP_ADD(0x118, 0xf, true);
            SSD_DPP_ADD(0x142, 0xa, false); SSD_DPP_ADD(0x143, 0xc, false);
#undef SSD_DPP_ADD
            aend = __builtin_bit_cast(float, __builtin_amdgcn_readlane(__builtin_bit_cast(int, s), 63));
            *(LAS f32x2v*)(acs + 2 * lane) = (f32x2v){s - v1, s}; *(LAS f32x2v*)(dtl + 2 * lane) = (f32x2v){dtp0, dtp1};
        }
#pragma unroll
        for (int k = 0; k < 4; ++k) { const int idx = tid + 512 * k, row = idx >> 4;
            if ((row & 63) >= 3) { *(LAS v4u*)(lds + BT_OFF + row * PITCH + 16 * (idx & 15)) = bcr[k]; if (!pre) *(LAS v4u*)(lds + CT_OFF + row * PITCH + 16 * (idx & 15)) = bcr[4 + k]; } }
        if (!pre || fc < 128) {
            LAS unsigned char* dst = lds + (fc < 128 ? BT_OFF + 2 * fc : CT_OFF + 2 * (fc - 128)) + 64 * fb * PITCH;
            const LAS float* fwp = (const LAS float*)(lds + FW_OFF) + fc;
            const float fw0 = fwp[0], fw1 = fwp[256], fw2 = fwp[512], fw3 = fwp[768], fbias = fwp[1024];
#pragma unroll
            for (int j = 0; j < 3; ++j) *(LAS bf16*)(dst + j * PITCH) = (bf16)f2bf(silu_fast(fbias + fw0 * fxr[j] + fw1 * fxr[j + 1] + fw2 * fxr[j + 2] + fw3 * fxr[j + 3]));
        }
        {
            const LAS f32x4* xwp = (const LAS f32x4*)(lds + XW_OFF) + xg;
            const f32x4 xw0 = xwp[0], xw1 = xwp[16], xw2 = xwp[32], xw3 = xwp[48], xb = xwp[64];
            float xv[7][4];
#pragma unroll
            for (int j = 0; j < 7; ++j) { xv[j][0] = bflo(xr[j].x); xv[j][1] = bfhi(xr[j].x); xv[j][2] = bflo(xr[j].y); xv[j][3] = bfhi(xr[j].y); }
#pragma unroll
            for (int i = 0; i < 4; ++i) {
                const int s = xr0 + i; const float dt = dtl[s], de = dt * __expf(aend - acs[s]); float v[4];
#pragma unroll
                for (int e = 0; e < 4; ++e) v[e] = silu_fast(xb[e] + xw0[e] * xv[i][e] + xw1[e] * xv[i + 1][e] + xw2[e] * xv[i + 2][e] + xw3[e] * xv[i + 3][e]);
                const int off = ((s >> 4) << 11) + xoff + (s & 15) * 64;
                if (!pre) *(LAS u32x2*)(lds + XD_OFF + off) = (u32x2){cvtpk_s(v[0] * dt, v[1] * dt), cvtpk_s(v[2] * dt, v[3] * dt)};
                *(LAS u32x2*)(lds + XH_OFF + off) = (u32x2){cvtpk_s(v[0] * de, v[1] * de), cvtpk_s(v[2] * de, v[3] * de)};
            }
        }
        asm volatile("" ::: "memory"); __builtin_amdgcn_sched_barrier(0);
        if (ch + 1 < ch_end) SSD_PREFETCH(t0 + 128);
        __syncthreads();
        f32x16 yt = {};
        if (!pre) {
        {
            const int j = w & 3; const float al = acs[32 * j + c];
#pragma unroll
            for (int ii = 0; ii < 2; ++ii) {
                const int i = 2 * (w >> 2) + ii;
                if (i <= j) {
                    f32x16 x = {};
                    const LAS unsigned char* ap = lds + BT_OFF + (32 * i + c) * PITCH + 16 * hi;
                    const LAS unsigned char* bp = lds + CT_OFF + (32 * j + c) * PITCH + 16 * hi;
#pragma unroll 4
                    for (int ks = 0; ks < 8; ++ks) x = __builtin_amdgcn_mfma_f32_32x32x16_bf16(*(const LAS bf16x8*)(ap + 32 * ks), *(const LAS bf16x8*)(bp + 32 * ks), x, 0, 0, 0);
                    const int l = 32 * j + c;
#pragma unroll
                    for (int g4 = 0; g4 < 4; ++g4) {
                        const int sb = 32 * i + 8 * g4 + 4 * hi; float gv[4];
                        const f32x4 as4 = *(const LAS f32x4*)(acs + sb);
#pragma unroll
                        for (int e = 0; e < 4; ++e) { const int s = sb + e; gv[e] = s <= l ? x[4 * g4 + e] * __builtin_amdgcn_exp2f((al - as4[e]) * LOG2E) : 0.f; }
                        *(LAS u32x2*)(lds + G_OFF + l * PITCH + sb * 2) = (u32x2){cvtpk_s(gv[0], gv[1]), cvtpk_s(gv[2], gv[3])};
                    }
                }
            }
        }
        {
            const LAS unsigned char* ap = lds + HB_OFF + (32 * pt + c) * PITCH + 16 * hi;
            const LAS unsigned char* bp = lds + CT_OFF + (32 * jt + c) * PITCH + 16 * hi;
#pragma unroll 4
            for (int ks = 0; ks < 8; ++ks) yt = __builtin_amdgcn_mfma_f32_32x32x16_bf16(*(const LAS bf16x8*)(ap + 32 * ks), *(const LAS bf16x8*)(bp + 32 * ks), yt, 0, 0, 0);
            const float el = __expf(acs[32 * jt + c]);
#pragma unroll
            for (int r = 0; r < 16; ++r) yt[r] *= el;
        }
        __syncthreads();
        {
            const LAS unsigned char* bp = lds + G_OFF + (32 * jt + c) * PITCH + 16 * hi;
            for (int ks = 0; ks < 2 * jt + 2; ++ks) {
                const LAS unsigned char* xp = lds + XD_OFF + ((ks * 2 + pt) << 10) + xtr;
                yt = __builtin_amdgcn_mfma_f32_32x32x16_bf16(trfrag(xp, xp + 256), *(const LAS bf16x8*)(bp + 32 * ks), yt, 0, 0, 0);
            }
        }
        }
        {
            const float ea = __expf(aend);
#pragma unroll
            for (int r = 0; r < 16; ++r) hacc[r] *= ea;
            const int btr = (8 * hi + q4) * PITCH + (32 * jt + 16 * odd + 4 * p4) * 2;
#pragma unroll 4
            for (int ks = 0; ks < 8; ++ks) {
                const LAS unsigned char* xp = lds + XH_OFF + ((ks * 2 + pt) << 10) + xtr;
                const LAS unsigned char* bp = lds + BT_OFF + 16 * ks * PITCH + btr;
                hacc = __builtin_amdgcn_mfma_f32_32x32x16_bf16(trfrag(xp, xp + 256), trfrag(bp, bp + 4 * PITCH), hacc, 0, 0, 0);
            }
        }
        if (!(seg && ch + 1 < HALF_CH)) {
#pragma unroll
            for (int r = 0; r < 16; r += 2) {
                *(LAS bf16*)(lds + HB_OFF + (32 * pt + crow(r, hi)) * PITCH + (32 * jt + c) * 2) = (bf16)(cvtpk_s(hacc[r], hacc[r + 1]) & 0xffffu);
                *(LAS bf16*)(lds + HB_OFF + (32 * pt + crow(r + 1, hi)) * PITCH + (32 * jt + c) * 2) = (bf16)(cvtpk_s(hacc[r], hacc[r + 1]) >> 16);
            }
        }
        if (!pre) {
            const int l = 32 * jt + c; const float rdt = dsk * __builtin_amdgcn_rcpf(dtl[l]);
            bf16* up = F.AU + (row0 + t0 + l) * 2048 + hd * 64 + 32 * pt;
            float sq = 0.f;
#pragma unroll
            for (int g4 = 0; g4 < 4; ++g4) {
                const int pl = 8 * g4 + 4 * hi;
                const u32x2 xw2 = *(const LAS u32x2*)(lds + XD_OFF + (((l >> 4) * 2 + pt) << 10) + (l & 15) * 64 + pl * 2);
                const u32x2 zw = zr[g4];
                const float u0 = (yt[4 * g4] + rdt * bflo(xw2.x)) * bflo(zw.x), u1 = (yt[4 * g4 + 1] + rdt * bfhi(xw2.x)) * bfhi(zw.x), u2 = (yt[4 * g4 + 2] + rdt * bflo(xw2.y)) * bflo(zw.y), u3 = (yt[4 * g4 + 3] + rdt * bfhi(xw2.y)) * bfhi(zw.y);
                sq += (u0 * u0 + u1 * u1) + (u2 * u2 + u3 * u3);
                *(u32x2*)(up + pl) = (u32x2){cvtpk_s(u0, u1), cvtpk_s(u2, u3)};
            }
            sq += __shfl_xor(sq, 32);
            if (hi == 0) ssql[128 * pt + l] = sq;
        }
        if (ch + 1 < ch_end && !(seg && ch + 1 < HALF_CH)) SSD_PREFETCH_Z(t0 + 128);
        __syncthreads();
    }
#undef SSD_PREFETCH
#undef SSD_PREFETCH_Z
    if (w < 2) { const int t0 = ch_end * 128; F.SSQ[(row0 + t0 - 128 + lane) * 32 + 2 * hd + w] = ssql[128 * w + lane]; F.SSQ[(row0 + t0 - 64 + lane) * 32 + 2 * hd + w] = ssql[128 * w + 64 + lane]; }
    if (seg) {
    float* ho = F.out + O_HP + (((size_t)b * NH + hd) * HD + 32 * pt) * DS + 32 * jt + c;
#pragma unroll
    for (int r = 0; r < 16; ++r) ho[(size_t)crow(r, hi) * DS] = hacc[r];
    }
    __syncthreads();
}
}

namespace smp {
__device__ __forceinline__ void attn_unit(Frame& F, int bhs) {
    const Ins& I = F.I;
    const int lane = F.lane, w = F.wave, b = bhs >> 4, h = bhs & 15, r = NTOK + b;
    LAS float* qs = (LAS float*)(F.lds + 4096); LAS float* acc = (LAS float*)F.lds;
    LAS float* ps = (LAS float*)(F.lds + 8192) + w * 64;
    if (F.tid < 64) qs[F.tid] = bf2f(F.Q[(size_t)r * DM + h * HD + F.tid]);
    if (F.tid < 65) acc[F.tid] = 0.f;
    __syncthreads();
    const int k0 = 49 * w, nk = (387 - k0) < 49 ? (387 - k0) : 49;
    float p = 0.f;
    if (lane < nk) {
        const int idx = k0 + lane, pat = idx / 129, j = idx - pat * 129, d = pat == 0 ? 1 : (pat == 1 ? 4 : 16);
        float s = 0.f;
        if (j > 0) { const f32x4* kp = (const f32x4*)(I.ck + (((size_t)b * WIN + (WIN - j * d)) * NH + h) * HD);
#pragma unroll
            for (int e = 0; e < 16; ++e) { const f32x4 kv = kp[e]; const f32x4 qv = *(const LAS f32x4*)(qs + 4 * e); s += (qv[0] * kv[0] + qv[1] * kv[1]) + (qv[2] * kv[2] + qv[3] * kv[3]); } }
        else { const bf16* kp = F.K + (size_t)r * DM + h * HD; for (int e = 0; e < 64; ++e) s += qs[e] * bf2f(kp[e]); }
        p = __builtin_amdgcn_exp2f(s + I.rel_bias[t5_bucket(j * d) * NH + h] * LOG2E);
    }
    ps[lane] = p;
    const float lsum = wave_sum(p);
    __builtin_amdgcn_wave_barrier();
    float o0 = 0.f, o1 = 0.f, o2 = 0.f, o3 = 0.f;
    const float vnew = bf2f(F.V[(size_t)r * DM + h * HD + lane]);
    const float* vbase = I.cv + ((size_t)b * WIN * NH + h) * HD + lane;
#define SMP_V(K) ({ const int idx_ = k0 + (K), pat_ = idx_ / 129, j_ = idx_ - pat_ * 129, d_ = pat_ == 0 ? 1 : (pat_ == 1 ? 4 : 16); \
                    (K) < nk ? ps[(K)] * (j_ > 0 ? vbase[(size_t)(WIN - j_ * d_) * (NH * HD)] : vnew) : 0.f; })
#pragma unroll
    for (int k = 0; k < 48; k += 4) { o0 += SMP_V(k); o1 += SMP_V(k + 1); o2 += SMP_V(k + 2); o3 += SMP_V(k + 3); }
    o0 += SMP_V(48);
#undef SMP_V
    __hip_atomic_fetch_add(acc + lane, (o0 + o1) + (o2 + o3), __ATOMIC_RELAXED, __HIP_MEMORY_SCOPE_WORKGROUP);
    if (lane == 0) __hip_atomic_fetch_add(acc + 64, lsum, __ATOMIC_RELAXED, __HIP_MEMORY_SCOPE_WORKGROUP);
    __syncthreads();
    if (F.tid < 64) F.AU[(size_t)r * 2048 + 1024 + h * HD + F.tid] = (bf16)f2bf(acc[F.tid] * __builtin_amdgcn_rcpf(acc[64]) * bf2f(F.Gb[(size_t)r * DM + h * HD + F.tid]));
    __syncthreads();
}

__device__ __forceinline__ void ssd_unit(Frame& F, int bhs) {
    const Ins& I = F.I;
    LAS float* xs_l = (LAS float*)F.lds; LAS float* B_l = xs_l + 64; LAS float* C_l = B_l + 128; LAS float* ssq_l = C_l + 128;
    const int tid = F.tid, p = tid >> 3, ng = tid & 7;
    const int b = bhs >> 4, hd = bhs & 15, grp = hd >> 3; const size_t r = (size_t)NTOK + b;
    float h[16];
    { const f32x4* hp = (const f32x4*)(I.sssm + (((size_t)b * NH + hd) * HD + p) * DS + ng * 16);
#pragma unroll
      for (int i = 0; i < 4; ++i) { const f32x4 v = hp[i]; h[4 * i] = v[0]; h[4 * i + 1] = v[1]; h[4 * i + 2] = v[2]; h[4 * i + 3] = v[3]; } }
    if (tid < 320) {
        const int ci = tid, c = ci < 64 ? hd * 64 + ci : (ci < 192 ? 1024 + grp * 128 + (ci - 64) : 1280 + grp * 128 + (ci - 192));
        float v = I.conv_b[c];
#pragma unroll
        for (int i = 0; i < 3; ++i) v += I.sconv[((size_t)b * 3 + i) * CONVD + c] * I.conv_w[i * CONVD + c];
        v += bf2f(F.XBC[r * CONVD + c]) * I.conv_w[3 * CONVD + c];
        xs_l[ci] = silu_f(v);
    }
    if (tid == 0) ssq_l[0] = 0.f;
    __syncthreads();
    const float dt = F.DT[(size_t)hd * MROWS + r], A = -__expf(I.a_log[hd]), x = xs_l[p], dec = __expf(dt * A), xdt = x * dt;
    float y = 0.f;
#pragma unroll
    for (int i = 0; i < 16; ++i) { h[i] = h[i] * dec + xdt * B_l[ng * 16 + i]; y += h[i] * C_l[ng * 16 + i]; }
    y += __shfl_xor(y, 1); y += __shfl_xor(y, 2); y += __shfl_xor(y, 4);
    if (ng == 0) {
        const float u = (y + I.d_skip[hd] * x) * bf2f(F.Zb[r * DM + hd * 64 + p]);
        F.AU[r * 2048 + hd * 64 + p] = (bf16)f2bf(u);
        __hip_atomic_fetch_add(ssq_l, u * u, __ATOMIC_RELAXED, __HIP_MEMORY_SCOPE_WORKGROUP);
    }
    { f32x4* ho = (f32x4*)(F.out + O_HS + (((size_t)b * NH + hd) * HD + p) * DS + ng * 16);
#pragma unroll
      for (int i = 0; i < 4; ++i) ho[i] = (f32x4){h[4 * i], h[4 * i + 1], h[4 * i + 2], h[4 * i + 3]}; }
    __syncthreads();
    if (tid == 0) { F.SSQ[r * 32 + 2 * hd] = ssq_l[0]; F.SSQ[r * 32 + 2 * hd + 1] = 0.f; }
    __syncthreads();
}
}

namespace smp {
typedef float f32x16s __attribute__((ext_vector_type(16)));
template <int KS>
__device__ __forceinline__ void mm32x32(Frame& F, const bf16* WT, int wrow0, const bf16* A, int apitch, int K) {
    const int lane = F.lane, w = F.wave, c = lane & 31, hi = lane >> 5;
    const bf16* ap = WT + (size_t)(wrow0 + c) * K + w * (16 * KS) + 8 * hi;
    const bf16* bp = A + (size_t)c * apitch + w * (16 * KS) + 8 * hi;
    bf16x8 af[KS], bf[KS];
#pragma unroll
    for (int ks = 0; ks < KS; ++ks) { af[ks] = *(const bf16x8*)(ap + 16 * ks); bf[ks] = *(const bf16x8*)(bp + 16 * ks); }
    f32x16s acc = {};
#pragma unroll
    for (int ks = 0; ks < KS; ++ks) acc = __builtin_amdgcn_mfma_f32_32x32x16_bf16(af[ks], bf[ks], acc, 0, 0, 0);
    LAS float* red = (LAS float*)F.lds + w * 1024;
#pragma unroll
    for (int r = 0; r < 16; ++r) red[((r & 3) + 8 * (r >> 2) + 4 * hi) * 32 + c] = acc[r];
    __syncthreads();
}
__device__ __forceinline__ void inproj_pair(Frame& F, int hp) {
    const Ins& I = F.I;
    const int a0 = 64 * hp;
    LAS float* val = (LAS float*)(F.lds + 32768);
    const int lane = F.lane, w = F.wave;
#pragma unroll 1
    for (int hf = 0; hf < 2; ++hf) {
        const int a = a0 + 32 * hf;
        mm32x32<8>(F, F.WinT, (a & ~255) + vrow_of_col(a & 255), F.XN + (size_t)NTOK * DM, DM, DM);
        const LAS float* red = (const LAS float*)F.lds;
        { const int col = F.tid >> 4, r0 = 2 * (F.tid & 15); float s0 = 0.f, s1 = 0.f;
#pragma unroll
          for (int k = 0; k < 8; ++k) { s0 += red[k * 1024 + col * 32 + r0]; s1 += red[k * 1024 + col * 32 + r0 + 1]; }
          val[r0 * 64 + 32 * hf + col] = s0; val[(r0 + 1) * 64 + 32 * hf + col] = s1; }
        __syncthreads();
    }
#pragma unroll 1
    for (int rr = 0; rr < 4; ++rr) {
        const int r = 4 * w + rr;
        const float v = val[r * 64 + lane];
        const size_t row = (size_t)NTOK + r; const int col = a0 + lane;
        if (col < C_V) {
            const float sc = rsqrtf(wave_sum(v * v) * (1.f / 64.f) + EPS);
            if (col < C_K) F.Q[row * DM + col] = (bf16)f2bf(v * sc * I.qnw[lane] * QSCALE);
            else { const float kv = v * sc * I.knw[lane]; F.K[row * DM + col - C_K] = (bf16)f2bf(kv); F.out[O_KS + (size_t)r * DM + col - C_K] = kv; }
        } else if (col < C_G) { F.V[row * DM + col - C_V] = (bf16)f2bf(v); F.out[O_VS + (size_t)r * DM + col - C_V] = v; }
        else if (col < C_Z) F.Gb[row * DM + col - C_G] = (bf16)f2bf(silu_fast(v));
        else if (col < C_XBC) F.Zb[row * DM + col - C_Z] = (bf16)f2bf(silu_fast(v));
        else { F.XBC[row * CONVD + col - C_XBC] = (bf16)f2bf(v); F.out[O_CS + ((size_t)r * 3 + 2) * CONVD + col - C_XBC] = v; }
    }
    __syncthreads();
}
__device__ __forceinline__ void outproj_unit(Frame& F, int ct) {
    const Ins& I = F.I;
    const int a0 = 32 * ct;
    mm32x32<16>(F, F.WoutT, (a0 & ~255) + vrow_of_col(a0 & 255), F.AU + (size_t)NTOK * 2048, 2048, 2048);
    const LAS float* red = (const LAS float*)F.lds;
    const int col = F.tid >> 4, r0 = 2 * (F.tid & 15);
#pragma unroll
    for (int q = 0; q < 2; ++q) {
        const int r = r0 + q; float su = 0.f, sa = 0.f;
#pragma unroll
        for (int k = 0; k < 4; ++k) { su += red[k * 1024 + col * 32 + r]; sa += red[(4 + k) * 1024 + col * 32 + r]; }
        const f32x4* sp = (const f32x4*)(F.SSQ + ((size_t)NTOK + r) * 32); float s = 0.f;
#pragma unroll
        for (int i = 0; i < 8; ++i) { const f32x4 t = sp[i]; s += (t[0] + t[1]) + (t[2] + t[3]); }
        F.out[O_YS + (size_t)r * DM + a0 + col] = I.xs[(size_t)r * DM + a0 + col] + su * rsqrtf(s * (1.f / 1024.f) + EPS) + sa;
    }
    __syncthreads();
}
}

__device__ __forceinline__ void phase2_queue(Frame& F, int qset) {
    const unsigned x = xb_xcc_id() & 7u;
    constexpr int PER_Q = att::NUNITS / 8;
    for (unsigned k = 0; k < 8; ++k) {
        const unsigned qx = (x + k) & 7u;
        gu32* qw = F.ctl + CW_Q + 64 * (8 * qset + qx);
        if (F.tid == 0) F.MISC[16] = __hip_atomic_fetch_add(qw, 1u, RLX_AGENT);
        __syncthreads();
        unsigned idx = F.MISC[16];
        while (idx < (unsigned)(PER_Q + 128)) {
            unsigned nxt = 0u;
            if (F.tid == 0) nxt = __hip_atomic_fetch_add(qw, 1u, RLX_AGENT);
            if (idx < 64u) smp::attn_unit(F, (int)(qx * 64 + idx));
            else if (idx < 128u) smp::ssd_unit(F, (int)(qx * 64 + idx - 64));
            else { { PB_BEGIN(32) att::unit(F, (int)(qx * PER_Q + idx - 128)); PB_END(32) } if (PROBE_ID == 31) { const unsigned long long t0_ = __builtin_amdgcn_s_memrealtime(); while (__builtin_amdgcn_s_memrealtime() - t0_ < 2000ull) __builtin_amdgcn_s_sleep(8); } }
            if (F.tid == 0) F.MISC[16] = nxt;
            __syncthreads();
            idx = F.MISC[16];
        }
        __syncthreads();
    }
}

constexpr int PROBE_REP_SSD = 1, PROBE_REP_ATT = 1;
struct Args { Ins in; float* out; unsigned char* ws; int ph_lo, ph_hi; };
__global__ void __launch_bounds__(NWAVES * 64, 2) mk_fwd(Args args) {
    extern __shared__ __attribute__((aligned(16))) unsigned char lds[];
    Frame F;
    F.lds = (LAS unsigned char*)lds;
    F.MISC = (volatile LAS unsigned*)(F.lds + MISC_OFF);
    F.tid = threadIdx.x; F.lane = F.tid & 63; F.wave = __builtin_amdgcn_readfirstlane(F.tid >> 6);
    F.G = gridDim.x; { const int bx = blockIdx.x; F.vcu = (F.G % 8 == 0) ? (bx % 8) * (F.G / 8) + bx / 8 : bx; }
    unsigned char* ws = args.ws;
    F.ctl = (gu32*)(ws + WS_CTL); F.I = args.in; F.out = args.out;
    F.WinT = (bf16*)(ws + WS_WIN); F.WoutT = (bf16*)(ws + WS_WOUT); F.XN = (bf16*)(ws + WS_XN); F.Q = (bf16*)(ws + WS_Q); F.K = (bf16*)(ws + WS_K); F.V = (bf16*)(ws + WS_V);
    F.AU = (bf16*)(ws + WS_AU); F.XBC = (bf16*)(ws + WS_XBC); F.DT = (float*)(ws + WS_DT); F.SSQ = (float*)(ws + WS_SSQ); F.RAWB = (float*)(ws + WS_RAWB); F.Gb = (bf16*)(ws + WS_G); F.Zb = (bf16*)(ws + WS_Z);
    for (int u = F.tid; u < (LDS_BYTES - LDSCTL_OFF) / 4; u += NWAVES * 64) ((LAS unsigned*)(F.lds + LDSCTL_OFF))[u] = 0u;
    __syncthreads();
    XcdBarrier bar = xcd_barrier_post((unsigned*)(F.ctl + CW_BAR), F.MISC + 8);
    const int lo = args.ph_lo, hi = args.ph_hi;
#define IN(k) (lo <= (k) && (k) < hi)
#define BOTH(k) (IN(k) && IN((k) + 1))
    if (IN(0)) { p0_prologue(F); if (BOTH(0)) xcd_barrier(bar); }
    if (IN(1)) {
        __syncthreads();
        pg8::Gemm g{F.XN, F.WinT, NTOK, NMAIN, DM}; pg8::StaticOrder S; S.init(NTOK, NMAIN, F.G, (int)blockIdx.x);
        pg8::EpiIn E{F.Q, F.K, F.V, F.Gb, F.Zb, F.XBC, F.out, F.I.qnw, F.I.knw, F.I.conv_w, F.I.conv_b, F.RAWB};
        pg8::gemm_phase<pg8::EpiIn, pg8::StaticOrder, true, true>(F.lds + RING_OFF, g, S, E);
        __syncthreads();
        for (int hp = F.vcu; hp < NMAIN / 64; hp += F.G) smp::inproj_pair(F, hp);
        if (BOTH(1)) xcd_barrier(bar);
    }
    if (IN(2)) { __syncthreads(); if ((F.vcu & 31) < 16 && (F.vcu >> 5) < 8) { ssd::chain(F, (F.vcu >> 5) * 16 + (F.vcu & 31)); if (PROBE_ID == 30 && (F.vcu & 1)) { const unsigned long long t0_ = __builtin_amdgcn_s_memrealtime(); while (__builtin_amdgcn_s_memrealtime() - t0_ < 10000ull) __builtin_amdgcn_s_sleep(8); } } for (int rep = 0; rep < PROBE_REP_ATT; ++rep) phase2_queue(F, rep);     if (BOTH(2)) xcd_barrier(bar); }
    if (IN(3)) {
        __syncthreads();
        pg8::Gemm g{F.AU, F.WoutT, NTOK, DM, 2048}; pg8::StaticOrder S; S.init(NTOK, DM, F.G, (int)blockIdx.x);
        LAS float* rs = (LAS float*)(F.lds + RING_BYTES);
        { pg8::Unit u;
          for (int ui = 0; ui < 4 && S.next(ui, u); ++ui)
              for (int r = F.tid; r < 256; r += NWAVES * 64) {
                  const f32x4* sp = (const f32x4*)(F.SSQ + (size_t)(u.pm * 256 + r) * 32);
                  float s = 0.f;
#pragma unroll
                  for (int q = 0; q < 8; ++q) { const f32x4 v = sp[q]; s += (v[0] + v[1]) + (v[2] + v[3]); }
                  rs[ui * 256 + r] = rsqrtf(s * (1.f / 1024.f) + EPS);
              }
          __syncthreads(); }
        pg8::EpiOut E{F.I.xp, F.I.xs, rs, F.out};
        pg8::gemm_phase<pg8::EpiOut, pg8::StaticOrder, true, true>(F.lds + RING_OFF, g, S, E);
        __syncthreads();
        for (int ct = F.G - 1 - F.vcu; ct >= 0 && ct < DM / 32; ct += F.G) smp::outproj_unit(F, ct);
    }
#undef IN
#undef BOTH
}

extern "C" void kernel_launch(void* const* d_in, const int* in_sizes, int n_in, void* d_out, int out_size, void* d_ws, size_t ws_size, hipStream_t stream) {
    static int grid = 0;
    if (grid == 0) {
        if (n_in != 18 || out_size != (int)O_END || ws_size < WS_END) { fprintf(stderr, "kernel_launch: unexpected n_in %d / out_size %d / ws_size %zu; nothing launched\n", n_in, out_size, ws_size); grid = -1; return; }
        int dev = 0, cus = 0;
        if (hipGetDevice(&dev) != hipSuccess || hipDeviceGetAttribute(&cus, hipDeviceAttributeMultiprocessorCount, dev) != hipSuccess) { grid = -1; return; }
        if (hipFuncSetAttribute((const void*)mk_fwd, hipFuncAttributeMaxDynamicSharedMemorySize, LDS_BYTES) != hipSuccess) { fprintf(stderr, "kernel_launch: hipFuncSetAttribute failed\n"); grid = -1; return; }
        (void)hipGetLastError();
        grid = cus;
    }
    if (grid < 0) return;
    (void)hipMemsetAsync((char*)d_ws + WS_CTL, 0, CTL_ZERO_BYTES, stream);
    Args a{};
    const float** ip = (const float**)&a.in;
    for (int i = 0; i < 18; ++i) ip[i] = (const float*)d_in[i];
    a.out = (float*)d_out; a.ws = (unsigned char*)d_ws;
    a.ph_lo = 0; a.ph_hi = 4;
    hipLaunchKernelGGL(mk_fwd, dim3(grid), dim3(NWAVES * 64), LDS_BYTES, stream, a);
}
```

```cpp
#include <hip/hip_runtime.h>
#include <cstdio>
#include <cstdint>

constexpr int DM = 1024, NB = 4, SEQ = 8192, DB = 32, WIN = 2048;
constexpr int NPROJ = 6672, NMAIN = 6656, NTOK = NB * SEQ, NROWS = NTOK + DB;
constexpr int MROWS = 33024;
constexpr int C_Q = 0, C_K = 1024, C_V = 2048, C_G = 3072, C_Z = 4096, C_XBC = 5120, C_DT = 6656;
constexpr int CONVD = 1536, NH = 16, HD = 64, DS = 128;
constexpr float EPS = 1e-6f;
constexpr float QSCALE = 0.125f * 1.4426950408889634f;
constexpr float LOG2E = 1.4426950408889634f;
constexpr size_t O_YP = 0, O_YS = O_YP + (size_t)NTOK * DM, O_KP = O_YS + (size_t)DB * DM, O_VP = O_KP + (size_t)NB * WIN * DM,
                 O_CP = O_VP + (size_t)NB * WIN * DM, O_HP = O_CP + (size_t)NB * 3 * CONVD, O_KS = O_HP + (size_t)NB * NH * HD * DS,
                 O_VS = O_KS + (size_t)DB * DM, O_CS = O_VS + (size_t)DB * DM, O_HS = O_CS + (size_t)DB * 3 * CONVD,
                 O_END = O_HS + (size_t)DB * NH * HD * DS;
static_assert(O_END == 55314432, "output size");

constexpr size_t MiB = 1u << 20;
constexpr size_t WS_CTL = 0, CTL_ZERO_BYTES = 1 * MiB;
constexpr size_t WS_WIN = 2 * MiB;
constexpr size_t WS_WOUT = 16 * MiB;
constexpr size_t WS_DT = 20 * MiB;
constexpr size_t WS_SSQ = 24 * MiB;
constexpr size_t WS_XN = 32 * MiB;
constexpr size_t WS_Q = 100 * MiB;
constexpr size_t WS_K = 168 * MiB;
constexpr size_t WS_V = 236 * MiB;
constexpr size_t WS_AU = 304 * MiB;
constexpr size_t WS_XBC = 436 * MiB;
constexpr size_t WS_RAWB = 536 * MiB;
constexpr size_t WS_G = 544 * MiB;
constexpr size_t WS_Z = 612 * MiB;
constexpr size_t WS_END = 680 * MiB;
static_assert(WS_XN + (size_t)MROWS * DM * 2 <= WS_Q && WS_Q + (size_t)MROWS * DM * 2 <= WS_K && WS_K + (size_t)MROWS * DM * 2 <= WS_V && WS_V + (size_t)MROWS * DM * 2 <= WS_AU &&
              WS_AU + (size_t)MROWS * 2048 * 2 <= WS_XBC && WS_XBC + (size_t)MROWS * CONVD * 2 <= WS_RAWB && WS_RAWB + (size_t)(MROWS / 64) * 6 * 512 * 4 <= WS_G && WS_G + (size_t)MROWS * DM * 2 <= WS_Z && WS_Z + (size_t)MROWS * DM * 2 <= WS_END && WS_WIN + (size_t)NMAIN * DM * 2 <= WS_WOUT && WS_WOUT + (size_t)DM * 2048 * 2 <= WS_DT &&
              WS_DT + (size_t)MROWS * 16 * 4 <= WS_SSQ && WS_SSQ + (size_t)MROWS * 32 * 4 <= WS_XN, "d_ws map");

struct Ins {
    const float *xp, *xs, *ck, *cv, *sconv, *sssm, *norm_w, *w_in, *qnw, *knw, *rel_bias, *conv_w, *conv_b, *dt_bias, *a_log, *d_skip, *ssd_norm_w, *w_out;
};

typedef unsigned short bf16;
__device__ __forceinline__ float wave_sum(float v) {
#pragma unroll
    for (int o = 1; o < 64; o <<= 1) v += __shfl_xor(v, o);
    return v;
}
__device__ __forceinline__ float wave_max(float v) {
#pragma unroll
    for (int o = 1; o < 64; o <<= 1) v = fmaxf(v, __shfl_xor(v, o));
    return v;
}
__device__ __forceinline__ float silu_f(float x) { return x / (1.f + __expf(-x)); }
__device__ __forceinline__ float silu_fast(float x) { return x * __builtin_amdgcn_rcpf(1.f + __builtin_amdgcn_exp2f(-LOG2E * x)); }
__device__ __forceinline__ float softplus_f(float x) { return x > 20.f ? x : log1pf(__expf(x)); }
__device__ __forceinline__ int t5_bucket(int d) {
    if (d < 16) return d;
    int b = 16;
    b += d >= 22; b += d >= 30; b += d >= 40; b += d >= 54; b += d >= 73; b += d >= 99; b += d >= 134; b += d >= 182;
    b += d >= 246; b += d >= 332; b += d >= 450; b += d >= 609; b += d >= 825; b += d >= 1117; b += d >= 1513;
    return b;
}
__device__ __forceinline__ const float* xrow(const Ins& I, int r) { return r < NTOK ? I.xp + (size_t)r * DM : I.xs + (size_t)(r - NTOK) * DM; }
__device__ __forceinline__ float bf2f(bf16 v) { return __uint_as_float((unsigned)v << 16); }
__device__ __forceinline__ unsigned f2bf(float f) { unsigned u = __float_as_uint(f); return (u + 0x7fffu + ((u >> 16) & 1u)) >> 16; }
__device__ __forceinline__ unsigned pk2(float lo, float hi) { return f2bf(lo) | (f2bf(hi) << 16); }
typedef float f32x2_cv __attribute__((ext_vector_type(2))); typedef __bf16 bf16x2_cv __attribute__((ext_vector_type(2)));
__device__ __forceinline__ unsigned cvtpk_s(float lo, float hi) { const f32x2_cv v = {lo, hi}; const bf16x2_cv b = __builtin_convertvector(v, bf16x2_cv); return __builtin_bit_cast(unsigned, b); }
__host__ __device__ __forceinline__ int vrow_of_col(int a) { return 128 * ((a >> 5) & 1) + 32 * ((a >> 6) & 3) + (a & 31); }

namespace pg8 {
#define PG8_LAS __attribute__((address_space(3)))
typedef unsigned short bf16_t;
typedef short bf16x8 __attribute__((ext_vector_type(8)));
typedef float f32x4 __attribute__((ext_vector_type(4)));
typedef unsigned u32x4 __attribute__((ext_vector_type(4)));
constexpr int BM = 256, BK = 64, HALF = 128, HTB = HALF * BK * 2  , STAGE_BYTES = 8 * HTB, NXCD = 8, WGM = 8;

__host__ __device__ __forceinline__ int lds_byte(int r, int c) { const int st = (r >> 4) * 2 + (c >> 5), rr = r & 15, cc = c & 31, ob = rr * 64 + cc * 2; return st * 1024 + (ob ^ (((ob >> 9) & 1) << 5)); }
__host__ __device__ __forceinline__ void stage_rc(int b, int& R, int& C) { const int st = b / 1024, sb = b % 1024, swz = sb ^ (((sb >> 9) & 1) << 5); R = (st >> 1) * 16 + swz / 64; C = (st & 1) * 32 + (swz % 64) / 2; }
__host__ __device__ __forceinline__ int perm32(int rho) { const int n = rho >> 4, i = rho & 15; return 8 * (i >> 2) + 4 * n + (i & 3); }

struct Unit { int pm, pn; };
struct Gemm { const bf16_t* A; const bf16_t* Bt; int M, N, K; };

struct StaticOrder {
    int nM, nN, nwg, G, c;
    __host__ __device__ void init(int M, int N, int G_, int c_) { nM = M / BM; nN = N / BM; nwg = nM * nN; G = G_; c = c_; }
    __host__ __device__ bool next(int i, Unit& u) const {
        const long L = (long)i * G + c; if (L >= nwg) return false;
        int wgid = (int)L; { const int q = nwg / NXCD, r = nwg % NXCD, xcd = wgid % NXCD, off = wgid / NXCD; wgid = (xcd < r ? xcd * (q + 1) : r * (q + 1) + (xcd - r) * q) + off; }
        const int nig = WGM * nN, gid = wgid / nig, fm = gid * WGM, gsz = (nM - fm) < WGM ? (nM - fm) : WGM;
        u.pm = fm + ((wgid % nig) % gsz); u.pn = (wgid % nig) / gsz; return true;
    }
    __device__ __forceinline__ void a_ready(const Unit&) const {}
    __device__ __forceinline__ void done(const Unit&) const {}
};

__device__ __forceinline__ unsigned cvt_pk_bf16(float lo, float hi) { unsigned r; asm volatile("v_cvt_pk_bf16_f32 %0, %1, %2" : "=v"(r) : "v"(lo), "v"(hi)); return r; }

template <int K> __device__ __forceinline__ float rowprev(float cur, float prevm) {
    const int t = __builtin_amdgcn_update_dpp(0, __builtin_bit_cast(int, prevm), 0x100 + (16 - K), 0xf, 0xf, true);
    return __builtin_bit_cast(float, __builtin_amdgcn_update_dpp(t, __builtin_bit_cast(int, cur), 0x110 + K, 0xf, 0xf, false));
}

struct EpiIn {
    static constexpr bool PERM = true, AFTER_DRAIN = false, MIDK = false;
    bf16_t *Q, *K, *V, *Gb, *Zb, *XBC; float* out; const float *qnw, *knw, *conv_w, *conv_b; float* rawb;
    __device__ __forceinline__ void mid(f32x4 (&)[2][2][4][2], const Unit&, int, int, int, int, int) const {}
    __device__ __forceinline__ void operator()(const f32x4 (&acc)[2][2][4][2], const Unit& u, int wr, int wc, int fr, int fq) const {
        const int pn = u.pn;
        const int rowb = u.pm * BM + wr * 64 + fr;
        const int cl = wc * 64 + 8 * fq;
        if (pn < 8) {
            const bool isq = pn < 4; const float* nw = isq ? qnw : knw;
            f32x4 w[2][2];
#pragma unroll
            for (int bj = 0; bj < 2; ++bj)
#pragma unroll
                for (int n = 0; n < 2; ++n) w[bj][n] = *(const f32x4*)(nw + 8 * fq + 32 * bj + 4 * n);
            bf16_t* dstb = (isq ? Q : K) + (pn & 3) * 256 + cl;
#pragma unroll
            for (int ai = 0; ai < 2; ++ai)
#pragma unroll
                for (int m = 0; m < 4; ++m) {
                    const int r = rowb + ai * HALF + m * 16;
                    float ss = 0.f;
#pragma unroll
                    for (int bj = 0; bj < 2; ++bj)
#pragma unroll
                        for (int n = 0; n < 2; ++n) { const f32x4 v = acc[ai][bj][m][n]; ss += (v[0] * v[0] + v[1] * v[1]) + (v[2] * v[2] + v[3] * v[3]); }
                    ss += __shfl_xor(ss, 16); ss += __shfl_xor(ss, 32);
                    const float sc = rsqrtf(ss * (1.f / 64.f) + EPS), scs = isq ? sc * QSCALE : sc;
                    float* f32dst = nullptr;
                    if (!isq) { if (r < NTOK) { const int t = r & (SEQ - 1); if (t >= SEQ - WIN) f32dst = out + O_KP + ((size_t)((r >> 13) * WIN + t - (SEQ - WIN))) * DM + (pn & 3) * 256 + cl; }
                                else if (r < NROWS) f32dst = out + O_KS + (size_t)(r - NTOK) * DM + (pn & 3) * 256 + cl; }
#pragma unroll
                    for (int bj = 0; bj < 2; ++bj) {
                        const f32x4 a0 = acc[ai][bj][m][0] * w[bj][0], a1 = acc[ai][bj][m][1] * w[bj][1];
                        u32x4 o; o.x = cvt_pk_bf16(a0[0] * scs, a0[1] * scs); o.y = cvt_pk_bf16(a0[2] * scs, a0[3] * scs); o.z = cvt_pk_bf16(a1[0] * scs, a1[1] * scs); o.w = cvt_pk_bf16(a1[2] * scs, a1[3] * scs);
                        *(u32x4*)(dstb + (size_t)r * DM + 32 * bj) = o;
                        if (f32dst) { *(f32x4*)(f32dst + 32 * bj) = a0 * sc; *(f32x4*)(f32dst + 32 * bj + 4) = a1 * sc; }
                    }
                }
        } else if (pn < 12) {
            bf16_t* dstb = V + (pn & 3) * 256 + cl;
#pragma unroll
            for (int ai = 0; ai < 2; ++ai)
#pragma unroll
                for (int m = 0; m < 4; ++m) {
                    const int r = rowb + ai * HALF + m * 16;
                    float* f32dst = nullptr;
                    if (r < NTOK) { const int t = r & (SEQ - 1); if (t >= SEQ - WIN) f32dst = out + O_VP + ((size_t)((r >> 13) * WIN + t - (SEQ - WIN))) * DM + (pn & 3) * 256 + cl; }
                    else if (r < NROWS) f32dst = out + O_VS + (size_t)(r - NTOK) * DM + (pn & 3) * 256 + cl;
#pragma unroll
                    for (int bj = 0; bj < 2; ++bj) {
                        const f32x4 a0 = acc[ai][bj][m][0], a1 = acc[ai][bj][m][1];
                        u32x4 o; o.x = cvt_pk_bf16(a0[0], a0[1]); o.y = cvt_pk_bf16(a0[2], a0[3]); o.z = cvt_pk_bf16(a1[0], a1[1]); o.w = cvt_pk_bf16(a1[2], a1[3]);
                        *(u32x4*)(dstb + (size_t)r * DM + 32 * bj) = o;
                        if (f32dst) { *(f32x4*)(f32dst + 32 * bj) = a0; *(f32x4*)(f32dst + 32 * bj + 4) = a1; }
                    }
                }
        } else if (pn < 20) {
            bf16_t* dstb = (pn < 16 ? Gb : Zb) + (pn & 3) * 256 + cl;
#pragma unroll
            for (int ai = 0; ai < 2; ++ai)
#pragma unroll
                for (int m = 0; m < 4; ++m) {
                    const int r = rowb + ai * HALF + m * 16;
#pragma unroll
                    for (int bj = 0; bj < 2; ++bj) {
                        f32x4 a0 = acc[ai][bj][m][0], a1 = acc[ai][bj][m][1];
#pragma unroll
                        for (int i = 0; i < 4; ++i) { a0[i] = silu_fast(a0[i]); a1[i] = silu_fast(a1[i]); }
                        u32x4 o; o.x = cvt_pk_bf16(a0[0], a0[1]); o.y = cvt_pk_bf16(a0[2], a0[3]); o.z = cvt_pk_bf16(a1[0], a1[1]); o.w = cvt_pk_bf16(a1[2], a1[3]);
                        *(u32x4*)(dstb + (size_t)r * DM + 32 * bj) = o;
                    }
                }
        } else {
            const int cb = (pn - 20) * 256 + cl;
            bf16_t* dstb = XBC + cb;
            const bool do_conv = pn >= 24 && u.pm < NTOK / BM;
#pragma unroll
            for (int ai = 0; ai < 2; ++ai)
#pragma unroll
                for (int m = 0; m < 4; ++m) {
                    const int r = rowb + ai * HALF + m * 16;
                    float* f32dst = nullptr;
                    if (r < NTOK) { const int t = r & (SEQ - 1); if (t >= SEQ - 3) f32dst = out + O_CP + ((size_t)((r >> 13) * 3 + t - (SEQ - 3))) * CONVD + cb; }
                    else if (r < NROWS) f32dst = out + O_CS + ((size_t)(r - NTOK) * 3 + 2) * CONVD + cb;
                    if (do_conv && (m == 0 || m == 3)) {
                        const int slot = m == 0 ? 3 + fr : fr - 13;
                        if (slot >= 0 && slot < 6) f32dst = rawb + ((size_t)(u.pm * 4 + ai * 2 + wr) * 6 + slot) * 512 + (cb - 1024);
                    }
#pragma unroll
                    for (int bj = 0; bj < 2; ++bj) {
                        const f32x4 a0 = acc[ai][bj][m][0], a1 = acc[ai][bj][m][1];
                        if (!do_conv) { u32x4 o; o.x = cvt_pk_bf16(a0[0], a0[1]); o.y = cvt_pk_bf16(a0[2], a0[3]); o.z = cvt_pk_bf16(a1[0], a1[1]); o.w = cvt_pk_bf16(a1[2], a1[3]);
                                        *(u32x4*)(dstb + (size_t)r * CONVD + 32 * bj) = o; }
                        if (f32dst) { *(f32x4*)(f32dst + 32 * bj) = a0; *(f32x4*)(f32dst + 32 * bj + 4) = a1; }
                    }
                }
            if (do_conv) {
                if ((u.pm & 31) == 31 && wr == 1 && fr >= 13) {
#pragma unroll
                    for (int bj = 0; bj < 2; ++bj) { float* d = out + O_CP + ((size_t)((u.pm >> 5) * 3 + fr - 13)) * CONVD + cb + 32 * bj; *(f32x4*)d = acc[1][bj][3][0]; *(f32x4*)(d + 4) = acc[1][bj][3][1]; }
                }
#pragma unroll
                for (int bj = 0; bj < 2; ++bj) {
                    f32x4 w[4][2], bb[2];
#pragma unroll
                    for (int n = 0; n < 2; ++n) { bb[n] = *(const f32x4*)(conv_b + cb + 32 * bj + 4 * n);
#pragma unroll
                        for (int t = 0; t < 4; ++t) w[t][n] = *(const f32x4*)(conv_w + t * CONVD + cb + 32 * bj + 4 * n); }
#pragma unroll
                    for (int ai = 0; ai < 2; ++ai) {
                        f32x4 pm[2] = {(f32x4){0.f, 0.f, 0.f, 0.f}, (f32x4){0.f, 0.f, 0.f, 0.f}};
#pragma unroll
                        for (int m = 0; m < 4; ++m) {
                            const int r = rowb + ai * HALF + m * 16;
                            unsigned ow[4];
#pragma unroll
                            for (int n = 0; n < 2; ++n) {
                                const f32x4 cur = acc[ai][bj][m][n]; f32x4 v;
#pragma unroll
                                for (int i = 0; i < 4; ++i) {
                                    const float p1 = rowprev<1>(cur[i], pm[n][i]), p2 = rowprev<2>(cur[i], pm[n][i]), p3 = rowprev<3>(cur[i], pm[n][i]);
                                    v[i] = silu_fast(bb[n][i] + w[0][n][i] * p3 + w[1][n][i] * p2 + w[2][n][i] * p1 + w[3][n][i] * cur[i]);
                                }
                                ow[2 * n] = cvt_pk_bf16(v[0], v[1]); ow[2 * n + 1] = cvt_pk_bf16(v[2], v[3]);
                                pm[n] = cur;
                            }
                            *(u32x4*)(dstb + (size_t)r * CONVD + 32 * bj) = (u32x4){ow[0], ow[1], ow[2], ow[3]};
                        }
                    }
                }
            }
        }
    }
};

struct EpiOut {
    static constexpr bool PERM = true, AFTER_DRAIN = false, MIDK = true;
    const float* xp; const float* xs; const PG8_LAS float* rs; float* out;
    __device__ __forceinline__ void mid(f32x4 (&acc)[2][2][4][2], const Unit& u, int ui, int wr, int wc, int fr, int fq) const {
        const PG8_LAS float* rp = rs + ui * 256 + wr * 64 + fr;
#pragma unroll
        for (int ai = 0; ai < 2; ++ai)
#pragma unroll
            for (int m = 0; m < 4; ++m) {
                const float r = rp[ai * HALF + m * 16];
#pragma unroll
                for (int bj = 0; bj < 2; ++bj)
#pragma unroll
                    for (int n = 0; n < 2; ++n) acc[ai][bj][m][n] *= r;
            }
    }
    __device__ __forceinline__ void operator()(const f32x4 (&acc)[2][2][4][2], const Unit& u, int wr, int wc, int fr, int fq) const {
        const int rowb = u.pm * BM + wr * 64 + fr, col = u.pn * BM + wc * 64 + 8 * fq;
#pragma unroll
        for (int ai = 0; ai < 2; ++ai) {
            f32x4 xv[4][2][2];
#pragma unroll
            for (int m = 0; m < 4; ++m) {
                const float* xr = xp + (size_t)(rowb + ai * HALF + m * 16) * DM + col;
#pragma unroll
                for (int bj = 0; bj < 2; ++bj) { xv[m][bj][0] = *(const f32x4*)(xr + 32 * bj); xv[m][bj][1] = *(const f32x4*)(xr + 32 * bj + 4); }
            }
#pragma unroll
            for (int m = 0; m < 4; ++m) {
                float* yr = out + O_YP + (size_t)(rowb + ai * HALF + m * 16) * DM + col;
#pragma unroll
                for (int bj = 0; bj < 2; ++bj) { *(f32x4*)(yr + 32 * bj) = xv[m][bj][0] + acc[ai][bj][m][0]; *(f32x4*)(yr + 32 * bj + 4) = xv[m][bj][1] + acc[ai][bj][m][1]; }
            }
        }
    }
};

template <class Epi, class Sched, bool ALIGN_EPI = false, bool SP2 = false>
__device__ __forceinline__ void gemm_phase(PG8_LAS unsigned char* lds, const Gemm g, const Sched& S, const Epi& E) {
    const int tid = threadIdx.x, wid = __builtin_amdgcn_readfirstlane(tid >> 6), lane = tid & 63, wr = wid >> 2, wc = wid & 3, fr = lane & 15, fq = lane >> 4;
    const int K = g.K, nt = K / BK;
    unsigned voffA[2], voffB[2];
#pragma unroll
    for (int i = 0; i < 2; ++i) { int R, C; stage_rc(tid * 16 + i * 8192, R, C); const int Rb = Epi::PERM ? ((R & ~31) + perm32(R & 31)) : R;
        voffA[i] = (unsigned)(R * K + C) * 2u; voffB[i] = (unsigned)(Rb * K + C) * 2u; }
    const size_t kstep = (size_t)(BK * 2);
    const size_t hstep = (size_t)HALF * K * 2;
    const size_t tstep = 2 * hstep;
    const unsigned ldsw = (unsigned)wid * 1024u;
    const int aoff = lds_byte(wr * 64 + fr, fq * 8), boff = lds_byte(wc * 32 + fr, fq * 8);
#define PG8_SA(b, h) (((b) * 2 + (h)) * HTB)
#define PG8_SB(b, h) ((4 + (b) * 2 + (h)) * HTB)
#define PG8_STAGE(bufoff, gbase, voff) do { _Pragma("unroll") for (int _i = 0; _i < 2; ++_i) \
        __builtin_amdgcn_global_load_lds((const unsigned*)((const char*)(gbase) + (voff)[_i]), (PG8_LAS unsigned*)(lds + (bufoff) + ldsw + _i * 8192), 16, 0, 0); } while (0)
#define PG8_LDA(dst, b, h) do { _Pragma("unroll") for (int m = 0; m < 4; ++m) _Pragma("unroll") for (int k = 0; k < 2; ++k) dst[m][k] = *(const PG8_LAS bf16x8*)(lds + PG8_SA(b, h) + aoff + m * 2048 + k * 1024); } while (0)
#define PG8_LDB(dst, b, h) do { _Pragma("unroll") for (int n = 0; n < 2; ++n) _Pragma("unroll") for (int k = 0; k < 2; ++k) dst[n][k] = *(const PG8_LAS bf16x8*)(lds + PG8_SB(b, h) + boff + n * 2048 + k * 1024); } while (0)
#define PG8_MMA(ai, bj, At, Bt) do { __builtin_amdgcn_s_setprio(1); _Pragma("unroll") for (int m = 0; m < 4; ++m) _Pragma("unroll") for (int n = 0; n < 2; ++n) _Pragma("unroll") for (int k = 0; k < 2; ++k) \
        acc[ai][bj][m][n] = __builtin_amdgcn_mfma_f32_16x16x32_bf16(Bt[n][k], At[m][k], acc[ai][bj][m][n], 0, 0, 0); __builtin_amdgcn_s_setprio(0); } while (0)
#define PG8_WAIT_V(n) asm volatile("s_waitcnt vmcnt(" #n ")" ::: "memory")
#define PG8_WAIT_L(n) asm volatile("s_waitcnt lgkmcnt(" #n ")" ::: "memory")
#define PG8_BAR __builtin_amdgcn_s_barrier()
#define PG8_SCHED __builtin_amdgcn_sched_barrier(0)
    Unit cur, nxt; int ui = 0;
    if (!S.next(0, cur)) return;
    f32x4 acc[2][2][4][2];
#pragma unroll
    for (int a = 0; a < 2; ++a)
#pragma unroll
        for (int b = 0; b < 2; ++b)
#pragma unroll
            for (int m = 0; m < 4; ++m)
#pragma unroll
                for (int n = 0; n < 2; ++n) acc[a][b][m][n] = (f32x4){0.f, 0.f, 0.f, 0.f};
    bf16x8 At[4][2], B0[2][2], B1[2][2];
    const char* cA = (const char*)g.A + (size_t)cur.pm * tstep; const char* cB = (const char*)g.Bt + (size_t)cur.pn * tstep;
    S.a_ready(cur);
    if constexpr (SP2) {
        PG8_STAGE(PG8_SB(0, 0), cB, voffB); PG8_STAGE(PG8_SB(0, 1), cB + hstep, voffB); PG8_STAGE(PG8_SA(0, 0), cA, voffA); PG8_STAGE(PG8_SA(0, 1), cA + hstep, voffA);
        if (wr == 1) PG8_BAR;
        PG8_WAIT_V(2); PG8_BAR;
        PG8_STAGE(PG8_SB(1, 0), cB + kstep, voffB); PG8_STAGE(PG8_SA(1, 0), cA + kstep, voffA); PG8_STAGE(PG8_SB(1, 1), cB + hstep + kstep, voffB);
        PG8_WAIT_V(6); PG8_BAR;
    } else {
        PG8_STAGE(PG8_SB(0, 0), cB, voffB); PG8_STAGE(PG8_SA(0, 0), cA, voffA); PG8_STAGE(PG8_SB(0, 1), cB + hstep, voffB); PG8_STAGE(PG8_SA(0, 1), cA + hstep, voffA);
        if (wr == 1) PG8_BAR;
        PG8_WAIT_V(4); PG8_BAR;
        PG8_STAGE(PG8_SB(1, 0), cB + kstep, voffB); PG8_STAGE(PG8_SA(1, 0), cA + kstep, voffA); PG8_STAGE(PG8_SB(1, 1), cB + hstep + kstep, voffB);
        PG8_WAIT_V(6); PG8_BAR;
    }
    for (;;) {
        const bool has_next = S.next(ui + 1, nxt);
        const char* nA = has_next ? (const char*)g.A + (size_t)nxt.pm * tstep : cA; const char* nB = has_next ? (const char*)g.Bt + (size_t)nxt.pn * tstep : cB;
        for (int t = 0; t < nt; t += 2) {
            const bool last = (t == nt - 2);
            if constexpr (Epi::MIDK) { if (t == (nt >> 1)) E.mid(acc, cur, ui, wr, wc, fr, fq); }
            const char* a1 = cA + (size_t)(t + 1) * kstep;
            const char* a2 = last ? nA : cA + (size_t)(t + 2) * kstep; const char* b2 = last ? nB : cB + (size_t)(t + 2) * kstep;
            const char* a3 = a2 + kstep; const char* b3 = b2 + kstep;
            if (last && has_next) S.a_ready(nxt);
            if constexpr (SP2) {
            PG8_LDB(B0, 0, 0); PG8_LDB(B1, 0, 1); PG8_SCHED; PG8_LDA(At, 0, 0); PG8_STAGE(PG8_SA(1, 1), a1 + hstep, voffA);
            PG8_WAIT_V(8); PG8_WAIT_L(0); PG8_BAR; PG8_MMA(0, 0, At, B0); PG8_MMA(0, 1, At, B1); PG8_BAR; PG8_SCHED;
            PG8_LDA(At, 0, 1); PG8_STAGE(PG8_SB(0, 0), b2, voffB); PG8_STAGE(PG8_SB(0, 1), b2 + hstep, voffB); PG8_STAGE(PG8_SA(0, 0), a2, voffA);
            PG8_WAIT_V(8); PG8_WAIT_L(0); PG8_BAR; PG8_MMA(1, 0, At, B0); PG8_MMA(1, 1, At, B1); PG8_BAR; PG8_SCHED;
            PG8_LDB(B0, 1, 0); PG8_LDB(B1, 1, 1); PG8_SCHED; PG8_LDA(At, 1, 0); PG8_STAGE(PG8_SA(0, 1), a2 + hstep, voffA);
            PG8_WAIT_V(8); PG8_WAIT_L(0); PG8_BAR; PG8_MMA(0, 0, At, B0); PG8_MMA(0, 1, At, B1); PG8_BAR; PG8_SCHED;
            PG8_LDA(At, 1, 1); PG8_STAGE(PG8_SB(1, 0), b3, voffB); PG8_STAGE(PG8_SB(1, 1), b3 + hstep, voffB); PG8_STAGE(PG8_SA(1, 0), a3, voffA);
            PG8_WAIT_V(8); PG8_WAIT_L(0); PG8_BAR; PG8_MMA(1, 0, At, B0); PG8_MMA(1, 1, At, B1); PG8_BAR; PG8_SCHED;
            } else {
            PG8_LDB(B0, 0, 0); PG8_SCHED; PG8_LDA(At, 0, 0); PG8_STAGE(PG8_SA(1, 1), a1 + hstep, voffA);
            PG8_WAIT_L(8); PG8_BAR; PG8_WAIT_L(0); PG8_MMA(0, 0, At, B0); PG8_BAR; PG8_SCHED;
            PG8_LDB(B1, 0, 1); PG8_STAGE(PG8_SB(0, 0), b2, voffB);
            PG8_BAR; PG8_WAIT_L(0); PG8_MMA(0, 1, At, B1); PG8_BAR;
            PG8_LDA(At, 0, 1); PG8_STAGE(PG8_SA(0, 0), a2, voffA);
            PG8_BAR; PG8_WAIT_L(0); PG8_MMA(1, 0, At, B0); PG8_BAR; PG8_SCHED;
            PG8_STAGE(PG8_SB(0, 1), b2 + hstep, voffB);
            PG8_WAIT_V(6); PG8_BAR; PG8_MMA(1, 1, At, B1); PG8_BAR;
            PG8_LDB(B0, 1, 0); PG8_SCHED; PG8_LDA(At, 1, 0); PG8_STAGE(PG8_SA(0, 1), a2 + hstep, voffA);
            PG8_WAIT_L(8); PG8_BAR; PG8_WAIT_L(0); PG8_MMA(0, 0, At, B0); PG8_BAR; PG8_SCHED;
            PG8_LDB(B1, 1, 1); PG8_STAGE(PG8_SB(1, 0), b3, voffB);
            PG8_BAR; PG8_WAIT_L(0); PG8_MMA(0, 1, At, B1); PG8_BAR;
            PG8_LDA(At, 1, 1); PG8_STAGE(PG8_SA(1, 0), a3, voffA);
            PG8_BAR; PG8_WAIT_L(0); PG8_MMA(1, 0, At, B0); PG8_BAR; PG8_SCHED;
            PG8_STAGE(PG8_SB(1, 1), b3 + hstep, voffB);
            PG8_WAIT_V(6); PG8_BAR; PG8_MMA(1, 1, At, B1); PG8_BAR;
            }
        }
        if constexpr (ALIGN_EPI) { if (wr == 0) PG8_BAR; }
        if constexpr (!Epi::AFTER_DRAIN) { E(acc, cur, wr, wc, fr, fq); S.done(cur); }
        if (!has_next) break;
#pragma unroll
        for (int a = 0; a < 2; ++a)
#pragma unroll
            for (int b = 0; b < 2; ++b)
#pragma unroll
                for (int m = 0; m < 4; ++m)
#pragma unroll
                    for (int n = 0; n < 2; ++n) acc[a][b][m][n] = (f32x4){0.f, 0.f, 0.f, 0.f};
        cur = nxt; cA = nA; cB = nB; ++ui;
        if constexpr (ALIGN_EPI) { if (wr == 1) PG8_BAR; }
    }
    PG8_WAIT_V(0);
    if constexpr (!ALIGN_EPI) { if (wr == 0) PG8_BAR; }
    PG8_BAR;
    if constexpr (Epi::AFTER_DRAIN) { E.fused(acc, cur, wr, wc, fr, fq, lds, wid, lane); S.done(cur); }
#undef PG8_SA
#undef PG8_SB
#undef PG8_STAGE
#undef PG8_LDA
#undef PG8_LDB
#undef PG8_MMA
#undef PG8_WAIT_V
#undef PG8_WAIT_L
#undef PG8_BAR
#undef PG8_SCHED
}
}
#define GAS __attribute__((address_space(1)))
#define LAS __attribute__((address_space(3)))
typedef unsigned v4u __attribute__((ext_vector_type(4)));
typedef float f32x4 __attribute__((ext_vector_type(4)));
typedef short bf16x8 __attribute__((ext_vector_type(8)));
typedef GAS unsigned gu32;
typedef GAS unsigned long long gu64;
#define RLX_AGENT __ATOMIC_RELAXED, __HIP_MEMORY_SCOPE_AGENT
#define LDS_WAIT() asm volatile("s_waitcnt lgkmcnt(0)" ::: "memory")
#define VM_WAIT() asm volatile("s_waitcnt vmcnt(0)" ::: "memory")
__device__ __forceinline__ unsigned long long rt() { return __builtin_amdgcn_s_memrealtime(); }

#define XB_TMO      128
#define XB_XCNT(j)  (256  + 64 * (j))
#define XB_XSUB(j)  (1280 + 64 * (j))
#define XB_XGEN(j)  (2304 + 64 * (j))
#define XB_TOP      3328
#define XB_TOPGEN   3392
#define XCD_BAR_WORDS 3456
#define XB_SPIN_CAP (1u << 18)

__device__ __forceinline__ unsigned xb_ld(unsigned* p)              { return __hip_atomic_load(p, __ATOMIC_RELAXED, __HIP_MEMORY_SCOPE_AGENT); }
__device__ __forceinline__ unsigned xb_add(unsigned* p, unsigned v) { return __hip_atomic_fetch_add(p, v, __ATOMIC_RELAXED, __HIP_MEMORY_SCOPE_AGENT); }
__device__ __forceinline__ unsigned xb_xcc_id() { return (unsigned)__builtin_amdgcn_s_getreg((3 << 11) | 20) & 0xFu; }
#define XB_SPIN(cond, bar) do { unsigned _sp = 0; while (cond) { __builtin_amdgcn_s_sleep(1); \
    if ((++_sp & 255u) == 0u) { if (xb_ld(&(bar)[XB_TMO])) break; if (_sp > XB_SPIN_CAP) { atomicAdd(&(bar)[XB_TMO], 1u); break; } } } } while (0)

struct XcdBarrier {
    unsigned* bar; unsigned x;
    volatile LAS unsigned* st;
};

__device__ __forceinline__ XcdBarrier xcd_barrier_post(unsigned* bar, volatile LAS unsigned* st) {
    XcdBarrier b; b.bar = bar; b.x = xb_xcc_id(); b.st = st;
    if (threadIdx.x == 0) (void)xb_add(&bar[XB_XCNT(b.x)], 1u);
    return b;
}
__device__ __forceinline__ void xcd_barrier_complete(unsigned* bar, unsigned x, unsigned& nloc, unsigned& nx) {
    const unsigned G = gridDim.x * gridDim.y * gridDim.z;
    unsigned sum, cnt, mine, sp = 0u;
    for (;;) {
        sum = 0u; cnt = 0u; mine = 0u;
#pragma unroll
        for (unsigned j = 0; j < 16; ++j) { const unsigned c = xb_ld(&bar[XB_XCNT(j)]); sum += c; cnt += (c > 0u) ? 1u : 0u; mine = (j == x) ? c : mine; }
        if (sum == G) break;
        __builtin_amdgcn_s_sleep(1);
        if ((++sp & 255u) == 0u) { if (xb_ld(&bar[XB_TMO])) break; if (sp > XB_SPIN_CAP) { atomicAdd(&bar[XB_TMO], 1u); break; } }
    }
    nloc = mine > 0u ? mine : 1u; nx = cnt > 0u ? cnt : 1u;
}

__device__ __forceinline__ void xcd_barrier(const XcdBarrier& b) {
    asm volatile("s_waitcnt vmcnt(0)" ::: "memory");
    __syncthreads();
    if (threadIdx.x == 0) {
        unsigned* bar = b.bar;
        __builtin_amdgcn_s_waitcnt(0);
        unsigned nloc = b.st[0], nx = b.st[1];
        if (nloc == 0u) { xcd_barrier_complete(bar, b.x, nloc, nx); b.st[0] = nloc; b.st[1] = nx; }
        const unsigned old = xb_add(&bar[XB_XSUB(b.x)], 1u);
        const unsigned gen = old / nloc;
        if (old + 1u == (gen + 1u) * nloc) {
            __builtin_amdgcn_fence(__ATOMIC_RELEASE, "agent");
            asm volatile("s_waitcnt vmcnt(0)" ::: "memory");
            const unsigned og = xb_add(&bar[XB_TOP], 1u);
            const unsigned tg = og / nx;
            if (og + 1u == (tg + 1u) * nx) xb_add(&bar[XB_TOPGEN], 1u);
            else XB_SPIN(xb_ld(&bar[XB_TOPGEN]) == tg, bar);
            __builtin_amdgcn_fence(__ATOMIC_ACQUIRE, "agent");
            xb_add(&bar[XB_XGEN(b.x)], 1u);
            asm volatile("s_waitcnt vmcnt(0)" ::: "memory");
        } else {
            XB_SPIN(xb_ld(&bar[XB_XGEN(b.x)]) == gen, bar);
            __builtin_amdgcn_fence(__ATOMIC_ACQUIRE, "agent");
            asm volatile("s_waitcnt vmcnt(0)" ::: "memory");
        }
    }
    __syncthreads();
}

constexpr int NWAVES = 8;
constexpr int RING_OFF = 0, RING_BYTES = 131072;
constexpr int LDS_BYTES = 163840;
constexpr int LDSCTL_OFF = LDS_BYTES - 512, MISC_OFF = LDSCTL_OFF + 320;
constexpr int CW_BAR = 4096;
constexpr int CW_Q = 16384;
static_assert((CW_BAR + XCD_BAR_WORDS) <= CW_Q && (CW_Q + 64 * 64) * 4 <= (int)CTL_ZERO_BYTES, "CTL words inside the memset region");

constexpr int PROBE_ID = 0;
#define PB_BEGIN(id) long long pb_t0_##id = 0; if (PROBE_ID == (id)) pb_t0_##id = clock64();
#define PB_END(id) if (PROBE_ID == (id)) { const long long t1_ = clock64(), dt_ = t1_ - pb_t0_##id; while (clock64() - t1_ < dt_) __builtin_amdgcn_s_sleep(2); }
struct Frame {
    LAS unsigned char* lds;
    volatile LAS unsigned* MISC;
    gu32* ctl;
    int tid, lane, wave, vcu, G;
    Ins I; float* out;
    bf16 *WinT, *WoutT, *XN, *Q, *K, *V, *AU, *XBC, *Gb, *Zb; float *DT, *SSQ, *RAWB;
};

template <class SrcF>
__device__ __forceinline__ void p0_transpose_item(SrcF src, int k0, int n0, bf16* WT, int dst_pitch, int dst_row0, int dst_k0, LAS float* scr, int lane) {
#pragma unroll 8
    for (int i = 0; i < 32; ++i) { const int kk = 2 * i + (lane >> 5); scr[kk * 33 + (lane & 31)] = src(k0 + kk, n0 + (lane & 31)); }
    LDS_WAIT(); asm volatile("" ::: "memory");
    const int c = lane & 7;
#pragma unroll
    for (int j = 0; j < 4; ++j) { const int n = (lane >> 3) + 8 * j; const LAS float* s = scr + (8 * c) * 33 + n;
        v4u o; o.x = pk2(s[0 * 33], s[1 * 33]); o.y = pk2(s[2 * 33], s[3 * 33]); o.z = pk2(s[4 * 33], s[5 * 33]); o.w = pk2(s[6 * 33], s[7 * 33]);
        *(GAS v4u*)(WT + (size_t)(dst_row0 + n) * dst_pitch + dst_k0 + 8 * c) = o; }
    LDS_WAIT(); asm volatile("" ::: "memory");
}
constexpr int P0_SCR_BYTES = 8448, WDT_OFF = NWAVES * P0_SCR_BYTES, WDT_PITCH = 20;
static_assert(WDT_OFF + 1024 * WDT_PITCH * 4 <= LDSCTL_OFF, "prologue LDS");

__device__ __forceinline__ void p0_prologue(Frame& F) {
    const Ins& I = F.I;
    LAS float* scr = (LAS float*)(F.lds + F.wave * P0_SCR_BYTES);
    LAS float* wdt = (LAS float*)(F.lds + WDT_OFF);
    const int gw = F.vcu * NWAVES + F.wave, NGW = F.G * NWAVES;
    for (int idx = F.tid; idx < 1024 * 16; idx += NWAVES * 64) {
        const int k = idx >> 4, j = idx & 15, pos = (((k >> 8) * 4 + (k & 3)) << 6) + ((k >> 2) & 63);
        wdt[pos * WDT_PITCH + j] = I.w_in[(size_t)k * NPROJ + C_DT + j] * I.norm_w[k];
    }
    constexpr int I_IN = (DM / 64) * (NMAIN / 32), I_OUT = (2048 / 64) * (DM / 32);
    for (int it = gw; it < I_IN + I_OUT; it += NGW) {
        if (it < I_IN) {
            const int nblk = NMAIN / 32, kb = it / nblk, nb = it % nblk, k0 = 64 * kb, n0 = 32 * nb;
            p0_transpose_item([&](int k, int n) { return I.w_in[(size_t)k * NPROJ + n] * I.norm_w[k]; }, k0, n0, F.WinT, DM, (n0 & ~255) + vrow_of_col(n0 & 255), k0, scr, F.lane);
        } else {
            const int r = it - I_IN, nblk = DM / 32, kb = r / nblk, nb = r % nblk, k0 = 64 * kb, n0 = 32 * nb;
            p0_transpose_item([&](int k, int n) { return I.w_out[(size_t)k * DM + n] * (k >= 1024 ? I.ssd_norm_w[k - 1024] : 1.f); }, k0, n0, F.WoutT, 2048, (n0 & ~255) + vrow_of_col(n0 & 255), (k0 + 1024) & 2047, scr, F.lane);
        }
    }
    __syncthreads();
    for (int rp = gw; rp < NROWS / 2; rp += NGW) {
        f32x4 v[2][4]; float rstd[2];
#pragma unroll
        for (int q = 0; q < 2; ++q) {
            const GAS f32x4* xr = (const GAS f32x4*)xrow(I, 2 * rp + q) + F.lane; float s = 0.f;
#pragma unroll
            for (int j = 0; j < 4; ++j) { v[q][j] = xr[64 * j]; s += (v[q][j].x * v[q][j].x + v[q][j].y * v[q][j].y) + (v[q][j].z * v[q][j].z + v[q][j].w * v[q][j].w); }
            rstd[q] = rsqrtf(wave_sum(s) * (1.f / DM) + EPS);
            GAS unsigned long long* o8 = (GAS unsigned long long*)(F.XN + (size_t)(2 * rp + q) * DM) + F.lane;
#pragma unroll
            for (int j = 0; j < 4; ++j) o8[64 * j] = (unsigned long long)pk2(v[q][j].x * rstd[q], v[q][j].y * rstd[q]) | ((unsigned long long)pk2(v[q][j].z * rstd[q], v[q][j].w * rstd[q]) << 32);
        }
        float a[32];
#pragma unroll
        for (int i = 0; i < 32; ++i) a[i] = 0.f;
#pragma unroll
        for (int j = 0; j < 4; ++j)
#pragma unroll
            for (int e = 0; e < 4; ++e) {
                const LAS f32x4* wp = (const LAS f32x4*)(wdt + ((j * 4 + e) * 64 + F.lane) * WDT_PITCH);
                const float x0 = v[0][j][e], x1 = v[1][j][e];
#pragma unroll
                for (int c4 = 0; c4 < 4; ++c4) { const f32x4 w = wp[c4];
#pragma unroll
                    for (int i = 0; i < 4; ++i) { a[c4 * 4 + i] += x0 * w[i]; a[16 + c4 * 4 + i] += x1 * w[i]; } }
                asm volatile("" ::: "memory");
            }
#define P0_HALVE(N, X) { const bool up = (F.lane & (X)) != 0; _Pragma("unroll") for (int i = 0; i < (N); ++i) { const float keep = up ? a[i + (N)] : a[i], send = up ? a[i] : a[i + (N)]; a[i] = keep + __shfl_xor(send, (X)); } }
        P0_HALVE(16, 32) P0_HALVE(8, 16) P0_HALVE(4, 8) P0_HALVE(2, 4) P0_HALVE(1, 2)
#undef P0_HALVE
        float tot = a[0] + __shfl_xor(a[0], 1);
        const int idx = F.lane >> 1, q = idx >> 4, c = idx & 15;
        tot = tot * (q ? rstd[1] : rstd[0]) + I.dt_bias[c];
        if ((F.lane & 1) == 0) F.DT[(size_t)c * MROWS + 2 * rp + q] = softplus_f(tot);
    }
    { v4u* zk = (v4u*)((unsigned char*)F.K - 4 * MiB); v4u* zv = (v4u*)((unsigned char*)F.V - 4 * MiB);
      for (size_t i = (size_t)F.vcu * NWAVES * 64 + F.tid; i < 4 * MiB / 16; i += (size_t)F.G * NWAVES * 64) {
          if (i * 16 >= 4 * MiB - (WS_K - (WS_Q + (size_t)MROWS * DM * 2))) zk[i] = (v4u){0u, 0u, 0u, 0u};
          if (i * 16 >= 4 * MiB - (WS_V - (WS_K + (size_t)MROWS * DM * 2))) zv[i] = (v4u){0u, 0u, 0u, 0u}; } }
    for (int r = NROWS + gw; r < MROWS; r += NGW) { GAS v4u* o = (GAS v4u*)(F.XN + (size_t)r * DM) + F.lane; o[0] = (v4u){0u, 0u, 0u, 0u}; o[64] = (v4u){0u, 0u, 0u, 0u};
                                                   GAS v4u* k = (GAS v4u*)(F.K + (size_t)r * DM) + F.lane; k[0] = (v4u){0u, 0u, 0u, 0u}; k[64] = (v4u){0u, 0u, 0u, 0u}; }
    for (int i = (F.vcu * NWAVES * 64 + F.tid); i < DB * 2 * CONVD; i += F.G * NWAVES * 64) {
        const int c = i % CONVD, rr = i / CONVD, j = rr & 1, b = rr >> 1;
        F.out[O_CS + ((size_t)b * 3 + j) * CONVD + c] = I.sconv[((size_t)b * 3 + j + 1) * CONVD + c];
    }
}

namespace att {
typedef float f32x16 __attribute__((ext_vector_type(16)));
typedef short v4i16_t __attribute__((ext_vector_type(4)));
typedef unsigned u32x4 __attribute__((ext_vector_type(4)));
constexpr int SPAN = 512, NSPAN = SEQ / SPAN, NUNITS = NB * NH * NSPAN;
constexpr int OPITCH = 64  , OACC_OFF = 0, LACC_OFF = SPAN * OPITCH * 4, LUT_OFF = LACC_OFF + 2048, LUTP = 192  , VST_OFF = LUT_OFF + 3072, VST_BYTES = 2048  , ATT_LDS_END = VST_OFF + NWAVES * VST_BYTES;
static_assert(ATT_LDS_END <= LDSCTL_OFF, "attention LDS");
__device__ __forceinline__ int crow(int r, int hi) { return (r & 3) + 8 * (r >> 2) + 4 * hi; }

struct ItemRegs { bf16x8 qf[4]; v4u kreg[4], vreg[4]; unsigned koff, voff; };
__device__ __forceinline__ int first_tile(int tq0, int d) { const int k = (97 * d - tq0 + 32 * d - 1) / (32 * d); return k < 0 ? 0 : (k > 4 ? 4 : k); }
struct ItemOut { f32x16 o0, o1; float lsum; };
#define ATT_LOAD_K(R, KT) do { const char* kb_ = (const char*)Kb + ((long)(tq0 + (-128 + 32 * (KT)) * d) * DM) * 2; \
        _Pragma("unroll") for (int i = 0; i < 4; ++i) (R).kreg[i] = *(const v4u*)(kb_ + (R).koff + (unsigned)((i & 1) * 16 * d * DM * 2) + 64 * (i >> 1)); } while (0)
#define ATT_LOAD_V(R, KT) do { const char* vb_ = (const char*)Vb + ((long)(tq0 + (-128 + 32 * (KT)) * d) * DM) * 2; \
        _Pragma("unroll") for (int i = 0; i < 4; ++i) (R).vreg[i] = *(const v4u*)(vb_ + (R).voff + (unsigned)(i * 8 * d * DM * 2)); } while (0)
template <int NQ>
__device__ __forceinline__ void item_load(ItemRegs& R, const bf16* Qb, const bf16* Kb, const bf16* Vb, int tq0, int d, int lane) {
    const int c = lane & 31, hi = lane >> 5;
    const bf16* qp = Qb + (size_t)(tq0 + (NQ == 32 ? c : (c & 15)) * d) * DM + 8 * hi;
#pragma unroll
    for (int ks = 0; ks < 4; ++ks) R.qf[ks] = *(const bf16x8*)(qp + 16 * ks);
    R.koff = (unsigned)(((lane >> 2) * d * DM + 8 * (lane & 3)) * 2); R.voff = (unsigned)(((lane >> 3) * d * DM + 8 * (lane & 7)) * 2);
    { const int kt0 = 97 * d - tq0 > 0 ? first_tile(tq0, d) : 0; ATT_LOAD_K(R, kt0); ATT_LOAD_V(R, kt0); }
}
template <int NQ>
__device__ __forceinline__ void item_tiles(ItemRegs& R, ItemOut& O, const bf16* Kb, const bf16* Vb, int tq0, int d, int pat, LAS unsigned char* lds, int wave, int lane) {
    const int c = lane & 31, hi = lane >> 5;
    LAS unsigned char* vst = lds + VST_OFF + wave * VST_BYTES;
    const LAS float* lut = (const LAS float*)(lds + LUT_OFF) + pat * LUTP + 31;
    f32x16 o0 = {}, o1 = {};
    float lsum = 0.f;
    const int lrow = lane >> 3, lch = lane & 7;
    const int stoff = lrow * 128 + ((lch ^ lrow) << 4);
    const int kwoff = (lane >> 2) * 64 + (((lane & 3) ^ ((lane >> 4) & 3)) << 4);
    const int q4 = (lane & 15) >> 2, odd = (lane >> 4) & 1, p4 = lane & 3;
#pragma unroll 1
    for (int kt = (97 * d - tq0 > 0 ? first_tile(tq0, d) : 0); kt < 5; ++kt) {
        bf16x8 kf[4];
#pragma unroll
        for (int h2 = 0; h2 < 2; ++h2) {
#pragma unroll
            for (int i = 0; i < 2; ++i) *(LAS v4u*)(vst + i * 1024 + kwoff) = R.kreg[2 * h2 + i];
#pragma unroll
            for (int ksl = 0; ksl < 2; ++ksl) kf[2 * h2 + ksl] = *(const LAS bf16x8*)(vst + c * 64 + (((2 * ksl + hi) ^ ((c >> 2) & 3)) << 4));
        }
        bf16x8 vb[2][2];
#pragma unroll
        for (int s = 0; s < 2; ++s) {
#pragma unroll
            for (int i = 0; i < 2; ++i) *(LAS v4u*)(vst + i * 1024 + stoff) = R.vreg[2 * s + i];
#pragma unroll
            for (int dh = 0; dh < 2; ++dh) {
                const int kr = 4 * hi + q4, ch16 = 4 * dh + 2 * odd + (p4 >> 1);
                const LAS unsigned char* vp0 = vst + kr * 128 + ((ch16 ^ (kr & 7)) << 4) + (p4 & 1) * 8;
                const LAS unsigned char* vp1 = vst + (kr + 8) * 128 + ((ch16 ^ (kr & 7)) << 4) + (p4 & 1) * 8;
                const v4i16_t lo = __builtin_amdgcn_ds_read_tr16_b64_v4i16((LAS v4i16_t*)vp0), hh = __builtin_amdgcn_ds_read_tr16_b64_v4i16((LAS v4i16_t*)vp1);
                vb[s][dh] = (bf16x8){lo[0], lo[1], lo[2], lo[3], hh[0], hh[1], hh[2], hh[3]};
            }
        }
        asm volatile("" ::: "memory");
        if (kt < 4) { ATT_LOAD_K(R, kt + 1); ATT_LOAD_V(R, kt + 1); }
        const int relb = c + 128 - 32 * kt - 4 * hi, tkb = tq0 + (-128 + 32 * kt + 4 * hi) * d;
        const bool edge = tq0 + (-128 + 32 * kt) * d < 0;
        f32x16 st;
        if (edge) {
#pragma unroll
            for (int r = 0; r < 16; ++r) { const int rel = relb - ((r & 3) + 8 * (r >> 2)); st[r] = lut[rel < 0 ? 0 : (rel > 128 ? 128 : rel)]; }
        } else {
#pragma unroll
            for (int r = 0; r < 16; ++r) st[r] = lut[relb - ((r & 3) + 8 * (r >> 2))];
        }
#pragma unroll
        for (int ks = 0; ks < 4; ++ks) st = __builtin_amdgcn_mfma_f32_32x32x16_bf16(kf[ks], R.qf[ks], st, 0, 0, 0);
        if (edge) {
#pragma unroll
            for (int r = 0; r < 16; ++r) {
                const int kk = (r & 3) + 8 * (r >> 2), rel = relb - kk;
                const bool valid = (rel >= 0) && (rel <= 128) && (tkb + kk * d >= 0);
                const float pe = __builtin_amdgcn_exp2f(st[r]), p = valid ? pe : 0.f;
                st[r] = p; lsum += p;
            }
        } else {
#pragma unroll
            for (int r = 0; r < 16; ++r) { const float p = __builtin_amdgcn_exp2f(st[r]); st[r] = p; lsum += p; }
        }
        u32x4 pw0, pw1;
        pw0.x = cvtpk_s(st[0], st[1]); pw0.y = cvtpk_s(st[2], st[3]); pw0.z = cvtpk_s(st[4], st[5]); pw0.w = cvtpk_s(st[6], st[7]);
        pw1.x = cvtpk_s(st[8], st[9]); pw1.y = cvtpk_s(st[10], st[11]); pw1.z = cvtpk_s(st[12], st[13]); pw1.w = cvtpk_s(st[14], st[15]);
        const bf16x8 pa0 = __builtin_bit_cast(bf16x8, pw0), pa1 = __builtin_bit_cast(bf16x8, pw1);
        o0 = __builtin_amdgcn_mfma_f32_32x32x16_bf16(pa0, vb[0][0], o0, 0, 0, 0);
        o1 = __builtin_amdgcn_mfma_f32_32x32x16_bf16(pa0, vb[0][1], o1, 0, 0, 0);
        o0 = __builtin_amdgcn_mfma_f32_32x32x16_bf16(pa1, vb[1][0], o0, 0, 0, 0);
        o1 = __builtin_amdgcn_mfma_f32_32x32x16_bf16(pa1, vb[1][1], o1, 0, 0, 0);
    }
    lsum += __shfl_xor(lsum, 32);
    O.o0 = o0; O.o1 = o1; O.lsum = lsum;
}
template <int NQ, bool ACC>
__device__ __forceinline__ void item_acc(const ItemOut& O, int toff, int d, LAS unsigned char* lds, int lane) {
    const int c = lane & 31, hi = lane >> 5;
    LAS float* oacc = (LAS float*)(lds + OACC_OFF); LAS float* lacc = (LAS float*)(lds + LACC_OFF);
    constexpr int NR = NQ == 32 ? 16 : 8;
    LAS float* base = oacc + (toff + 4 * hi * d) * OPITCH + c;
    float a0[NR], a1[NR], lo = 0.f;
    if (ACC) {
#pragma unroll
        for (int r = 0; r < NR; ++r) { const LAS float* row = base + ((r & 3) + 8 * (r >> 2)) * d * OPITCH; a0[r] = row[0]; a1[r] = row[32]; }
        if (hi == 0 && c < NQ) lo = lacc[toff + c * d];
        asm volatile("" ::: "memory");
    }
#pragma unroll
    for (int r = 0; r < NR; ++r) { LAS float* row = base + ((r & 3) + 8 * (r >> 2)) * d * OPITCH; row[0] = ACC ? a0[r] + O.o0[r] : O.o0[r]; row[32] = ACC ? a1[r] + O.o1[r] : O.o1[r]; }
    if (hi == 0 && c < NQ) lacc[toff + c * d] = ACC ? lo + O.lsum : O.lsum;
}

__device__ __forceinline__ void unit(Frame& F, int uidx, int& lut_h) {
    const int span = uidx % NSPAN, bh = uidx / NSPAN, h = bh % NH, b = bh / NH, t0 = span * SPAN;
    LAS unsigned char* lds = F.lds;
    LAS float* oacc = (LAS float*)(lds + OACC_OFF); LAS float* lacc = (LAS float*)(lds + LACC_OFF); LAS float* lut = (LAS float*)(lds + LUT_OFF);
    const bool newlut = h != lut_h; lut_h = h;
    if (newlut) for (int i = F.tid; i < 3 * LUTP; i += NWAVES * 64) { const int pat = i / LUTP, rel = i - pat * LUTP - 31, d = pat == 0 ? 1 : (pat == 1 ? 4 : 16);
        lut[i] = (rel >= 0 && rel <= 128) ? F.I.rel_bias[t5_bucket(rel * d) * NH + h] * LOG2E : -1e30f; }
    const size_t boff = (size_t)b * SEQ * DM + h * HD;
    const bf16 *Qb = F.Q + boff, *Kb = F.K + boff, *Vb = F.V + boff;
    const int w = F.wave, lane = F.lane;
    ItemRegs R; ItemOut O;
    const int tqA0 = t0 + 64 * w, tqA1 = tqA0 + 32, tqB0 = t0 + (w & 3) + 256 * (w >> 2), tqB1 = tqB0 + 128, tqC0 = t0 + w, tqC1 = t0 + w + 8;
    item_load<32>(R, Qb, Kb, Vb, tqA0, 1, lane);
    if (newlut) __syncthreads();
    item_tiles<32>(R, O, Kb, Vb, tqA0, 1, 0, lds, w, lane);
    item_load<32>(R, Qb, Kb, Vb, tqA1, 1, lane);
    item_acc<32, false>(O, tqA0 - t0, 1, lds, lane);
    item_tiles<32>(R, O, Kb, Vb, tqA1, 1, 0, lds, w, lane);
    item_load<32>(R, Qb, Kb, Vb, tqB0, 4, lane);
    item_acc<32, false>(O, tqA1 - t0, 1, lds, lane);
    __syncthreads();
    item_tiles<32>(R, O, Kb, Vb, tqB0, 4, 1, lds, w, lane);
    item_load<32>(R, Qb, Kb, Vb, tqB1, 4, lane);
    item_acc<32, true>(O, tqB0 - t0, 4, lds, lane);
    item_tiles<32>(R, O, Kb, Vb, tqB1, 4, 1, lds, w, lane);
    item_load<32>(R, Qb, Kb, Vb, tqC0, 16, lane);
    item_acc<32, true>(O, tqB1 - t0, 4, lds, lane);
    __syncthreads();
    item_tiles<32>(R, O, Kb, Vb, tqC0, 16, 2, lds, w, lane);
    item_load<32>(R, Qb, Kb, Vb, tqC1, 16, lane);
    item_acc<32, true>(O, tqC0 - t0, 16, lds, lane);
    item_tiles<32>(R, O, Kb, Vb, tqC1, 16, 2, lds, w, lane);
    item_acc<32, true>(O, tqC1 - t0, 16, lds, lane);
    v4u g[2][4];
#pragma unroll
    for (int ps = 0; ps < 2; ++ps) { const bf16* gp = F.Gb + ((size_t)b * SEQ + t0 + 64 * w + 32 * ps + (lane >> 1)) * DM + h * HD + 32 * (lane & 1);
#pragma unroll
        for (int j4 = 0; j4 < 4; ++j4) g[ps][j4] = *(const v4u*)(gp + 8 * j4); }
    __syncthreads();
#pragma unroll
    for (int ps = 0; ps < 2; ++ps) {
        const int tl = 64 * w + 32 * ps + (lane >> 1), hf = lane & 1;
        bf16* ap = F.AU + ((size_t)b * SEQ + t0 + tl) * 2048 + 1024 + h * HD + 32 * hf;
        const float rl = __builtin_amdgcn_rcpf(lacc[tl]);
        const LAS f32x4* op = (const LAS f32x4*)(oacc + tl * OPITCH + 32 * hf);
#pragma unroll
        for (int j4 = 0; j4 < 4; ++j4) {
            const f32x4 a = op[2 * j4], bq = op[2 * j4 + 1]; const v4u gg = g[ps][j4];
            v4u o;
            o.x = cvtpk_s(a[0] * rl * __uint_as_float(gg.x << 16), a[1] * rl * __uint_as_float(gg.x & 0xffff0000u));
            o.y = cvtpk_s(a[2] * rl * __uint_as_float(gg.y << 16), a[3] * rl * __uint_as_float(gg.y & 0xffff0000u));
            o.z = cvtpk_s(bq[0] * rl * __uint_as_float(gg.z << 16), bq[1] * rl * __uint_as_float(gg.z & 0xffff0000u));
            o.w = cvtpk_s(bq[2] * rl * __uint_as_float(gg.w << 16), bq[3] * rl * __uint_as_float(gg.w & 0xffff0000u));
            *(v4u*)(ap + 8 * j4) = o;
        }
    }
    __syncthreads();
}

}

namespace ssd {
typedef float f32x16 __attribute__((ext_vector_type(16)));
typedef short v4i16_t __attribute__((ext_vector_type(4)));
typedef unsigned u32x2 __attribute__((ext_vector_type(2)));
typedef float f32x2v __attribute__((ext_vector_type(2)));
constexpr int PITCH = 272;
constexpr int BT_OFF = 0, CT_OFF = 34816, G_OFF = 69632, HB_OFF = 104448, XD_OFF = 121856, XH_OFF = 138240, ACS_OFF = 154624, DTL_OFF = ACS_OFF + 512, SSQL_OFF = DTL_OFF + 512  , XW_OFF = SSQL_OFF + 1024  , FW_OFF = XW_OFF + 1280  , SSD_LDS_END = FW_OFF + 5120;
static_assert(SSD_LDS_END <= LDSCTL_OFF, "SSD LDS");
__device__ __forceinline__ int crow(int r, int hi) { return (r & 3) + 8 * (r >> 2) + 4 * hi; }
__device__ __forceinline__ bf16x8 trfrag(const LAS unsigned char* p0, const LAS unsigned char* p1) {
    const v4i16_t lo = __builtin_amdgcn_ds_read_tr16_b64_v4i16((LAS v4i16_t*)p0), hh = __builtin_amdgcn_ds_read_tr16_b64_v4i16((LAS v4i16_t*)p1);
    return (bf16x8){lo[0], lo[1], lo[2], lo[3], hh[0], hh[1], hh[2], hh[3]};
}
__device__ __forceinline__ float bflo(unsigned w) { return __uint_as_float(w << 16); }
__device__ __forceinline__ float bfhi(unsigned w) { return __uint_as_float(w & 0xffff0000u); }

constexpr int NSEG = 2;
__device__ __forceinline__ int seg_begin(int s) { return NSEG == 2 ? (s == 0 ? 0 : (s == 1 ? 32 : 64)) : (s == 0 ? 0 : (s == 1 ? 20 : (s == 2 ? 42 : 64))); }
__device__ __forceinline__ void chain(Frame& F, int item) {
    const Ins& I = F.I;
    const int bg = item / (8 * NSEG), li = item % (8 * NSEG), b = bg >> 1, hd = (bg & 1) * 8 + li / NSEG, seg = li % NSEG, grp = hd >> 3;
    constexpr int NCH = SEQ / 128; const int ch_begin = seg_begin(seg), ch_end = seg_begin(seg + 1);
    const int tid = F.tid, lane = F.lane, w = F.wave, c = lane & 31, hi = lane >> 5;
    LAS unsigned char* lds = F.lds;
    LAS float* acs = (LAS float*)(lds + ACS_OFF); LAS float* dtl = (LAS float*)(lds + DTL_OFF); LAS float* ssql = (LAS float*)(lds + SSQL_OFF);
    const float A = -__expf(I.a_log[hd]), dsk = I.d_skip[hd];
    const size_t row0 = (size_t)b * SEQ;
    for (int i = tid; i < 17408 / 16; i += NWAVES * 64) ((LAS v4u*)(lds + HB_OFF))[i] = (v4u){0u, 0u, 0u, 0u};
    f32x16 hacc = {};
    const int pt = w & 1, jt = w >> 1;
    const int q4 = (lane & 15) >> 2, odd = (lane >> 4) & 1, p4 = lane & 3;
    const int xtr = (8 * hi + q4) * 64 + (16 * odd + 4 * p4) * 2;
    const int xg = tid & 15, xr0 = (tid >> 4) * 4;
    const int fb = tid >> 8, fc = tid & 255;
    for (int i = tid; i < 5 * 64 + 5 * 256; i += NWAVES * 64) {
        if (i < 320) { const int t = i >> 6, e = i & 63; ((LAS float*)(lds + XW_OFF))[i] = t < 4 ? I.conv_w[t * CONVD + hd * 64 + e] : I.conv_b[hd * 64 + e]; }
        else { const int k = i - 320, t = k >> 8, e = k & 255, chn = 1024 + (e < 128 ? grp * 128 + e : 256 + grp * 128 + (e - 128)); ((LAS float*)(lds + FW_OFF))[k] = t < 4 ? I.conv_w[t * CONVD + chn] : I.conv_b[chn]; }
    }
    const int xoff = ((xg >> 3) << 10) + (xg & 7) * 8;
    float dtp0, dtp1; u32x2 xr[7]; v4u bcr[8]; float fxr[6]; u32x2 zr[4];
#define SSD_PREFETCH(T0) do { int t0_ = (T0), tv_ = tid, lv_ = lane; asm volatile("" : "+v"(t0_), "+v"(tv_), "+v"(lv_)); \
        const int xg_ = tv_ & 15, xr0_ = (tv_ >> 4) * 4, fb_ = tv_ >> 8, fc_ = tv_ & 255, fch_ = fc_ < 128 ? grp * 128 + fc_ : 256 + grp * 128 + (fc_ - 128); \
        { const float* dp_ = F.DT + (size_t)hd * MROWS + row0 + t0_ + 2 * lv_; dtp0 = dp_[0]; dtp1 = dp_[1]; } \
        { const bf16* xp_ = F.XBC + (row0 + t0_ + xr0_) * CONVD + hd * 64 + 4 * xg_; \
          _Pragma("unroll") for (int j = 0; j < 7; ++j) xr[j] = (t0_ + xr0_ - 3 + j) >= 0 ? *(const u32x2*)(xp_ + (j - 3) * CONVD) : (u32x2){0u, 0u}; } \
        { const bf16* bp_ = F.XBC + (row0 + t0_ + (tv_ >> 4)) * CONVD + 1024 + grp * 128 + 8 * (tv_ & 15); \
          _Pragma("unroll") for (int k = 0; k < 4; ++k) { bcr[k] = *(const v4u*)(bp_ + (size_t)k * 32 * CONVD); bcr[4 + k] = *(const v4u*)(bp_ + (size_t)k * 32 * CONVD + 256); } } \
        { const size_t blk = (row0 + t0_ + 64 * fb_) >> 6; const bool hasprev = (t0_ + 64 * fb_) > 0; const float* rp_ = F.RAWB + (blk * 6) * 512 + fch_; \
          _Pragma("unroll") for (int j = 0; j < 3; ++j) { fxr[j] = hasprev ? rp_[(j - 6) * 512] : 0.f; fxr[3 + j] = rp_[(3 + j) * 512]; } } \
    } while (0)
#define SSD_PREFETCH_Z(T0) do { int t0_ = (T0), lv_ = lane; asm volatile("" : "+v"(t0_), "+v"(lv_)); \
        const bf16* zp_ = F.Zb + (row0 + t0_ + 32 * jt + (lv_ & 31)) * DM + hd * 64 + 32 * pt + 4 * (lv_ >> 5); \
        _Pragma("unroll") for (int g4 = 0; g4 < 4; ++g4) zr[g4] = *(const u32x2*)(zp_ + 8 * g4); } while (0)
    __syncthreads();
    if (ch_begin > 0) {
        float dq[4]; u32x2 xr2[11]; v4u bcr2[8]; float fxr2[6];
        LAS float* det = (LAS float*)(lds + ACS_OFF);
#define SSD_PRE2_PREFETCH(T0) do { int t0_ = (T0), tv_ = tid, lv_ = lane; asm volatile("" : "+v"(t0_), "+v"(tv_), "+v"(lv_)); \
        const int xg_ = tv_ & 15, xr0_ = (tv_ >> 4) * 8, fb_ = tv_ >> 7, fch_ = grp * 128 + (tv_ & 127); \
        { const float* dp_ = F.DT + (size_t)hd * MROWS + row0 + t0_ + 2 * lv_; dq[0] = dp_[0]; dq[1] = dp_[1]; dq[2] = dp_[128]; dq[3] = dp_[129]; } \
        { const bf16* xp_ = F.XBC + (row0 + t0_ + xr0_) * CONVD + hd * 64 + 4 * xg_; \
          _Pragma("unroll") for (int j = 0; j < 11; ++j) xr2[j] = (t0_ + xr0_ - 3 + j) >= 0 ? *(const u32x2*)(xp_ + (j - 3) * CONVD) : (u32x2){0u, 0u}; } \
        { const bf16* bp_ = F.XBC + (row0 + t0_ + (tv_ >> 4)) * CONVD + 1024 + grp * 128 + 8 * (tv_ & 15); \
          _Pragma("unroll") for (int k = 0; k < 8; ++k) bcr2[k] = *(const v4u*)(bp_ + (size_t)k * 32 * CONVD); } \
        { const size_t blk = (row0 + t0_ + 64 * fb_) >> 6; const bool hasprev = (t0_ + 64 * fb_) > 0; const float* rp_ = F.RAWB + (blk * 6) * 512 + fch_; \
          _Pragma("unroll") for (int j = 0; j < 3; ++j) { fxr2[j] = hasprev ? rp_[(j - 6) * 512] : 0.f; fxr2[3 + j] = rp_[(3 + j) * 512]; } } \
    } while (0)
        SSD_PRE2_PREFETCH(0);
#pragma unroll 1
        for (int cp = 0; cp < ch_begin / 2; ++cp) {
            const int t0 = cp * 256;
            float atot;
            {
                const float v0 = dq[0] * A, v1 = dq[1] * A, v2 = dq[2] * A, v3 = dq[3] * A; float s1 = v0 + v1, s2 = v2 + v3;
#define SSD_DPP_ADD2(S, CTRL, RMASK, BC) S += __builtin_bit_cast(float, __builtin_amdgcn_update_dpp(0, __builtin_bit_cast(int, S), CTRL, RMASK, 0xf, BC))
                SSD_DPP_ADD2(s1, 0x111, 0xf, true); SSD_DPP_ADD2(s1, 0x112, 0xf, true); SSD_DPP_ADD2(s1, 0x114, 0xf, true); SSD_DPP_ADD2(s1, 0x118, 0xf, true); SSD_DPP_ADD2(s1, 0x142, 0xa, false); SSD_DPP_ADD2(s1, 0x143, 0xc, false);
                SSD_DPP_ADD2(s2, 0x111, 0xf, true); SSD_DPP_ADD2(s2, 0x112, 0xf, true); SSD_DPP_ADD2(s2, 0x114, 0xf, true); SSD_DPP_ADD2(s2, 0x118, 0xf, true); SSD_DPP_ADD2(s2, 0x142, 0xa, false); SSD_DPP_ADD2(s2, 0x143, 0xc, false);
#undef SSD_DPP_ADD2
                const float tot1 = __builtin_bit_cast(float, __builtin_amdgcn_readlane(__builtin_bit_cast(int, s1), 63));
                const float tot2 = __builtin_bit_cast(float, __builtin_amdgcn_readlane(__builtin_bit_cast(int, s2), 63));
                atot = tot1 + tot2;
                *(LAS f32x2v*)(det + 2 * lane) = (f32x2v){dq[0] * __expf(atot - (s1 - v1)), dq[1] * __expf(atot - s1)};
                *(LAS f32x2v*)(det + 128 + 2 * lane) = (f32x2v){dq[2] * __expf(tot2 - (s2 - v3)), dq[3] * __expf(tot2 - s2)};
            }
#pragma unroll
            for (int k = 0; k < 8; ++k) { const int row = (tid >> 4) + 32 * k; if ((row & 63) >= 3) *(LAS v4u*)(lds + BT_OFF + row * PITCH + 16 * (tid & 15)) = bcr2[k]; }
            {   const int fb2 = tid >> 7, fc2 = tid & 127;
                LAS unsigned char* dst = lds + BT_OFF + 2 * fc2 + 64 * fb2 * PITCH;
                const LAS float* fwp = (const LAS float*)(lds + FW_OFF) + fc2;
                const float fw0 = fwp[0], fw1 = fwp[256], fw2 = fwp[512], fw3 = fwp[768], fbias = fwp[1024];
#pragma unroll
                for (int j = 0; j < 3; ++j) *(LAS bf16*)(dst + j * PITCH) = (bf16)f2bf(silu_fast(fbias + fw0 * fxr2[j] + fw1 * fxr2[j + 1] + fw2 * fxr2[j + 2] + fw3 * fxr2[j + 3]));
            }
            {
                const LAS f32x4* xwp = (const LAS f32x4*)(lds + XW_OFF) + xg;
                const f32x4 xw0 = xwp[0], xw1 = xwp[16], xw2 = xwp[32], xw3 = xwp[48], xb = xwp[64];
                float xv[11][4];
#pragma unroll
                for (int j = 0; j < 11; ++j) { xv[j][0] = bflo(xr2[j].x); xv[j][1] = bfhi(xr2[j].x); xv[j][2] = bflo(xr2[j].y); xv[j][3] = bfhi(xr2[j].y); }
                const int xr8 = (tid >> 4) * 8;
#pragma unroll
                for (int i = 0; i < 8; ++i) {
                    const int s = xr8 + i; const float de = det[s]; float v[4];
#pragma unroll
                    for (int e = 0; e < 4; ++e) v[e] = silu_fast(xb[e] + xw0[e] * xv[i][e] + xw1[e] * xv[i + 1][e] + xw2[e] * xv[i + 2][e] + xw3[e] * xv[i + 3][e]);
                    *(LAS u32x2*)(lds + G_OFF + ((s >> 4) << 11) + xoff + (s & 15) * 64) = (u32x2){cvtpk_s(v[0] * de, v[1] * de), cvtpk_s(v[2] * de, v[3] * de)};
                }
            }
            asm volatile("" ::: "memory"); __builtin_amdgcn_sched_barrier(0);
            if (cp + 1 < ch_begin / 2) SSD_PRE2_PREFETCH(t0 + 256);
            __syncthreads();
            {   const float ea = __expf(atot);
#pragma unroll
                for (int r = 0; r < 16; ++r) hacc[r] *= ea;
                const int btr = (8 * hi + q4) * PITCH + (32 * jt + 16 * odd + 4 * p4) * 2;
#pragma unroll 4
                for (int ks = 0; ks < 16; ++ks) {
                    const LAS unsigned char* xp = lds + G_OFF + ((ks * 2 + pt) << 10) + xtr;
                    const LAS unsigned char* bp = lds + BT_OFF + 16 * ks * PITCH + btr;
                    hacc = __builtin_amdgcn_mfma_f32_32x32x16_bf16(trfrag(xp, xp + 256), trfrag(bp, bp + 4 * PITCH), hacc, 0, 0, 0);
                }
            }
            __syncthreads();
        }
#undef SSD_PRE2_PREFETCH
#pragma unroll
        for (int r = 0; r < 16; ++r) *(LAS bf16*)(lds + HB_OFF + (32 * pt + crow(r, hi)) * PITCH + (32 * jt + c) * 2) = (bf16)f2bf(hacc[r]);
        __syncthreads();
    }
    SSD_PREFETCH(ch_begin * 128); SSD_PREFETCH_Z(ch_begin * 128);
#pragma unroll 1
    for (int ch = ch_begin; ch < ch_end; ++ch) {
        const int t0 = ch * 128;
        const bool pre = false, prevfull = ch > ch_begin;
        float aend;
        {
            if (w < 2 && prevfull) { F.SSQ[(row0 + t0 - 128 + lane) * 32 + 2 * hd + w] = ssql[128 * w + lane]; F.SSQ[(row0 + t0 - 64 + lane) * 32 + 2 * hd + w] = ssql[128 * w + 64 + lane]; }
            const float v0 = dtp0 * A, v1 = dtp1 * A; float s = v0 + v1;
#define SSD_DPP_ADD(CTRL, RMASK, BC) s += __builtin_bit_cast(float, __builtin_amdgcn_update_dpp(0, __builtin_bit_cast(int, s), CTRL, RMASK, 0xf, BC))
            SSD_DPP_ADD(0x111, 0xf, true); SSD_DPP_ADD(0x112, 0xf, true); SSD_DPP_ADD(0x114, 0xf, true); SSD_DPP_ADD(0x118, 0xf, true);
            SSD_DPP_ADD(0x142, 0xa, false); SSD_DPP_ADD(0x143, 0xc, false);
#undef SSD_DPP_ADD
            aend = __builtin_bit_cast(float, __builtin_amdgcn_readlane(__builtin_bit_cast(int, s), 63));
            *(LAS f32x2v*)(acs + 2 * lane) = (f32x2v){s - v1, s}; *(LAS f32x2v*)(dtl + 2 * lane) = (f32x2v){dtp0, dtp1};
        }
#pragma unroll
        for (int k = 0; k < 4; ++k) { const int idx = tid + 512 * k, row = idx >> 4;
            if ((row & 63) >= 3) { *(LAS v4u*)(lds + BT_OFF + row * PITCH + 16 * (idx & 15)) = bcr[k]; if (!pre) *(LAS v4u*)(lds + CT_OFF + row * PITCH + 16 * (idx & 15)) = bcr[4 + k]; } }
        if (!pre || fc < 128) {
            LAS unsigned char* dst = lds + (fc < 128 ? BT_OFF + 2 * fc : CT_OFF + 2 * (fc - 128)) + 64 * fb * PITCH;
            const LAS float* fwp = (const LAS float*)(lds + FW_OFF) + fc;
            const float fw0 = fwp[0], fw1 = fwp[256], fw2 = fwp[512], fw3 = fwp[768], fbias = fwp[1024];
#pragma unroll
            for (int j = 0; j < 3; ++j) *(LAS bf16*)(dst + j * PITCH) = (bf16)f2bf(silu_fast(fbias + fw0 * fxr[j] + fw1 * fxr[j + 1] + fw2 * fxr[j + 2] + fw3 * fxr[j + 3]));
        }
        {
            const LAS f32x4* xwp = (const LAS f32x4*)(lds + XW_OFF) + xg;
            const f32x4 xw0 = xwp[0], xw1 = xwp[16], xw2 = xwp[32], xw3 = xwp[48], xb = xwp[64];
            float xv[7][4];
#pragma unroll
            for (int j = 0; j < 7; ++j) { xv[j][0] = bflo(xr[j].x); xv[j][1] = bfhi(xr[j].x); xv[j][2] = bflo(xr[j].y); xv[j][3] = bfhi(xr[j].y); }
#pragma unroll
            for (int i = 0; i < 4; ++i) {
                const int s = xr0 + i; const float dt = dtl[s], de = dt * __expf(aend - acs[s]); float v[4];
#pragma unroll
                for (int e = 0; e < 4; ++e) v[e] = silu_fast(xb[e] + xw0[e] * xv[i][e] + xw1[e] * xv[i + 1][e] + xw2[e] * xv[i + 2][e] + xw3[e] * xv[i + 3][e]);
                const int off = ((s >> 4) << 11) + xoff + (s & 15) * 64;
                if (!pre) *(LAS u32x2*)(lds + XD_OFF + off) = (u32x2){cvtpk_s(v[0] * dt, v[1] * dt), cvtpk_s(v[2] * dt, v[3] * dt)};
                *(LAS u32x2*)(lds + XH_OFF + off) = (u32x2){cvtpk_s(v[0] * de, v[1] * de), cvtpk_s(v[2] * de, v[3] * de)};
            }
        }
        asm volatile("" ::: "memory"); __builtin_amdgcn_sched_barrier(0);
        if (ch + 1 < ch_end) SSD_PREFETCH(t0 + 128);
        __syncthreads();
        f32x16 yt = {};
        if (!pre) {
        {
            const int j = w & 3; const float al = acs[32 * j + c];
#pragma unroll
            for (int ii = 0; ii < 2; ++ii) {
                const int i = 2 * (w >> 2) + ii;
                if (i <= j) {
                    f32x16 x = {};
                    const LAS unsigned char* ap = lds + BT_OFF + (32 * i + c) * PITCH + 16 * hi;
                    const LAS unsigned char* bp = lds + CT_OFF + (32 * j + c) * PITCH + 16 * hi;
#pragma unroll 4
                    for (int ks = 0; ks < 8; ++ks) x = __builtin_amdgcn_mfma_f32_32x32x16_bf16(*(const LAS bf16x8*)(ap + 32 * ks), *(const LAS bf16x8*)(bp + 32 * ks), x, 0, 0, 0);
                    const int l = 32 * j + c;
#pragma unroll
                    for (int g4 = 0; g4 < 4; ++g4) {
                        const int sb = 32 * i + 8 * g4 + 4 * hi; float gv[4];
                        const f32x4 as4 = *(const LAS f32x4*)(acs + sb);
#pragma unroll
                        for (int e = 0; e < 4; ++e) { const int s = sb + e; gv[e] = s <= l ? x[4 * g4 + e] * __builtin_amdgcn_exp2f((al - as4[e]) * LOG2E) : 0.f; }
                        *(LAS u32x2*)(lds + G_OFF + l * PITCH + sb * 2) = (u32x2){cvtpk_s(gv[0], gv[1]), cvtpk_s(gv[2], gv[3])};
                    }
                }
            }
        }
        {
            const LAS unsigned char* ap = lds + HB_OFF + (32 * pt + c) * PITCH + 16 * hi;
            const LAS unsigned char* bp = lds + CT_OFF + (32 * jt + c) * PITCH + 16 * hi;
#pragma unroll 4
            for (int ks = 0; ks < 8; ++ks) yt = __builtin_amdgcn_mfma_f32_32x32x16_bf16(*(const LAS bf16x8*)(ap + 32 * ks), *(const LAS bf16x8*)(bp + 32 * ks), yt, 0, 0, 0);
            const float el = __expf(acs[32 * jt + c]);
#pragma unroll
            for (int r = 0; r < 16; ++r) yt[r] *= el;
        }
        __syncthreads();
        {
            const LAS unsigned char* bp = lds + G_OFF + (32 * jt + c) * PITCH + 16 * hi;
            for (int ks = 0; ks < 2 * jt + 2; ++ks) {
                const LAS unsigned char* xp = lds + XD_OFF + ((ks * 2 + pt) << 10) + xtr;
                yt = __builtin_amdgcn_mfma_f32_32x32x16_bf16(trfrag(xp, xp + 256), *(const LAS bf16x8*)(bp + 32 * ks), yt, 0, 0, 0);
            }
        }
        }
        {
            const float ea = __expf(aend);
#pragma unroll
            for (int r = 0; r < 16; ++r) hacc[r] *= ea;
            const int btr = (8 * hi + q4) * PITCH + (32 * jt + 16 * odd + 4 * p4) * 2;
#pragma unroll 4
            for (int ks = 0; ks < 8; ++ks) {
                const LAS unsigned char* xp = lds + XH_OFF + ((ks * 2 + pt) << 10) + xtr;
                const LAS unsigned char* bp = lds + BT_OFF + 16 * ks * PITCH + btr;
                hacc = __builtin_amdgcn_mfma_f32_32x32x16_bf16(trfrag(xp, xp + 256), trfrag(bp, bp + 4 * PITCH), hacc, 0, 0, 0);
            }
        }
        {
#pragma unroll
            for (int r = 0; r < 16; r += 2) {
                *(LAS bf16*)(lds + HB_OFF + (32 * pt + crow(r, hi)) * PITCH + (32 * jt + c) * 2) = (bf16)(cvtpk_s(hacc[r], hacc[r + 1]) & 0xffffu);
                *(LAS bf16*)(lds + HB_OFF + (32 * pt + crow(r + 1, hi)) * PITCH + (32 * jt + c) * 2) = (bf16)(cvtpk_s(hacc[r], hacc[r + 1]) >> 16);
            }
        }
        if (!pre) {
            const int l = 32 * jt + c; const float rdt = dsk * __builtin_amdgcn_rcpf(dtl[l]);
            bf16* up = F.AU + (row0 + t0 + l) * 2048 + hd * 64 + 32 * pt;
            float sq = 0.f;
#pragma unroll
            for (int g4 = 0; g4 < 4; ++g4) {
                const int pl = 8 * g4 + 4 * hi;
                const u32x2 xw2 = *(const LAS u32x2*)(lds + XD_OFF + (((l >> 4) * 2 + pt) << 10) + (l & 15) * 64 + pl * 2);
                const u32x2 zw = zr[g4];
                const float u0 = (yt[4 * g4] + rdt * bflo(xw2.x)) * bflo(zw.x), u1 = (yt[4 * g4 + 1] + rdt * bfhi(xw2.x)) * bfhi(zw.x), u2 = (yt[4 * g4 + 2] + rdt * bflo(xw2.y)) * bflo(zw.y), u3 = (yt[4 * g4 + 3] + rdt * bfhi(xw2.y)) * bfhi(zw.y);
                sq += (u0 * u0 + u1 * u1) + (u2 * u2 + u3 * u3);
                *(u32x2*)(up + pl) = (u32x2){cvtpk_s(u0, u1), cvtpk_s(u2, u3)};
            }
            sq += __shfl_xor(sq, 32);
            if (hi == 0) ssql[128 * pt + l] = sq;
        }
        if (ch + 1 < ch_end) SSD_PREFETCH_Z(t0 + 128);
        __syncthreads();
    }
#undef SSD_PREFETCH
#undef SSD_PREFETCH_Z
    if (w < 2) { const int t0 = ch_end * 128; F.SSQ[(row0 + t0 - 128 + lane) * 32 + 2 * hd + w] = ssql[128 * w + lane]; F.SSQ[(row0 + t0 - 64 + lane) * 32 + 2 * hd + w] = ssql[128 * w + 64 + lane]; }
    if (seg == NSEG - 1) {
    float* ho = F.out + O_HP + (((size_t)b * NH + hd) * HD + 32 * pt) * DS + 32 * jt + c;
#pragma unroll
    for (int r = 0; r < 16; ++r) ho[(size_t)crow(r, hi) * DS] = hacc[r];
    }
    __syncthreads();
}
}

namespace smp {
__device__ __forceinline__ void attn_unit(Frame& F, int bhs) {
    const Ins& I = F.I;
    const int lane = F.lane, w = F.wave, b = bhs >> 4, h = bhs & 15, r = NTOK + b;
    LAS float* qs = (LAS float*)(F.lds + 4096); LAS float* acc = (LAS float*)F.lds;
    LAS float* ps = (LAS float*)(F.lds + 8192) + w * 64;
    if (F.tid < 64) qs[F.tid] = bf2f(F.Q[(size_t)r * DM + h * HD + F.tid]);
    if (F.tid < 65) acc[F.tid] = 0.f;
    const int k0 = 49 * w, nk = (387 - k0) < 49 ? (387 - k0) : 49;
    const float gate = bf2f(F.Gb[(size_t)r * DM + h * HD + lane]);
    const float vnew = bf2f(F.V[(size_t)r * DM + h * HD + lane]), knew = bf2f(F.K[(size_t)r * DM + h * HD + lane]);
    const float* vbase = I.cv + ((size_t)b * WIN * NH + h) * HD + lane;
    float vv[49];
#pragma unroll
    for (int k = 0; k < 49; ++k) {
        const int idx = (k0 + k) < 386 ? (k0 + k) : 386, pat = idx / 129, j = idx - pat * 129, d = pat == 0 ? 1 : (pat == 1 ? 4 : 16), jj = j > 0 ? j : 1;
        vv[k] = vbase[(size_t)(WIN - jj * d) * (NH * HD)];
    }
    const int idx = (k0 + lane) < 386 ? (k0 + lane) : 386, pat = idx / 129, j = idx - pat * 129, d = pat == 0 ? 1 : (pat == 1 ? 4 : 16), jj = j > 0 ? j : 1;
    const float bias = I.rel_bias[t5_bucket(j * d) * NH + h] * LOG2E;
    f32x4 kv[16];
    { const f32x4* kp = (const f32x4*)(I.ck + (((size_t)b * WIN + (WIN - jj * d)) * NH + h) * HD);
#pragma unroll
      for (int e = 0; e < 16; ++e) kv[e] = kp[e]; }
    __syncthreads();
    const float snew = wave_sum(qs[lane] * knew);
    float s = 0.f;
#pragma unroll
    for (int e = 0; e < 16; ++e) { const f32x4 qv = *(const LAS f32x4*)(qs + 4 * e); s += (qv[0] * kv[e][0] + qv[1] * kv[e][1]) + (qv[2] * kv[e][2] + qv[3] * kv[e][3]); }
    const float p = lane < nk ? __builtin_amdgcn_exp2f((j > 0 ? s : snew) + bias) : 0.f;
    ps[lane] = p;
    const float lsum = wave_sum(p);
    __builtin_amdgcn_wave_barrier();
    float o0 = 0.f, o1 = 0.f, o2 = 0.f, o3 = 0.f;
#define SMP_V(K) ({ const int idx_ = (k0 + (K)) < 386 ? (k0 + (K)) : 386; ps[(K)] * ((idx_ % 129) > 0 ? vv[(K)] : vnew); })
#pragma unroll
    for (int k = 0; k < 48; k += 4) { o0 += SMP_V(k); o1 += SMP_V(k + 1); o2 += SMP_V(k + 2); o3 += SMP_V(k + 3); }
    o0 += SMP_V(48);
#undef SMP_V
    __hip_atomic_fetch_add(acc + lane, (o0 + o1) + (o2 + o3), __ATOMIC_RELAXED, __HIP_MEMORY_SCOPE_WORKGROUP);
    if (lane == 0) __hip_atomic_fetch_add(acc + 64, lsum, __ATOMIC_RELAXED, __HIP_MEMORY_SCOPE_WORKGROUP);
    __syncthreads();
    if (w == 0) F.AU[(size_t)r * 2048 + 1024 + h * HD + lane] = (bf16)f2bf(acc[lane] * __builtin_amdgcn_rcpf(acc[64]) * gate);
    __syncthreads();
}

__device__ __forceinline__ void ssd_unit(Frame& F, int bhs) {
    const Ins& I = F.I;
    LAS float* xs_l = (LAS float*)F.lds; LAS float* B_l = xs_l + 64; LAS float* C_l = B_l + 128; LAS float* ssq_l = C_l + 128;
    const int tid = F.tid, p = tid >> 3, ng = tid & 7;
    const int b = bhs >> 4, hd = bhs & 15, grp = hd >> 3; const size_t r = (size_t)NTOK + b;
    float h[16];
    { const f32x4* hp = (const f32x4*)(I.sssm + (((size_t)b * NH + hd) * HD + p) * DS + ng * 16);
#pragma unroll
      for (int i = 0; i < 4; ++i) { const f32x4 v = hp[i]; h[4 * i] = v[0]; h[4 * i + 1] = v[1]; h[4 * i + 2] = v[2]; h[4 * i + 3] = v[3]; } }
    if (tid < 320) {
        const int ci = tid, c = ci < 64 ? hd * 64 + ci : (ci < 192 ? 1024 + grp * 128 + (ci - 64) : 1280 + grp * 128 + (ci - 192));
        float v = I.conv_b[c];
#pragma unroll
        for (int i = 0; i < 3; ++i) v += I.sconv[((size_t)b * 3 + i) * CONVD + c] * I.conv_w[i * CONVD + c];
        v += bf2f(F.XBC[r * CONVD + c]) * I.conv_w[3 * CONVD + c];
        xs_l[ci] = silu_f(v);
    }
    if (tid == 0) ssq_l[0] = 0.f;
    const float dt = F.DT[(size_t)hd * MROWS + r], A = -__expf(I.a_log[hd]), dsk = I.d_skip[hd], zg = bf2f(F.Zb[r * DM + hd * 64 + p]);
    __syncthreads();
    const float x = xs_l[p], dec = __expf(dt * A), xdt = x * dt;
    float y = 0.f;
#pragma unroll
    for (int i = 0; i < 16; ++i) { h[i] = h[i] * dec + xdt * B_l[ng * 16 + i]; y += h[i] * C_l[ng * 16 + i]; }
    y += __shfl_xor(y, 1); y += __shfl_xor(y, 2); y += __shfl_xor(y, 4);
    if (ng == 0) {
        const float u = (y + dsk * x) * zg;
        F.AU[r * 2048 + hd * 64 + p] = (bf16)f2bf(u);
        __hip_atomic_fetch_add(ssq_l, u * u, __ATOMIC_RELAXED, __HIP_MEMORY_SCOPE_WORKGROUP);
    }
    { f32x4* ho = (f32x4*)(F.out + O_HS + (((size_t)b * NH + hd) * HD + p) * DS + ng * 16);
#pragma unroll
      for (int i = 0; i < 4; ++i) ho[i] = (f32x4){h[4 * i], h[4 * i + 1], h[4 * i + 2], h[4 * i + 3]}; }
    __syncthreads();
    if (tid == 0) { F.SSQ[r * 32 + 2 * hd] = ssq_l[0]; F.SSQ[r * 32 + 2 * hd + 1] = 0.f; }
    __syncthreads();
}
}

namespace smp {
typedef float f32x16s __attribute__((ext_vector_type(16)));
template <int KS>
__device__ __forceinline__ void mm32x32(Frame& F, const bf16* WT, int wrow0, const bf16* A, int apitch, int K) {
    const int lane = F.lane, w = F.wave, c = lane & 31, hi = lane >> 5;
    const bf16* ap = WT + (size_t)(wrow0 + c) * K + w * (16 * KS) + 8 * hi;
    const bf16* bp = A + (size_t)c * apitch + w * (16 * KS) + 8 * hi;
    bf16x8 af[KS], bf[KS];
#pragma unroll
    for (int ks = 0; ks < KS; ++ks) { af[ks] = *(const bf16x8*)(ap + 16 * ks); bf[ks] = *(const bf16x8*)(bp + 16 * ks); }
    f32x16s acc = {};
#pragma unroll
    for (int ks = 0; ks < KS; ++ks) acc = __builtin_amdgcn_mfma_f32_32x32x16_bf16(af[ks], bf[ks], acc, 0, 0, 0);
    LAS float* red = (LAS float*)F.lds + w * 1024;
#pragma unroll
    for (int r = 0; r < 16; ++r) red[((r & 3) + 8 * (r >> 2) + 4 * hi) * 32 + c] = acc[r];
    __syncthreads();
}
__device__ __forceinline__ void inproj_pair(Frame& F, int hp) {
    const Ins& I = F.I;
    const int a0 = 64 * hp;
    LAS float* val = (LAS float*)(F.lds + 32768);
    const int lane = F.lane, w = F.wave;
#pragma unroll 1
    for (int hf = 0; hf < 2; ++hf) {
        const int a = a0 + 32 * hf;
        mm32x32<8>(F, F.WinT, (a & ~255) + vrow_of_col(a & 255), F.XN + (size_t)NTOK * DM, DM, DM);
        const LAS float* red = (const LAS float*)F.lds;
        { const int col = F.tid >> 4, r0 = 2 * (F.tid & 15); float s0 = 0.f, s1 = 0.f;
#pragma unroll
          for (int k = 0; k < 8; ++k) { s0 += red[k * 1024 + col * 32 + r0]; s1 += red[k * 1024 + col * 32 + r0 + 1]; }
          val[r0 * 64 + 32 * hf + col] = s0; val[(r0 + 1) * 64 + 32 * hf + col] = s1; }
        __syncthreads();
    }
#pragma unroll 1
    for (int rr = 0; rr < 4; ++rr) {
        const int r = 4 * w + rr;
        const float v = val[r * 64 + lane];
        const size_t row = (size_t)NTOK + r; const int col = a0 + lane;
        if (col < C_V) {
            const float sc = rsqrtf(wave_sum(v * v) * (1.f / 64.f) + EPS);
            if (col < C_K) F.Q[row * DM + col] = (bf16)f2bf(v * sc * I.qnw[lane] * QSCALE);
            else { const float kv = v * sc * I.knw[lane]; F.K[row * DM + col - C_K] = (bf16)f2bf(kv); F.out[O_KS + (size_t)r * DM + col - C_K] = kv; }
        } else if (col < C_G) { F.V[row * DM + col - C_V] = (bf16)f2bf(v); F.out[O_VS + (size_t)r * DM + col - C_V] = v; }
        else if (col < C_Z) F.Gb[row * DM + col - C_G] = (bf16)f2bf(silu_fast(v));
        else if (col < C_XBC) F.Zb[row * DM + col - C_Z] = (bf16)f2bf(silu_fast(v));
        else { F.XBC[row * CONVD + col - C_XBC] = (bf16)f2bf(v); F.out[O_CS + ((size_t)r * 3 + 2) * CONVD + col - C_XBC] = v; }
    }
    __syncthreads();
}
__device__ __forceinline__ void outproj_unit(Frame& F, int ct) {
    const Ins& I = F.I;
    const int a0 = 32 * ct;
    const int col = F.tid >> 4, r0 = 2 * (F.tid & 15);
    float ssq[2], xres[2];
#pragma unroll
    for (int q = 0; q < 2; ++q) {
        const int r = r0 + q; const f32x4* sp = (const f32x4*)(F.SSQ + ((size_t)NTOK + r) * 32); float s = 0.f;
#pragma unroll
        for (int i = 0; i < 8; ++i) { const f32x4 t = sp[i]; s += (t[0] + t[1]) + (t[2] + t[3]); }
        ssq[q] = s; xres[q] = I.xs[(size_t)r * DM + a0 + col];
    }
    mm32x32<16>(F, F.WoutT, (a0 & ~255) + vrow_of_col(a0 & 255), F.AU + (size_t)NTOK * 2048, 2048, 2048);
    const LAS float* red = (const LAS float*)F.lds;
#pragma unroll
    for (int q = 0; q < 2; ++q) {
        const int r = r0 + q; float su = 0.f, sa = 0.f;
#pragma unroll
        for (int k = 0; k < 4; ++k) { su += red[k * 1024 + col * 32 + r]; sa += red[(4 + k) * 1024 + col * 32 + r]; }
        F.out[O_YS + (size_t)r * DM + a0 + col] = xres[q] + su * rsqrtf(ssq[q] * (1.f / 1024.f) + EPS) + sa;
    }
    __syncthreads();
}
}

__device__ __forceinline__ void phase2_queue(Frame& F, int qset) {
    const unsigned x = xb_xcc_id() & 7u;
    constexpr int PER_Q = att::NUNITS / 8;
    int lut_h = -1;
    for (unsigned k = 0; k < 8; ++k) {
        const unsigned qx = (x + k) & 7u;
        gu32* qw = F.ctl + CW_Q + 64 * (8 * qset + qx);
        if (k == 1) {
            if (F.tid < 8) F.MISC[24 + F.tid] = __hip_atomic_load(F.ctl + CW_Q + 64 * (8 * qset + F.tid), RLX_AGENT);
            __syncthreads();
        }
        if (k >= 1 && F.MISC[24 + qx] >= (unsigned)(PER_Q + 128)) continue;
        if (F.tid == 0) F.MISC[16] = __hip_atomic_fetch_add(qw, 1u, RLX_AGENT);
        __syncthreads();
        unsigned idx = F.MISC[16];
        while (idx < (unsigned)(PER_Q + 128)) {
            unsigned nxt = 0u;
            if (F.tid == 0) nxt = __hip_atomic_fetch_add(qw, 1u, RLX_AGENT);
            if (idx < (unsigned)PER_Q) { att::unit(F, (int)(qx * PER_Q + idx), lut_h); }
            else if (idx < (unsigned)(PER_Q + 64)) smp::attn_unit(F, (int)(qx * 64 + idx - PER_Q));
            else smp::ssd_unit(F, (int)(qx * 64 + idx - PER_Q - 64));
            if (F.tid == 0) F.MISC[16] = nxt;
            __syncthreads();
            idx = F.MISC[16];
        }
        __syncthreads();
    }
}

constexpr int PROBE_REP_SSD = 1, PROBE_REP_ATT = 1;
struct Args { Ins in; float* out; unsigned char* ws; int ph_lo, ph_hi; };
__global__ void __launch_bounds__(NWAVES * 64, 2) mk_fwd(Args args) {
    extern __shared__ __attribute__((aligned(16))) unsigned char lds[];
    Frame F;
    F.lds = (LAS unsigned char*)lds;
    F.MISC = (volatile LAS unsigned*)(F.lds + MISC_OFF);
    F.tid = threadIdx.x; F.lane = F.tid & 63; F.wave = __builtin_amdgcn_readfirstlane(F.tid >> 6);
    F.G = gridDim.x; { const int bx = blockIdx.x; F.vcu = (F.G % 8 == 0) ? (bx % 8) * (F.G / 8) + bx / 8 : bx; }
    unsigned char* ws = args.ws;
    F.ctl = (gu32*)(ws + WS_CTL); F.I = args.in; F.out = args.out;
    F.WinT = (bf16*)(ws + WS_WIN); F.WoutT = (bf16*)(ws + WS_WOUT); F.XN = (bf16*)(ws + WS_XN); F.Q = (bf16*)(ws + WS_Q); F.K = (bf16*)(ws + WS_K); F.V = (bf16*)(ws + WS_V);
    F.AU = (bf16*)(ws + WS_AU); F.XBC = (bf16*)(ws + WS_XBC); F.DT = (float*)(ws + WS_DT); F.SSQ = (float*)(ws + WS_SSQ); F.RAWB = (float*)(ws + WS_RAWB); F.Gb = (bf16*)(ws + WS_G); F.Zb = (bf16*)(ws + WS_Z);
    for (int u = F.tid; u < (LDS_BYTES - LDSCTL_OFF) / 4; u += NWAVES * 64) ((LAS unsigned*)(F.lds + LDSCTL_OFF))[u] = 0u;
    __syncthreads();
    XcdBarrier bar = xcd_barrier_post((unsigned*)(F.ctl + CW_BAR), F.MISC + 8);
    const int lo = args.ph_lo, hi = args.ph_hi;
#define IN(k) (lo <= (k) && (k) < hi)
#define BOTH(k) (IN(k) && IN((k) + 1))
    if (IN(0)) { p0_prologue(F); if (BOTH(0)) xcd_barrier(bar); }
    if (IN(1)) {
        __syncthreads();
        pg8::Gemm g{F.XN, F.WinT, NTOK, NMAIN, DM}; pg8::StaticOrder S; S.init(NTOK, NMAIN, F.G, (int)blockIdx.x);
        pg8::EpiIn E{F.Q, F.K, F.V, F.Gb, F.Zb, F.XBC, F.out, F.I.qnw, F.I.knw, F.I.conv_w, F.I.conv_b, F.RAWB};
        pg8::gemm_phase<pg8::EpiIn, pg8::StaticOrder, true, true>(F.lds + RING_OFF, g, S, E);
        __syncthreads();
        for (int hp = F.vcu; hp < NMAIN / 64; hp += F.G) smp::inproj_pair(F, hp);
        if (BOTH(1)) xcd_barrier(bar);
    }
    if (IN(2)) { __syncthreads(); if ((F.vcu & 31) < 8 * ssd::NSEG && (F.vcu >> 5) < 8) { ssd::chain(F, (F.vcu >> 5) * (8 * ssd::NSEG) + (F.vcu & 31)); if (PROBE_ID == 30 && (F.vcu & 1)) { const unsigned long long t0_ = __builtin_amdgcn_s_memrealtime(); while (__builtin_amdgcn_s_memrealtime() - t0_ < 10000ull) __builtin_amdgcn_s_sleep(8); } } for (int rep = 0; rep < PROBE_REP_ATT; ++rep) phase2_queue(F, rep);     if (BOTH(2)) xcd_barrier(bar); }
    if (IN(3)) {
        __syncthreads();
        pg8::Gemm g{F.AU, F.WoutT, NTOK, DM, 2048}; pg8::StaticOrder S; S.init(NTOK, DM, F.G, (int)blockIdx.x);
        LAS float* rs = (LAS float*)(F.lds + RING_BYTES);
        { pg8::Unit u;
          for (int ui0 = 0; ui0 < 4; ui0 += 2) {
              const int ui = ui0 + (F.tid >> 8), r = F.tid & 255;
              if (S.next(ui, u)) {
                  const f32x4* sp = (const f32x4*)(F.SSQ + (size_t)(u.pm * 256 + r) * 32);
                  float s = 0.f;
#pragma unroll
                  for (int q = 0; q < 8; ++q) { const f32x4 v = sp[q]; s += (v[0] + v[1]) + (v[2] + v[3]); }
                  rs[ui * 256 + r] = rsqrtf(s * (1.f / 1024.f) + EPS);
              }
          }
          __syncthreads(); }
        pg8::EpiOut E{F.I.xp, F.I.xs, rs, F.out};
        pg8::gemm_phase<pg8::EpiOut, pg8::StaticOrder, true, true>(F.lds + RING_OFF, g, S, E);
        __syncthreads();
        for (int ct = F.G - 1 - F.vcu; ct >= 0 && ct < DM / 32; ct += F.G) smp::outproj_unit(F, ct);
    }
#undef IN
#undef BOTH
}

extern "C" void kernel_launch(void* const* d_in, const int* in_sizes, int n_in, void* d_out, int out_size, void* d_ws, size_t ws_size, hipStream_t stream) {
    static int grid = 0;
    if (grid == 0) {
        if (n_in != 18 || out_size != (int)O_END || ws_size < WS_END) { fprintf(stderr, "kernel_launch: unexpected n_in %d / out_size %d / ws_size %zu; nothing launched\n", n_in, out_size, ws_size); grid = -1; return; }
        int dev = 0, cus = 0;
        if (hipGetDevice(&dev) != hipSuccess || hipDeviceGetAttribute(&cus, hipDeviceAttributeMultiprocessorCount, dev) != hipSuccess) { grid = -1; return; }
        if (hipFuncSetAttribute((const void*)mk_fwd, hipFuncAttributeMaxDynamicSharedMemorySize, LDS_BYTES) != hipSuccess) { fprintf(stderr, "kernel_launch: hipFuncSetAttribute failed\n"); grid = -1; return; }
        (void)hipGetLastError();
        grid = cus;
    }
    if (grid < 0) return;
    (void)hipMemsetAsync((char*)d_ws + WS_CTL, 0, CTL_ZERO_BYTES, stream);
    Args a{};
    const float** ip = (const float**)&a.in;
    for (int i = 0; i < 18; ++i) ip[i] = (const float*)d_in[i];
    a.out = (float*)d_out; a.ws = (unsigned char*)d_ws;
    a.ph_lo = 0; a.ph_hi = 4;
    hipLaunchKernelGGL(mk_fwd, dim3(grid), dim3(NWAVES * 64), LDS_BYTES, stream, a);
}
```

```cpp
#include <hip/hip_runtime.h>
#include <cstdio>
#include <cstdint>

constexpr int DM = 1024, NB = 4, SEQ = 8192, DB = 32, WIN = 2048;
constexpr int NPROJ = 6672, NMAIN = 6656, NTOK = NB * SEQ, NROWS = NTOK + DB;
constexpr int MROWS = 33024;
constexpr int C_Q = 0, C_K = 1024, C_V = 2048, C_G = 3072, C_Z = 4096, C_XBC = 5120, C_DT = 6656;
constexpr int CONVD = 1536, NH = 16, HD = 64, DS = 128;
constexpr float EPS = 1e-6f;
constexpr float QSCALE = 0.125f * 1.4426950408889634f;
constexpr float LOG2E = 1.4426950408889634f;
constexpr size_t O_YP = 0, O_YS = O_YP + (size_t)NTOK * DM, O_KP = O_YS + (size_t)DB * DM, O_VP = O_KP + (size_t)NB * WIN * DM,
                 O_CP = O_VP + (size_t)NB * WIN * DM, O_HP = O_CP + (size_t)NB * 3 * CONVD, O_KS = O_HP + (size_t)NB * NH * HD * DS,
                 O_VS = O_KS + (size_t)DB * DM, O_CS = O_VS + (size_t)DB * DM, O_HS = O_CS + (size_t)DB * 3 * CONVD,
                 O_END = O_HS + (size_t)DB * NH * HD * DS;
static_assert(O_END == 55314432, "output size");

constexpr size_t MiB = 1u << 20;
constexpr size_t WS_CTL = 0, CTL_ZERO_BYTES = 1 * MiB;
constexpr size_t WS_WIN = 2 * MiB;
constexpr size_t WS_WOUT = 16 * MiB;
constexpr size_t WS_DT = 20 * MiB;
constexpr size_t WS_SSQ = 24 * MiB;
constexpr size_t WS_XN = 32 * MiB;
constexpr size_t WS_Q = 100 * MiB;
constexpr size_t WS_K = 168 * MiB;
constexpr size_t WS_V = 236 * MiB;
constexpr size_t WS_AU = 304 * MiB;
constexpr size_t WS_XBC = 436 * MiB;
constexpr size_t WS_RAWB = 536 * MiB;
constexpr size_t WS_G = 544 * MiB;
constexpr size_t WS_Z = 612 * MiB;
constexpr size_t WS_END = 680 * MiB;
static_assert(WS_XN + (size_t)MROWS * DM * 2 <= WS_Q && WS_Q + (size_t)MROWS * DM * 2 <= WS_K && WS_K + (size_t)MROWS * DM * 2 <= WS_V && WS_V + (size_t)MROWS * DM * 2 <= WS_AU &&
              WS_AU + (size_t)MROWS * 2048 * 2 <= WS_XBC && WS_XBC + (size_t)MROWS * CONVD * 2 <= WS_RAWB && WS_RAWB + (size_t)(MROWS / 64) * 6 * 512 * 4 <= WS_G && WS_G + (size_t)MROWS * DM * 2 <= WS_Z && WS_Z + (size_t)MROWS * DM * 2 <= WS_END && WS_WIN + (size_t)NMAIN * DM * 2 <= WS_WOUT && WS_WOUT + (size_t)DM * 2048 * 2 <= WS_DT &&
              WS_DT + (size_t)MROWS * 16 * 4 <= WS_SSQ && WS_SSQ + (size_t)MROWS * 32 * 4 <= WS_XN, "d_ws map");

struct Ins {
    const float *xp, *xs, *ck, *cv, *sconv, *sssm, *norm_w, *w_in, *qnw, *knw, *rel_bias, *conv_w, *conv_b, *dt_bias, *a_log, *d_skip, *ssd_norm_w, *w_out;
};

typedef unsigned short bf16;
__device__ __forceinline__ float wave_sum(float v) {
#pragma unroll
    for (int o = 1; o < 64; o <<= 1) v += __shfl_xor(v, o);
    return v;
}
__device__ __forceinline__ float wave_max(float v) {
#pragma unroll
    for (int o = 1; o < 64; o <<= 1) v = fmaxf(v, __shfl_xor(v, o));
    return v;
}
__device__ __forceinline__ float silu_f(float x) { return x / (1.f + __expf(-x)); }
__device__ __forceinline__ float silu_fast(float x) { return x * __builtin_amdgcn_rcpf(1.f + __builtin_amdgcn_exp2f(-LOG2E * x)); }
__device__ __forceinline__ float softplus_f(float x) { return x > 20.f ? x : log1pf(__expf(x)); }
__device__ __forceinline__ int t5_bucket(int d) {
    if (d < 16) return d;
    int b = 16;
    b += d >= 22; b += d >= 30; b += d >= 40; b += d >= 54; b += d >= 73; b += d >= 99; b += d >= 134; b += d >= 182;
    b += d >= 246; b += d >= 332; b += d >= 450; b += d >= 609; b += d >= 825; b += d >= 1117; b += d >= 1513;
    return b;
}
__device__ __forceinline__ const float* xrow(const Ins& I, int r) { return r < NTOK ? I.xp + (size_t)r * DM : I.xs + (size_t)(r - NTOK) * DM; }
__device__ __forceinline__ float bf2f(bf16 v) { return __uint_as_float((unsigned)v << 16); }
__device__ __forceinline__ unsigned f2bf(float f) { unsigned u = __float_as_uint(f); return (u + 0x7fffu + ((u >> 16) & 1u)) >> 16; }
__device__ __forceinline__ unsigned pk2(float lo, float hi) { return f2bf(lo) | (f2bf(hi) << 16); }
typedef float f32x2_cv __attribute__((ext_vector_type(2))); typedef __bf16 bf16x2_cv __attribute__((ext_vector_type(2)));
__device__ __forceinline__ unsigned cvtpk_s(float lo, float hi) { const f32x2_cv v = {lo, hi}; const bf16x2_cv b = __builtin_convertvector(v, bf16x2_cv); return __builtin_bit_cast(unsigned, b); }
__host__ __device__ __forceinline__ int vrow_of_col(int a) { return 128 * ((a >> 5) & 1) + 32 * ((a >> 6) & 3) + (a & 31); }

namespace pg8 {
#define PG8_LAS __attribute__((address_space(3)))
typedef unsigned short bf16_t;
typedef short bf16x8 __attribute__((ext_vector_type(8)));
typedef float f32x4 __attribute__((ext_vector_type(4)));
typedef unsigned u32x4 __attribute__((ext_vector_type(4)));
constexpr int BM = 256, BK = 64, HALF = 128, HTB = HALF * BK * 2  , STAGE_BYTES = 8 * HTB, NXCD = 8, WGM = 8;

__host__ __device__ __forceinline__ int lds_byte(int r, int c) { const int st = (r >> 4) * 2 + (c >> 5), rr = r & 15, cc = c & 31, ob = rr * 64 + cc * 2; return st * 1024 + (ob ^ (((ob >> 9) & 1) << 5)); }
__host__ __device__ __forceinline__ void stage_rc(int b, int& R, int& C) { const int st = b / 1024, sb = b % 1024, swz = sb ^ (((sb >> 9) & 1) << 5); R = (st >> 1) * 16 + swz / 64; C = (st & 1) * 32 + (swz % 64) / 2; }
__host__ __device__ __forceinline__ int perm32(int rho) { const int n = rho >> 4, i = rho & 15; return 8 * (i >> 2) + 4 * n + (i & 3); }

struct Unit { int pm, pn; };
struct Gemm { const bf16_t* A; const bf16_t* Bt; int M, N, K; };

struct StaticOrder {
    int nM, nN, nwg, G, c;
    __host__ __device__ void init(int M, int N, int G_, int c_) { nM = M / BM; nN = N / BM; nwg = nM * nN; G = G_; c = c_; }
    __host__ __device__ bool next(int i, Unit& u) const {
        const long L = (long)i * G + c; if (L >= nwg) return false;
        int wgid = (int)L; { const int q = nwg / NXCD, r = nwg % NXCD, xcd = wgid % NXCD, off = wgid / NXCD; wgid = (xcd < r ? xcd * (q + 1) : r * (q + 1) + (xcd - r) * q) + off; }
        const int nig = WGM * nN, gid = wgid / nig, fm = gid * WGM, gsz = (nM - fm) < WGM ? (nM - fm) : WGM;
        u.pm = fm + ((wgid % nig) % gsz); u.pn = (wgid % nig) / gsz; return true;
    }
    __device__ __forceinline__ void a_ready(const Unit&) const {}
    __device__ __forceinline__ void done(const Unit&) const {}
};

__device__ __forceinline__ unsigned cvt_pk_bf16(float lo, float hi) { unsigned r; asm volatile("v_cvt_pk_bf16_f32 %0, %1, %2" : "=v"(r) : "v"(lo), "v"(hi)); return r; }

template <int K> __device__ __forceinline__ float rowprev(float cur, float prevm) {
    const int t = __builtin_amdgcn_update_dpp(0, __builtin_bit_cast(int, prevm), 0x100 + (16 - K), 0xf, 0xf, true);
    return __builtin_bit_cast(float, __builtin_amdgcn_update_dpp(t, __builtin_bit_cast(int, cur), 0x110 + K, 0xf, 0xf, false));
}

struct EpiIn {
    static constexpr bool PERM = true, AFTER_DRAIN = false, MIDK = false;
    bf16_t *Q, *K, *V, *Gb, *Zb, *XBC; float* out; const float *qnw, *knw, *conv_w, *conv_b; float* rawb;
    __device__ __forceinline__ void mid(f32x4 (&)[2][2][4][2], const Unit&, int, int, int, int, int) const {}
    __device__ __forceinline__ void operator()(const f32x4 (&acc)[2][2][4][2], const Unit& u, int wr, int wc, int fr, int fq) const {
        const int pn = u.pn;
        const int rowb = u.pm * BM + wr * 64 + fr;
        const int cl = wc * 64 + 8 * fq;
        if (pn < 8) {
            const bool isq = pn < 4; const float* nw = isq ? qnw : knw;
            f32x4 w[2][2];
#pragma unroll
            for (int bj = 0; bj < 2; ++bj)
#pragma unroll
                for (int n = 0; n < 2; ++n) w[bj][n] = *(const f32x4*)(nw + 8 * fq + 32 * bj + 4 * n);
            bf16_t* dstb = (isq ? Q : K) + (pn & 3) * 256 + cl;
#pragma unroll
            for (int ai = 0; ai < 2; ++ai)
#pragma unroll
                for (int m = 0; m < 4; ++m) {
                    const int r = rowb + ai * HALF + m * 16;
                    float ss = 0.f;
#pragma unroll
                    for (int bj = 0; bj < 2; ++bj)
#pragma unroll
                        for (int n = 0; n < 2; ++n) { const f32x4 v = acc[ai][bj][m][n]; ss += (v[0] * v[0] + v[1] * v[1]) + (v[2] * v[2] + v[3] * v[3]); }
                    ss += __shfl_xor(ss, 16); ss += __shfl_xor(ss, 32);
                    const float sc = rsqrtf(ss * (1.f / 64.f) + EPS), scs = isq ? sc * QSCALE : sc;
                    float* f32dst = nullptr;
                    if (!isq) { if (r < NTOK) { const int t = r & (SEQ - 1); if (t >= SEQ - WIN) f32dst = out + O_KP + ((size_t)((r >> 13) * WIN + t - (SEQ - WIN))) * DM + (pn & 3) * 256 + cl; }
                                else if (r < NROWS) f32dst = out + O_KS + (size_t)(r - NTOK) * DM + (pn & 3) * 256 + cl; }
#pragma unroll
                    for (int bj = 0; bj < 2; ++bj) {
                        const f32x4 a0 = acc[ai][bj][m][0] * w[bj][0], a1 = acc[ai][bj][m][1] * w[bj][1];
                        u32x4 o; o.x = cvt_pk_bf16(a0[0] * scs, a0[1] * scs); o.y = cvt_pk_bf16(a0[2] * scs, a0[3] * scs); o.z = cvt_pk_bf16(a1[0] * scs, a1[1] * scs); o.w = cvt_pk_bf16(a1[2] * scs, a1[3] * scs);
                        *(u32x4*)(dstb + (size_t)r * DM + 32 * bj) = o;
                        if (f32dst) { *(f32x4*)(f32dst + 32 * bj) = a0 * sc; *(f32x4*)(f32dst + 32 * bj + 4) = a1 * sc; }
                    }
                }
        } else if (pn < 12) {
            bf16_t* dstb = V + (pn & 3) * 256 + cl;
#pragma unroll
            for (int ai = 0; ai < 2; ++ai)
#pragma unroll
                for (int m = 0; m < 4; ++m) {
                    const int r = rowb + ai * HALF + m * 16;
                    float* f32dst = nullptr;
                    if (r < NTOK) { const int t = r & (SEQ - 1); if (t >= SEQ - WIN) f32dst = out + O_VP + ((size_t)((r >> 13) * WIN + t - (SEQ - WIN))) * DM + (pn & 3) * 256 + cl; }
                    else if (r < NROWS) f32dst = out + O_VS + (size_t)(r - NTOK) * DM + (pn & 3) * 256 + cl;
#pragma unroll
                    for (int bj = 0; bj < 2; ++bj) {
                        const f32x4 a0 = acc[ai][bj][m][0], a1 = acc[ai][bj][m][1];
                        u32x4 o; o.x = cvt_pk_bf16(a0[0], a0[1]); o.y = cvt_pk_bf16(a0[2], a0[3]); o.z = cvt_pk_bf16(a1[0], a1[1]); o.w = cvt_pk_bf16(a1[2], a1[3]);
                        *(u32x4*)(dstb + (size_t)r * DM + 32 * bj) = o;
                        if (f32dst) { *(f32x4*)(f32dst + 32 * bj) = a0; *(f32x4*)(f32dst + 32 * bj + 4) = a1; }
                    }
                }
        } else if (pn < 20) {
            bf16_t* dstb = (pn < 16 ? Gb : Zb) + (pn & 3) * 256 + cl;
#pragma unroll
            for (int ai = 0; ai < 2; ++ai)
#pragma unroll
                for (int m = 0; m < 4; ++m) {
                    const int r = rowb + ai * HALF + m * 16;
#pragma unroll
                    for (int bj = 0; bj < 2; ++bj) {
                        f32x4 a0 = acc[ai][bj][m][0], a1 = acc[ai][bj][m][1];
#pragma unroll
                        for (int i = 0; i < 4; ++i) { a0[i] = silu_fast(a0[i]); a1[i] = silu_fast(a1[i]); }
                        u32x4 o; o.x = cvt_pk_bf16(a0[0], a0[1]); o.y = cvt_pk_bf16(a0[2], a0[3]); o.z = cvt_pk_bf16(a1[0], a1[1]); o.w = cvt_pk_bf16(a1[2], a1[3]);
                        *(u32x4*)(dstb + (size_t)r * DM + 32 * bj) = o;
                    }
                }
        } else {
            const int cb = (pn - 20) * 256 + cl;
            bf16_t* dstb = XBC + cb;
            const bool do_conv = pn >= 24 && u.pm < NTOK / BM;
#pragma unroll
            for (int ai = 0; ai < 2; ++ai)
#pragma unroll
                for (int m = 0; m < 4; ++m) {
                    const int r = rowb + ai * HALF + m * 16;
                    float* f32dst = nullptr;
                    if (r < NTOK) { const int t = r & (SEQ - 1); if (t >= SEQ - 3) f32dst = out + O_CP + ((size_t)((r >> 13) * 3 + t - (SEQ - 3))) * CONVD + cb; }
                    else if (r < NROWS) f32dst = out + O_CS + ((size_t)(r - NTOK) * 3 + 2) * CONVD + cb;
                    if (do_conv && (m == 0 || m == 3)) {
                        const int slot = m == 0 ? 3 + fr : fr - 13;
                        if (slot >= 0 && slot < 6) f32dst = rawb + ((size_t)(u.pm * 4 + ai * 2 + wr) * 6 + slot) * 512 + (cb - 1024);
                    }
#pragma unroll
                    for (int bj = 0; bj < 2; ++bj) {
                        const f32x4 a0 = acc[ai][bj][m][0], a1 = acc[ai][bj][m][1];
                        if (!do_conv) { u32x4 o; o.x = cvt_pk_bf16(a0[0], a0[1]); o.y = cvt_pk_bf16(a0[2], a0[3]); o.z = cvt_pk_bf16(a1[0], a1[1]); o.w = cvt_pk_bf16(a1[2], a1[3]);
                                        *(u32x4*)(dstb + (size_t)r * CONVD + 32 * bj) = o; }
                        if (f32dst) { *(f32x4*)(f32dst + 32 * bj) = a0; *(f32x4*)(f32dst + 32 * bj + 4) = a1; }
                    }
                }
            if (do_conv) {
                if ((u.pm & 31) == 31 && wr == 1 && fr >= 13) {
#pragma unroll
                    for (int bj = 0; bj < 2; ++bj) { float* d = out + O_CP + ((size_t)((u.pm >> 5) * 3 + fr - 13)) * CONVD + cb + 32 * bj; *(f32x4*)d = acc[1][bj][3][0]; *(f32x4*)(d + 4) = acc[1][bj][3][1]; }
                }
#pragma unroll
                for (int bj = 0; bj < 2; ++bj) {
                    f32x4 w[4][2], bb[2];
#pragma unroll
                    for (int n = 0; n < 2; ++n) { bb[n] = *(const f32x4*)(conv_b + cb + 32 * bj + 4 * n);
#pragma unroll
                        for (int t = 0; t < 4; ++t) w[t][n] = *(const f32x4*)(conv_w + t * CONVD + cb + 32 * bj + 4 * n); }
#pragma unroll
                    for (int ai = 0; ai < 2; ++ai) {
                        f32x4 pm[2] = {(f32x4){0.f, 0.f, 0.f, 0.f}, (f32x4){0.f, 0.f, 0.f, 0.f}};
#pragma unroll
                        for (int m = 0; m < 4; ++m) {
                            const int r = rowb + ai * HALF + m * 16;
                            unsigned ow[4];
#pragma unroll
                            for (int n = 0; n < 2; ++n) {
                                const f32x4 cur = acc[ai][bj][m][n]; f32x4 v;
#pragma unroll
                                for (int i = 0; i < 4; ++i) {
                                    const float p1 = rowprev<1>(cur[i], pm[n][i]), p2 = rowprev<2>(cur[i], pm[n][i]), p3 = rowprev<3>(cur[i], pm[n][i]);
                                    v[i] = silu_fast(bb[n][i] + w[0][n][i] * p3 + w[1][n][i] * p2 + w[2][n][i] * p1 + w[3][n][i] * cur[i]);
                                }
                                ow[2 * n] = cvt_pk_bf16(v[0], v[1]); ow[2 * n + 1] = cvt_pk_bf16(v[2], v[3]);
                                pm[n] = cur;
                            }
                            *(u32x4*)(dstb + (size_t)r * CONVD + 32 * bj) = (u32x4){ow[0], ow[1], ow[2], ow[3]};
                        }
                    }
                }
            }
        }
    }
};

struct EpiOut {
    static constexpr bool PERM = true, AFTER_DRAIN = false, MIDK = true;
    const float* xp; const float* xs; const PG8_LAS float* rs; float* out;
    __device__ __forceinline__ void mid(f32x4 (&acc)[2][2][4][2], const Unit& u, int ui, int wr, int wc, int fr, int fq) const {
        const PG8_LAS float* rp = rs + ui * 256 + wr * 64 + fr;
#pragma unroll
        for (int ai = 0; ai < 2; ++ai)
#pragma unroll
            for (int m = 0; m < 4; ++m) {
                const float r = rp[ai * HALF + m * 16];
#pragma unroll
                for (int bj = 0; bj < 2; ++bj)
#pragma unroll
                    for (int n = 0; n < 2; ++n) acc[ai][bj][m][n] *= r;
            }
    }
    __device__ __forceinline__ void operator()(const f32x4 (&acc)[2][2][4][2], const Unit& u, int wr, int wc, int fr, int fq) const {
        const int rowb = u.pm * BM + wr * 64 + fr, col = u.pn * BM + wc * 64 + 8 * fq;
#pragma unroll
        for (int ai = 0; ai < 2; ++ai) {
            f32x4 xv[4][2][2];
#pragma unroll
            for (int m = 0; m < 4; ++m) {
                const float* xr = xp + (size_t)(rowb + ai * HALF + m * 16) * DM + col;
#pragma unroll
                for (int bj = 0; bj < 2; ++bj) { xv[m][bj][0] = *(const f32x4*)(xr + 32 * bj); xv[m][bj][1] = *(const f32x4*)(xr + 32 * bj + 4); }
            }
#pragma unroll
            for (int m = 0; m < 4; ++m) {
                float* yr = out + O_YP + (size_t)(rowb + ai * HALF + m * 16) * DM + col;
#pragma unroll
                for (int bj = 0; bj < 2; ++bj) { *(f32x4*)(yr + 32 * bj) = xv[m][bj][0] + acc[ai][bj][m][0]; *(f32x4*)(yr + 32 * bj + 4) = xv[m][bj][1] + acc[ai][bj][m][1]; }
            }
        }
    }
};

template <class Epi, class Sched, bool ALIGN_EPI = false, bool SP2 = false>
__device__ __forceinline__ void gemm_phase(PG8_LAS unsigned char* lds, const Gemm g, const Sched& S, const Epi& E) {
    const int tid = threadIdx.x, wid = __builtin_amdgcn_readfirstlane(tid >> 6), lane = tid & 63, wr = wid >> 2, wc = wid & 3, fr = lane & 15, fq = lane >> 4;
    const int K = g.K, nt = K / BK;
    unsigned voffA[2], voffB[2];
#pragma unroll
    for (int i = 0; i < 2; ++i) { int R, C; stage_rc(tid * 16 + i * 8192, R, C); const int Rb = Epi::PERM ? ((R & ~31) + perm32(R & 31)) : R;
        voffA[i] = (unsigned)(R * K + C) * 2u; voffB[i] = (unsigned)(Rb * K + C) * 2u; }
    const size_t kstep = (size_t)(BK * 2);
    const size_t hstep = (size_t)HALF * K * 2;
    const size_t tstep = 2 * hstep;
    const unsigned ldsw = (unsigned)wid * 1024u;
    const int aoff = lds_byte(wr * 64 + fr, fq * 8), boff = lds_byte(wc * 32 + fr, fq * 8);
#define PG8_SA(b, h) (((b) * 2 + (h)) * HTB)
#define PG8_SB(b, h) ((4 + (b) * 2 + (h)) * HTB)
#define PG8_STAGE(bufoff, gbase, voff) do { _Pragma("unroll") for (int _i = 0; _i < 2; ++_i) \
        __builtin_amdgcn_global_load_lds((const unsigned*)((const char*)(gbase) + (voff)[_i]), (PG8_LAS unsigned*)(lds + (bufoff) + ldsw + _i * 8192), 16, 0, 0); } while (0)
#define PG8_LDA(dst, b, h) do { _Pragma("unroll") for (int m = 0; m < 4; ++m) _Pragma("unroll") for (int k = 0; k < 2; ++k) dst[m][k] = *(const PG8_LAS bf16x8*)(lds + PG8_SA(b, h) + aoff + m * 2048 + k * 1024); } while (0)
#define PG8_LDB(dst, b, h) do { _Pragma("unroll") for (int n = 0; n < 2; ++n) _Pragma("unroll") for (int k = 0; k < 2; ++k) dst[n][k] = *(const PG8_LAS bf16x8*)(lds + PG8_SB(b, h) + boff + n * 2048 + k * 1024); } while (0)
#define PG8_MMA(ai, bj, At, Bt) do { __builtin_amdgcn_s_setprio(1); _Pragma("unroll") for (int m = 0; m < 4; ++m) _Pragma("unroll") for (int n = 0; n < 2; ++n) _Pragma("unroll") for (int k = 0; k < 2; ++k) \
        acc[ai][bj][m][n] = __builtin_amdgcn_mfma_f32_16x16x32_bf16(Bt[n][k], At[m][k], acc[ai][bj][m][n], 0, 0, 0); __builtin_amdgcn_s_setprio(0); } while (0)
#define PG8_WAIT_V(n) asm volatile("s_waitcnt vmcnt(" #n ")" ::: "memory")
#define PG8_WAIT_L(n) asm volatile("s_waitcnt lgkmcnt(" #n ")" ::: "memory")
#define PG8_BAR __builtin_amdgcn_s_barrier()
#define PG8_SCHED __builtin_amdgcn_sched_barrier(0)
    Unit cur, nxt; int ui = 0;
    if (!S.next(0, cur)) return;
    f32x4 acc[2][2][4][2];
#pragma unroll
    for (int a = 0; a < 2; ++a)
#pragma unroll
        for (int b = 0; b < 2; ++b)
#pragma unroll
            for (int m = 0; m < 4; ++m)
#pragma unroll
                for (int n = 0; n < 2; ++n) acc[a][b][m][n] = (f32x4){0.f, 0.f, 0.f, 0.f};
    bf16x8 At[4][2], B0[2][2], B1[2][2];
    const char* cA = (const char*)g.A + (size_t)cur.pm * tstep; const char* cB = (const char*)g.Bt + (size_t)cur.pn * tstep;
    S.a_ready(cur);
    if constexpr (SP2) {
        PG8_STAGE(PG8_SB(0, 0), cB, voffB); PG8_STAGE(PG8_SB(0, 1), cB + hstep, voffB); PG8_STAGE(PG8_SA(0, 0), cA, voffA); PG8_STAGE(PG8_SA(0, 1), cA + hstep, voffA);
        if (wr == 1) PG8_BAR;
        PG8_WAIT_V(2); PG8_BAR;
        PG8_STAGE(PG8_SB(1, 0), cB + kstep, voffB); PG8_STAGE(PG8_SA(1, 0), cA + kstep, voffA); PG8_STAGE(PG8_SB(1, 1), cB + hstep + kstep, voffB);
        PG8_WAIT_V(6); PG8_BAR;
    } else {
        PG8_STAGE(PG8_SB(0, 0), cB, voffB); PG8_STAGE(PG8_SA(0, 0), cA, voffA); PG8_STAGE(PG8_SB(0, 1), cB + hstep, voffB); PG8_STAGE(PG8_SA(0, 1), cA + hstep, voffA);
        if (wr == 1) PG8_BAR;
        PG8_WAIT_V(4); PG8_BAR;
        PG8_STAGE(PG8_SB(1, 0), cB + kstep, voffB); PG8_STAGE(PG8_SA(1, 0), cA + kstep, voffA); PG8_STAGE(PG8_SB(1, 1), cB + hstep + kstep, voffB);
        PG8_WAIT_V(6); PG8_BAR;
    }
    for (;;) {
        const bool has_next = S.next(ui + 1, nxt);
        const char* nA = has_next ? (const char*)g.A + (size_t)nxt.pm * tstep : cA; const char* nB = has_next ? (const char*)g.Bt + (size_t)nxt.pn * tstep : cB;
        for (int t = 0; t < nt; t += 2) {
            const bool last = (t == nt - 2);
            if constexpr (Epi::MIDK) { if (t == (nt >> 1)) E.mid(acc, cur, ui, wr, wc, fr, fq); }
            const char* a1 = cA + (size_t)(t + 1) * kstep;
            const char* a2 = last ? nA : cA + (size_t)(t + 2) * kstep; const char* b2 = last ? nB : cB + (size_t)(t + 2) * kstep;
            const char* a3 = a2 + kstep; const char* b3 = b2 + kstep;
            if (last && has_next) S.a_ready(nxt);
            if constexpr (SP2) {
            PG8_LDB(B0, 0, 0); PG8_LDB(B1, 0, 1); PG8_SCHED; PG8_LDA(At, 0, 0); PG8_STAGE(PG8_SA(1, 1), a1 + hstep, voffA);
            PG8_WAIT_V(8); PG8_WAIT_L(0); PG8_BAR; PG8_MMA(0, 0, At, B0); PG8_MMA(0, 1, At, B1); PG8_BAR; PG8_SCHED;
            PG8_LDA(At, 0, 1); PG8_STAGE(PG8_SB(0, 0), b2, voffB); PG8_STAGE(PG8_SB(0, 1), b2 + hstep, voffB); PG8_STAGE(PG8_SA(0, 0), a2, voffA);
            PG8_WAIT_V(8); PG8_WAIT_L(0); PG8_BAR; PG8_MMA(1, 0, At, B0); PG8_MMA(1, 1, At, B1); PG8_BAR; PG8_SCHED;
            PG8_LDB(B0, 1, 0); PG8_LDB(B1, 1, 1); PG8_SCHED; PG8_LDA(At, 1, 0); PG8_STAGE(PG8_SA(0, 1), a2 + hstep, voffA);
            PG8_WAIT_V(8); PG8_WAIT_L(0); PG8_BAR; PG8_MMA(0, 0, At, B0); PG8_MMA(0, 1, At, B1); PG8_BAR; PG8_SCHED;
            PG8_LDA(At, 1, 1); PG8_STAGE(PG8_SB(1, 0), b3, voffB); PG8_STAGE(PG8_SB(1, 1), b3 + hstep, voffB); PG8_STAGE(PG8_SA(1, 0), a3, voffA);
            PG8_WAIT_V(8); PG8_WAIT_L(0); PG8_BAR; PG8_MMA(1, 0, At, B0); PG8_MMA(1, 1, At, B1); PG8_BAR; PG8_SCHED;
            } else {
            PG8_LDB(B0, 0, 0); PG8_SCHED; PG8_LDA(At, 0, 0); PG8_STAGE(PG8_SA(1, 1), a1 + hstep, voffA);
            PG8_WAIT_L(8); PG8_BAR; PG8_WAIT_L(0); PG8_MMA(0, 0, At, B0); PG8_BAR; PG8_SCHED;
            PG8_LDB(B1, 0, 1); PG8_STAGE(PG8_SB(0, 0), b2, voffB);
            PG8_BAR; PG8_WAIT_L(0); PG8_MMA(0, 1, At, B1); PG8_BAR;
            PG8_LDA(At, 0, 1); PG8_STAGE(PG8_SA(0, 0), a2, voffA);
            PG8_BAR; PG8_WAIT_L(0); PG8_MMA(1, 0, At, B0); PG8_BAR; PG8_SCHED;
            PG8_STAGE(PG8_SB(0, 1), b2 + hstep, voffB);
            PG8_WAIT_V(6); PG8_BAR; PG8_MMA(1, 1, At, B1); PG8_BAR;
            PG8_LDB(B0, 1, 0); PG8_SCHED; PG8_LDA(At, 1, 0); PG8_STAGE(PG8_SA(0, 1), a2 + hstep, voffA);
            PG8_WAIT_L(8); PG8_BAR; PG8_WAIT_L(0); PG8_MMA(0, 0, At, B0); PG8_BAR; PG8_SCHED;
            PG8_LDB(B1, 1, 1); PG8_STAGE(PG8_SB(1, 0), b3, voffB);
            PG8_BAR; PG8_WAIT_L(0); PG8_MMA(0, 1, At, B1); PG8_BAR;
            PG8_LDA(At, 1, 1); PG8_STAGE(PG8_SA(1, 0), a3, voffA);
            PG8_BAR; PG8_WAIT_L(0); PG8_MMA(1, 0, At, B0); PG8_BAR; PG8_SCHED;
            PG8_STAGE(PG8_SB(1, 1), b3 + hstep, voffB);
            PG8_WAIT_V(6); PG8_BAR; PG8_MMA(1, 1, At, B1); PG8_BAR;
            }
        }
        if constexpr (ALIGN_EPI) { if (wr == 0) PG8_BAR; }
        if constexpr (!Epi::AFTER_DRAIN) { E(acc, cur, wr, wc, fr, fq); S.done(cur); }
        if (!has_next) break;
#pragma unroll
        for (int a = 0; a < 2; ++a)
#pragma unroll
            for (int b = 0; b < 2; ++b)
#pragma unroll
                for (int m = 0; m < 4; ++m)
#pragma unroll
                    for (int n = 0; n < 2; ++n) acc[a][b][m][n] = (f32x4){0.f, 0.f, 0.f, 0.f};
        cur = nxt; cA = nA; cB = nB; ++ui;
        if constexpr (ALIGN_EPI) { if (wr == 1) PG8_BAR; }
    }
    PG8_WAIT_V(0);
    if constexpr (!ALIGN_EPI) { if (wr == 0) PG8_BAR; }
    PG8_BAR;
    if constexpr (Epi::AFTER_DRAIN) { E.fused(acc, cur, wr, wc, fr, fq, lds, wid, lane); S.done(cur); }
#undef PG8_SA
#undef PG8_SB
#undef PG8_STAGE
#undef PG8_LDA
#undef PG8_LDB
#undef PG8_MMA
#undef PG8_WAIT_V
#undef PG8_WAIT_L
#undef PG8_BAR
#undef PG8_SCHED
}
}
#define GAS __attribute__((address_space(1)))
#define LAS __attribute__((address_space(3)))
typedef unsigned v4u __attribute__((ext_vector_type(4)));
typedef float f32x4 __attribute__((ext_vector_type(4)));
typedef short bf16x8 __attribute__((ext_vector_type(8)));
typedef GAS unsigned gu32;
typedef GAS unsigned long long gu64;
#define RLX_AGENT __ATOMIC_RELAXED, __HIP_MEMORY_SCOPE_AGENT
#define LDS_WAIT() asm volatile("s_waitcnt lgkmcnt(0)" ::: "memory")
#define VM_WAIT() asm volatile("s_waitcnt vmcnt(0)" ::: "memory")
__device__ __forceinline__ unsigned long long rt() { return __builtin_amdgcn_s_memrealtime(); }

#define XB_TMO      128
#define XB_XCNT(j)  (256  + 64 * (j))
#define XB_XSUB(j)  (1280 + 64 * (j))
#define XB_XGEN(j)  (2304 + 64 * (j))
#define XB_TOP      3328
#define XB_TOPGEN   3392
#define XCD_BAR_WORDS 3456
#define XB_SPIN_CAP (1u << 18)

__device__ __forceinline__ unsigned xb_ld(unsigned* p)              { return __hip_atomic_load(p, __ATOMIC_RELAXED, __HIP_MEMORY_SCOPE_AGENT); }
__device__ __forceinline__ unsigned xb_add(unsigned* p, unsigned v) { return __hip_atomic_fetch_add(p, v, __ATOMIC_RELAXED, __HIP_MEMORY_SCOPE_AGENT); }
__device__ __forceinline__ unsigned xb_xcc_id() { return (unsigned)__builtin_amdgcn_s_getreg((3 << 11) | 20) & 0xFu; }
#define XB_SPIN(cond, bar) do { unsigned _sp = 0; while (cond) { __builtin_amdgcn_s_sleep(1); \
    if ((++_sp & 255u) == 0u) { if (xb_ld(&(bar)[XB_TMO])) break; if (_sp > XB_SPIN_CAP) { atomicAdd(&(bar)[XB_TMO], 1u); break; } } } } while (0)

struct XcdBarrier {
    unsigned* bar; unsigned x;
    volatile LAS unsigned* st;
};

__device__ __forceinline__ XcdBarrier xcd_barrier_post(unsigned* bar, volatile LAS unsigned* st) {
    XcdBarrier b; b.bar = bar; b.x = xb_xcc_id(); b.st = st;
    if (threadIdx.x == 0) (void)xb_add(&bar[XB_XCNT(b.x)], 1u);
    return b;
}
__device__ __forceinline__ void xcd_barrier_complete(unsigned* bar, unsigned x, unsigned& nloc, unsigned& nx) {
    const unsigned G = gridDim.x * gridDim.y * gridDim.z;
    unsigned sum, cnt, mine, sp = 0u;
    for (;;) {
        sum = 0u; cnt = 0u; mine = 0u;
#pragma unroll
        for (unsigned j = 0; j < 16; ++j) { const unsigned c = xb_ld(&bar[XB_XCNT(j)]); sum += c; cnt += (c > 0u) ? 1u : 0u; mine = (j == x) ? c : mine; }
        if (sum == G) break;
        __builtin_amdgcn_s_sleep(1);
        if ((++sp & 255u) == 0u) { if (xb_ld(&bar[XB_TMO])) break; if (sp > XB_SPIN_CAP) { atomicAdd(&bar[XB_TMO], 1u); break; } }
    }
    nloc = mine > 0u ? mine : 1u; nx = cnt > 0u ? cnt : 1u;
}

__device__ __forceinline__ void xcd_barrier(const XcdBarrier& b) {
    asm volatile("s_waitcnt vmcnt(0)" ::: "memory");
    __syncthreads();
    if (threadIdx.x == 0) {
        unsigned* bar = b.bar;
        __builtin_amdgcn_s_waitcnt(0);
        unsigned nloc = b.st[0], nx = b.st[1];
        if (nloc == 0u) { xcd_barrier_complete(bar, b.x, nloc, nx); b.st[0] = nloc; b.st[1] = nx; }
        const unsigned old = xb_add(&bar[XB_XSUB(b.x)], 1u);
        const unsigned gen = old / nloc;
        if (old + 1u == (gen + 1u) * nloc) {
            __builtin_amdgcn_fence(__ATOMIC_RELEASE, "agent");
            asm volatile("s_waitcnt vmcnt(0)" ::: "memory");
            const unsigned og = xb_add(&bar[XB_TOP], 1u);
            const unsigned tg = og / nx;
            if (og + 1u == (tg + 1u) * nx) xb_add(&bar[XB_TOPGEN], 1u);
            else XB_SPIN(xb_ld(&bar[XB_TOPGEN]) == tg, bar);
            __builtin_amdgcn_fence(__ATOMIC_ACQUIRE, "agent");
            xb_add(&bar[XB_XGEN(b.x)], 1u);
            asm volatile("s_waitcnt vmcnt(0)" ::: "memory");
        } else {
            XB_SPIN(xb_ld(&bar[XB_XGEN(b.x)]) == gen, bar);
            __builtin_amdgcn_fence(__ATOMIC_ACQUIRE, "agent");
            asm volatile("s_waitcnt vmcnt(0)" ::: "memory");
        }
    }
    __syncthreads();
}

constexpr int NWAVES = 8;
constexpr int RING_OFF = 0, RING_BYTES = 131072;
constexpr int LDS_BYTES = 163840;
constexpr int LDSCTL_OFF = LDS_BYTES - 512, MISC_OFF = LDSCTL_OFF + 320;
constexpr int CW_BAR = 4096;
constexpr int CW_Q = 16384;
static_assert((CW_BAR + XCD_BAR_WORDS) <= CW_Q && (CW_Q + 64 * 64) * 4 <= (int)CTL_ZERO_BYTES, "CTL words inside the memset region");

constexpr int PROBE_ID = 0;
#define PB_BEGIN(id) long long pb_t0_##id = 0; if (PROBE_ID == (id)) pb_t0_##id = clock64();
#define PB_END(id) if (PROBE_ID == (id)) { const long long t1_ = clock64(), dt_ = t1_ - pb_t0_##id; while (clock64() - t1_ < dt_) __builtin_amdgcn_s_sleep(2); }
struct Frame {
    LAS unsigned char* lds;
    volatile LAS unsigned* MISC;
    gu32* ctl;
    int tid, lane, wave, vcu, G;
    Ins I; float* out;
    bf16 *WinT, *WoutT, *XN, *Q, *K, *V, *AU, *XBC, *Gb, *Zb; float *DT, *SSQ, *RAWB;
};

template <class SrcF>
__device__ __forceinline__ void p0_transpose_item(SrcF src, int k0, int n0, bf16* WT, int dst_pitch, int dst_row0, int dst_k0, LAS float* scr, int lane) {
#pragma unroll 8
    for (int i = 0; i < 32; ++i) { const int kk = 2 * i + (lane >> 5); scr[kk * 33 + (lane & 31)] = src(k0 + kk, n0 + (lane & 31)); }
    LDS_WAIT(); asm volatile("" ::: "memory");
    const int c = lane & 7;
#pragma unroll
    for (int j = 0; j < 4; ++j) { const int n = (lane >> 3) + 8 * j; const LAS float* s = scr + (8 * c) * 33 + n;
        v4u o; o.x = pk2(s[0 * 33], s[1 * 33]); o.y = pk2(s[2 * 33], s[3 * 33]); o.z = pk2(s[4 * 33], s[5 * 33]); o.w = pk2(s[6 * 33], s[7 * 33]);
        *(GAS v4u*)(WT + (size_t)(dst_row0 + n) * dst_pitch + dst_k0 + 8 * c) = o; }
    LDS_WAIT(); asm volatile("" ::: "memory");
}
constexpr int P0_SCR_BYTES = 8448, WDT_OFF = NWAVES * P0_SCR_BYTES, WDT_PITCH = 20;
static_assert(WDT_OFF + 1024 * WDT_PITCH * 4 <= LDSCTL_OFF, "prologue LDS");

__device__ __forceinline__ void p0_prologue(Frame& F) {
    const Ins& I = F.I;
    LAS float* scr = (LAS float*)(F.lds + F.wave * P0_SCR_BYTES);
    LAS float* wdt = (LAS float*)(F.lds + WDT_OFF);
    const int gw = F.vcu * NWAVES + F.wave, NGW = F.G * NWAVES;
    for (int idx = F.tid; idx < 1024 * 16; idx += NWAVES * 64) {
        const int k = idx >> 4, j = idx & 15, pos = (((k >> 8) * 4 + (k & 3)) << 6) + ((k >> 2) & 63);
        wdt[pos * WDT_PITCH + j] = I.w_in[(size_t)k * NPROJ + C_DT + j] * I.norm_w[k];
    }
    constexpr int I_IN = (DM / 64) * (NMAIN / 32), I_OUT = (2048 / 64) * (DM / 32);
    for (int it = gw; it < I_IN + I_OUT; it += NGW) {
        if (it < I_IN) {
            const int nblk = NMAIN / 32, kb = it / nblk, nb = it % nblk, k0 = 64 * kb, n0 = 32 * nb;
            p0_transpose_item([&](int k, int n) { return I.w_in[(size_t)k * NPROJ + n] * I.norm_w[k]; }, k0, n0, F.WinT, DM, (n0 & ~255) + vrow_of_col(n0 & 255), k0, scr, F.lane);
        } else {
            const int r = it - I_IN, nblk = DM / 32, kb = r / nblk, nb = r % nblk, k0 = 64 * kb, n0 = 32 * nb;
            p0_transpose_item([&](int k, int n) { return I.w_out[(size_t)k * DM + n] * (k >= 1024 ? I.ssd_norm_w[k - 1024] : 1.f); }, k0, n0, F.WoutT, 2048, (n0 & ~255) + vrow_of_col(n0 & 255), (k0 + 1024) & 2047, scr, F.lane);
        }
    }
    __syncthreads();
    for (int rp = gw; rp < NROWS / 2; rp += NGW) {
        f32x4 v[2][4]; float rstd[2];
#pragma unroll
        for (int q = 0; q < 2; ++q) {
            const GAS f32x4* xr = (const GAS f32x4*)xrow(I, 2 * rp + q) + F.lane; float s = 0.f;
#pragma unroll
            for (int j = 0; j < 4; ++j) { v[q][j] = xr[64 * j]; s += (v[q][j].x * v[q][j].x + v[q][j].y * v[q][j].y) + (v[q][j].z * v[q][j].z + v[q][j].w * v[q][j].w); }
            rstd[q] = rsqrtf(wave_sum(s) * (1.f / DM) + EPS);
            GAS unsigned long long* o8 = (GAS unsigned long long*)(F.XN + (size_t)(2 * rp + q) * DM) + F.lane;
#pragma unroll
            for (int j = 0; j < 4; ++j) o8[64 * j] = (unsigned long long)pk2(v[q][j].x * rstd[q], v[q][j].y * rstd[q]) | ((unsigned long long)pk2(v[q][j].z * rstd[q], v[q][j].w * rstd[q]) << 32);
        }
        float a[32];
#pragma unroll
        for (int i = 0; i < 32; ++i) a[i] = 0.f;
#pragma unroll
        for (int j = 0; j < 4; ++j)
#pragma unroll
            for (int e = 0; e < 4; ++e) {
                const LAS f32x4* wp = (const LAS f32x4*)(wdt + ((j * 4 + e) * 64 + F.lane) * WDT_PITCH);
                const float x0 = v[0][j][e], x1 = v[1][j][e];
#pragma unroll
                for (int c4 = 0; c4 < 4; ++c4) { const f32x4 w = wp[c4];
#pragma unroll
                    for (int i = 0; i < 4; ++i) { a[c4 * 4 + i] += x0 * w[i]; a[16 + c4 * 4 + i] += x1 * w[i]; } }
                asm volatile("" ::: "memory");
            }
#define P0_HALVE(N, X) { const bool up = (F.lane & (X)) != 0; _Pragma("unroll") for (int i = 0; i < (N); ++i) { const float keep = up ? a[i + (N)] : a[i], send = up ? a[i] : a[i + (N)]; a[i] = keep + __shfl_xor(send, (X)); } }
        P0_HALVE(16, 32) P0_HALVE(8, 16) P0_HALVE(4, 8) P0_HALVE(2, 4) P0_HALVE(1, 2)
#undef P0_HALVE
        float tot = a[0] + __shfl_xor(a[0], 1);
        const int idx = F.lane >> 1, q = idx >> 4, c = idx & 15;
        tot = tot * (q ? rstd[1] : rstd[0]) + I.dt_bias[c];
        if ((F.lane & 1) == 0) F.DT[(size_t)c * MROWS + 2 * rp + q] = softplus_f(tot);
    }
    { v4u* zk = (v4u*)((unsigned char*)F.K - 4 * MiB); v4u* zv = (v4u*)((unsigned char*)F.V - 4 * MiB);
      for (size_t i = (size_t)F.vcu * NWAVES * 64 + F.tid; i < 4 * MiB / 16; i += (size_t)F.G * NWAVES * 64) {
          if (i * 16 >= 4 * MiB - (WS_K - (WS_Q + (size_t)MROWS * DM * 2))) zk[i] = (v4u){0u, 0u, 0u, 0u};
          if (i * 16 >= 4 * MiB - (WS_V - (WS_K + (size_t)MROWS * DM * 2))) zv[i] = (v4u){0u, 0u, 0u, 0u}; } }
    for (int r = NROWS + gw; r < MROWS; r += NGW) { GAS v4u* o = (GAS v4u*)(F.XN + (size_t)r * DM) + F.lane; o[0] = (v4u){0u, 0u, 0u, 0u}; o[64] = (v4u){0u, 0u, 0u, 0u};
                                                   GAS v4u* k = (GAS v4u*)(F.K + (size_t)r * DM) + F.lane; k[0] = (v4u){0u, 0u, 0u, 0u}; k[64] = (v4u){0u, 0u, 0u, 0u}; }
    for (int i = (F.vcu * NWAVES * 64 + F.tid); i < DB * 2 * CONVD; i += F.G * NWAVES * 64) {
        const int c = i % CONVD, rr = i / CONVD, j = rr & 1, b = rr >> 1;
        F.out[O_CS + ((size_t)b * 3 + j) * CONVD + c] = I.sconv[((size_t)b * 3 + j + 1) * CONVD + c];
    }
}

namespace att {
typedef float f32x16 __attribute__((ext_vector_type(16)));
typedef short v4i16_t __attribute__((ext_vector_type(4)));
typedef unsigned u32x4 __attribute__((ext_vector_type(4)));
constexpr int SPAN = 512, NSPAN = SEQ / SPAN, NUNITS = NB * NH * NSPAN;
constexpr int OPITCH = 64  , OACC_OFF = 0, LACC_OFF = SPAN * OPITCH * 4, LUT_OFF = LACC_OFF + 2048, LUTP = 192  , VST_OFF = LUT_OFF + 3072, VST_BYTES = 2048  , ATT_LDS_END = VST_OFF + NWAVES * VST_BYTES;
static_assert(ATT_LDS_END <= LDSCTL_OFF, "attention LDS");
__device__ __forceinline__ int crow(int r, int hi) { return (r & 3) + 8 * (r >> 2) + 4 * hi; }

struct ItemRegs { bf16x8 qf[4]; v4u kreg[4], vreg[4]; unsigned koff, voff; };
__device__ __forceinline__ int first_tile(int tq0, int d) { const int k = (97 * d - tq0 + 32 * d - 1) / (32 * d); return k < 0 ? 0 : (k > 4 ? 4 : k); }
struct ItemOut { f32x16 o0, o1; float lsum; };
#define ATT_LOAD_K(R, KT) do { const char* kb_ = (const char*)Kb + ((long)(tq0 + (-128 + 32 * (KT)) * d) * DM) * 2; \
        _Pragma("unroll") for (int i = 0; i < 4; ++i) (R).kreg[i] = *(const v4u*)(kb_ + (R).koff + (unsigned)((i & 1) * 16 * d * DM * 2) + 64 * (i >> 1)); } while (0)
#define ATT_LOAD_V(R, KT) do { const char* vb_ = (const char*)Vb + ((long)(tq0 + (-128 + 32 * (KT)) * d) * DM) * 2; \
        _Pragma("unroll") for (int i = 0; i < 4; ++i) (R).vreg[i] = *(const v4u*)(vb_ + (R).voff + (unsigned)(i * 8 * d * DM * 2)); } while (0)
template <int NQ>
__device__ __forceinline__ void item_load(ItemRegs& R, const bf16* Qb, const bf16* Kb, const bf16* Vb, int tq0, int d, int lane) {
    const int c = lane & 31, hi = lane >> 5;
    const bf16* qp = Qb + (size_t)(tq0 + (NQ == 32 ? c : (c & 15)) * d) * DM + 8 * hi;
#pragma unroll
    for (int ks = 0; ks < 4; ++ks) R.qf[ks] = *(const bf16x8*)(qp + 16 * ks);
    R.koff = (unsigned)(((lane >> 2) * d * DM + 8 * (lane & 3)) * 2); R.voff = (unsigned)(((lane >> 3) * d * DM + 8 * (lane & 7)) * 2);
    { const int kt0 = 97 * d - tq0 > 0 ? first_tile(tq0, d) : 0; ATT_LOAD_K(R, kt0); ATT_LOAD_V(R, kt0); }
}
template <int NQ>
__device__ __forceinline__ void item_tiles(ItemRegs& R, ItemOut& O, const bf16* Kb, const bf16* Vb, int tq0, int d, int pat, LAS unsigned char* lds, int wave, int lane) {
    const int c = lane & 31, hi = lane >> 5;
    LAS unsigned char* vst = lds + VST_OFF + wave * VST_BYTES;
    const LAS float* lut = (const LAS float*)(lds + LUT_OFF) + pat * LUTP + 31;
    f32x16 o0 = {}, o1 = {};
    float lsum = 0.f;
    const int lrow = lane >> 3, lch = lane & 7;
    const int stoff = lrow * 128 + ((lch ^ lrow) << 4);
    const int kwoff = (lane >> 2) * 64 + (((lane & 3) ^ ((lane >> 4) & 3)) << 4);
    const int q4 = (lane & 15) >> 2, odd = (lane >> 4) & 1, p4 = lane & 3;
#pragma unroll 1
    for (int kt = (97 * d - tq0 > 0 ? first_tile(tq0, d) : 0); kt < 5; ++kt) {
        bf16x8 kf[4];
#pragma unroll
        for (int h2 = 0; h2 < 2; ++h2) {
#pragma unroll
            for (int i = 0; i < 2; ++i) *(LAS v4u*)(vst + i * 1024 + kwoff) = R.kreg[2 * h2 + i];
#pragma unroll
            for (int ksl = 0; ksl < 2; ++ksl) kf[2 * h2 + ksl] = *(const LAS bf16x8*)(vst + c * 64 + (((2 * ksl + hi) ^ ((c >> 2) & 3)) << 4));
        }
        bf16x8 vb[2][2];
#pragma unroll
        for (int s = 0; s < 2; ++s) {
#pragma unroll
            for (int i = 0; i < 2; ++i) *(LAS v4u*)(vst + i * 1024 + stoff) = R.vreg[2 * s + i];
#pragma unroll
            for (int dh = 0; dh < 2; ++dh) {
                const int kr = 4 * hi + q4, ch16 = 4 * dh + 2 * odd + (p4 >> 1);
                const LAS unsigned char* vp0 = vst + kr * 128 + ((ch16 ^ (kr & 7)) << 4) + (p4 & 1) * 8;
                const LAS unsigned char* vp1 = vst + (kr + 8) * 128 + ((ch16 ^ (kr & 7)) << 4) + (p4 & 1) * 8;
                const v4i16_t lo = __builtin_amdgcn_ds_read_tr16_b64_v4i16((LAS v4i16_t*)vp0), hh = __builtin_amdgcn_ds_read_tr16_b64_v4i16((LAS v4i16_t*)vp1);
                vb[s][dh] = (bf16x8){lo[0], lo[1], lo[2], lo[3], hh[0], hh[1], hh[2], hh[3]};
            }
        }
        asm volatile("" ::: "memory");
        if (kt < 4) { ATT_LOAD_K(R, kt + 1); ATT_LOAD_V(R, kt + 1); }
        const int relb = c + 128 - 32 * kt - 4 * hi, tkb = tq0 + (-128 + 32 * kt + 4 * hi) * d;
        const bool edge = tq0 + (-128 + 32 * kt) * d < 0;
        f32x16 st;
        if (edge) {
#pragma unroll
            for (int r = 0; r < 16; ++r) { const int rel = relb - ((r & 3) + 8 * (r >> 2)); st[r] = lut[rel < 0 ? 0 : (rel > 128 ? 128 : rel)]; }
        } else {
#pragma unroll
            for (int r = 0; r < 16; ++r) st[r] = lut[relb - ((r & 3) + 8 * (r >> 2))];
        }
#pragma unroll
        for (int ks = 0; ks < 4; ++ks) st = __builtin_amdgcn_mfma_f32_32x32x16_bf16(kf[ks], R.qf[ks], st, 0, 0, 0);
        if (edge) {
#pragma unroll
            for (int r = 0; r < 16; ++r) {
                const int kk = (r & 3) + 8 * (r >> 2), rel = relb - kk;
                const bool valid = (rel >= 0) && (rel <= 128) && (tkb + kk * d >= 0);
                const float pe = __builtin_amdgcn_exp2f(st[r]), p = valid ? pe : 0.f;
                st[r] = p; lsum += p;
            }
        } else {
#pragma unroll
            for (int r = 0; r < 16; ++r) { const float p = __builtin_amdgcn_exp2f(st[r]); st[r] = p; lsum += p; }
        }
        u32x4 pw0, pw1;
        pw0.x = cvtpk_s(st[0], st[1]); pw0.y = cvtpk_s(st[2], st[3]); pw0.z = cvtpk_s(st[4], st[5]); pw0.w = cvtpk_s(st[6], st[7]);
        pw1.x = cvtpk_s(st[8], st[9]); pw1.y = cvtpk_s(st[10], st[11]); pw1.z = cvtpk_s(st[12], st[13]); pw1.w = cvtpk_s(st[14], st[15]);
        const bf16x8 pa0 = __builtin_bit_cast(bf16x8, pw0), pa1 = __builtin_bit_cast(bf16x8, pw1);
        o0 = __builtin_amdgcn_mfma_f32_32x32x16_bf16(pa0, vb[0][0], o0, 0, 0, 0);
        o1 = __builtin_amdgcn_mfma_f32_32x32x16_bf16(pa0, vb[0][1], o1, 0, 0, 0);
        o0 = __builtin_amdgcn_mfma_f32_32x32x16_bf16(pa1, vb[1][0], o0, 0, 0, 0);
        o1 = __builtin_amdgcn_mfma_f32_32x32x16_bf16(pa1, vb[1][1], o1, 0, 0, 0);
    }
    lsum += __shfl_xor(lsum, 32);
    O.o0 = o0; O.o1 = o1; O.lsum = lsum;
}
template <int NQ, bool ACC>
__device__ __forceinline__ void item_acc(const ItemOut& O, int toff, int d, LAS unsigned char* lds, int lane) {
    const int c = lane & 31, hi = lane >> 5;
    LAS float* oacc = (LAS float*)(lds + OACC_OFF); LAS float* lacc = (LAS float*)(lds + LACC_OFF);
    constexpr int NR = NQ == 32 ? 16 : 8;
    LAS float* base = oacc + (toff + 4 * hi * d) * OPITCH + c;
    float a0[NR], a1[NR], lo = 0.f;
    if (ACC) {
#pragma unroll
        for (int r = 0; r < NR; ++r) { const LAS float* row = base + ((r & 3) + 8 * (r >> 2)) * d * OPITCH; a0[r] = row[0]; a1[r] = row[32]; }
        if (hi == 0 && c < NQ) lo = lacc[toff + c * d];
        asm volatile("" ::: "memory");
    }
#pragma unroll
    for (int r = 0; r < NR; ++r) { LAS float* row = base + ((r & 3) + 8 * (r >> 2)) * d * OPITCH; row[0] = ACC ? a0[r] + O.o0[r] : O.o0[r]; row[32] = ACC ? a1[r] + O.o1[r] : O.o1[r]; }
    if (hi == 0 && c < NQ) lacc[toff + c * d] = ACC ? lo + O.lsum : O.lsum;
}

__device__ __forceinline__ void unit(Frame& F, int uidx, int& lut_h) {
    const int span = uidx % NSPAN, bh = uidx / NSPAN, h = bh % NH, b = bh / NH, t0 = span * SPAN;
    LAS unsigned char* lds = F.lds;
    LAS float* oacc = (LAS float*)(lds + OACC_OFF); LAS float* lacc = (LAS float*)(lds + LACC_OFF); LAS float* lut = (LAS float*)(lds + LUT_OFF);
    const bool newlut = h != lut_h; lut_h = h;
    if (newlut) for (int i = F.tid; i < 3 * LUTP; i += NWAVES * 64) { const int pat = i / LUTP, rel = i - pat * LUTP - 31, d = pat == 0 ? 1 : (pat == 1 ? 4 : 16);
        lut[i] = (rel >= 0 && rel <= 128) ? F.I.rel_bias[t5_bucket(rel * d) * NH + h] * LOG2E : -1e30f; }
    const size_t boff = (size_t)b * SEQ * DM + h * HD;
    const bf16 *Qb = F.Q + boff, *Kb = F.K + boff, *Vb = F.V + boff;
    const int w = F.wave, lane = F.lane;
    ItemRegs R; ItemOut O;
    const int tqA0 = t0 + 64 * w, tqA1 = tqA0 + 32, tqB0 = t0 + (w & 3) + 256 * (w >> 2), tqB1 = tqB0 + 128, tqC0 = t0 + w, tqC1 = t0 + w + 8;
    item_load<32>(R, Qb, Kb, Vb, tqA0, 1, lane);
    if (newlut) __syncthreads();
    item_tiles<32>(R, O, Kb, Vb, tqA0, 1, 0, lds, w, lane);
    item_load<32>(R, Qb, Kb, Vb, tqA1, 1, lane);
    item_acc<32, false>(O, tqA0 - t0, 1, lds, lane);
    item_tiles<32>(R, O, Kb, Vb, tqA1, 1, 0, lds, w, lane);
    item_load<32>(R, Qb, Kb, Vb, tqB0, 4, lane);
    item_acc<32, false>(O, tqA1 - t0, 1, lds, lane);
    __syncthreads();
    item_tiles<32>(R, O, Kb, Vb, tqB0, 4, 1, lds, w, lane);
    item_load<32>(R, Qb, Kb, Vb, tqB1, 4, lane);
    item_acc<32, true>(O, tqB0 - t0, 4, lds, lane);
    item_tiles<32>(R, O, Kb, Vb, tqB1, 4, 1, lds, w, lane);
    item_load<32>(R, Qb, Kb, Vb, tqC0, 16, lane);
    item_acc<32, true>(O, tqB1 - t0, 4, lds, lane);
    __syncthreads();
    item_tiles<32>(R, O, Kb, Vb, tqC0, 16, 2, lds, w, lane);
    item_load<32>(R, Qb, Kb, Vb, tqC1, 16, lane);
    item_acc<32, true>(O, tqC0 - t0, 16, lds, lane);
    item_tiles<32>(R, O, Kb, Vb, tqC1, 16, 2, lds, w, lane);
    item_acc<32, true>(O, tqC1 - t0, 16, lds, lane);
    v4u g[2][4];
#pragma unroll
    for (int ps = 0; ps < 2; ++ps) { const bf16* gp = F.Gb + ((size_t)b * SEQ + t0 + 64 * w + 32 * ps + (lane >> 1)) * DM + h * HD + 32 * (lane & 1);
#pragma unroll
        for (int j4 = 0; j4 < 4; ++j4) g[ps][j4] = *(const v4u*)(gp + 8 * j4); }
    __syncthreads();
#pragma unroll
    for (int ps = 0; ps < 2; ++ps) {
        const int tl = 64 * w + 32 * ps + (lane >> 1), hf = lane & 1;
        bf16* ap = F.AU + ((size_t)b * SEQ + t0 + tl) * 2048 + 1024 + h * HD + 32 * hf;
        const float rl = __builtin_amdgcn_rcpf(lacc[tl]);
        const LAS f32x4* op = (const LAS f32x4*)(oacc + tl * OPITCH + 32 * hf);
#pragma unroll
        for (int j4 = 0; j4 < 4; ++j4) {
            const f32x4 a = op[2 * j4], bq = op[2 * j4 + 1]; const v4u gg = g[ps][j4];
            v4u o;
            o.x = cvtpk_s(a[0] * rl * __uint_as_float(gg.x << 16), a[1] * rl * __uint_as_float(gg.x & 0xffff0000u));
            o.y = cvtpk_s(a[2] * rl * __uint_as_float(gg.y << 16), a[3] * rl * __uint_as_float(gg.y & 0xffff0000u));
            o.z = cvtpk_s(bq[0] * rl * __uint_as_float(gg.z << 16), bq[1] * rl * __uint_as_float(gg.z & 0xffff0000u));
            o.w = cvtpk_s(bq[2] * rl * __uint_as_float(gg.w << 16), bq[3] * rl * __uint_as_float(gg.w & 0xffff0000u));
            *(v4u*)(ap + 8 * j4) = o;
        }
    }
    __syncthreads();
}

}

namespace ssd {
typedef float f32x16 __attribute__((ext_vector_type(16)));
typedef short v4i16_t __attribute__((ext_vector_type(4)));
typedef unsigned u32x2 __attribute__((ext_vector_type(2)));
typedef float f32x2v __attribute__((ext_vector_type(2)));
constexpr int PITCH = 272;
constexpr int BT_OFF = 0, CT_OFF = 34816, G_OFF = 69632, HB_OFF = 104448, XD_OFF = 121856, XH_OFF = 138240, ACS_OFF = 154624, DTL_OFF = ACS_OFF + 512, SSQL_OFF = DTL_OFF + 512  , XW_OFF = SSQL_OFF + 1024  , FW_OFF = XW_OFF + 1280  , SSD_LDS_END = FW_OFF + 5120;
static_assert(SSD_LDS_END <= LDSCTL_OFF, "SSD LDS");
__device__ __forceinline__ int crow(int r, int hi) { return (r & 3) + 8 * (r >> 2) + 4 * hi; }
__device__ __forceinline__ bf16x8 trfrag(const LAS unsigned char* p0, const LAS unsigned char* p1) {
    const v4i16_t lo = __builtin_amdgcn_ds_read_tr16_b64_v4i16((LAS v4i16_t*)p0), hh = __builtin_amdgcn_ds_read_tr16_b64_v4i16((LAS v4i16_t*)p1);
    return (bf16x8){lo[0], lo[1], lo[2], lo[3], hh[0], hh[1], hh[2], hh[3]};
}
__device__ __forceinline__ float bflo(unsigned w) { return __uint_as_float(w << 16); }
__device__ __forceinline__ float bfhi(unsigned w) { return __uint_as_float(w & 0xffff0000u); }

constexpr int NSEG = 2;
__device__ __forceinline__ int seg_begin(int s) { return NSEG == 2 ? (s == 0 ? 0 : (s == 1 ? 32 : 64)) : (s == 0 ? 0 : (s == 1 ? 20 : (s == 2 ? 42 : 64))); }
__device__ __forceinline__ void chain(Frame& F, int item) {
    const Ins& I = F.I;
    const int bg = item / (8 * NSEG), li = item % (8 * NSEG), b = bg >> 1, hd = (bg & 1) * 8 + li / NSEG, seg = li % NSEG, grp = hd >> 3;
    constexpr int NCH = SEQ / 128; const int ch_begin = seg_begin(seg), ch_end = seg_begin(seg + 1);
    const int tid = F.tid, lane = F.lane, w = F.wave, c = lane & 31, hi = lane >> 5;
    LAS unsigned char* lds = F.lds;
    LAS float* acs = (LAS float*)(lds + ACS_OFF); LAS float* dtl = (LAS float*)(lds + DTL_OFF); LAS float* ssql = (LAS float*)(lds + SSQL_OFF);
    const float A = -__expf(I.a_log[hd]), dsk = I.d_skip[hd];
    const size_t row0 = (size_t)b * SEQ;
    for (int i = tid; i < 17408 / 16; i += NWAVES * 64) ((LAS v4u*)(lds + HB_OFF))[i] = (v4u){0u, 0u, 0u, 0u};
    f32x16 hacc = {};
    const int pt = w & 1, jt = w >> 1;
    const int q4 = (lane & 15) >> 2, odd = (lane >> 4) & 1, p4 = lane & 3;
    const int xtr = (8 * hi + q4) * 64 + (16 * odd + 4 * p4) * 2;
    const int xg = tid & 15, xr0 = (tid >> 4) * 4;
    const int fb = tid >> 8, fc = tid & 255;
    for (int i = tid; i < 5 * 64 + 5 * 256; i += NWAVES * 64) {
        if (i < 320) { const int t = i >> 6, e = i & 63; ((LAS float*)(lds + XW_OFF))[i] = t < 4 ? I.conv_w[t * CONVD + hd * 64 + e] : I.conv_b[hd * 64 + e]; }
        else { const int k = i - 320, t = k >> 8, e = k & 255, chn = 1024 + (e < 128 ? grp * 128 + e : 256 + grp * 128 + (e - 128)); ((LAS float*)(lds + FW_OFF))[k] = t < 4 ? I.conv_w[t * CONVD + chn] : I.conv_b[chn]; }
    }
    const int xoff = ((xg >> 3) << 10) + (xg & 7) * 8;
    float dtp0, dtp1; u32x2 xr[7]; v4u bcr[8]; float fxr[6]; u32x2 zr[4];
#define SSD_PREFETCH(T0) do { int t0_ = (T0), tv_ = tid, lv_ = lane; asm volatile("" : "+v"(t0_), "+v"(tv_), "+v"(lv_)); \
        const int xg_ = tv_ & 15, xr0_ = (tv_ >> 4) * 4, fb_ = tv_ >> 8, fc_ = tv_ & 255, fch_ = fc_ < 128 ? grp * 128 + fc_ : 256 + grp * 128 + (fc_ - 128); \
        { const float* dp_ = F.DT + (size_t)hd * MROWS + row0 + t0_ + 2 * lv_; dtp0 = dp_[0]; dtp1 = dp_[1]; } \
        { const bf16* xp_ = F.XBC + (row0 + t0_ + xr0_) * CONVD + hd * 64 + 4 * xg_; \
          _Pragma("unroll") for (int j = 0; j < 7; ++j) xr[j] = (t0_ + xr0_ - 3 + j) >= 0 ? *(const u32x2*)(xp_ + (j - 3) * CONVD) : (u32x2){0u, 0u}; } \
        { const bf16* bp_ = F.XBC + (row0 + t0_ + (tv_ >> 4)) * CONVD + 1024 + grp * 128 + 8 * (tv_ & 15); \
          _Pragma("unroll") for (int k = 0; k < 4; ++k) { bcr[k] = *(const v4u*)(bp_ + (size_t)k * 32 * CONVD); bcr[4 + k] = *(const v4u*)(bp_ + (size_t)k * 32 * CONVD + 256); } } \
        { const size_t blk = (row0 + t0_ + 64 * fb_) >> 6; const bool hasprev = (t0_ + 64 * fb_) > 0; const float* rp_ = F.RAWB + (blk * 6) * 512 + fch_; \
          _Pragma("unroll") for (int j = 0; j < 3; ++j) { fxr[j] = hasprev ? rp_[(j - 6) * 512] : 0.f; fxr[3 + j] = rp_[(3 + j) * 512]; } } \
    } while (0)
#define SSD_PREFETCH_Z(T0) do { int t0_ = (T0), lv_ = lane; asm volatile("" : "+v"(t0_), "+v"(lv_)); \
        const bf16* zp_ = F.Zb + (row0 + t0_ + 32 * jt + (lv_ & 31)) * DM + hd * 64 + 32 * pt + 4 * (lv_ >> 5); \
        _Pragma("unroll") for (int g4 = 0; g4 < 4; ++g4) zr[g4] = *(const u32x2*)(zp_ + 8 * g4); } while (0)
    __syncthreads();
    if (ch_begin > 0) {
        float dq[4]; u32x2 xr2[11]; v4u bcr2[8]; float fxr2[6];
        LAS float* det = (LAS float*)(lds + ACS_OFF);
#define SSD_PRE2_PREFETCH(T0) do { int t0_ = (T0), tv_ = tid, lv_ = lane; asm volatile("" : "+v"(t0_), "+v"(tv_), "+v"(lv_)); \
        const int xg_ = tv_ & 15, xr0_ = (tv_ >> 4) * 8, fb_ = tv_ >> 7, fch_ = grp * 128 + (tv_ & 127); \
        { const float* dp_ = F.DT + (size_t)hd * MROWS + row0 + t0_ + 2 * lv_; dq[0] = dp_[0]; dq[1] = dp_[1]; dq[2] = dp_[128]; dq[3] = dp_[129]; } \
        { const bf16* xp_ = F.XBC + (row0 + t0_ + xr0_) * CONVD + hd * 64 + 4 * xg_; \
          _Pragma("unroll") for (int j = 0; j < 11; ++j) xr2[j] = (t0_ + xr0_ - 3 + j) >= 0 ? *(const u32x2*)(xp_ + (j - 3) * CONVD) : (u32x2){0u, 0u}; } \
        { const bf16* bp_ = F.XBC + (row0 + t0_ + (tv_ >> 4)) * CONVD + 1024 + grp * 128 + 8 * (tv_ & 15); \
          _Pragma("unroll") for (int k = 0; k < 8; ++k) bcr2[k] = *(const v4u*)(bp_ + (size_t)k * 32 * CONVD); } \
        { const size_t blk = (row0 + t0_ + 64 * fb_) >> 6; const bool hasprev = (t0_ + 64 * fb_) > 0; const float* rp_ = F.RAWB + (blk * 6) * 512 + fch_; \
          _Pragma("unroll") for (int j = 0; j < 3; ++j) { fxr2[j] = hasprev ? rp_[(j - 6) * 512] : 0.f; fxr2[3 + j] = rp_[(3 + j) * 512]; } } \
    } while (0)
        SSD_PRE2_PREFETCH(0);
#pragma unroll 1
        for (int cp = 0; cp < ch_begin / 2; ++cp) {
            const int t0 = cp * 256;
            float atot;
            {
                const float v0 = dq[0] * A, v1 = dq[1] * A, v2 = dq[2] * A, v3 = dq[3] * A; float s1 = v0 + v1, s2 = v2 + v3;
#define SSD_DPP_ADD2(S, CTRL, RMASK, BC) S += __builtin_bit_cast(float, __builtin_amdgcn_update_dpp(0, __builtin_bit_cast(int, S), CTRL, RMASK, 0xf, BC))
                SSD_DPP_ADD2(s1, 0x111, 0xf, true); SSD_DPP_ADD2(s1, 0x112, 0xf, true); SSD_DPP_ADD2(s1, 0x114, 0xf, true); SSD_DPP_ADD2(s1, 0x118, 0xf, true); SSD_DPP_ADD2(s1, 0x142, 0xa, false); SSD_DPP_ADD2(s1, 0x143, 0xc, false);
                SSD_DPP_ADD2(s2, 0x111, 0xf, true); SSD_DPP_ADD2(s2, 0x112, 0xf, true); SSD_DPP_ADD2(s2, 0x114, 0xf, true); SSD_DPP_ADD2(s2, 0x118, 0xf, true); SSD_DPP_ADD2(s2, 0x142, 0xa, false); SSD_DPP_ADD2(s2, 0x143, 0xc, false);
#undef SSD_DPP_ADD2
                const float tot1 = __builtin_bit_cast(float, __builtin_amdgcn_readlane(__builtin_bit_cast(int, s1), 63));
                const float tot2 = __builtin_bit_cast(float, __builtin_amdgcn_readlane(__builtin_bit_cast(int, s2), 63));
                atot = tot1 + tot2;
                *(LAS f32x2v*)(det + 2 * lane) = (f32x2v){dq[0] * __expf(atot - (s1 - v1)), dq[1] * __expf(atot - s1)};
                *(LAS f32x2v*)(det + 128 + 2 * lane) = (f32x2v){dq[2] * __expf(tot2 - (s2 - v3)), dq[3] * __expf(tot2 - s2)};
            }
#pragma unroll
            for (int k = 0; k < 8; ++k) { const int row = (tid >> 4) + 32 * k; if ((row & 63) >= 3) *(LAS v4u*)(lds + BT_OFF + row * PITCH + 16 * (tid & 15)) = bcr2[k]; }
            {   const int fb2 = tid >> 7, fc2 = tid & 127;
                LAS unsigned char* dst = lds + BT_OFF + 2 * fc2 + 64 * fb2 * PITCH;
                const LAS float* fwp = (const LAS float*)(lds + FW_OFF) + fc2;
                const float fw0 = fwp[0], fw1 = fwp[256], fw2 = fwp[512], fw3 = fwp[768], fbias = fwp[1024];
#pragma unroll
                for (int j = 0; j < 3; ++j) *(LAS bf16*)(dst + j * PITCH) = (bf16)f2bf(silu_fast(fbias + fw0 * fxr2[j] + fw1 * fxr2[j + 1] + fw2 * fxr2[j + 2] + fw3 * fxr2[j + 3]));
            }
            {
                const LAS f32x4* xwp = (const LAS f32x4*)(lds + XW_OFF) + xg;
                const f32x4 xw0 = xwp[0], xw1 = xwp[16], xw2 = xwp[32], xw3 = xwp[48], xb = xwp[64];
                float xv[11][4];
#pragma unroll
                for (int j = 0; j < 11; ++j) { xv[j][0] = bflo(xr2[j].x); xv[j][1] = bfhi(xr2[j].x); xv[j][2] = bflo(xr2[j].y); xv[j][3] = bfhi(xr2[j].y); }
                const int xr8 = (tid >> 4) * 8;
#pragma unroll
                for (int i = 0; i < 8; ++i) {
                    const int s = xr8 + i; const float de = det[s]; float v[4];
#pragma unroll
                    for (int e = 0; e < 4; ++e) v[e] = silu_fast(xb[e] + xw0[e] * xv[i][e] + xw1[e] * xv[i + 1][e] + xw2[e] * xv[i + 2][e] + xw3[e] * xv[i + 3][e]);
                    *(LAS u32x2*)(lds + G_OFF + ((s >> 4) << 11) + xoff + (s & 15) * 64) = (u32x2){cvtpk_s(v[0] * de, v[1] * de), cvtpk_s(v[2] * de, v[3] * de)};
                }
            }
            asm volatile("" ::: "memory"); __builtin_amdgcn_sched_barrier(0);
            if (cp + 1 < ch_begin / 2) SSD_PRE2_PREFETCH(t0 + 256);
            __syncthreads();
            {   const float ea = __expf(atot);
#pragma unroll
                for (int r = 0; r < 16; ++r) hacc[r] *= ea;
                const int btr = (8 * hi + q4) * PITCH + (32 * jt + 16 * odd + 4 * p4) * 2;
#pragma unroll 4
                for (int ks = 0; ks < 16; ++ks) {
                    const LAS unsigned char* xp = lds + G_OFF + ((ks * 2 + pt) << 10) + xtr;
                    const LAS unsigned char* bp = lds + BT_OFF + 16 * ks * PITCH + btr;
                    hacc = __builtin_amdgcn_mfma_f32_32x32x16_bf16(trfrag(xp, xp + 256), trfrag(bp, bp + 4 * PITCH), hacc, 0, 0, 0);
                }
            }
            __syncthreads();
        }
#undef SSD_PRE2_PREFETCH
#pragma unroll
        for (int r = 0; r < 16; ++r) *(LAS bf16*)(lds + HB_OFF + (32 * pt + crow(r, hi)) * PITCH + (32 * jt + c) * 2) = (bf16)f2bf(hacc[r]);
        __syncthreads();
    }
    SSD_PREFETCH(ch_begin * 128); SSD_PREFETCH_Z(ch_begin * 128);
#pragma unroll 1
    for (int ch = ch_begin; ch < ch_end; ++ch) {
        const int t0 = ch * 128;
        const bool pre = false, prevfull = ch > ch_begin;
        float aend;
        {
            if (w < 2 && prevfull) { F.SSQ[(row0 + t0 - 128 + lane) * 32 + 2 * hd + w] = ssql[128 * w + lane]; F.SSQ[(row0 + t0 - 64 + lane) * 32 + 2 * hd + w] = ssql[128 * w + 64 + lane]; }
            const float v0 = dtp0 * A, v1 = dtp1 * A; float s = v0 + v1;
#define SSD_DPP_ADD(CTRL, RMASK, BC) s += __builtin_bit_cast(float, __builtin_amdgcn_update_dpp(0, __builtin_bit_cast(int, s), CTRL, RMASK, 0xf, BC))
            SSD_DPP_ADD(0x111, 0xf, true); SSD_DPP_ADD(0x112, 0xf, true); SSD_DPP_ADD(0x114, 0xf, true); SSD_DPP_ADD(0x118, 0xf, true);
            SSD_DPP_ADD(0x142, 0xa, false); SSD_DPP_ADD(0x143, 0xc, false);
#undef SSD_DPP_ADD
            aend = __builtin_bit_cast(float, __builtin_amdgcn_readlane(__builtin_bit_cast(int, s), 63));
            *(LAS f32x2v*)(acs + 2 * lane) = (f32x2v){s - v1, s}; *(LAS f32x2v*)(dtl + 2 * lane) = (f32x2v){dtp0, dtp1};
        }
#pragma unroll
        for (int k = 0; k < 4; ++k) { const int idx = tid + 512 * k, row = idx >> 4;
            if ((row & 63) >= 3) { *(LAS v4u*)(lds + BT_OFF + row * PITCH + 16 * (idx & 15)) = bcr[k]; if (!pre) *(LAS v4u*)(lds + CT_OFF + row * PITCH + 16 * (idx & 15)) = bcr[4 + k]; } }
        if (!pre || fc < 128) {
            LAS unsigned char* dst = lds + (fc < 128 ? BT_OFF + 2 * fc : CT_OFF + 2 * (fc - 128)) + 64 * fb * PITCH;
            const LAS float* fwp = (const LAS float*)(lds + FW_OFF) + fc;
            const float fw0 = fwp[0], fw1 = fwp[256], fw2 = fwp[512], fw3 = fwp[768], fbias = fwp[1024];
#pragma unroll
            for (int j = 0; j < 3; ++j) *(LAS bf16*)(dst + j * PITCH) = (bf16)f2bf(silu_fast(fbias + fw0 * fxr[j] + fw1 * fxr[j + 1] + fw2 * fxr[j + 2] + fw3 * fxr[j + 3]));
        }
        {
            const LAS f32x4* xwp = (const LAS f32x4*)(lds + XW_OFF) + xg;
            const f32x4 xw0 = xwp[0], xw1 = xwp[16], xw2 = xwp[32], xw3 = xwp[48], xb = xwp[64];
            float xv[7][4];
#pragma unroll
            for (int j = 0; j < 7; ++j) { xv[j][0] = bflo(xr[j].x); xv[j][1] = bfhi(xr[j].x); xv[j][2] = bflo(xr[j].y); xv[j][3] = bfhi(xr[j].y); }
#pragma unroll
            for (int i = 0; i < 4; ++i) {
                const int s = xr0 + i; const float dt = dtl[s], de = dt * __expf(aend - acs[s]); float v[4];
#pragma unroll
                for (int e = 0; e < 4; ++e) v[e] = silu_fast(xb[e] + xw0[e] * xv[i][e] + xw1[e] * xv[i + 1][e] + xw2[e] * xv[i + 2][e] + xw3[e] * xv[i + 3][e]);
                const int off = ((s >> 4) << 11) + xoff + (s & 15) * 64;
                if (!pre) *(LAS u32x2*)(lds + XD_OFF + off) = (u32x2){cvtpk_s(v[0] * dt, v[1] * dt), cvtpk_s(v[2] * dt, v[3] * dt)};
                *(LAS u32x2*)(lds + XH_OFF + off) = (u32x2){cvtpk_s(v[0] * de, v[1] * de), cvtpk_s(v[2] * de, v[3] * de)};
            }
        }
        asm volatile("" ::: "memory"); __builtin_amdgcn_sched_barrier(0);
        if (ch + 1 < ch_end) SSD_PREFETCH(t0 + 128);
        __syncthreads();
        f32x16 yt = {};
        if (!pre) {
        {
            const int j = w & 3; const float al = acs[32 * j + c];
#pragma unroll
            for (int ii = 0; ii < 2; ++ii) {
                const int i = 2 * (w >> 2) + ii;
                if (i <= j) {
                    f32x16 x = {};
                    const LAS unsigned char* ap = lds + BT_OFF + (32 * i + c) * PITCH + 16 * hi;
                    const LAS unsigned char* bp = lds + CT_OFF + (32 * j + c) * PITCH + 16 * hi;
#pragma unroll 4
                    for (int ks = 0; ks < 8; ++ks) x = __builtin_amdgcn_mfma_f32_32x32x16_bf16(*(const LAS bf16x8*)(ap + 32 * ks), *(const LAS bf16x8*)(bp + 32 * ks), x, 0, 0, 0);
                    const int l = 32 * j + c;
#pragma unroll
                    for (int g4 = 0; g4 < 4; ++g4) {
                        const int sb = 32 * i + 8 * g4 + 4 * hi; float gv[4];
                        const f32x4 as4 = *(const LAS f32x4*)(acs + sb);
#pragma unroll
                        for (int e = 0; e < 4; ++e) { const int s = sb + e; gv[e] = s <= l ? x[4 * g4 + e] * __builtin_amdgcn_exp2f((al - as4[e]) * LOG2E) : 0.f; }
                        *(LAS u32x2*)(lds + G_OFF + l * PITCH + sb * 2) = (u32x2){cvtpk_s(gv[0], gv[1]), cvtpk_s(gv[2], gv[3])};
                    }
                }
            }
        }
        {
            const LAS unsigned char* ap = lds + HB_OFF + (32 * pt + c) * PITCH + 16 * hi;
            const LAS unsigned char* bp = lds + CT_OFF + (32 * jt + c) * PITCH + 16 * hi;
#pragma unroll 4
            for (int ks = 0; ks < 8; ++ks) yt = __builtin_amdgcn_mfma_f32_32x32x16_bf16(*(const LAS bf16x8*)(ap + 32 * ks), *(const LAS bf16x8*)(bp + 32 * ks), yt, 0, 0, 0);
            const float el = __expf(acs[32 * jt + c]);
#pragma unroll
            for (int r = 0; r < 16; ++r) yt[r] *= el;
        }
        __syncthreads();
        {
            const LAS unsigned char* bp = lds + G_OFF + (32 * jt + c) * PITCH + 16 * hi;
            for (int ks = 0; ks < 2 * jt + 2; ++ks) {
                const LAS unsigned char* xp = lds + XD_OFF + ((ks * 2 + pt) << 10) + xtr;
                yt = __builtin_amdgcn_mfma_f32_32x32x16_bf16(trfrag(xp, xp + 256), *(const LAS bf16x8*)(bp + 32 * ks), yt, 0, 0, 0);
            }
        }
        }
        {
            const float ea = __expf(aend);
#pragma unroll
            for (int r = 0; r < 16; ++r) hacc[r] *= ea;
            const int btr = (8 * hi + q4) * PITCH + (32 * jt + 16 * odd + 4 * p4) * 2;
#pragma unroll 4
            for (int ks = 0; ks < 8; ++ks) {
                const LAS unsigned char* xp = lds + XH_OFF + ((ks * 2 + pt) << 10) + xtr;
                const LAS unsigned char* bp = lds + BT_OFF + 16 * ks * PITCH + btr;
                hacc = __builtin_amdgcn_mfma_f32_32x32x16_bf16(trfrag(xp, xp + 256), trfrag(bp, bp + 4 * PITCH), hacc, 0, 0, 0);
            }
        }
        {
#pragma unroll
            for (int r = 0; r < 16; r += 2) {
                *(LAS bf16*)(lds + HB_OFF + (32 * pt + crow(r, hi)) * PITCH + (32 * jt + c) * 2) = (bf16)(cvtpk_s(hacc[r], hacc[r + 1]) & 0xffffu);
                *(LAS bf16*)(lds + HB_OFF + (32 * pt + crow(r + 1, hi)) * PITCH + (32 * jt + c) * 2) = (bf16)(cvtpk_s(hacc[r], hacc[r + 1]) >> 16);
            }
        }
        if (!pre) {
            const int l = 32 * jt + c; const float rdt = dsk * __builtin_amdgcn_rcpf(dtl[l]);
            bf16* up = F.AU + (row0 + t0 + l) * 2048 + hd * 64 + 32 * pt;
            float sq = 0.f;
#pragma unroll
            for (int g4 = 0; g4 < 4; ++g4) {
                const int pl = 8 * g4 + 4 * hi;
                const u32x2 xw2 = *(const LAS u32x2*)(lds + XD_OFF + (((l >> 4) * 2 + pt) << 10) + (l & 15) * 64 + pl * 2);
                const u32x2 zw = zr[g4];
                const float u0 = (yt[4 * g4] + rdt * bflo(xw2.x)) * bflo(zw.x), u1 = (yt[4 * g4 + 1] + rdt * bfhi(xw2.x)) * bfhi(zw.x), u2 = (yt[4 * g4 + 2] + rdt * bflo(xw2.y)) * bflo(zw.y), u3 = (yt[4 * g4 + 3] + rdt * bfhi(xw2.y)) * bfhi(zw.y);
                sq += (u0 * u0 + u1 * u1) + (u2 * u2 + u3 * u3);
                *(u32x2*)(up + pl) = (u32x2){cvtpk_s(u0, u1), cvtpk_s(u2, u3)};
            }
            sq += __shfl_xor(sq, 32);
            if (hi == 0) ssql[128 * pt + l] = sq;
        }
        if (ch + 1 < ch_end) SSD_PREFETCH_Z(t0 + 128);
        __syncthreads();
    }
#undef SSD_PREFETCH
#undef SSD_PREFETCH_Z
    if (w < 2) { const int t0 = ch_end * 128; F.SSQ[(row0 + t0 - 128 + lane) * 32 + 2 * hd + w] = ssql[128 * w + lane]; F.SSQ[(row0 + t0 - 64 + lane) * 32 + 2 * hd + w] = ssql[128 * w + 64 + lane]; }
    if (seg == NSEG - 1) {
    float* ho = F.out + O_HP + (((size_t)b * NH + hd) * HD + 32 * pt) * DS + 32 * jt + c;
#pragma unroll
    for (int r = 0; r < 16; ++r) ho[(size_t)crow(r, hi) * DS] = hacc[r];
    }
    __syncthreads();
}
}

namespace smp {
__device__ __forceinline__ void attn_unit(Frame& F, int bhs) {
    const Ins& I = F.I;
    const int lane = F.lane, w = F.wave, b = bhs >> 4, h = bhs & 15, r = NTOK + b;
    LAS float* qs = (LAS float*)(F.lds + 4096); LAS float* acc = (LAS float*)F.lds;
    LAS float* ps = (LAS float*)(F.lds + 8192) + w * 64;
    if (F.tid < 64) qs[F.tid] = bf2f(F.Q[(size_t)r * DM + h * HD + F.tid]);
    if (F.tid < 65) acc[F.tid] = 0.f;
    const int k0 = 49 * w, nk = (387 - k0) < 49 ? (387 - k0) : 49;
    const float gate = bf2f(F.Gb[(size_t)r * DM + h * HD + lane]);
    const float vnew = bf2f(F.V[(size_t)r * DM + h * HD + lane]), knew = bf2f(F.K[(size_t)r * DM + h * HD + lane]);
    const float* vbase = I.cv + ((size_t)b * WIN * NH + h) * HD + lane;
    float vv[49];
#pragma unroll
    for (int k = 0; k < 49; ++k) {
        const int idx = (k0 + k) < 386 ? (k0 + k) : 386, pat = idx / 129, j = idx - pat * 129, d = pat == 0 ? 1 : (pat == 1 ? 4 : 16), jj = j > 0 ? j : 1;
        vv[k] = vbase[(size_t)(WIN - jj * d) * (NH * HD)];
    }
    const int idx = (k0 + lane) < 386 ? (k0 + lane) : 386, pat = idx / 129, j = idx - pat * 129, d = pat == 0 ? 1 : (pat == 1 ? 4 : 16), jj = j > 0 ? j : 1;
    const float bias = I.rel_bias[t5_bucket(j * d) * NH + h] * LOG2E;
    f32x4 kv[16];
    { const f32x4* kp = (const f32x4*)(I.ck + (((size_t)b * WIN + (WIN - jj * d)) * NH + h) * HD);
#pragma unroll
      for (int e = 0; e < 16; ++e) kv[e] = kp[e]; }
    __syncthreads();
    const float snew = wave_sum(qs[lane] * knew);
    float s = 0.f;
#pragma unroll
    for (int e = 0; e < 16; ++e) { const f32x4 qv = *(const LAS f32x4*)(qs + 4 * e); s += (qv[0] * kv[e][0] + qv[1] * kv[e][1]) + (qv[2] * kv[e][2] + qv[3] * kv[e][3]); }
    const float p = lane < nk ? __builtin_amdgcn_exp2f((j > 0 ? s : snew) + bias) : 0.f;
    ps[lane] = p;
    const float lsum = wave_sum(p);
    __builtin_amdgcn_wave_barrier();
    float o0 = 0.f, o1 = 0.f, o2 = 0.f, o3 = 0.f;
#define SMP_V(K) ({ const int idx_ = (k0 + (K)) < 386 ? (k0 + (K)) : 386; ps[(K)] * ((idx_ % 129) > 0 ? vv[(K)] : vnew); })
#pragma unroll
    for (int k = 0; k < 48; k += 4) { o0 += SMP_V(k); o1 += SMP_V(k + 1); o2 += SMP_V(k + 2); o3 += SMP_V(k + 3); }
    o0 += SMP_V(48);
#undef SMP_V
    __hip_atomic_fetch_add(acc + lane, (o0 + o1) + (o2 + o3), __ATOMIC_RELAXED, __HIP_MEMORY_SCOPE_WORKGROUP);
    if (lane == 0) __hip_atomic_fetch_add(acc + 64, lsum, __ATOMIC_RELAXED, __HIP_MEMORY_SCOPE_WORKGROUP);
    __syncthreads();
    if (w == 0) F.AU[(size_t)r * 2048 + 1024 + h * HD + lane] = (bf16)f2bf(acc[lane] * __builtin_amdgcn_rcpf(acc[64]) * gate);
    __syncthreads();
}

__device__ __forceinline__ void ssd_unit(Frame& F, int bhs) {
    const Ins& I = F.I;
    LAS float* xs_l = (LAS float*)F.lds; LAS float* B_l = xs_l + 64; LAS float* C_l = B_l + 128; LAS float* ssq_l = C_l + 128;
    const int tid = F.tid, p = tid >> 3, ng = tid & 7;
    const int b = bhs >> 4, hd = bhs & 15, grp = hd >> 3; const size_t r = (size_t)NTOK + b;
    float h[16];
    { const f32x4* hp = (const f32x4*)(I.sssm + (((size_t)b * NH + hd) * HD + p) * DS + ng * 16);
#pragma unroll
      for (int i = 0; i < 4; ++i) { const f32x4 v = hp[i]; h[4 * i] = v[0]; h[4 * i + 1] = v[1]; h[4 * i + 2] = v[2]; h[4 * i + 3] = v[3]; } }
    if (tid < 320) {
        const int ci = tid, c = ci < 64 ? hd * 64 + ci : (ci < 192 ? 1024 + grp * 128 + (ci - 64) : 1280 + grp * 128 + (ci - 192));
        float v = I.conv_b[c];
#pragma unroll
        for (int i = 0; i < 3; ++i) v += I.sconv[((size_t)b * 3 + i) * CONVD + c] * I.conv_w[i * CONVD + c];
        v += bf2f(F.XBC[r * CONVD + c]) * I.conv_w[3 * CONVD + c];
        xs_l[ci] = silu_f(v);
    }
    if (tid == 0) ssq_l[0] = 0.f;
    const float dt = F.DT[(size_t)hd * MROWS + r], A = -__expf(I.a_log[hd]), dsk = I.d_skip[hd], zg = bf2f(F.Zb[r * DM + hd * 64 + p]);
    __syncthreads();
    const float x = xs_l[p], dec = __expf(dt * A), xdt = x * dt;
    float y = 0.f;
#pragma unroll
    for (int i = 0; i < 16; ++i) { h[i] = h[i] * dec + xdt * B_l[ng * 16 + i]; y += h[i] * C_l[ng * 16 + i]; }
    y += __shfl_xor(y, 1); y += __shfl_xor(y, 2); y += __shfl_xor(y, 4);
    if (ng == 0) {
        const float u = (y + dsk * x) * zg;
        F.AU[r * 2048 + hd * 64 + p] = (bf16)f2bf(u);
        __hip_atomic_fetch_add(ssq_l, u * u, __ATOMIC_RELAXED, __HIP_MEMORY_SCOPE_WORKGROUP);
    }
    { f32x4* ho = (f32x4*)(F.out + O_HS + (((size_t)b * NH + hd) * HD + p) * DS + ng * 16);
#pragma unroll
      for (int i = 0; i < 4; ++i) ho[i] = (f32x4){h[4 * i], h[4 * i + 1], h[4 * i + 2], h[4 * i + 3]}; }
    __syncthreads();
    if (tid == 0) { F.SSQ[r * 32 + 2 * hd] = ssq_l[0]; F.SSQ[r * 32 + 2 * hd + 1] = 0.f; }
    __syncthreads();
}
}

namespace smp {
typedef float f32x16s __attribute__((ext_vector_type(16)));
template <int KS>
__device__ __forceinline__ void mm32x32(Frame& F, const bf16* WT, int wrow0, const bf16* A, int apitch, int K) {
    const int lane = F.lane, w = F.wave, c = lane & 31, hi = lane >> 5;
    const bf16* ap = WT + (size_t)(wrow0 + c) * K + w * (16 * KS) + 8 * hi;
    const bf16* bp = A + (size_t)c * apitch + w * (16 * KS) + 8 * hi;
    bf16x8 af[KS], bf[KS];
#pragma unroll
    for (int ks = 0; ks < KS; ++ks) { af[ks] = *(const bf16x8*)(ap + 16 * ks); bf[ks] = *(const bf16x8*)(bp + 16 * ks); }
    f32x16s acc = {};
#pragma unroll
    for (int ks = 0; ks < KS; ++ks) acc = __builtin_amdgcn_mfma_f32_32x32x16_bf16(af[ks], bf[ks], acc, 0, 0, 0);
    LAS float* red = (LAS float*)F.lds + w * 1024;
#pragma unroll
    for (int r = 0; r < 16; ++r) red[((r & 3) + 8 * (r >> 2) + 4 * hi) * 32 + c] = acc[r];
    __syncthreads();
}
__device__ __forceinline__ void inproj_pair(Frame& F, int hp) {
    const Ins& I = F.I;
    const int a0 = 64 * hp;
    LAS float* val = (LAS float*)(F.lds + 32768);
    const int lane = F.lane, w = F.wave;
#pragma unroll 1
    for (int hf = 0; hf < 2; ++hf) {
        const int a = a0 + 32 * hf;
        mm32x32<8>(F, F.WinT, (a & ~255) + vrow_of_col(a & 255), F.XN + (size_t)NTOK * DM, DM, DM);
        const LAS float* red = (const LAS float*)F.lds;
        { const int col = F.tid >> 4, r0 = 2 * (F.tid & 15); float s0 = 0.f, s1 = 0.f;
#pragma unroll
          for (int k = 0; k < 8; ++k) { s0 += red[k * 1024 + col * 32 + r0]; s1 += red[k * 1024 + col * 32 + r0 + 1]; }
          val[r0 * 64 + 32 * hf + col] = s0; val[(r0 + 1) * 64 + 32 * hf + col] = s1; }
        __syncthreads();
    }
#pragma unroll 1
    for (int rr = 0; rr < 4; ++rr) {
        const int r = 4 * w + rr;
        const float v = val[r * 64 + lane];
        const size_t row = (size_t)NTOK + r; const int col = a0 + lane;
        if (col < C_V) {
            const float sc = rsqrtf(wave_sum(v * v) * (1.f / 64.f) + EPS);
            if (col < C_K) F.Q[row * DM + col] = (bf16)f2bf(v * sc * I.qnw[lane] * QSCALE);
            else { const float kv = v * sc * I.knw[lane]; F.K[row * DM + col - C_K] = (bf16)f2bf(kv); F.out[O_KS + (size_t)r * DM + col - C_K] = kv; }
        } else if (col < C_G) { F.V[row * DM + col - C_V] = (bf16)f2bf(v); F.out[O_VS + (size_t)r * DM + col - C_V] = v; }
        else if (col < C_Z) F.Gb[row * DM + col - C_G] = (bf16)f2bf(silu_fast(v));
        else if (col < C_XBC) F.Zb[row * DM + col - C_Z] = (bf16)f2bf(silu_fast(v));
        else { F.XBC[row * CONVD + col - C_XBC] = (bf16)f2bf(v); F.out[O_CS + ((size_t)r * 3 + 2) * CONVD + col - C_XBC] = v; }
    }
    __syncthreads();
}
__device__ __forceinline__ void outproj_unit(Frame& F, int ct) {
    const Ins& I = F.I;
    const int a0 = 32 * ct;
    mm32x32<16>(F, F.WoutT, (a0 & ~255) + vrow_of_col(a0 & 255), F.AU + (size_t)NTOK * 2048, 2048, 2048);
    const LAS float* red = (const LAS float*)F.lds;
    const int col = F.tid >> 4, r0 = 2 * (F.tid & 15);
#pragma unroll
    for (int q = 0; q < 2; ++q) {
        const int r = r0 + q; float su = 0.f, sa = 0.f;
#pragma unroll
        for (int k = 0; k < 4; ++k) { su += red[k * 1024 + col * 32 + r]; sa += red[(4 + k) * 1024 + col * 32 + r]; }
        const f32x4* sp = (const f32x4*)(F.SSQ + ((size_t)NTOK + r) * 32); float s = 0.f;
#pragma unroll
        for (int i = 0; i < 8; ++i) { const f32x4 t = sp[i]; s += (t[0] + t[1]) + (t[2] + t[3]); }
        F.out[O_YS + (size_t)r * DM + a0 + col] = I.xs[(size_t)r * DM + a0 + col] + su * rsqrtf(s * (1.f / 1024.f) + EPS) + sa;
    }
    __syncthreads();
}
}

__device__ __forceinline__ void phase2_queue(Frame& F, int qset) {
    const unsigned x = xb_xcc_id() & 7u;
    constexpr int PER_Q = att::NUNITS / 8;
    int lut_h = -1;
    for (unsigned k = 0; k < 8; ++k) {
        const unsigned qx = (x + k) & 7u;
        gu32* qw = F.ctl + CW_Q + 64 * (8 * qset + qx);
        if (k == 1) {
            if (F.tid < 8) F.MISC[24 + F.tid] = __hip_atomic_load(F.ctl + CW_Q + 64 * (8 * qset + F.tid), RLX_AGENT);
            __syncthreads();
        }
        if (k >= 1 && F.MISC[24 + qx] >= (unsigned)(PER_Q + 128)) continue;
        if (F.tid == 0) F.MISC[16] = __hip_atomic_fetch_add(qw, 1u, RLX_AGENT);
        __syncthreads();
        unsigned idx = F.MISC[16];
        while (idx < (unsigned)(PER_Q + 128)) {
            unsigned nxt = 0u;
            if (F.tid == 0) nxt = __hip_atomic_fetch_add(qw, 1u, RLX_AGENT);
            if (idx < (unsigned)PER_Q) { att::unit(F, (int)(qx * PER_Q + idx), lut_h); }
            else if (idx < (unsigned)(PER_Q + 64)) smp::attn_unit(F, (int)(qx * 64 + idx - PER_Q));
            else smp::ssd_unit(F, (int)(qx * 64 + idx - PER_Q - 64));
            if (F.tid == 0) F.MISC[16] = nxt;
            __syncthreads();
            idx = F.MISC[16];
        }
        __syncthreads();
    }
}

constexpr int PROBE_REP_SSD = 1, PROBE_REP_ATT = 1;
struct Args { Ins in; float* out; unsigned char* ws; int ph_lo, ph_hi; };
__global__ void __launch_bounds__(NWAVES * 64, 2) mk_fwd(Args args) {
    extern __shared__ __attribute__((aligned(16))) unsigned char lds[];
    Frame F;
    F.lds = (LAS unsigned char*)lds;
    F.MISC = (volatile LAS unsigned*)(F.lds + MISC_OFF);
    F.tid = threadIdx.x; F.lane = F.tid & 63; F.wave = __builtin_amdgcn_readfirstlane(F.tid >> 6);
    F.G = gridDim.x; { const int bx = blockIdx.x; F.vcu = (F.G % 8 == 0) ? (bx % 8) * (F.G / 8) + bx / 8 : bx; }
    unsigned char* ws = args.ws;
    F.ctl = (gu32*)(ws + WS_CTL); F.I = args.in; F.out = args.out;
    F.WinT = (bf16*)(ws + WS_WIN); F.WoutT = (bf16*)(ws + WS_WOUT); F.XN = (bf16*)(ws + WS_XN); F.Q = (bf16*)(ws + WS_Q); F.K = (bf16*)(ws + WS_K); F.V = (bf16*)(ws + WS_V);
    F.AU = (bf16*)(ws + WS_AU); F.XBC = (bf16*)(ws + WS_XBC); F.DT = (float*)(ws + WS_DT); F.SSQ = (float*)(ws + WS_SSQ); F.RAWB = (float*)(ws + WS_RAWB); F.Gb = (bf16*)(ws + WS_G); F.Zb = (bf16*)(ws + WS_Z);
    for (int u = F.tid; u < (LDS_BYTES - LDSCTL_OFF) / 4; u += NWAVES * 64) ((LAS unsigned*)(F.lds + LDSCTL_OFF))[u] = 0u;
    __syncthreads();
    XcdBarrier bar = xcd_barrier_post((unsigned*)(F.ctl + CW_BAR), F.MISC + 8);
    const int lo = args.ph_lo, hi = args.ph_hi;
#define IN(k) (lo <= (k) && (k) < hi)
#define BOTH(k) (IN(k) && IN((k) + 1))
    if (IN(0)) { p0_prologue(F); if (BOTH(0)) xcd_barrier(bar); }
    if (IN(1)) {
        __syncthreads();
        pg8::Gemm g{F.XN, F.WinT, NTOK, NMAIN, DM}; pg8::StaticOrder S; S.init(NTOK, NMAIN, F.G, (int)blockIdx.x);
        pg8::EpiIn E{F.Q, F.K, F.V, F.Gb, F.Zb, F.XBC, F.out, F.I.qnw, F.I.knw, F.I.conv_w, F.I.conv_b, F.RAWB};
        pg8::gemm_phase<pg8::EpiIn, pg8::StaticOrder, true, true>(F.lds + RING_OFF, g, S, E);
        __syncthreads();
        for (int hp = F.vcu; hp < NMAIN / 64; hp += F.G) smp::inproj_pair(F, hp);
        if (BOTH(1)) xcd_barrier(bar);
    }
    if (IN(2)) { __syncthreads(); if ((F.vcu & 31) < 8 * ssd::NSEG && (F.vcu >> 5) < 8) { ssd::chain(F, (F.vcu >> 5) * (8 * ssd::NSEG) + (F.vcu & 31)); if (PROBE_ID == 30 && (F.vcu & 1)) { const unsigned long long t0_ = __builtin_amdgcn_s_memrealtime(); while (__builtin_amdgcn_s_memrealtime() - t0_ < 10000ull) __builtin_amdgcn_s_sleep(8); } } for (int rep = 0; rep < PROBE_REP_ATT; ++rep) phase2_queue(F, rep);     if (BOTH(2)) xcd_barrier(bar); }
    if (IN(3)) {
        __syncthreads();
        pg8::Gemm g{F.AU, F.WoutT, NTOK, DM, 2048}; pg8::StaticOrder S; S.init(NTOK, DM, F.G, (int)blockIdx.x);
        LAS float* rs = (LAS float*)(F.lds + RING_BYTES);
        { pg8::Unit u;
          for (int ui = 0; ui < 4 && S.next(ui, u); ++ui)
              for (int r = F.tid; r < 256; r += NWAVES * 64) {
                  const f32x4* sp = (const f32x4*)(F.SSQ + (size_t)(u.pm * 256 + r) * 32);
                  float s = 0.f;
#pragma unroll
                  for (int q = 0; q < 8; ++q) { const f32x4 v = sp[q]; s += (v[0] + v[1]) + (v[2] + v[3]); }
                  rs[ui * 256 + r] = rsqrtf(s * (1.f / 1024.f) + EPS);
              }
          __syncthreads(); }
        pg8::EpiOut E{F.I.xp, F.I.xs, rs, F.out};
        pg8::gemm_phase<pg8::EpiOut, pg8::StaticOrder, true, true>(F.lds + RING_OFF, g, S, E);
        __syncthreads();
        for (int ct = F.G - 1 - F.vcu; ct >= 0 && ct < DM / 32; ct += F.G) smp::outproj_unit(F, ct);
    }
#undef IN
#undef BOTH
}

extern "C" void kernel_launch(void* const* d_in, const int* in_sizes, int n_in, void* d_out, int out_size, void* d_ws, size_t ws_size, hipStream_t stream) {
    static int grid = 0;
    if (grid == 0) {
        if (n_in != 18 || out_size != (int)O_END || ws_size < WS_END) { fprintf(stderr, "kernel_launch: unexpected n_in %d / out_size %d / ws_size %zu; nothing launched\n", n_in, out_size, ws_size); grid = -1; return; }
        int dev = 0, cus = 0;
        if (hipGetDevice(&dev) != hipSuccess || hipDeviceGetAttribute(&cus, hipDeviceAttributeMultiprocessorCount, dev) != hipSuccess) { grid = -1; return; }
        if (hipFuncSetAttribute((const void*)mk_fwd, hipFuncAttributeMaxDynamicSharedMemorySize, LDS_BYTES) != hipSuccess) { fprintf(stderr, "kernel_launch: hipFuncSetAttribute failed\n"); grid = -1; return; }
        (void)hipGetLastError();
        grid = cus;
    }
    if (grid < 0) return;
    (void)hipMemsetAsync((char*)d_ws + WS_CTL, 0, CTL_ZERO_BYTES, stream);
    Args a{};
    const float** ip = (const float**)&a.in;
    for (int i = 0; i < 18; ++i) ip[i] = (const float*)d_in[i];
    a.out = (float*)d_out; a.ws = (unsigned char*)d_ws;
    a.ph_lo = 0; a.ph_hi = 4;
    hipLaunchKernelGGL(mk_fwd, dim3(grid), dim3(NWAVES * 64), LDS_BYTES, stream, a);
}
```

```cpp
#include <hip/hip_runtime.h>
#include <cstdio>
#include <cstdint>

constexpr int DM = 1024, NB = 4, SEQ = 8192, DB = 32, WIN = 2048;
constexpr int NPROJ = 6672, NMAIN = 6656, NTOK = NB * SEQ, NROWS = NTOK + DB;
constexpr int MROWS = 33024;
constexpr int C_Q = 0, C_K = 1024, C_V = 2048, C_G = 3072, C_Z = 4096, C_XBC = 5120, C_DT = 6656;
constexpr int CONVD = 1536, NH = 16, HD = 64, DS = 128;
constexpr float EPS = 1e-6f;
constexpr float QSCALE = 0.125f * 1.4426950408889634f;
constexpr float LOG2E = 1.4426950408889634f;
constexpr size_t O_YP = 0, O_YS = O_YP + (size_t)NTOK * DM, O_KP = O_YS + (size_t)DB * DM, O_VP = O_KP + (size_t)NB * WIN * DM,
                 O_CP = O_VP + (size_t)NB * WIN * DM, O_HP = O_CP + (size_t)NB * 3 * CONVD, O_KS = O_HP + (size_t)NB * NH * HD * DS,
                 O_VS = O_KS + (size_t)DB * DM, O_CS = O_VS + (size_t)DB * DM, O_HS = O_CS + (size_t)DB * 3 * CONVD,
                 O_END = O_HS + (size_t)DB * NH * HD * DS;
static_assert(O_END == 55314432, "output size");

constexpr size_t MiB = 1u << 20;
constexpr size_t WS_CTL = 0, CTL_ZERO_BYTES = 1 * MiB;
constexpr size_t WS_WIN = 2 * MiB;
constexpr size_t WS_WOUT = 16 * MiB;
constexpr size_t WS_DT = 20 * MiB;
constexpr size_t WS_SSQ = 24 * MiB;
constexpr size_t WS_XN = 32 * MiB;
constexpr size_t WS_Q = 100 * MiB;
constexpr size_t WS_K = 168 * MiB;
constexpr size_t WS_V = 236 * MiB;
constexpr size_t WS_AU = 304 * MiB;
constexpr size_t WS_XBC = 436 * MiB;
constexpr size_t WS_RAWB = 536 * MiB;
constexpr size_t WS_G = 544 * MiB;
constexpr size_t WS_Z = 612 * MiB;
constexpr size_t WS_END = 680 * MiB;
static_assert(WS_XN + (size_t)MROWS * DM * 2 <= WS_Q && WS_Q + (size_t)MROWS * DM * 2 <= WS_K && WS_K + (size_t)MROWS * DM * 2 <= WS_V && WS_V + (size_t)MROWS * DM * 2 <= WS_AU &&
              WS_AU + (size_t)MROWS * 2048 * 2 <= WS_XBC && WS_XBC + (size_t)MROWS * CONVD * 2 <= WS_RAWB && WS_RAWB + (size_t)(MROWS / 64) * 6 * 512 * 4 <= WS_G && WS_G + (size_t)MROWS * DM * 2 <= WS_Z && WS_Z + (size_t)MROWS * DM * 2 <= WS_END && WS_WIN + (size_t)NMAIN * DM * 2 <= WS_WOUT && WS_WOUT + (size_t)DM * 2048 * 2 <= WS_DT &&
              WS_DT + (size_t)MROWS * 16 * 4 <= WS_SSQ && WS_SSQ + (size_t)MROWS * 32 * 4 <= WS_XN, "d_ws map");

struct Ins {
    const float *xp, *xs, *ck, *cv, *sconv, *sssm, *norm_w, *w_in, *qnw, *knw, *rel_bias, *conv_w, *conv_b, *dt_bias, *a_log, *d_skip, *ssd_norm_w, *w_out;
};

typedef unsigned short bf16;
__device__ __forceinline__ float wave_sum(float v) {
#pragma unroll
    for (int o = 1; o < 64; o <<= 1) v += __shfl_xor(v, o);
    return v;
}
__device__ __forceinline__ float wave_max(float v) {
#pragma unroll
    for (int o = 1; o < 64; o <<= 1) v = fmaxf(v, __shfl_xor(v, o));
    return v;
}
__device__ __forceinline__ float silu_f(float x) { return x / (1.f + __expf(-x)); }
__device__ __forceinline__ float silu_fast(float x) { return x * __builtin_amdgcn_rcpf(1.f + __builtin_amdgcn_exp2f(-LOG2E * x)); }
__device__ __forceinline__ float softplus_f(float x) { return x > 20.f ? x : log1pf(__expf(x)); }
__device__ __forceinline__ int t5_bucket(int d) {
    if (d < 16) return d;
    int b = 16;
    b += d >= 22; b += d >= 30; b += d >= 40; b += d >= 54; b += d >= 73; b += d >= 99; b += d >= 134; b += d >= 182;
    b += d >= 246; b += d >= 332; b += d >= 450; b += d >= 609; b += d >= 825; b += d >= 1117; b += d >= 1513;
    return b;
}
__device__ __forceinline__ const float* xrow(const Ins& I, int r) { return r < NTOK ? I.xp + (size_t)r * DM : I.xs + (size_t)(r - NTOK) * DM; }
__device__ __forceinline__ float bf2f(bf16 v) { return __uint_as_float((unsigned)v << 16); }
__device__ __forceinline__ unsigned f2bf(float f) { unsigned u = __float_as_uint(f); return (u + 0x7fffu + ((u >> 16) & 1u)) >> 16; }
__device__ __forceinline__ unsigned pk2(float lo, float hi) { return f2bf(lo) | (f2bf(hi) << 16); }
typedef float f32x2_cv __attribute__((ext_vector_type(2))); typedef __bf16 bf16x2_cv __attribute__((ext_vector_type(2)));
__device__ __forceinline__ unsigned cvtpk_s(float lo, float hi) { const f32x2_cv v = {lo, hi}; const bf16x2_cv b = __builtin_convertvector(v, bf16x2_cv); return __builtin_bit_cast(unsigned, b); }
__host__ __device__ __forceinline__ int vrow_of_col(int a) { return 128 * ((a >> 5) & 1) + 32 * ((a >> 6) & 3) + (a & 31); }

namespace pg8 {
#define PG8_LAS __attribute__((address_space(3)))
typedef unsigned short bf16_t;
typedef short bf16x8 __attribute__((ext_vector_type(8)));
typedef float f32x4 __attribute__((ext_vector_type(4)));
typedef unsigned u32x4 __attribute__((ext_vector_type(4)));
constexpr int BM = 256, BK = 64, HALF = 128, HTB = HALF * BK * 2  , STAGE_BYTES = 8 * HTB, NXCD = 8, WGM = 4;

__host__ __device__ __forceinline__ int lds_byte(int r, int c) { const int st = (r >> 4) * 2 + (c >> 5), rr = r & 15, cc = c & 31, ob = rr * 64 + cc * 2; return st * 1024 + (ob ^ (((ob >> 9) & 1) << 5)); }
__host__ __device__ __forceinline__ void stage_rc(int b, int& R, int& C) { const int st = b / 1024, sb = b % 1024, swz = sb ^ (((sb >> 9) & 1) << 5); R = (st >> 1) * 16 + swz / 64; C = (st & 1) * 32 + (swz % 64) / 2; }
__host__ __device__ __forceinline__ int perm32(int rho) { const int n = rho >> 4, i = rho & 15; return 8 * (i >> 2) + 4 * n + (i & 3); }

struct Unit { int pm, pn; };
struct Gemm { const bf16_t* A; const bf16_t* Bt; int M, N, K; };

struct StaticOrder {
    int nM, nN, nwg, G, c;
    __host__ __device__ void init(int M, int N, int G_, int c_) { nM = M / BM; nN = N / BM; nwg = nM * nN; G = G_; c = c_; }
    __host__ __device__ bool next(int i, Unit& u) const {
        const long L = (long)i * G + c; if (L >= nwg) return false;
        int wgid = (int)L; { const int q = nwg / NXCD, r = nwg % NXCD, xcd = wgid % NXCD, off = wgid / NXCD; wgid = (xcd < r ? xcd * (q + 1) : r * (q + 1) + (xcd - r) * q) + off; }
        const int nig = WGM * nN, gid = wgid / nig, fm = gid * WGM, gsz = (nM - fm) < WGM ? (nM - fm) : WGM;
        u.pm = fm + ((wgid % nig) % gsz); u.pn = (wgid % nig) / gsz; return true;
    }
    __device__ __forceinline__ void a_ready(const Unit&) const {}
    __device__ __forceinline__ void done(const Unit&) const {}
};

__device__ __forceinline__ unsigned cvt_pk_bf16(float lo, float hi) { unsigned r; asm volatile("v_cvt_pk_bf16_f32 %0, %1, %2" : "=v"(r) : "v"(lo), "v"(hi)); return r; }

template <int K> __device__ __forceinline__ float rowprev(float cur, float prevm) {
    const int t = __builtin_amdgcn_update_dpp(0, __builtin_bit_cast(int, prevm), 0x100 + (16 - K), 0xf, 0xf, true);
    return __builtin_bit_cast(float, __builtin_amdgcn_update_dpp(t, __builtin_bit_cast(int, cur), 0x110 + K, 0xf, 0xf, false));
}

struct EpiIn {
    static constexpr bool PERM = true, AFTER_DRAIN = false, MIDK = false;
    bf16_t *Q, *K, *V, *Gb, *Zb, *XBC; float* out; const float *qnw, *knw, *conv_w, *conv_b; float* rawb;
    __device__ __forceinline__ void mid(f32x4 (&)[2][2][4][2], const Unit&, int, int, int, int, int) const {}
    __device__ __forceinline__ void operator()(const f32x4 (&acc)[2][2][4][2], const Unit& u, int wr, int wc, int fr, int fq) const {
        const int pn = u.pn;
        const int rowb = u.pm * BM + wr * 64 + fr;
        const int cl = wc * 64 + 8 * fq;
        if (pn < 8) {
            const bool isq = pn < 4; const float* nw = isq ? qnw : knw;
            f32x4 w[2][2];
#pragma unroll
            for (int bj = 0; bj < 2; ++bj)
#pragma unroll
                for (int n = 0; n < 2; ++n) w[bj][n] = *(const f32x4*)(nw + 8 * fq + 32 * bj + 4 * n);
            bf16_t* dstb = (isq ? Q : K) + (pn & 3) * 256 + cl;
#pragma unroll
            for (int ai = 0; ai < 2; ++ai)
#pragma unroll
                for (int m = 0; m < 4; ++m) {
                    const int r = rowb + ai * HALF + m * 16;
                    float ss = 0.f;
#pragma unroll
                    for (int bj = 0; bj < 2; ++bj)
#pragma unroll
                        for (int n = 0; n < 2; ++n) { const f32x4 v = acc[ai][bj][m][n]; ss += (v[0] * v[0] + v[1] * v[1]) + (v[2] * v[2] + v[3] * v[3]); }
                    ss += __shfl_xor(ss, 16); ss += __shfl_xor(ss, 32);
                    const float sc = rsqrtf(ss * (1.f / 64.f) + EPS), scs = isq ? sc * QSCALE : sc;
                    float* f32dst = nullptr;
                    if (!isq) { if (r < NTOK) { const int t = r & (SEQ - 1); if (t >= SEQ - WIN) f32dst = out + O_KP + ((size_t)((r >> 13) * WIN + t - (SEQ - WIN))) * DM + (pn & 3) * 256 + cl; }
                                else if (r < NROWS) f32dst = out + O_KS + (size_t)(r - NTOK) * DM + (pn & 3) * 256 + cl; }
#pragma unroll
                    for (int bj = 0; bj < 2; ++bj) {
                        const f32x4 a0 = acc[ai][bj][m][0] * w[bj][0], a1 = acc[ai][bj][m][1] * w[bj][1];
                        u32x4 o; o.x = cvt_pk_bf16(a0[0] * scs, a0[1] * scs); o.y = cvt_pk_bf16(a0[2] * scs, a0[3] * scs); o.z = cvt_pk_bf16(a1[0] * scs, a1[1] * scs); o.w = cvt_pk_bf16(a1[2] * scs, a1[3] * scs);
                        *(u32x4*)(dstb + (size_t)r * DM + 32 * bj) = o;
                        if (f32dst) { *(f32x4*)(f32dst + 32 * bj) = a0 * sc; *(f32x4*)(f32dst + 32 * bj + 4) = a1 * sc; }
                    }
                }
        } else if (pn < 12) {
            bf16_t* dstb = V + (pn & 3) * 256 + cl;
#pragma unroll
            for (int ai = 0; ai < 2; ++ai)
#pragma unroll
                for (int m = 0; m < 4; ++m) {
                    const int r = rowb + ai * HALF + m * 16;
                    float* f32dst = nullptr;
                    if (r < NTOK) { const int t = r & (SEQ - 1); if (t >= SEQ - WIN) f32dst = out + O_VP + ((size_t)((r >> 13) * WIN + t - (SEQ - WIN))) * DM + (pn & 3) * 256 + cl; }
                    else if (r < NROWS) f32dst = out + O_VS + (size_t)(r - NTOK) * DM + (pn & 3) * 256 + cl;
#pragma unroll
                    for (int bj = 0; bj < 2; ++bj) {
                        const f32x4 a0 = acc[ai][bj][m][0], a1 = acc[ai][bj][m][1];
                        u32x4 o; o.x = cvt_pk_bf16(a0[0], a0[1]); o.y = cvt_pk_bf16(a0[2], a0[3]); o.z = cvt_pk_bf16(a1[0], a1[1]); o.w = cvt_pk_bf16(a1[2], a1[3]);
                        *(u32x4*)(dstb + (size_t)r * DM + 32 * bj) = o;
                        if (f32dst) { *(f32x4*)(f32dst + 32 * bj) = a0; *(f32x4*)(f32dst + 32 * bj + 4) = a1; }
                    }
                }
        } else if (pn < 20) {
            bf16_t* dstb = (pn < 16 ? Gb : Zb) + (pn & 3) * 256 + cl;
#pragma unroll
            for (int ai = 0; ai < 2; ++ai)
#pragma unroll
                for (int m = 0; m < 4; ++m) {
                    const int r = rowb + ai * HALF + m * 16;
#pragma unroll
                    for (int bj = 0; bj < 2; ++bj) {
                        f32x4 a0 = acc[ai][bj][m][0], a1 = acc[ai][bj][m][1];
#pragma unroll
                        for (int i = 0; i < 4; ++i) { a0[i] = silu_fast(a0[i]); a1[i] = silu_fast(a1[i]); }
                        u32x4 o; o.x = cvt_pk_bf16(a0[0], a0[1]); o.y = cvt_pk_bf16(a0[2], a0[3]); o.z = cvt_pk_bf16(a1[0], a1[1]); o.w = cvt_pk_bf16(a1[2], a1[3]);
                        *(u32x4*)(dstb + (size_t)r * DM + 32 * bj) = o;
                    }
                }
        } else {
            const int cb = (pn - 20) * 256 + cl;
            bf16_t* dstb = XBC + cb;
            const bool do_conv = pn >= 24 && u.pm < NTOK / BM;
#pragma unroll
            for (int ai = 0; ai < 2; ++ai)
#pragma unroll
                for (int m = 0; m < 4; ++m) {
                    const int r = rowb + ai * HALF + m * 16;
                    float* f32dst = nullptr;
                    if (r < NTOK) { const int t = r & (SEQ - 1); if (t >= SEQ - 3) f32dst = out + O_CP + ((size_t)((r >> 13) * 3 + t - (SEQ - 3))) * CONVD + cb; }
                    else if (r < NROWS) f32dst = out + O_CS + ((size_t)(r - NTOK) * 3 + 2) * CONVD + cb;
                    if (do_conv && (m == 0 || m == 3)) {
                        const int slot = m == 0 ? 3 + fr : fr - 13;
                        if (slot >= 0 && slot < 6) f32dst = rawb + ((size_t)(u.pm * 4 + ai * 2 + wr) * 6 + slot) * 512 + (cb - 1024);
                    }
#pragma unroll
                    for (int bj = 0; bj < 2; ++bj) {
                        const f32x4 a0 = acc[ai][bj][m][0], a1 = acc[ai][bj][m][1];
                        if (!do_conv) { u32x4 o; o.x = cvt_pk_bf16(a0[0], a0[1]); o.y = cvt_pk_bf16(a0[2], a0[3]); o.z = cvt_pk_bf16(a1[0], a1[1]); o.w = cvt_pk_bf16(a1[2], a1[3]);
                                        *(u32x4*)(dstb + (size_t)r * CONVD + 32 * bj) = o; }
                        if (f32dst) { *(f32x4*)(f32dst + 32 * bj) = a0; *(f32x4*)(f32dst + 32 * bj + 4) = a1; }
                    }
                }
            if (do_conv) {
                if ((u.pm & 31) == 31 && wr == 1 && fr >= 13) {
#pragma unroll
                    for (int bj = 0; bj < 2; ++bj) { float* d = out + O_CP + ((size_t)((u.pm >> 5) * 3 + fr - 13)) * CONVD + cb + 32 * bj; *(f32x4*)d = acc[1][bj][3][0]; *(f32x4*)(d + 4) = acc[1][bj][3][1]; }
                }
#pragma unroll
                for (int bj = 0; bj < 2; ++bj) {
                    f32x4 w[4][2], bb[2];
#pragma unroll
                    for (int n = 0; n < 2; ++n) { bb[n] = *(const f32x4*)(conv_b + cb + 32 * bj + 4 * n);
#pragma unroll
                        for (int t = 0; t < 4; ++t) w[t][n] = *(const f32x4*)(conv_w + t * CONVD + cb + 32 * bj + 4 * n); }
#pragma unroll
                    for (int ai = 0; ai < 2; ++ai) {
                        f32x4 pm[2] = {(f32x4){0.f, 0.f, 0.f, 0.f}, (f32x4){0.f, 0.f, 0.f, 0.f}};
#pragma unroll
                        for (int m = 0; m < 4; ++m) {
                            const int r = rowb + ai * HALF + m * 16;
                            unsigned ow[4];
#pragma unroll
                            for (int n = 0; n < 2; ++n) {
                                const f32x4 cur = acc[ai][bj][m][n]; f32x4 v;
#pragma unroll
                                for (int i = 0; i < 4; ++i) {
                                    const float p1 = rowprev<1>(cur[i], pm[n][i]), p2 = rowprev<2>(cur[i], pm[n][i]), p3 = rowprev<3>(cur[i], pm[n][i]);
                                    v[i] = silu_fast(bb[n][i] + w[0][n][i] * p3 + w[1][n][i] * p2 + w[2][n][i] * p1 + w[3][n][i] * cur[i]);
                                }
                                ow[2 * n] = cvt_pk_bf16(v[0], v[1]); ow[2 * n + 1] = cvt_pk_bf16(v[2], v[3]);
                                pm[n] = cur;
                            }
                            *(u32x4*)(dstb + (size_t)r * CONVD + 32 * bj) = (u32x4){ow[0], ow[1], ow[2], ow[3]};
                        }
                    }
                }
            }
        }
    }
};

struct EpiOut {
    static constexpr bool PERM = true, AFTER_DRAIN = false, MIDK = true;
    const float* xp; const float* xs; const PG8_LAS float* rs; float* out;
    __device__ __forceinline__ void mid(f32x4 (&acc)[2][2][4][2], const Unit& u, int ui, int wr, int wc, int fr, int fq) const {
        const PG8_LAS float* rp = rs + ui * 256 + wr * 64 + fr;
#pragma unroll
        for (int ai = 0; ai < 2; ++ai)
#pragma unroll
            for (int m = 0; m < 4; ++m) {
                const float r = rp[ai * HALF + m * 16];
#pragma unroll
                for (int bj = 0; bj < 2; ++bj)
#pragma unroll
                    for (int n = 0; n < 2; ++n) acc[ai][bj][m][n] *= r;
            }
    }
    __device__ __forceinline__ void operator()(const f32x4 (&acc)[2][2][4][2], const Unit& u, int wr, int wc, int fr, int fq) const {
        const int rowb = u.pm * BM + wr * 64 + fr, col = u.pn * BM + wc * 64 + 8 * fq;
#pragma unroll
        for (int ai = 0; ai < 2; ++ai) {
            f32x4 xv[4][2][2];
#pragma unroll
            for (int m = 0; m < 4; ++m) {
                const float* xr = xp + (size_t)(rowb + ai * HALF + m * 16) * DM + col;
#pragma unroll
                for (int bj = 0; bj < 2; ++bj) { xv[m][bj][0] = *(const f32x4*)(xr + 32 * bj); xv[m][bj][1] = *(const f32x4*)(xr + 32 * bj + 4); }
            }
#pragma unroll
            for (int m = 0; m < 4; ++m) {
                float* yr = out + O_YP + (size_t)(rowb + ai * HALF + m * 16) * DM + col;
#pragma unroll
                for (int bj = 0; bj < 2; ++bj) { *(f32x4*)(yr + 32 * bj) = xv[m][bj][0] + acc[ai][bj][m][0]; *(f32x4*)(yr + 32 * bj + 4) = xv[m][bj][1] + acc[ai][bj][m][1]; }
            }
        }
    }
};

template <class Epi, class Sched, bool ALIGN_EPI = false, bool SP2 = false>
__device__ __forceinline__ void gemm_phase(PG8_LAS unsigned char* lds, const Gemm g, const Sched& S, const Epi& E) {
    const int tid = threadIdx.x, wid = __builtin_amdgcn_readfirstlane(tid >> 6), lane = tid & 63, wr = wid >> 2, wc = wid & 3, fr = lane & 15, fq = lane >> 4;
    const int K = g.K, nt = K / BK;
    unsigned voffA[2], voffB[2];
#pragma unroll
    for (int i = 0; i < 2; ++i) { int R, C; stage_rc(tid * 16 + i * 8192, R, C); const int Rb = Epi::PERM ? ((R & ~31) + perm32(R & 31)) : R;
        voffA[i] = (unsigned)(R * K + C) * 2u; voffB[i] = (unsigned)(Rb * K + C) * 2u; }
    const size_t kstep = (size_t)(BK * 2);
    const size_t hstep = (size_t)HALF * K * 2;
    const size_t tstep = 2 * hstep;
    const unsigned ldsw = (unsigned)wid * 1024u;
    const int aoff = lds_byte(wr * 64 + fr, fq * 8), boff = lds_byte(wc * 32 + fr, fq * 8);
#define PG8_SA(b, h) (((b) * 2 + (h)) * HTB)
#define PG8_SB(b, h) ((4 + (b) * 2 + (h)) * HTB)
#define PG8_STAGE(bufoff, gbase, voff) do { _Pragma("unroll") for (int _i = 0; _i < 2; ++_i) \
        __builtin_amdgcn_global_load_lds((const unsigned*)((const char*)(gbase) + (voff)[_i]), (PG8_LAS unsigned*)(lds + (bufoff) + ldsw + _i * 8192), 16, 0, 0); } while (0)
#define PG8_LDA(dst, b, h) do { _Pragma("unroll") for (int m = 0; m < 4; ++m) _Pragma("unroll") for (int k = 0; k < 2; ++k) dst[m][k] = *(const PG8_LAS bf16x8*)(lds + PG8_SA(b, h) + aoff + m * 2048 + k * 1024); } while (0)
#define PG8_LDB(dst, b, h) do { _Pragma("unroll") for (int n = 0; n < 2; ++n) _Pragma("unroll") for (int k = 0; k < 2; ++k) dst[n][k] = *(const PG8_LAS bf16x8*)(lds + PG8_SB(b, h) + boff + n * 2048 + k * 1024); } while (0)
#define PG8_MMA(ai, bj, At, Bt) do { __builtin_amdgcn_s_setprio(1); _Pragma("unroll") for (int m = 0; m < 4; ++m) _Pragma("unroll") for (int n = 0; n < 2; ++n) _Pragma("unroll") for (int k = 0; k < 2; ++k) \
        acc[ai][bj][m][n] = __builtin_amdgcn_mfma_f32_16x16x32_bf16(Bt[n][k], At[m][k], acc[ai][bj][m][n], 0, 0, 0); __builtin_amdgcn_s_setprio(0); } while (0)
#define PG8_WAIT_V(n) asm volatile("s_waitcnt vmcnt(" #n ")" ::: "memory")
#define PG8_WAIT_L(n) asm volatile("s_waitcnt lgkmcnt(" #n ")" ::: "memory")
#define PG8_BAR __builtin_amdgcn_s_barrier()
#define PG8_SCHED __builtin_amdgcn_sched_barrier(0)
    Unit cur, nxt; int ui = 0;
    if (!S.next(0, cur)) return;
    f32x4 acc[2][2][4][2];
#pragma unroll
    for (int a = 0; a < 2; ++a)
#pragma unroll
        for (int b = 0; b < 2; ++b)
#pragma unroll
            for (int m = 0; m < 4; ++m)
#pragma unroll
                for (int n = 0; n < 2; ++n) acc[a][b][m][n] = (f32x4){0.f, 0.f, 0.f, 0.f};
    bf16x8 At[4][2], B0[2][2], B1[2][2];
    const char* cA = (const char*)g.A + (size_t)cur.pm * tstep; const char* cB = (const char*)g.Bt + (size_t)cur.pn * tstep;
    S.a_ready(cur);
    if constexpr (SP2) {
        PG8_STAGE(PG8_SB(0, 0), cB, voffB); PG8_STAGE(PG8_SB(0, 1), cB + hstep, voffB); PG8_STAGE(PG8_SA(0, 0), cA, voffA); PG8_STAGE(PG8_SA(0, 1), cA + hstep, voffA);
        if (wr == 1) PG8_BAR;
        PG8_WAIT_V(2); PG8_BAR;
        PG8_STAGE(PG8_SB(1, 0), cB + kstep, voffB); PG8_STAGE(PG8_SA(1, 0), cA + kstep, voffA); PG8_STAGE(PG8_SB(1, 1), cB + hstep + kstep, voffB);
        PG8_WAIT_V(6); PG8_BAR;
    } else {
        PG8_STAGE(PG8_SB(0, 0), cB, voffB); PG8_STAGE(PG8_SA(0, 0), cA, voffA); PG8_STAGE(PG8_SB(0, 1), cB + hstep, voffB); PG8_STAGE(PG8_SA(0, 1), cA + hstep, voffA);
        if (wr == 1) PG8_BAR;
        PG8_WAIT_V(4); PG8_BAR;
        PG8_STAGE(PG8_SB(1, 0), cB + kstep, voffB); PG8_STAGE(PG8_SA(1, 0), cA + kstep, voffA); PG8_STAGE(PG8_SB(1, 1), cB + hstep + kstep, voffB);
        PG8_WAIT_V(6); PG8_BAR;
    }
    for (;;) {
        const bool has_next = S.next(ui + 1, nxt);
        const char* nA = has_next ? (const char*)g.A + (size_t)nxt.pm * tstep : cA; const char* nB = has_next ? (const char*)g.Bt + (size_t)nxt.pn * tstep : cB;
        for (int t = 0; t < nt; t += 2) {
            const bool last = (t == nt - 2);
            if constexpr (Epi::MIDK) { if (t == (nt >> 1)) E.mid(acc, cur, ui, wr, wc, fr, fq); }
            const char* a1 = cA + (size_t)(t + 1) * kstep;
            const char* a2 = last ? nA : cA + (size_t)(t + 2) * kstep; const char* b2 = last ? nB : cB + (size_t)(t + 2) * kstep;
            const char* a3 = a2 + kstep; const char* b3 = b2 + kstep;
            if (last && has_next) S.a_ready(nxt);
            if constexpr (SP2) {
            PG8_LDB(B0, 0, 0); PG8_LDB(B1, 0, 1); PG8_SCHED; PG8_LDA(At, 0, 0); PG8_STAGE(PG8_SA(1, 1), a1 + hstep, voffA);
            PG8_WAIT_V(8); PG8_WAIT_L(0); PG8_BAR; PG8_MMA(0, 0, At, B0); PG8_MMA(0, 1, At, B1); PG8_BAR; PG8_SCHED;
            PG8_LDA(At, 0, 1); PG8_STAGE(PG8_SB(0, 0), b2, voffB); PG8_STAGE(PG8_SB(0, 1), b2 + hstep, voffB); PG8_STAGE(PG8_SA(0, 0), a2, voffA);
            PG8_WAIT_V(8); PG8_WAIT_L(0); PG8_BAR; PG8_MMA(1, 0, At, B0); PG8_MMA(1, 1, At, B1); PG8_BAR; PG8_SCHED;
            PG8_LDB(B0, 1, 0); PG8_LDB(B1, 1, 1); PG8_SCHED; PG8_LDA(At, 1, 0); PG8_STAGE(PG8_SA(0, 1), a2 + hstep, voffA);
            PG8_WAIT_V(8); PG8_WAIT_L(0); PG8_BAR; PG8_MMA(0, 0, At, B0); PG8_MMA(0, 1, At, B1); PG8_BAR; PG8_SCHED;
            PG8_LDA(At, 1, 1); PG8_STAGE(PG8_SB(1, 0), b3, voffB); PG8_STAGE(PG8_SB(1, 1), b3 + hstep, voffB); PG8_STAGE(PG8_SA(1, 0), a3, voffA);
            PG8_WAIT_V(8); PG8_WAIT_L(0); PG8_BAR; PG8_MMA(1, 0, At, B0); PG8_MMA(1, 1, At, B1); PG8_BAR; PG8_SCHED;
            } else {
            PG8_LDB(B0, 0, 0); PG8_SCHED; PG8_LDA(At, 0, 0); PG8_STAGE(PG8_SA(1, 1), a1 + hstep, voffA);
            PG8_WAIT_L(8); PG8_BAR; PG8_WAIT_L(0); PG8_MMA(0, 0, At, B0); PG8_BAR; PG8_SCHED;
            PG8_LDB(B1, 0, 1); PG8_STAGE(PG8_SB(0, 0), b2, voffB);
            PG8_BAR; PG8_WAIT_L(0); PG8_MMA(0, 1, At, B1); PG8_BAR;
            PG8_LDA(At, 0, 1); PG8_STAGE(PG8_SA(0, 0), a2, voffA);
            PG8_BAR; PG8_WAIT_L(0); PG8_MMA(1, 0, At, B0); PG8_BAR; PG8_SCHED;
            PG8_STAGE(PG8_SB(0, 1), b2 + hstep, voffB);
            PG8_WAIT_V(6); PG8_BAR; PG8_MMA(1, 1, At, B1); PG8_BAR;
            PG8_LDB(B0, 1, 0); PG8_SCHED; PG8_LDA(At, 1, 0); PG8_STAGE(PG8_SA(0, 1), a2 + hstep, voffA);
            PG8_WAIT_L(8); PG8_BAR; PG8_WAIT_L(0); PG8_MMA(0, 0, At, B0); PG8_BAR; PG8_SCHED;
            PG8_LDB(B1, 1, 1); PG8_STAGE(PG8_SB(1, 0), b3, voffB);
            PG8_BAR; PG8_WAIT_L(0); PG8_MMA(0, 1, At, B1); PG8_BAR;
            PG8_LDA(At, 1, 1); PG8_STAGE(PG8_SA(1, 0), a3, voffA);
            PG8_BAR; PG8_WAIT_L(0); PG8_MMA(1, 0, At, B0); PG8_BAR; PG8_SCHED;
            PG8_STAGE(PG8_SB(1, 1), b3 + hstep, voffB);
            PG8_WAIT_V(6); PG8_BAR; PG8_MMA(1, 1, At, B1); PG8_BAR;
            }
        }
        if constexpr (ALIGN_EPI) { if (wr == 0) PG8_BAR; }
        if constexpr (!Epi::AFTER_DRAIN) { E(acc, cur, wr, wc, fr, fq); S.done(cur); }
        if (!has_next) break;
#pragma unroll
        for (int a = 0; a < 2; ++a)
#pragma unroll
            for (int b = 0; b < 2; ++b)
#pragma unroll
                for (int m = 0; m < 4; ++m)
#pragma unroll
                    for (int n = 0; n < 2; ++n) acc[a][b][m][n] = (f32x4){0.f, 0.f, 0.f, 0.f};
        cur = nxt; cA = nA; cB = nB; ++ui;
        if constexpr (ALIGN_EPI) { if (wr == 1) PG8_BAR; }
    }
    PG8_WAIT_V(0);
    if constexpr (!ALIGN_EPI) { if (wr == 0) PG8_BAR; }
    PG8_BAR;
    if constexpr (Epi::AFTER_DRAIN) { E.fused(acc, cur, wr, wc, fr, fq, lds, wid, lane); S.done(cur); }
#undef PG8_SA
#undef PG8_SB
#undef PG8_STAGE
#undef PG8_LDA
#undef PG8_LDB
#undef PG8_MMA
#undef PG8_WAIT_V
#undef PG8_WAIT_L
#undef PG8_BAR
#undef PG8_SCHED
}
}
#define GAS __attribute__((address_space(1)))
#define LAS __attribute__((address_space(3)))
typedef unsigned v4u __attribute__((ext_vector_type(4)));
typedef float f32x4 __attribute__((ext_vector_type(4)));
typedef short bf16x8 __attribute__((ext_vector_type(8)));
typedef GAS unsigned gu32;
typedef GAS unsigned long long gu64;
#define RLX_AGENT __ATOMIC_RELAXED, __HIP_MEMORY_SCOPE_AGENT
#define LDS_WAIT() asm volatile("s_waitcnt lgkmcnt(0)" ::: "memory")
#define VM_WAIT() asm volatile("s_waitcnt vmcnt(0)" ::: "memory")
__device__ __forceinline__ unsigned long long rt() { return __builtin_amdgcn_s_memrealtime(); }

#define XB_TMO      128
#define XB_XCNT(j)  (256  + 64 * (j))
#define XB_XSUB(j)  (1280 + 64 * (j))
#define XB_XGEN(j)  (2304 + 64 * (j))
#define XB_TOP      3328
#define XB_TOPGEN   3392
#define XCD_BAR_WORDS 3456
#define XB_SPIN_CAP (1u << 18)

__device__ __forceinline__ unsigned xb_ld(unsigned* p)              { return __hip_atomic_load(p, __ATOMIC_RELAXED, __HIP_MEMORY_SCOPE_AGENT); }
__device__ __forceinline__ unsigned xb_add(unsigned* p, unsigned v) { return __hip_atomic_fetch_add(p, v, __ATOMIC_RELAXED, __HIP_MEMORY_SCOPE_AGENT); }
__device__ __forceinline__ unsigned xb_xcc_id() { return (unsigned)__builtin_amdgcn_s_getreg((3 << 11) | 20) & 0xFu; }
#define XB_SPIN(cond, bar) do { unsigned _sp = 0; while (cond) { __builtin_amdgcn_s_sleep(1); \
    if ((++_sp & 255u) == 0u) { if (xb_ld(&(bar)[XB_TMO])) break; if (_sp > XB_SPIN_CAP) { atomicAdd(&(bar)[XB_TMO], 1u); break; } } } } while (0)

struct XcdBarrier {
    unsigned* bar; unsigned x;
    volatile LAS unsigned* st;
};

__device__ __forceinline__ XcdBarrier xcd_barrier_post(unsigned* bar, volatile LAS unsigned* st) {
    XcdBarrier b; b.bar = bar; b.x = xb_xcc_id(); b.st = st;
    if (threadIdx.x == 0) (void)xb_add(&bar[XB_XCNT(b.x)], 1u);
    return b;
}
__device__ __forceinline__ void xcd_barrier_complete(unsigned* bar, unsigned x, unsigned& nloc, unsigned& nx) {
    const unsigned G = gridDim.x * gridDim.y * gridDim.z;
    unsigned sum, cnt, mine, sp = 0u;
    for (;;) {
        sum = 0u; cnt = 0u; mine = 0u;
#pragma unroll
        for (unsigned j = 0; j < 16; ++j) { const unsigned c = xb_ld(&bar[XB_XCNT(j)]); sum += c; cnt += (c > 0u) ? 1u : 0u; mine = (j == x) ? c : mine; }
        if (sum == G) break;
        __builtin_amdgcn_s_sleep(1);
        if ((++sp & 255u) == 0u) { if (xb_ld(&bar[XB_TMO])) break; if (sp > XB_SPIN_CAP) { atomicAdd(&bar[XB_TMO], 1u); break; } }
    }
    nloc = mine > 0u ? mine : 1u; nx = cnt > 0u ? cnt : 1u;
}

__device__ __forceinline__ void xcd_barrier(const XcdBarrier& b) {
    asm volatile("s_waitcnt vmcnt(0)" ::: "memory");
    __syncthreads();
    if (threadIdx.x == 0) {
        unsigned* bar = b.bar;
        __builtin_amdgcn_s_waitcnt(0);
        unsigned nloc = b.st[0], nx = b.st[1];
        if (nloc == 0u) { xcd_barrier_complete(bar, b.x, nloc, nx); b.st[0] = nloc; b.st[1] = nx; }
        const unsigned old = xb_add(&bar[XB_XSUB(b.x)], 1u);
        const unsigned gen = old / nloc;
        if (old + 1u == (gen + 1u) * nloc) {
            __builtin_amdgcn_fence(__ATOMIC_RELEASE, "agent");
            asm volatile("s_waitcnt vmcnt(0)" ::: "memory");
            const unsigned og = xb_add(&bar[XB_TOP], 1u);
            const unsigned tg = og / nx;
            if (og + 1u == (tg + 1u) * nx) xb_add(&bar[XB_TOPGEN], 1u);
            else XB_SPIN(xb_ld(&bar[XB_TOPGEN]) == tg, bar);
            __builtin_amdgcn_fence(__ATOMIC_ACQUIRE, "agent");
            xb_add(&bar[XB_XGEN(b.x)], 1u);
            asm volatile("s_waitcnt vmcnt(0)" ::: "memory");
        } else {
            XB_SPIN(xb_ld(&bar[XB_XGEN(b.x)]) == gen, bar);
            __builtin_amdgcn_fence(__ATOMIC_ACQUIRE, "agent");
            asm volatile("s_waitcnt vmcnt(0)" ::: "memory");
        }
    }
    __syncthreads();
}

constexpr int NWAVES = 8;
constexpr int RING_OFF = 0, RING_BYTES = 131072;
constexpr int LDS_BYTES = 163840;
constexpr int LDSCTL_OFF = LDS_BYTES - 512, MISC_OFF = LDSCTL_OFF + 320;
constexpr int CW_BAR = 4096;
constexpr int CW_Q = 16384;
static_assert((CW_BAR + XCD_BAR_WORDS) <= CW_Q && (CW_Q + 64 * 64) * 4 <= (int)CTL_ZERO_BYTES, "CTL words inside the memset region");

constexpr int PROBE_ID = 0;
#define PB_BEGIN(id) long long pb_t0_##id = 0; if (PROBE_ID == (id)) pb_t0_##id = clock64();
#define PB_END(id) if (PROBE_ID == (id)) { const long long t1_ = clock64(), dt_ = t1_ - pb_t0_##id; while (clock64() - t1_ < dt_) __builtin_amdgcn_s_sleep(2); }
struct Frame {
    LAS unsigned char* lds;
    volatile LAS unsigned* MISC;
    gu32* ctl;
    int tid, lane, wave, vcu, G;
    Ins I; float* out;
    bf16 *WinT, *WoutT, *XN, *Q, *K, *V, *AU, *XBC, *Gb, *Zb; float *DT, *SSQ, *RAWB;
};

template <class SrcF>
__device__ __forceinline__ void p0_transpose_item(SrcF src, int k0, int n0, bf16* WT, int dst_pitch, int dst_row0, int dst_k0, LAS float* scr, int lane) {
#pragma unroll 8
    for (int i = 0; i < 32; ++i) { const int kk = 2 * i + (lane >> 5); scr[kk * 33 + (lane & 31)] = src(k0 + kk, n0 + (lane & 31)); }
    LDS_WAIT(); asm volatile("" ::: "memory");
    const int c = lane & 7;
#pragma unroll
    for (int j = 0; j < 4; ++j) { const int n = (lane >> 3) + 8 * j; const LAS float* s = scr + (8 * c) * 33 + n;
        v4u o; o.x = pk2(s[0 * 33], s[1 * 33]); o.y = pk2(s[2 * 33], s[3 * 33]); o.z = pk2(s[4 * 33], s[5 * 33]); o.w = pk2(s[6 * 33], s[7 * 33]);
        *(GAS v4u*)(WT + (size_t)(dst_row0 + n) * dst_pitch + dst_k0 + 8 * c) = o; }
    LDS_WAIT(); asm volatile("" ::: "memory");
}
constexpr int P0_SCR_BYTES = 8448, WDT_OFF = NWAVES * P0_SCR_BYTES, WDT_PITCH = 20;
static_assert(WDT_OFF + 1024 * WDT_PITCH * 4 <= LDSCTL_OFF, "prologue LDS");

__device__ __forceinline__ void p0_prologue(Frame& F) {
    const Ins& I = F.I;
    LAS float* scr = (LAS float*)(F.lds + F.wave * P0_SCR_BYTES);
    LAS float* wdt = (LAS float*)(F.lds + WDT_OFF);
    const int gw = F.vcu * NWAVES + F.wave, NGW = F.G * NWAVES;
    for (int idx = F.tid; idx < 1024 * 16; idx += NWAVES * 64) {
        const int k = idx >> 4, j = idx & 15, pos = (((k >> 8) * 4 + (k & 3)) << 6) + ((k >> 2) & 63);
        wdt[pos * WDT_PITCH + j] = I.w_in[(size_t)k * NPROJ + C_DT + j] * I.norm_w[k];
    }
    constexpr int I_IN = (DM / 64) * (NMAIN / 32), I_OUT = (2048 / 64) * (DM / 32);
    for (int it = gw; it < I_IN + I_OUT; it += NGW) {
        if (it < I_IN) {
            const int nblk = NMAIN / 32, kb = it / nblk, nb = it % nblk, k0 = 64 * kb, n0 = 32 * nb;
            p0_transpose_item([&](int k, int n) { return I.w_in[(size_t)k * NPROJ + n] * I.norm_w[k]; }, k0, n0, F.WinT, DM, (n0 & ~255) + vrow_of_col(n0 & 255), k0, scr, F.lane);
        } else {
            const int r = it - I_IN, nblk = DM / 32, kb = r / nblk, nb = r % nblk, k0 = 64 * kb, n0 = 32 * nb;
            p0_transpose_item([&](int k, int n) { return I.w_out[(size_t)k * DM + n] * (k >= 1024 ? I.ssd_norm_w[k - 1024] : 1.f); }, k0, n0, F.WoutT, 2048, (n0 & ~255) + vrow_of_col(n0 & 255), (k0 + 1024) & 2047, scr, F.lane);
        }
    }
    __syncthreads();
    for (int rp = gw; rp < NROWS / 2; rp += NGW) {
        f32x4 v[2][4]; float rstd[2];
#pragma unroll
        for (int q = 0; q < 2; ++q) {
            const GAS f32x4* xr = (const GAS f32x4*)xrow(I, 2 * rp + q) + F.lane; float s = 0.f;
#pragma unroll
            for (int j = 0; j < 4; ++j) { v[q][j] = xr[64 * j]; s += (v[q][j].x * v[q][j].x + v[q][j].y * v[q][j].y) + (v[q][j].z * v[q][j].z + v[q][j].w * v[q][j].w); }
            rstd[q] = rsqrtf(wave_sum(s) * (1.f / DM) + EPS);
            GAS unsigned long long* o8 = (GAS unsigned long long*)(F.XN + (size_t)(2 * rp + q) * DM) + F.lane;
#pragma unroll
            for (int j = 0; j < 4; ++j) o8[64 * j] = (unsigned long long)pk2(v[q][j].x * rstd[q], v[q][j].y * rstd[q]) | ((unsigned long long)pk2(v[q][j].z * rstd[q], v[q][j].w * rstd[q]) << 32);
        }
        float a[32];
#pragma unroll
        for (int i = 0; i < 32; ++i) a[i] = 0.f;
#pragma unroll
        for (int j = 0; j < 4; ++j)
#pragma unroll
            for (int e = 0; e < 4; ++e) {
                const LAS f32x4* wp = (const LAS f32x4*)(wdt + ((j * 4 + e) * 64 + F.lane) * WDT_PITCH);
                const float x0 = v[0][j][e], x1 = v[1][j][e];
#pragma unroll
                for (int c4 = 0; c4 < 4; ++c4) { const f32x4 w = wp[c4];
#pragma unroll
                    for (int i = 0; i < 4; ++i) { a[c4 * 4 + i] += x0 * w[i]; a[16 + c4 * 4 + i] += x1 * w[i]; } }
                asm volatile("" ::: "memory");
            }
#define P0_HALVE(N, X) { const bool up = (F.lane & (X)) != 0; _Pragma("unroll") for (int i = 0; i < (N); ++i) { const float keep = up ? a[i + (N)] : a[i], send = up ? a[i] : a[i + (N)]; a[i] = keep + __shfl_xor(send, (X)); } }
        P0_HALVE(16, 32) P0_HALVE(8, 16) P0_HALVE(4, 8) P0_HALVE(2, 4) P0_HALVE(1, 2)
#undef P0_HALVE
        float tot = a[0] + __shfl_xor(a[0], 1);
        const int idx = F.lane >> 1, q = idx >> 4, c = idx & 15;
        tot = tot * (q ? rstd[1] : rstd[0]) + I.dt_bias[c];
        if ((F.lane & 1) == 0) F.DT[(size_t)c * MROWS + 2 * rp + q] = softplus_f(tot);
    }
    { v4u* zk = (v4u*)((unsigned char*)F.K - 4 * MiB); v4u* zv = (v4u*)((unsigned char*)F.V - 4 * MiB);
      for (size_t i = (size_t)F.vcu * NWAVES * 64 + F.tid; i < 4 * MiB / 16; i += (size_t)F.G * NWAVES * 64) {
          if (i * 16 >= 4 * MiB - (WS_K - (WS_Q + (size_t)MROWS * DM * 2))) zk[i] = (v4u){0u, 0u, 0u, 0u};
          if (i * 16 >= 4 * MiB - (WS_V - (WS_K + (size_t)MROWS * DM * 2))) zv[i] = (v4u){0u, 0u, 0u, 0u}; } }
    for (int r = NROWS + gw; r < MROWS; r += NGW) { GAS v4u* o = (GAS v4u*)(F.XN + (size_t)r * DM) + F.lane; o[0] = (v4u){0u, 0u, 0u, 0u}; o[64] = (v4u){0u, 0u, 0u, 0u};
                                                   GAS v4u* k = (GAS v4u*)(F.K + (size_t)r * DM) + F.lane; k[0] = (v4u){0u, 0u, 0u, 0u}; k[64] = (v4u){0u, 0u, 0u, 0u}; }
    for (int i = (F.vcu * NWAVES * 64 + F.tid); i < DB * 2 * CONVD; i += F.G * NWAVES * 64) {
        const int c = i % CONVD, rr = i / CONVD, j = rr & 1, b = rr >> 1;
        F.out[O_CS + ((size_t)b * 3 + j) * CONVD + c] = I.sconv[((size_t)b * 3 + j + 1) * CONVD + c];
    }
}

namespace att {
typedef float f32x16 __attribute__((ext_vector_type(16)));
typedef short v4i16_t __attribute__((ext_vector_type(4)));
typedef unsigned u32x4 __attribute__((ext_vector_type(4)));
constexpr int SPAN = 512, NSPAN = SEQ / SPAN, NUNITS = NB * NH * NSPAN;
constexpr int OPITCH = 64  , OACC_OFF = 0, LACC_OFF = SPAN * OPITCH * 4, LUT_OFF = LACC_OFF + 2048, LUTP = 192  , VST_OFF = LUT_OFF + 3072, VST_BYTES = 2048  , ATT_LDS_END = VST_OFF + NWAVES * VST_BYTES;
static_assert(ATT_LDS_END <= LDSCTL_OFF, "attention LDS");
__device__ __forceinline__ int crow(int r, int hi) { return (r & 3) + 8 * (r >> 2) + 4 * hi; }

struct ItemRegs { bf16x8 qf[4]; v4u kreg[4], vreg[4]; unsigned koff, voff; };
__device__ __forceinline__ int first_tile(int tq0, int d) { const int k = (97 * d - tq0 + 32 * d - 1) / (32 * d); return k < 0 ? 0 : (k > 4 ? 4 : k); }
struct ItemOut { f32x16 o0, o1; float lsum; };
#define ATT_LOAD_K(R, KT) do { const char* kb_ = (const char*)Kb + ((long)(tq0 + (-128 + 32 * (KT)) * d) * DM) * 2; \
        _Pragma("unroll") for (int i = 0; i < 4; ++i) (R).kreg[i] = *(const v4u*)(kb_ + (R).koff + (unsigned)((i & 1) * 16 * d * DM * 2) + 64 * (i >> 1)); } while (0)
#define ATT_LOAD_V(R, KT) do { const char* vb_ = (const char*)Vb + ((long)(tq0 + (-128 + 32 * (KT)) * d) * DM) * 2; \
        _Pragma("unroll") for (int i = 0; i < 4; ++i) (R).vreg[i] = *(const v4u*)(vb_ + (R).voff + (unsigned)(i * 8 * d * DM * 2)); } while (0)
template <int NQ>
__device__ __forceinline__ void item_load(ItemRegs& R, const bf16* Qb, const bf16* Kb, const bf16* Vb, int tq0, int d, int lane) {
    const int c = lane & 31, hi = lane >> 5;
    const bf16* qp = Qb + (size_t)(tq0 + (NQ == 32 ? c : (c & 15)) * d) * DM + 8 * hi;
#pragma unroll
    for (int ks = 0; ks < 4; ++ks) R.qf[ks] = *(const bf16x8*)(qp + 16 * ks);
    R.koff = (unsigned)(((lane >> 2) * d * DM + 8 * (lane & 3)) * 2); R.voff = (unsigned)(((lane >> 3) * d * DM + 8 * (lane & 7)) * 2);
    { const int kt0 = 97 * d - tq0 > 0 ? first_tile(tq0, d) : 0; ATT_LOAD_K(R, kt0); ATT_LOAD_V(R, kt0); }
}
template <int NQ>
__device__ __forceinline__ void item_tiles(ItemRegs& R, ItemOut& O, const bf16* Kb, const bf16* Vb, int tq0, int d, int pat, LAS unsigned char* lds, int wave, int lane) {
    const int c = lane & 31, hi = lane >> 5;
    LAS unsigned char* vst = lds + VST_OFF + wave * VST_BYTES;
    const LAS float* lut = (const LAS float*)(lds + LUT_OFF) + pat * LUTP + 31;
    f32x16 o0 = {}, o1 = {};
    float lsum = 0.f;
    const int lrow = lane >> 3, lch = lane & 7;
    const int stoff = lrow * 128 + ((lch ^ lrow) << 4);
    const int kwoff = (lane >> 2) * 64 + (((lane & 3) ^ ((lane >> 4) & 3)) << 4);
    const int q4 = (lane & 15) >> 2, odd = (lane >> 4) & 1, p4 = lane & 3;
#pragma unroll 1
    for (int kt = (97 * d - tq0 > 0 ? first_tile(tq0, d) : 0); kt < 5; ++kt) {
        bf16x8 kf[4];
#pragma unroll
        for (int h2 = 0; h2 < 2; ++h2) {
#pragma unroll
            for (int i = 0; i < 2; ++i) *(LAS v4u*)(vst + i * 1024 + kwoff) = R.kreg[2 * h2 + i];
#pragma unroll
            for (int ksl = 0; ksl < 2; ++ksl) kf[2 * h2 + ksl] = *(const LAS bf16x8*)(vst + c * 64 + (((2 * ksl + hi) ^ ((c >> 2) & 3)) << 4));
        }
        bf16x8 vb[2][2];
#pragma unroll
        for (int s = 0; s < 2; ++s) {
#pragma unroll
            for (int i = 0; i < 2; ++i) *(LAS v4u*)(vst + i * 1024 + stoff) = R.vreg[2 * s + i];
#pragma unroll
            for (int dh = 0; dh < 2; ++dh) {
                const int kr = 4 * hi + q4, ch16 = 4 * dh + 2 * odd + (p4 >> 1);
                const LAS unsigned char* vp0 = vst + kr * 128 + ((ch16 ^ (kr & 7)) << 4) + (p4 & 1) * 8;
                const LAS unsigned char* vp1 = vst + (kr + 8) * 128 + ((ch16 ^ (kr & 7)) << 4) + (p4 & 1) * 8;
                const v4i16_t lo = __builtin_amdgcn_ds_read_tr16_b64_v4i16((LAS v4i16_t*)vp0), hh = __builtin_amdgcn_ds_read_tr16_b64_v4i16((LAS v4i16_t*)vp1);
                vb[s][dh] = (bf16x8){lo[0], lo[1], lo[2], lo[3], hh[0], hh[1], hh[2], hh[3]};
            }
        }
        asm volatile("" ::: "memory");
        if (kt < 4) { ATT_LOAD_K(R, kt + 1); ATT_LOAD_V(R, kt + 1); }
        const int relb = c + 128 - 32 * kt - 4 * hi, tkb = tq0 + (-128 + 32 * kt + 4 * hi) * d;
        const bool edge = tq0 + (-128 + 32 * kt) * d < 0;
        f32x16 st;
        if (edge) {
#pragma unroll
            for (int r = 0; r < 16; ++r) { const int rel = relb - ((r & 3) + 8 * (r >> 2)); st[r] = lut[rel < 0 ? 0 : (rel > 128 ? 128 : rel)]; }
        } else {
#pragma unroll
            for (int r = 0; r < 16; ++r) st[r] = lut[relb - ((r & 3) + 8 * (r >> 2))];
        }
#pragma unroll
        for (int ks = 0; ks < 4; ++ks) st = __builtin_amdgcn_mfma_f32_32x32x16_bf16(kf[ks], R.qf[ks], st, 0, 0, 0);
        if (edge) {
#pragma unroll
            for (int r = 0; r < 16; ++r) {
                const int kk = (r & 3) + 8 * (r >> 2), rel = relb - kk;
                const bool valid = (rel >= 0) && (rel <= 128) && (tkb + kk * d >= 0);
                const float pe = __builtin_amdgcn_exp2f(st[r]), p = valid ? pe : 0.f;
                st[r] = p; lsum += p;
            }
        } else {
#pragma unroll
            for (int r = 0; r < 16; ++r) { const float p = __builtin_amdgcn_exp2f(st[r]); st[r] = p; lsum += p; }
        }
        u32x4 pw0, pw1;
        pw0.x = cvtpk_s(st[0], st[1]); pw0.y = cvtpk_s(st[2], st[3]); pw0.z = cvtpk_s(st[4], st[5]); pw0.w = cvtpk_s(st[6], st[7]);
        pw1.x = cvtpk_s(st[8], st[9]); pw1.y = cvtpk_s(st[10], st[11]); pw1.z = cvtpk_s(st[12], st[13]); pw1.w = cvtpk_s(st[14], st[15]);
        const bf16x8 pa0 = __builtin_bit_cast(bf16x8, pw0), pa1 = __builtin_bit_cast(bf16x8, pw1);
        o0 = __builtin_amdgcn_mfma_f32_32x32x16_bf16(pa0, vb[0][0], o0, 0, 0, 0);
        o1 = __builtin_amdgcn_mfma_f32_32x32x16_bf16(pa0, vb[0][1], o1, 0, 0, 0);
        o0 = __builtin_amdgcn_mfma_f32_32x32x16_bf16(pa1, vb[1][0], o0, 0, 0, 0);
        o1 = __builtin_amdgcn_mfma_f32_32x32x16_bf16(pa1, vb[1][1], o1, 0, 0, 0);
    }
    lsum += __shfl_xor(lsum, 32);
    O.o0 = o0; O.o1 = o1; O.lsum = lsum;
}
template <int NQ, bool ACC>
__device__ __forceinline__ void item_acc(const ItemOut& O, int toff, int d, LAS unsigned char* lds, int lane) {
    const int c = lane & 31, hi = lane >> 5;
    LAS float* oacc = (LAS float*)(lds + OACC_OFF); LAS float* lacc = (LAS float*)(lds + LACC_OFF);
    constexpr int NR = NQ == 32 ? 16 : 8;
    LAS float* base = oacc + (toff + 4 * hi * d) * OPITCH + c;
    float a0[NR], a1[NR], lo = 0.f;
    if (ACC) {
#pragma unroll
        for (int r = 0; r < NR; ++r) { const LAS float* row = base + ((r & 3) + 8 * (r >> 2)) * d * OPITCH; a0[r] = row[0]; a1[r] = row[32]; }
        if (hi == 0 && c < NQ) lo = lacc[toff + c * d];
        asm volatile("" ::: "memory");
    }
#pragma unroll
    for (int r = 0; r < NR; ++r) { LAS float* row = base + ((r & 3) + 8 * (r >> 2)) * d * OPITCH; row[0] = ACC ? a0[r] + O.o0[r] : O.o0[r]; row[32] = ACC ? a1[r] + O.o1[r] : O.o1[r]; }
    if (hi == 0 && c < NQ) lacc[toff + c * d] = ACC ? lo + O.lsum : O.lsum;
}

__device__ __forceinline__ void unit(Frame& F, int uidx, int& lut_h) {
    const int span = uidx % NSPAN, bh = uidx / NSPAN, h = bh % NH, b = bh / NH, t0 = span * SPAN;
    LAS unsigned char* lds = F.lds;
    LAS float* oacc = (LAS float*)(lds + OACC_OFF); LAS float* lacc = (LAS float*)(lds + LACC_OFF); LAS float* lut = (LAS float*)(lds + LUT_OFF);
    const bool newlut = h != lut_h; lut_h = h;
    if (newlut) for (int i = F.tid; i < 3 * LUTP; i += NWAVES * 64) { const int pat = i / LUTP, rel = i - pat * LUTP - 31, d = pat == 0 ? 1 : (pat == 1 ? 4 : 16);
        lut[i] = (rel >= 0 && rel <= 128) ? F.I.rel_bias[t5_bucket(rel * d) * NH + h] * LOG2E : -1e30f; }
    const size_t boff = (size_t)b * SEQ * DM + h * HD;
    const bf16 *Qb = F.Q + boff, *Kb = F.K + boff, *Vb = F.V + boff;
    const int w = F.wave, lane = F.lane;
    ItemRegs R; ItemOut O;
    const int tqA0 = t0 + 64 * w, tqA1 = tqA0 + 32, tqB0 = t0 + (w & 3) + 256 * (w >> 2), tqB1 = tqB0 + 128, tqC0 = t0 + w, tqC1 = t0 + w + 8;
    item_load<32>(R, Qb, Kb, Vb, tqA0, 1, lane);
    if (newlut) __syncthreads();
    item_tiles<32>(R, O, Kb, Vb, tqA0, 1, 0, lds, w, lane);
    item_load<32>(R, Qb, Kb, Vb, tqA1, 1, lane);
    item_acc<32, false>(O, tqA0 - t0, 1, lds, lane);
    item_tiles<32>(R, O, Kb, Vb, tqA1, 1, 0, lds, w, lane);
    item_load<32>(R, Qb, Kb, Vb, tqB0, 4, lane);
    item_acc<32, false>(O, tqA1 - t0, 1, lds, lane);
    __syncthreads();
    item_tiles<32>(R, O, Kb, Vb, tqB0, 4, 1, lds, w, lane);
    item_load<32>(R, Qb, Kb, Vb, tqB1, 4, lane);
    item_acc<32, true>(O, tqB0 - t0, 4, lds, lane);
    item_tiles<32>(R, O, Kb, Vb, tqB1, 4, 1, lds, w, lane);
    item_load<32>(R, Qb, Kb, Vb, tqC0, 16, lane);
    item_acc<32, true>(O, tqB1 - t0, 4, lds, lane);
    __syncthreads();
    item_tiles<32>(R, O, Kb, Vb, tqC0, 16, 2, lds, w, lane);
    item_load<32>(R, Qb, Kb, Vb, tqC1, 16, lane);
    item_acc<32, true>(O, tqC0 - t0, 16, lds, lane);
    item_tiles<32>(R, O, Kb, Vb, tqC1, 16, 2, lds, w, lane);
    item_acc<32, true>(O, tqC1 - t0, 16, lds, lane);
    v4u g[2][4];
#pragma unroll
    for (int ps = 0; ps < 2; ++ps) { const bf16* gp = F.Gb + ((size_t)b * SEQ + t0 + 64 * w + 32 * ps + (lane >> 1)) * DM + h * HD + 32 * (lane & 1);
#pragma unroll
        for (int j4 = 0; j4 < 4; ++j4) g[ps][j4] = *(const v4u*)(gp + 8 * j4); }
    __syncthreads();
#pragma unroll
    for (int ps = 0; ps < 2; ++ps) {
        const int tl = 64 * w + 32 * ps + (lane >> 1), hf = lane & 1;
        bf16* ap = F.AU + ((size_t)b * SEQ + t0 + tl) * 2048 + 1024 + h * HD + 32 * hf;
        const float rl = __builtin_amdgcn_rcpf(lacc[tl]);
        const LAS f32x4* op = (const LAS f32x4*)(oacc + tl * OPITCH + 32 * hf);
#pragma unroll
        for (int j4 = 0; j4 < 4; ++j4) {
            const f32x4 a = op[2 * j4], bq = op[2 * j4 + 1]; const v4u gg = g[ps][j4];
            v4u o;
            o.x = cvtpk_s(a[0] * rl * __uint_as_float(gg.x << 16), a[1] * rl * __uint_as_float(gg.x & 0xffff0000u));
            o.y = cvtpk_s(a[2] * rl * __uint_as_float(gg.y << 16), a[3] * rl * __uint_as_float(gg.y & 0xffff0000u));
            o.z = cvtpk_s(bq[0] * rl * __uint_as_float(gg.z << 16), bq[1] * rl * __uint_as_float(gg.z & 0xffff0000u));
            o.w = cvtpk_s(bq[2] * rl * __uint_as_float(gg.w << 16), bq[3] * rl * __uint_as_float(gg.w & 0xffff0000u));
            *(v4u*)(ap + 8 * j4) = o;
        }
    }
    __syncthreads();
}

}

namespace ssd {
typedef float f32x16 __attribute__((ext_vector_type(16)));
typedef short v4i16_t __attribute__((ext_vector_type(4)));
typedef unsigned u32x2 __attribute__((ext_vector_type(2)));
typedef float f32x2v __attribute__((ext_vector_type(2)));
constexpr int PITCH = 272;
constexpr int BT_OFF = 0, CT_OFF = 34816, G_OFF = 69632, HB_OFF = 104448, XD_OFF = 121856, XH_OFF = 138240, ACS_OFF = 154624, DTL_OFF = ACS_OFF + 512, SSQL_OFF = DTL_OFF + 512  , XW_OFF = SSQL_OFF + 1024  , FW_OFF = XW_OFF + 1280  , SSD_LDS_END = FW_OFF + 5120;
static_assert(SSD_LDS_END <= LDSCTL_OFF, "SSD LDS");
__device__ __forceinline__ int crow(int r, int hi) { return (r & 3) + 8 * (r >> 2) + 4 * hi; }
__device__ __forceinline__ bf16x8 trfrag(const LAS unsigned char* p0, const LAS unsigned char* p1) {
    const v4i16_t lo = __builtin_amdgcn_ds_read_tr16_b64_v4i16((LAS v4i16_t*)p0), hh = __builtin_amdgcn_ds_read_tr16_b64_v4i16((LAS v4i16_t*)p1);
    return (bf16x8){lo[0], lo[1], lo[2], lo[3], hh[0], hh[1], hh[2], hh[3]};
}
__device__ __forceinline__ float bflo(unsigned w) { return __uint_as_float(w << 16); }
__device__ __forceinline__ float bfhi(unsigned w) { return __uint_as_float(w & 0xffff0000u); }

constexpr int NSEG = 2;
__device__ __forceinline__ int seg_begin(int s) { return NSEG == 2 ? (s == 0 ? 0 : (s == 1 ? 32 : 64)) : (s == 0 ? 0 : (s == 1 ? 20 : (s == 2 ? 42 : 64))); }
__device__ __forceinline__ void chain(Frame& F, int item) {
    const Ins& I = F.I;
    const int bg = item / (8 * NSEG), li = item % (8 * NSEG), b = bg >> 1, hd = (bg & 1) * 8 + li / NSEG, seg = li % NSEG, grp = hd >> 3;
    constexpr int NCH = SEQ / 128; const int ch_begin = seg_begin(seg), ch_end = seg_begin(seg + 1);
    const int tid = F.tid, lane = F.lane, w = F.wave, c = lane & 31, hi = lane >> 5;
    LAS unsigned char* lds = F.lds;
    LAS float* acs = (LAS float*)(lds + ACS_OFF); LAS float* dtl = (LAS float*)(lds + DTL_OFF); LAS float* ssql = (LAS float*)(lds + SSQL_OFF);
    const float A = -__expf(I.a_log[hd]), dsk = I.d_skip[hd];
    const size_t row0 = (size_t)b * SEQ;
    for (int i = tid; i < 17408 / 16; i += NWAVES * 64) ((LAS v4u*)(lds + HB_OFF))[i] = (v4u){0u, 0u, 0u, 0u};
    f32x16 hacc = {};
    const int pt = w & 1, jt = w >> 1;
    const int q4 = (lane & 15) >> 2, odd = (lane >> 4) & 1, p4 = lane & 3;
    const int xtr = (8 * hi + q4) * 64 + (16 * odd + 4 * p4) * 2;
    const int xg = tid & 15, xr0 = (tid >> 4) * 4;
    const int fb = tid >> 8, fc = tid & 255;
    for (int i = tid; i < 5 * 64 + 5 * 256; i += NWAVES * 64) {
        if (i < 320) { const int t = i >> 6, e = i & 63; ((LAS float*)(lds + XW_OFF))[i] = t < 4 ? I.conv_w[t * CONVD + hd * 64 + e] : I.conv_b[hd * 64 + e]; }
        else { const int k = i - 320, t = k >> 8, e = k & 255, chn = 1024 + (e < 128 ? grp * 128 + e : 256 + grp * 128 + (e - 128)); ((LAS float*)(lds + FW_OFF))[k] = t < 4 ? I.conv_w[t * CONVD + chn] : I.conv_b[chn]; }
    }
    const int xoff = ((xg >> 3) << 10) + (xg & 7) * 8;
    float dtp0, dtp1; u32x2 xr[7]; v4u bcr[8]; float fxr[6]; u32x2 zr[4];
#define SSD_PREFETCH(T0) do { int t0_ = (T0), tv_ = tid, lv_ = lane; asm volatile("" : "+v"(t0_), "+v"(tv_), "+v"(lv_)); \
        const int xg_ = tv_ & 15, xr0_ = (tv_ >> 4) * 4, fb_ = tv_ >> 8, fc_ = tv_ & 255, fch_ = fc_ < 128 ? grp * 128 + fc_ : 256 + grp * 128 + (fc_ - 128); \
        { const float* dp_ = F.DT + (size_t)hd * MROWS + row0 + t0_ + 2 * lv_; dtp0 = dp_[0]; dtp1 = dp_[1]; } \
        { const bf16* xp_ = F.XBC + (row0 + t0_ + xr0_) * CONVD + hd * 64 + 4 * xg_; \
          _Pragma("unroll") for (int j = 0; j < 7; ++j) xr[j] = (t0_ + xr0_ - 3 + j) >= 0 ? *(const u32x2*)(xp_ + (j - 3) * CONVD) : (u32x2){0u, 0u}; } \
        { const bf16* bp_ = F.XBC + (row0 + t0_ + (tv_ >> 4)) * CONVD + 1024 + grp * 128 + 8 * (tv_ & 15); \
          _Pragma("unroll") for (int k = 0; k < 4; ++k) { bcr[k] = *(const v4u*)(bp_ + (size_t)k * 32 * CONVD); bcr[4 + k] = *(const v4u*)(bp_ + (size_t)k * 32 * CONVD + 256); } } \
        { const size_t blk = (row0 + t0_ + 64 * fb_) >> 6; const bool hasprev = (t0_ + 64 * fb_) > 0; const float* rp_ = F.RAWB + (blk * 6) * 512 + fch_; \
          _Pragma("unroll") for (int j = 0; j < 3; ++j) { fxr[j] = hasprev ? rp_[(j - 6) * 512] : 0.f; fxr[3 + j] = rp_[(3 + j) * 512]; } } \
    } while (0)
#define SSD_PREFETCH_Z(T0) do { int t0_ = (T0), lv_ = lane; asm volatile("" : "+v"(t0_), "+v"(lv_)); \
        const bf16* zp_ = F.Zb + (row0 + t0_ + 32 * jt + (lv_ & 31)) * DM + hd * 64 + 32 * pt + 4 * (lv_ >> 5); \
        _Pragma("unroll") for (int g4 = 0; g4 < 4; ++g4) zr[g4] = *(const u32x2*)(zp_ + 8 * g4); } while (0)
    __syncthreads();
    if (ch_begin > 0) {
        float dq[4]; u32x2 xr2[11]; v4u bcr2[8]; float fxr2[6];
        LAS float* det = (LAS float*)(lds + ACS_OFF);
#define SSD_PRE2_PREFETCH(T0) do { int t0_ = (T0), tv_ = tid, lv_ = lane; asm volatile("" : "+v"(t0_), "+v"(tv_), "+v"(lv_)); \
        const int xg_ = tv_ & 15, xr0_ = (tv_ >> 4) * 8, fb_ = tv_ >> 7, fch_ = grp * 128 + (tv_ & 127); \
        { const float* dp_ = F.DT + (size_t)hd * MROWS + row0 + t0_ + 2 * lv_; dq[0] = dp_[0]; dq[1] = dp_[1]; dq[2] = dp_[128]; dq[3] = dp_[129]; } \
        { const bf16* xp_ = F.XBC + (row0 + t0_ + xr0_) * CONVD + hd * 64 + 4 * xg_; \
          _Pragma("unroll") for (int j = 0; j < 11; ++j) xr2[j] = (t0_ + xr0_ - 3 + j) >= 0 ? *(const u32x2*)(xp_ + (j - 3) * CONVD) : (u32x2){0u, 0u}; } \
        { const bf16* bp_ = F.XBC + (row0 + t0_ + (tv_ >> 4)) * CONVD + 1024 + grp * 128 + 8 * (tv_ & 15); \
          _Pragma("unroll") for (int k = 0; k < 8; ++k) bcr2[k] = *(const v4u*)(bp_ + (size_t)k * 32 * CONVD); } \
        { const size_t blk = (row0 + t0_ + 64 * fb_) >> 6; const bool hasprev = (t0_ + 64 * fb_) > 0; const float* rp_ = F.RAWB + (blk * 6) * 512 + fch_; \
          _Pragma("unroll") for (int j = 0; j < 3; ++j) { fxr2[j] = hasprev ? rp_[(j - 6) * 512] : 0.f; fxr2[3 + j] = rp_[(3 + j) * 512]; } } \
    } while (0)
        SSD_PRE2_PREFETCH(0);
#pragma unroll 1
        for (int cp = 0; cp < ch_begin / 2; ++cp) {
            const int t0 = cp * 256;
            float atot;
            {
                const float v0 = dq[0] * A, v1 = dq[1] * A, v2 = dq[2] * A, v3 = dq[3] * A; float s1 = v0 + v1, s2 = v2 + v3;
#define SSD_DPP_ADD2(S, CTRL, RMASK, BC) S += __builtin_bit_cast(float, __builtin_amdgcn_update_dpp(0, __builtin_bit_cast(int, S), CTRL, RMASK, 0xf, BC))
                SSD_DPP_ADD2(s1, 0x111, 0xf, true); SSD_DPP_ADD2(s1, 0x112, 0xf, true); SSD_DPP_ADD2(s1, 0x114, 0xf, true); SSD_DPP_ADD2(s1, 0x118, 0xf, true); SSD_DPP_ADD2(s1, 0x142, 0xa, false); SSD_DPP_ADD2(s1, 0x143, 0xc, false);
                SSD_DPP_ADD2(s2, 0x111, 0xf, true); SSD_DPP_ADD2(s2, 0x112, 0xf, true); SSD_DPP_ADD2(s2, 0x114, 0xf, true); SSD_DPP_ADD2(s2, 0x118, 0xf, true); SSD_DPP_ADD2(s2, 0x142, 0xa, false); SSD_DPP_ADD2(s2, 0x143, 0xc, false);
#undef SSD_DPP_ADD2
                const float tot1 = __builtin_bit_cast(float, __builtin_amdgcn_readlane(__builtin_bit_cast(int, s1), 63));
                const float tot2 = __builtin_bit_cast(float, __builtin_amdgcn_readlane(__builtin_bit_cast(int, s2), 63));
                atot = tot1 + tot2;
                *(LAS f32x2v*)(det + 2 * lane) = (f32x2v){dq[0] * __expf(atot - (s1 - v1)), dq[1] * __expf(atot - s1)};
                *(LAS f32x2v*)(det + 128 + 2 * lane) = (f32x2v){dq[2] * __expf(tot2 - (s2 - v3)), dq[3] * __expf(tot2 - s2)};
            }
#pragma unroll
            for (int k = 0; k < 8; ++k) { const int row = (tid >> 4) + 32 * k; if ((row & 63) >= 3) *(LAS v4u*)(lds + BT_OFF + row * PITCH + 16 * (tid & 15)) = bcr2[k]; }
            {   const int fb2 = tid >> 7, fc2 = tid & 127;
                LAS unsigned char* dst = lds + BT_OFF + 2 * fc2 + 64 * fb2 * PITCH;
                const LAS float* fwp = (const LAS float*)(lds + FW_OFF) + fc2;
                const float fw0 = fwp[0], fw1 = fwp[256], fw2 = fwp[512], fw3 = fwp[768], fbias = fwp[1024];
#pragma unroll
                for (int j = 0; j < 3; ++j) *(LAS bf16*)(dst + j * PITCH) = (bf16)f2bf(silu_fast(fbias + fw0 * fxr2[j] + fw1 * fxr2[j + 1] + fw2 * fxr2[j + 2] + fw3 * fxr2[j + 3]));
            }
            {
                const LAS f32x4* xwp = (const LAS f32x4*)(lds + XW_OFF) + xg;
                const f32x4 xw0 = xwp[0], xw1 = xwp[16], xw2 = xwp[32], xw3 = xwp[48], xb = xwp[64];
                float xv[11][4];
#pragma unroll
                for (int j = 0; j < 11; ++j) { xv[j][0] = bflo(xr2[j].x); xv[j][1] = bfhi(xr2[j].x); xv[j][2] = bflo(xr2[j].y); xv[j][3] = bfhi(xr2[j].y); }
                const int xr8 = (tid >> 4) * 8;
#pragma unroll
                for (int i = 0; i < 8; ++i) {
                    const int s = xr8 + i; const float de = det[s]; float v[4];
#pragma unroll
                    for (int e = 0; e < 4; ++e) v[e] = silu_fast(xb[e] + xw0[e] * xv[i][e] + xw1[e] * xv[i + 1][e] + xw2[e] * xv[i + 2][e] + xw3[e] * xv[i + 3][e]);
                    *(LAS u32x2*)(lds + G_OFF + ((s >> 4) << 11) + xoff + (s & 15) * 64) = (u32x2){cvtpk_s(v[0] * de, v[1] * de), cvtpk_s(v[2] * de, v[3] * de)};
                }
            }
            asm volatile("" ::: "memory"); __builtin_amdgcn_sched_barrier(0);
            if (cp + 1 < ch_begin / 2) SSD_PRE2_PREFETCH(t0 + 256);
            __syncthreads();
            {   const float ea = __expf(atot);
#pragma unroll
                for (int r = 0; r < 16; ++r) hacc[r] *= ea;
                const int btr = (8 * hi + q4) * PITCH + (32 * jt + 16 * odd + 4 * p4) * 2;
#pragma unroll 4
                for (int ks = 0; ks < 16; ++ks) {
                    const LAS unsigned char* xp = lds + G_OFF + ((ks * 2 + pt) << 10) + xtr;
                    const LAS unsigned char* bp = lds + BT_OFF + 16 * ks * PITCH + btr;
                    hacc = __builtin_amdgcn_mfma_f32_32x32x16_bf16(trfrag(xp, xp + 256), trfrag(bp, bp + 4 * PITCH), hacc, 0, 0, 0);
                }
            }
            __syncthreads();
        }
#undef SSD_PRE2_PREFETCH
#pragma unroll
        for (int r = 0; r < 16; ++r) *(LAS bf16*)(lds + HB_OFF + (32 * pt + crow(r, hi)) * PITCH + (32 * jt + c) * 2) = (bf16)f2bf(hacc[r]);
        __syncthreads();
    }
    SSD_PREFETCH(ch_begin * 128); SSD_PREFETCH_Z(ch_begin * 128);
#pragma unroll 1
    for (int ch = ch_begin; ch < ch_end; ++ch) {
        const int t0 = ch * 128;
        const bool pre = false, prevfull = ch > ch_begin;
        float aend;
        {
            if (w < 2 && prevfull) { F.SSQ[(row0 + t0 - 128 + lane) * 32 + 2 * hd + w] = ssql[128 * w + lane]; F.SSQ[(row0 + t0 - 64 + lane) * 32 + 2 * hd + w] = ssql[128 * w + 64 + lane]; }
            const float v0 = dtp0 * A, v1 = dtp1 * A; float s = v0 + v1;
#define SSD_DPP_ADD(CTRL, RMASK, BC) s += __builtin_bit_cast(float, __builtin_amdgcn_update_dpp(0, __builtin_bit_cast(int, s), CTRL, RMASK, 0xf, BC))
            SSD_DPP_ADD(0x111, 0xf, true); SSD_DPP_ADD(0x112, 0xf, true); SSD_DPP_ADD(0x114, 0xf, true); SSD_DPP_ADD(0x118, 0xf, true);
            SSD_DPP_ADD(0x142, 0xa, false); SSD_DPP_ADD(0x143, 0xc, false);
#undef SSD_DPP_ADD
            aend = __builtin_bit_cast(float, __builtin_amdgcn_readlane(__builtin_bit_cast(int, s), 63));
            *(LAS f32x2v*)(acs + 2 * lane) = (f32x2v){s - v1, s}; *(LAS f32x2v*)(dtl + 2 * lane) = (f32x2v){dtp0, dtp1};
        }
#pragma unroll
        for (int k = 0; k < 4; ++k) { const int idx = tid + 512 * k, row = idx >> 4;
            if ((row & 63) >= 3) { *(LAS v4u*)(lds + BT_OFF + row * PITCH + 16 * (idx & 15)) = bcr[k]; if (!pre) *(LAS v4u*)(lds + CT_OFF + row * PITCH + 16 * (idx & 15)) = bcr[4 + k]; } }
        if (!pre || fc < 128) {
            LAS unsigned char* dst = lds + (fc < 128 ? BT_OFF + 2 * fc : CT_OFF + 2 * (fc - 128)) + 64 * fb * PITCH;
            const LAS float* fwp = (const LAS float*)(lds + FW_OFF) + fc;
            const float fw0 = fwp[0], fw1 = fwp[256], fw2 = fwp[512], fw3 = fwp[768], fbias = fwp[1024];
#pragma unroll
            for (int j = 0; j < 3; ++j) *(LAS bf16*)(dst + j * PITCH) = (bf16)f2bf(silu_fast(fbias + fw0 * fxr[j] + fw1 * fxr[j + 1] + fw2 * fxr[j + 2] + fw3 * fxr[j + 3]));
        }
        {
            const LAS f32x4* xwp = (const LAS f32x4*)(lds + XW_OFF) + xg;
            const f32x4 xw0 = xwp[0], xw1 = xwp[16], xw2 = xwp[32], xw3 = xwp[48], xb = xwp[64];
            float xv[7][4];
#pragma unroll
            for (int j = 0; j < 7; ++j) { xv[j][0] = bflo(xr[j].x); xv[j][1] = bfhi(xr[j].x); xv[j][2] = bflo(xr[j].y); xv[j][3] = bfhi(xr[j].y); }
#pragma unroll
            for (int i = 0; i < 4; ++i) {
                const int s = xr0 + i; const float dt = dtl[s], de = dt * __expf(aend - acs[s]); float v[4];
#pragma unroll
                for (int e = 0; e < 4; ++e) v[e] = silu_fast(xb[e] + xw0[e] * xv[i][e] + xw1[e] * xv[i + 1][e] + xw2[e] * xv[i + 2][e] + xw3[e] * xv[i + 3][e]);
                const int off = ((s >> 4) << 11) + xoff + (s & 15) * 64;
                if (!pre) *(LAS u32x2*)(lds + XD_OFF + off) = (u32x2){cvtpk_s(v[0] * dt, v[1] * dt), cvtpk_s(v[2] * dt, v[3] * dt)};
                *(LAS u32x2*)(lds + XH_OFF + off) = (u32x2){cvtpk_s(v[0] * de, v[1] * de), cvtpk_s(v[2] * de, v[3] * de)};
            }
        }
        asm volatile("" ::: "memory"); __builtin_amdgcn_sched_barrier(0);
        if (ch + 1 < ch_end) SSD_PREFETCH(t0 + 128);
        __syncthreads();
        f32x16 yt = {};
        if (!pre) {
        {
            const int j = w & 3; const float al = acs[32 * j + c];
#pragma unroll
            for (int ii = 0; ii < 2; ++ii) {
                const int i = 2 * (w >> 2) + ii;
                if (i <= j) {
                    f32x16 x = {};
                    const LAS unsigned char* ap = lds + BT_OFF + (32 * i + c) * PITCH + 16 * hi;
                    const LAS unsigned char* bp = lds + CT_OFF + (32 * j + c) * PITCH + 16 * hi;
#pragma unroll 4
                    for (int ks = 0; ks < 8; ++ks) x = __builtin_amdgcn_mfma_f32_32x32x16_bf16(*(const LAS bf16x8*)(ap + 32 * ks), *(const LAS bf16x8*)(bp + 32 * ks), x, 0, 0, 0);
                    const int l = 32 * j + c;
#pragma unroll
                    for (int g4 = 0; g4 < 4; ++g4) {
                        const int sb = 32 * i + 8 * g4 + 4 * hi; float gv[4];
                        const f32x4 as4 = *(const LAS f32x4*)(acs + sb);
#pragma unroll
                        for (int e = 0; e < 4; ++e) { const int s = sb + e; gv[e] = s <= l ? x[4 * g4 + e] * __builtin_amdgcn_exp2f((al - as4[e]) * LOG2E) : 0.f; }
                        *(LAS u32x2*)(lds + G_OFF + l * PITCH + sb * 2) = (u32x2){cvtpk_s(gv[0], gv[1]), cvtpk_s(gv[2], gv[3])};
                    }
                }
            }
        }
        {
            const LAS unsigned char* ap = lds + HB_OFF + (32 * pt + c) * PITCH + 16 * hi;
            const LAS unsigned char* bp = lds + CT_OFF + (32 * jt + c) * PITCH + 16 * hi;
#pragma unroll 4
            for (int ks = 0; ks < 8; ++ks) yt = __builtin_amdgcn_mfma_f32_32x32x16_bf16(*(const LAS bf16x8*)(ap + 32 * ks), *(const LAS bf16x8*)(bp + 32 * ks), yt, 0, 0, 0);
            const float el = __expf(acs[32 * jt + c]);
#pragma unroll
            for (int r = 0; r < 16; ++r) yt[r] *= el;
        }
        __syncthreads();
        {
            const LAS unsigned char* bp = lds + G_OFF + (32 * jt + c) * PITCH + 16 * hi;
            for (int ks = 0; ks < 2 * jt + 2; ++ks) {
                const LAS unsigned char* xp = lds + XD_OFF + ((ks * 2 + pt) << 10) + xtr;
                yt = __builtin_amdgcn_mfma_f32_32x32x16_bf16(trfrag(xp, xp + 256), *(const LAS bf16x8*)(bp + 32 * ks), yt, 0, 0, 0);
            }
        }
        }
        {
            const float ea = __expf(aend);
#pragma unroll
            for (int r = 0; r < 16; ++r) hacc[r] *= ea;
            const int btr = (8 * hi + q4) * PITCH + (32 * jt + 16 * odd + 4 * p4) * 2;
#pragma unroll 4
            for (int ks = 0; ks < 8; ++ks) {
                const LAS unsigned char* xp = lds + XH_OFF + ((ks * 2 + pt) << 10) + xtr;
                const LAS unsigned char* bp = lds + BT_OFF + 16 * ks * PITCH + btr;
                hacc = __builtin_amdgcn_mfma_f32_32x32x16_bf16(trfrag(xp, xp + 256), trfrag(bp, bp + 4 * PITCH), hacc, 0, 0, 0);
            }
        }
        {
#pragma unroll
            for (int r = 0; r < 16; r += 2) {
                *(LAS bf16*)(lds + HB_OFF + (32 * pt + crow(r, hi)) * PITCH + (32 * jt + c) * 2) = (bf16)(cvtpk_s(hacc[r], hacc[r + 1]) & 0xffffu);
                *(LAS bf16*)(lds + HB_OFF + (32 * pt + crow(r + 1, hi)) * PITCH + (32 * jt + c) * 2) = (bf16)(cvtpk_s(hacc[r], hacc[r + 1]) >> 16);
            }
        }
        if (!pre) {
            const int l = 32 * jt + c; const float rdt = dsk * __builtin_amdgcn_rcpf(dtl[l]);
            bf16* up = F.AU + (row0 + t0 + l) * 2048 + hd * 64 + 32 * pt;
            float sq = 0.f;
#pragma unroll
            for (int g4 = 0; g4 < 4; ++g4) {
                const int pl = 8 * g4 + 4 * hi;
                const u32x2 xw2 = *(const LAS u32x2*)(lds + XD_OFF + (((l >> 4) * 2 + pt) << 10) + (l & 15) * 64 + pl * 2);
                const u32x2 zw = zr[g4];
                const float u0 = (yt[4 * g4] + rdt * bflo(xw2.x)) * bflo(zw.x), u1 = (yt[4 * g4 + 1] + rdt * bfhi(xw2.x)) * bfhi(zw.x), u2 = (yt[4 * g4 + 2] + rdt * bflo(xw2.y)) * bflo(zw.y), u3 = (yt[4 * g4 + 3] + rdt * bfhi(xw2.y)) * bfhi(zw.y);
                sq += (u0 * u0 + u1 * u1) + (u2 * u2 + u3 * u3);
                *(u32x2*)(up + pl) = (u32x2){cvtpk_s(u0, u1), cvtpk_s(u2, u3)};
            }
            sq += __shfl_xor(sq, 32);
            if (hi == 0) ssql[128 * pt + l] = sq;
        }
        if (ch + 1 < ch_end) SSD_PREFETCH_Z(t0 + 128);
        __syncthreads();
    }
#undef SSD_PREFETCH
#undef SSD_PREFETCH_Z
    if (w < 2) { const int t0 = ch_end * 128; F.SSQ[(row0 + t0 - 128 + lane) * 32 + 2 * hd + w] = ssql[128 * w + lane]; F.SSQ[(row0 + t0 - 64 + lane) * 32 + 2 * hd + w] = ssql[128 * w + 64 + lane]; }
    if (seg == NSEG - 1) {
    float* ho = F.out + O_HP + (((size_t)b * NH + hd) * HD + 32 * pt) * DS + 32 * jt + c;
#pragma unroll
    for (int r = 0; r < 16; ++r) ho[(size_t)crow(r, hi) * DS] = hacc[r];
    }
    __syncthreads();
}
}

namespace smp {
__device__ __forceinline__ void attn_unit(Frame& F, int bhs) {
    const Ins& I = F.I;
    const int lane = F.lane, w = F.wave, b = bhs >> 4, h = bhs & 15, r = NTOK + b;
    LAS float* qs = (LAS float*)(F.lds + 4096); LAS float* acc = (LAS float*)F.lds;
    LAS float* ps = (LAS float*)(F.lds + 8192) + w * 64;
    if (F.tid < 64) qs[F.tid] = bf2f(F.Q[(size_t)r * DM + h * HD + F.tid]);
    if (F.tid < 65) acc[F.tid] = 0.f;
    const int k0 = 49 * w, nk = (387 - k0) < 49 ? (387 - k0) : 49;
    const float gate = bf2f(F.Gb[(size_t)r * DM + h * HD + lane]);
    const float vnew = bf2f(F.V[(size_t)r * DM + h * HD + lane]), knew = bf2f(F.K[(size_t)r * DM + h * HD + lane]);
    const float* vbase = I.cv + ((size_t)b * WIN * NH + h) * HD + lane;
    float vv[49];
#pragma unroll
    for (int k = 0; k < 49; ++k) {
        const int idx = (k0 + k) < 386 ? (k0 + k) : 386, pat = idx / 129, j = idx - pat * 129, d = pat == 0 ? 1 : (pat == 1 ? 4 : 16), jj = j > 0 ? j : 1;
        vv[k] = vbase[(size_t)(WIN - jj * d) * (NH * HD)];
    }
    const int idx = (k0 + lane) < 386 ? (k0 + lane) : 386, pat = idx / 129, j = idx - pat * 129, d = pat == 0 ? 1 : (pat == 1 ? 4 : 16), jj = j > 0 ? j : 1;
    const float bias = I.rel_bias[t5_bucket(j * d) * NH + h] * LOG2E;
    f32x4 kv[16];
    { const f32x4* kp = (const f32x4*)(I.ck + (((size_t)b * WIN + (WIN - jj * d)) * NH + h) * HD);
#pragma unroll
      for (int e = 0; e < 16; ++e) kv[e] = kp[e]; }
    __syncthreads();
    const float snew = wave_sum(qs[lane] * knew);
    float s = 0.f;
#pragma unroll
    for (int e = 0; e < 16; ++e) { const f32x4 qv = *(const LAS f32x4*)(qs + 4 * e); s += (qv[0] * kv[e][0] + qv[1] * kv[e][1]) + (qv[2] * kv[e][2] + qv[3] * kv[e][3]); }
    const float p = lane < nk ? __builtin_amdgcn_exp2f((j > 0 ? s : snew) + bias) : 0.f;
    ps[lane] = p;
    const float lsum = wave_sum(p);
    __builtin_amdgcn_wave_barrier();
    float o0 = 0.f, o1 = 0.f, o2 = 0.f, o3 = 0.f;
#define SMP_V(K) ({ const int idx_ = (k0 + (K)) < 386 ? (k0 + (K)) : 386; ps[(K)] * ((idx_ % 129) > 0 ? vv[(K)] : vnew); })
#pragma unroll
    for (int k = 0; k < 48; k += 4) { o0 += SMP_V(k); o1 += SMP_V(k + 1); o2 += SMP_V(k + 2); o3 += SMP_V(k + 3); }
    o0 += SMP_V(48);
#undef SMP_V
    __hip_atomic_fetch_add(acc + lane, (o0 + o1) + (o2 + o3), __ATOMIC_RELAXED, __HIP_MEMORY_SCOPE_WORKGROUP);
    if (lane == 0) __hip_atomic_fetch_add(acc + 64, lsum, __ATOMIC_RELAXED, __HIP_MEMORY_SCOPE_WORKGROUP);
    __syncthreads();
    if (w == 0) F.AU[(size_t)r * 2048 + 1024 + h * HD + lane] = (bf16)f2bf(acc[lane] * __builtin_amdgcn_rcpf(acc[64]) * gate);
    __syncthreads();
}

__device__ __forceinline__ void ssd_unit(Frame& F, int bhs) {
    const Ins& I = F.I;
    LAS float* xs_l = (LAS float*)F.lds; LAS float* B_l = xs_l + 64; LAS float* C_l = B_l + 128; LAS float* ssq_l = C_l + 128;
    const int tid = F.tid, p = tid >> 3, ng = tid & 7;
    const int b = bhs >> 4, hd = bhs & 15, grp = hd >> 3; const size_t r = (size_t)NTOK + b;
    float h[16];
    { const f32x4* hp = (const f32x4*)(I.sssm + (((size_t)b * NH + hd) * HD + p) * DS + ng * 16);
#pragma unroll
      for (int i = 0; i < 4; ++i) { const f32x4 v = hp[i]; h[4 * i] = v[0]; h[4 * i + 1] = v[1]; h[4 * i + 2] = v[2]; h[4 * i + 3] = v[3]; } }
    if (tid < 320) {
        const int ci = tid, c = ci < 64 ? hd * 64 + ci : (ci < 192 ? 1024 + grp * 128 + (ci - 64) : 1280 + grp * 128 + (ci - 192));
        float v = I.conv_b[c];
#pragma unroll
        for (int i = 0; i < 3; ++i) v += I.sconv[((size_t)b * 3 + i) * CONVD + c] * I.conv_w[i * CONVD + c];
        v += bf2f(F.XBC[r * CONVD + c]) * I.conv_w[3 * CONVD + c];
        xs_l[ci] = silu_f(v);
    }
    if (tid == 0) ssq_l[0] = 0.f;
    const float dt = F.DT[(size_t)hd * MROWS + r], A = -__expf(I.a_log[hd]), dsk = I.d_skip[hd], zg = bf2f(F.Zb[r * DM + hd * 64 + p]);
    __syncthreads();
    const float x = xs_l[p], dec = __expf(dt * A), xdt = x * dt;
    float y = 0.f;
#pragma unroll
    for (int i = 0; i < 16; ++i) { h[i] = h[i] * dec + xdt * B_l[ng * 16 + i]; y += h[i] * C_l[ng * 16 + i]; }
    y += __shfl_xor(y, 1); y += __shfl_xor(y, 2); y += __shfl_xor(y, 4);
    if (ng == 0) {
        const float u = (y + dsk * x) * zg;
        F.AU[r * 2048 + hd * 64 + p] = (bf16)f2bf(u);
        __hip_atomic_fetch_add(ssq_l, u * u, __ATOMIC_RELAXED, __HIP_MEMORY_SCOPE_WORKGROUP);
    }
    { f32x4* ho = (f32x4*)(F.out + O_HS + (((size_t)b * NH + hd) * HD + p) * DS + ng * 16);
#pragma unroll
      for (int i = 0; i < 4; ++i) ho[i] = (f32x4){h[4 * i], h[4 * i + 1], h[4 * i + 2], h[4 * i + 3]}; }
    __syncthreads();
    if (tid == 0) { F.SSQ[r * 32 + 2 * hd] = ssq_l[0]; F.SSQ[r * 32 + 2 * hd + 1] = 0.f; }
    __syncthreads();
}
}

namespace smp {
typedef float f32x16s __attribute__((ext_vector_type(16)));
template <int KS>
__device__ __forceinline__ void mm32x32(Frame& F, const bf16* WT, int wrow0, const bf16* A, int apitch, int K) {
    const int lane = F.lane, w = F.wave, c = lane & 31, hi = lane >> 5;
    const bf16* ap = WT + (size_t)(wrow0 + c) * K + w * (16 * KS) + 8 * hi;
    const bf16* bp = A + (size_t)c * apitch + w * (16 * KS) + 8 * hi;
    bf16x8 af[KS], bf[KS];
#pragma unroll
    for (int ks = 0; ks < KS; ++ks) { af[ks] = *(const bf16x8*)(ap + 16 * ks); bf[ks] = *(const bf16x8*)(bp + 16 * ks); }
    f32x16s acc = {};
#pragma unroll
    for (int ks = 0; ks < KS; ++ks) acc = __builtin_amdgcn_mfma_f32_32x32x16_bf16(af[ks], bf[ks], acc, 0, 0, 0);
    LAS float* red = (LAS float*)F.lds + w * 1024;
#pragma unroll
    for (int r = 0; r < 16; ++r) red[((r & 3) + 8 * (r >> 2) + 4 * hi) * 32 + c] = acc[r];
    __syncthreads();
}
__device__ __forceinline__ void inproj_pair(Frame& F, int hp) {
    const Ins& I = F.I;
    const int a0 = 64 * hp;
    LAS float* val = (LAS float*)(F.lds + 32768);
    const int lane = F.lane, w = F.wave;
#pragma unroll 1
    for (int hf = 0; hf < 2; ++hf) {
        const int a = a0 + 32 * hf;
        mm32x32<8>(F, F.WinT, (a & ~255) + vrow_of_col(a & 255), F.XN + (size_t)NTOK * DM, DM, DM);
        const LAS float* red = (const LAS float*)F.lds;
        { const int col = F.tid >> 4, r0 = 2 * (F.tid & 15); float s0 = 0.f, s1 = 0.f;
#pragma unroll
          for (int k = 0; k < 8; ++k) { s0 += red[k * 1024 + col * 32 + r0]; s1 += red[k * 1024 + col * 32 + r0 + 1]; }
          val[r0 * 64 + 32 * hf + col] = s0; val[(r0 + 1) * 64 + 32 * hf + col] = s1; }
        __syncthreads();
    }
#pragma unroll 1
    for (int rr = 0; rr < 4; ++rr) {
        const int r = 4 * w + rr;
        const float v = val[r * 64 + lane];
        const size_t row = (size_t)NTOK + r; const int col = a0 + lane;
        if (col < C_V) {
            const float sc = rsqrtf(wave_sum(v * v) * (1.f / 64.f) + EPS);
            if (col < C_K) F.Q[row * DM + col] = (bf16)f2bf(v * sc * I.qnw[lane] * QSCALE);
            else { const float kv = v * sc * I.knw[lane]; F.K[row * DM + col - C_K] = (bf16)f2bf(kv); F.out[O_KS + (size_t)r * DM + col - C_K] = kv; }
        } else if (col < C_G) { F.V[row * DM + col - C_V] = (bf16)f2bf(v); F.out[O_VS + (size_t)r * DM + col - C_V] = v; }
        else if (col < C_Z) F.Gb[row * DM + col - C_G] = (bf16)f2bf(silu_fast(v));
        else if (col < C_XBC) F.Zb[row * DM + col - C_Z] = (bf16)f2bf(silu_fast(v));
        else { F.XBC[row * CONVD + col - C_XBC] = (bf16)f2bf(v); F.out[O_CS + ((size_t)r * 3 + 2) * CONVD + col - C_XBC] = v; }
    }
    __syncthreads();
}
__device__ __forceinline__ void outproj_unit(Frame& F, int ct) {
    const Ins& I = F.I;
    const int a0 = 32 * ct;
    mm32x32<16>(F, F.WoutT, (a0 & ~255) + vrow_of_col(a0 & 255), F.AU + (size_t)NTOK * 2048, 2048, 2048);
    const LAS float* red = (const LAS float*)F.lds;
    const int col = F.tid >> 4, r0 = 2 * (F.tid & 15);
#pragma unroll
    for (int q = 0; q < 2; ++q) {
        const int r = r0 + q; float su = 0.f, sa = 0.f;
#pragma unroll
        for (int k = 0; k < 4; ++k) { su += red[k * 1024 + col * 32 + r]; sa += red[(4 + k) * 1024 + col * 32 + r]; }
        const f32x4* sp = (const f32x4*)(F.SSQ + ((size_t)NTOK + r) * 32); float s = 0.f;
#pragma unroll
        for (int i = 0; i < 8; ++i) { const f32x4 t = sp[i]; s += (t[0] + t[1]) + (t[2] + t[3]); }
        F.out[O_YS + (size_t)r * DM + a0 + col] = I.xs[(size_t)r * DM + a0 + col] + su * rsqrtf(s * (1.f / 1024.f) + EPS) + sa;
    }
    __syncthreads();
}
}

__device__ __forceinline__ void phase2_queue(Frame& F, int qset) {
    const unsigned x = xb_xcc_id() & 7u;
    constexpr int PER_Q = att::NUNITS / 8;
    int lut_h = -1;
    for (unsigned k = 0; k < 8; ++k) {
        const unsigned qx = (x + k) & 7u;
        gu32* qw = F.ctl + CW_Q + 64 * (8 * qset + qx);
        if (k == 1) {
            if (F.tid < 8) F.MISC[24 + F.tid] = __hip_atomic_load(F.ctl + CW_Q + 64 * (8 * qset + F.tid), RLX_AGENT);
            __syncthreads();
        }
        if (k >= 1 && F.MISC[24 + qx] >= (unsigned)(PER_Q + 128)) continue;
        if (F.tid == 0) F.MISC[16] = __hip_atomic_fetch_add(qw, 1u, RLX_AGENT);
        __syncthreads();
        unsigned idx = F.MISC[16];
        while (idx < (unsigned)(PER_Q + 128)) {
            unsigned nxt = 0u;
            if (F.tid == 0) nxt = __hip_atomic_fetch_add(qw, 1u, RLX_AGENT);
            if (idx < (unsigned)PER_Q) { att::unit(F, (int)(qx * PER_Q + idx), lut_h); }
            else if (idx < (unsigned)(PER_Q + 64)) smp::attn_unit(F, (int)(qx * 64 + idx - PER_Q));
            else smp::ssd_unit(F, (int)(qx * 64 + idx - PER_Q - 64));
            if (F.tid == 0) F.MISC[16] = nxt;
            __syncthreads();
            idx = F.MISC[16];
        }
        __syncthreads();
    }
}

constexpr int PROBE_REP_SSD = 1, PROBE_REP_ATT = 1;
struct Args { Ins in; float* out; unsigned char* ws; int ph_lo, ph_hi; };
__global__ void __launch_bounds__(NWAVES * 64, 2) mk_fwd(Args args) {
    extern __shared__ __attribute__((aligned(16))) unsigned char lds[];
    Frame F;
    F.lds = (LAS unsigned char*)lds;
    F.MISC = (volatile LAS unsigned*)(F.lds + MISC_OFF);
    F.tid = threadIdx.x; F.lane = F.tid & 63; F.wave = __builtin_amdgcn_readfirstlane(F.tid >> 6);
    F.G = gridDim.x; { const int bx = blockIdx.x; F.vcu = (F.G % 8 == 0) ? (bx % 8) * (F.G / 8) + bx / 8 : bx; }
    unsigned char* ws = args.ws;
    F.ctl = (gu32*)(ws + WS_CTL); F.I = args.in; F.out = args.out;
    F.WinT = (bf16*)(ws + WS_WIN); F.WoutT = (bf16*)(ws + WS_WOUT); F.XN = (bf16*)(ws + WS_XN); F.Q = (bf16*)(ws + WS_Q); F.K = (bf16*)(ws + WS_K); F.V = (bf16*)(ws + WS_V);
    F.AU = (bf16*)(ws + WS_AU); F.XBC = (bf16*)(ws + WS_XBC); F.DT = (float*)(ws + WS_DT); F.SSQ = (float*)(ws + WS_SSQ); F.RAWB = (float*)(ws + WS_RAWB); F.Gb = (bf16*)(ws + WS_G); F.Zb = (bf16*)(ws + WS_Z);
    for (int u = F.tid; u < (LDS_BYTES - LDSCTL_OFF) / 4; u += NWAVES * 64) ((LAS unsigned*)(F.lds + LDSCTL_OFF))[u] = 0u;
    __syncthreads();
    XcdBarrier bar = xcd_barrier_post((unsigned*)(F.ctl + CW_BAR), F.MISC + 8);
    const int lo = args.ph_lo, hi = args.ph_hi;
#define IN(k) (lo <= (k) && (k) < hi)
#define BOTH(k) (IN(k) && IN((k) + 1))
    if (IN(0)) { p0_prologue(F); if (BOTH(0)) xcd_barrier(bar); }
    if (IN(1)) {
        __syncthreads();
        pg8::Gemm g{F.XN, F.WinT, NTOK, NMAIN, DM}; pg8::StaticOrder S; S.init(NTOK, NMAIN, F.G, (int)blockIdx.x);
        pg8::EpiIn E{F.Q, F.K, F.V, F.Gb, F.Zb, F.XBC, F.out, F.I.qnw, F.I.knw, F.I.conv_w, F.I.conv_b, F.RAWB};
        pg8::gemm_phase<pg8::EpiIn, pg8::StaticOrder, true, true>(F.lds + RING_OFF, g, S, E);
        __syncthreads();
        for (int hp = F.vcu; hp < NMAIN / 64; hp += F.G) smp::inproj_pair(F, hp);
        if (BOTH(1)) xcd_barrier(bar);
    }
    if (IN(2)) { __syncthreads(); if ((F.vcu & 31) < 8 * ssd::NSEG && (F.vcu >> 5) < 8) { ssd::chain(F, (F.vcu >> 5) * (8 * ssd::NSEG) + (F.vcu & 31)); if (PROBE_ID == 30 && (F.vcu & 1)) { const unsigned long long t0_ = __builtin_amdgcn_s_memrealtime(); while (__builtin_amdgcn_s_memrealtime() - t0_ < 10000ull) __builtin_amdgcn_s_sleep(8); } } for (int rep = 0; rep < PROBE_REP_ATT; ++rep) phase2_queue(F, rep);     if (BOTH(2)) xcd_barrier(bar); }
    if (IN(3)) {
        __syncthreads();
        pg8::Gemm g{F.AU, F.WoutT, NTOK, DM, 2048}; pg8::StaticOrder S; S.init(NTOK, DM, F.G, (int)blockIdx.x);
        LAS float* rs = (LAS float*)(F.lds + RING_BYTES);
        { pg8::Unit u;
          for (int ui = 0; ui < 4 && S.next(ui, u); ++ui)
              for (int r = F.tid; r < 256; r += NWAVES * 64) {
                  const f32x4* sp = (const f32x4*)(F.SSQ + (size_t)(u.pm * 256 + r) * 32);
                  float s = 0.f;
#pragma unroll
                  for (int q = 0; q < 8; ++q) { const f32x4 v = sp[q]; s += (v[0] + v[1]) + (v[2] + v[3]); }
                  rs[ui * 256 + r] = rsqrtf(s * (1.f / 1024.f) + EPS);
              }
          __syncthreads(); }
        pg8::EpiOut E{F.I.xp, F.I.xs, rs, F.out};
        pg8::gemm_phase<pg8::EpiOut, pg8::StaticOrder, true, true>(F.lds + RING_OFF, g, S, E);
        __syncthreads();
        for (int ct = F.G - 1 - F.vcu; ct >= 0 && ct < DM / 32; ct += F.G) smp::outproj_unit(F, ct);
    }
#undef IN
#undef BOTH
}

extern "C" void kernel_launch(void* const* d_in, const int* in_sizes, int n_in, void* d_out, int out_size, void* d_ws, size_t ws_size, hipStream_t stream) {
    static int grid = 0;
    if (grid == 0) {
        if (n_in != 18 || out_size != (int)O_END || ws_size < WS_END) { fprintf(stderr, "kernel_launch: unexpected n_in %d / out_size %d / ws_size %zu; nothing launched\n", n_in, out_size, ws_size); grid = -1; return; }
        int dev = 0, cus = 0;
        if (hipGetDevice(&dev) != hipSuccess || hipDeviceGetAttribute(&cus, hipDeviceAttributeMultiprocessorCount, dev) != hipSuccess) { grid = -1; return; }
        if (hipFuncSetAttribute((const void*)mk_fwd, hipFuncAttributeMaxDynamicSharedMemorySize, LDS_BYTES) != hipSuccess) { fprintf(stderr, "kernel_launch: hipFuncSetAttribute failed\n"); grid = -1; return; }
        (void)hipGetLastError();
        grid = cus;
    }
    if (grid < 0) return;
    (void)hipMemsetAsync((char*)d_ws + WS_CTL, 0, CTL_ZERO_BYTES, stream);
    Args a{};
    const float** ip = (const float**)&a.in;
    for (int i = 0; i < 18; ++i) ip[i] = (const float*)d_in[i];
    a.out = (float*)d_out; a.ws = (unsigned char*)d_ws;
    a.ph_lo = 0; a.ph_hi = 4;
    hipLaunchKernelGGL(mk_fwd, dim3(grid), dim3(NWAVES * 64), LDS_BYTES, stream, a);
}
```

```cpp
#include <hip/hip_runtime.h>
#include <cstdio>
#include <cstdint>

constexpr int DM = 1024, NB = 4, SEQ = 8192, DB = 32, WIN = 2048;
constexpr int NPROJ = 6672, NMAIN = 6656, NTOK = NB * SEQ, NROWS = NTOK + DB;
constexpr int MROWS = 33024;
constexpr int C_Q = 0, C_K = 1024, C_V = 2048, C_G = 3072, C_Z = 4096, C_XBC = 5120, C_DT = 6656;
constexpr int CONVD = 1536, NH = 16, HD = 64, DS = 128;
constexpr float EPS = 1e-6f;
constexpr float QSCALE = 0.125f * 1.4426950408889634f;
constexpr float LOG2E = 1.4426950408889634f;
constexpr size_t O_YP = 0, O_YS = O_YP + (size_t)NTOK * DM, O_KP = O_YS + (size_t)DB * DM, O_VP = O_KP + (size_t)NB * WIN * DM,
                 O_CP = O_VP + (size_t)NB * WIN * DM, O_HP = O_CP + (size_t)NB * 3 * CONVD, O_KS = O_HP + (size_t)NB * NH * HD * DS,
                 O_VS = O_KS + (size_t)DB * DM, O_CS = O_VS + (size_t)DB * DM, O_HS = O_CS + (size_t)DB * 3 * CONVD,
                 O_END = O_HS + (size_t)DB * NH * HD * DS;
static_assert(O_END == 55314432, "output size");

constexpr size_t MiB = 1u << 20;
constexpr size_t WS_CTL = 0, CTL_ZERO_BYTES = 1 * MiB;
constexpr size_t WS_WIN = 2 * MiB;
constexpr size_t WS_WOUT = 16 * MiB;
constexpr size_t WS_DT = 20 * MiB;
constexpr size_t WS_SSQ = 24 * MiB;
constexpr size_t WS_XN = 32 * MiB;
constexpr size_t WS_Q = 100 * MiB;
constexpr size_t WS_K = 168 * MiB;
constexpr size_t WS_V = 236 * MiB;
constexpr size_t WS_AU = 304 * MiB;
constexpr size_t WS_XBC = 436 * MiB;
constexpr size_t WS_RAWB = 536 * MiB;
constexpr size_t WS_G = 544 * MiB;
constexpr size_t WS_Z = 612 * MiB;
constexpr size_t WS_END = 680 * MiB;
static_assert(WS_XN + (size_t)MROWS * DM * 2 <= WS_Q && WS_Q + (size_t)MROWS * DM * 2 <= WS_K && WS_K + (size_t)MROWS * DM * 2 <= WS_V && WS_V + (size_t)MROWS * DM * 2 <= WS_AU &&
              WS_AU + (size_t)MROWS * 2048 * 2 <= WS_XBC && WS_XBC + (size_t)MROWS * CONVD * 2 <= WS_RAWB && WS_RAWB + (size_t)(MROWS / 64) * 6 * 512 * 4 <= WS_G && WS_G + (size_t)MROWS * DM * 2 <= WS_Z && WS_Z + (size_t)MROWS * DM * 2 <= WS_END && WS_WIN + (size_t)NMAIN * DM * 2 <= WS_WOUT && WS_WOUT + (size_t)DM * 2048 * 2 <= WS_DT &&
              WS_DT + (size_t)MROWS * 16 * 4 <= WS_SSQ && WS_SSQ + (size_t)MROWS * 32 * 4 <= WS_XN, "d_ws map");

struct Ins {
    const float *xp, *xs, *ck, *cv, *sconv, *sssm, *norm_w, *w_in, *qnw, *knw, *rel_bias, *conv_w, *conv_b, *dt_bias, *a_log, *d_skip, *ssd_norm_w, *w_out;
};

typedef unsigned short bf16;
__device__ __forceinline__ float wave_sum(float v) {
#pragma unroll
    for (int o = 1; o < 64; o <<= 1) v += __shfl_xor(v, o);
    return v;
}
__device__ __forceinline__ float wave_max(float v) {
#pragma unroll
    for (int o = 1; o < 64; o <<= 1) v = fmaxf(v, __shfl_xor(v, o));
    return v;
}
__device__ __forceinline__ float silu_f(float x) { return x / (1.f + __expf(-x)); }
__device__ __forceinline__ float silu_fast(float x) { return x * __builtin_amdgcn_rcpf(1.f + __builtin_amdgcn_exp2f(-LOG2E * x)); }
__device__ __forceinline__ float softplus_f(float x) { return x > 20.f ? x : log1pf(__expf(x)); }
__device__ __forceinline__ int t5_bucket(int d) {
    if (d < 16) return d;
    int b = 16;
    b += d >= 22; b += d >= 30; b += d >= 40; b += d >= 54; b += d >= 73; b += d >= 99; b += d >= 134; b += d >= 182;
    b += d >= 246; b += d >= 332; b += d >= 450; b += d >= 609; b += d >= 825; b += d >= 1117; b += d >= 1513;
    return b;
}
__device__ __forceinline__ const float* xrow(const Ins& I, int r) { return r < NTOK ? I.xp + (size_t)r * DM : I.xs + (size_t)(r - NTOK) * DM; }
__device__ __forceinline__ float bf2f(bf16 v) { return __uint_as_float((unsigned)v << 16); }
__device__ __forceinline__ unsigned f2bf(float f) { unsigned u = __float_as_uint(f); return (u + 0x7fffu + ((u >> 16) & 1u)) >> 16; }
__device__ __forceinline__ unsigned pk2(float lo, float hi) { return f2bf(lo) | (f2bf(hi) << 16); }
typedef float f32x2_cv __attribute__((ext_vector_type(2))); typedef __bf16 bf16x2_cv __attribute__((ext_vector_type(2)));
__device__ __forceinline__ unsigned cvtpk_s(float lo, float hi) { const f32x2_cv v = {lo, hi}; const bf16x2_cv b = __builtin_convertvector(v, bf16x2_cv); return __builtin_bit_cast(unsigned, b); }
__host__ __device__ __forceinline__ int vrow_of_col(int a) { return 128 * ((a >> 5) & 1) + 32 * ((a >> 6) & 3) + (a & 31); }

namespace pg8 {
#define PG8_LAS __attribute__((address_space(3)))
typedef unsigned short bf16_t;
typedef short bf16x8 __attribute__((ext_vector_type(8)));
typedef float f32x4 __attribute__((ext_vector_type(4)));
typedef unsigned u32x4 __attribute__((ext_vector_type(4)));
constexpr int BM = 256, BK = 64, HALF = 128, HTB = HALF * BK * 2  , STAGE_BYTES = 8 * HTB, NXCD = 8, WGM = 4;

__host__ __device__ __forceinline__ int lds_byte(int r, int c) { const int st = (r >> 4) * 2 + (c >> 5), rr = r & 15, cc = c & 31, ob = rr * 64 + cc * 2; return st * 1024 + (ob ^ (((ob >> 9) & 1) << 5)); }
__host__ __device__ __forceinline__ void stage_rc(int b, int& R, int& C) { const int st = b / 1024, sb = b % 1024, swz = sb ^ (((sb >> 9) & 1) << 5); R = (st >> 1) * 16 + swz / 64; C = (st & 1) * 32 + (swz % 64) / 2; }
__host__ __device__ __forceinline__ int perm32(int rho) { const int n = rho >> 4, i = rho & 15; return 8 * (i >> 2) + 4 * n + (i & 3); }

struct Unit { int pm, pn; };
struct Gemm { const bf16_t* A; const bf16_t* Bt; int M, N, K; };

struct StaticOrder {
    int nM, nN, nwg, G, c;
    __host__ __device__ void init(int M, int N, int G_, int c_) { nM = M / BM; nN = N / BM; nwg = nM * nN; G = G_; c = c_; }
    __host__ __device__ bool next(int i, Unit& u) const {
        const long L = (long)i * G + c; if (L >= nwg) return false;
        int wgid = (int)L; { const int q = nwg / NXCD, r = nwg % NXCD, xcd = wgid % NXCD, off = wgid / NXCD; wgid = (xcd < r ? xcd * (q + 1) : r * (q + 1) + (xcd - r) * q) + off; }
        const int nig = WGM * nN, gid = wgid / nig, fm = gid * WGM, gsz = (nM - fm) < WGM ? (nM - fm) : WGM;
        u.pm = fm + ((wgid % nig) % gsz); u.pn = (wgid % nig) / gsz; return true;
    }
    __device__ __forceinline__ void a_ready(const Unit&) const {}
    __device__ __forceinline__ void done(const Unit&) const {}
};

__device__ __forceinline__ unsigned cvt_pk_bf16(float lo, float hi) { unsigned r; asm volatile("v_cvt_pk_bf16_f32 %0, %1, %2" : "=v"(r) : "v"(lo), "v"(hi)); return r; }

template <int K> __device__ __forceinline__ float rowprev(float cur, float prevm) {
    const int t = __builtin_amdgcn_update_dpp(0, __builtin_bit_cast(int, prevm), 0x100 + (16 - K), 0xf, 0xf, true);
    return __builtin_bit_cast(float, __builtin_amdgcn_update_dpp(t, __builtin_bit_cast(int, cur), 0x110 + K, 0xf, 0xf, false));
}

struct EpiIn {
    static constexpr bool PERM = true, AFTER_DRAIN = false, MIDK = false;
    bf16_t *Q, *K, *V, *Gb, *Zb, *XBC; float* out; const float *qnw, *knw, *conv_w, *conv_b; float* rawb;
    __device__ __forceinline__ void mid(f32x4 (&)[2][2][4][2], const Unit&, int, int, int, int, int) const {}
    __device__ __forceinline__ void operator()(const f32x4 (&acc)[2][2][4][2], const Unit& u, int wr, int wc, int fr, int fq) const {
        const int pn = u.pn;
        const int rowb = u.pm * BM + wr * 64 + fr;
        const int cl = wc * 64 + 8 * fq;
        if (pn < 8) {
            const bool isq = pn < 4; const float* nw = isq ? qnw : knw;
            f32x4 w[2][2];
#pragma unroll
            for (int bj = 0; bj < 2; ++bj)
#pragma unroll
                for (int n = 0; n < 2; ++n) w[bj][n] = *(const f32x4*)(nw + 8 * fq + 32 * bj + 4 * n);
            bf16_t* dstb = (isq ? Q : K) + (pn & 3) * 256 + cl;
#pragma unroll
            for (int ai = 0; ai < 2; ++ai)
#pragma unroll
                for (int m = 0; m < 4; ++m) {
                    const int r = rowb + ai * HALF + m * 16;
                    float ss = 0.f;
#pragma unroll
                    for (int bj = 0; bj < 2; ++bj)
#pragma unroll
                        for (int n = 0; n < 2; ++n) { const f32x4 v = acc[ai][bj][m][n]; ss += (v[0] * v[0] + v[1] * v[1]) + (v[2] * v[2] + v[3] * v[3]); }
                    ss += __shfl_xor(ss, 16); ss += __shfl_xor(ss, 32);
                    const float sc = rsqrtf(ss * (1.f / 64.f) + EPS), scs = isq ? sc * QSCALE : sc;
                    float* f32dst = nullptr;
                    if (!isq) { if (r < NTOK) { const int t = r & (SEQ - 1); if (t >= SEQ - WIN) f32dst = out + O_KP + ((size_t)((r >> 13) * WIN + t - (SEQ - WIN))) * DM + (pn & 3) * 256 + cl; }
                                else if (r < NROWS) f32dst = out + O_KS + (size_t)(r - NTOK) * DM + (pn & 3) * 256 + cl; }
#pragma unroll
                    for (int bj = 0; bj < 2; ++bj) {
                        const f32x4 a0 = acc[ai][bj][m][0] * w[bj][0], a1 = acc[ai][bj][m][1] * w[bj][1];
                        u32x4 o; o.x = cvt_pk_bf16(a0[0] * scs, a0[1] * scs); o.y = cvt_pk_bf16(a0[2] * scs, a0[3] * scs); o.z = cvt_pk_bf16(a1[0] * scs, a1[1] * scs); o.w = cvt_pk_bf16(a1[2] * scs, a1[3] * scs);
                        __builtin_nontemporal_store(o, (u32x4*)(dstb + (size_t)r * DM + 32 * bj));
                        if (f32dst) { __builtin_nontemporal_store(a0 * sc, (f32x4*)(f32dst + 32 * bj)); __builtin_nontemporal_store(a1 * sc, (f32x4*)(f32dst + 32 * bj + 4)); }
                    }
                }
        } else if (pn < 12) {
            bf16_t* dstb = V + (pn & 3) * 256 + cl;
#pragma unroll
            for (int ai = 0; ai < 2; ++ai)
#pragma unroll
                for (int m = 0; m < 4; ++m) {
                    const int r = rowb + ai * HALF + m * 16;
                    float* f32dst = nullptr;
                    if (r < NTOK) { const int t = r & (SEQ - 1); if (t >= SEQ - WIN) f32dst = out + O_VP + ((size_t)((r >> 13) * WIN + t - (SEQ - WIN))) * DM + (pn & 3) * 256 + cl; }
                    else if (r < NROWS) f32dst = out + O_VS + (size_t)(r - NTOK) * DM + (pn & 3) * 256 + cl;
#pragma unroll
                    for (int bj = 0; bj < 2; ++bj) {
                        const f32x4 a0 = acc[ai][bj][m][0], a1 = acc[ai][bj][m][1];
                        u32x4 o; o.x = cvt_pk_bf16(a0[0], a0[1]); o.y = cvt_pk_bf16(a0[2], a0[3]); o.z = cvt_pk_bf16(a1[0], a1[1]); o.w = cvt_pk_bf16(a1[2], a1[3]);
                        __builtin_nontemporal_store(o, (u32x4*)(dstb + (size_t)r * DM + 32 * bj));
                        if (f32dst) { __builtin_nontemporal_store(a0, (f32x4*)(f32dst + 32 * bj)); __builtin_nontemporal_store(a1, (f32x4*)(f32dst + 32 * bj + 4)); }
                    }
                }
        } else if (pn < 20) {
            bf16_t* dstb = (pn < 16 ? Gb : Zb) + (pn & 3) * 256 + cl;
#pragma unroll
            for (int ai = 0; ai < 2; ++ai)
#pragma unroll
                for (int m = 0; m < 4; ++m) {
                    const int r = rowb + ai * HALF + m * 16;
#pragma unroll
                    for (int bj = 0; bj < 2; ++bj) {
                        f32x4 a0 = acc[ai][bj][m][0], a1 = acc[ai][bj][m][1];
#pragma unroll
                        for (int i = 0; i < 4; ++i) { a0[i] = silu_fast(a0[i]); a1[i] = silu_fast(a1[i]); }
                        u32x4 o; o.x = cvt_pk_bf16(a0[0], a0[1]); o.y = cvt_pk_bf16(a0[2], a0[3]); o.z = cvt_pk_bf16(a1[0], a1[1]); o.w = cvt_pk_bf16(a1[2], a1[3]);
                        __builtin_nontemporal_store(o, (u32x4*)(dstb + (size_t)r * DM + 32 * bj));
                    }
                }
        } else {
            const int cb = (pn - 20) * 256 + cl;
            bf16_t* dstb = XBC + cb;
            const bool do_conv = pn >= 24 && u.pm < NTOK / BM;
#pragma unroll
            for (int ai = 0; ai < 2; ++ai)
#pragma unroll
                for (int m = 0; m < 4; ++m) {
                    const int r = rowb + ai * HALF + m * 16;
                    float* f32dst = nullptr;
                    if (r < NTOK) { const int t = r & (SEQ - 1); if (t >= SEQ - 3) f32dst = out + O_CP + ((size_t)((r >> 13) * 3 + t - (SEQ - 3))) * CONVD + cb; }
                    else if (r < NROWS) f32dst = out + O_CS + ((size_t)(r - NTOK) * 3 + 2) * CONVD + cb;
                    if (do_conv && (m == 0 || m == 3)) {
                        const int slot = m == 0 ? 3 + fr : fr - 13;
                        if (slot >= 0 && slot < 6) f32dst = rawb + ((size_t)(u.pm * 4 + ai * 2 + wr) * 6 + slot) * 512 + (cb - 1024);
                    }
#pragma unroll
                    for (int bj = 0; bj < 2; ++bj) {
                        const f32x4 a0 = acc[ai][bj][m][0], a1 = acc[ai][bj][m][1];
                        if (!do_conv) { u32x4 o; o.x = cvt_pk_bf16(a0[0], a0[1]); o.y = cvt_pk_bf16(a0[2], a0[3]); o.z = cvt_pk_bf16(a1[0], a1[1]); o.w = cvt_pk_bf16(a1[2], a1[3]);
                                        __builtin_nontemporal_store(o, (u32x4*)(dstb + (size_t)r * CONVD + 32 * bj)); }
                        if (f32dst) { __builtin_nontemporal_store(a0, (f32x4*)(f32dst + 32 * bj)); __builtin_nontemporal_store(a1, (f32x4*)(f32dst + 32 * bj + 4)); }
                    }
                }
            if (do_conv) {
                if ((u.pm & 31) == 31 && wr == 1 && fr >= 13) {
#pragma unroll
                    for (int bj = 0; bj < 2; ++bj) { float* d = out + O_CP + ((size_t)((u.pm >> 5) * 3 + fr - 13)) * CONVD + cb + 32 * bj; *(f32x4*)d = acc[1][bj][3][0]; *(f32x4*)(d + 4) = acc[1][bj][3][1]; }
                }
#pragma unroll
                for (int bj = 0; bj < 2; ++bj) {
                    f32x4 w[4][2], bb[2];
#pragma unroll
                    for (int n = 0; n < 2; ++n) { bb[n] = *(const f32x4*)(conv_b + cb + 32 * bj + 4 * n);
#pragma unroll
                        for (int t = 0; t < 4; ++t) w[t][n] = *(const f32x4*)(conv_w + t * CONVD + cb + 32 * bj + 4 * n); }
#pragma unroll
                    for (int ai = 0; ai < 2; ++ai) {
                        f32x4 pm[2] = {(f32x4){0.f, 0.f, 0.f, 0.f}, (f32x4){0.f, 0.f, 0.f, 0.f}};
#pragma unroll
                        for (int m = 0; m < 4; ++m) {
                            const int r = rowb + ai * HALF + m * 16;
                            unsigned ow[4];
#pragma unroll
                            for (int n = 0; n < 2; ++n) {
                                const f32x4 cur = acc[ai][bj][m][n]; f32x4 v;
#pragma unroll
                                for (int i = 0; i < 4; ++i) {
                                    const float p1 = rowprev<1>(cur[i], pm[n][i]), p2 = rowprev<2>(cur[i], pm[n][i]), p3 = rowprev<3>(cur[i], pm[n][i]);
                                    v[i] = silu_fast(bb[n][i] + w[0][n][i] * p3 + w[1][n][i] * p2 + w[2][n][i] * p1 + w[3][n][i] * cur[i]);
                                }
                                ow[2 * n] = cvt_pk_bf16(v[0], v[1]); ow[2 * n + 1] = cvt_pk_bf16(v[2], v[3]);
                                pm[n] = cur;
                            }
                            __builtin_nontemporal_store((u32x4){ow[0], ow[1], ow[2], ow[3]}, (u32x4*)(dstb + (size_t)r * CONVD + 32 * bj));
                        }
                    }
                }
            }
        }
    }
};

struct EpiOut {
    static constexpr bool PERM = true, AFTER_DRAIN = false, MIDK = true;
    const float* xp; const float* xs; const PG8_LAS float* rs; float* out;
    __device__ __forceinline__ void mid(f32x4 (&acc)[2][2][4][2], const Unit& u, int ui, int wr, int wc, int fr, int fq) const {
        const PG8_LAS float* rp = rs + ui * 256 + wr * 64 + fr;
#pragma unroll
        for (int ai = 0; ai < 2; ++ai)
#pragma unroll
            for (int m = 0; m < 4; ++m) {
                const float r = rp[ai * HALF + m * 16];
#pragma unroll
                for (int bj = 0; bj < 2; ++bj)
#pragma unroll
                    for (int n = 0; n < 2; ++n) acc[ai][bj][m][n] *= r;
            }
    }
    __device__ __forceinline__ void operator()(const f32x4 (&acc)[2][2][4][2], const Unit& u, int wr, int wc, int fr, int fq) const {
        const int rowb = u.pm * BM + wr * 64 + fr, col = u.pn * BM + wc * 64 + 8 * fq;
#pragma unroll
        for (int ai = 0; ai < 2; ++ai) {
            f32x4 xv[4][2][2];
#pragma unroll
            for (int m = 0; m < 4; ++m) {
                const float* xr = xp + (size_t)(rowb + ai * HALF + m * 16) * DM + col;
#pragma unroll
                for (int bj = 0; bj < 2; ++bj) { xv[m][bj][0] = *(const f32x4*)(xr + 32 * bj); xv[m][bj][1] = *(const f32x4*)(xr + 32 * bj + 4); }
            }
#pragma unroll
            for (int m = 0; m < 4; ++m) {
                float* yr = out + O_YP + (size_t)(rowb + ai * HALF + m * 16) * DM + col;
#pragma unroll
                for (int bj = 0; bj < 2; ++bj) { *(f32x4*)(yr + 32 * bj) = xv[m][bj][0] + acc[ai][bj][m][0]; *(f32x4*)(yr + 32 * bj + 4) = xv[m][bj][1] + acc[ai][bj][m][1]; }
            }
        }
    }
};

template <class Epi, class Sched, bool ALIGN_EPI = false, bool SP2 = false>
__device__ __forceinline__ void gemm_phase(PG8_LAS unsigned char* lds, const Gemm g, const Sched& S, const Epi& E) {
    const int tid = threadIdx.x, wid = __builtin_amdgcn_readfirstlane(tid >> 6), lane = tid & 63, wr = wid >> 2, wc = wid & 3, fr = lane & 15, fq = lane >> 4;
    const int K = g.K, nt = K / BK;
    unsigned voffA[2], voffB[2];
#pragma unroll
    for (int i = 0; i < 2; ++i) { int R, C; stage_rc(tid * 16 + i * 8192, R, C); const int Rb = Epi::PERM ? ((R & ~31) + perm32(R & 31)) : R;
        voffA[i] = (unsigned)(R * K + C) * 2u; voffB[i] = (unsigned)(Rb * K + C) * 2u; }
    const size_t kstep = (size_t)(BK * 2);
    const size_t hstep = (size_t)HALF * K * 2;
    const size_t tstep = 2 * hstep;
    const unsigned ldsw = (unsigned)wid * 1024u;
    const int aoff = lds_byte(wr * 64 + fr, fq * 8), boff = lds_byte(wc * 32 + fr, fq * 8);
#define PG8_SA(b, h) (((b) * 2 + (h)) * HTB)
#define PG8_SB(b, h) ((4 + (b) * 2 + (h)) * HTB)
#define PG8_STAGE(bufoff, gbase, voff) do { _Pragma("unroll") for (int _i = 0; _i < 2; ++_i) \
        __builtin_amdgcn_global_load_lds((const unsigned*)((const char*)(gbase) + (voff)[_i]), (PG8_LAS unsigned*)(lds + (bufoff) + ldsw + _i * 8192), 16, 0, 0); } while (0)
#define PG8_LDA(dst, b, h) do { _Pragma("unroll") for (int m = 0; m < 4; ++m) _Pragma("unroll") for (int k = 0; k < 2; ++k) dst[m][k] = *(const PG8_LAS bf16x8*)(lds + PG8_SA(b, h) + aoff + m * 2048 + k * 1024); } while (0)
#define PG8_LDB(dst, b, h) do { _Pragma("unroll") for (int n = 0; n < 2; ++n) _Pragma("unroll") for (int k = 0; k < 2; ++k) dst[n][k] = *(const PG8_LAS bf16x8*)(lds + PG8_SB(b, h) + boff + n * 2048 + k * 1024); } while (0)
#define PG8_MMA(ai, bj, At, Bt) do { __builtin_amdgcn_s_setprio(1); _Pragma("unroll") for (int m = 0; m < 4; ++m) _Pragma("unroll") for (int n = 0; n < 2; ++n) _Pragma("unroll") for (int k = 0; k < 2; ++k) \
        acc[ai][bj][m][n] = __builtin_amdgcn_mfma_f32_16x16x32_bf16(Bt[n][k], At[m][k], acc[ai][bj][m][n], 0, 0, 0); __builtin_amdgcn_s_setprio(0); } while (0)
#define PG8_WAIT_V(n) asm volatile("s_waitcnt vmcnt(" #n ")" ::: "memory")
#define PG8_WAIT_L(n) asm volatile("s_waitcnt lgkmcnt(" #n ")" ::: "memory")
#define PG8_BAR __builtin_amdgcn_s_barrier()
#define PG8_SCHED __builtin_amdgcn_sched_barrier(0)
    Unit cur, nxt; int ui = 0;
    if (!S.next(0, cur)) return;
    f32x4 acc[2][2][4][2];
#pragma unroll
    for (int a = 0; a < 2; ++a)
#pragma unroll
        for (int b = 0; b < 2; ++b)
#pragma unroll
            for (int m = 0; m < 4; ++m)
#pragma unroll
                for (int n = 0; n < 2; ++n) acc[a][b][m][n] = (f32x4){0.f, 0.f, 0.f, 0.f};
    bf16x8 At[4][2], B0[2][2], B1[2][2];
    const char* cA = (const char*)g.A + (size_t)cur.pm * tstep; const char* cB = (const char*)g.Bt + (size_t)cur.pn * tstep;
    S.a_ready(cur);
    if constexpr (SP2) {
        PG8_STAGE(PG8_SB(0, 0), cB, voffB); PG8_STAGE(PG8_SB(0, 1), cB + hstep, voffB); PG8_STAGE(PG8_SA(0, 0), cA, voffA); PG8_STAGE(PG8_SA(0, 1), cA + hstep, voffA);
        if (wr == 1) PG8_BAR;
        PG8_WAIT_V(2); PG8_BAR;
        PG8_STAGE(PG8_SB(1, 0), cB + kstep, voffB); PG8_STAGE(PG8_SA(1, 0), cA + kstep, voffA); PG8_STAGE(PG8_SB(1, 1), cB + hstep + kstep, voffB);
        PG8_WAIT_V(6); PG8_BAR;
    } else {
        PG8_STAGE(PG8_SB(0, 0), cB, voffB); PG8_STAGE(PG8_SA(0, 0), cA, voffA); PG8_STAGE(PG8_SB(0, 1), cB + hstep, voffB); PG8_STAGE(PG8_SA(0, 1), cA + hstep, voffA);
        if (wr == 1) PG8_BAR;
        PG8_WAIT_V(4); PG8_BAR;
        PG8_STAGE(PG8_SB(1, 0), cB + kstep, voffB); PG8_STAGE(PG8_SA(1, 0), cA + kstep, voffA); PG8_STAGE(PG8_SB(1, 1), cB + hstep + kstep, voffB);
        PG8_WAIT_V(6); PG8_BAR;
    }
    for (;;) {
        const bool has_next = S.next(ui + 1, nxt);
        const char* nA = has_next ? (const char*)g.A + (size_t)nxt.pm * tstep : cA; const char* nB = has_next ? (const char*)g.Bt + (size_t)nxt.pn * tstep : cB;
        for (int t = 0; t < nt; t += 2) {
            const bool last = (t == nt - 2);
            if constexpr (Epi::MIDK) { if (t == (nt >> 1)) E.mid(acc, cur, ui, wr, wc, fr, fq); }
            const char* a1 = cA + (size_t)(t + 1) * kstep;
            const char* a2 = last ? nA : cA + (size_t)(t + 2) * kstep; const char* b2 = last ? nB : cB + (size_t)(t + 2) * kstep;
            const char* a3 = a2 + kstep; const char* b3 = b2 + kstep;
            if (last && has_next) S.a_ready(nxt);
            if constexpr (SP2) {
            PG8_LDB(B0, 0, 0); PG8_LDB(B1, 0, 1); PG8_SCHED; PG8_LDA(At, 0, 0); PG8_STAGE(PG8_SA(1, 1), a1 + hstep, voffA);
            PG8_WAIT_V(8); PG8_WAIT_L(0); PG8_BAR; PG8_MMA(0, 0, At, B0); PG8_MMA(0, 1, At, B1); PG8_BAR; PG8_SCHED;
            PG8_LDA(At, 0, 1); PG8_STAGE(PG8_SB(0, 0), b2, voffB); PG8_STAGE(PG8_SB(0, 1), b2 + hstep, voffB); PG8_STAGE(PG8_SA(0, 0), a2, voffA);
            PG8_WAIT_V(8); PG8_WAIT_L(0); PG8_BAR; PG8_MMA(1, 0, At, B0); PG8_MMA(1, 1, At, B1); PG8_BAR; PG8_SCHED;
            PG8_LDB(B0, 1, 0); PG8_LDB(B1, 1, 1); PG8_SCHED; PG8_LDA(At, 1, 0); PG8_STAGE(PG8_SA(0, 1), a2 + hstep, voffA);
            PG8_WAIT_V(8); PG8_WAIT_L(0); PG8_BAR; PG8_MMA(0, 0, At, B0); PG8_MMA(0, 1, At, B1); PG8_BAR; PG8_SCHED;
            PG8_LDA(At, 1, 1); PG8_STAGE(PG8_SB(1, 0), b3, voffB); PG8_STAGE(PG8_SB(1, 1), b3 + hstep, voffB); PG8_STAGE(PG8_SA(1, 0), a3, voffA);
            PG8_WAIT_V(8); PG8_WAIT_L(0); PG8_BAR; PG8_MMA(1, 0, At, B0); PG8_MMA(1, 1, At, B1); PG8_BAR; PG8_SCHED;
            } else {
            PG8_LDB(B0, 0, 0); PG8_SCHED; PG8_LDA(At, 0, 0); PG8_STAGE(PG8_SA(1, 1), a1 + hstep, voffA);
            PG8_WAIT_L(8); PG8_BAR; PG8_WAIT_L(0); PG8_MMA(0, 0, At, B0); PG8_BAR; PG8_SCHED;
            PG8_LDB(B1, 0, 1); PG8_STAGE(PG8_SB(0, 0), b2, voffB);
            PG8_BAR; PG8_WAIT_L(0); PG8_MMA(0, 1, At, B1); PG8_BAR;
            PG8_LDA(At, 0, 1); PG8_STAGE(PG8_SA(0, 0), a2, voffA);
            PG8_BAR; PG8_WAIT_L(0); PG8_MMA(1, 0, At, B0); PG8_BAR; PG8_SCHED;
            PG8_STAGE(PG8_SB(0, 1), b2 + hstep, voffB);
            PG8_WAIT_V(6); PG8_BAR; PG8_MMA(1, 1, At, B1); PG8_BAR;
            PG8_LDB(B0, 1, 0); PG8_SCHED; PG8_LDA(At, 1, 0); PG8_STAGE(PG8_SA(0, 1), a2 + hstep, voffA);
            PG8_WAIT_L(8); PG8_BAR; PG8_WAIT_L(0); PG8_MMA(0, 0, At, B0); PG8_BAR; PG8_SCHED;
            PG8_LDB(B1, 1, 1); PG8_STAGE(PG8_SB(1, 0), b3, voffB);
            PG8_BAR; PG8_WAIT_L(0); PG8_MMA(0, 1, At, B1); PG8_BAR;
            PG8_LDA(At, 1, 1); PG8_STAGE(PG8_SA(1, 0), a3, voffA);
            PG8_BAR; PG8_WAIT_L(0); PG8_MMA(1, 0, At, B0); PG8_BAR; PG8_SCHED;
            PG8_STAGE(PG8_SB(1, 1), b3 + hstep, voffB);
            PG8_WAIT_V(6); PG8_BAR; PG8_MMA(1, 1, At, B1); PG8_BAR;
            }
        }
        if constexpr (ALIGN_EPI) { if (wr == 0) PG8_BAR; }
        if constexpr (!Epi::AFTER_DRAIN) { E(acc, cur, wr, wc, fr, fq); S.done(cur); }
        if (!has_next) break;
#pragma unroll
        for (int a = 0; a < 2; ++a)
#pragma unroll
            for (int b = 0; b < 2; ++b)
#pragma unroll
                for (int m = 0; m < 4; ++m)
#pragma unroll
                    for (int n = 0; n < 2; ++n) acc[a][b][m][n] = (f32x4){0.f, 0.f, 0.f, 0.f};
        cur = nxt; cA = nA; cB = nB; ++ui;
        if constexpr (ALIGN_EPI) { if (wr == 1) PG8_BAR; }
    }
    PG8_WAIT_V(0);
    if constexpr (!ALIGN_EPI) { if (wr == 0) PG8_BAR; }
    PG8_BAR;
    if constexpr (Epi::AFTER_DRAIN) { E.fused(acc, cur, wr, wc, fr, fq, lds, wid, lane); S.done(cur); }
#undef PG8_SA
#undef PG8_SB
#undef PG8_STAGE
#undef PG8_LDA
#undef PG8_LDB
#undef PG8_MMA
#undef PG8_WAIT_V
#undef PG8_WAIT_L
#undef PG8_BAR
#undef PG8_SCHED
}
}
#define GAS __attribute__((address_space(1)))
#define LAS __attribute__((address_space(3)))
typedef unsigned v4u __attribute__((ext_vector_type(4)));
typedef float f32x4 __attribute__((ext_vector_type(4)));
typedef short bf16x8 __attribute__((ext_vector_type(8)));
typedef GAS unsigned gu32;
typedef GAS unsigned long long gu64;
#define RLX_AGENT __ATOMIC_RELAXED, __HIP_MEMORY_SCOPE_AGENT
#define LDS_WAIT() asm volatile("s_waitcnt lgkmcnt(0)" ::: "memory")
#define VM_WAIT() asm volatile("s_waitcnt vmcnt(0)" ::: "memory")
__device__ __forceinline__ unsigned long long rt() { return __builtin_amdgcn_s_memrealtime(); }

#define XB_TMO      128
#define XB_XCNT(j)  (256  + 64 * (j))
#define XB_XSUB(j)  (1280 + 64 * (j))
#define XB_XGEN(j)  (2304 + 64 * (j))
#define XB_TOP      3328
#define XB_TOPGEN   3392
#define XCD_BAR_WORDS 3456
#define XB_SPIN_CAP (1u << 18)

__device__ __forceinline__ unsigned xb_ld(unsigned* p)              { return __hip_atomic_load(p, __ATOMIC_RELAXED, __HIP_MEMORY_SCOPE_AGENT); }
__device__ __forceinline__ unsigned xb_add(unsigned* p, unsigned v) { return __hip_atomic_fetch_add(p, v, __ATOMIC_RELAXED, __HIP_MEMORY_SCOPE_AGENT); }
__device__ __forceinline__ unsigned xb_xcc_id() { return (unsigned)__builtin_amdgcn_s_getreg((3 << 11) | 20) & 0xFu; }
#define XB_SPIN(cond, bar) do { unsigned _sp = 0; while (cond) { __builtin_amdgcn_s_sleep(1); \
    if ((++_sp & 255u) == 0u) { if (xb_ld(&(bar)[XB_TMO])) break; if (_sp > XB_SPIN_CAP) { atomicAdd(&(bar)[XB_TMO], 1u); break; } } } } while (0)

struct XcdBarrier {
    unsigned* bar; unsigned x;
    volatile LAS unsigned* st;
};

__device__ __forceinline__ XcdBarrier xcd_barrier_post(unsigned* bar, volatile LAS unsigned* st) {
    XcdBarrier b; b.bar = bar; b.x = xb_xcc_id(); b.st = st;
    if (threadIdx.x == 0) (void)xb_add(&bar[XB_XCNT(b.x)], 1u);
    return b;
}
__device__ __forceinline__ void xcd_barrier_complete(unsigned* bar, unsigned x, unsigned& nloc, unsigned& nx) {
    const unsigned G = gridDim.x * gridDim.y * gridDim.z;
    unsigned sum, cnt, mine, sp = 0u;
    for (;;) {
        sum = 0u; cnt = 0u; mine = 0u;
#pragma unroll
        for (unsigned j = 0; j < 16; ++j) { const unsigned c = xb_ld(&bar[XB_XCNT(j)]); sum += c; cnt += (c > 0u) ? 1u : 0u; mine = (j == x) ? c : mine; }
        if (sum == G) break;
        __builtin_amdgcn_s_sleep(1);
        if ((++sp & 255u) == 0u) { if (xb_ld(&bar[XB_TMO])) break; if (sp > XB_SPIN_CAP) { atomicAdd(&bar[XB_TMO], 1u); break; } }
    }
    nloc = mine > 0u ? mine : 1u; nx = cnt > 0u ? cnt : 1u;
}

__device__ __forceinline__ void xcd_barrier(const XcdBarrier& b) {
    asm volatile("s_waitcnt vmcnt(0)" ::: "memory");
    __syncthreads();
    if (threadIdx.x == 0) {
        unsigned* bar = b.bar;
        __builtin_amdgcn_s_waitcnt(0);
        unsigned nloc = b.st[0], nx = b.st[1];
        if (nloc == 0u) { xcd_barrier_complete(bar, b.x, nloc, nx); b.st[0] = nloc; b.st[1] = nx; }
        const unsigned old = xb_add(&bar[XB_XSUB(b.x)], 1u);
        const unsigned gen = old / nloc;
        if (old + 1u == (gen + 1u) * nloc) {
            __builtin_amdgcn_fence(__ATOMIC_RELEASE, "agent");
            asm volatile("s_waitcnt vmcnt(0)" ::: "memory");
            const unsigned og = xb_add(&bar[XB_TOP], 1u);
            const unsigned tg = og / nx;
            if (og + 1u == (tg + 1u) * nx) xb_add(&bar[XB_TOPGEN], 1u);
            else XB_SPIN(xb_ld(&bar[XB_TOPGEN]) == tg, bar);
            __builtin_amdgcn_fence(__ATOMIC_ACQUIRE, "agent");
            xb_add(&bar[XB_XGEN(b.x)], 1u);
            asm volatile("s_waitcnt vmcnt(0)" ::: "memory");
        } else {
            XB_SPIN(xb_ld(&bar[XB_XGEN(b.x)]) == gen, bar);
            __builtin_amdgcn_fence(__ATOMIC_ACQUIRE, "agent");
            asm volatile("s_waitcnt vmcnt(0)" ::: "memory");
        }
    }
    __syncthreads();
}

constexpr int NWAVES = 8;
constexpr int RING_OFF = 0, RING_BYTES = 131072;
constexpr int LDS_BYTES = 163840;
constexpr int LDSCTL_OFF = LDS_BYTES - 512, MISC_OFF = LDSCTL_OFF + 320;
constexpr int CW_BAR = 4096;
constexpr int CW_Q = 16384;
static_assert((CW_BAR + XCD_BAR_WORDS) <= CW_Q && (CW_Q + 64 * 64) * 4 <= (int)CTL_ZERO_BYTES, "CTL words inside the memset region");

constexpr int PROBE_ID = 0;
#define PB_BEGIN(id) long long pb_t0_##id = 0; if (PROBE_ID == (id)) pb_t0_##id = clock64();
#define PB_END(id) if (PROBE_ID == (id)) { const long long t1_ = clock64(), dt_ = t1_ - pb_t0_##id; while (clock64() - t1_ < dt_) __builtin_amdgcn_s_sleep(2); }
struct Frame {
    LAS unsigned char* lds;
    volatile LAS unsigned* MISC;
    gu32* ctl;
    int tid, lane, wave, vcu, G;
    Ins I; float* out;
    bf16 *WinT, *WoutT, *XN, *Q, *K, *V, *AU, *XBC, *Gb, *Zb; float *DT, *SSQ, *RAWB;
};

template <class SrcF>
__device__ __forceinline__ void p0_transpose_item(SrcF src, int k0, int n0, bf16* WT, int dst_pitch, int dst_row0, int dst_k0, LAS float* scr, int lane) {
#pragma unroll 8
    for (int i = 0; i < 32; ++i) { const int kk = 2 * i + (lane >> 5); scr[kk * 33 + (lane & 31)] = src(k0 + kk, n0 + (lane & 31)); }
    LDS_WAIT(); asm volatile("" ::: "memory");
    const int c = lane & 7;
#pragma unroll
    for (int j = 0; j < 4; ++j) { const int n = (lane >> 3) + 8 * j; const LAS float* s = scr + (8 * c) * 33 + n;
        v4u o; o.x = pk2(s[0 * 33], s[1 * 33]); o.y = pk2(s[2 * 33], s[3 * 33]); o.z = pk2(s[4 * 33], s[5 * 33]); o.w = pk2(s[6 * 33], s[7 * 33]);
        *(GAS v4u*)(WT + (size_t)(dst_row0 + n) * dst_pitch + dst_k0 + 8 * c) = o; }
    LDS_WAIT(); asm volatile("" ::: "memory");
}
constexpr int P0_SCR_BYTES = 8448, WDT_OFF = NWAVES * P0_SCR_BYTES, WDT_PITCH = 20;
static_assert(WDT_OFF + 1024 * WDT_PITCH * 4 <= LDSCTL_OFF, "prologue LDS");

__device__ __forceinline__ void p0_prologue(Frame& F) {
    const Ins& I = F.I;
    LAS float* scr = (LAS float*)(F.lds + F.wave * P0_SCR_BYTES);
    LAS float* wdt = (LAS float*)(F.lds + WDT_OFF);
    const int gw = F.vcu * NWAVES + F.wave, NGW = F.G * NWAVES;
    for (int idx = F.tid; idx < 1024 * 16; idx += NWAVES * 64) {
        const int k = idx >> 4, j = idx & 15, pos = (((k >> 8) * 4 + (k & 3)) << 6) + ((k >> 2) & 63);
        wdt[pos * WDT_PITCH + j] = I.w_in[(size_t)k * NPROJ + C_DT + j] * I.norm_w[k];
    }
    constexpr int I_IN = (DM / 64) * (NMAIN / 32), I_OUT = (2048 / 64) * (DM / 32);
    for (int it = gw; it < I_IN + I_OUT; it += NGW) {
        if (it < I_IN) {
            const int nblk = NMAIN / 32, kb = it / nblk, nb = it % nblk, k0 = 64 * kb, n0 = 32 * nb;
            p0_transpose_item([&](int k, int n) { return I.w_in[(size_t)k * NPROJ + n] * I.norm_w[k]; }, k0, n0, F.WinT, DM, (n0 & ~255) + vrow_of_col(n0 & 255), k0, scr, F.lane);
        } else {
            const int r = it - I_IN, nblk = DM / 32, kb = r / nblk, nb = r % nblk, k0 = 64 * kb, n0 = 32 * nb;
            p0_transpose_item([&](int k, int n) { return I.w_out[(size_t)k * DM + n] * (k >= 1024 ? I.ssd_norm_w[k - 1024] : 1.f); }, k0, n0, F.WoutT, 2048, (n0 & ~255) + vrow_of_col(n0 & 255), (k0 + 1024) & 2047, scr, F.lane);
        }
    }
    __syncthreads();
    for (int rp = gw; rp < NROWS / 2; rp += NGW) {
        f32x4 v[2][4]; float rstd[2];
#pragma unroll
        for (int q = 0; q < 2; ++q) {
            const GAS f32x4* xr = (const GAS f32x4*)xrow(I, 2 * rp + q) + F.lane; float s = 0.f;
#pragma unroll
            for (int j = 0; j < 4; ++j) { v[q][j] = xr[64 * j]; s += (v[q][j].x * v[q][j].x + v[q][j].y * v[q][j].y) + (v[q][j].z * v[q][j].z + v[q][j].w * v[q][j].w); }
            rstd[q] = rsqrtf(wave_sum(s) * (1.f / DM) + EPS);
            GAS unsigned long long* o8 = (GAS unsigned long long*)(F.XN + (size_t)(2 * rp + q) * DM) + F.lane;
#pragma unroll
            for (int j = 0; j < 4; ++j) o8[64 * j] = (unsigned long long)pk2(v[q][j].x * rstd[q], v[q][j].y * rstd[q]) | ((unsigned long long)pk2(v[q][j].z * rstd[q], v[q][j].w * rstd[q]) << 32);
        }
        float a[32];
#pragma unroll
        for (int i = 0; i < 32; ++i) a[i] = 0.f;
#pragma unroll
        for (int j = 0; j < 4; ++j)
#pragma unroll
            for (int e = 0; e < 4; ++e) {
                const LAS f32x4* wp = (const LAS f32x4*)(wdt + ((j * 4 + e) * 64 + F.lane) * WDT_PITCH);
                const float x0 = v[0][j][e], x1 = v[1][j][e];
#pragma unroll
                for (int c4 = 0; c4 < 4; ++c4) { const f32x4 w = wp[c4];
#pragma unroll
                    for (int i = 0; i < 4; ++i) { a[c4 * 4 + i] += x0 * w[i]; a[16 + c4 * 4 + i] += x1 * w[i]; } }
                asm volatile("" ::: "memory");
            }
#define P0_HALVE(N, X) { const bool up = (F.lane & (X)) != 0; _Pragma("unroll") for (int i = 0; i < (N); ++i) { const float keep = up ? a[i + (N)] : a[i], send = up ? a[i] : a[i + (N)]; a[i] = keep + __shfl_xor(send, (X)); } }
        P0_HALVE(16, 32) P0_HALVE(8, 16) P0_HALVE(4, 8) P0_HALVE(2, 4) P0_HALVE(1, 2)
#undef P0_HALVE
        float tot = a[0] + __shfl_xor(a[0], 1);
        const int idx = F.lane >> 1, q = idx >> 4, c = idx & 15;
        tot = tot * (q ? rstd[1] : rstd[0]) + I.dt_bias[c];
        if ((F.lane & 1) == 0) F.DT[(size_t)c * MROWS + 2 * rp + q] = softplus_f(tot);
    }
    { v4u* zk = (v4u*)((unsigned char*)F.K - 4 * MiB); v4u* zv = (v4u*)((unsigned char*)F.V - 4 * MiB);
      for (size_t i = (size_t)F.vcu * NWAVES * 64 + F.tid; i < 4 * MiB / 16; i += (size_t)F.G * NWAVES * 64) {
          if (i * 16 >= 4 * MiB - (WS_K - (WS_Q + (size_t)MROWS * DM * 2))) zk[i] = (v4u){0u, 0u, 0u, 0u};
          if (i * 16 >= 4 * MiB - (WS_V - (WS_K + (size_t)MROWS * DM * 2))) zv[i] = (v4u){0u, 0u, 0u, 0u}; } }
    for (int r = NROWS + gw; r < MROWS; r += NGW) { GAS v4u* o = (GAS v4u*)(F.XN + (size_t)r * DM) + F.lane; o[0] = (v4u){0u, 0u, 0u, 0u}; o[64] = (v4u){0u, 0u, 0u, 0u};
                                                   GAS v4u* k = (GAS v4u*)(F.K + (size_t)r * DM) + F.lane; k[0] = (v4u){0u, 0u, 0u, 0u}; k[64] = (v4u){0u, 0u, 0u, 0u}; }
    for (int i = (F.vcu * NWAVES * 64 + F.tid); i < DB * 2 * CONVD; i += F.G * NWAVES * 64) {
        const int c = i % CONVD, rr = i / CONVD, j = rr & 1, b = rr >> 1;
        F.out[O_CS + ((size_t)b * 3 + j) * CONVD + c] = I.sconv[((size_t)b * 3 + j + 1) * CONVD + c];
    }
}

namespace att {
typedef float f32x16 __attribute__((ext_vector_type(16)));
typedef short v4i16_t __attribute__((ext_vector_type(4)));
typedef unsigned u32x4 __attribute__((ext_vector_type(4)));
constexpr int SPAN = 512, NSPAN = SEQ / SPAN, NUNITS = NB * NH * NSPAN;
constexpr int OPITCH = 64  , OACC_OFF = 0, LACC_OFF = SPAN * OPITCH * 4, LUT_OFF = LACC_OFF + 2048, LUTP = 192  , VST_OFF = LUT_OFF + 3072, VST_BYTES = 2048  , ATT_LDS_END = VST_OFF + NWAVES * VST_BYTES;
static_assert(ATT_LDS_END <= LDSCTL_OFF, "attention LDS");
__device__ __forceinline__ int crow(int r, int hi) { return (r & 3) + 8 * (r >> 2) + 4 * hi; }

struct ItemRegs { bf16x8 qf[4]; v4u kreg[4], vreg[4]; unsigned koff, voff; };
__device__ __forceinline__ int first_tile(int tq0, int d) { const int k = (97 * d - tq0 + 32 * d - 1) / (32 * d); return k < 0 ? 0 : (k > 4 ? 4 : k); }
struct ItemOut { f32x16 o0, o1; float lsum; };
#define ATT_LOAD_K(R, KT) do { const char* kb_ = (const char*)Kb + ((long)(tq0 + (-128 + 32 * (KT)) * d) * DM) * 2; \
        _Pragma("unroll") for (int i = 0; i < 4; ++i) (R).kreg[i] = *(const v4u*)(kb_ + (R).koff + (unsigned)((i & 1) * 16 * d * DM * 2) + 64 * (i >> 1)); } while (0)
#define ATT_LOAD_V(R, KT) do { const char* vb_ = (const char*)Vb + ((long)(tq0 + (-128 + 32 * (KT)) * d) * DM) * 2; \
        _Pragma("unroll") for (int i = 0; i < 4; ++i) (R).vreg[i] = *(const v4u*)(vb_ + (R).voff + (unsigned)(i * 8 * d * DM * 2)); } while (0)
template <int NQ>
__device__ __forceinline__ void item_load(ItemRegs& R, const bf16* Qb, const bf16* Kb, const bf16* Vb, int tq0, int d, int lane) {
    const int c = lane & 31, hi = lane >> 5;
    const bf16* qp = Qb + (size_t)(tq0 + (NQ == 32 ? c : (c & 15)) * d) * DM + 8 * hi;
#pragma unroll
    for (int ks = 0; ks < 4; ++ks) R.qf[ks] = *(const bf16x8*)(qp + 16 * ks);
    R.koff = (unsigned)(((lane >> 2) * d * DM + 8 * (lane & 3)) * 2); R.voff = (unsigned)(((lane >> 3) * d * DM + 8 * (lane & 7)) * 2);
    { const int kt0 = 97 * d - tq0 > 0 ? first_tile(tq0, d) : 0; ATT_LOAD_K(R, kt0); ATT_LOAD_V(R, kt0); }
}
template <int NQ>
__device__ __forceinline__ void item_tiles(ItemRegs& R, ItemOut& O, const bf16* Kb, const bf16* Vb, int tq0, int d, int pat, LAS unsigned char* lds, int wave, int lane) {
    const int c = lane & 31, hi = lane >> 5;
    LAS unsigned char* vst = lds + VST_OFF + wave * VST_BYTES;
    const LAS float* lut = (const LAS float*)(lds + LUT_OFF) + pat * LUTP + 31;
    f32x16 o0 = {}, o1 = {};
    float lsum = 0.f;
    const int lrow = lane >> 3, lch = lane & 7;
    const int stoff = lrow * 128 + ((lch ^ lrow) << 4);
    const int kwoff = (lane >> 2) * 64 + (((lane & 3) ^ ((lane >> 4) & 3)) << 4);
    const int q4 = (lane & 15) >> 2, odd = (lane >> 4) & 1, p4 = lane & 3;
#pragma unroll 1
    for (int kt = (97 * d - tq0 > 0 ? first_tile(tq0, d) : 0); kt < 5; ++kt) {
        bf16x8 kf[4];
#pragma unroll
        for (int h2 = 0; h2 < 2; ++h2) {
#pragma unroll
            for (int i = 0; i < 2; ++i) *(LAS v4u*)(vst + i * 1024 + kwoff) = R.kreg[2 * h2 + i];
#pragma unroll
            for (int ksl = 0; ksl < 2; ++ksl) kf[2 * h2 + ksl] = *(const LAS bf16x8*)(vst + c * 64 + (((2 * ksl + hi) ^ ((c >> 2) & 3)) << 4));
        }
        bf16x8 vb[2][2];
#pragma unroll
        for (int s = 0; s < 2; ++s) {
#pragma unroll
            for (int i = 0; i < 2; ++i) *(LAS v4u*)(vst + i * 1024 + stoff) = R.vreg[2 * s + i];
#pragma unroll
            for (int dh = 0; dh < 2; ++dh) {
                const int kr = 4 * hi + q4, ch16 = 4 * dh + 2 * odd + (p4 >> 1);
                const LAS unsigned char* vp0 = vst + kr * 128 + ((ch16 ^ (kr & 7)) << 4) + (p4 & 1) * 8;
                const LAS unsigned char* vp1 = vst + (kr + 8) * 128 + ((ch16 ^ (kr & 7)) << 4) + (p4 & 1) * 8;
                const v4i16_t lo = __builtin_amdgcn_ds_read_tr16_b64_v4i16((LAS v4i16_t*)vp0), hh = __builtin_amdgcn_ds_read_tr16_b64_v4i16((LAS v4i16_t*)vp1);
                vb[s][dh] = (bf16x8){lo[0], lo[1], lo[2], lo[3], hh[0], hh[1], hh[2], hh[3]};
            }
        }
        asm volatile("" ::: "memory");
        if (kt < 4) { ATT_LOAD_K(R, kt + 1); ATT_LOAD_V(R, kt + 1); }
        const int relb = c + 128 - 32 * kt - 4 * hi, tkb = tq0 + (-128 + 32 * kt + 4 * hi) * d;
        const bool edge = tq0 + (-128 + 32 * kt) * d < 0;
        f32x16 st;
        if (edge) {
#pragma unroll
            for (int r = 0; r < 16; ++r) { const int rel = relb - ((r & 3) + 8 * (r >> 2)); st[r] = lut[rel < 0 ? 0 : (rel > 128 ? 128 : rel)]; }
        } else {
#pragma unroll
            for (int r = 0; r < 16; ++r) st[r] = lut[relb - ((r & 3) + 8 * (r >> 2))];
        }
#pragma unroll
        for (int ks = 0; ks < 4; ++ks) st = __builtin_amdgcn_mfma_f32_32x32x16_bf16(kf[ks], R.qf[ks], st, 0, 0, 0);
        if (edge) {
#pragma unroll
            for (int r = 0; r < 16; ++r) {
                const int kk = (r & 3) + 8 * (r >> 2), rel = relb - kk;
                const bool valid = (rel >= 0) && (rel <= 128) && (tkb + kk * d >= 0);
                const float pe = __builtin_amdgcn_exp2f(st[r]), p = valid ? pe : 0.f;
                st[r] = p; lsum += p;
            }
        } else {
#pragma unroll
            for (int r = 0; r < 16; ++r) { const float p = __builtin_amdgcn_exp2f(st[r]); st[r] = p; lsum += p; }
        }
        u32x4 pw0, pw1;
        pw0.x = cvtpk_s(st[0], st[1]); pw0.y = cvtpk_s(st[2], st[3]); pw0.z = cvtpk_s(st[4], st[5]); pw0.w = cvtpk_s(st[6], st[7]);
        pw1.x = cvtpk_s(st[8], st[9]); pw1.y = cvtpk_s(st[10], st[11]); pw1.z = cvtpk_s(st[12], st[13]); pw1.w = cvtpk_s(st[14], st[15]);
        const bf16x8 pa0 = __builtin_bit_cast(bf16x8, pw0), pa1 = __builtin_bit_cast(bf16x8, pw1);
        o0 = __builtin_amdgcn_mfma_f32_32x32x16_bf16(pa0, vb[0][0], o0, 0, 0, 0);
        o1 = __builtin_amdgcn_mfma_f32_32x32x16_bf16(pa0, vb[0][1], o1, 0, 0, 0);
        o0 = __builtin_amdgcn_mfma_f32_32x32x16_bf16(pa1, vb[1][0], o0, 0, 0, 0);
        o1 = __builtin_amdgcn_mfma_f32_32x32x16_bf16(pa1, vb[1][1], o1, 0, 0, 0);
    }
    lsum += __shfl_xor(lsum, 32);
    O.o0 = o0; O.o1 = o1; O.lsum = lsum;
}
template <int NQ, bool ACC>
__device__ __forceinline__ void item_acc(const ItemOut& O, int toff, int d, LAS unsigned char* lds, int lane) {
    const int c = lane & 31, hi = lane >> 5;
    LAS float* oacc = (LAS float*)(lds + OACC_OFF); LAS float* lacc = (LAS float*)(lds + LACC_OFF);
    constexpr int NR = NQ == 32 ? 16 : 8;
    LAS float* base = oacc + (toff + 4 * hi * d) * OPITCH + c;
    float a0[NR], a1[NR], lo = 0.f;
    if (ACC) {
#pragma unroll
        for (int r = 0; r < NR; ++r) { const LAS float* row = base + ((r & 3) + 8 * (r >> 2)) * d * OPITCH; a0[r] = row[0]; a1[r] = row[32]; }
        if (hi == 0 && c < NQ) lo = lacc[toff + c * d];
        asm volatile("" ::: "memory");
    }
#pragma unroll
    for (int r = 0; r < NR; ++r) { LAS float* row = base + ((r & 3) + 8 * (r >> 2)) * d * OPITCH; row[0] = ACC ? a0[r] + O.o0[r] : O.o0[r]; row[32] = ACC ? a1[r] + O.o1[r] : O.o1[r]; }
    if (hi == 0 && c < NQ) lacc[toff + c * d] = ACC ? lo + O.lsum : O.lsum;
}

__device__ __forceinline__ void unit(Frame& F, int uidx, int& lut_h) {
    const int span = uidx % NSPAN, bh = uidx / NSPAN, h = bh % NH, b = bh / NH, t0 = span * SPAN;
    LAS unsigned char* lds = F.lds;
    LAS float* oacc = (LAS float*)(lds + OACC_OFF); LAS float* lacc = (LAS float*)(lds + LACC_OFF); LAS float* lut = (LAS float*)(lds + LUT_OFF);
    const bool newlut = h != lut_h; lut_h = h;
    if (newlut) for (int i = F.tid; i < 3 * LUTP; i += NWAVES * 64) { const int pat = i / LUTP, rel = i - pat * LUTP - 31, d = pat == 0 ? 1 : (pat == 1 ? 4 : 16);
        lut[i] = (rel >= 0 && rel <= 128) ? F.I.rel_bias[t5_bucket(rel * d) * NH + h] * LOG2E : -1e30f; }
    const size_t boff = (size_t)b * SEQ * DM + h * HD;
    const bf16 *Qb = F.Q + boff, *Kb = F.K + boff, *Vb = F.V + boff;
    const int w = F.wave, lane = F.lane;
    ItemRegs R; ItemOut O;
    const int tqA0 = t0 + 64 * w, tqA1 = tqA0 + 32, tqB0 = t0 + (w & 3) + 256 * (w >> 2), tqB1 = tqB0 + 128, tqC0 = t0 + w, tqC1 = t0 + w + 8;
    item_load<32>(R, Qb, Kb, Vb, tqA0, 1, lane);
    if (newlut) __syncthreads();
    item_tiles<32>(R, O, Kb, Vb, tqA0, 1, 0, lds, w, lane);
    item_load<32>(R, Qb, Kb, Vb, tqA1, 1, lane);
    item_acc<32, false>(O, tqA0 - t0, 1, lds, lane);
    item_tiles<32>(R, O, Kb, Vb, tqA1, 1, 0, lds, w, lane);
    item_load<32>(R, Qb, Kb, Vb, tqB0, 4, lane);
    item_acc<32, false>(O, tqA1 - t0, 1, lds, lane);
    __syncthreads();
    item_tiles<32>(R, O, Kb, Vb, tqB0, 4, 1, lds, w, lane);
    item_load<32>(R, Qb, Kb, Vb, tqB1, 4, lane);
    item_acc<32, true>(O, tqB0 - t0, 4, lds, lane);
    item_tiles<32>(R, O, Kb, Vb, tqB1, 4, 1, lds, w, lane);
    item_load<32>(R, Qb, Kb, Vb, tqC0, 16, lane);
    item_acc<32, true>(O, tqB1 - t0, 4, lds, lane);
    __syncthreads();
    item_tiles<32>(R, O, Kb, Vb, tqC0, 16, 2, lds, w, lane);
    item_load<32>(R, Qb, Kb, Vb, tqC1, 16, lane);
    item_acc<32, true>(O, tqC0 - t0, 16, lds, lane);
    item_tiles<32>(R, O, Kb, Vb, tqC1, 16, 2, lds, w, lane);
    item_acc<32, true>(O, tqC1 - t0, 16, lds, lane);
    v4u g[2][4];
#pragma unroll
    for (int ps = 0; ps < 2; ++ps) { const bf16* gp = F.Gb + ((size_t)b * SEQ + t0 + 64 * w + 32 * ps + (lane >> 1)) * DM + h * HD + 32 * (lane & 1);
#pragma unroll
        for (int j4 = 0; j4 < 4; ++j4) g[ps][j4] = *(const v4u*)(gp + 8 * j4); }
    __syncthreads();
#pragma unroll
    for (int ps = 0; ps < 2; ++ps) {
        const int tl = 64 * w + 32 * ps + (lane >> 1), hf = lane & 1;
        bf16* ap = F.AU + ((size_t)b * SEQ + t0 + tl) * 2048 + 1024 + h * HD + 32 * hf;
        const float rl = __builtin_amdgcn_rcpf(lacc[tl]);
        const LAS f32x4* op = (const LAS f32x4*)(oacc + tl * OPITCH + 32 * hf);
#pragma unroll
        for (int j4 = 0; j4 < 4; ++j4) {
            const f32x4 a = op[2 * j4], bq = op[2 * j4 + 1]; const v4u gg = g[ps][j4];
            v4u o;
            o.x = cvtpk_s(a[0] * rl * __uint_as_float(gg.x << 16), a[1] * rl * __uint_as_float(gg.x & 0xffff0000u));
            o.y = cvtpk_s(a[2] * rl * __uint_as_float(gg.y << 16), a[3] * rl * __uint_as_float(gg.y & 0xffff0000u));
            o.z = cvtpk_s(bq[0] * rl * __uint_as_float(gg.z << 16), bq[1] * rl * __uint_as_float(gg.z & 0xffff0000u));
            o.w = cvtpk_s(bq[2] * rl * __uint_as_float(gg.w << 16), bq[3] * rl * __uint_as_float(gg.w & 0xffff0000u));
            *(v4u*)(ap + 8 * j4) = o;
        }
    }
    __syncthreads();
}

}

namespace ssd {
typedef float f32x16 __attribute__((ext_vector_type(16)));
typedef short v4i16_t __attribute__((ext_vector_type(4)));
typedef unsigned u32x2 __attribute__((ext_vector_type(2)));
typedef float f32x2v __attribute__((ext_vector_type(2)));
constexpr int PITCH = 272;
constexpr int BT_OFF = 0, CT_OFF = 34816, G_OFF = 69632, HB_OFF = 104448, XD_OFF = 121856, XH_OFF = 138240, ACS_OFF = 154624, DTL_OFF = ACS_OFF + 512, SSQL_OFF = DTL_OFF + 512  , XW_OFF = SSQL_OFF + 1024  , FW_OFF = XW_OFF + 1280  , SSD_LDS_END = FW_OFF + 5120;
static_assert(SSD_LDS_END <= LDSCTL_OFF, "SSD LDS");
__device__ __forceinline__ int crow(int r, int hi) { return (r & 3) + 8 * (r >> 2) + 4 * hi; }
__device__ __forceinline__ bf16x8 trfrag(const LAS unsigned char* p0, const LAS unsigned char* p1) {
    const v4i16_t lo = __builtin_amdgcn_ds_read_tr16_b64_v4i16((LAS v4i16_t*)p0), hh = __builtin_amdgcn_ds_read_tr16_b64_v4i16((LAS v4i16_t*)p1);
    return (bf16x8){lo[0], lo[1], lo[2], lo[3], hh[0], hh[1], hh[2], hh[3]};
}
__device__ __forceinline__ float bflo(unsigned w) { return __uint_as_float(w << 16); }
__device__ __forceinline__ float bfhi(unsigned w) { return __uint_as_float(w & 0xffff0000u); }

constexpr int NSEG = 2;
__device__ __forceinline__ int seg_begin(int s) { return NSEG == 2 ? (s == 0 ? 0 : (s == 1 ? 32 : 64)) : (s == 0 ? 0 : (s == 1 ? 20 : (s == 2 ? 42 : 64))); }
__device__ __forceinline__ void chain(Frame& F, int item) {
    const Ins& I = F.I;
    const int bg = item / (8 * NSEG), li = item % (8 * NSEG), b = bg >> 1, hd = (bg & 1) * 8 + li / NSEG, seg = li % NSEG, grp = hd >> 3;
    constexpr int NCH = SEQ / 128; const int ch_begin = seg_begin(seg), ch_end = seg_begin(seg + 1);
    const int tid = F.tid, lane = F.lane, w = F.wave, c = lane & 31, hi = lane >> 5;
    LAS unsigned char* lds = F.lds;
    LAS float* acs = (LAS float*)(lds + ACS_OFF); LAS float* dtl = (LAS float*)(lds + DTL_OFF); LAS float* ssql = (LAS float*)(lds + SSQL_OFF);
    const float A = -__expf(I.a_log[hd]), dsk = I.d_skip[hd];
    const size_t row0 = (size_t)b * SEQ;
    for (int i = tid; i < 17408 / 16; i += NWAVES * 64) ((LAS v4u*)(lds + HB_OFF))[i] = (v4u){0u, 0u, 0u, 0u};
    f32x16 hacc = {};
    const int pt = w & 1, jt = w >> 1;
    const int q4 = (lane & 15) >> 2, odd = (lane >> 4) & 1, p4 = lane & 3;
    const int xtr = (8 * hi + q4) * 64 + (16 * odd + 4 * p4) * 2;
    const int xg = tid & 15, xr0 = (tid >> 4) * 4;
    const int fb = tid >> 8, fc = tid & 255;
    for (int i = tid; i < 5 * 64 + 5 * 256; i += NWAVES * 64) {
        if (i < 320) { const int t = i >> 6, e = i & 63; ((LAS float*)(lds + XW_OFF))[i] = t < 4 ? I.conv_w[t * CONVD + hd * 64 + e] : I.conv_b[hd * 64 + e]; }
        else { const int k = i - 320, t = k >> 8, e = k & 255, chn = 1024 + (e < 128 ? grp * 128 + e : 256 + grp * 128 + (e - 128)); ((LAS float*)(lds + FW_OFF))[k] = t < 4 ? I.conv_w[t * CONVD + chn] : I.conv_b[chn]; }
    }
    const int xoff = ((xg >> 3) << 10) + (xg & 7) * 8;
    float dtp0, dtp1; u32x2 xr[7]; v4u bcr[8]; float fxr[6]; u32x2 zr[4];
#define SSD_PREFETCH(T0) do { int t0_ = (T0), tv_ = tid, lv_ = lane; asm volatile("" : "+v"(t0_), "+v"(tv_), "+v"(lv_)); \
        const int xg_ = tv_ & 15, xr0_ = (tv_ >> 4) * 4, fb_ = tv_ >> 8, fc_ = tv_ & 255, fch_ = fc_ < 128 ? grp * 128 + fc_ : 256 + grp * 128 + (fc_ - 128); \
        { const float* dp_ = F.DT + (size_t)hd * MROWS + row0 + t0_ + 2 * lv_; dtp0 = dp_[0]; dtp1 = dp_[1]; } \
        { const bf16* xp_ = F.XBC + (row0 + t0_ + xr0_) * CONVD + hd * 64 + 4 * xg_; \
          _Pragma("unroll") for (int j = 0; j < 7; ++j) xr[j] = (t0_ + xr0_ - 3 + j) >= 0 ? *(const u32x2*)(xp_ + (j - 3) * CONVD) : (u32x2){0u, 0u}; } \
        { const bf16* bp_ = F.XBC + (row0 + t0_ + (tv_ >> 4)) * CONVD + 1024 + grp * 128 + 8 * (tv_ & 15); \
          _Pragma("unroll") for (int k = 0; k < 4; ++k) { bcr[k] = *(const v4u*)(bp_ + (size_t)k * 32 * CONVD); bcr[4 + k] = *(const v4u*)(bp_ + (size_t)k * 32 * CONVD + 256); } } \
        { const size_t blk = (row0 + t0_ + 64 * fb_) >> 6; const bool hasprev = (t0_ + 64 * fb_) > 0; const float* rp_ = F.RAWB + (blk * 6) * 512 + fch_; \
          _Pragma("unroll") for (int j = 0; j < 3; ++j) { fxr[j] = hasprev ? rp_[(j - 6) * 512] : 0.f; fxr[3 + j] = rp_[(3 + j) * 512]; } } \
    } while (0)
#define SSD_PREFETCH_Z(T0) do { int t0_ = (T0), lv_ = lane; asm volatile("" : "+v"(t0_), "+v"(lv_)); \
        const bf16* zp_ = F.Zb + (row0 + t0_ + 32 * jt + (lv_ & 31)) * DM + hd * 64 + 32 * pt + 4 * (lv_ >> 5); \
        _Pragma("unroll") for (int g4 = 0; g4 < 4; ++g4) zr[g4] = *(const u32x2*)(zp_ + 8 * g4); } while (0)
    __syncthreads();
    if (ch_begin > 0) {
        float dq[4]; u32x2 xr2[11]; v4u bcr2[8]; float fxr2[6];
        LAS float* det = (LAS float*)(lds + ACS_OFF);
#define SSD_PRE2_PREFETCH(T0) do { int t0_ = (T0), tv_ = tid, lv_ = lane; asm volatile("" : "+v"(t0_), "+v"(tv_), "+v"(lv_)); \
        const int xg_ = tv_ & 15, xr0_ = (tv_ >> 4) * 8, fb_ = tv_ >> 7, fch_ = grp * 128 + (tv_ & 127); \
        { const float* dp_ = F.DT + (size_t)hd * MROWS + row0 + t0_ + 2 * lv_; dq[0] = dp_[0]; dq[1] = dp_[1]; dq[2] = dp_[128]; dq[3] = dp_[129]; } \
        { const bf16* xp_ = F.XBC + (row0 + t0_ + xr0_) * CONVD + hd * 64 + 4 * xg_; \
          _Pragma("unroll") for (int j = 0; j < 11; ++j) xr2[j] = (t0_ + xr0_ - 3 + j) >= 0 ? *(const u32x2*)(xp_ + (j - 3) * CONVD) : (u32x2){0u, 0u}; } \
        { const bf16* bp_ = F.XBC + (row0 + t0_ + (tv_ >> 4)) * CONVD + 1024 + grp * 128 + 8 * (tv_ & 15); \
          _Pragma("unroll") for (int k = 0; k < 8; ++k) bcr2[k] = *(const v4u*)(bp_ + (size_t)k * 32 * CONVD); } \
        { const size_t blk = (row0 + t0_ + 64 * fb_) >> 6; const bool hasprev = (t0_ + 64 * fb_) > 0; const float* rp_ = F.RAWB + (blk * 6) * 512 + fch_; \
          _Pragma("unroll") for (int j = 0; j < 3; ++j) { fxr2[j] = hasprev ? rp_[(j - 6) * 512] : 0.f; fxr2[3 + j] = rp_[(3 + j) * 512]; } } \
    } while (0)
        SSD_PRE2_PREFETCH(0);
#pragma unroll 1
        for (int cp = 0; cp < ch_begin / 2; ++cp) {
            const int t0 = cp * 256;
            float atot;
            {
                const float v0 = dq[0] * A, v1 = dq[1] * A, v2 = dq[2] * A, v3 = dq[3] * A; float s1 = v0 + v1, s2 = v2 + v3;
#define SSD_DPP_ADD2(S, CTRL, RMASK, BC) S += __builtin_bit_cast(float, __builtin_amdgcn_update_dpp(0, __builtin_bit_cast(int, S), CTRL, RMASK, 0xf, BC))
                SSD_DPP_ADD2(s1, 0x111, 0xf, true); SSD_DPP_ADD2(s1, 0x112, 0xf, true); SSD_DPP_ADD2(s1, 0x114, 0xf, true); SSD_DPP_ADD2(s1, 0x118, 0xf, true); SSD_DPP_ADD2(s1, 0x142, 0xa, false); SSD_DPP_ADD2(s1, 0x143, 0xc, false);
                SSD_DPP_ADD2(s2, 0x111, 0xf, true); SSD_DPP_ADD2(s2, 0x112, 0xf, true); SSD_DPP_ADD2(s2, 0x114, 0xf, true); SSD_DPP_ADD2(s2, 0x118, 0xf, true); SSD_DPP_ADD2(s2, 0x142, 0xa, false); SSD_DPP_ADD2(s2, 0x143, 0xc, false);
#undef SSD_DPP_ADD2
                const float tot1 = __builtin_bit_cast(float, __builtin_amdgcn_readlane(__builtin_bit_cast(int, s1), 63));
                const float tot2 = __builtin_bit_cast(float, __builtin_amdgcn_readlane(__builtin_bit_cast(int, s2), 63));
                atot = tot1 + tot2;
                *(LAS f32x2v*)(det + 2 * lane) = (f32x2v){dq[0] * __expf(atot - (s1 - v1)), dq[1] * __expf(atot - s1)};
                *(LAS f32x2v*)(det + 128 + 2 * lane) = (f32x2v){dq[2] * __expf(tot2 - (s2 - v3)), dq[3] * __expf(tot2 - s2)};
            }
#pragma unroll
            for (int k = 0; k < 8; ++k) { const int row = (tid >> 4) + 32 * k; if ((row & 63) >= 3) *(LAS v4u*)(lds + BT_OFF + row * PITCH + 16 * (tid & 15)) = bcr2[k]; }
            {   const int fb2 = tid >> 7, fc2 = tid & 127;
                LAS unsigned char* dst = lds + BT_OFF + 2 * fc2 + 64 * fb2 * PITCH;
                const LAS float* fwp = (const LAS float*)(lds + FW_OFF) + fc2;
                const float fw0 = fwp[0], fw1 = fwp[256], fw2 = fwp[512], fw3 = fwp[768], fbias = fwp[1024];
#pragma unroll
                for (int j = 0; j < 3; ++j) *(LAS bf16*)(dst + j * PITCH) = (bf16)f2bf(silu_fast(fbias + fw0 * fxr2[j] + fw1 * fxr2[j + 1] + fw2 * fxr2[j + 2] + fw3 * fxr2[j + 3]));
            }
            {
                const LAS f32x4* xwp = (const LAS f32x4*)(lds + XW_OFF) + xg;
                const f32x4 xw0 = xwp[0], xw1 = xwp[16], xw2 = xwp[32], xw3 = xwp[48], xb = xwp[64];
                float xv[11][4];
#pragma unroll
                for (int j = 0; j < 11; ++j) { xv[j][0] = bflo(xr2[j].x); xv[j][1] = bfhi(xr2[j].x); xv[j][2] = bflo(xr2[j].y); xv[j][3] = bfhi(xr2[j].y); }
                const int xr8 = (tid >> 4) * 8;
#pragma unroll
                for (int i = 0; i < 8; ++i) {
                    const int s = xr8 + i; const float de = det[s]; float v[4];
#pragma unroll
                    for (int e = 0; e < 4; ++e) v[e] = silu_fast(xb[e] + xw0[e] * xv[i][e] + xw1[e] * xv[i + 1][e] + xw2[e] * xv[i + 2][e] + xw3[e] * xv[i + 3][e]);
                    *(LAS u32x2*)(lds + G_OFF + ((s >> 4) << 11) + xoff + (s & 15) * 64) = (u32x2){cvtpk_s(v[0] * de, v[1] * de), cvtpk_s(v[2] * de, v[3] * de)};
                }
            }
            asm volatile("" ::: "memory"); __builtin_amdgcn_sched_barrier(0);
            if (cp + 1 < ch_begin / 2) SSD_PRE2_PREFETCH(t0 + 256);
            __syncthreads();
            {   const float ea = __expf(atot);
#pragma unroll
                for (int r = 0; r < 16; ++r) hacc[r] *= ea;
                const int btr = (8 * hi + q4) * PITCH + (32 * jt + 16 * odd + 4 * p4) * 2;
#pragma unroll 4
                for (int ks = 0; ks < 16; ++ks) {
                    const LAS unsigned char* xp = lds + G_OFF + ((ks * 2 + pt) << 10) + xtr;
                    const LAS unsigned char* bp = lds + BT_OFF + 16 * ks * PITCH + btr;
                    hacc = __builtin_amdgcn_mfma_f32_32x32x16_bf16(trfrag(xp, xp + 256), trfrag(bp, bp + 4 * PITCH), hacc, 0, 0, 0);
                }
            }
            __syncthreads();
        }
#undef SSD_PRE2_PREFETCH
#pragma unroll
        for (int r = 0; r < 16; ++r) *(LAS bf16*)(lds + HB_OFF + (32 * pt + crow(r, hi)) * PITCH + (32 * jt + c) * 2) = (bf16)f2bf(hacc[r]);
        __syncthreads();
    }
    SSD_PREFETCH(ch_begin * 128); SSD_PREFETCH_Z(ch_begin * 128);
#pragma unroll 1
    for (int ch = ch_begin; ch < ch_end; ++ch) {
        const int t0 = ch * 128;
        const bool pre = false, prevfull = ch > ch_begin;
        float aend;
        {
            if (w < 2 && prevfull) { F.SSQ[(row0 + t0 - 128 + lane) * 32 + 2 * hd + w] = ssql[128 * w + lane]; F.SSQ[(row0 + t0 - 64 + lane) * 32 + 2 * hd + w] = ssql[128 * w + 64 + lane]; }
            const float v0 = dtp0 * A, v1 = dtp1 * A; float s = v0 + v1;
#define SSD_DPP_ADD(CTRL, RMASK, BC) s += __builtin_bit_cast(float, __builtin_amdgcn_update_dpp(0, __builtin_bit_cast(int, s), CTRL, RMASK, 0xf, BC))
            SSD_DPP_ADD(0x111, 0xf, true); SSD_DPP_ADD(0x112, 0xf, true); SSD_DPP_ADD(0x114, 0xf, true); SSD_DPP_ADD(0x118, 0xf, true);
            SSD_DPP_ADD(0x142, 0xa, false); SSD_DPP_ADD(0x143, 0xc, false);
#undef SSD_DPP_ADD
            aend = __builtin_bit_cast(float, __builtin_amdgcn_readlane(__builtin_bit_cast(int, s), 63));
            *(LAS f32x2v*)(acs + 2 * lane) = (f32x2v){s - v1, s}; *(LAS f32x2v*)(dtl + 2 * lane) = (f32x2v){dtp0, dtp1};
        }
#pragma unroll
        for (int k = 0; k < 4; ++k) { const int idx = tid + 512 * k, row = idx >> 4;
            if ((row & 63) >= 3) { *(LAS v4u*)(lds + BT_OFF + row * PITCH + 16 * (idx & 15)) = bcr[k]; if (!pre) *(LAS v4u*)(lds + CT_OFF + row * PITCH + 16 * (idx & 15)) = bcr[4 + k]; } }
        if (!pre || fc < 128) {
            LAS unsigned char* dst = lds + (fc < 128 ? BT_OFF + 2 * fc : CT_OFF + 2 * (fc - 128)) + 64 * fb * PITCH;
            const LAS float* fwp = (const LAS float*)(lds + FW_OFF) + fc;
            const float fw0 = fwp[0], fw1 = fwp[256], fw2 = fwp[512], fw3 = fwp[768], fbias = fwp[1024];
#pragma unroll
            for (int j = 0; j < 3; ++j) *(LAS bf16*)(dst + j * PITCH) = (bf16)f2bf(silu_fast(fbias + fw0 * fxr[j] + fw1 * fxr[j + 1] + fw2 * fxr[j + 2] + fw3 * fxr[j + 3]));
        }
        {
            const LAS f32x4* xwp = (const LAS f32x4*)(lds + XW_OFF) + xg;
            const f32x4 xw0 = xwp[0], xw1 = xwp[16], xw2 = xwp[32], xw3 = xwp[48], xb = xwp[64];
            float xv[7][4];
#pragma unroll
            for (int j = 0; j < 7; ++j) { xv[j][0] = bflo(xr[j].x); xv[j][1] = bfhi(xr[j].x); xv[j][2] = bflo(xr[j].y); xv[j][3] = bfhi(xr[j].y); }
#pragma unroll
            for (int i = 0; i < 4; ++i) {
                const int s = xr0 + i; const float dt = dtl[s], de = dt * __expf(aend - acs[s]); float v[4];
#pragma unroll
                for (int e = 0; e < 4; ++e) v[e] = silu_fast(xb[e] + xw0[e] * xv[i][e] + xw1[e] * xv[i + 1][e] + xw2[e] * xv[i + 2][e] + xw3[e] * xv[i + 3][e]);
                const int off = ((s >> 4) << 11) + xoff + (s & 15) * 64;
                if (!pre) *(LAS u32x2*)(lds + XD_OFF + off) = (u32x2){cvtpk_s(v[0] * dt, v[1] * dt), cvtpk_s(v[2] * dt, v[3] * dt)};
                *(LAS u32x2*)(lds + XH_OFF + off) = (u32x2){cvtpk_s(v[0] * de, v[1] * de), cvtpk_s(v[2] * de, v[3] * de)};
            }
        }
        asm volatile("" ::: "memory"); __builtin_amdgcn_sched_barrier(0);
        if (ch + 1 < ch_end) SSD_PREFETCH(t0 + 128);
        __syncthreads();
        f32x16 yt = {};
        if (!pre) {
        {
            const int j = w & 3; const float al = acs[32 * j + c];
#pragma unroll
            for (int ii = 0; ii < 2; ++ii) {
                const int i = 2 * (w >> 2) + ii;
                if (i <= j) {
                    f32x16 x = {};
                    const LAS unsigned char* ap = lds + BT_OFF + (32 * i + c) * PITCH + 16 * hi;
                    const LAS unsigned char* bp = lds + CT_OFF + (32 * j + c) * PITCH + 16 * hi;
#pragma unroll 4
                    for (int ks = 0; ks < 8; ++ks) x = __builtin_amdgcn_mfma_f32_32x32x16_bf16(*(const LAS bf16x8*)(ap + 32 * ks), *(const LAS bf16x8*)(bp + 32 * ks), x, 0, 0, 0);
                    const int l = 32 * j + c;
#pragma unroll
                    for (int g4 = 0; g4 < 4; ++g4) {
                        const int sb = 32 * i + 8 * g4 + 4 * hi; float gv[4];
                        const f32x4 as4 = *(const LAS f32x4*)(acs + sb);
#pragma unroll
                        for (int e = 0; e < 4; ++e) { const int s = sb + e; gv[e] = s <= l ? x[4 * g4 + e] * __builtin_amdgcn_exp2f((al - as4[e]) * LOG2E) : 0.f; }
                        *(LAS u32x2*)(lds + G_OFF + l * PITCH + sb * 2) = (u32x2){cvtpk_s(gv[0], gv[1]), cvtpk_s(gv[2], gv[3])};
                    }
                }
            }
        }
        {
            const LAS unsigned char* ap = lds + HB_OFF + (32 * pt + c) * PITCH + 16 * hi;
            const LAS unsigned char* bp = lds + CT_OFF + (32 * jt + c) * PITCH + 16 * hi;
#pragma unroll 4
            for (int ks = 0; ks < 8; ++ks) yt = __builtin_amdgcn_mfma_f32_32x32x16_bf16(*(const LAS bf16x8*)(ap + 32 * ks), *(const LAS bf16x8*)(bp + 32 * ks), yt, 0, 0, 0);
            const float el = __expf(acs[32 * jt + c]);
#pragma unroll
            for (int r = 0; r < 16; ++r) yt[r] *= el;
        }
        __syncthreads();
        {
            const LAS unsigned char* bp = lds + G_OFF + (32 * jt + c) * PITCH + 16 * hi;
            for (int ks = 0; ks < 2 * jt + 2; ++ks) {
                const LAS unsigned char* xp = lds + XD_OFF + ((ks * 2 + pt) << 10) + xtr;
                yt = __builtin_amdgcn_mfma_f32_32x32x16_bf16(trfrag(xp, xp + 256), *(const LAS bf16x8*)(bp + 32 * ks), yt, 0, 0, 0);
            }
        }
        }
        {
            const float ea = __expf(aend);
#pragma unroll
            for (int r = 0; r < 16; ++r) hacc[r] *= ea;
            const int btr = (8 * hi + q4) * PITCH + (32 * jt + 16 * odd + 4 * p4) * 2;
#pragma unroll 4
            for (int ks = 0; ks < 8; ++ks) {
                const LAS unsigned char* xp = lds + XH_OFF + ((ks * 2 + pt) << 10) + xtr;
                const LAS unsigned char* bp = lds + BT_OFF + 16 * ks * PITCH + btr;
                hacc = __builtin_amdgcn_mfma_f32_32x32x16_bf16(trfrag(xp, xp + 256), trfrag(bp, bp + 4 * PITCH), hacc, 0, 0, 0);
            }
        }
        {
#pragma unroll
            for (int r = 0; r < 16; r += 2) {
                *(LAS bf16*)(lds + HB_OFF + (32 * pt + crow(r, hi)) * PITCH + (32 * jt + c) * 2) = (bf16)(cvtpk_s(hacc[r], hacc[r + 1]) & 0xffffu);
                *(LAS bf16*)(lds + HB_OFF + (32 * pt + crow(r + 1, hi)) * PITCH + (32 * jt + c) * 2) = (bf16)(cvtpk_s(hacc[r], hacc[r + 1]) >> 16);
            }
        }
        if (!pre) {
            const int l = 32 * jt + c; const float rdt = dsk * __builtin_amdgcn_rcpf(dtl[l]);
            bf16* up = F.AU + (row0 + t0 + l) * 2048 + hd * 64 + 32 * pt;
            float sq = 0.f;
#pragma unroll
            for (int g4 = 0; g4 < 4; ++g4) {
                const int pl = 8 * g4 + 4 * hi;
                const u32x2 xw2 = *(const LAS u32x2*)(lds + XD_OFF + (((l >> 4) * 2 + pt) << 10) + (l & 15) * 64 + pl * 2);
                const u32x2 zw = zr[g4];
                const float u0 = (yt[4 * g4] + rdt * bflo(xw2.x)) * bflo(zw.x), u1 = (yt[4 * g4 + 1] + rdt * bfhi(xw2.x)) * bfhi(zw.x), u2 = (yt[4 * g4 + 2] + rdt * bflo(xw2.y)) * bflo(zw.y), u3 = (yt[4 * g4 + 3] + rdt * bfhi(xw2.y)) * bfhi(zw.y);
                sq += (u0 * u0 + u1 * u1) + (u2 * u2 + u3 * u3);
                *(u32x2*)(up + pl) = (u32x2){cvtpk_s(u0, u1), cvtpk_s(u2, u3)};
            }
            sq += __shfl_xor(sq, 32);
            if (hi == 0) ssql[128 * pt + l] = sq;
        }
        if (ch + 1 < ch_end) SSD_PREFETCH_Z(t0 + 128);
        __syncthreads();
    }
#undef SSD_PREFETCH
#undef SSD_PREFETCH_Z
    if (w < 2) { const int t0 = ch_end * 128; F.SSQ[(row0 + t0 - 128 + lane) * 32 + 2 * hd + w] = ssql[128 * w + lane]; F.SSQ[(row0 + t0 - 64 + lane) * 32 + 2 * hd + w] = ssql[128 * w + 64 + lane]; }
    if (seg == NSEG - 1) {
    float* ho = F.out + O_HP + (((size_t)b * NH + hd) * HD + 32 * pt) * DS + 32 * jt + c;
#pragma unroll
    for (int r = 0; r < 16; ++r) ho[(size_t)crow(r, hi) * DS] = hacc[r];
    }
    __syncthreads();
}
}

namespace smp {
__device__ __forceinline__ void attn_unit(Frame& F, int bhs) {
    const Ins& I = F.I;
    const int lane = F.lane, w = F.wave, b = bhs >> 4, h = bhs & 15, r = NTOK + b;
    LAS float* qs = (LAS float*)(F.lds + 4096); LAS float* acc = (LAS float*)F.lds;
    LAS float* ps = (LAS float*)(F.lds + 8192) + w * 64;
    if (F.tid < 64) qs[F.tid] = bf2f(F.Q[(size_t)r * DM + h * HD + F.tid]);
    if (F.tid < 65) acc[F.tid] = 0.f;
    const int k0 = 49 * w, nk = (387 - k0) < 49 ? (387 - k0) : 49;
    const float gate = bf2f(F.Gb[(size_t)r * DM + h * HD + lane]);
    const float vnew = bf2f(F.V[(size_t)r * DM + h * HD + lane]), knew = bf2f(F.K[(size_t)r * DM + h * HD + lane]);
    const float* vbase = I.cv + ((size_t)b * WIN * NH + h) * HD + lane;
    float vv[49];
#pragma unroll
    for (int k = 0; k < 49; ++k) {
        const int idx = (k0 + k) < 386 ? (k0 + k) : 386, pat = idx / 129, j = idx - pat * 129, d = pat == 0 ? 1 : (pat == 1 ? 4 : 16), jj = j > 0 ? j : 1;
        vv[k] = vbase[(size_t)(WIN - jj * d) * (NH * HD)];
    }
    const int idx = (k0 + lane) < 386 ? (k0 + lane) : 386, pat = idx / 129, j = idx - pat * 129, d = pat == 0 ? 1 : (pat == 1 ? 4 : 16), jj = j > 0 ? j : 1;
    const float bias = I.rel_bias[t5_bucket(j * d) * NH + h] * LOG2E;
    f32x4 kv[16];
    { const f32x4* kp = (const f32x4*)(I.ck + (((size_t)b * WIN + (WIN - jj * d)) * NH + h) * HD);
#pragma unroll
      for (int e = 0; e < 16; ++e) kv[e] = kp[e]; }
    __syncthreads();
    const float snew = wave_sum(qs[lane] * knew);
    float s = 0.f;
#pragma unroll
    for (int e = 0; e < 16; ++e) { const f32x4 qv = *(const LAS f32x4*)(qs + 4 * e); s += (qv[0] * kv[e][0] + qv[1] * kv[e][1]) + (qv[2] * kv[e][2] + qv[3] * kv[e][3]); }
    const float p = lane < nk ? __builtin_amdgcn_exp2f((j > 0 ? s : snew) + bias) : 0.f;
    ps[lane] = p;
    const float lsum = wave_sum(p);
    __builtin_amdgcn_wave_barrier();
    float o0 = 0.f, o1 = 0.f, o2 = 0.f, o3 = 0.f;
#define SMP_V(K) ({ const int idx_ = (k0 + (K)) < 386 ? (k0 + (K)) : 386; ps[(K)] * ((idx_ % 129) > 0 ? vv[(K)] : vnew); })
#pragma unroll
    for (int k = 0; k < 48; k += 4) { o0 += SMP_V(k); o1 += SMP_V(k + 1); o2 += SMP_V(k + 2); o3 += SMP_V(k + 3); }
    o0 += SMP_V(48);
#undef SMP_V
    __hip_atomic_fetch_add(acc + lane, (o0 + o1) + (o2 + o3), __ATOMIC_RELAXED, __HIP_MEMORY_SCOPE_WORKGROUP);
    if (lane == 0) __hip_atomic_fetch_add(acc + 64, lsum, __ATOMIC_RELAXED, __HIP_MEMORY_SCOPE_WORKGROUP);
    __syncthreads();
    if (w == 0) F.AU[(size_t)r * 2048 + 1024 + h * HD + lane] = (bf16)f2bf(acc[lane] * __builtin_amdgcn_rcpf(acc[64]) * gate);
    __syncthreads();
}

__device__ __forceinline__ void ssd_unit(Frame& F, int bhs) {
    const Ins& I = F.I;
    LAS float* xs_l = (LAS float*)F.lds; LAS float* B_l = xs_l + 64; LAS float* C_l = B_l + 128; LAS float* ssq_l = C_l + 128;
    const int tid = F.tid, p = tid >> 3, ng = tid & 7;
    const int b = bhs >> 4, hd = bhs & 15, grp = hd >> 3; const size_t r = (size_t)NTOK + b;
    float h[16];
    { const f32x4* hp = (const f32x4*)(I.sssm + (((size_t)b * NH + hd) * HD + p) * DS + ng * 16);
#pragma unroll
      for (int i = 0; i < 4; ++i) { const f32x4 v = hp[i]; h[4 * i] = v[0]; h[4 * i + 1] = v[1]; h[4 * i + 2] = v[2]; h[4 * i + 3] = v[3]; } }
    if (tid < 320) {
        const int ci = tid, c = ci < 64 ? hd * 64 + ci : (ci < 192 ? 1024 + grp * 128 + (ci - 64) : 1280 + grp * 128 + (ci - 192));
        float v = I.conv_b[c];
#pragma unroll
        for (int i = 0; i < 3; ++i) v += I.sconv[((size_t)b * 3 + i) * CONVD + c] * I.conv_w[i * CONVD + c];
        v += bf2f(F.XBC[r * CONVD + c]) * I.conv_w[3 * CONVD + c];
        xs_l[ci] = silu_f(v);
    }
    if (tid == 0) ssq_l[0] = 0.f;
    const float dt = F.DT[(size_t)hd * MROWS + r], A = -__expf(I.a_log[hd]), dsk = I.d_skip[hd], zg = bf2f(F.Zb[r * DM + hd * 64 + p]);
    __syncthreads();
    const float x = xs_l[p], dec = __expf(dt * A), xdt = x * dt;
    float y = 0.f;
#pragma unroll
    for (int i = 0; i < 16; ++i) { h[i] = h[i] * dec + xdt * B_l[ng * 16 + i]; y += h[i] * C_l[ng * 16 + i]; }
    y += __shfl_xor(y, 1); y += __shfl_xor(y, 2); y += __shfl_xor(y, 4);
    if (ng == 0) {
        const float u = (y + dsk * x) * zg;
        F.AU[r * 2048 + hd * 64 + p] = (bf16)f2bf(u);
        __hip_atomic_fetch_add(ssq_l, u * u, __ATOMIC_RELAXED, __HIP_MEMORY_SCOPE_WORKGROUP);
    }
    { f32x4* ho = (f32x4*)(F.out + O_HS + (((size_t)b * NH + hd) * HD + p) * DS + ng * 16);
#pragma unroll
      for (int i = 0; i < 4; ++i) ho[i] = (f32x4){h[4 * i], h[4 * i + 1], h[4 * i + 2], h[4 * i + 3]}; }
    __syncthreads();
    if (tid == 0) { F.SSQ[r * 32 + 2 * hd] = ssq_l[0]; F.SSQ[r * 32 + 2 * hd + 1] = 0.f; }
    __syncthreads();
}
}

namespace smp {
typedef float f32x16s __attribute__((ext_vector_type(16)));
template <int KS>
__device__ __forceinline__ void mm32x32(Frame& F, const bf16* WT, int wrow0, const bf16* A, int apitch, int K) {
    const int lane = F.lane, w = F.wave, c = lane & 31, hi = lane >> 5;
    const bf16* ap = WT + (size_t)(wrow0 + c) * K + w * (16 * KS) + 8 * hi;
    const bf16* bp = A + (size_t)c * apitch + w * (16 * KS) + 8 * hi;
    bf16x8 af[KS], bf[KS];
#pragma unroll
    for (int ks = 0; ks < KS; ++ks) { af[ks] = *(const bf16x8*)(ap + 16 * ks); bf[ks] = *(const bf16x8*)(bp + 16 * ks); }
    f32x16s acc = {};
#pragma unroll
    for (int ks = 0; ks < KS; ++ks) acc = __builtin_amdgcn_mfma_f32_32x32x16_bf16(af[ks], bf[ks], acc, 0, 0, 0);
    LAS float* red = (LAS float*)F.lds + w * 1024;
#pragma unroll
    for (int r = 0; r < 16; ++r) red[((r & 3) + 8 * (r >> 2) + 4 * hi) * 32 + c] = acc[r];
    __syncthreads();
}
__device__ __forceinline__ void inproj_pair(Frame& F, int hp) {
    const Ins& I = F.I;
    const int a0 = 64 * hp;
    LAS float* val = (LAS float*)(F.lds + 32768);
    const int lane = F.lane, w = F.wave;
#pragma unroll 1
    for (int hf = 0; hf < 2; ++hf) {
        const int a = a0 + 32 * hf;
        mm32x32<8>(F, F.WinT, (a & ~255) + vrow_of_col(a & 255), F.XN + (size_t)NTOK * DM, DM, DM);
        const LAS float* red = (const LAS float*)F.lds;
        { const int col = F.tid >> 4, r0 = 2 * (F.tid & 15); float s0 = 0.f, s1 = 0.f;
#pragma unroll
          for (int k = 0; k < 8; ++k) { s0 += red[k * 1024 + col * 32 + r0]; s1 += red[k * 1024 + col * 32 + r0 + 1]; }
          val[r0 * 64 + 32 * hf + col] = s0; val[(r0 + 1) * 64 + 32 * hf + col] = s1; }
        __syncthreads();
    }
#pragma unroll 1
    for (int rr = 0; rr < 4; ++rr) {
        const int r = 4 * w + rr;
        const float v = val[r * 64 + lane];
        const size_t row = (size_t)NTOK + r; const int col = a0 + lane;
        if (col < C_V) {
            const float sc = rsqrtf(wave_sum(v * v) * (1.f / 64.f) + EPS);
            if (col < C_K) F.Q[row * DM + col] = (bf16)f2bf(v * sc * I.qnw[lane] * QSCALE);
            else { const float kv = v * sc * I.knw[lane]; F.K[row * DM + col - C_K] = (bf16)f2bf(kv); F.out[O_KS + (size_t)r * DM + col - C_K] = kv; }
        } else if (col < C_G) { F.V[row * DM + col - C_V] = (bf16)f2bf(v); F.out[O_VS + (size_t)r * DM + col - C_V] = v; }
        else if (col < C_Z) F.Gb[row * DM + col - C_G] = (bf16)f2bf(silu_fast(v));
        else if (col < C_XBC) F.Zb[row * DM + col - C_Z] = (bf16)f2bf(silu_fast(v));
        else { F.XBC[row * CONVD + col - C_XBC] = (bf16)f2bf(v); F.out[O_CS + ((size_t)r * 3 + 2) * CONVD + col - C_XBC] = v; }
    }
    __syncthreads();
}
__device__ __forceinline__ void outproj_unit(Frame& F, int ct) {
    const Ins& I = F.I;
    const int a0 = 32 * ct;
    mm32x32<16>(F, F.WoutT, (a0 & ~255) + vrow_of_col(a0 & 255), F.AU + (size_t)NTOK * 2048, 2048, 2048);
    const LAS float* red = (const LAS float*)F.lds;
    const int col = F.tid >> 4, r0 = 2 * (F.tid & 15);
#pragma unroll
    for (int q = 0; q < 2; ++q) {
        const int r = r0 + q; float su = 0.f, sa = 0.f;
#pragma unroll
        for (int k = 0; k < 4; ++k) { su += red[k * 1024 + col * 32 + r]; sa += red[(4 + k) * 1024 + col * 32 + r]; }
        const f32x4* sp = (const f32x4*)(F.SSQ + ((size_t)NTOK + r) * 32); float s = 0.f;
#pragma unroll
        for (int i = 0; i < 8; ++i) { const f32x4 t = sp[i]; s += (t[0] + t[1]) + (t[2] + t[3]); }
        F.out[O_YS + (size_t)r * DM + a0 + col] = I.xs[(size_t)r * DM + a0 + col] + su * rsqrtf(s * (1.f / 1024.f) + EPS) + sa;
    }
    __syncthreads();
}
}

__device__ __forceinline__ void phase2_queue(Frame& F, int qset) {
    const unsigned x = xb_xcc_id() & 7u;
    constexpr int PER_Q = att::NUNITS / 8;
    int lut_h = -1;
    for (unsigned k = 0; k < 8; ++k) {
        const unsigned qx = (x + k) & 7u;
        gu32* qw = F.ctl + CW_Q + 64 * (8 * qset + qx);
        if (k == 1) {
            if (F.tid < 8) F.MISC[24 + F.tid] = __hip_atomic_load(F.ctl + CW_Q + 64 * (8 * qset + F.tid), RLX_AGENT);
            __syncthreads();
        }
        if (k >= 1 && F.MISC[24 + qx] >= (unsigned)(PER_Q + 128)) continue;
        if (F.tid == 0) F.MISC[16] = __hip_atomic_fetch_add(qw, 1u, RLX_AGENT);
        __syncthreads();
        unsigned idx = F.MISC[16];
        while (idx < (unsigned)(PER_Q + 128)) {
            unsigned nxt = 0u;
            if (F.tid == 0) nxt = __hip_atomic_fetch_add(qw, 1u, RLX_AGENT);
            if (idx < (unsigned)PER_Q) { att::unit(F, (int)(qx * PER_Q + idx), lut_h); }
            else if (idx < (unsigned)(PER_Q + 64)) smp::attn_unit(F, (int)(qx * 64 + idx - PER_Q));
            else smp::ssd_unit(F, (int)(qx * 64 + idx - PER_Q - 64));
            if (F.tid == 0) F.MISC[16] = nxt;
            __syncthreads();
            idx = F.MISC[16];
        }
        __syncthreads();
    }
}

constexpr int PROBE_REP_SSD = 1, PROBE_REP_ATT = 1;
struct Args { Ins in; float* out; unsigned char* ws; int ph_lo, ph_hi; };
__global__ void __launch_bounds__(NWAVES * 64, 2) mk_fwd(Args args) {
    extern __shared__ __attribute__((aligned(16))) unsigned char lds[];
    Frame F;
    F.lds = (LAS unsigned char*)lds;
    F.MISC = (volatile LAS unsigned*)(F.lds + MISC_OFF);
    F.tid = threadIdx.x; F.lane = F.tid & 63; F.wave = __builtin_amdgcn_readfirstlane(F.tid >> 6);
    F.G = gridDim.x; { const int bx = blockIdx.x; F.vcu = (F.G % 8 == 0) ? (bx % 8) * (F.G / 8) + bx / 8 : bx; }
    unsigned char* ws = args.ws;
    F.ctl = (gu32*)(ws + WS_CTL); F.I = args.in; F.out = args.out;
    F.WinT = (bf16*)(ws + WS_WIN); F.WoutT = (bf16*)(ws + WS_WOUT); F.XN = (bf16*)(ws + WS_XN); F.Q = (bf16*)(ws + WS_Q); F.K = (bf16*)(ws + WS_K); F.V = (bf16*)(ws + WS_V);
    F.AU = (bf16*)(ws + WS_AU); F.XBC = (bf16*)(ws + WS_XBC); F.DT = (float*)(ws + WS_DT); F.SSQ = (float*)(ws + WS_SSQ); F.RAWB = (float*)(ws + WS_RAWB); F.Gb = (bf16*)(ws + WS_G); F.Zb = (bf16*)(ws + WS_Z);
    for (int u = F.tid; u < (LDS_BYTES - LDSCTL_OFF) / 4; u += NWAVES * 64) ((LAS unsigned*)(F.lds + LDSCTL_OFF))[u] = 0u;
    __syncthreads();
    XcdBarrier bar = xcd_barrier_post((unsigned*)(F.ctl + CW_BAR), F.MISC + 8);
    const int lo = args.ph_lo, hi = args.ph_hi;
#define IN(k) (lo <= (k) && (k) < hi)
#define BOTH(k) (IN(k) && IN((k) + 1))
    if (IN(0)) { p0_prologue(F); if (BOTH(0)) xcd_barrier(bar); }
    if (IN(1)) {
        __syncthreads();
        pg8::Gemm g{F.XN, F.WinT, NTOK, NMAIN, DM}; pg8::StaticOrder S; S.init(NTOK, NMAIN, F.G, (int)blockIdx.x);
        pg8::EpiIn E{F.Q, F.K, F.V, F.Gb, F.Zb, F.XBC, F.out, F.I.qnw, F.I.knw, F.I.conv_w, F.I.conv_b, F.RAWB};
        pg8::gemm_phase<pg8::EpiIn, pg8::StaticOrder, true, true>(F.lds + RING_OFF, g, S, E);
        __syncthreads();
        for (int hp = F.vcu; hp < NMAIN / 64; hp += F.G) smp::inproj_pair(F, hp);
        if (BOTH(1)) xcd_barrier(bar);
    }
    if (IN(2)) { __syncthreads(); if ((F.vcu & 31) < 8 * ssd::NSEG && (F.vcu >> 5) < 8) { ssd::chain(F, (F.vcu >> 5) * (8 * ssd::NSEG) + (F.vcu & 31)); if (PROBE_ID == 30 && (F.vcu & 1)) { const unsigned long long t0_ = __builtin_amdgcn_s_memrealtime(); while (__builtin_amdgcn_s_memrealtime() - t0_ < 10000ull) __builtin_amdgcn_s_sleep(8); } } for (int rep = 0; rep < PROBE_REP_ATT; ++rep) phase2_queue(F, rep);     if (BOTH(2)) xcd_barrier(bar); }
    if (IN(3)) {
        __syncthreads();
        pg8::Gemm g{F.AU, F.WoutT, NTOK, DM, 2048}; pg8::StaticOrder S; S.init(NTOK, DM, F.G, (int)blockIdx.x);
        LAS float* rs = (LAS float*)(F.lds + RING_BYTES);
        { pg8::Unit u;
          for (int ui = 0; ui < 4 && S.next(ui, u); ++ui)
              for (int r = F.tid; r < 256; r += NWAVES * 64) {
                  const f32x4* sp = (const f32x4*)(F.SSQ + (size_t)(u.pm * 256 + r) * 32);
                  float s = 0.f;
#pragma unroll
                  for (int q = 0; q < 8; ++q) { const f32x4 v = sp[q]; s += (v[0] + v[1]) + (v[2] + v[3]); }
                  rs[ui * 256 + r] = rsqrtf(s * (1.f / 1024.f) + EPS);
              }
          __syncthreads(); }
        pg8::EpiOut E{F.I.xp, F.I.xs, rs, F.out};
        pg8::gemm_phase<pg8::EpiOut, pg8::StaticOrder, true, true>(F.lds + RING_OFF, g, S, E);
        __syncthreads();
        for (int ct = F.G - 1 - F.vcu; ct >= 0 && ct < DM / 32; ct += F.G) smp::outproj_unit(F, ct);
    }
#undef IN
#undef BOTH
}

extern "C" void kernel_launch(void* const* d_in, const int* in_sizes, int n_in, void* d_out, int out_size, void* d_ws, size_t ws_size, hipStream_t stream) {
    static int grid = 0;
    if (grid == 0) {
        if (n_in != 18 || out_size != (int)O_END || ws_size < WS_END) { fprintf(stderr, "kernel_launch: unexpected n_in %d / out_size %d / ws_size %zu; nothing launched\n", n_in, out_size, ws_size); grid = -1; return; }
        int dev = 0, cus = 0;
        if (hipGetDevice(&dev) != hipSuccess || hipDeviceGetAttribute(&cus, hipDeviceAttributeMultiprocessorCount, dev) != hipSuccess) { grid = -1; return; }
        if (hipFuncSetAttribute((const void*)mk_fwd, hipFuncAttributeMaxDynamicSharedMemorySize, LDS_BYTES) != hipSuccess) { fprintf(stderr, "kernel_launch: hipFuncSetAttribute failed\n"); grid = -1; return; }
        (void)hipGetLastError();
        grid = cus;
    }
    if (grid < 0) return;
    (void)hipMemsetAsync((char*)d_ws + WS_CTL, 0, CTL_ZERO_BYTES, stream);
    Args a{};
    const float** ip = (const float**)&a.in;
    for (int i = 0; i < 18; ++i) ip[i] = (const float*)d_in[i];
    a.out = (float*)d_out; a.ws = (unsigned char*)d_ws;
    a.ph_lo = 0; a.ph_hi = 4;
    hipLaunchKernelGGL(mk_fwd, dim3(grid), dim3(NWAVES * 64), LDS_BYTES, stream, a);
}
```

```cpp
#include <hip/hip_runtime.h>
#include <cstdio>
#include <cstdint>

constexpr int DM = 1024, NB = 4, SEQ = 8192, DB = 32, WIN = 2048;
constexpr int NPROJ = 6672, NMAIN = 6656, NTOK = NB * SEQ, NROWS = NTOK + DB;
constexpr int MROWS = 33024;
constexpr int C_Q = 0, C_K = 1024, C_V = 2048, C_G = 3072, C_Z = 4096, C_XBC = 5120, C_DT = 6656;
constexpr int CONVD = 1536, NH = 16, HD = 64, DS = 128;
constexpr float EPS = 1e-6f;
constexpr float QSCALE = 0.125f * 1.4426950408889634f;
constexpr float LOG2E = 1.4426950408889634f;
constexpr size_t O_YP = 0, O_YS = O_YP + (size_t)NTOK * DM, O_KP = O_YS + (size_t)DB * DM, O_VP = O_KP + (size_t)NB * WIN * DM,
                 O_CP = O_VP + (size_t)NB * WIN * DM, O_HP = O_CP + (size_t)NB * 3 * CONVD, O_KS = O_HP + (size_t)NB * NH * HD * DS,
                 O_VS = O_KS + (size_t)DB * DM, O_CS = O_VS + (size_t)DB * DM, O_HS = O_CS + (size_t)DB * 3 * CONVD,
                 O_END = O_HS + (size_t)DB * NH * HD * DS;
static_assert(O_END == 55314432, "output size");

constexpr size_t MiB = 1u << 20;
constexpr size_t WS_CTL = 0, CTL_ZERO_BYTES = 1 * MiB;
constexpr size_t WS_WIN = 2 * MiB;
constexpr size_t WS_WOUT = 16 * MiB;
constexpr size_t WS_DT = 20 * MiB;
constexpr size_t WS_SSQ = 24 * MiB;
constexpr size_t WS_XN = 32 * MiB;
constexpr size_t WS_Q = 100 * MiB;
constexpr size_t WS_K = 168 * MiB;
constexpr size_t WS_V = 236 * MiB;
constexpr size_t WS_AU = 304 * MiB;
constexpr size_t WS_XBC = 436 * MiB;
constexpr size_t WS_RAWB = 536 * MiB;
constexpr size_t WS_G = 544 * MiB;
constexpr size_t WS_Z = 612 * MiB;
constexpr size_t WS_END = 680 * MiB;
static_assert(WS_XN + (size_t)MROWS * DM * 2 <= WS_Q && WS_Q + (size_t)MROWS * DM * 2 <= WS_K && WS_K + (size_t)MROWS * DM * 2 <= WS_V && WS_V + (size_t)MROWS * DM * 2 <= WS_AU &&
              WS_AU + (size_t)MROWS * 2048 * 2 <= WS_XBC && WS_XBC + (size_t)MROWS * CONVD * 2 <= WS_RAWB && WS_RAWB + (size_t)(MROWS / 64) * 6 * 512 * 4 <= WS_G && WS_G + (size_t)MROWS * DM * 2 <= WS_Z && WS_Z + (size_t)MROWS * DM * 2 <= WS_END && WS_WIN + (size_t)NMAIN * DM * 2 <= WS_WOUT && WS_WOUT + (size_t)DM * 2048 * 2 <= WS_DT &&
              WS_DT + (size_t)MROWS * 16 * 4 <= WS_SSQ && WS_SSQ + (size_t)MROWS * 32 * 4 <= WS_XN, "d_ws map");

struct Ins {
    const float *xp, *xs, *ck, *cv, *sconv, *sssm, *norm_w, *w_in, *qnw, *knw, *rel_bias, *conv_w, *conv_b, *dt_bias, *a_log, *d_skip, *ssd_norm_w, *w_out;
};

typedef unsigned short bf16;
__device__ __forceinline__ float wave_sum(float v) {
#pragma unroll
    for (int o = 1; o < 64; o <<= 1) v += __shfl_xor(v, o);
    return v;
}
__device__ __forceinline__ float wave_max(float v) {
#pragma unroll
    for (int o = 1; o < 64; o <<= 1) v = fmaxf(v, __shfl_xor(v, o));
    return v;
}
__device__ __forceinline__ float silu_f(float x) { return x / (1.f + __expf(-x)); }
__device__ __forceinline__ float silu_fast(float x) { return x * __builtin_amdgcn_rcpf(1.f + __builtin_amdgcn_exp2f(-LOG2E * x)); }
__device__ __forceinline__ float softplus_f(float x) { return x > 20.f ? x : log1pf(__expf(x)); }
__device__ __forceinline__ int t5_bucket(int d) {
    if (d < 16) return d;
    int b = 16;
    b += d >= 22; b += d >= 30; b += d >= 40; b += d >= 54; b += d >= 73; b += d >= 99; b += d >= 134; b += d >= 182;
    b += d >= 246; b += d >= 332; b += d >= 450; b += d >= 609; b += d >= 825; b += d >= 1117; b += d >= 1513;
    return b;
}
__device__ __forceinline__ const float* xrow(const Ins& I, int r) { return r < NTOK ? I.xp + (size_t)r * DM : I.xs + (size_t)(r - NTOK) * DM; }
__device__ __forceinline__ float bf2f(bf16 v) { return __uint_as_float((unsigned)v << 16); }
__device__ __forceinline__ unsigned f2bf(float f) { unsigned u = __float_as_uint(f); return (u + 0x7fffu + ((u >> 16) & 1u)) >> 16; }
__device__ __forceinline__ unsigned pk2(float lo, float hi) { return f2bf(lo) | (f2bf(hi) << 16); }
typedef float f32x2_cv __attribute__((ext_vector_type(2))); typedef __bf16 bf16x2_cv __attribute__((ext_vector_type(2)));
__device__ __forceinline__ unsigned cvtpk_s(float lo, float hi) { const f32x2_cv v = {lo, hi}; const bf16x2_cv b = __builtin_convertvector(v, bf16x2_cv); return __builtin_bit_cast(unsigned, b); }
__host__ __device__ __forceinline__ int vrow_of_col(int a) { return 128 * ((a >> 5) & 1) + 32 * ((a >> 6) & 3) + (a & 31); }

namespace pg8 {
#define PG8_LAS __attribute__((address_space(3)))
typedef unsigned short bf16_t;
typedef short bf16x8 __attribute__((ext_vector_type(8)));
typedef float f32x4 __attribute__((ext_vector_type(4)));
typedef unsigned u32x4 __attribute__((ext_vector_type(4)));
constexpr int BM = 256, BK = 64, HALF = 128, HTB = HALF * BK * 2  , STAGE_BYTES = 8 * HTB, NXCD = 8, WGM = 4;

__host__ __device__ __forceinline__ int lds_byte(int r, int c) { const int st = (r >> 4) * 2 + (c >> 5), rr = r & 15, cc = c & 31, ob = rr * 64 + cc * 2; return st * 1024 + (ob ^ (((ob >> 9) & 1) << 5)); }
__host__ __device__ __forceinline__ void stage_rc(int b, int& R, int& C) { const int st = b / 1024, sb = b % 1024, swz = sb ^ (((sb >> 9) & 1) << 5); R = (st >> 1) * 16 + swz / 64; C = (st & 1) * 32 + (swz % 64) / 2; }
__host__ __device__ __forceinline__ int perm32(int rho) { const int n = rho >> 4, i = rho & 15; return 8 * (i >> 2) + 4 * n + (i & 3); }

struct Unit { int pm, pn; };
struct Gemm { const bf16_t* A; const bf16_t* Bt; int M, N, K; };

struct StaticOrder {
    int nM, nN, nwg, G, c;
    __host__ __device__ void init(int M, int N, int G_, int c_) { nM = M / BM; nN = N / BM; nwg = nM * nN; G = G_; c = c_; }
    __host__ __device__ bool next(int i, Unit& u) const {
        const long L = (long)i * G + c; if (L >= nwg) return false;
        int wgid = (int)L; { const int q = nwg / NXCD, r = nwg % NXCD, xcd = wgid % NXCD, off = wgid / NXCD; wgid = (xcd < r ? xcd * (q + 1) : r * (q + 1) + (xcd - r) * q) + off; }
        const int nig = WGM * nN, gid = wgid / nig, fm = gid * WGM, gsz = (nM - fm) < WGM ? (nM - fm) : WGM;
        u.pm = fm + ((wgid % nig) % gsz); u.pn = (wgid % nig) / gsz; return true;
    }
    __device__ __forceinline__ void a_ready(const Unit&) const {}
    __device__ __forceinline__ void done(const Unit&) const {}
};

__device__ __forceinline__ unsigned cvt_pk_bf16(float lo, float hi) { unsigned r; asm volatile("v_cvt_pk_bf16_f32 %0, %1, %2" : "=v"(r) : "v"(lo), "v"(hi)); return r; }

template <int K> __device__ __forceinline__ float rowprev(float cur, float prevm) {
    const int t = __builtin_amdgcn_update_dpp(0, __builtin_bit_cast(int, prevm), 0x100 + (16 - K), 0xf, 0xf, true);
    return __builtin_bit_cast(float, __builtin_amdgcn_update_dpp(t, __builtin_bit_cast(int, cur), 0x110 + K, 0xf, 0xf, false));
}

struct EpiIn {
    static constexpr bool PERM = true, AFTER_DRAIN = false, MIDK = false;
    bf16_t *Q, *K, *V, *Gb, *Zb, *XBC; float* out; const float *qnw, *knw, *conv_w, *conv_b; float* rawb;
    __device__ __forceinline__ void mid(f32x4 (&)[2][2][4][2], const Unit&, int, int, int, int, int) const {}
    __device__ __forceinline__ void operator()(const f32x4 (&acc)[2][2][4][2], const Unit& u, int wr, int wc, int fr, int fq) const {
        const int pn = u.pn;
        const int rowb = u.pm * BM + wr * 64 + fr;
        const int cl = wc * 64 + 8 * fq;
        if (pn < 8) {
            const bool isq = pn < 4; const float* nw = isq ? qnw : knw;
            f32x4 w[2][2];
#pragma unroll
            for (int bj = 0; bj < 2; ++bj)
#pragma unroll
                for (int n = 0; n < 2; ++n) w[bj][n] = *(const f32x4*)(nw + 8 * fq + 32 * bj + 4 * n);
            bf16_t* dstb = (isq ? Q : K) + (pn & 3) * 256 + cl;
#pragma unroll
            for (int ai = 0; ai < 2; ++ai)
#pragma unroll
                for (int m = 0; m < 4; ++m) {
                    const int r = rowb + ai * HALF + m * 16;
                    float ss = 0.f;
#pragma unroll
                    for (int bj = 0; bj < 2; ++bj)
#pragma unroll
                        for (int n = 0; n < 2; ++n) { const f32x4 v = acc[ai][bj][m][n]; ss += (v[0] * v[0] + v[1] * v[1]) + (v[2] * v[2] + v[3] * v[3]); }
                    ss += __shfl_xor(ss, 16); ss += __shfl_xor(ss, 32);
                    const float sc = rsqrtf(ss * (1.f / 64.f) + EPS), scs = isq ? sc * QSCALE : sc;
                    float* f32dst = nullptr;
                    if (!isq) { if (r < NTOK) { const int t = r & (SEQ - 1); if (t >= SEQ - WIN) f32dst = out + O_KP + ((size_t)((r >> 13) * WIN + t - (SEQ - WIN))) * DM + (pn & 3) * 256 + cl; }
                                else if (r < NROWS) f32dst = out + O_KS + (size_t)(r - NTOK) * DM + (pn & 3) * 256 + cl; }
#pragma unroll
                    for (int bj = 0; bj < 2; ++bj) {
                        const f32x4 a0 = acc[ai][bj][m][0] * w[bj][0], a1 = acc[ai][bj][m][1] * w[bj][1];
                        u32x4 o; o.x = cvt_pk_bf16(a0[0] * scs, a0[1] * scs); o.y = cvt_pk_bf16(a0[2] * scs, a0[3] * scs); o.z = cvt_pk_bf16(a1[0] * scs, a1[1] * scs); o.w = cvt_pk_bf16(a1[2] * scs, a1[3] * scs);
                        __builtin_nontemporal_store(o, (u32x4*)(dstb + (size_t)r * DM + 32 * bj));
                        if (f32dst) { __builtin_nontemporal_store(a0 * sc, (f32x4*)(f32dst + 32 * bj)); __builtin_nontemporal_store(a1 * sc, (f32x4*)(f32dst + 32 * bj + 4)); }
                    }
                }
        } else if (pn < 12) {
            bf16_t* dstb = V + (pn & 3) * 256 + cl;
#pragma unroll
            for (int ai = 0; ai < 2; ++ai)
#pragma unroll
                for (int m = 0; m < 4; ++m) {
                    const int r = rowb + ai * HALF + m * 16;
                    float* f32dst = nullptr;
                    if (r < NTOK) { const int t = r & (SEQ - 1); if (t >= SEQ - WIN) f32dst = out + O_VP + ((size_t)((r >> 13) * WIN + t - (SEQ - WIN))) * DM + (pn & 3) * 256 + cl; }
                    else if (r < NROWS) f32dst = out + O_VS + (size_t)(r - NTOK) * DM + (pn & 3) * 256 + cl;
#pragma unroll
                    for (int bj = 0; bj < 2; ++bj) {
                        const f32x4 a0 = acc[ai][bj][m][0], a1 = acc[ai][bj][m][1];
                        u32x4 o; o.x = cvt_pk_bf16(a0[0], a0[1]); o.y = cvt_pk_bf16(a0[2], a0[3]); o.z = cvt_pk_bf16(a1[0], a1[1]); o.w = cvt_pk_bf16(a1[2], a1[3]);
                        __builtin_nontemporal_store(o, (u32x4*)(dstb + (size_t)r * DM + 32 * bj));
                        if (f32dst) { __builtin_nontemporal_store(a0, (f32x4*)(f32dst + 32 * bj)); __builtin_nontemporal_store(a1, (f32x4*)(f32dst + 32 * bj + 4)); }
                    }
                }
        } else if (pn < 20) {
            bf16_t* dstb = (pn < 16 ? Gb : Zb) + (pn & 3) * 256 + cl;
#pragma unroll
            for (int ai = 0; ai < 2; ++ai)
#pragma unroll
                for (int m = 0; m < 4; ++m) {
                    const int r = rowb + ai * HALF + m * 16;
#pragma unroll
                    for (int bj = 0; bj < 2; ++bj) {
                        f32x4 a0 = acc[ai][bj][m][0], a1 = acc[ai][bj][m][1];
#pragma unroll
                        for (int i = 0; i < 4; ++i) { a0[i] = silu_fast(a0[i]); a1[i] = silu_fast(a1[i]); }
                        u32x4 o; o.x = cvt_pk_bf16(a0[0], a0[1]); o.y = cvt_pk_bf16(a0[2], a0[3]); o.z = cvt_pk_bf16(a1[0], a1[1]); o.w = cvt_pk_bf16(a1[2], a1[3]);
                        __builtin_nontemporal_store(o, (u32x4*)(dstb + (size_t)r * DM + 32 * bj));
                    }
                }
        } else {
            const int cb = (pn - 20) * 256 + cl;
            bf16_t* dstb = XBC + cb;
            const bool do_conv = pn >= 24 && u.pm < NTOK / BM;
#pragma unroll
            for (int ai = 0; ai < 2; ++ai)
#pragma unroll
                for (int m = 0; m < 4; ++m) {
                    const int r = rowb + ai * HALF + m * 16;
                    float* f32dst = nullptr;
                    if (r < NTOK) { const int t = r & (SEQ - 1); if (t >= SEQ - 3) f32dst = out + O_CP + ((size_t)((r >> 13) * 3 + t - (SEQ - 3))) * CONVD + cb; }
                    else if (r < NROWS) f32dst = out + O_CS + ((size_t)(r - NTOK) * 3 + 2) * CONVD + cb;
                    if (do_conv && (m == 0 || m == 3)) {
                        const int slot = m == 0 ? 3 + fr : fr - 13;
                        if (slot >= 0 && slot < 6) f32dst = rawb + ((size_t)(u.pm * 4 + ai * 2 + wr) * 6 + slot) * 512 + (cb - 1024);
                    }
#pragma unroll
                    for (int bj = 0; bj < 2; ++bj) {
                        const f32x4 a0 = acc[ai][bj][m][0], a1 = acc[ai][bj][m][1];
                        if (!do_conv) { u32x4 o; o.x = cvt_pk_bf16(a0[0], a0[1]); o.y = cvt_pk_bf16(a0[2], a0[3]); o.z = cvt_pk_bf16(a1[0], a1[1]); o.w = cvt_pk_bf16(a1[2], a1[3]);
                                        __builtin_nontemporal_store(o, (u32x4*)(dstb + (size_t)r * CONVD + 32 * bj)); }
                        if (f32dst) { __builtin_nontemporal_store(a0, (f32x4*)(f32dst + 32 * bj)); __builtin_nontemporal_store(a1, (f32x4*)(f32dst + 32 * bj + 4)); }
                    }
                }
            if (do_conv) {
                if ((u.pm & 31) == 31 && wr == 1 && fr >= 13) {
#pragma unroll
                    for (int bj = 0; bj < 2; ++bj) { float* d = out + O_CP + ((size_t)((u.pm >> 5) * 3 + fr - 13)) * CONVD + cb + 32 * bj; *(f32x4*)d = acc[1][bj][3][0]; *(f32x4*)(d + 4) = acc[1][bj][3][1]; }
                }
#pragma unroll
                for (int bj = 0; bj < 2; ++bj) {
                    f32x4 w[4][2], bb[2];
#pragma unroll
                    for (int n = 0; n < 2; ++n) { bb[n] = *(const f32x4*)(conv_b + cb + 32 * bj + 4 * n);
#pragma unroll
                        for (int t = 0; t < 4; ++t) w[t][n] = *(const f32x4*)(conv_w + t * CONVD + cb + 32 * bj + 4 * n); }
#pragma unroll
                    for (int ai = 0; ai < 2; ++ai) {
                        f32x4 pm[2] = {(f32x4){0.f, 0.f, 0.f, 0.f}, (f32x4){0.f, 0.f, 0.f, 0.f}};
#pragma unroll
                        for (int m = 0; m < 4; ++m) {
                            const int r = rowb + ai * HALF + m * 16;
                            unsigned ow[4];
#pragma unroll
                            for (int n = 0; n < 2; ++n) {
                                const f32x4 cur = acc[ai][bj][m][n]; f32x4 v;
#pragma unroll
                                for (int i = 0; i < 4; ++i) {
                                    const float p1 = rowprev<1>(cur[i], pm[n][i]), p2 = rowprev<2>(cur[i], pm[n][i]), p3 = rowprev<3>(cur[i], pm[n][i]);
                                    v[i] = silu_fast(bb[n][i] + w[0][n][i] * p3 + w[1][n][i] * p2 + w[2][n][i] * p1 + w[3][n][i] * cur[i]);
                                }
                                ow[2 * n] = cvt_pk_bf16(v[0], v[1]); ow[2 * n + 1] = cvt_pk_bf16(v[2], v[3]);
                                pm[n] = cur;
                            }
                            __builtin_nontemporal_store((u32x4){ow[0], ow[1], ow[2], ow[3]}, (u32x4*)(dstb + (size_t)r * CONVD + 32 * bj));
                        }
                    }
                }
            }
        }
    }
};

struct EpiOut {
    static constexpr bool PERM = true, AFTER_DRAIN = false, MIDK = true;
    const float* xp; const float* xs; const PG8_LAS float* rs; float* out;
    __device__ __forceinline__ void mid(f32x4 (&acc)[2][2][4][2], const Unit& u, int ui, int wr, int wc, int fr, int fq) const {
        const PG8_LAS float* rp = rs + ui * 256 + wr * 64 + fr;
#pragma unroll
        for (int ai = 0; ai < 2; ++ai)
#pragma unroll
            for (int m = 0; m < 4; ++m) {
                const float r = rp[ai * HALF + m * 16];
#pragma unroll
                for (int bj = 0; bj < 2; ++bj)
#pragma unroll
                    for (int n = 0; n < 2; ++n) acc[ai][bj][m][n] *= r;
            }
    }
    __device__ __forceinline__ void operator()(const f32x4 (&acc)[2][2][4][2], const Unit& u, int wr, int wc, int fr, int fq) const {
        const int rowb = u.pm * BM + wr * 64 + fr, col = u.pn * BM + wc * 64 + 8 * fq;
#pragma unroll
        for (int ai = 0; ai < 2; ++ai) {
            f32x4 xv[4][2][2];
#pragma unroll
            for (int m = 0; m < 4; ++m) {
                const float* xr = xp + (size_t)(rowb + ai * HALF + m * 16) * DM + col;
#pragma unroll
                for (int bj = 0; bj < 2; ++bj) { xv[m][bj][0] = *(const f32x4*)(xr + 32 * bj); xv[m][bj][1] = *(const f32x4*)(xr + 32 * bj + 4); }
            }
#pragma unroll
            for (int m = 0; m < 4; ++m) {
                float* yr = out + O_YP + (size_t)(rowb + ai * HALF + m * 16) * DM + col;
#pragma unroll
                for (int bj = 0; bj < 2; ++bj) { *(f32x4*)(yr + 32 * bj) = xv[m][bj][0] + acc[ai][bj][m][0]; *(f32x4*)(yr + 32 * bj + 4) = xv[m][bj][1] + acc[ai][bj][m][1]; }
            }
        }
    }
};

template <class Epi, class Sched, bool ALIGN_EPI = false, bool SP2 = false>
__device__ __forceinline__ void gemm_phase(PG8_LAS unsigned char* lds, const Gemm g, const Sched& S, const Epi& E) {
    const int tid = threadIdx.x, wid = __builtin_amdgcn_readfirstlane(tid >> 6), lane = tid & 63, wr = wid >> 2, wc = wid & 3, fr = lane & 15, fq = lane >> 4;
    const int K = g.K, nt = K / BK;
    unsigned voffA[2], voffB[2];
#pragma unroll
    for (int i = 0; i < 2; ++i) { int R, C; stage_rc(tid * 16 + i * 8192, R, C); const int Rb = Epi::PERM ? ((R & ~31) + perm32(R & 31)) : R;
        voffA[i] = (unsigned)(R * K + C) * 2u; voffB[i] = (unsigned)(Rb * K + C) * 2u; }
    const size_t kstep = (size_t)(BK * 2);
    const size_t hstep = (size_t)HALF * K * 2;
    const size_t tstep = 2 * hstep;
    const unsigned ldsw = (unsigned)wid * 1024u;
    const int aoff = lds_byte(wr * 64 + fr, fq * 8), boff = lds_byte(wc * 32 + fr, fq * 8);
#define PG8_SA(b, h) (((b) * 2 + (h)) * HTB)
#define PG8_SB(b, h) ((4 + (b) * 2 + (h)) * HTB)
#define PG8_STAGE(bufoff, gbase, voff) do { _Pragma("unroll") for (int _i = 0; _i < 2; ++_i) \
        __builtin_amdgcn_global_load_lds((const unsigned*)((const char*)(gbase) + (voff)[_i]), (PG8_LAS unsigned*)(lds + (bufoff) + ldsw + _i * 8192), 16, 0, 0); } while (0)
#define PG8_LDA(dst, b, h) do { _Pragma("unroll") for (int m = 0; m < 4; ++m) _Pragma("unroll") for (int k = 0; k < 2; ++k) dst[m][k] = *(const PG8_LAS bf16x8*)(lds + PG8_SA(b, h) + aoff + m * 2048 + k * 1024); } while (0)
#define PG8_LDB(dst, b, h) do { _Pragma("unroll") for (int n = 0; n < 2; ++n) _Pragma("unroll") for (int k = 0; k < 2; ++k) dst[n][k] = *(const PG8_LAS bf16x8*)(lds + PG8_SB(b, h) + boff + n * 2048 + k * 1024); } while (0)
#define PG8_MMA(ai, bj, At, Bt) do { __builtin_amdgcn_s_setprio(1); _Pragma("unroll") for (int m = 0; m < 4; ++m) _Pragma("unroll") for (int n = 0; n < 2; ++n) _Pragma("unroll") for (int k = 0; k < 2; ++k) \
        acc[ai][bj][m][n] = __builtin_amdgcn_mfma_f32_16x16x32_bf16(Bt[n][k], At[m][k], acc[ai][bj][m][n], 0, 0, 0); __builtin_amdgcn_s_setprio(0); } while (0)
#define PG8_WAIT_V(n) asm volatile("s_waitcnt vmcnt(" #n ")" ::: "memory")
#define PG8_WAIT_L(n) asm volatile("s_waitcnt lgkmcnt(" #n ")" ::: "memory")
#define PG8_BAR __builtin_amdgcn_s_barrier()
#define PG8_SCHED __builtin_amdgcn_sched_barrier(0)
    Unit cur, nxt; int ui = 0;
    if (!S.next(0, cur)) return;
    f32x4 acc[2][2][4][2];
#pragma unroll
    for (int a = 0; a < 2; ++a)
#pragma unroll
        for (int b = 0; b < 2; ++b)
#pragma unroll
            for (int m = 0; m < 4; ++m)
#pragma unroll
                for (int n = 0; n < 2; ++n) acc[a][b][m][n] = (f32x4){0.f, 0.f, 0.f, 0.f};
    bf16x8 At[4][2], B0[2][2], B1[2][2];
    const char* cA = (const char*)g.A + (size_t)cur.pm * tstep; const char* cB = (const char*)g.Bt + (size_t)cur.pn * tstep;
    S.a_ready(cur);
    if constexpr (SP2) {
        PG8_STAGE(PG8_SB(0, 0), cB, voffB); PG8_STAGE(PG8_SB(0, 1), cB + hstep, voffB); PG8_STAGE(PG8_SA(0, 0), cA, voffA); PG8_STAGE(PG8_SA(0, 1), cA + hstep, voffA);
        if (wr == 1) PG8_BAR;
        PG8_WAIT_V(2); PG8_BAR;
        PG8_STAGE(PG8_SB(1, 0), cB + kstep, voffB); PG8_STAGE(PG8_SA(1, 0), cA + kstep, voffA); PG8_STAGE(PG8_SB(1, 1), cB + hstep + kstep, voffB);
        PG8_WAIT_V(6); PG8_BAR;
    } else {
        PG8_STAGE(PG8_SB(0, 0), cB, voffB); PG8_STAGE(PG8_SA(0, 0), cA, voffA); PG8_STAGE(PG8_SB(0, 1), cB + hstep, voffB); PG8_STAGE(PG8_SA(0, 1), cA + hstep, voffA);
        if (wr == 1) PG8_BAR;
        PG8_WAIT_V(4); PG8_BAR;
        PG8_STAGE(PG8_SB(1, 0), cB + kstep, voffB); PG8_STAGE(PG8_SA(1, 0), cA + kstep, voffA); PG8_STAGE(PG8_SB(1, 1), cB + hstep + kstep, voffB);
        PG8_WAIT_V(6); PG8_BAR;
    }
    for (;;) {
        const bool has_next = S.next(ui + 1, nxt);
        const char* nA = has_next ? (const char*)g.A + (size_t)nxt.pm * tstep : cA; const char* nB = has_next ? (const char*)g.Bt + (size_t)nxt.pn * tstep : cB;
        for (int t = 0; t < nt; t += 2) {
            const bool last = (t == nt - 2);
            if constexpr (Epi::MIDK) { if (t == (nt >> 1)) E.mid(acc, cur, ui, wr, wc, fr, fq); }
            const char* a1 = cA + (size_t)(t + 1) * kstep;
            const char* a2 = last ? nA : cA + (size_t)(t + 2) * kstep; const char* b2 = last ? nB : cB + (size_t)(t + 2) * kstep;
            const char* a3 = a2 + kstep; const char* b3 = b2 + kstep;
            if (last && has_next) S.a_ready(nxt);
            if constexpr (SP2) {
            PG8_LDB(B0, 0, 0); PG8_LDB(B1, 0, 1); PG8_SCHED; PG8_LDA(At, 0, 0); PG8_STAGE(PG8_SA(1, 1), a1 + hstep, voffA);
            PG8_WAIT_V(8); PG8_WAIT_L(0); PG8_BAR; PG8_MMA(0, 0, At, B0); PG8_MMA(0, 1, At, B1); PG8_BAR; PG8_SCHED;
            PG8_LDA(At, 0, 1); PG8_STAGE(PG8_SB(0, 0), b2, voffB); PG8_STAGE(PG8_SB(0, 1), b2 + hstep, voffB); PG8_STAGE(PG8_SA(0, 0), a2, voffA);
            PG8_WAIT_V(8); PG8_WAIT_L(0); PG8_BAR; PG8_MMA(1, 0, At, B0); PG8_MMA(1, 1, At, B1); PG8_BAR; PG8_SCHED;
            PG8_LDB(B0, 1, 0); PG8_LDB(B1, 1, 1); PG8_SCHED; PG8_LDA(At, 1, 0); PG8_STAGE(PG8_SA(0, 1), a2 + hstep, voffA);
            PG8_WAIT_V(8); PG8_WAIT_L(0); PG8_BAR; PG8_MMA(0, 0, At, B0); PG8_MMA(0, 1, At, B1); PG8_BAR; PG8_SCHED;
            PG8_LDA(At, 1, 1); PG8_STAGE(PG8_SB(1, 0), b3, voffB); PG8_STAGE(PG8_SB(1, 1), b3 + hstep, voffB); PG8_STAGE(PG8_SA(1, 0), a3, voffA);
            PG8_WAIT_V(8); PG8_WAIT_L(0); PG8_BAR; PG8_MMA(1, 0, At, B0); PG8_MMA(1, 1, At, B1); PG8_BAR; PG8_SCHED;
            } else {
            PG8_LDB(B0, 0, 0); PG8_SCHED; PG8_LDA(At, 0, 0); PG8_STAGE(PG8_SA(1, 1), a1 + hstep, voffA);
            PG8_WAIT_L(8); PG8_BAR; PG8_WAIT_L(0); PG8_MMA(0, 0, At, B0); PG8_BAR; PG8_SCHED;
            PG8_LDB(B1, 0, 1); PG8_STAGE(PG8_SB(0, 0), b2, voffB);
            PG8_BAR; PG8_WAIT_L(0); PG8_MMA(0, 1, At, B1); PG8_BAR;
            PG8_LDA(At, 0, 1); PG8_STAGE(PG8_SA(0, 0), a2, voffA);
            PG8_BAR; PG8_WAIT_L(0); PG8_MMA(1, 0, At, B0); PG8_BAR; PG8_SCHED;
            PG8_STAGE(PG8_SB(0, 1), b2 + hstep, voffB);
            PG8_WAIT_V(6); PG8_BAR; PG8_MMA(1, 1, At, B1); PG8_BAR;
            PG8_LDB(B0, 1, 0); PG8_SCHED; PG8_LDA(At, 1, 0); PG8_STAGE(PG8_SA(0, 1), a2 + hstep, voffA);
            PG8_WAIT_L(8); PG8_BAR; PG8_WAIT_L(0); PG8_MMA(0, 0, At, B0); PG8_BAR; PG8_SCHED;
            PG8_LDB(B1, 1, 1); PG8_STAGE(PG8_SB(1, 0), b3, voffB);
            PG8_BAR; PG8_WAIT_L(0); PG8_MMA(0, 1, At, B1); PG8_BAR;
            PG8_LDA(At, 1, 1); PG8_STAGE(PG8_SA(1, 0), a3, voffA);
            PG8_BAR; PG8_WAIT_L(0); PG8_MMA(1, 0, At, B0); PG8_BAR; PG8_SCHED;
            PG8_STAGE(PG8_SB(1, 1), b3 + hstep, voffB);
            PG8_WAIT_V(6); PG8_BAR; PG8_MMA(1, 1, At, B1); PG8_BAR;
            }
        }
        if constexpr (ALIGN_EPI) { if (wr == 0) PG8_BAR; }
        if constexpr (!Epi::AFTER_DRAIN) { E(acc, cur, wr, wc, fr, fq); S.done(cur); }
        if (!has_next) break;
#pragma unroll
        for (int a = 0; a < 2; ++a)
#pragma unroll
            for (int b = 0; b < 2; ++b)
#pragma unroll
                for (int m = 0; m < 4; ++m)
#pragma unroll
                    for (int n = 0; n < 2; ++n) acc[a][b][m][n] = (f32x4){0.f, 0.f, 0.f, 0.f};
        cur = nxt; cA = nA; cB = nB; ++ui;
        if constexpr (ALIGN_EPI) { if (wr == 1) PG8_BAR; }
    }
    PG8_WAIT_V(0);
    if constexpr (!ALIGN_EPI) { if (wr == 0) PG8_BAR; }
    PG8_BAR;
    if constexpr (Epi::AFTER_DRAIN) { E.fused(acc, cur, wr, wc, fr, fq, lds, wid, lane); S.done(cur); }
#undef PG8_SA
#undef PG8_SB
#undef PG8_STAGE
#undef PG8_LDA
#undef PG8_LDB
#undef PG8_MMA
#undef PG8_WAIT_V
#undef PG8_WAIT_L
#undef PG8_BAR
#undef PG8_SCHED
}
}
#define GAS __attribute__((address_space(1)))
#define LAS __attribute__((address_space(3)))
typedef unsigned v4u __attribute__((ext_vector_type(4)));
typedef float f32x4 __attribute__((ext_vector_type(4)));
typedef short bf16x8 __attribute__((ext_vector_type(8)));
typedef GAS unsigned gu32;
typedef GAS unsigned long long gu64;
#define RLX_AGENT __ATOMIC_RELAXED, __HIP_MEMORY_SCOPE_AGENT
#define LDS_WAIT() asm volatile("s_waitcnt lgkmcnt(0)" ::: "memory")
#define VM_WAIT() asm volatile("s_waitcnt vmcnt(0)" ::: "memory")
__device__ __forceinline__ unsigned long long rt() { return __builtin_amdgcn_s_memrealtime(); }

#define XB_TMO      128
#define XB_XCNT(j)  (256  + 64 * (j))
#define XB_XSUB(j)  (1280 + 64 * (j))
#define XB_XGEN(j)  (2304 + 64 * (j))
#define XB_TOP      3328
#define XB_TOPGEN   3392
#define XCD_BAR_WORDS 3456
#define XB_SPIN_CAP (1u << 18)

__device__ __forceinline__ unsigned xb_ld(unsigned* p)              { return __hip_atomic_load(p, __ATOMIC_RELAXED, __HIP_MEMORY_SCOPE_AGENT); }
__device__ __forceinline__ unsigned xb_add(unsigned* p, unsigned v) { return __hip_atomic_fetch_add(p, v, __ATOMIC_RELAXED, __HIP_MEMORY_SCOPE_AGENT); }
__device__ __forceinline__ unsigned xb_xcc_id() { return (unsigned)__builtin_amdgcn_s_getreg((3 << 11) | 20) & 0xFu; }
#define XB_SPIN(cond, bar) do { unsigned _sp = 0; while (cond) { __builtin_amdgcn_s_sleep(1); \
    if ((++_sp & 255u) == 0u) { if (xb_ld(&(bar)[XB_TMO])) break; if (_sp > XB_SPIN_CAP) { atomicAdd(&(bar)[XB_TMO], 1u); break; } } } } while (0)

struct XcdBarrier {
    unsigned* bar; unsigned x;
    volatile LAS unsigned* st;
};

__device__ __forceinline__ XcdBarrier xcd_barrier_post(unsigned* bar, volatile LAS unsigned* st) {
    XcdBarrier b; b.bar = bar; b.x = xb_xcc_id(); b.st = st;
    if (threadIdx.x == 0) (void)xb_add(&bar[XB_XCNT(b.x)], 1u);
    return b;
}
__device__ __forceinline__ void xcd_barrier_complete(unsigned* bar, unsigned x, unsigned& nloc, unsigned& nx) {
    const unsigned G = gridDim.x * gridDim.y * gridDim.z;
    unsigned sum, cnt, mine, sp = 0u;
    for (;;) {
        sum = 0u; cnt = 0u; mine = 0u;
#pragma unroll
        for (unsigned j = 0; j < 16; ++j) { const unsigned c = xb_ld(&bar[XB_XCNT(j)]); sum += c; cnt += (c > 0u) ? 1u : 0u; mine = (j == x) ? c : mine; }
        if (sum == G) break;
        __builtin_amdgcn_s_sleep(1);
        if ((++sp & 255u) == 0u) { if (xb_ld(&bar[XB_TMO])) break; if (sp > XB_SPIN_CAP) { atomicAdd(&bar[XB_TMO], 1u); break; } }
    }
    nloc = mine > 0u ? mine : 1u; nx = cnt > 0u ? cnt : 1u;
}

__device__ __forceinline__ void xcd_barrier(const XcdBarrier& b) {
    asm volatile("s_waitcnt vmcnt(0)" ::: "memory");
    __syncthreads();
    if (threadIdx.x == 0) {
        unsigned* bar = b.bar;
        __builtin_amdgcn_s_waitcnt(0);
        unsigned nloc = b.st[0], nx = b.st[1];
        if (nloc == 0u) { xcd_barrier_complete(bar, b.x, nloc, nx); b.st[0] = nloc; b.st[1] = nx; }
        const unsigned old = xb_add(&bar[XB_XSUB(b.x)], 1u);
        const unsigned gen = old / nloc;
        if (old + 1u == (gen + 1u) * nloc) {
            __builtin_amdgcn_fence(__ATOMIC_RELEASE, "agent");
            asm volatile("s_waitcnt vmcnt(0)" ::: "memory");
            const unsigned og = xb_add(&bar[XB_TOP], 1u);
            const unsigned tg = og / nx;
            if (og + 1u == (tg + 1u) * nx) xb_add(&bar[XB_TOPGEN], 1u);
            else XB_SPIN(xb_ld(&bar[XB_TOPGEN]) == tg, bar);
            __builtin_amdgcn_fence(__ATOMIC_ACQUIRE, "agent");
            xb_add(&bar[XB_XGEN(b.x)], 1u);
            asm volatile("s_waitcnt vmcnt(0)" ::: "memory");
        } else {
            XB_SPIN(xb_ld(&bar[XB_XGEN(b.x)]) == gen, bar);
            __builtin_amdgcn_fence(__ATOMIC_ACQUIRE, "agent");
            asm volatile("s_waitcnt vmcnt(0)" ::: "memory");
        }
    }
    __syncthreads();
}

constexpr int NWAVES = 8;
constexpr int RING_OFF = 0, RING_BYTES = 131072;
constexpr int LDS_BYTES = 163840;
constexpr int LDSCTL_OFF = LDS_BYTES - 512, MISC_OFF = LDSCTL_OFF + 320;
constexpr int CW_BAR = 4096;
constexpr int CW_Q = 16384;
static_assert((CW_BAR + XCD_BAR_WORDS) <= CW_Q && (CW_Q + 64 * 64) * 4 <= (int)CTL_ZERO_BYTES, "CTL words inside the memset region");

constexpr int PROBE_ID = 0;
#define PB_BEGIN(id) long long pb_t0_##id = 0; if (PROBE_ID == (id)) pb_t0_##id = clock64();
#define PB_END(id) if (PROBE_ID == (id)) { const long long t1_ = clock64(), dt_ = t1_ - pb_t0_##id; while (clock64() - t1_ < dt_) __builtin_amdgcn_s_sleep(2); }
struct Frame {
    LAS unsigned char* lds;
    volatile LAS unsigned* MISC;
    gu32* ctl;
    int tid, lane, wave, vcu, G;
    Ins I; float* out;
    bf16 *WinT, *WoutT, *XN, *Q, *K, *V, *AU, *XBC, *Gb, *Zb; float *DT, *SSQ, *RAWB;
};

template <class SrcF>
__device__ __forceinline__ void p0_transpose_item(SrcF src, int k0, int n0, bf16* WT, int dst_pitch, int dst_row0, int dst_k0, LAS float* scr, int lane) {
#pragma unroll 8
    for (int i = 0; i < 32; ++i) { const int kk = 2 * i + (lane >> 5); scr[kk * 33 + (lane & 31)] = src(k0 + kk, n0 + (lane & 31)); }
    LDS_WAIT(); asm volatile("" ::: "memory");
    const int c = lane & 7;
#pragma unroll
    for (int j = 0; j < 4; ++j) { const int n = (lane >> 3) + 8 * j; const LAS float* s = scr + (8 * c) * 33 + n;
        v4u o; o.x = pk2(s[0 * 33], s[1 * 33]); o.y = pk2(s[2 * 33], s[3 * 33]); o.z = pk2(s[4 * 33], s[5 * 33]); o.w = pk2(s[6 * 33], s[7 * 33]);
        *(GAS v4u*)(WT + (size_t)(dst_row0 + n) * dst_pitch + dst_k0 + 8 * c) = o; }
    LDS_WAIT(); asm volatile("" ::: "memory");
}
constexpr int P0_SCR_BYTES = 8448, WDT_OFF = NWAVES * P0_SCR_BYTES, WDT_PITCH = 20;
static_assert(WDT_OFF + 1024 * WDT_PITCH * 4 <= LDSCTL_OFF, "prologue LDS");

__device__ __forceinline__ void p0_prologue(Frame& F) {
    const Ins& I = F.I;
    LAS float* scr = (LAS float*)(F.lds + F.wave * P0_SCR_BYTES);
    LAS float* wdt = (LAS float*)(F.lds + WDT_OFF);
    const int gw = F.vcu * NWAVES + F.wave, NGW = F.G * NWAVES;
    {
        float wv[32], nv[32];
#pragma unroll
        for (int q = 0; q < 32; ++q) { const int idx = F.tid + q * (NWAVES * 64), k = idx >> 4, j = idx & 15; wv[q] = I.w_in[(size_t)k * NPROJ + C_DT + j]; nv[q] = I.norm_w[k]; }
#pragma unroll
        for (int q = 0; q < 32; ++q) { const int idx = F.tid + q * (NWAVES * 64), k = idx >> 4, j = idx & 15, pos = (((k >> 8) * 4 + (k & 3)) << 6) + ((k >> 2) & 63); wdt[pos * WDT_PITCH + j] = wv[q] * nv[q]; }
    }
    constexpr int I_IN = (DM / 64) * (NMAIN / 32), I_OUT = (2048 / 64) * (DM / 32);
    for (int it = gw; it < I_IN + I_OUT; it += NGW) {
        if (it < I_IN) {
            const int nblk = NMAIN / 32, kb = it / nblk, nb = it % nblk, k0 = 64 * kb, n0 = 32 * nb;
            p0_transpose_item([&](int k, int n) { return I.w_in[(size_t)k * NPROJ + n] * I.norm_w[k]; }, k0, n0, F.WinT, DM, (n0 & ~255) + vrow_of_col(n0 & 255), k0, scr, F.lane);
        } else {
            const int r = it - I_IN, nblk = DM / 32, kb = r / nblk, nb = r % nblk, k0 = 64 * kb, n0 = 32 * nb;
            p0_transpose_item([&](int k, int n) { const float nw = I.ssd_norm_w[k & 1023]; return I.w_out[(size_t)k * DM + n] * (k >= 1024 ? nw : 1.f); },     k0, n0, F.WoutT, 2048, (n0 & ~255) + vrow_of_col(n0 & 255), (k0 + 1024) & 2047, scr, F.lane);
        }
    }
    __syncthreads();
    for (int rp = gw; rp < NROWS / 2; rp += NGW) {
        f32x4 v[2][4]; float rstd[2];
#pragma unroll
        for (int q = 0; q < 2; ++q) {
            const GAS f32x4* xr = (const GAS f32x4*)xrow(I, 2 * rp + q) + F.lane; float s = 0.f;
#pragma unroll
            for (int j = 0; j < 4; ++j) { v[q][j] = xr[64 * j]; s += (v[q][j].x * v[q][j].x + v[q][j].y * v[q][j].y) + (v[q][j].z * v[q][j].z + v[q][j].w * v[q][j].w); }
            rstd[q] = rsqrtf(wave_sum(s) * (1.f / DM) + EPS);
            GAS unsigned long long* o8 = (GAS unsigned long long*)(F.XN + (size_t)(2 * rp + q) * DM) + F.lane;
#pragma unroll
            for (int j = 0; j < 4; ++j) o8[64 * j] = (unsigned long long)pk2(v[q][j].x * rstd[q], v[q][j].y * rstd[q]) | ((unsigned long long)pk2(v[q][j].z * rstd[q], v[q][j].w * rstd[q]) << 32);
        }
        float a[32];
#pragma unroll
        for (int i = 0; i < 32; ++i) a[i] = 0.f;
#pragma unroll
        for (int j = 0; j < 4; ++j)
#pragma unroll
            for (int e = 0; e < 4; ++e) {
                const LAS f32x4* wp = (const LAS f32x4*)(wdt + ((j * 4 + e) * 64 + F.lane) * WDT_PITCH);
                const float x0 = v[0][j][e], x1 = v[1][j][e];
#pragma unroll
                for (int c4 = 0; c4 < 4; ++c4) { const f32x4 w = wp[c4];
#pragma unroll
                    for (int i = 0; i < 4; ++i) { a[c4 * 4 + i] += x0 * w[i]; a[16 + c4 * 4 + i] += x1 * w[i]; } }
                asm volatile("" ::: "memory");
            }
#define P0_HALVE(N, X) { const bool up = (F.lane & (X)) != 0; _Pragma("unroll") for (int i = 0; i < (N); ++i) { const float keep = up ? a[i + (N)] : a[i], send = up ? a[i] : a[i + (N)]; a[i] = keep + __shfl_xor(send, (X)); } }
        P0_HALVE(16, 32) P0_HALVE(8, 16) P0_HALVE(4, 8) P0_HALVE(2, 4) P0_HALVE(1, 2)
#undef P0_HALVE
        float tot = a[0] + __shfl_xor(a[0], 1);
        const int idx = F.lane >> 1, q = idx >> 4, c = idx & 15;
        tot = tot * (q ? rstd[1] : rstd[0]) + I.dt_bias[c];
        if ((F.lane & 1) == 0) F.DT[(size_t)c * MROWS + 2 * rp + q] = softplus_f(tot);
    }
    { v4u* zk = (v4u*)((unsigned char*)F.K - 4 * MiB); v4u* zv = (v4u*)((unsigned char*)F.V - 4 * MiB);
      for (size_t i = (size_t)F.vcu * NWAVES * 64 + F.tid; i < 4 * MiB / 16; i += (size_t)F.G * NWAVES * 64) {
          if (i * 16 >= 4 * MiB - (WS_K - (WS_Q + (size_t)MROWS * DM * 2))) zk[i] = (v4u){0u, 0u, 0u, 0u};
          if (i * 16 >= 4 * MiB - (WS_V - (WS_K + (size_t)MROWS * DM * 2))) zv[i] = (v4u){0u, 0u, 0u, 0u}; } }
    for (int r = NROWS + gw; r < MROWS; r += NGW) { GAS v4u* o = (GAS v4u*)(F.XN + (size_t)r * DM) + F.lane; o[0] = (v4u){0u, 0u, 0u, 0u}; o[64] = (v4u){0u, 0u, 0u, 0u};
                                                   GAS v4u* k = (GAS v4u*)(F.K + (size_t)r * DM) + F.lane; k[0] = (v4u){0u, 0u, 0u, 0u}; k[64] = (v4u){0u, 0u, 0u, 0u}; }
    for (int i = (F.vcu * NWAVES * 64 + F.tid); i < DB * 2 * CONVD; i += F.G * NWAVES * 64) {
        const int c = i % CONVD, rr = i / CONVD, j = rr & 1, b = rr >> 1;
        F.out[O_CS + ((size_t)b * 3 + j) * CONVD + c] = I.sconv[((size_t)b * 3 + j + 1) * CONVD + c];
    }
}

namespace att {
typedef float f32x16 __attribute__((ext_vector_type(16)));
typedef short v4i16_t __attribute__((ext_vector_type(4)));
typedef unsigned u32x4 __attribute__((ext_vector_type(4)));
constexpr int SPAN = 512, NSPAN = SEQ / SPAN, NUNITS = NB * NH * NSPAN;
constexpr int OPITCH = 64  , OACC_OFF = 0, LACC_OFF = SPAN * OPITCH * 4, LUT_OFF = LACC_OFF + 2048, LUTP = 192  , VST_OFF = LUT_OFF + 3072, VST_BYTES = 2048  , ATT_LDS_END = VST_OFF + NWAVES * VST_BYTES;
static_assert(ATT_LDS_END <= LDSCTL_OFF, "attention LDS");
__device__ __forceinline__ int crow(int r, int hi) { return (r & 3) + 8 * (r >> 2) + 4 * hi; }

struct ItemRegs { bf16x8 qf[4]; v4u kreg[4], vreg[4]; unsigned koff, voff; };
__device__ __forceinline__ int first_tile(int tq0, int d) { const int k = (97 * d - tq0 + 32 * d - 1) / (32 * d); return k < 0 ? 0 : (k > 4 ? 4 : k); }
struct ItemOut { f32x16 o0, o1; float lsum; };
#define ATT_LOAD_K(R, KT) do { const char* kb_ = (const char*)Kb + ((long)(tq0 + (-128 + 32 * (KT)) * d) * DM) * 2; \
        _Pragma("unroll") for (int i = 0; i < 4; ++i) (R).kreg[i] = *(const v4u*)(kb_ + (R).koff + (unsigned)((i & 1) * 16 * d * DM * 2) + 64 * (i >> 1)); } while (0)
#define ATT_LOAD_V(R, KT) do { const char* vb_ = (const char*)Vb + ((long)(tq0 + (-128 + 32 * (KT)) * d) * DM) * 2; \
        _Pragma("unroll") for (int i = 0; i < 4; ++i) (R).vreg[i] = *(const v4u*)(vb_ + (R).voff + (unsigned)(i * 8 * d * DM * 2)); } while (0)
template <int NQ>
__device__ __forceinline__ void item_load(ItemRegs& R, const bf16* Qb, const bf16* Kb, const bf16* Vb, int tq0, int d, int lane) {
    const int c = lane & 31, hi = lane >> 5;
    const bf16* qp = Qb + (size_t)(tq0 + (NQ == 32 ? c : (c & 15)) * d) * DM + 8 * hi;
#pragma unroll
    for (int ks = 0; ks < 4; ++ks) R.qf[ks] = *(const bf16x8*)(qp + 16 * ks);
    R.koff = (unsigned)(((lane >> 2) * d * DM + 8 * (lane & 3)) * 2); R.voff = (unsigned)(((lane >> 3) * d * DM + 8 * (lane & 7)) * 2);
    { const int kt0 = 97 * d - tq0 > 0 ? first_tile(tq0, d) : 0; ATT_LOAD_K(R, kt0); ATT_LOAD_V(R, kt0); }
}
template <int NQ>
__device__ __forceinline__ void item_tiles(ItemRegs& R, ItemOut& O, const bf16* Kb, const bf16* Vb, int tq0, int d, int pat, LAS unsigned char* lds, int wave, int lane) {
    const int c = lane & 31, hi = lane >> 5;
    LAS unsigned char* vst = lds + VST_OFF + wave * VST_BYTES;
    const LAS float* lut = (const LAS float*)(lds + LUT_OFF) + pat * LUTP + 31;
    f32x16 o0 = {}, o1 = {};
    float lsum = 0.f;
    const int lrow = lane >> 3, lch = lane & 7;
    const int stoff = lrow * 128 + ((lch ^ lrow) << 4);
    const int kwoff = (lane >> 2) * 64 + (((lane & 3) ^ ((lane >> 4) & 3)) << 4);
    const int q4 = (lane & 15) >> 2, odd = (lane >> 4) & 1, p4 = lane & 3;
#pragma unroll 1
    for (int kt = (97 * d - tq0 > 0 ? first_tile(tq0, d) : 0); kt < 5; ++kt) {
        bf16x8 kf[4];
#pragma unroll
        for (int h2 = 0; h2 < 2; ++h2) {
#pragma unroll
            for (int i = 0; i < 2; ++i) *(LAS v4u*)(vst + i * 1024 + kwoff) = R.kreg[2 * h2 + i];
#pragma unroll
            for (int ksl = 0; ksl < 2; ++ksl) kf[2 * h2 + ksl] = *(const LAS bf16x8*)(vst + c * 64 + (((2 * ksl + hi) ^ ((c >> 2) & 3)) << 4));
        }
        bf16x8 vb[2][2];
#pragma unroll
        for (int s = 0; s < 2; ++s) {
#pragma unroll
            for (int i = 0; i < 2; ++i) *(LAS v4u*)(vst + i * 1024 + stoff) = R.vreg[2 * s + i];
#pragma unroll
            for (int dh = 0; dh < 2; ++dh) {
                const int kr = 4 * hi + q4, ch16 = 4 * dh + 2 * odd + (p4 >> 1);
                const LAS unsigned char* vp0 = vst + kr * 128 + ((ch16 ^ (kr & 7)) << 4) + (p4 & 1) * 8;
                const LAS unsigned char* vp1 = vst + (kr + 8) * 128 + ((ch16 ^ (kr & 7)) << 4) + (p4 & 1) * 8;
                const v4i16_t lo = __builtin_amdgcn_ds_read_tr16_b64_v4i16((LAS v4i16_t*)vp0), hh = __builtin_amdgcn_ds_read_tr16_b64_v4i16((LAS v4i16_t*)vp1);
                vb[s][dh] = (bf16x8){lo[0], lo[1], lo[2], lo[3], hh[0], hh[1], hh[2], hh[3]};
            }
        }
        asm volatile("" ::: "memory");
        if (kt < 4) { ATT_LOAD_K(R, kt + 1); ATT_LOAD_V(R, kt + 1); }
        const int relb = c + 128 - 32 * kt - 4 * hi, tkb = tq0 + (-128 + 32 * kt + 4 * hi) * d;
        const bool edge = tq0 + (-128 + 32 * kt) * d < 0;
        f32x16 st;
        if (edge) {
#pragma unroll
            for (int r = 0; r < 16; ++r) { const int rel = relb - ((r & 3) + 8 * (r >> 2)); st[r] = lut[rel < 0 ? 0 : (rel > 128 ? 128 : rel)]; }
        } else {
#pragma unroll
            for (int r = 0; r < 16; ++r) st[r] = lut[relb - ((r & 3) + 8 * (r >> 2))];
        }
#pragma unroll
        for (int ks = 0; ks < 4; ++ks) st = __builtin_amdgcn_mfma_f32_32x32x16_bf16(kf[ks], R.qf[ks], st, 0, 0, 0);
        if (edge) {
#pragma unroll
            for (int r = 0; r < 16; ++r) {
                const int kk = (r & 3) + 8 * (r >> 2), rel = relb - kk;
                const bool valid = (rel >= 0) && (rel <= 128) && (tkb + kk * d >= 0);
                const float pe = __builtin_amdgcn_exp2f(st[r]), p = valid ? pe : 0.f;
                st[r] = p; lsum += p;
            }
        } else {
#pragma unroll
            for (int r = 0; r < 16; ++r) { const float p = __builtin_amdgcn_exp2f(st[r]); st[r] = p; lsum += p; }
        }
        u32x4 pw0, pw1;
        pw0.x = cvtpk_s(st[0], st[1]); pw0.y = cvtpk_s(st[2], st[3]); pw0.z = cvtpk_s(st[4], st[5]); pw0.w = cvtpk_s(st[6], st[7]);
        pw1.x = cvtpk_s(st[8], st[9]); pw1.y = cvtpk_s(st[10], st[11]); pw1.z = cvtpk_s(st[12], st[13]); pw1.w = cvtpk_s(st[14], st[15]);
        const bf16x8 pa0 = __builtin_bit_cast(bf16x8, pw0), pa1 = __builtin_bit_cast(bf16x8, pw1);
        o0 = __builtin_amdgcn_mfma_f32_32x32x16_bf16(pa0, vb[0][0], o0, 0, 0, 0);
        o1 = __builtin_amdgcn_mfma_f32_32x32x16_bf16(pa0, vb[0][1], o1, 0, 0, 0);
        o0 = __builtin_amdgcn_mfma_f32_32x32x16_bf16(pa1, vb[1][0], o0, 0, 0, 0);
        o1 = __builtin_amdgcn_mfma_f32_32x32x16_bf16(pa1, vb[1][1], o1, 0, 0, 0);
    }
    lsum += __shfl_xor(lsum, 32);
    O.o0 = o0; O.o1 = o1; O.lsum = lsum;
}
template <int NQ, bool ACC>
__device__ __forceinline__ void item_acc(const ItemOut& O, int toff, int d, LAS unsigned char* lds, int lane) {
    const int c = lane & 31, hi = lane >> 5;
    LAS float* oacc = (LAS float*)(lds + OACC_OFF); LAS float* lacc = (LAS float*)(lds + LACC_OFF);
    constexpr int NR = NQ == 32 ? 16 : 8;
    LAS float* base = oacc + (toff + 4 * hi * d) * OPITCH + c;
    float a0[NR], a1[NR], lo = 0.f;
    if (ACC) {
#pragma unroll
        for (int r = 0; r < NR; ++r) { const LAS float* row = base + ((r & 3) + 8 * (r >> 2)) * d * OPITCH; a0[r] = row[0]; a1[r] = row[32]; }
        if (hi == 0 && c < NQ) lo = lacc[toff + c * d];
        asm volatile("" ::: "memory");
    }
#pragma unroll
    for (int r = 0; r < NR; ++r) { LAS float* row = base + ((r & 3) + 8 * (r >> 2)) * d * OPITCH; row[0] = ACC ? a0[r] + O.o0[r] : O.o0[r]; row[32] = ACC ? a1[r] + O.o1[r] : O.o1[r]; }
    if (hi == 0 && c < NQ) lacc[toff + c * d] = ACC ? lo + O.lsum : O.lsum;
}

__device__ __forceinline__ void unit(Frame& F, int uidx, int& lut_h) {
    const int span = uidx % NSPAN, bh = uidx / NSPAN, h = bh % NH, b = bh / NH, t0 = span * SPAN;
    LAS unsigned char* lds = F.lds;
    LAS float* oacc = (LAS float*)(lds + OACC_OFF); LAS float* lacc = (LAS float*)(lds + LACC_OFF); LAS float* lut = (LAS float*)(lds + LUT_OFF);
    const bool newlut = h != lut_h; lut_h = h;
    if (newlut) for (int i = F.tid; i < 3 * LUTP; i += NWAVES * 64) { const int pat = i / LUTP, rel = i - pat * LUTP - 31, d = pat == 0 ? 1 : (pat == 1 ? 4 : 16);
        lut[i] = (rel >= 0 && rel <= 128) ? F.I.rel_bias[t5_bucket(rel * d) * NH + h] * LOG2E : -1e30f; }
    const size_t boff = (size_t)b * SEQ * DM + h * HD;
    const bf16 *Qb = F.Q + boff, *Kb = F.K + boff, *Vb = F.V + boff;
    const int w = F.wave, lane = F.lane;
    ItemRegs R; ItemOut O;
    const int tqA0 = t0 + 64 * w, tqA1 = tqA0 + 32, tqB0 = t0 + (w & 3) + 256 * (w >> 2), tqB1 = tqB0 + 128, tqC0 = t0 + w, tqC1 = t0 + w + 8;
    item_load<32>(R, Qb, Kb, Vb, tqA0, 1, lane);
    if (newlut) __syncthreads();
    item_tiles<32>(R, O, Kb, Vb, tqA0, 1, 0, lds, w, lane);
    item_load<32>(R, Qb, Kb, Vb, tqA1, 1, lane);
    item_acc<32, false>(O, tqA0 - t0, 1, lds, lane);
    item_tiles<32>(R, O, Kb, Vb, tqA1, 1, 0, lds, w, lane);
    item_load<32>(R, Qb, Kb, Vb, tqB0, 4, lane);
    item_acc<32, false>(O, tqA1 - t0, 1, lds, lane);
    __syncthreads();
    item_tiles<32>(R, O, Kb, Vb, tqB0, 4, 1, lds, w, lane);
    item_load<32>(R, Qb, Kb, Vb, tqB1, 4, lane);
    item_acc<32, true>(O, tqB0 - t0, 4, lds, lane);
    item_tiles<32>(R, O, Kb, Vb, tqB1, 4, 1, lds, w, lane);
    item_load<32>(R, Qb, Kb, Vb, tqC0, 16, lane);
    item_acc<32, true>(O, tqB1 - t0, 4, lds, lane);
    __syncthreads();
    item_tiles<32>(R, O, Kb, Vb, tqC0, 16, 2, lds, w, lane);
    item_load<32>(R, Qb, Kb, Vb, tqC1, 16, lane);
    item_acc<32, true>(O, tqC0 - t0, 16, lds, lane);
    item_tiles<32>(R, O, Kb, Vb, tqC1, 16, 2, lds, w, lane);
    item_acc<32, true>(O, tqC1 - t0, 16, lds, lane);
    v4u g[2][4];
#pragma unroll
    for (int ps = 0; ps < 2; ++ps) { const bf16* gp = F.Gb + ((size_t)b * SEQ + t0 + 64 * w + 32 * ps + (lane >> 1)) * DM + h * HD + 32 * (lane & 1);
#pragma unroll
        for (int j4 = 0; j4 < 4; ++j4) g[ps][j4] = *(const v4u*)(gp + 8 * j4); }
    __syncthreads();
#pragma unroll
    for (int ps = 0; ps < 2; ++ps) {
        const int tl = 64 * w + 32 * ps + (lane >> 1), hf = lane & 1;
        bf16* ap = F.AU + ((size_t)b * SEQ + t0 + tl) * 2048 + 1024 + h * HD + 32 * hf;
        const float rl = __builtin_amdgcn_rcpf(lacc[tl]);
        const LAS f32x4* op = (const LAS f32x4*)(oacc + tl * OPITCH + 32 * hf);
#pragma unroll
        for (int j4 = 0; j4 < 4; ++j4) {
            const f32x4 a = op[2 * j4], bq = op[2 * j4 + 1]; const v4u gg = g[ps][j4];
            v4u o;
            o.x = cvtpk_s(a[0] * rl * __uint_as_float(gg.x << 16), a[1] * rl * __uint_as_float(gg.x & 0xffff0000u));
            o.y = cvtpk_s(a[2] * rl * __uint_as_float(gg.y << 16), a[3] * rl * __uint_as_float(gg.y & 0xffff0000u));
            o.z = cvtpk_s(bq[0] * rl * __uint_as_float(gg.z << 16), bq[1] * rl * __uint_as_float(gg.z & 0xffff0000u));
            o.w = cvtpk_s(bq[2] * rl * __uint_as_float(gg.w << 16), bq[3] * rl * __uint_as_float(gg.w & 0xffff0000u));
            *(v4u*)(ap + 8 * j4) = o;
        }
    }
    __syncthreads();
}

}

namespace ssd {
typedef float f32x16 __attribute__((ext_vector_type(16)));
typedef short v4i16_t __attribute__((ext_vector_type(4)));
typedef unsigned u32x2 __attribute__((ext_vector_type(2)));
typedef float f32x2v __attribute__((ext_vector_type(2)));
constexpr int PITCH = 272;
constexpr int BT_OFF = 0, CT_OFF = 34816, G_OFF = 69632, HB_OFF = 104448, XD_OFF = 121856, XH_OFF = 138240, ACS_OFF = 154624, DTL_OFF = ACS_OFF + 512, SSQL_OFF = DTL_OFF + 512  , XW_OFF = SSQL_OFF + 1024  , FW_OFF = XW_OFF + 1280  , SSD_LDS_END = FW_OFF + 5120;
static_assert(SSD_LDS_END <= LDSCTL_OFF, "SSD LDS");
__device__ __forceinline__ int crow(int r, int hi) { return (r & 3) + 8 * (r >> 2) + 4 * hi; }
__device__ __forceinline__ bf16x8 trfrag(const LAS unsigned char* p0, const LAS unsigned char* p1) {
    const v4i16_t lo = __builtin_amdgcn_ds_read_tr16_b64_v4i16((LAS v4i16_t*)p0), hh = __builtin_amdgcn_ds_read_tr16_b64_v4i16((LAS v4i16_t*)p1);
    return (bf16x8){lo[0], lo[1], lo[2], lo[3], hh[0], hh[1], hh[2], hh[3]};
}
__device__ __forceinline__ float bflo(unsigned w) { return __uint_as_float(w << 16); }
__device__ __forceinline__ float bfhi(unsigned w) { return __uint_as_float(w & 0xffff0000u); }

constexpr int NSEG = 2;
__device__ __forceinline__ int seg_begin(int s) { return NSEG == 2 ? (s == 0 ? 0 : (s == 1 ? 32 : 64)) : (s == 0 ? 0 : (s == 1 ? 20 : (s == 2 ? 42 : 64))); }
__device__ __forceinline__ void chain(Frame& F, int item) {
    const Ins& I = F.I;
    const int bg = item / (8 * NSEG), li = item % (8 * NSEG), b = bg >> 1, hd = (bg & 1) * 8 + li / NSEG, seg = li % NSEG, grp = hd >> 3;
    constexpr int NCH = SEQ / 128; const int ch_begin = seg_begin(seg), ch_end = seg_begin(seg + 1);
    const int tid = F.tid, lane = F.lane, w = F.wave, c = lane & 31, hi = lane >> 5;
    LAS unsigned char* lds = F.lds;
    LAS float* acs = (LAS float*)(lds + ACS_OFF); LAS float* dtl = (LAS float*)(lds + DTL_OFF); LAS float* ssql = (LAS float*)(lds + SSQL_OFF);
    const float A = -__expf(I.a_log[hd]), dsk = I.d_skip[hd];
    const size_t row0 = (size_t)b * SEQ;
    for (int i = tid; i < 17408 / 16; i += NWAVES * 64) ((LAS v4u*)(lds + HB_OFF))[i] = (v4u){0u, 0u, 0u, 0u};
    f32x16 hacc = {};
    const int pt = w & 1, jt = w >> 1;
    const int q4 = (lane & 15) >> 2, odd = (lane >> 4) & 1, p4 = lane & 3;
    const int xtr = (8 * hi + q4) * 64 + (16 * odd + 4 * p4) * 2;
    const int xg = tid & 15, xr0 = (tid >> 4) * 4;
    const int fb = tid >> 8, fc = tid & 255;
    for (int i = tid; i < 5 * 64 + 5 * 256; i += NWAVES * 64) {
        if (i < 320) { const int t = i >> 6, e = i & 63; ((LAS float*)(lds + XW_OFF))[i] = t < 4 ? I.conv_w[t * CONVD + hd * 64 + e] : I.conv_b[hd * 64 + e]; }
        else { const int k = i - 320, t = k >> 8, e = k & 255, chn = 1024 + (e < 128 ? grp * 128 + e : 256 + grp * 128 + (e - 128)); ((LAS float*)(lds + FW_OFF))[k] = t < 4 ? I.conv_w[t * CONVD + chn] : I.conv_b[chn]; }
    }
    const int xoff = ((xg >> 3) << 10) + (xg & 7) * 8;
    float dtp0, dtp1; u32x2 xr[7]; v4u bcr[8]; float fxr[6]; u32x2 zr[4];
#define SSD_PREFETCH(T0) do { int t0_ = (T0), tv_ = tid, lv_ = lane; asm volatile("" : "+v"(t0_), "+v"(tv_), "+v"(lv_)); \
        const int xg_ = tv_ & 15, xr0_ = (tv_ >> 4) * 4, fb_ = tv_ >> 8, fc_ = tv_ & 255, fch_ = fc_ < 128 ? grp * 128 + fc_ : 256 + grp * 128 + (fc_ - 128); \
        { const float* dp_ = F.DT + (size_t)hd * MROWS + row0 + t0_ + 2 * lv_; dtp0 = dp_[0]; dtp1 = dp_[1]; } \
        { const bf16* xp_ = F.XBC + (row0 + t0_ + xr0_) * CONVD + hd * 64 + 4 * xg_; \
          _Pragma("unroll") for (int j = 0; j < 7; ++j) xr[j] = (t0_ + xr0_ - 3 + j) >= 0 ? *(const u32x2*)(xp_ + (j - 3) * CONVD) : (u32x2){0u, 0u}; } \
        { const bf16* bp_ = F.XBC + (row0 + t0_ + (tv_ >> 4)) * CONVD + 1024 + grp * 128 + 8 * (tv_ & 15); \
          _Pragma("unroll") for (int k = 0; k < 4; ++k) { bcr[k] = *(const v4u*)(bp_ + (size_t)k * 32 * CONVD); bcr[4 + k] = *(const v4u*)(bp_ + (size_t)k * 32 * CONVD + 256); } } \
        { const size_t blk = (row0 + t0_ + 64 * fb_) >> 6; const bool hasprev = (t0_ + 64 * fb_) > 0; const float* rp_ = F.RAWB + (blk * 6) * 512 + fch_; \
          _Pragma("unroll") for (int j = 0; j < 3; ++j) { fxr[j] = hasprev ? rp_[(j - 6) * 512] : 0.f; fxr[3 + j] = rp_[(3 + j) * 512]; } } \
    } while (0)
#define SSD_PREFETCH_Z(T0) do { int t0_ = (T0), lv_ = lane; asm volatile("" : "+v"(t0_), "+v"(lv_)); \
        const bf16* zp_ = F.Zb + (row0 + t0_ + 32 * jt + (lv_ & 31)) * DM + hd * 64 + 32 * pt + 4 * (lv_ >> 5); \
        _Pragma("unroll") for (int g4 = 0; g4 < 4; ++g4) zr[g4] = *(const u32x2*)(zp_ + 8 * g4); } while (0)
    __syncthreads();
    if (ch_begin > 0) {
        float dq[4]; u32x2 xr2[11]; v4u bcr2[8]; float fxr2[6];
        LAS float* det = (LAS float*)(lds + ACS_OFF);
#define SSD_PRE2_PREFETCH(T0) do { int t0_ = (T0), tv_ = tid, lv_ = lane; asm volatile("" : "+v"(t0_), "+v"(tv_), "+v"(lv_)); \
        const int xg_ = tv_ & 15, xr0_ = (tv_ >> 4) * 8, fb_ = tv_ >> 7, fch_ = grp * 128 + (tv_ & 127); \
        { const float* dp_ = F.DT + (size_t)hd * MROWS + row0 + t0_ + 2 * lv_; dq[0] = dp_[0]; dq[1] = dp_[1]; dq[2] = dp_[128]; dq[3] = dp_[129]; } \
        { const bf16* xp_ = F.XBC + (row0 + t0_ + xr0_) * CONVD + hd * 64 + 4 * xg_; \
          _Pragma("unroll") for (int j = 0; j < 11; ++j) xr2[j] = (t0_ + xr0_ - 3 + j) >= 0 ? *(const u32x2*)(xp_ + (j - 3) * CONVD) : (u32x2){0u, 0u}; } \
        { const bf16* bp_ = F.XBC + (row0 + t0_ + (tv_ >> 4)) * CONVD + 1024 + grp * 128 + 8 * (tv_ & 15); \
          _Pragma("unroll") for (int k = 0; k < 8; ++k) bcr2[k] = *(const v4u*)(bp_ + (size_t)k * 32 * CONVD); } \
        { const size_t blk = (row0 + t0_ + 64 * fb_) >> 6; const bool hasprev = (t0_ + 64 * fb_) > 0; const float* rp_ = F.RAWB + (blk * 6) * 512 + fch_; \
          _Pragma("unroll") for (int j = 0; j < 3; ++j) { fxr2[j] = hasprev ? rp_[(j - 6) * 512] : 0.f; fxr2[3 + j] = rp_[(3 + j) * 512]; } } \
    } while (0)
        SSD_PRE2_PREFETCH(0);
#pragma unroll 1
        for (int cp = 0; cp < ch_begin / 2; ++cp) {
            const int t0 = cp * 256;
            float atot;
            {
                const float v0 = dq[0] * A, v1 = dq[1] * A, v2 = dq[2] * A, v3 = dq[3] * A; float s1 = v0 + v1, s2 = v2 + v3;
#define SSD_DPP_ADD2(S, CTRL, RMASK, BC) S += __builtin_bit_cast(float, __builtin_amdgcn_update_dpp(0, __builtin_bit_cast(int, S), CTRL, RMASK, 0xf, BC))
                SSD_DPP_ADD2(s1, 0x111, 0xf, true); SSD_DPP_ADD2(s1, 0x112, 0xf, true); SSD_DPP_ADD2(s1, 0x114, 0xf, true); SSD_DPP_ADD2(s1, 0x118, 0xf, true); SSD_DPP_ADD2(s1, 0x142, 0xa, false); SSD_DPP_ADD2(s1, 0x143, 0xc, false);
                SSD_DPP_ADD2(s2, 0x111, 0xf, true); SSD_DPP_ADD2(s2, 0x112, 0xf, true); SSD_DPP_ADD2(s2, 0x114, 0xf, true); SSD_DPP_ADD2(s2, 0x118, 0xf, true); SSD_DPP_ADD2(s2, 0x142, 0xa, false); SSD_DPP_ADD2(s2, 0x143, 0xc, false);
#undef SSD_DPP_ADD2
                const float tot1 = __builtin_bit_cast(float, __builtin_amdgcn_readlane(__builtin_bit_cast(int, s1), 63));
                const float tot2 = __builtin_bit_cast(float, __builtin_amdgcn_readlane(__builtin_bit_cast(int, s2), 63));
                atot = tot1 + tot2;
                *(LAS f32x2v*)(det + 2 * lane) = (f32x2v){dq[0] * __expf(atot - (s1 - v1)), dq[1] * __expf(atot - s1)};
                *(LAS f32x2v*)(det + 128 + 2 * lane) = (f32x2v){dq[2] * __expf(tot2 - (s2 - v3)), dq[3] * __expf(tot2 - s2)};
            }
#pragma unroll
            for (int k = 0; k < 8; ++k) { const int row = (tid >> 4) + 32 * k; if ((row & 63) >= 3) *(LAS v4u*)(lds + BT_OFF + row * PITCH + 16 * (tid & 15)) = bcr2[k]; }
            {   const int fb2 = tid >> 7, fc2 = tid & 127;
                LAS unsigned char* dst = lds + BT_OFF + 2 * fc2 + 64 * fb2 * PITCH;
                const LAS float* fwp = (const LAS float*)(lds + FW_OFF) + fc2;
                const float fw0 = fwp[0], fw1 = fwp[256], fw2 = fwp[512], fw3 = fwp[768], fbias = fwp[1024];
#pragma unroll
                for (int j = 0; j < 3; ++j) *(LAS bf16*)(dst + j * PITCH) = (bf16)f2bf(silu_fast(fbias + fw0 * fxr2[j] + fw1 * fxr2[j + 1] + fw2 * fxr2[j + 2] + fw3 * fxr2[j + 3]));
            }
            {
                const LAS f32x4* xwp = (const LAS f32x4*)(lds + XW_OFF) + xg;
                const f32x4 xw0 = xwp[0], xw1 = xwp[16], xw2 = xwp[32], xw3 = xwp[48], xb = xwp[64];
                float xv[11][4];
#pragma unroll
                for (int j = 0; j < 11; ++j) { xv[j][0] = bflo(xr2[j].x); xv[j][1] = bfhi(xr2[j].x); xv[j][2] = bflo(xr2[j].y); xv[j][3] = bfhi(xr2[j].y); }
                const int xr8 = (tid >> 4) * 8;
#pragma unroll
                for (int i = 0; i < 8; ++i) {
                    const int s = xr8 + i; const float de = det[s]; float v[4];
#pragma unroll
                    for (int e = 0; e < 4; ++e) v[e] = silu_fast(xb[e] + xw0[e] * xv[i][e] + xw1[e] * xv[i + 1][e] + xw2[e] * xv[i + 2][e] + xw3[e] * xv[i + 3][e]);
                    *(LAS u32x2*)(lds + G_OFF + ((s >> 4) << 11) + xoff + (s & 15) * 64) = (u32x2){cvtpk_s(v[0] * de, v[1] * de), cvtpk_s(v[2] * de, v[3] * de)};
                }
            }
            asm volatile("" ::: "memory"); __builtin_amdgcn_sched_barrier(0);
            if (cp + 1 < ch_begin / 2) SSD_PRE2_PREFETCH(t0 + 256);
            __syncthreads();
            {   const float ea = __expf(atot);
#pragma unroll
                for (int r = 0; r < 16; ++r) hacc[r] *= ea;
                const int btr = (8 * hi + q4) * PITCH + (32 * jt + 16 * odd + 4 * p4) * 2;
#pragma unroll 4
                for (int ks = 0; ks < 16; ++ks) {
                    const LAS unsigned char* xp = lds + G_OFF + ((ks * 2 + pt) << 10) + xtr;
                    const LAS unsigned char* bp = lds + BT_OFF + 16 * ks * PITCH + btr;
                    hacc = __builtin_amdgcn_mfma_f32_32x32x16_bf16(trfrag(xp, xp + 256), trfrag(bp, bp + 4 * PITCH), hacc, 0, 0, 0);
                }
            }
            __syncthreads();
        }
#undef SSD_PRE2_PREFETCH
#pragma unroll
        for (int r = 0; r < 16; ++r) *(LAS bf16*)(lds + HB_OFF + (32 * pt + crow(r, hi)) * PITCH + (32 * jt + c) * 2) = (bf16)f2bf(hacc[r]);
        __syncthreads();
    }
    SSD_PREFETCH(ch_begin * 128); SSD_PREFETCH_Z(ch_begin * 128);
#pragma unroll 1
    for (int ch = ch_begin; ch < ch_end; ++ch) {
        const int t0 = ch * 128;
        const bool pre = false, prevfull = ch > ch_begin;
        float aend;
        {
            if (w < 2 && prevfull) { F.SSQ[(row0 + t0 - 128 + lane) * 32 + 2 * hd + w] = ssql[128 * w + lane]; F.SSQ[(row0 + t0 - 64 + lane) * 32 + 2 * hd + w] = ssql[128 * w + 64 + lane]; }
            const float v0 = dtp0 * A, v1 = dtp1 * A; float s = v0 + v1;
#define SSD_DPP_ADD(CTRL, RMASK, BC) s += __builtin_bit_cast(float, __builtin_amdgcn_update_dpp(0, __builtin_bit_cast(int, s), CTRL, RMASK, 0xf, BC))
            SSD_DPP_ADD(0x111, 0xf, true); SSD_DPP_ADD(0x112, 0xf, true); SSD_DPP_ADD(0x114, 0xf, true); SSD_DPP_ADD(0x118, 0xf, true);
            SSD_DPP_ADD(0x142, 0xa, false); SSD_DPP_ADD(0x143, 0xc, false);
#undef SSD_DPP_ADD
            aend = __builtin_bit_cast(float, __builtin_amdgcn_readlane(__builtin_bit_cast(int, s), 63));
            *(LAS f32x2v*)(acs + 2 * lane) = (f32x2v){s - v1, s}; *(LAS f32x2v*)(dtl + 2 * lane) = (f32x2v){dtp0, dtp1};
        }
#pragma unroll
        for (int k = 0; k < 4; ++k) { const int idx = tid + 512 * k, row = idx >> 4;
            if ((row & 63) >= 3) { *(LAS v4u*)(lds + BT_OFF + row * PITCH + 16 * (idx & 15)) = bcr[k]; if (!pre) *(LAS v4u*)(lds + CT_OFF + row * PITCH + 16 * (idx & 15)) = bcr[4 + k]; } }
        if (!pre || fc < 128) {
            LAS unsigned char* dst = lds + (fc < 128 ? BT_OFF + 2 * fc : CT_OFF + 2 * (fc - 128)) + 64 * fb * PITCH;
            const LAS float* fwp = (const LAS float*)(lds + FW_OFF) + fc;
            const float fw0 = fwp[0], fw1 = fwp[256], fw2 = fwp[512], fw3 = fwp[768], fbias = fwp[1024];
#pragma unroll
            for (int j = 0; j < 3; ++j) *(LAS bf16*)(dst + j * PITCH) = (bf16)f2bf(silu_fast(fbias + fw0 * fxr[j] + fw1 * fxr[j + 1] + fw2 * fxr[j + 2] + fw3 * fxr[j + 3]));
        }
        {
            const LAS f32x4* xwp = (const LAS f32x4*)(lds + XW_OFF) + xg;
            const f32x4 xw0 = xwp[0], xw1 = xwp[16], xw2 = xwp[32], xw3 = xwp[48], xb = xwp[64];
            float xv[7][4];
#pragma unroll
            for (int j = 0; j < 7; ++j) { xv[j][0] = bflo(xr[j].x); xv[j][1] = bfhi(xr[j].x); xv[j][2] = bflo(xr[j].y); xv[j][3] = bfhi(xr[j].y); }
#pragma unroll
            for (int i = 0; i < 4; ++i) {
                const int s = xr0 + i; const float dt = dtl[s], de = dt * __expf(aend - acs[s]); float v[4];
#pragma unroll
                for (int e = 0; e < 4; ++e) v[e] = silu_fast(xb[e] + xw0[e] * xv[i][e] + xw1[e] * xv[i + 1][e] + xw2[e] * xv[i + 2][e] + xw3[e] * xv[i + 3][e]);
                const int off = ((s >> 4) << 11) + xoff + (s & 15) * 64;
                if (!pre) *(LAS u32x2*)(lds + XD_OFF + off) = (u32x2){cvtpk_s(v[0] * dt, v[1] * dt), cvtpk_s(v[2] * dt, v[3] * dt)};
                *(LAS u32x2*)(lds + XH_OFF + off) = (u32x2){cvtpk_s(v[0] * de, v[1] * de), cvtpk_s(v[2] * de, v[3] * de)};
            }
        }
        asm volatile("" ::: "memory"); __builtin_amdgcn_sched_barrier(0);
        if (ch + 1 < ch_end) SSD_PREFETCH(t0 + 128);
        __syncthreads();
        f32x16 yt = {};
        if (!pre) {
        {
            const int j = w & 3; const float al = acs[32 * j + c];
#pragma unroll
            for (int ii = 0; ii < 2; ++ii) {
                const int i = 2 * (w >> 2) + ii;
                if (i <= j) {
                    f32x16 x = {};
                    const LAS unsigned char* ap = lds + BT_OFF + (32 * i + c) * PITCH + 16 * hi;
                    const LAS unsigned char* bp = lds + CT_OFF + (32 * j + c) * PITCH + 16 * hi;
#pragma unroll 4
                    for (int ks = 0; ks < 8; ++ks) x = __builtin_amdgcn_mfma_f32_32x32x16_bf16(*(const LAS bf16x8*)(ap + 32 * ks), *(const LAS bf16x8*)(bp + 32 * ks), x, 0, 0, 0);
                    const int l = 32 * j + c;
#pragma unroll
                    for (int g4 = 0; g4 < 4; ++g4) {
                        const int sb = 32 * i + 8 * g4 + 4 * hi; float gv[4];
                        const f32x4 as4 = *(const LAS f32x4*)(acs + sb);
#pragma unroll
                        for (int e = 0; e < 4; ++e) { const int s = sb + e; gv[e] = s <= l ? x[4 * g4 + e] * __builtin_amdgcn_exp2f((al - as4[e]) * LOG2E) : 0.f; }
                        *(LAS u32x2*)(lds + G_OFF + l * PITCH + sb * 2) = (u32x2){cvtpk_s(gv[0], gv[1]), cvtpk_s(gv[2], gv[3])};
                    }
                }
            }
        }
        {
            const LAS unsigned char* ap = lds + HB_OFF + (32 * pt + c) * PITCH + 16 * hi;
            const LAS unsigned char* bp = lds + CT_OFF + (32 * jt + c) * PITCH + 16 * hi;
#pragma unroll 4
            for (int ks = 0; ks < 8; ++ks) yt = __builtin_amdgcn_mfma_f32_32x32x16_bf16(*(const LAS bf16x8*)(ap + 32 * ks), *(const LAS bf16x8*)(bp + 32 * ks), yt, 0, 0, 0);
            const float el = __expf(acs[32 * jt + c]);
#pragma unroll
            for (int r = 0; r < 16; ++r) yt[r] *= el;
        }
        __syncthreads();
        {
            const LAS unsigned char* bp = lds + G_OFF + (32 * jt + c) * PITCH + 16 * hi;
            for (int ks = 0; ks < 2 * jt + 2; ++ks) {
                const LAS unsigned char* xp = lds + XD_OFF + ((ks * 2 + pt) << 10) + xtr;
                yt = __builtin_amdgcn_mfma_f32_32x32x16_bf16(trfrag(xp, xp + 256), *(const LAS bf16x8*)(bp + 32 * ks), yt, 0, 0, 0);
            }
        }
        }
        {
            const float ea = __expf(aend);
#pragma unroll
            for (int r = 0; r < 16; ++r) hacc[r] *= ea;
            const int btr = (8 * hi + q4) * PITCH + (32 * jt + 16 * odd + 4 * p4) * 2;
#pragma unroll 4
            for (int ks = 0; ks < 8; ++ks) {
                const LAS unsigned char* xp = lds + XH_OFF + ((ks * 2 + pt) << 10) + xtr;
                const LAS unsigned char* bp = lds + BT_OFF + 16 * ks * PITCH + btr;
                hacc = __builtin_amdgcn_mfma_f32_32x32x16_bf16(trfrag(xp, xp + 256), trfrag(bp, bp + 4 * PITCH), hacc, 0, 0, 0);
            }
        }
        {
#pragma unroll
            for (int r = 0; r < 16; r += 2) {
                *(LAS bf16*)(lds + HB_OFF + (32 * pt + crow(r, hi)) * PITCH + (32 * jt + c) * 2) = (bf16)(cvtpk_s(hacc[r], hacc[r + 1]) & 0xffffu);
                *(LAS bf16*)(lds + HB_OFF + (32 * pt + crow(r + 1, hi)) * PITCH + (32 * jt + c) * 2) = (bf16)(cvtpk_s(hacc[r], hacc[r + 1]) >> 16);
            }
        }
        if (!pre) {
            const int l = 32 * jt + c; const float rdt = dsk * __builtin_amdgcn_rcpf(dtl[l]);
            bf16* up = F.AU + (row0 + t0 + l) * 2048 + hd * 64 + 32 * pt;
            float sq = 0.f;
#pragma unroll
            for (int g4 = 0; g4 < 4; ++g4) {
                const int pl = 8 * g4 + 4 * hi;
                const u32x2 xw2 = *(const LAS u32x2*)(lds + XD_OFF + (((l >> 4) * 2 + pt) << 10) + (l & 15) * 64 + pl * 2);
                const u32x2 zw = zr[g4];
                const float u0 = (yt[4 * g4] + rdt * bflo(xw2.x)) * bflo(zw.x), u1 = (yt[4 * g4 + 1] + rdt * bfhi(xw2.x)) * bfhi(zw.x), u2 = (yt[4 * g4 + 2] + rdt * bflo(xw2.y)) * bflo(zw.y), u3 = (yt[4 * g4 + 3] + rdt * bfhi(xw2.y)) * bfhi(zw.y);
                sq += (u0 * u0 + u1 * u1) + (u2 * u2 + u3 * u3);
                *(u32x2*)(up + pl) = (u32x2){cvtpk_s(u0, u1), cvtpk_s(u2, u3)};
            }
            sq += __shfl_xor(sq, 32);
            if (hi == 0) ssql[128 * pt + l] = sq;
        }
        if (ch + 1 < ch_end) SSD_PREFETCH_Z(t0 + 128);
        __syncthreads();
    }
#undef SSD_PREFETCH
#undef SSD_PREFETCH_Z
    if (w < 2) { const int t0 = ch_end * 128; F.SSQ[(row0 + t0 - 128 + lane) * 32 + 2 * hd + w] = ssql[128 * w + lane]; F.SSQ[(row0 + t0 - 64 + lane) * 32 + 2 * hd + w] = ssql[128 * w + 64 + lane]; }
    if (seg == NSEG - 1) {
    float* ho = F.out + O_HP + (((size_t)b * NH + hd) * HD + 32 * pt) * DS + 32 * jt + c;
#pragma unroll
    for (int r = 0; r < 16; ++r) ho[(size_t)crow(r, hi) * DS] = hacc[r];
    }
    __syncthreads();
}
}

namespace smp {
__device__ __forceinline__ void attn_unit(Frame& F, int bhs) {
    const Ins& I = F.I;
    const int lane = F.lane, w = F.wave, b = bhs >> 4, h = bhs & 15, r = NTOK + b;
    LAS float* qs = (LAS float*)(F.lds + 4096); LAS float* acc = (LAS float*)F.lds;
    LAS float* ps = (LAS float*)(F.lds + 8192) + w * 64;
    if (F.tid < 64) qs[F.tid] = bf2f(F.Q[(size_t)r * DM + h * HD + F.tid]);
    if (F.tid < 65) acc[F.tid] = 0.f;
    const int k0 = 49 * w, nk = (387 - k0) < 49 ? (387 - k0) : 49;
    const float gate = bf2f(F.Gb[(size_t)r * DM + h * HD + lane]);
    const float vnew = bf2f(F.V[(size_t)r * DM + h * HD + lane]), knew = bf2f(F.K[(size_t)r * DM + h * HD + lane]);
    const float* vbase = I.cv + ((size_t)b * WIN * NH + h) * HD + lane;
    float vv[49];
#pragma unroll
    for (int k = 0; k < 49; ++k) {
        const int idx = (k0 + k) < 386 ? (k0 + k) : 386, pat = idx / 129, j = idx - pat * 129, d = pat == 0 ? 1 : (pat == 1 ? 4 : 16), jj = j > 0 ? j : 1;
        vv[k] = vbase[(size_t)(WIN - jj * d) * (NH * HD)];
    }
    const int idx = (k0 + lane) < 386 ? (k0 + lane) : 386, pat = idx / 129, j = idx - pat * 129, d = pat == 0 ? 1 : (pat == 1 ? 4 : 16), jj = j > 0 ? j : 1;
    const float bias = I.rel_bias[t5_bucket(j * d) * NH + h] * LOG2E;
    f32x4 kv[16];
    { const f32x4* kp = (const f32x4*)(I.ck + (((size_t)b * WIN + (WIN - jj * d)) * NH + h) * HD);
#pragma unroll
      for (int e = 0; e < 16; ++e) kv[e] = kp[e]; }
    __syncthreads();
    const float snew = wave_sum(qs[lane] * knew);
    float s = 0.f;
#pragma unroll
    for (int e = 0; e < 16; ++e) { const f32x4 qv = *(const LAS f32x4*)(qs + 4 * e); s += (qv[0] * kv[e][0] + qv[1] * kv[e][1]) + (qv[2] * kv[e][2] + qv[3] * kv[e][3]); }
    const float p = lane < nk ? __builtin_amdgcn_exp2f((j > 0 ? s : snew) + bias) : 0.f;
    ps[lane] = p;
    const float lsum = wave_sum(p);
    __builtin_amdgcn_wave_barrier();
    float o0 = 0.f, o1 = 0.f, o2 = 0.f, o3 = 0.f;
#define SMP_V(K) ({ const int idx_ = (k0 + (K)) < 386 ? (k0 + (K)) : 386; ps[(K)] * ((idx_ % 129) > 0 ? vv[(K)] : vnew); })
#pragma unroll
    for (int k = 0; k < 48; k += 4) { o0 += SMP_V(k); o1 += SMP_V(k + 1); o2 += SMP_V(k + 2); o3 += SMP_V(k + 3); }
    o0 += SMP_V(48);
#undef SMP_V
    __hip_atomic_fetch_add(acc + lane, (o0 + o1) + (o2 + o3), __ATOMIC_RELAXED, __HIP_MEMORY_SCOPE_WORKGROUP);
    if (lane == 0) __hip_atomic_fetch_add(acc + 64, lsum, __ATOMIC_RELAXED, __HIP_MEMORY_SCOPE_WORKGROUP);
    __syncthreads();
    if (w == 0) F.AU[(size_t)r * 2048 + 1024 + h * HD + lane] = (bf16)f2bf(acc[lane] * __builtin_amdgcn_rcpf(acc[64]) * gate);
    __syncthreads();
}

__device__ __forceinline__ void ssd_unit(Frame& F, int bhs) {
    const Ins& I = F.I;
    LAS float* xs_l = (LAS float*)F.lds; LAS float* B_l = xs_l + 64; LAS float* C_l = B_l + 128; LAS float* ssq_l = C_l + 128;
    const int tid = F.tid, p = tid >> 3, ng = tid & 7;
    const int b = bhs >> 4, hd = bhs & 15, grp = hd >> 3; const size_t r = (size_t)NTOK + b;
    float h[16];
    { const f32x4* hp = (const f32x4*)(I.sssm + (((size_t)b * NH + hd) * HD + p) * DS + ng * 16);
#pragma unroll
      for (int i = 0; i < 4; ++i) { const f32x4 v = hp[i]; h[4 * i] = v[0]; h[4 * i + 1] = v[1]; h[4 * i + 2] = v[2]; h[4 * i + 3] = v[3]; } }
    if (tid < 320) {
        const int ci = tid, c = ci < 64 ? hd * 64 + ci : (ci < 192 ? 1024 + grp * 128 + (ci - 64) : 1280 + grp * 128 + (ci - 192));
        float v = I.conv_b[c];
#pragma unroll
        for (int i = 0; i < 3; ++i) v += I.sconv[((size_t)b * 3 + i) * CONVD + c] * I.conv_w[i * CONVD + c];
        v += bf2f(F.XBC[r * CONVD + c]) * I.conv_w[3 * CONVD + c];
        xs_l[ci] = silu_f(v);
    }
    if (tid == 0) ssq_l[0] = 0.f;
    const float dt = F.DT[(size_t)hd * MROWS + r], A = -__expf(I.a_log[hd]), dsk = I.d_skip[hd], zg = bf2f(F.Zb[r * DM + hd * 64 + p]);
    __syncthreads();
    const float x = xs_l[p], dec = __expf(dt * A), xdt = x * dt;
    float y = 0.f;
#pragma unroll
    for (int i = 0; i < 16; ++i) { h[i] = h[i] * dec + xdt * B_l[ng * 16 + i]; y += h[i] * C_l[ng * 16 + i]; }
    y += __shfl_xor(y, 1); y += __shfl_xor(y, 2); y += __shfl_xor(y, 4);
    if (ng == 0) {
        const float u = (y + dsk * x) * zg;
        F.AU[r * 2048 + hd * 64 + p] = (bf16)f2bf(u);
        __hip_atomic_fetch_add(ssq_l, u * u, __ATOMIC_RELAXED, __HIP_MEMORY_SCOPE_WORKGROUP);
    }
    { f32x4* ho = (f32x4*)(F.out + O_HS + (((size_t)b * NH + hd) * HD + p) * DS + ng * 16);
#pragma unroll
      for (int i = 0; i < 4; ++i) ho[i] = (f32x4){h[4 * i], h[4 * i + 1], h[4 * i + 2], h[4 * i + 3]}; }
    __syncthreads();
    if (tid == 0) { F.SSQ[r * 32 + 2 * hd] = ssq_l[0]; F.SSQ[r * 32 + 2 * hd + 1] = 0.f; }
    __syncthreads();
}
}

namespace smp {
typedef float f32x16s __attribute__((ext_vector_type(16)));
template <int KS>
__device__ __forceinline__ void mm32x32(Frame& F, const bf16* WT, int wrow0, const bf16* A, int apitch, int K) {
    const int lane = F.lane, w = F.wave, c = lane & 31, hi = lane >> 5;
    const bf16* ap = WT + (size_t)(wrow0 + c) * K + w * (16 * KS) + 8 * hi;
    const bf16* bp = A + (size_t)c * apitch + w * (16 * KS) + 8 * hi;
    bf16x8 af[KS], bf[KS];
#pragma unroll
    for (int ks = 0; ks < KS; ++ks) { af[ks] = *(const bf16x8*)(ap + 16 * ks); bf[ks] = *(const bf16x8*)(bp + 16 * ks); }
    f32x16s acc = {};
#pragma unroll
    for (int ks = 0; ks < KS; ++ks) acc = __builtin_amdgcn_mfma_f32_32x32x16_bf16(af[ks], bf[ks], acc, 0, 0, 0);
    LAS float* red = (LAS float*)F.lds + w * 1024;
#pragma unroll
    for (int r = 0; r < 16; ++r) red[((r & 3) + 8 * (r >> 2) + 4 * hi) * 32 + c] = acc[r];
    __syncthreads();
}
__device__ __forceinline__ void inproj_pair(Frame& F, int hp) {
    const Ins& I = F.I;
    const int a0 = 64 * hp;
    LAS float* val = (LAS float*)(F.lds + 32768);
    const int lane = F.lane, w = F.wave;
#pragma unroll 1
    for (int hf = 0; hf < 2; ++hf) {
        const int a = a0 + 32 * hf;
        mm32x32<8>(F, F.WinT, (a & ~255) + vrow_of_col(a & 255), F.XN + (size_t)NTOK * DM, DM, DM);
        const LAS float* red = (const LAS float*)F.lds;
        { const int col = F.tid >> 4, r0 = 2 * (F.tid & 15); float s0 = 0.f, s1 = 0.f;
#pragma unroll
          for (int k = 0; k < 8; ++k) { s0 += red[k * 1024 + col * 32 + r0]; s1 += red[k * 1024 + col * 32 + r0 + 1]; }
          val[r0 * 64 + 32 * hf + col] = s0; val[(r0 + 1) * 64 + 32 * hf + col] = s1; }
        __syncthreads();
    }
#pragma unroll 1
    for (int rr = 0; rr < 4; ++rr) {
        const int r = 4 * w + rr;
        const float v = val[r * 64 + lane];
        const size_t row = (size_t)NTOK + r; const int col = a0 + lane;
        if (col < C_V) {
            const float sc = rsqrtf(wave_sum(v * v) * (1.f / 64.f) + EPS);
            if (col < C_K) F.Q[row * DM + col] = (bf16)f2bf(v * sc * I.qnw[lane] * QSCALE);
            else { const float kv = v * sc * I.knw[lane]; F.K[row * DM + col - C_K] = (bf16)f2bf(kv); F.out[O_KS + (size_t)r * DM + col - C_K] = kv; }
        } else if (col < C_G) { F.V[row * DM + col - C_V] = (bf16)f2bf(v); F.out[O_VS + (size_t)r * DM + col - C_V] = v; }
        else if (col < C_Z) F.Gb[row * DM + col - C_G] = (bf16)f2bf(silu_fast(v));
        else if (col < C_XBC) F.Zb[row * DM + col - C_Z] = (bf16)f2bf(silu_fast(v));
        else { F.XBC[row * CONVD + col - C_XBC] = (bf16)f2bf(v); F.out[O_CS + ((size_t)r * 3 + 2) * CONVD + col - C_XBC] = v; }
    }
    __syncthreads();
}
__device__ __forceinline__ void outproj_unit(Frame& F, int ct) {
    const Ins& I = F.I;
    const int a0 = 32 * ct;
    mm32x32<16>(F, F.WoutT, (a0 & ~255) + vrow_of_col(a0 & 255), F.AU + (size_t)NTOK * 2048, 2048, 2048);
    const LAS float* red = (const LAS float*)F.lds;
    const int col = F.tid >> 4, r0 = 2 * (F.tid & 15);
#pragma unroll
    for (int q = 0; q < 2; ++q) {
        const int r = r0 + q; float su = 0.f, sa = 0.f;
#pragma unroll
        for (int k = 0; k < 4; ++k) { su += red[k * 1024 + col * 32 + r]; sa += red[(4 + k) * 1024 + col * 32 + r]; }
        const f32x4* sp = (const f32x4*)(F.SSQ + ((size_t)NTOK + r) * 32); float s = 0.f;
#pragma unroll
        for (int i = 0; i < 8; ++i) { const f32x4 t = sp[i]; s += (t[0] + t[1]) + (t[2] + t[3]); }
        F.out[O_YS + (size_t)r * DM + a0 + col] = I.xs[(size_t)r * DM + a0 + col] + su * rsqrtf(s * (1.f / 1024.f) + EPS) + sa;
    }
    __syncthreads();
}
}

__device__ __forceinline__ void phase2_queue(Frame& F, int qset) {
    const unsigned x = xb_xcc_id() & 7u;
    constexpr int PER_Q = att::NUNITS / 8;
    int lut_h = -1;
    for (unsigned k = 0; k < 8; ++k) {
        const unsigned qx = (x + k) & 7u;
        gu32* qw = F.ctl + CW_Q + 64 * (8 * qset + qx);
        if (k == 1) {
            if (F.tid < 8) F.MISC[24 + F.tid] = __hip_atomic_load(F.ctl + CW_Q + 64 * (8 * qset + F.tid), RLX_AGENT);
            __syncthreads();
        }
        if (k >= 1 && F.MISC[24 + qx] >= (unsigned)(PER_Q + 128)) continue;
        if (F.tid == 0) F.MISC[16] = __hip_atomic_fetch_add(qw, 1u, RLX_AGENT);
        __syncthreads();
        unsigned idx = F.MISC[16];
        while (idx < (unsigned)(PER_Q + 128)) {
            unsigned nxt = 0u;
            if (F.tid == 0) nxt = __hip_atomic_fetch_add(qw, 1u, RLX_AGENT);
            if (idx < (unsigned)PER_Q) { att::unit(F, (int)(qx * PER_Q + idx), lut_h); }
            else if (idx < (unsigned)(PER_Q + 64)) smp::attn_unit(F, (int)(qx * 64 + idx - PER_Q));
            else smp::ssd_unit(F, (int)(qx * 64 + idx - PER_Q - 64));
            if (F.tid == 0) F.MISC[16] = nxt;
            __syncthreads();
            idx = F.MISC[16];
        }
        __syncthreads();
    }
}

constexpr int PROBE_REP_SSD = 1, PROBE_REP_ATT = 1;
struct Args { Ins in; float* out; unsigned char* ws; int ph_lo, ph_hi; };
__global__ void __launch_bounds__(NWAVES * 64, 2) mk_fwd(Args args) {
    extern __shared__ __attribute__((aligned(16))) unsigned char lds[];
    Frame F;
    F.lds = (LAS unsigned char*)lds;
    F.MISC = (volatile LAS unsigned*)(F.lds + MISC_OFF);
    F.tid = threadIdx.x; F.lane = F.tid & 63; F.wave = __builtin_amdgcn_readfirstlane(F.tid >> 6);
    F.G = gridDim.x; { const int bx = blockIdx.x; F.vcu = (F.G % 8 == 0) ? (bx % 8) * (F.G / 8) + bx / 8 : bx; }
    unsigned char* ws = args.ws;
    F.ctl = (gu32*)(ws + WS_CTL); F.I = args.in; F.out = args.out;
    F.WinT = (bf16*)(ws + WS_WIN); F.WoutT = (bf16*)(ws + WS_WOUT); F.XN = (bf16*)(ws + WS_XN); F.Q = (bf16*)(ws + WS_Q); F.K = (bf16*)(ws + WS_K); F.V = (bf16*)(ws + WS_V);
    F.AU = (bf16*)(ws + WS_AU); F.XBC = (bf16*)(ws + WS_XBC); F.DT = (float*)(ws + WS_DT); F.SSQ = (float*)(ws + WS_SSQ); F.RAWB = (float*)(ws + WS_RAWB); F.Gb = (bf16*)(ws + WS_G); F.Zb = (bf16*)(ws + WS_Z);
    for (int u = F.tid; u < (LDS_BYTES - LDSCTL_OFF) / 4; u += NWAVES * 64) ((LAS unsigned*)(F.lds + LDSCTL_OFF))[u] = 0u;
    __syncthreads();
    XcdBarrier bar = xcd_barrier_post((unsigned*)(F.ctl + CW_BAR), F.MISC + 8);
    const int lo = args.ph_lo, hi = args.ph_hi;
#define IN(k) (lo <= (k) && (k) < hi)
#define BOTH(k) (IN(k) && IN((k) + 1))
    if (IN(0)) { p0_prologue(F); if (BOTH(0)) xcd_barrier(bar); }
    if (IN(1)) {
        __syncthreads();
        pg8::Gemm g{F.XN, F.WinT, NTOK, NMAIN, DM}; pg8::StaticOrder S; S.init(NTOK, NMAIN, F.G, (int)blockIdx.x);
        pg8::EpiIn E{F.Q, F.K, F.V, F.Gb, F.Zb, F.XBC, F.out, F.I.qnw, F.I.knw, F.I.conv_w, F.I.conv_b, F.RAWB};
        pg8::gemm_phase<pg8::EpiIn, pg8::StaticOrder, true, true>(F.lds + RING_OFF, g, S, E);
        __syncthreads();
        for (int hp = F.vcu; hp < NMAIN / 64; hp += F.G) smp::inproj_pair(F, hp);
        if (BOTH(1)) xcd_barrier(bar);
    }
    if (IN(2)) { __syncthreads(); if ((F.vcu & 31) < 8 * ssd::NSEG && (F.vcu >> 5) < 8) { ssd::chain(F, (F.vcu >> 5) * (8 * ssd::NSEG) + (F.vcu & 31)); if (PROBE_ID == 30 && (F.vcu & 1)) { const unsigned long long t0_ = __builtin_amdgcn_s_memrealtime(); while (__builtin_amdgcn_s_memrealtime() - t0_ < 10000ull) __builtin_amdgcn_s_sleep(8); } } for (int rep = 0; rep < PROBE_REP_ATT; ++rep) phase2_queue(F, rep);     if (BOTH(2)) xcd_barrier(bar); }
    if (IN(3)) {
        __syncthreads();
        pg8::Gemm g{F.AU, F.WoutT, NTOK, DM, 2048}; pg8::StaticOrder S; S.init(NTOK, DM, F.G, (int)blockIdx.x);
        LAS float* rs = (LAS float*)(F.lds + RING_BYTES);
        { pg8::Unit u;
          for (int ui = 0; ui < 4 && S.next(ui, u); ++ui)
              for (int r = F.tid; r < 256; r += NWAVES * 64) {
                  const f32x4* sp = (const f32x4*)(F.SSQ + (size_t)(u.pm * 256 + r) * 32);
                  float s = 0.f;
#pragma unroll
                  for (int q = 0; q < 8; ++q) { const f32x4 v = sp[q]; s += (v[0] + v[1]) + (v[2] + v[3]); }
                  rs[ui * 256 + r] = rsqrtf(s * (1.f / 1024.f) + EPS);
              }
          __syncthreads(); }
        pg8::EpiOut E{F.I.xp, F.I.xs, rs, F.out};
        pg8::gemm_phase<pg8::EpiOut, pg8::StaticOrder, true, true>(F.lds + RING_OFF, g, S, E);
        __syncthreads();
        for (int ct = F.G - 1 - F.vcu; ct >= 0 && ct < DM / 32; ct += F.G) smp::outproj_unit(F, ct);
    }
#undef IN
#undef BOTH
}

extern "C" void kernel_launch(void* const* d_in, const int* in_sizes, int n_in, void* d_out, int out_size, void* d_ws, size_t ws_size, hipStream_t stream) {
    static int grid = 0;
    if (grid == 0) {
        if (n_in != 18 || out_size != (int)O_END || ws_size < WS_END) { fprintf(stderr, "kernel_launch: unexpected n_in %d / out_size %d / ws_size %zu; nothing launched\n", n_in, out_size, ws_size); grid = -1; return; }
        int dev = 0, cus = 0;
        if (hipGetDevice(&dev) != hipSuccess || hipDeviceGetAttribute(&cus, hipDeviceAttributeMultiprocessorCount, dev) != hipSuccess) { grid = -1; return; }
        if (hipFuncSetAttribute((const void*)mk_fwd, hipFuncAttributeMaxDynamicSharedMemorySize, LDS_BYTES) != hipSuccess) { fprintf(stderr, "kernel_launch: hipFuncSetAttribute failed\n"); grid = -1; return; }
        (void)hipGetLastError();
        grid = cus;
    }
    if (grid < 0) return;
    (void)hipMemsetAsync((char*)d_ws + WS_CTL, 0, CTL_ZERO_BYTES, stream);
    Args a{};
    const float** ip = (const float**)&a.in;
    for (int i = 0; i < 18; ++i) ip[i] = (const float*)d_in[i];
    a.out = (float*)d_out; a.ws = (unsigned char*)d_ws;
    a.ph_lo = 0; a.ph_hi = 4;
    hipLaunchKernelGGL(mk_fwd, dim3(grid), dim3(NWAVES * 64), LDS_BYTES, stream, a);
}
```
